# Optimizing an MI355X kernel written in HIP

```python
import math
import jax, jax.numpy as jnp
from jax import lax
import numpy as np

D_MODEL = 1024
BATCH = 4
SEQ = 8192
DEPTH = 1

NSA_HEADS = 8
NSA_KV_HEADS = 2
HEAD_DIM = 64
CMP_BLOCK = 32
CMP_STRIDE = 16
CMP_HIDDEN = 256
SEL_BLOCK = 64
N_SEL = 16
WINDOW = 512
Q_BLOCK = 64
FORCE_BONUS = 1e3
NEG_INF = -1e30
ROPE_THETA = 500000.0
ROPE_DIM = HEAD_DIM // 4
SSM_WIDTH = D_MODEL // 2
SSM_GROUP = 16
SSM_GROUPS = SSM_WIDTH // SSM_GROUP
SSM_STATE = 64
D_FF = 4 * D_MODEL
EPS = 1e-6

NSA_WIDTH = NSA_HEADS * HEAD_DIM
KV_WIDTH = NSA_KV_HEADS * HEAD_DIM
SPLITS = (NSA_WIDTH, 6 * KV_WIDTH, 3 * NSA_HEADS, SSM_WIDTH, 2 * D_MODEL)
IN_WIDTH = sum(SPLITS)

kernel_name = "hybrid_nsa_s5_gated_block"


def rmsnorm(x, g):
    x32 = x.astype(jnp.float32)
    y = x32 * lax.rsqrt(jnp.mean(x32 * x32, axis=-1, keepdims=True) + EPS)
    return (y * g.astype(jnp.float32)).astype(x.dtype)


def rope_partial(x, pos):
    half = ROPE_DIM // 2
    inv = ROPE_THETA ** (-(jnp.arange(half, dtype=jnp.float32) * 2.0) / ROPE_DIM)
    ang = pos.astype(jnp.float32)[:, None] * inv[None, :]
    cos = jnp.cos(ang)[None, :, None, :]
    sin = jnp.sin(ang)[None, :, None, :]
    x32 = x.astype(jnp.float32)
    x1, x2 = x32[..., :half], x32[..., half:ROPE_DIM]
    out = jnp.concatenate([x1 * cos - x2 * sin, x2 * cos + x1 * sin, x32[..., ROPE_DIM:]], axis=-1)
    return out.astype(x.dtype)


def compress(kv, pe, w1, w2):
    b, s, g, d = kv.shape
    r = kv.reshape(b, s // CMP_STRIDE, CMP_STRIDE, g, d)
    blocks = jnp.concatenate([r[:, :-1], r[:, 1:]], axis=2) + pe[None, None, :, None, :]
    nc = blocks.shape[1]
    flat = blocks.transpose(0, 1, 3, 2, 4).reshape(b, nc, g, CMP_BLOCK * d)
    return jax.nn.gelu(flat @ w1) @ w2


def nsa(q_raw, q_rot, kc, vc, ks, vs, kw, vw, gates):
    b, s, h, d = q_raw.shape
    g = kc.shape[2]
    hg = h // g
    nc = kc.shape[1]
    nb = s // SEL_BLOCK
    n_sel = min(N_SEL, nb)
    scale = d ** -0.5
    q_raw = q_raw.reshape(b, s, g, hg, d)
    q_rot = q_rot.reshape(b, s, g, hg, d)
    gates = gates.reshape(b, s, g, hg, 3)
    cmp_end = jnp.arange(nc) * CMP_STRIDE + CMP_BLOCK - 1
    n_np = np.arange(nc)[:, None] * CMP_STRIDE
    j_np = np.arange(nb)[None, :] * SEL_BLOCK
    overlap = jnp.asarray(((n_np < j_np + SEL_BLOCK) & (n_np + CMP_BLOCK > j_np)).astype(np.float32))
    ks_blk = ks.reshape(b, nb, SEL_BLOCK, g, d).transpose(0, 3, 1, 2, 4)
    vs_blk = vs.reshape(b, nb, SEL_BLOCK, g, d).transpose(0, 3, 1, 2, 4)
    kw_pad = jnp.pad(kw, ((0, 0), (WINDOW, 0), (0, 0), (0, 0)))
    vw_pad = jnp.pad(vw, ((0, 0), (WINDOW, 0), (0, 0), (0, 0)))
    gather = jax.vmap(jax.vmap(lambda blk, idx: blk[idx]))
    jb = jnp.arange(nb)

    def block(i):
        t0 = i * Q_BLOCK
        tq = t0 + jnp.arange(Q_BLOCK)
        sl = lambda a: lax.dynamic_slice_in_dim(a, t0, Q_BLOCK, axis=1)
        qr, qp, gt = sl(q_raw), sl(q_rot), sl(gates).astype(jnp.float32)
        mask_c = cmp_end[None, :] <= tq[:, None]
        s_c = jnp.einsum('bqghd,bngd->bghqn', qr, kc).astype(jnp.float32) * scale
        p_c = jax.nn.softmax(jnp.where(mask_c, s_c, NEG_INF), axis=-1)
        p_c = p_c * jnp.any(mask_c, axis=-1)[:, None].astype(jnp.float32)
        o_c = jnp.einsum('bghqn,bngd->bqghd', p_c.astype(vc.dtype), vc)
        imp = jnp.einsum('bghqn,nj->bgqj', p_c, overlap)
        cur = tq // SEL_BLOCK
        valid_j = jb[None, :] * SEL_BLOCK <= tq[:, None]
        forced = (jb[None, :] == 0) | (jb[None, :] == cur[:, None]) | (jb[None, :] == cur[:, None] - 1)
        score = jnp.where(valid_j, imp + FORCE_BONUS * forced.astype(jnp.float32), NEG_INF)
        _, idx = lax.top_k(score, n_sel)
        k_sel = gather(ks_blk, idx).reshape(b, g, Q_BLOCK, n_sel * SEL_BLOCK, d)
        v_sel = gather(vs_blk, idx).reshape(b, g, Q_BLOCK, n_sel * SEL_BLOCK, d)
        kpos = (idx[..., None] * SEL_BLOCK + jnp.arange(SEL_BLOCK)).reshape(b, g, Q_BLOCK, n_sel * SEL_BLOCK)
        mask_s = kpos <= tq[:, None]
        s_s = jnp.einsum('bqghd,bgqkd->bghqk', qp, k_sel).astype(jnp.float32) * scale
        p_s = jax.nn.softmax(jnp.where(mask_s[:, :, None], s_s, NEG_INF), axis=-1)
        o_s = jnp.einsum('bghqk,bgqkd->bqghd', p_s.astype(v_sel.dtype), v_sel)
        kwb = lax.dynamic_slice_in_dim(kw_pad, t0, WINDOW + Q_BLOCK, axis=1)
        vwb = lax.dynamic_slice_in_dim(vw_pad, t0, WINDOW + Q_BLOCK, axis=1)
        kp = t0 - WINDOW + jnp.arange(WINDOW + Q_BLOCK)
        mask_w = (kp[None, :] <= tq[:, None]) & (kp[None, :] > tq[:, None] - WINDOW) & (kp[None, :] >= 0)
        s_w = jnp.einsum('bqghd,bkgd->bghqk', qp, kwb).astype(jnp.float32) * scale
        p_w = jax.nn.softmax(jnp.where(mask_w, s_w, NEG_INF), axis=-1)
        o_w = jnp.einsum('bghqk,bkgd->bqghd', p_w.astype(vwb.dtype), vwb)
        out = gt[..., 0:1] * o_c + gt[..., 1:2] * o_s + gt[..., 2:3] * o_w
        return out.reshape(b, Q_BLOCK, h * d).astype(q_raw.dtype)

    out = lax.map(block, jnp.arange(s // Q_BLOCK))
    return out.transpose(1, 0, 2, 3).reshape(b, s, h * d)


def _scan_op(e1, e2):
    a1, b1 = e1
    a2, b2 = e2
    return a1 * a2, a2 * b1 + b2


def s5(u, lam_re, lam_im, log_step, b_re, b_im, c_re, c_im, d_skip):
    b, s, _ = u.shape
    f32 = jnp.float32
    u32 = u.astype(f32).reshape(b, s, SSM_GROUPS, SSM_GROUP)
    lam = lax.complex(lam_re.astype(f32), lam_im.astype(f32))
    step = jnp.exp(log_step.astype(f32))[:, None]
    lam_bar = jnp.exp(lam * step)
    b_bar = ((lam_bar - 1.0) / lam)[..., None] * lax.complex(b_re.astype(f32), b_im.astype(f32))
    bu = jnp.einsum('bsgc,gnc->bsgn', u32.astype(jnp.complex64), b_bar)
    a = jnp.broadcast_to(lam_bar, bu.shape)
    _, hs = lax.associative_scan(_scan_op, (a, bu), axis=1)
    cc = lax.complex(c_re.astype(f32), c_im.astype(f32))
    y = jnp.real(jnp.einsum('bsgn,gcn->bsgc', hs, cc)) + d_skip.astype(f32).reshape(SSM_GROUPS, SSM_GROUP) * u32
    return y.reshape(b, s, SSM_WIDTH).astype(u.dtype)


def setup_inputs(seed: int = 0) -> dict:
    key = jax.random.key(seed)
    ks = jax.random.split(key, 24)
    nrm = lambda k, shape, fan: jax.random.normal(k, shape, jnp.float32) * fan ** -0.5
    L = DEPTH
    n_idx = jnp.arange(SSM_STATE, dtype=jnp.float32)
    return {
        "x": jax.random.normal(ks[0], (BATCH, SEQ, D_MODEL), jnp.float32),
        "norm_mix_g": 1.0 + 0.02 * jax.random.normal(ks[1], (L, D_MODEL), jnp.float32),
        "w_in": nrm(ks[2], (L, D_MODEL, IN_WIDTH), D_MODEL),
        "cmp_pe": 0.02 * jax.random.normal(ks[3], (L, CMP_BLOCK, HEAD_DIM), jnp.float32),
        "cmp_k_w1": nrm(ks[4], (L, CMP_BLOCK * HEAD_DIM, CMP_HIDDEN), CMP_BLOCK * HEAD_DIM),
        "cmp_k_w2": nrm(ks[5], (L, CMP_HIDDEN, HEAD_DIM), CMP_HIDDEN),
        "cmp_v_w1": nrm(ks[6], (L, CMP_BLOCK * HEAD_DIM, CMP_HIDDEN), CMP_BLOCK * HEAD_DIM),
        "cmp_v_w2": nrm(ks[7], (L, CMP_HIDDEN, HEAD_DIM), CMP_HIDDEN),
        "ssm_lam_re": -0.5 * jnp.exp(0.05 * jax.random.normal(ks[8], (L, SSM_GROUPS, SSM_STATE), jnp.float32)),
        "ssm_lam_im": jnp.broadcast_to(math.pi * n_idx, (L, SSM_GROUPS, SSM_STATE)),
        "ssm_log_step": jax.random.uniform(ks[9], (L, SSM_GROUPS), jnp.float32, math.log(1e-3), math.log(1e-1)),
        "ssm_b_re": nrm(ks[10], (L, SSM_GROUPS, SSM_STATE, SSM_GROUP), 2 * SSM_GROUP),
        "ssm_b_im": nrm(ks[11], (L, SSM_GROUPS, SSM_STATE, SSM_GROUP), 2 * SSM_GROUP),
        "ssm_c_re": nrm(ks[12], (L, SSM_GROUPS, SSM_GROUP, SSM_STATE), SSM_STATE),
        "ssm_c_im": nrm(ks[13], (L, SSM_GROUPS, SSM_GROUP, SSM_STATE), SSM_STATE),
        "ssm_d": jax.random.normal(ks[14], (L, SSM_WIDTH), jnp.float32),
        "w_attn_branch": nrm(ks[15], (L, NSA_WIDTH, D_MODEL), NSA_WIDTH),
        "w_ssm_val": nrm(ks[16], (L, SSM_WIDTH, D_MODEL), SSM_WIDTH),
        "w_ssm_gate": nrm(ks[17], (L, SSM_WIDTH, D_MODEL), SSM_WIDTH),
        "w_out": nrm(ks[18], (L, D_MODEL, D_MODEL), D_MODEL),
        "norm_mlp_g": 1.0 + 0.02 * jax.random.normal(ks[19], (L, D_MODEL), jnp.float32),
        "w_up": nrm(ks[20], (L, D_MODEL, D_FF), D_MODEL),
        "w_down": nrm(ks[21], (L, D_FF, D_MODEL), D_FF),
        "norm_final_g": 1.0 + 0.02 * jax.random.normal(ks[22], (D_MODEL,), jnp.float32),
    }


def reference(x, norm_mix_g, w_in, cmp_pe, cmp_k_w1, cmp_k_w2, cmp_v_w1, cmp_v_w2,
              ssm_lam_re, ssm_lam_im, ssm_log_step, ssm_b_re, ssm_b_im, ssm_c_re, ssm_c_im, ssm_d,
              w_attn_branch, w_ssm_val, w_ssm_gate, w_out, norm_mlp_g, w_up, w_down, norm_final_g):
    b, s, _ = x.shape
    pos = jnp.arange(s)
    offs = [int(v) for v in np.cumsum(SPLITS)[:-1]]
    for l in range(DEPTH):
        h = rmsnorm(x, norm_mix_g[l])
        proj = h @ w_in[l]
        q, kv, nsa_g, u, merge_g = jnp.split(proj, offs, axis=-1)
        q = q.reshape(b, s, NSA_HEADS, HEAD_DIM)
        kv = kv.reshape(b, s, 6, NSA_KV_HEADS, HEAD_DIM)
        k_c, v_c, k_s, v_s, k_w, v_w = (kv[:, :, i] for i in range(6))
        q_rot = rope_partial(q, pos)
        k_s = rope_partial(k_s, pos)
        k_w = rope_partial(k_w, pos)
        kc = compress(k_c, cmp_pe[l], cmp_k_w1[l], cmp_k_w2[l])
        vc = compress(v_c, cmp_pe[l], cmp_v_w1[l], cmp_v_w2[l])
        gates = jax.nn.sigmoid(nsa_g.astype(jnp.float32)).reshape(b, s, NSA_HEADS, 3)
        y_a = nsa(q, q_rot, kc, vc, k_s, v_s, k_w, v_w, gates) @ w_attn_branch[l]
        y_ssm = jax.nn.gelu(s5(u, ssm_lam_re[l], ssm_lam_im[l], ssm_log_step[l], ssm_b_re[l], ssm_b_im[l],
                               ssm_c_re[l], ssm_c_im[l], ssm_d[l]))
        y_b = (y_ssm @ w_ssm_val[l]) * jax.nn.sigmoid(y_ssm @ w_ssm_gate[l])
        g_a, g_b = jnp.split(merge_g, 2, axis=-1)
        merged = jax.nn.sigmoid(g_a) * y_a + jax.nn.sigmoid(g_b) * y_b
        x = x + merged @ w_out[l]
        h2 = rmsnorm(x, norm_mlp_g[l])
        x = x + jnp.square(jax.nn.relu(h2 @ w_up[l])) @ w_down[l]
    return rmsnorm(x, norm_final_g)
```

```cpp
#include <hip/hip_runtime.h>
#include <hip/hip_cooperative_groups.h>
#include <cstdio>
namespace cg = cooperative_groups;

#ifndef MULTI_LAUNCH
#define MULTI_LAUNCH 0
#endif

#define DI __device__ __forceinline__
typedef unsigned short u16;
typedef unsigned long long u64;
using bf16x8 = __attribute__((ext_vector_type(8))) short;
using f32x4 = __attribute__((ext_vector_type(4))) float;
using u32x4 = __attribute__((ext_vector_type(4))) unsigned;

constexpr int B_ = 4, S_ = 8192, T_ = B_ * S_;
constexpr int NINP = 3968;

constexpr size_t MB = 1024 * 1024;
constexpr size_t OFF_WINT = 0;
constexpr size_t OFF_W1KT = OFF_WINT + (size_t)NINP * 1024 * 2;
constexpr size_t OFF_W1VT = OFF_W1KT + 256 * 2048 * 2;
constexpr size_t OFF_W2KT = OFF_W1VT + 256 * 2048 * 2;
constexpr size_t OFF_W2VT = OFF_W2KT + 128 * 256 * 2;
constexpr size_t OFF_WAT = OFF_W2VT + 128 * 256 * 2;
constexpr size_t OFF_WVT = OFF_WAT + 1024 * 512 * 2;
constexpr size_t OFF_WGT = OFF_WVT + 1024 * 512 * 2;
constexpr size_t OFF_WOT = OFF_WGT + 1024 * 512 * 2;
constexpr size_t OFF_WUPT = OFF_WOT + 1024 * 1024 * 2;
constexpr size_t OFF_WDT = OFF_WUPT + 4096 * 1024 * 2;
constexpr size_t OFF_ROPE = OFF_WDT + 4096 * 1024 * 2;
constexpr size_t OFF_CBIAS = OFF_ROPE + 8192 * 16 * 4;
constexpr size_t OFF_CTR = OFF_CBIAS + 2 * 256 * 4;
constexpr size_t OFF_SS1 = OFF_CTR + 256;
constexpr size_t OFF_SS2 = OFF_SS1 + (size_t)T_ * 16 * 4;
constexpr size_t OFF_NG = OFF_SS2 + (size_t)T_ * 16 * 4;
constexpr size_t OFF_HC = OFF_NG + (size_t)T_ * 24 * 4;
constexpr size_t OFF_KCC = OFF_HC + 2 * 4096 * 256 * 2;
constexpr size_t OFF_VCT = OFF_KCC + 8 * 512 * 64 * 2;
constexpr size_t OFF_HLOC = OFF_VCT + 8 * 512 * 64 * 2;
constexpr size_t OFF_ARENA = OFF_HLOC + (size_t)4 * 128 * 32 * 64 * 8;
constexpr size_t OFF_MG = OFF_ARENA;
constexpr size_t OFF_HN = OFF_ARENA + 128 * MB;
constexpr size_t OFF_QRAW = OFF_ARENA + 192 * MB;
constexpr size_t OFF_QROT = OFF_ARENA + 224 * MB;
constexpr size_t OFF_KCIN = OFF_ARENA + 256 * MB;
constexpr size_t OFF_VCIN = OFF_KCIN + 8 * MB;
constexpr size_t OFF_KS = OFF_VCIN + 8 * MB;
constexpr size_t OFF_VST = OFF_KS + 8 * MB;
constexpr size_t OFF_KW = OFF_VST + 8 * MB;
constexpr size_t OFF_VWT = OFF_KW + 8 * MB;
constexpr size_t OFF_U = OFF_ARENA + 304 * MB;
constexpr size_t OFF_NSA = OFF_ARENA + 336 * MB;
constexpr size_t OFF_YS = OFF_ARENA + 368 * MB;
constexpr size_t WS_NEED = OFF_ARENA + 400 * MB;
constexpr size_t OFF_ACT = OFF_ARENA;
constexpr size_t OFF_X1B = OFF_ARENA + 256 * MB;
constexpr size_t OFF_MERGED = OFF_HN;

constexpr int SMEM_BYTES = 58368;

struct Params {
  const float *x, *g1, *w_in, *pe, *kw1, *kw2, *vw1, *vw2, *lam_re, *lam_im, *log_step, *b_re, *b_im, *c_re, *c_im, *dsk,
      *w_attn, *w_val, *w_gate, *w_out, *g2, *w_up, *w_down, *g3;
  float* out;
  unsigned char* ws;
  int lo, hi;
};

DI u16 f2bf(float x) { unsigned u = __float_as_uint(x); u += 0x7fffu + ((u >> 16) & 1u); return (u16)(u >> 16); }
DI float bf2f(u16 h) { return __uint_as_float(((unsigned)h) << 16); }
DI unsigned pk2(float a, float b) { return (unsigned)f2bf(a) | ((unsigned)f2bf(b) << 16); }
DI float sigmoidf_(float x) { return 1.f / (1.f + __expf(-x)); }
DI float gelu_t(float x) {
  float u = 0.7978845608f * (x + 0.044715f * x * x * x);
  float e = __expf(2.f * u);
  float th = 1.f - 2.f / (e + 1.f);
  return 0.5f * x * (1.f + th);
}
DI float wave_sum(float v) {
#pragma unroll
  for (int o = 32; o > 0; o >>= 1) v += __shfl_xor(v, o);
  return v;
}
DI f32x4 mfma16(bf16x8 a, bf16x8 b, f32x4 c) { return __builtin_amdgcn_mfma_f32_16x16x32_bf16(a, b, c, 0, 0, 0); }

DI void gemm_core(f32x4 (&acc)[4][4], const u16* __restrict__ A, int lda, const u16* __restrict__ Bt, int ldb, int K,
                  unsigned char* smem) {
  u16* sA = (u16*)smem;
  u16* sB = sA + 128 * 72;
  const int tid = threadIdx.x, lane = tid & 63, wv = tid >> 6, l15 = lane & 15, lg = lane >> 4;
  const int wm = wv >> 1, wn = wv & 1;
  const int lrow = tid >> 3, lpart = tid & 7;
  const u16* ga = A + (size_t)lrow * lda + lpart * 8;
  const u16* gb = Bt + (size_t)lrow * ldb + lpart * 8;
  u32x4 ra0, ra1, ra2, ra3, rb0, rb1, rb2, rb3;
#define GLOAD(KO)                                                 \
  ra0 = *(const u32x4*)(ga + (KO));                               \
  ra1 = *(const u32x4*)(ga + (size_t)32 * lda + (KO));            \
  ra2 = *(const u32x4*)(ga + (size_t)64 * lda + (KO));            \
  ra3 = *(const u32x4*)(ga + (size_t)96 * lda + (KO));            \
  rb0 = *(const u32x4*)(gb + (KO));                               \
  rb1 = *(const u32x4*)(gb + (size_t)32 * ldb + (KO));            \
  rb2 = *(const u32x4*)(gb + (size_t)64 * ldb + (KO));            \
  rb3 = *(const u32x4*)(gb + (size_t)96 * ldb + (KO));
#define LSTORE()                                                  \
  *(u32x4*)(sA + (lrow)*72 + lpart * 8) = ra0;                    \
  *(u32x4*)(sA + (lrow + 32) * 72 + lpart * 8) = ra1;             \
  *(u32x4*)(sA + (lrow + 64) * 72 + lpart * 8) = ra2;             \
  *(u32x4*)(sA + (lrow + 96) * 72 + lpart * 8) = ra3;             \
  *(u32x4*)(sB + (lrow)*72 + lpart * 8) = rb0;                    \
  *(u32x4*)(sB + (lrow + 32) * 72 + lpart * 8) = rb1;             \
  *(u32x4*)(sB + (lrow + 64) * 72 + lpart * 8) = rb2;             \
  *(u32x4*)(sB + (lrow + 96) * 72 + lpart * 8) = rb3;
  GLOAD(0)
  LSTORE()
  __syncthreads();
  for (int k0 = 0; k0 < K; k0 += 64) {
    const bool more = (k0 + 64) < K;
    if (more) { GLOAD(k0 + 64) }
#pragma unroll
    for (int ks = 0; ks < 2; ++ks) {
      bf16x8 af[4], bfr[4];
#pragma unroll
      for (int mt = 0; mt < 4; ++mt) af[mt] = *(const bf16x8*)(sA + (wm * 64 + mt * 16 + l15) * 72 + ks * 32 + lg * 8);
#pragma unroll
      for (int nt = 0; nt < 4; ++nt) bfr[nt] = *(const bf16x8*)(sB + (wn * 64 + nt * 16 + l15) * 72 + ks * 32 + lg * 8);
#pragma unroll
      for (int mt = 0; mt < 4; ++mt)
#pragma unroll
        for (int nt = 0; nt < 4; ++nt) acc[mt][nt] = mfma16(af[mt], bfr[nt], acc[mt][nt]);
    }
    __syncthreads();
    if (more) {
      LSTORE()
      __syncthreads();
    }
  }
}
DI void zero_acc(f32x4 (&acc)[4][4]) {
#pragma unroll
  for (int a = 0; a < 4; ++a)
#pragma unroll
    for (int b = 0; b < 4; ++b) acc[a][b] = f32x4{0.f, 0.f, 0.f, 0.f};
}
template <class F>
DI void epi_loop(f32x4 (&acc)[4][4], int m0, int n0, F f) {
  const int _lane = threadIdx.x & 63, _wv = threadIdx.x >> 6;
#pragma unroll
  for (int mt = 0; mt < 4; ++mt) {
#pragma unroll
    for (int nt = 0; nt < 4; ++nt) {
      const int row0 = m0 + (_wv >> 1) * 64 + mt * 16 + (_lane >> 4) * 4;
      const int col = n0 + (_wv & 1) * 64 + nt * 16 + (_lane & 15);
      f(mt, nt, row0, col, acc[mt][nt]);
    }
  }
}

DI void phaseA(const Params& p, unsigned char* smem) {
  const int tid = threadIdx.x, lane = tid & 63, wv = tid >> 6;
  u16* HN = (u16*)(p.ws + OFF_HN);
  for (int row = blockIdx.x * 4 + wv; row < T_; row += gridDim.x * 4) {
    const float4* xr = (const float4*)(p.x + (size_t)row * 1024);
    float4 v[4];
    float ss = 0.f;
#pragma unroll
    for (int r = 0; r < 4; ++r) {
      v[r] = xr[lane + 64 * r];
      ss += v[r].x * v[r].x + v[r].y * v[r].y + v[r].z * v[r].z + v[r].w * v[r].w;
    }
    ss = wave_sum(ss);
    const float rinv = rsqrtf(ss * (1.f / 1024.f) + 1e-6f);
#pragma unroll
    for (int r = 0; r < 4; ++r) {
      const float4 g = ((const float4*)p.g1)[lane + 64 * r];
      uint2 o;
      o.x = pk2(v[r].x * rinv * g.x, v[r].y * rinv * g.y);
      o.y = pk2(v[r].z * rinv * g.z, v[r].w * rinv * g.w);
      *(uint2*)(HN + (size_t)row * 1024 + (lane + 64 * r) * 4) = o;
    }
  }
  float* tile = (float*)smem;
  constexpr int NXT = 992 + 128 + 128 + 8 + 8 + 128 * 3 + 256 + 1024 + 1024;
  for (int jt = blockIdx.x; jt < NXT + 8; jt += gridDim.x) {
    if (jt < NXT) {
      int t = jt;
      const float* src;
      u16* dst;
      int K, Nsrc, mode = 0;
      const float* scl = nullptr;
      if (t < 992) { src = p.w_in; dst = (u16*)(p.ws + OFF_WINT); K = 1024; Nsrc = 3864; mode = 1; }
      else if ((t -= 992) < 128) { src = p.kw1; dst = (u16*)(p.ws + OFF_W1KT); K = 2048; Nsrc = 256; }
      else if ((t -= 128) < 128) { src = p.vw1; dst = (u16*)(p.ws + OFF_W1VT); K = 2048; Nsrc = 256; }
      else if ((t -= 128) < 8) { src = p.kw2; dst = (u16*)(p.ws + OFF_W2KT); K = 256; Nsrc = 64; mode = 2; }
      else if ((t -= 8) < 8) { src = p.vw2; dst = (u16*)(p.ws + OFF_W2VT); K = 256; Nsrc = 64; mode = 2; }
      else if ((t -= 8) < 128) { src = p.w_attn; dst = (u16*)(p.ws + OFF_WAT); K = 512; Nsrc = 1024; }
      else if ((t -= 128) < 128) { src = p.w_val; dst = (u16*)(p.ws + OFF_WVT); K = 512; Nsrc = 1024; }
      else if ((t -= 128) < 128) { src = p.w_gate; dst = (u16*)(p.ws + OFF_WGT); K = 512; Nsrc = 1024; }
      else if ((t -= 128) < 256) { src = p.w_out; dst = (u16*)(p.ws + OFF_WOT); K = 1024; Nsrc = 1024; }
      else if ((t -= 256) < 1024) { src = p.w_up; dst = (u16*)(p.ws + OFF_WUPT); K = 1024; Nsrc = 4096; scl = p.g2; }
      else { t -= 1024; src = p.w_down; dst = (u16*)(p.ws + OFF_WDT); K = 4096; Nsrc = 1024; }
      const int nkt = K >> 6, tn = t / nkt, tk = t % nkt, n0 = tn * 64, k0 = tk * 64;
      const int tx = tid & 63, ty = tid >> 6;
      const int np = n0 + tx;
      int sc = np;
      if (mode == 1) {
        if (np < 1280) sc = np;
        else if (np < 1792) sc = 1304 + (np - 1280);
        else if (np < 3840) sc = 1816 + (np - 1792);
        else if (np < 3864) sc = 1280 + (np - 3840);
        else sc = -1;
      } else if (mode == 2) {
        sc = np < 64 ? np : -1;
      }
      for (int kk = ty; kk < 64; kk += 4) {
        float val = 0.f;
        if (sc >= 0) val = src[(size_t)(k0 + kk) * Nsrc + sc];
        if (scl) val *= scl[k0 + kk];
        tile[kk * 65 + tx] = val;
      }
      __syncthreads();
#pragma unroll
      for (int r = 0; r < 2; ++r) {
        const int c = tid + 256 * r, n = c >> 3, kc = c & 7;
        uint4 o;
        o.x = pk2(tile[(kc * 8 + 0) * 65 + n], tile[(kc * 8 + 1) * 65 + n]);
        o.y = pk2(tile[(kc * 8 + 2) * 65 + n], tile[(kc * 8 + 3) * 65 + n]);
        o.z = pk2(tile[(kc * 8 + 4) * 65 + n], tile[(kc * 8 + 5) * 65 + n]);
        o.w = pk2(tile[(kc * 8 + 6) * 65 + n], tile[(kc * 8 + 7) * 65 + n]);
        *(uint4*)(dst + (size_t)(n0 + n) * K + k0 + kc * 8) = o;
      }
      __syncthreads();
    } else {
      const int item = jt - NXT, kv = item >> 2, cgp = item & 3;
      const float* w1 = kv ? p.vw1 : p.kw1;
      const int col = cgp * 64 + (tid & 63), ks = tid >> 6;
      float s = 0.f;
      for (int k = ks * 512; k < ks * 512 + 512; ++k) s += p.pe[k] * w1[(size_t)k * 256 + col];
      tile[ks * 64 + (tid & 63)] = s;
      __syncthreads();
      if (tid < 64) ((float*)(p.ws + OFF_CBIAS))[kv * 256 + col] = tile[tid] + tile[64 + tid] + tile[128 + tid] + tile[192 + tid];
      __syncthreads();
    }
  }
  float* rope = (float*)(p.ws + OFF_ROPE);
  for (int i = blockIdx.x * 256 + tid; i < S_ * 8; i += gridDim.x * 256) {
    const int pos = i >> 3, k = i & 7;
    const float inv = powf(500000.0f, -(2.0f * (float)k) / 16.0f);
    const float ang = (float)pos * inv;
    rope[pos * 16 + k] = cosf(ang);
    rope[pos * 16 + 8 + k] = sinf(ang);
  }
  if (blockIdx.x == 0 && tid < 16) ((int*)(p.ws + OFF_CTR))[tid] = 0;
}

DI void phaseB(const Params& p, unsigned char* smem) {
  const u16* HN = (const u16*)(p.ws + OFF_HN);
  const u16* WT = (const u16*)(p.ws + OFF_WINT);
  const float* rope = (const float*)(p.ws + OFF_ROPE);
  const int lane = threadIdx.x & 63;
  for (int id = blockIdx.x; id < 256 * 31; id += gridDim.x) {
    const int tm = id / 31, tn = id % 31, m0 = tm * 128, n0 = tn * 128;
    f32x4 acc[4][4];
    zero_acc(acc);
    gemm_core(acc, HN + (size_t)m0 * 1024, 1024, WT + (size_t)n0 * 1024, 1024, 1024, smem);
    if (tn < 4) {
      u16* QR = (u16*)(p.ws + OFF_QRAW);
      u16* QO = (u16*)(p.ws + OFF_QROT);
      epi_loop(acc, m0, n0, [&](int mt, int nt, int row0, int col, f32x4& v) {
        f32x4 r = v;
        if (nt == 0) {
          const int k = lane & 7;
#pragma unroll
          for (int i = 0; i < 4; ++i) {
            const float pr = __shfl_xor(v[i], 8);
            const int pos = (row0 + i) & (S_ - 1);
            const float c = rope[pos * 16 + k], s = rope[pos * 16 + 8 + k];
            r[i] = (lane & 8) ? (v[i] * c + pr * s) : (v[i] * c - pr * s);
          }
        }
#pragma unroll
        for (int i = 0; i < 4; ++i) {
          QR[(size_t)(row0 + i) * 512 + col] = f2bf(v[i]);
          QO[(size_t)(row0 + i) * 512 + col] = f2bf(r[i]);
        }
      });
    } else if (tn < 10) {
      const int sub = tn - 4;
      const bool dorope = (sub == 2 || sub == 4), transposed = (sub == 3 || sub == 5);
      u16* dst = (u16*)(p.ws + OFF_KCIN + (size_t)sub * 8 * MB);
      epi_loop(acc, m0, n0, [&](int mt, int nt, int row0, int col, f32x4& v) {
        const int c128 = col - n0, g = c128 >> 6, d = c128 & 63;
        const int b = row0 >> 13, s = row0 & (S_ - 1);
        f32x4 r = v;
        if (dorope && nt == 0) {
          const int k = lane & 7;
#pragma unroll
          for (int i = 0; i < 4; ++i) {
            const float pr = __shfl_xor(v[i], 8);
            const float c = rope[(s + i) * 16 + k], sn = rope[(s + i) * 16 + 8 + k];
            r[i] = (lane & 8) ? (v[i] * c + pr * sn) : (v[i] * c - pr * sn);
          }
        }
        if (transposed) {
          uint2 o;
          o.x = pk2(r[0], r[1]);
          o.y = pk2(r[2], r[3]);
          *(uint2*)(dst + ((size_t)((b * 2 + g) * 64 + d)) * S_ + s) = o;
        } else {
#pragma unroll
          for (int i = 0; i < 4; ++i) dst[((size_t)(b * 2 + g) * S_ + s + i) * 64 + d] = f2bf(r[i]);
        }
      });
    } else if (tn < 14) {
      u16* U = (u16*)(p.ws + OFF_U);
      epi_loop(acc, m0, n0, [&](int mt, int nt, int row0, int col, f32x4& v) {
#pragma unroll
        for (int i = 0; i < 4; ++i) U[(size_t)(row0 + i) * 512 + (col - 1280)] = f2bf(v[i]);
      });
    } else if (tn < 30) {
      u16* MG = (u16*)(p.ws + OFF_MG);
      epi_loop(acc, m0, n0, [&](int mt, int nt, int row0, int col, f32x4& v) {
#pragma unroll
        for (int i = 0; i < 4; ++i) MG[(size_t)(row0 + i) * 2048 + (col - 1792)] = f2bf(sigmoidf_(v[i]));
      });
    } else {
      float* NG = (float*)(p.ws + OFF_NG);
      epi_loop(acc, m0, n0, [&](int mt, int nt, int row0, int col, f32x4& v) {
        const int cc = col - 3840;
        if (cc < 24) {
#pragma unroll
          for (int i = 0; i < 4; ++i) NG[(size_t)(row0 + i) * 24 + cc] = sigmoidf_(v[i]);
        }
      });
    }
  }
}

struct S5c {
  float lbr, lbi;
  float br[16], bi[16];
};
DI void s5_setup(const Params& p, int g, int n, S5c& c) {
  const float step = expf(p.log_step[g]);
  const float lr = p.lam_re[g * 64 + n], li = p.lam_im[g * 64 + n];
  const float er = expf(lr * step);
  float sn, cs;
  sincosf(li * step, &sn, &cs);
  c.lbr = er * cs;
  c.lbi = er * sn;
  const float nr = c.lbr - 1.f, ni = c.lbi, den = lr * lr + li * li;
  const float cr = (nr * lr + ni * li) / den, ci = (ni * lr - nr * li) / den;
#pragma unroll
  for (int k = 0; k < 16; ++k) {
    const float bre = p.b_re[(g * 64 + n) * 16 + k], bim = p.b_im[(g * 64 + n) * 16 + k];
    c.br[k] = cr * bre - ci * bim;
    c.bi[k] = cr * bim + ci * bre;
  }
}
DI void s5_load_u(const Params& p, int b, int ch, int g, float* su, int lane) {
  const u16* U = (const u16*)(p.ws + OFF_U) + ((size_t)(b * S_ + ch * 64 + lane)) * 512 + g * 16;
  const uint4 a = *(const uint4*)U, c = *(const uint4*)(U + 8);
  float* d = su + lane * 16;
  const unsigned w[8] = {a.x, a.y, a.z, a.w, c.x, c.y, c.z, c.w};
#pragma unroll
  for (int k = 0; k < 8; ++k) {
    d[2 * k] = __uint_as_float(w[k] << 16);
    d[2 * k + 1] = __uint_as_float(w[k] & 0xffff0000u);
  }
}
DI void s5_step(const S5c& c, const float* ut, float& hr, float& hi) {
  float bur = 0.f, bui = 0.f;
#pragma unroll
  for (int k4 = 0; k4 < 4; ++k4) {
    const float4 u = *(const float4*)(ut + 4 * k4);
    bur += c.br[4 * k4] * u.x + c.br[4 * k4 + 1] * u.y + c.br[4 * k4 + 2] * u.z + c.br[4 * k4 + 3] * u.w;
    bui += c.bi[4 * k4] * u.x + c.bi[4 * k4 + 1] * u.y + c.bi[4 * k4 + 2] * u.z + c.bi[4 * k4 + 3] * u.w;
  }
  const float nr = c.lbr * hr - c.lbi * hi + bur;
  const float nim = c.lbr * hi + c.lbi * hr + bui;
  hr = nr;
  hi = nim;
}
DI void s5_pass1(const Params& p, int item, unsigned char* smem) {
  const int tid = threadIdx.x, lane = tid & 63, wv = tid >> 6;
  const int b = item >> 10, g = (item >> 5) & 31, cq = item & 31, ch = cq * 4 + wv;
  float* su = (float*)smem + wv * 1024;
  S5c c;
  s5_setup(p, g, lane, c);
  s5_load_u(p, b, ch, g, su, lane);
  __syncthreads();
  float hr = 0.f, hi = 0.f;
  for (int t = 0; t < 64; ++t) s5_step(c, su + t * 16, hr, hi);
  float2* HL = (float2*)(p.ws + OFF_HLOC);
  HL[((size_t)(b * 128 + ch) * 32 + g) * 64 + lane] = make_float2(hr, hi);
  __syncthreads();
}
DI void s5_carry(const Params& p) {
  const int x = blockIdx.x * 256 + threadIdx.x;
  if (x >= 8192) return;
  const int b = x >> 11, g = (x >> 6) & 31, n = x & 63;
  const float step = expf(p.log_step[g]);
  const float lr = p.lam_re[g * 64 + n], li = p.lam_im[g * 64 + n];
  const float er = expf(64.f * lr * step);
  float sn, cs;
  sincosf(64.f * li * step, &sn, &cs);
  const float Lr = er * cs, Li = er * sn;
  float2* HL = (float2*)(p.ws + OFF_HLOC) + (size_t)b * 128 * 2048 + g * 64 + n;
  float hr = 0.f, hi = 0.f;
  for (int c0 = 0; c0 < 128; c0 += 16) {
    float2 v[16];
#pragma unroll
    for (int k = 0; k < 16; ++k) v[k] = HL[(size_t)(c0 + k) * 2048];
#pragma unroll
    for (int k = 0; k < 16; ++k) {
      HL[(size_t)(c0 + k) * 2048] = make_float2(hr, hi);
      const float nr = Lr * hr - Li * hi + v[k].x;
      const float nim = Lr * hi + Li * hr + v[k].y;
      hr = nr;
      hi = nim;
    }
  }
}
DI void s5_pass3(const Params& p, int item, unsigned char* smem) {
  const int tid = threadIdx.x, lane = tid & 63, wv = tid >> 6;
  const int b = item >> 10, g = (item >> 5) & 31, cq = item & 31, ch = cq * 4 + wv;
  float* su = (float*)smem + wv * 1024;
  float* sh = (float*)smem + 4096 + wv * (16 * 130);
  float* sC = (float*)smem + 4096 + 4 * 16 * 130;
  S5c c;
  s5_setup(p, g, lane, c);
  s5_load_u(p, b, ch, g, su, lane);
  for (int e = tid; e < 1024; e += 256) {
    const int cc = e >> 6, n = e & 63;
    sC[(n * 16 + cc) * 2] = p.c_re[(g * 16 + cc) * 64 + n];
    sC[(n * 16 + cc) * 2 + 1] = p.c_im[(g * 16 + cc) * 64 + n];
  }
  const float2 h0 = ((const float2*)(p.ws + OFF_HLOC))[((size_t)(b * 128 + ch) * 32 + g) * 64 + lane];
  float hr = h0.x, hi = h0.y;
  const int tt = lane >> 2, c4 = lane & 3;
  float dk[4];
#pragma unroll
  for (int k = 0; k < 4; ++k) dk[k] = p.dsk[g * 16 + c4 * 4 + k];
  u16* YS = (u16*)(p.ws + OFF_YS);
  __syncthreads();
  for (int sub = 0; sub < 4; ++sub) {
    for (int t = 0; t < 16; ++t) {
      s5_step(c, su + (sub * 16 + t) * 16, hr, hi);
      *(float2*)(sh + t * 130 + 2 * lane) = make_float2(hr, hi);
    }
    __syncthreads();
    float a0 = 0.f, a1 = 0.f, a2 = 0.f, a3 = 0.f;
    for (int n = 0; n < 64; ++n) {
      const float2 h = *(const float2*)(sh + tt * 130 + 2 * n);
      const float4 c0 = *(const float4*)(sC + (n * 16 + c4 * 4) * 2);
      const float4 c1 = *(const float4*)(sC + (n * 16 + c4 * 4) * 2 + 4);
      a0 += c0.x * h.x - c0.y * h.y;
      a1 += c0.z * h.x - c0.w * h.y;
      a2 += c1.x * h.x - c1.y * h.y;
      a3 += c1.z * h.x - c1.w * h.y;
    }
    const int t = sub * 16 + tt;
    const float4 uu = *(const float4*)(su + t * 16 + c4 * 4);
    uint2 o;
    o.x = pk2(gelu_t(a0 + dk[0] * uu.x), gelu_t(a1 + dk[1] * uu.y));
    o.y = pk2(gelu_t(a2 + dk[2] * uu.z), gelu_t(a3 + dk[3] * uu.w));
    *(uint2*)(YS + ((size_t)(b * S_ + ch * 64 + t)) * 512 + g * 16 + c4 * 4) = o;
    __syncthreads();
  }
}

DI void phaseC(const Params& p, unsigned char* smem) {
  const float* cb = (const float*)(p.ws + OFF_CBIAS);
  for (int id = blockIdx.x; id < 128 + 4096; id += gridDim.x) {
    if (id < 128) {
      const int kv = id >> 6, tm = (id >> 1) & 31, tn = id & 1, m0 = tm * 128, n0 = tn * 128;
      const u16* A = (const u16*)(p.ws + (kv ? OFF_VCIN : OFF_KCIN)) + (size_t)m0 * 1024;
      const u16* Bt = (const u16*)(p.ws + (kv ? OFF_W1VT : OFF_W1KT)) + (size_t)n0 * 2048;
      f32x4 acc[4][4];
      zero_acc(acc);
      gemm_core(acc, A, 1024, Bt, 2048, 2048, smem);
      u16* HC = (u16*)(p.ws + OFF_HC) + (size_t)kv * 4096 * 256;
      epi_loop(acc, m0, n0, [&](int mt, int nt, int row0, int col, f32x4& v) {
        const float bb = cb[kv * 256 + col];
#pragma unroll
        for (int i = 0; i < 4; ++i) HC[(size_t)(row0 + i) * 256 + col] = f2bf(gelu_t(v[i] + bb));
      });
    } else {
      s5_pass1(p, id - 128, smem);
    }
  }
}
DI void phaseD(const Params& p, unsigned char* smem) {
  for (int id = blockIdx.x; id < 64; id += gridDim.x) {
    const int kv = id >> 5, tm = id & 31, m0 = tm * 128;
    const u16* A = (const u16*)(p.ws + OFF_HC) + (size_t)kv * 4096 * 256 + (size_t)m0 * 256;
    const u16* Bt = (const u16*)(p.ws + (kv ? OFF_W2VT : OFF_W2KT));
    f32x4 acc[4][4];
    zero_acc(acc);
    gemm_core(acc, A, 256, Bt, 256, 256, smem);
    u16* KCC = (u16*)(p.ws + OFF_KCC);
    u16* VCT = (u16*)(p.ws + OFF_VCT);
    epi_loop(acc, m0, 0, [&](int mt, int nt, int row0, int col, f32x4& v) {
      if (col < 64) {
        const int bg = row0 >> 9, n = row0 & 511;
        f32x4 r = v;
        if (n + 3 == 511) r[3] = 0.f;
        if (kv == 0) {
#pragma unroll
          for (int i = 0; i < 4; ++i) KCC[((size_t)bg * 512 + n + i) * 64 + col] = f2bf(r[i]);
        } else {
          uint2 o;
          o.x = pk2(r[0], r[1]);
          o.y = pk2(r[2], r[3]);
          *(uint2*)(VCT + ((size_t)bg * 64 + col) * 512 + n) = o;
        }
      }
    });
  }
  s5_carry(p);
}

DI bool bit128(u64 lo, u64 hi, int j) { return j < 64 ? ((lo >> j) & 1ull) : ((hi >> (j - 64)) & 1ull); }
DI int next_bit(u64 lo, u64 hi, int from) {
  if (from < 64) {
    const u64 x = (lo >> from) << from;
    if (x) return __ffsll((long long)x) - 1;
    from = 64;
  }
  if (from >= 128) return -1;
  const u64 y = (hi >> (from - 64)) << (from - 64);
  return y ? 63 + __ffsll((long long)y) : -1;
}

template <int MODE, class MaskF>
DI void flash_tile(const u16* sK, const u16* sV, const bf16x8 (&qf)[4][2], f32x4 (&O)[4][4], float (&m)[4], float (&l)[4],
                   float (&ps)[4][4], MaskF ok, int lane) {
  const int l15 = lane & 15, lg = lane >> 4;
  constexpr float CS = 0.125f * 1.44269504089f;
  bf16x8 kf[4][2];
#pragma unroll
  for (int kt = 0; kt < 4; ++kt)
#pragma unroll
    for (int ks = 0; ks < 2; ++ks) kf[kt][ks] = *(const bf16x8*)(sK + (16 * kt + l15) * 72 + ks * 32 + lg * 8);
  if (MODE == 1) {
#pragma unroll
    for (int a = 0; a < 4; ++a)
#pragma unroll
      for (int b = 0; b < 4; ++b) ps[a][b] = 0.f;
  }
#pragma unroll
  for (int qt = 0; qt < 4; ++qt) {
    f32x4 s[4];
#pragma unroll
    for (int kt = 0; kt < 4; ++kt) {
      s[kt] = f32x4{0.f, 0.f, 0.f, 0.f};
#pragma unroll
      for (int ks = 0; ks < 2; ++ks) s[kt] = mfma16(kf[kt][ks], qf[qt][ks], s[kt]);
    }
    float mx = -1e30f;
#pragma unroll
    for (int kt = 0; kt < 4; ++kt)
#pragma unroll
      for (int i = 0; i < 4; ++i) {
        const float v = ok(kt, i) ? s[kt][i] * CS : -1e30f;
        s[kt][i] = v;
        mx = fmaxf(mx, v);
      }
    float pr[4][4];
    if (MODE == 1) {
      const float mm = m[qt], il = l[qt];
#pragma unroll
      for (int kt = 0; kt < 4; ++kt)
#pragma unroll
        for (int i = 0; i < 4; ++i) {
          const float pv = (s[kt][i] > -1e29f) ? __builtin_amdgcn_exp2f(s[kt][i] - mm) * il : 0.f;
          pr[kt][i] = pv;
          ps[kt][i] += pv;
        }
    } else {
      mx = fmaxf(mx, __shfl_xor(mx, 16));
      mx = fmaxf(mx, __shfl_xor(mx, 32));
      const float mnew = fmaxf(m[qt], mx);
      const float alpha = __builtin_amdgcn_exp2f(m[qt] - mnew);
      m[qt] = mnew;
      float rs = 0.f;
#pragma unroll
      for (int kt = 0; kt < 4; ++kt)
#pragma unroll
        for (int i = 0; i < 4; ++i) {
          const float pv = (s[kt][i] > -1e29f) ? __builtin_amdgcn_exp2f(s[kt][i] - mnew) : 0.f;
          pr[kt][i] = pv;
          rs += pv;
        }
      l[qt] = l[qt] * alpha + rs;
      if (MODE == 2) {
#pragma unroll
        for (int dt = 0; dt < 4; ++dt) O[qt][dt] *= alpha;
      }
    }
    if (MODE != 0) {
#pragma unroll
      for (int ks2 = 0; ks2 < 2; ++ks2) {
        union { unsigned u[4]; bf16x8 v; } pf;
        pf.u[0] = pk2(pr[2 * ks2][0], pr[2 * ks2][1]);
        pf.u[1] = pk2(pr[2 * ks2][2], pr[2 * ks2][3]);
        pf.u[2] = pk2(pr[2 * ks2 + 1][0], pr[2 * ks2 + 1][1]);
        pf.u[3] = pk2(pr[2 * ks2 + 1][2], pr[2 * ks2 + 1][3]);
#pragma unroll
        for (int dt = 0; dt < 4; ++dt) {
          union { uint2 h[2]; bf16x8 v; } vf;
          vf.h[0] = *(const uint2*)(sV + (16 * dt + l15) * 72 + 32 * ks2 + 4 * lg);
          vf.h[1] = *(const uint2*)(sV + (16 * dt + l15) * 72 + 32 * ks2 + 16 + 4 * lg);
          O[qt][dt] = mfma16(vf.v, pf.v, O[qt][dt]);
        }
      }
    }
  }
}

DI void nsa_item(const Params& p, int item, unsigned char* smem) {
  const int tid = threadIdx.x, lane = tid & 63, wv = tid >> 6, l15 = lane & 15, lg = lane >> 4;
  const int i = 127 - (item >> 3), bg = item & 7, b = bg >> 1, g = bg & 1;
  u16* sK = (u16*)smem;
  u16* sV = sK + 64 * 72;
  float* sImp = (float*)(smem + 18432);
  u64* sUni = (u64*)(smem + 18432 + 64 * 132 * 4);
  const int t0 = i * 64, qloc = 16 * wv + l15, tq = t0 + qloc;
  const size_t tokq = (size_t)b * S_ + tq;
  const float* NG = (const float*)(p.ws + OFF_NG) + tokq * 24 + g * 12;
  float* ACC = p.out + tokq * 512 + g * 256;
  const int lrow = tid >> 3, lpart = tid & 7;

  for (int e = tid; e < 64 * 132; e += 256) sImp[e] = 0.f;

  bf16x8 qf[4][2];
  {
    const u16* Q = (const u16*)(p.ws + OFF_QRAW) + tokq * 512 + g * 256;
#pragma unroll
    for (int qt = 0; qt < 4; ++qt)
#pragma unroll
      for (int ks = 0; ks < 2; ++ks) qf[qt][ks] = *(const bf16x8*)(Q + qt * 64 + ks * 32 + lg * 8);
  }
  f32x4 O[4][4];
  float m[4], l[4], ps[4][4];
  u32x4 pk0, pk1, pv0, pv1;

#define ISSUE_TILE(KSRC, VSRC, LDV)                                                  \
  {                                                                                  \
    pk0 = *(const u32x4*)((KSRC) + (size_t)(lrow)*64 + lpart * 8);                   \
    pk1 = *(const u32x4*)((KSRC) + (size_t)(lrow + 32) * 64 + lpart * 8);            \
    pv0 = *(const u32x4*)((VSRC) + (size_t)(lrow) * (LDV) + lpart * 8);              \
    pv1 = *(const u32x4*)((VSRC) + (size_t)(lrow + 32) * (LDV) + lpart * 8);         \
  }
#define COMMIT_TILE()                                                                \
  {                                                                                  \
    *(u32x4*)(sK + (lrow)*72 + lpart * 8) = pk0;                                     \
    *(u32x4*)(sK + (lrow + 32) * 72 + lpart * 8) = pk1;                              \
    *(u32x4*)(sV + (lrow)*72 + lpart * 8) = pv0;                                     \
    *(u32x4*)(sV + (lrow + 32) * 72 + lpart * 8) = pv1;                              \
  }

  const u16* Kc = (const u16*)(p.ws + OFF_KCC) + (size_t)bg * 512 * 64;
  const u16* Vc = (const u16*)(p.ws + OFF_VCT) + (size_t)bg * 64 * 512;
  const int nE = (4 * i + 3) < 511 ? (4 * i + 3) : 511;
  const int nkb = (nE + 63) >> 6;
#pragma unroll
  for (int qt = 0; qt < 4; ++qt) { m[qt] = -1e30f; l[qt] = 0.f; }
  ISSUE_TILE(Kc, Vc, 512)
  for (int kb = 0; kb < nkb; ++kb) {
    __syncthreads();
    COMMIT_TILE()
    __syncthreads();
    if (kb + 1 < nkb) ISSUE_TILE(Kc + (size_t)(kb + 1) * 64 * 64, Vc + (kb + 1) * 64, 512)
    auto ok = [&](int kt, int ii) { return 16 * (kb * 64 + 16 * kt + 4 * lg + ii) + 31 <= tq; };
    flash_tile<0>(sK, sV, qf, O, m, l, ps, ok, lane);
  }
#pragma unroll
  for (int qt = 0; qt < 4; ++qt) {
    float s = l[qt];
    s += __shfl_xor(s, 16);
    s += __shfl_xor(s, 32);
    l[qt] = s > 0.f ? 1.f / s : 0.f;
  }
#pragma unroll
  for (int a = 0; a < 4; ++a)
#pragma unroll
    for (int c = 0; c < 4; ++c) O[a][c] = f32x4{0.f, 0.f, 0.f, 0.f};
  ISSUE_TILE(Kc, Vc, 512)
  for (int kb = 0; kb < nkb; ++kb) {
    __syncthreads();
    COMMIT_TILE()
    __syncthreads();
    if (kb + 1 < nkb) ISSUE_TILE(Kc + (size_t)(kb + 1) * 64 * 64, Vc + (kb + 1) * 64, 512)
    auto ok = [&](int kt, int ii) { return 16 * (kb * 64 + 16 * kt + 4 * lg + ii) + 31 <= tq; };
    flash_tile<1>(sK, sV, qf, O, m, l, ps, ok, lane);
#pragma unroll
    for (int kt = 0; kt < 4; ++kt) {
      const int j = kb * 16 + kt * 4 + lg;
      sImp[qloc * 132 + j] += ps[kt][0] + ps[kt][1] + ps[kt][2] + ps[kt][3];
    }
    __syncthreads();
#pragma unroll
    for (int kt = 0; kt < 4; ++kt) {
      const int j1 = kb * 16 + kt * 4 + lg + 1;
      if (j1 < 128) sImp[qloc * 132 + j1] += ps[kt][3];
    }
  }
#pragma unroll
  for (int qt = 0; qt < 4; ++qt) {
    const float gt = NG[qt * 3 + 0];
#pragma unroll
    for (int dt = 0; dt < 4; ++dt) {
      float4 o = make_float4(O[qt][dt][0] * gt, O[qt][dt][1] * gt, O[qt][dt][2] * gt, O[qt][dt][3] * gt);
      *(float4*)(ACC + qt * 64 + 16 * dt + 4 * lg) = o;
    }
  }
  __syncthreads();
  u64 mlo = 0, mhi = 0, wlo = 0, whi = 0;
  if (i < 16) {
    mlo = (1ull << (i + 1)) - 1ull;
    wlo = mlo;
  } else {
    const bool v0 = lane <= i, v1 = (lane + 64) <= i;
    const bool f0 = (lane == 0) || (lane == i) || (lane == i - 1);
    const bool f1 = (lane + 64 == i) || (lane + 64 == i - 1);
    const u64 ltm = (1ull << lane) - 1ull;
    for (int qq = 0; qq < 16; ++qq) {
      const float* ir = sImp + (16 * wv + qq) * 132;
      const unsigned k0 = v0 ? __float_as_uint(ir[lane] + (f0 ? 1000.f : 0.f)) : 0u;
      const unsigned k1 = v1 ? __float_as_uint(ir[lane + 64] + (f1 ? 1000.f : 0.f)) : 0u;
      unsigned T = 0;
      for (int bit = 30; bit >= 0; --bit) {
        const unsigned cand = T | (1u << bit);
        const int cnt = __popcll(__ballot(k0 >= cand)) + __popcll(__ballot(k1 >= cand));
        if (cnt >= 16) T = cand;
      }
      const bool g0 = k0 > T, g1 = k1 > T, e0 = k0 == T, e1 = k1 == T;
      const int need = 16 - (__popcll(__ballot(g0)) + __popcll(__ballot(g1)));
      const u64 be0 = __ballot(e0), be1 = __ballot(e1);
      const int r0 = __popcll(be0 & ltm), r1 = __popcll(be0) + __popcll(be1 & ltm);
      const u64 s0 = __ballot(v0 && (g0 || (e0 && r0 < need)));
      const u64 s1 = __ballot(v1 && (g1 || (e1 && r1 < need)));
      wlo |= s0;
      whi |= s1;
      if (l15 == qq) { mlo = s0; mhi = s1; }
    }
  }
  if (lane == 0) { sUni[wv * 2] = wlo; sUni[wv * 2 + 1] = whi; }
  __syncthreads();
  const u64 blo = sUni[0] | sUni[2] | sUni[4] | sUni[6];
  const u64 bhi = sUni[1] | sUni[3] | sUni[5] | sUni[7];

  {
    const u16* Q = (const u16*)(p.ws + OFF_QROT) + tokq * 512 + g * 256;
#pragma unroll
    for (int qt = 0; qt < 4; ++qt)
#pragma unroll
      for (int ks = 0; ks < 2; ++ks) qf[qt][ks] = *(const bf16x8*)(Q + qt * 64 + ks * 32 + lg * 8);
  }
  {
    const u16* Ks = (const u16*)(p.ws + OFF_KS) + (size_t)bg * S_ * 64;
    const u16* Vs = (const u16*)(p.ws + OFF_VST) + (size_t)bg * 64 * S_;
#pragma unroll
    for (int qt = 0; qt < 4; ++qt) { m[qt] = -1e30f; l[qt] = 0.f; }
#pragma unroll
    for (int a = 0; a < 4; ++a)
#pragma unroll
      for (int c = 0; c < 4; ++c) O[a][c] = f32x4{0.f, 0.f, 0.f, 0.f};
    int jn = next_bit(blo, bhi, 0);
    if (jn >= 0) ISSUE_TILE(Ks + (size_t)jn * 64 * 64, Vs + jn * 64, S_)
    while (jn >= 0) {
      const int j = jn;
      __syncthreads();
      COMMIT_TILE()
      __syncthreads();
      jn = next_bit(blo, bhi, j + 1);
      if (jn >= 0) ISSUE_TILE(Ks + (size_t)jn * 64 * 64, Vs + jn * 64, S_)
      if (bit128(wlo, whi, j)) {
        const bool sel = bit128(mlo, mhi, j);
        const bool diag = (j == i);
        auto ok = [&](int kt, int ii) { return sel && (!diag || (16 * kt + 4 * lg + ii) <= qloc); };
        flash_tile<2>(sK, sV, qf, O, m, l, ps, ok, lane);
      }
    }
#pragma unroll
    for (int qt = 0; qt < 4; ++qt) {
      float s = l[qt];
      s += __shfl_xor(s, 16);
      s += __shfl_xor(s, 32);
      const float sc = NG[qt * 3 + 1] / s;
#pragma unroll
      for (int dt = 0; dt < 4; ++dt) {
        float4* a = (float4*)(ACC + qt * 64 + 16 * dt + 4 * lg);
        float4 o = *a;
        o.x += O[qt][dt][0] * sc; o.y += O[qt][dt][1] * sc; o.z += O[qt][dt][2] * sc; o.w += O[qt][dt][3] * sc;
        *a = o;
      }
    }
  }
  {
    const u16* Kw = (const u16*)(p.ws + OFF_KW) + (size_t)bg * S_ * 64;
    const u16* Vw = (const u16*)(p.ws + OFF_VWT) + (size_t)bg * 64 * S_;
#pragma unroll
    for (int qt = 0; qt < 4; ++qt) { m[qt] = -1e30f; l[qt] = 0.f; }
#pragma unroll
    for (int a = 0; a < 4; ++a)
#pragma unroll
      for (int c = 0; c < 4; ++c) O[a][c] = f32x4{0.f, 0.f, 0.f, 0.f};
    const int j0 = i >= 8 ? i - 8 : 0;
    ISSUE_TILE(Kw + (size_t)j0 * 64 * 64, Vw + j0 * 64, S_)
    for (int j = j0; j <= i; ++j) {
      __syncthreads();
      COMMIT_TILE()
      __syncthreads();
      if (j + 1 <= i) ISSUE_TILE(Kw + (size_t)(j + 1) * 64 * 64, Vw + (j + 1) * 64, S_)
      auto ok = [&](int kt, int ii) {
        const int kp = j * 64 + 16 * kt + 4 * lg + ii;
        return kp <= tq && kp > tq - 512;
      };
      flash_tile<2>(sK, sV, qf, O, m, l, ps, ok, lane);
    }
    u16* NSA = (u16*)(p.ws + OFF_NSA) + tokq * 512 + g * 256;
#pragma unroll
    for (int qt = 0; qt < 4; ++qt) {
      float s = l[qt];
      s += __shfl_xor(s, 16);
      s += __shfl_xor(s, 32);
      const float sc = NG[qt * 3 + 2] / s;
#pragma unroll
      for (int dt = 0; dt < 4; ++dt) {
        const float4 a = *(const float4*)(ACC + qt * 64 + 16 * dt + 4 * lg);
        uint2 o;
        o.x = pk2(a.x + O[qt][dt][0] * sc, a.y + O[qt][dt][1] * sc);
        o.y = pk2(a.z + O[qt][dt][2] * sc, a.w + O[qt][dt][3] * sc);
        *(uint2*)(NSA + qt * 64 + 16 * dt + 4 * lg) = o;
      }
    }
  }
  __syncthreads();
}

DI void phaseE(const Params& p, unsigned char* smem) {
  __shared__ int s_item;
  int* ctr = (int*)(p.ws + OFF_CTR);
  for (;;) {
    __syncthreads();
    if (threadIdx.x == 0) s_item = atomicAdd(ctr, 1);
    __syncthreads();
    const int item = s_item;
    if (item >= 1024 + 4096) break;
    if (item < 1024) nsa_item(p, item, smem);
    else s5_pass3(p, item - 1024, smem);
  }
}

DI void phaseF(const Params& p, unsigned char* smem) {
  const u16* YS = (const u16*)(p.ws + OFF_YS);
  const u16* NSA = (const u16*)(p.ws + OFF_NSA);
  const u16* MG = (const u16*)(p.ws + OFF_MG);
  u16* MR = (u16*)(p.ws + OFF_MERGED);
  for (int id = blockIdx.x; id < 256 * 8; id += gridDim.x) {
    const int tm = id >> 3, tn = id & 7, m0 = tm * 128, n0 = tn * 128;
    f32x4 acc[4][4], hold[4][4];
    zero_acc(acc);
    gemm_core(acc, YS + (size_t)m0 * 512, 512, (const u16*)(p.ws + OFF_WGT) + (size_t)n0 * 512, 512, 512, smem);
#pragma unroll
    for (int a = 0; a < 4; ++a)
#pragma unroll
      for (int c = 0; c < 4; ++c)
#pragma unroll
        for (int k = 0; k < 4; ++k) hold[a][c][k] = sigmoidf_(acc[a][c][k]);
    zero_acc(acc);
    gemm_core(acc, YS + (size_t)m0 * 512, 512, (const u16*)(p.ws + OFF_WVT) + (size_t)n0 * 512, 512, 512, smem);
#pragma unroll
    for (int a = 0; a < 4; ++a)
#pragma unroll
      for (int c = 0; c < 4; ++c) hold[a][c] *= acc[a][c];
    zero_acc(acc);
    gemm_core(acc, NSA + (size_t)m0 * 512, 512, (const u16*)(p.ws + OFF_WAT) + (size_t)n0 * 512, 512, 512, smem);
    epi_loop(acc, m0, n0, [&](int mt, int nt, int row0, int col, f32x4& v) {
#pragma unroll
      for (int i = 0; i < 4; ++i) {
        const float ga = bf2f(MG[(size_t)(row0 + i) * 2048 + col]);
        const float gb = bf2f(MG[(size_t)(row0 + i) * 2048 + 1024 + col]);
        MR[(size_t)(row0 + i) * 1024 + col] = f2bf(ga * v[i] + gb * hold[mt][nt][i]);
      }
    });
  }
}
#define SS_PARTIAL(SSPTR, m0, tn)                                                                       \
  {                                                                                                     \
    const int _lane = threadIdx.x & 63, _wv = threadIdx.x >> 6;                                         \
    _Pragma("unroll") for (int mt = 0; mt < 4; ++mt) {                                                  \
      _Pragma("unroll") for (int i = 0; i < 4; ++i) {                                                   \
        float s = acc[mt][0][i] * acc[mt][0][i] + acc[mt][1][i] * acc[mt][1][i] +                       \
                  acc[mt][2][i] * acc[mt][2][i] + acc[mt][3][i] * acc[mt][3][i];                        \
        s += __shfl_xor(s, 1); s += __shfl_xor(s, 2); s += __shfl_xor(s, 4); s += __shfl_xor(s, 8);     \
        if ((_lane & 15) == 0)                                                                          \
          (SSPTR)[(size_t)((m0) + (_wv >> 1) * 64 + mt * 16 + (_lane >> 4) * 4 + i) * 16 + (tn) * 2 + (_wv & 1)] = s; \
      }                                                                                                 \
    }                                                                                                   \
  }
DI void phaseG(const Params& p, unsigned char* smem) {
  const u16* MR = (const u16*)(p.ws + OFF_MERGED);
  u16* X1B = (u16*)(p.ws + OFF_X1B);
  float* SS1 = (float*)(p.ws + OFF_SS1);
  for (int id = blockIdx.x; id < 256 * 8; id += gridDim.x) {
    const int tm = id >> 3, tn = id & 7, m0 = tm * 128, n0 = tn * 128;
    f32x4 acc[4][4];
    zero_acc(acc);
    gemm_core(acc, MR + (size_t)m0 * 1024, 1024, (const u16*)(p.ws + OFF_WOT) + (size_t)n0 * 1024, 1024, 1024, smem);
    epi_loop(acc, m0, n0, [&](int mt, int nt, int row0, int col, f32x4& v) {
#pragma unroll
      for (int i = 0; i < 4; ++i) {
        const size_t o = (size_t)(row0 + i) * 1024 + col;
        const float x1 = v[i] + p.x[o];
        p.out[o] = x1;
        X1B[o] = f2bf(x1);
        v[i] = x1;
      }
    });
    SS_PARTIAL(SS1, m0, tn)
  }
}
DI void phaseH(const Params& p, unsigned char* smem) {
  const u16* X1B = (const u16*)(p.ws + OFF_X1B);
  const float* SS1 = (const float*)(p.ws + OFF_SS1);
  u16* ACT = (u16*)(p.ws + OFF_ACT);
  float* sR = (float*)(smem + 40960);
  for (int id = blockIdx.x; id < 256 * 32; id += gridDim.x) {
    const int tm = id >> 5, tn = id & 31, m0 = tm * 128, n0 = tn * 128;
    if (threadIdx.x < 128) {
      const float4* s = (const float4*)(SS1 + (size_t)(m0 + threadIdx.x) * 16);
      const float4 a = s[0], b = s[1], c = s[2], d = s[3];
      const float t = a.x + a.y + a.z + a.w + b.x + b.y + b.z + b.w + c.x + c.y + c.z + c.w + d.x + d.y + d.z + d.w;
      sR[threadIdx.x] = rsqrtf(t * (1.f / 1024.f) + 1e-6f);
    }
    f32x4 acc[4][4];
    zero_acc(acc);
    gemm_core(acc, X1B + (size_t)m0 * 1024, 1024, (const u16*)(p.ws + OFF_WUPT) + (size_t)n0 * 1024, 1024, 1024, smem);
    epi_loop(acc, m0, n0, [&](int mt, int nt, int row0, int col, f32x4& v) {
#pragma unroll
      for (int i = 0; i < 4; ++i) {
        float a = fmaxf(v[i] * sR[row0 + i - m0], 0.f);
        ACT[(size_t)(row0 + i) * 4096 + col] = f2bf(a * a);
      }
    });
    __syncthreads();
  }
}
DI void phaseI(const Params& p, unsigned char* smem) {
  const u16* ACT = (const u16*)(p.ws + OFF_ACT);
  float* SS2 = (float*)(p.ws + OFF_SS2);
  for (int id = blockIdx.x; id < 256 * 8; id += gridDim.x) {
    const int tm = id >> 3, tn = id & 7, m0 = tm * 128, n0 = tn * 128;
    f32x4 acc[4][4];
    zero_acc(acc);
    gemm_core(acc, ACT + (size_t)m0 * 4096, 4096, (const u16*)(p.ws + OFF_WDT) + (size_t)n0 * 4096, 4096, 4096, smem);
    epi_loop(acc, m0, n0, [&](int mt, int nt, int row0, int col, f32x4& v) {
#pragma unroll
      for (int i = 0; i < 4; ++i) {
        const size_t o = (size_t)(row0 + i) * 1024 + col;
        const float x2 = v[i] + p.out[o];
        p.out[o] = x2;
        v[i] = x2;
      }
    });
    SS_PARTIAL(SS2, m0, tn)
  }
}
DI void phaseJ(const Params& p) {
  const int lane = threadIdx.x & 63, wv = threadIdx.x >> 6;
  const float* SS2 = (const float*)(p.ws + OFF_SS2);
  for (int row = blockIdx.x * 4 + wv; row < T_; row += gridDim.x * 4) {
    float t = (lane < 16) ? SS2[(size_t)row * 16 + lane] : 0.f;
    t = wave_sum(t);
    const float rinv = rsqrtf(t * (1.f / 1024.f) + 1e-6f);
    float4* xr = (float4*)(p.out + (size_t)row * 1024);
#pragma unroll
    for (int r = 0; r < 4; ++r) {
      float4 v = xr[lane + 64 * r];
      const float4 g = ((const float4*)p.g3)[lane + 64 * r];
      v.x *= rinv * g.x; v.y *= rinv * g.y; v.z *= rinv * g.z; v.w *= rinv * g.w;
      xr[lane + 64 * r] = v;
    }
  }
}

__global__ void __launch_bounds__(256) mega(Params p) {
  __shared__ __attribute__((aligned(16))) unsigned char smem[SMEM_BYTES];
#define PH(N, CALL)                                  \
  if (p.lo <= N && N < p.hi) {                       \
    if (N > p.lo) cg::this_grid().sync();            \
    CALL;                                            \
  }
  PH(0, phaseA(p, smem))
  PH(1, phaseB(p, smem))
  PH(2, phaseC(p, smem))
  PH(3, phaseD(p, smem))
  PH(4, phaseE(p, smem))
  PH(5, phaseF(p, smem))
  PH(6, phaseG(p, smem))
  PH(7, phaseH(p, smem))
  PH(8, phaseI(p, smem))
  PH(9, phaseJ(p))
}

extern "C" void kernel_launch(void* const* d_in, const int* in_sizes, int n_in, void* d_out, int out_size, void* d_ws,
                              size_t ws_size, hipStream_t stream) {
  static int grid_blocks = 0;
  if (!grid_blocks) {
    int dev = 0, cus = 0, per_cu = 0;
    hipGetDevice(&dev);
    hipDeviceGetAttribute(&cus, hipDeviceAttributeMultiprocessorCount, dev);
    hipOccupancyMaxActiveBlocksPerMultiprocessor(&per_cu, mega, 256, 0);
    if (per_cu > 2) per_cu = 2;
    if (per_cu < 1) per_cu = 1;
    grid_blocks = cus * per_cu;
  }
  if (ws_size < WS_NEED) { fprintf(stderr, "workspace too small: %zu < %zu\n", ws_size, (size_t)WS_NEED); }
  Params p{};
  const float** f = (const float**)&p;
  for (int i = 0; i < 24; ++i) f[i] = (const float*)d_in[i];
  p.out = (float*)d_out;
  p.ws = (unsigned char*)d_ws;
#if MULTI_LAUNCH
  for (int ph = 0; ph < 10; ++ph) {
    p.lo = ph; p.hi = ph + 1;
    hipLaunchKernelGGL(mega, dim3(grid_blocks), dim3(256), 0, stream, p);
  }
#else
  p.lo = 0; p.hi = 10;
  void* args[] = {&p};
  hipError_t e = hipLaunchCooperativeKernel((void*)mega, dim3(grid_blocks), dim3(256), args, 0, stream);
  if (e != hipSuccess) fprintf(stderr, "cooperative launch failed: %s (grid %d)\n", hipGetErrorString(e), grid_blocks);
#endif
}
```

```cpp
#include <hip/hip_runtime.h>
#include <hip/hip_cooperative_groups.h>
#include <cstdio>
namespace cg = cooperative_groups;

#ifndef MULTI_LAUNCH
#define MULTI_LAUNCH 0
#endif

#define DI __device__ __forceinline__
typedef unsigned short u16;
typedef unsigned long long u64;
using bf16x8 = __attribute__((ext_vector_type(8))) short;
using f32x4 = __attribute__((ext_vector_type(4))) float;
using u32x4 = __attribute__((ext_vector_type(4))) unsigned;

constexpr int B_ = 4, S_ = 8192, T_ = B_ * S_;
constexpr int NINP = 3968;
constexpr float QSCALE = 0.125f * 1.44269504089f;

constexpr size_t MB = 1024 * 1024;
constexpr size_t OFF_WINT = 0;
constexpr size_t OFF_W1KT = OFF_WINT + (size_t)NINP * 1024 * 2;
constexpr size_t OFF_W1VT = OFF_W1KT + 256 * 2048 * 2;
constexpr size_t OFF_W2KT = OFF_W1VT + 256 * 2048 * 2;
constexpr size_t OFF_W2VT = OFF_W2KT + 128 * 256 * 2;
constexpr size_t OFF_WAT = OFF_W2VT + 128 * 256 * 2;
constexpr size_t OFF_WVT = OFF_WAT + 1024 * 512 * 2;
constexpr size_t OFF_WGT = OFF_WVT + 1024 * 512 * 2;
constexpr size_t OFF_WOT = OFF_WGT + 1024 * 512 * 2;
constexpr size_t OFF_WUPT = OFF_WOT + 1024 * 1024 * 2;
constexpr size_t OFF_WDT = OFF_WUPT + 4096 * 1024 * 2;
constexpr size_t OFF_ROPE = OFF_WDT + 4096 * 1024 * 2;
constexpr size_t OFF_CBIAS = OFF_ROPE + 8192 * 16 * 4;
constexpr size_t OFF_CTR = OFF_CBIAS + 2 * 256 * 4;
constexpr size_t OFF_SS1 = OFF_CTR + 256;
constexpr size_t OFF_SS2 = OFF_SS1 + (size_t)T_ * 16 * 4;
constexpr size_t OFF_NG = OFF_SS2 + (size_t)T_ * 16 * 4;
constexpr size_t OFF_HC = OFF_NG + (size_t)T_ * 24 * 4;
constexpr size_t OFF_KCC = OFF_HC + 2 * 4096 * 256 * 2;
constexpr size_t OFF_VCT = OFF_KCC + 8 * 512 * 64 * 2;
constexpr size_t OFF_HLOC = OFF_VCT + 8 * 512 * 64 * 2;
constexpr size_t OFF_ARENA = OFF_HLOC + (size_t)4 * 128 * 32 * 64 * 8;
constexpr size_t OFF_MG = OFF_ARENA;
constexpr size_t OFF_HN = OFF_ARENA + 128 * MB;
constexpr size_t OFF_QRAW = OFF_ARENA + 192 * MB;
constexpr size_t OFF_QROT = OFF_ARENA + 224 * MB;
constexpr size_t OFF_KCIN = OFF_ARENA + 256 * MB;
constexpr size_t OFF_VCIN = OFF_KCIN + 8 * MB;
constexpr size_t OFF_KS = OFF_VCIN + 8 * MB;
constexpr size_t OFF_VST = OFF_KS + 8 * MB;
constexpr size_t OFF_KW = OFF_VST + 8 * MB;
constexpr size_t OFF_VWT = OFF_KW + 8 * MB;
constexpr size_t OFF_U = OFF_ARENA + 304 * MB;
constexpr size_t OFF_NSA = OFF_ARENA + 336 * MB;
constexpr size_t OFF_YS = OFF_ARENA + 368 * MB;
constexpr size_t WS_NEED = OFF_ARENA + 400 * MB;
constexpr size_t OFF_ACT = OFF_ARENA;
constexpr size_t OFF_X1B = OFF_ARENA + 256 * MB;
constexpr size_t OFF_MERGED = OFF_HN;

constexpr int SMEM_BYTES = 74752;

struct Params {
  const float *x, *g1, *w_in, *pe, *kw1, *kw2, *vw1, *vw2, *lam_re, *lam_im, *log_step, *b_re, *b_im, *c_re, *c_im, *dsk,
      *w_attn, *w_val, *w_gate, *w_out, *g2, *w_up, *w_down, *g3;
  float* out;
  unsigned char* ws;
  int lo, hi;
};

typedef const __attribute__((address_space(4))) Params* PP;

DI int my_tid(int wv0) {
  int t = wv0 * 64 + (int)__lane_id();
  asm volatile("" : "+v"(t));
  return t;
}
DI u16 f2bf(float x) { unsigned u = __float_as_uint(x); u += 0x7fffu + ((u >> 16) & 1u); return (u16)(u >> 16); }
DI float bf2f(u16 h) { return __uint_as_float(((unsigned)h) << 16); }
DI unsigned pk2(float a, float b) { return (unsigned)f2bf(a) | ((unsigned)f2bf(b) << 16); }
DI float sigmoidf_(float x) { return 1.f / (1.f + __expf(-x)); }
DI float gelu_t(float x) {
  float u = 0.7978845608f * (x + 0.044715f * x * x * x);
  float e = __expf(2.f * u);
  float th = 1.f - 2.f / (e + 1.f);
  return 0.5f * x * (1.f + th);
}
DI float wave_sum(float v) {
#pragma unroll
  for (int o = 32; o > 0; o >>= 1) v += __shfl_xor(v, o);
  return v;
}
template <class T> DI T* launder(T* p) { asm volatile("" : "+v"(p)); return p; }
DI f32x4 mfma16(bf16x8 a, bf16x8 b, f32x4 c) { return __builtin_amdgcn_mfma_f32_16x16x32_bf16(a, b, c, 0, 0, 0); }

DI void gemm_core(int wv0, f32x4 (&acc)[4][4], const u16* __restrict__ A, int lda, const u16* __restrict__ Bt, int ldb, int K,
                  unsigned char* smem) {
  u16* sbase = (u16*)smem;
  const int tid = my_tid(wv0), lane = tid & 63, wv = wv0, l15 = lane & 15, lg = lane >> 4;
  const int wm = wv >> 1, wn = wv & 1;
  const int lrow = tid >> 3, lpart = tid & 7;
  const u16* ga = A + (size_t)lrow * lda + lpart * 8;
  const u16* gb = Bt + (size_t)lrow * ldb + lpart * 8;
  u32x4 ra0, ra1, ra2, ra3, rb0, rb1, rb2, rb3;
#define GLOAD(KO)                                                 \
  ra0 = *(const u32x4*)(ga + (KO));                               \
  ra1 = *(const u32x4*)(ga + (size_t)32 * lda + (KO));            \
  ra2 = *(const u32x4*)(ga + (size_t)64 * lda + (KO));            \
  ra3 = *(const u32x4*)(ga + (size_t)96 * lda + (KO));            \
  rb0 = *(const u32x4*)(gb + (KO));                               \
  rb1 = *(const u32x4*)(gb + (size_t)32 * ldb + (KO));            \
  rb2 = *(const u32x4*)(gb + (size_t)64 * ldb + (KO));            \
  rb3 = *(const u32x4*)(gb + (size_t)96 * ldb + (KO));
#define LSTORE(SA)                                                \
  {                                                               \
    u16* _a = (SA) + lrow * 72 + lpart * 8;                       \
    *(u32x4*)(_a) = ra0;                                          \
    *(u32x4*)(_a + 32 * 72) = ra1;                                \
    *(u32x4*)(_a + 64 * 72) = ra2;                                \
    *(u32x4*)(_a + 96 * 72) = ra3;                                \
    *(u32x4*)(_a + 128 * 72) = rb0;                               \
    *(u32x4*)(_a + 160 * 72) = rb1;                               \
    *(u32x4*)(_a + 192 * 72) = rb2;                               \
    *(u32x4*)(_a + 224 * 72) = rb3;                               \
  }
  GLOAD(0)
  LSTORE(sbase)
  __syncthreads();
  int cur = 0;
#pragma unroll 1
  for (int k0 = 0; k0 < K; k0 += 64) {
    const bool more = (k0 + 64) < K;
    if (more) { GLOAD(k0 + 64) }
    const u16* sA = sbase + cur * (256 * 72);
    const u16* sB = sA + 128 * 72;
#pragma unroll
    for (int ks = 0; ks < 2; ++ks) {
      bf16x8 af[4], bfr[4];
#pragma unroll
      for (int mt = 0; mt < 4; ++mt) af[mt] = *(const bf16x8*)(sA + (wm * 64 + mt * 16 + l15) * 72 + ks * 32 + lg * 8);
#pragma unroll
      for (int nt = 0; nt < 4; ++nt) bfr[nt] = *(const bf16x8*)(sB + (wn * 64 + nt * 16 + l15) * 72 + ks * 32 + lg * 8);
#pragma unroll
      for (int mt = 0; mt < 4; ++mt)
#pragma unroll
        for (int nt = 0; nt < 4; ++nt) acc[mt][nt] = mfma16(af[mt], bfr[nt], acc[mt][nt]);
    }
    cur ^= 1;
    if (more) LSTORE(sbase + cur * (256 * 72))
    __syncthreads();
  }
}
DI void zero_acc(f32x4 (&acc)[4][4]) {
#pragma unroll
  for (int a = 0; a < 4; ++a)
#pragma unroll
    for (int b = 0; b < 4; ++b) acc[a][b] = f32x4{0.f, 0.f, 0.f, 0.f};
}
template <class F>
DI void epi_loop(int wv0, f32x4 (&acc)[4][4], int m0, int n0, F f) {
  const int _lane = my_tid(wv0) & 63, _wv = wv0;
#pragma unroll
  for (int mt = 0; mt < 4; ++mt) {
#pragma unroll
    for (int nt = 0; nt < 4; ++nt) {
      const int row0 = m0 + (_wv >> 1) * 64 + mt * 16 + (_lane >> 4) * 4;
      const int col = n0 + (_wv & 1) * 64 + nt * 16 + (_lane & 15);
      f(mt, nt, row0, col, acc[mt][nt]);
    }
  }
}

DI void phaseA(int wv0, PP p, unsigned char* smem) {
  const int tid = my_tid(wv0), lane = tid & 63, wv = wv0;
  u16* HN = (u16*)(p->ws + OFF_HN);
  for (int row = blockIdx.x * 4 + wv; row < T_; row += gridDim.x * 4) {
    const float4* xr = (const float4*)(p->x + (size_t)row * 1024);
    float4 v[4];
    float ss = 0.f;
#pragma unroll
    for (int r = 0; r < 4; ++r) {
      v[r] = xr[lane + 64 * r];
      ss += v[r].x * v[r].x + v[r].y * v[r].y + v[r].z * v[r].z + v[r].w * v[r].w;
    }
    ss = wave_sum(ss);
    const float rinv = rsqrtf(ss * (1.f / 1024.f) + 1e-6f);
#pragma unroll
    for (int r = 0; r < 4; ++r) {
      const float4 g = ((const float4*)p->g1)[lane + 64 * r];
      uint2 o;
      o.x = pk2(v[r].x * rinv * g.x, v[r].y * rinv * g.y);
      o.y = pk2(v[r].z * rinv * g.z, v[r].w * rinv * g.w);
      *(uint2*)(HN + (size_t)row * 1024 + (lane + 64 * r) * 4) = o;
    }
  }
  float* tile = (float*)smem;
  constexpr int NXT = 992 + 128 + 128 + 8 + 8 + 128 * 3 + 256 + 1024 + 1024;
  for (int jt = blockIdx.x; jt < NXT + 8; jt += gridDim.x) {
    if (jt < NXT) {
      int t = jt;
      const float* src;
      u16* dst;
      int K, Nsrc, mode = 0;
      const float* scl = nullptr;
      if (t < 992) { src = p->w_in; dst = (u16*)(p->ws + OFF_WINT); K = 1024; Nsrc = 3864; mode = 1; }
      else if ((t -= 992) < 128) { src = p->kw1; dst = (u16*)(p->ws + OFF_W1KT); K = 2048; Nsrc = 256; }
      else if ((t -= 128) < 128) { src = p->vw1; dst = (u16*)(p->ws + OFF_W1VT); K = 2048; Nsrc = 256; }
      else if ((t -= 128) < 8) { src = p->kw2; dst = (u16*)(p->ws + OFF_W2KT); K = 256; Nsrc = 64; mode = 2; }
      else if ((t -= 8) < 8) { src = p->vw2; dst = (u16*)(p->ws + OFF_W2VT); K = 256; Nsrc = 64; mode = 2; }
      else if ((t -= 8) < 128) { src = p->w_attn; dst = (u16*)(p->ws + OFF_WAT); K = 512; Nsrc = 1024; }
      else if ((t -= 128) < 128) { src = p->w_val; dst = (u16*)(p->ws + OFF_WVT); K = 512; Nsrc = 1024; }
      else if ((t -= 128) < 128) { src = p->w_gate; dst = (u16*)(p->ws + OFF_WGT); K = 512; Nsrc = 1024; }
      else if ((t -= 128) < 256) { src = p->w_out; dst = (u16*)(p->ws + OFF_WOT); K = 1024; Nsrc = 1024; }
      else if ((t -= 256) < 1024) { src = p->w_up; dst = (u16*)(p->ws + OFF_WUPT); K = 1024; Nsrc = 4096; scl = p->g2; }
      else { t -= 1024; src = p->w_down; dst = (u16*)(p->ws + OFF_WDT); K = 4096; Nsrc = 1024; }
      const int nkt = K >> 6, tn = t / nkt, tk = t % nkt, n0 = tn * 64, k0 = tk * 64;
      const int tx = tid & 63, ty = tid >> 6;
      const int np = n0 + tx;
      int sc = np;
      if (mode == 1) {
        if (np < 1280) sc = np;
        else if (np < 1792) sc = 1304 + (np - 1280);
        else if (np < 3840) sc = 1816 + (np - 1792);
        else if (np < 3864) sc = 1280 + (np - 3840);
        else sc = -1;
      } else if (mode == 2) {
        sc = np < 64 ? np : -1;
      }
      for (int kk = ty; kk < 64; kk += 4) {
        float val = 0.f;
        if (sc >= 0) val = src[(size_t)(k0 + kk) * Nsrc + sc];
        if (scl) val *= scl[k0 + kk];
        tile[kk * 65 + tx] = val;
      }
      __syncthreads();
#pragma unroll
      for (int r = 0; r < 2; ++r) {
        const int c = tid + 256 * r, n = c >> 3, kc = c & 7;
        uint4 o;
        o.x = pk2(tile[(kc * 8 + 0) * 65 + n], tile[(kc * 8 + 1) * 65 + n]);
        o.y = pk2(tile[(kc * 8 + 2) * 65 + n], tile[(kc * 8 + 3) * 65 + n]);
        o.z = pk2(tile[(kc * 8 + 4) * 65 + n], tile[(kc * 8 + 5) * 65 + n]);
        o.w = pk2(tile[(kc * 8 + 6) * 65 + n], tile[(kc * 8 + 7) * 65 + n]);
        *(uint4*)(dst + (size_t)(n0 + n) * K + k0 + kc * 8) = o;
      }
      __syncthreads();
    } else {
      const int item = jt - NXT, kv = item >> 2, cgp = item & 3;
      const float* w1 = kv ? p->vw1 : p->kw1;
      const int col = cgp * 64 + (tid & 63), ks = tid >> 6;
      float s = 0.f;
      for (int k = ks * 512; k < ks * 512 + 512; ++k) s += p->pe[k] * w1[(size_t)k * 256 + col];
      tile[ks * 64 + (tid & 63)] = s;
      __syncthreads();
      if (tid < 64) ((float*)(p->ws + OFF_CBIAS))[kv * 256 + col] = tile[tid] + tile[64 + tid] + tile[128 + tid] + tile[192 + tid];
      __syncthreads();
    }
  }
  float* rope = (float*)(p->ws + OFF_ROPE);
  for (int i = blockIdx.x * 256 + tid; i < S_ * 8; i += gridDim.x * 256) {
    const int pos = i >> 3, k = i & 7;
    const float inv = powf(500000.0f, -(2.0f * (float)k) / 16.0f);
    const float ang = (float)pos * inv;
    rope[pos * 16 + k] = cosf(ang);
    rope[pos * 16 + 8 + k] = sinf(ang);
  }
  if (blockIdx.x == 0 && tid < 16) ((int*)(p->ws + OFF_CTR))[tid] = 0;
}

DI void phaseB(int wv0, PP p, unsigned char* smem) {
  const u16* HN = (const u16*)(p->ws + OFF_HN);
  const u16* WT = (const u16*)(p->ws + OFF_WINT);
  const float* rope = (const float*)(p->ws + OFF_ROPE);
  const int lane = my_tid(wv0) & 63;
  for (int id = blockIdx.x; id < 256 * 31; id += gridDim.x) {
    const int tm = id / 31, tn = id % 31, m0 = tm * 128, n0 = tn * 128;
    f32x4 acc[4][4];
    zero_acc(acc);
    gemm_core(wv0, acc, HN + (size_t)m0 * 1024, 1024, WT + (size_t)n0 * 1024, 1024, 1024, smem);
    if (tn < 4) {
      u16* QR = (u16*)(p->ws + OFF_QRAW);
      u16* QO = (u16*)(p->ws + OFF_QROT);
      epi_loop(wv0, acc, m0, n0, [&](int mt, int nt, int row0, int col, f32x4& v) {
        f32x4 r = v;
        if (nt == 0) {
          const int k = lane & 7;
#pragma unroll
          for (int i = 0; i < 4; ++i) {
            const float pr = __shfl_xor(v[i], 8);
            const int pos = (row0 + i) & (S_ - 1);
            const float c = rope[pos * 16 + k], s = rope[pos * 16 + 8 + k];
            r[i] = (lane & 8) ? (v[i] * c + pr * s) : (v[i] * c - pr * s);
          }
        }
#pragma unroll
        for (int i = 0; i < 4; ++i) {
          QR[(size_t)(row0 + i) * 512 + col] = f2bf(v[i] * QSCALE);
          QO[(size_t)(row0 + i) * 512 + col] = f2bf(r[i] * QSCALE);
        }
      });
    } else if (tn < 10) {
      const int sub = tn - 4;
      const bool dorope = (sub == 2 || sub == 4), transposed = (sub == 3 || sub == 5);
      u16* dst = (u16*)(p->ws + OFF_KCIN + (size_t)sub * 8 * MB);
      epi_loop(wv0, acc, m0, n0, [&](int mt, int nt, int row0, int col, f32x4& v) {
        const int c128 = col - n0, g = c128 >> 6, d = c128 & 63;
        const int b = row0 >> 13, s = row0 & (S_ - 1);
        f32x4 r = v;
        if (dorope && nt == 0) {
          const int k = lane & 7;
#pragma unroll
          for (int i = 0; i < 4; ++i) {
            const float pr = __shfl_xor(v[i], 8);
            const float c = rope[(s + i) * 16 + k], sn = rope[(s + i) * 16 + 8 + k];
            r[i] = (lane & 8) ? (v[i] * c + pr * sn) : (v[i] * c - pr * sn);
          }
        }
        if (transposed) {
          uint2 o;
          o.x = pk2(r[0], r[1]);
          o.y = pk2(r[2], r[3]);
          *(uint2*)(dst + ((size_t)((b * 2 + g) * 64 + d)) * S_ + s) = o;
        } else {
#pragma unroll
          for (int i = 0; i < 4; ++i) dst[((size_t)(b * 2 + g) * S_ + s + i) * 64 + d] = f2bf(r[i]);
        }
      });
    } else if (tn < 14) {
      u16* U = (u16*)(p->ws + OFF_U);
      epi_loop(wv0, acc, m0, n0, [&](int mt, int nt, int row0, int col, f32x4& v) {
#pragma unroll
        for (int i = 0; i < 4; ++i) U[(size_t)(row0 + i) * 512 + (col - 1280)] = f2bf(v[i]);
      });
    } else if (tn < 30) {
      u16* MG = (u16*)(p->ws + OFF_MG);
      epi_loop(wv0, acc, m0, n0, [&](int mt, int nt, int row0, int col, f32x4& v) {
#pragma unroll
        for (int i = 0; i < 4; ++i) MG[(size_t)(row0 + i) * 2048 + (col - 1792)] = f2bf(sigmoidf_(v[i]));
      });
    } else {
      float* NG = (float*)(p->ws + OFF_NG);
      epi_loop(wv0, acc, m0, n0, [&](int mt, int nt, int row0, int col, f32x4& v) {
        const int cc = col - 3840;
        if (cc < 24) {
#pragma unroll
          for (int i = 0; i < 4; ++i) NG[(size_t)(row0 + i) * 24 + cc] = sigmoidf_(v[i]);
        }
      });
    }
  }
}

struct S5c {
  float lbr, lbi;
  float br[16], bi[16];
};
DI void s5_setup(PP p, int g, int n, S5c& c) {
  const float step = expf(p->log_step[g]);
  const float lr = p->lam_re[g * 64 + n], li = p->lam_im[g * 64 + n];
  const float er = expf(lr * step);
  float sn, cs;
  sincosf(li * step, &sn, &cs);
  c.lbr = er * cs;
  c.lbi = er * sn;
  const float nr = c.lbr - 1.f, ni = c.lbi, den = lr * lr + li * li;
  const float cr = (nr * lr + ni * li) / den, ci = (ni * lr - nr * li) / den;
#pragma unroll
  for (int k = 0; k < 16; ++k) {
    const float bre = p->b_re[(g * 64 + n) * 16 + k], bim = p->b_im[(g * 64 + n) * 16 + k];
    c.br[k] = cr * bre - ci * bim;
    c.bi[k] = cr * bim + ci * bre;
  }
}
DI void s5_load_u(PP p, int b, int ch, int g, float* su, int lane) {
  const u16* U = (const u16*)(p->ws + OFF_U) + ((size_t)(b * S_ + ch * 64 + lane)) * 512 + g * 16;
  const uint4 a = *(const uint4*)U, c = *(const uint4*)(U + 8);
  float* d = su + lane * 16;
  const unsigned w[8] = {a.x, a.y, a.z, a.w, c.x, c.y, c.z, c.w};
#pragma unroll
  for (int k = 0; k < 8; ++k) {
    d[2 * k] = __uint_as_float(w[k] << 16);
    d[2 * k + 1] = __uint_as_float(w[k] & 0xffff0000u);
  }
}
DI void s5_step(const S5c& c, const float* ut, float& hr, float& hi) {
  float bur = 0.f, bui = 0.f;
#pragma unroll
  for (int k4 = 0; k4 < 4; ++k4) {
    const float4 u = *(const float4*)(ut + 4 * k4);
    bur += c.br[4 * k4] * u.x + c.br[4 * k4 + 1] * u.y + c.br[4 * k4 + 2] * u.z + c.br[4 * k4 + 3] * u.w;
    bui += c.bi[4 * k4] * u.x + c.bi[4 * k4 + 1] * u.y + c.bi[4 * k4 + 2] * u.z + c.bi[4 * k4 + 3] * u.w;
  }
  const float nr = c.lbr * hr - c.lbi * hi + bur;
  const float nim = c.lbr * hi + c.lbi * hr + bui;
  hr = nr;
  hi = nim;
}
DI void s5_pass1(int wv0, PP p, int item, unsigned char* smem) {
  const int tid = my_tid(wv0), lane = tid & 63, wv = wv0;
  const int b = item >> 10, g = (item >> 5) & 31, cq = item & 31, ch = cq * 4 + wv;
  float* su = (float*)smem + wv * 1024;
  S5c c;
  s5_setup(p, g, lane, c);
  s5_load_u(p, b, ch, g, su, lane);
  __syncthreads();
  float hr = 0.f, hi = 0.f;
  for (int t = 0; t < 64; ++t) s5_step(c, su + t * 16, hr, hi);
  float2* HL = (float2*)(p->ws + OFF_HLOC);
  HL[((size_t)(b * 128 + ch) * 32 + g) * 64 + lane] = make_float2(hr, hi);
  __syncthreads();
}
DI void s5_carry(int wv0, PP p) {
  const int x = blockIdx.x * 256 + my_tid(wv0);
  if (x >= 8192) return;
  const int b = x >> 11, g = (x >> 6) & 31, n = x & 63;
  const float step = expf(p->log_step[g]);
  const float lr = p->lam_re[g * 64 + n], li = p->lam_im[g * 64 + n];
  const float er = expf(64.f * lr * step);
  float sn, cs;
  sincosf(64.f * li * step, &sn, &cs);
  const float Lr = er * cs, Li = er * sn;
  float2* HL = (float2*)(p->ws + OFF_HLOC) + (size_t)b * 128 * 2048 + g * 64 + n;
  float hr = 0.f, hi = 0.f;
  for (int c0 = 0; c0 < 128; c0 += 16) {
    float2 v[16];
#pragma unroll
    for (int k = 0; k < 16; ++k) v[k] = HL[(size_t)(c0 + k) * 2048];
#pragma unroll
    for (int k = 0; k < 16; ++k) {
      HL[(size_t)(c0 + k) * 2048] = make_float2(hr, hi);
      const float nr = Lr * hr - Li * hi + v[k].x;
      const float nim = Lr * hi + Li * hr + v[k].y;
      hr = nr;
      hi = nim;
    }
  }
}
DI void s5_pass3(int wv0, PP p, int item, unsigned char* smem) {
  const int tid = my_tid(wv0), lane = tid & 63, wv = wv0;
  const int b = item >> 10, g = (item >> 5) & 31, cq = item & 31, ch = cq * 4 + wv;
  float* su = (float*)smem + wv * 1024;
  float* sh = (float*)smem + 4096 + wv * (16 * 130);
  float* sC = (float*)smem + 4096 + 4 * 16 * 130;
  S5c c;
  s5_setup(p, g, lane, c);
  s5_load_u(p, b, ch, g, su, lane);
  for (int e = tid; e < 1024; e += 256) {
    const int cc = e >> 6, n = e & 63;
    sC[(n * 16 + cc) * 2] = p->c_re[(g * 16 + cc) * 64 + n];
    sC[(n * 16 + cc) * 2 + 1] = p->c_im[(g * 16 + cc) * 64 + n];
  }
  const float2 h0 = ((const float2*)(p->ws + OFF_HLOC))[((size_t)(b * 128 + ch) * 32 + g) * 64 + lane];
  float hr = h0.x, hi = h0.y;
  const int tt = lane >> 2, c4 = lane & 3;
  float dk[4];
#pragma unroll
  for (int k = 0; k < 4; ++k) dk[k] = p->dsk[g * 16 + c4 * 4 + k];
  u16* YS = (u16*)(p->ws + OFF_YS);
  __syncthreads();
  for (int sub = 0; sub < 4; ++sub) {
    for (int t = 0; t < 16; ++t) {
      s5_step(c, su + (sub * 16 + t) * 16, hr, hi);
      *(float2*)(sh + t * 130 + 2 * lane) = make_float2(hr, hi);
    }
    __syncthreads();
    float a0 = 0.f, a1 = 0.f, a2 = 0.f, a3 = 0.f;
    for (int n = 0; n < 64; ++n) {
      const float2 h = *(const float2*)(sh + tt * 130 + 2 * n);
      const float4 c0 = *(const float4*)(sC + (n * 16 + c4 * 4) * 2);
      const float4 c1 = *(const float4*)(sC + (n * 16 + c4 * 4) * 2 + 4);
      a0 += c0.x * h.x - c0.y * h.y;
      a1 += c0.z * h.x - c0.w * h.y;
      a2 += c1.x * h.x - c1.y * h.y;
      a3 += c1.z * h.x - c1.w * h.y;
    }
    const int t = sub * 16 + tt;
    const float4 uu = *(const float4*)(su + t * 16 + c4 * 4);
    uint2 o;
    o.x = pk2(gelu_t(a0 + dk[0] * uu.x), gelu_t(a1 + dk[1] * uu.y));
    o.y = pk2(gelu_t(a2 + dk[2] * uu.z), gelu_t(a3 + dk[3] * uu.w));
    *(uint2*)(YS + ((size_t)(b * S_ + ch * 64 + t)) * 512 + g * 16 + c4 * 4) = o;
    __syncthreads();
  }
}

DI void phaseC(int wv0, PP p, unsigned char* smem) {
  const float* cb = (const float*)(p->ws + OFF_CBIAS);
  for (int id = blockIdx.x; id < 128 + 4096; id += gridDim.x) {
    if (id < 128) {
      const int kv = id >> 6, tm = (id >> 1) & 31, tn = id & 1, m0 = tm * 128, n0 = tn * 128;
      const u16* A = (const u16*)(p->ws + (kv ? OFF_VCIN : OFF_KCIN)) + (size_t)m0 * 1024;
      const u16* Bt = (const u16*)(p->ws + (kv ? OFF_W1VT : OFF_W1KT)) + (size_t)n0 * 2048;
      f32x4 acc[4][4];
      zero_acc(acc);
      gemm_core(wv0, acc, A, 1024, Bt, 2048, 2048, smem);
      u16* HC = (u16*)(p->ws + OFF_HC) + (size_t)kv * 4096 * 256;
      epi_loop(wv0, acc, m0, n0, [&](int mt, int nt, int row0, int col, f32x4& v) {
        const float bb = cb[kv * 256 + col];
#pragma unroll
        for (int i = 0; i < 4; ++i) HC[(size_t)(row0 + i) * 256 + col] = f2bf(gelu_t(v[i] + bb));
      });
    } else {
      s5_pass1(wv0, p, id - 128, smem);
    }
  }
}
DI void phaseD(int wv0, PP p, unsigned char* smem) {
  for (int id = blockIdx.x; id < 64; id += gridDim.x) {
    const int kv = id >> 5, tm = id & 31, m0 = tm * 128;
    const u16* A = (const u16*)(p->ws + OFF_HC) + (size_t)kv * 4096 * 256 + (size_t)m0 * 256;
    const u16* Bt = (const u16*)(p->ws + (kv ? OFF_W2VT : OFF_W2KT));
    f32x4 acc[4][4];
    zero_acc(acc);
    gemm_core(wv0, acc, A, 256, Bt, 256, 256, smem);
    u16* KCC = (u16*)(p->ws + OFF_KCC);
    u16* VCT = (u16*)(p->ws + OFF_VCT);
    epi_loop(wv0, acc, m0, 0, [&](int mt, int nt, int row0, int col, f32x4& v) {
      if (col < 64) {
        const int bg = row0 >> 9, n = row0 & 511;
        f32x4 r = v;
        if (n + 3 == 511) r[3] = 0.f;
        if (kv == 0) {
#pragma unroll
          for (int i = 0; i < 4; ++i) KCC[((size_t)bg * 512 + n + i) * 64 + col] = f2bf(r[i]);
        } else {
          uint2 o;
          o.x = pk2(r[0], r[1]);
          o.y = pk2(r[2], r[3]);
          *(uint2*)(VCT + ((size_t)bg * 64 + col) * 512 + n) = o;
        }
      }
    });
  }
  s5_carry(wv0, p);
}

DI bool bit128(u64 lo, u64 hi, int j) { return j < 64 ? ((lo >> j) & 1ull) : ((hi >> (j - 64)) & 1ull); }
DI int next_bit(u64 lo, u64 hi, int from) {
  if (from < 64) {
    const u64 x = (lo >> from) << from;
    if (x) return __ffsll((long long)x) - 1;
    from = 64;
  }
  if (from >= 128) return -1;
  const u64 y = (hi >> (from - 64)) << (from - 64);
  return y ? 63 + __ffsll((long long)y) : -1;
}

template <int MODE, bool MASKED, class MaskF>
DI void flash_tile(const u16* sK, const u16* sV, const bf16x8 (&qf)[2][2], f32x4 (&O)[2][4], float (&m)[2], float (&l)[2],
                   float (&ps)[4][4], MaskF ok, bool sel, int lane) {
  const int l15 = lane & 15, lg = lane >> 4;
  bf16x8 kf[4][2];
#pragma unroll
  for (int kt = 0; kt < 4; ++kt)
#pragma unroll
    for (int ks = 0; ks < 2; ++ks) kf[kt][ks] = *(const bf16x8*)(sK + (16 * kt + l15) * 72 + ks * 32 + lg * 8);
  if (MODE == 1) {
#pragma unroll
    for (int a = 0; a < 4; ++a)
#pragma unroll
      for (int b = 0; b < 4; ++b) ps[a][b] = 0.f;
  }
#pragma unroll
  for (int qt = 0; qt < 2; ++qt) {
    f32x4 s[4];
#pragma unroll
    for (int kt = 0; kt < 4; ++kt) {
      s[kt] = f32x4{0.f, 0.f, 0.f, 0.f};
#pragma unroll
      for (int ks = 0; ks < 2; ++ks) s[kt] = mfma16(kf[kt][ks], qf[qt][ks], s[kt]);
    }
    float mx = -1e30f;
#pragma unroll
    for (int kt = 0; kt < 4; ++kt)
#pragma unroll
      for (int i = 0; i < 4; ++i) {
        if (MASKED) s[kt][i] = ok(kt, i) ? s[kt][i] : -1e30f;
        mx = fmaxf(mx, s[kt][i]);
      }
    if (!MASKED) mx = sel ? mx : -1e30f;
    float pr[4][4];
    if (MODE == 1) {
      const float mm = m[qt], il = l[qt];
#pragma unroll
      for (int kt = 0; kt < 4; ++kt)
#pragma unroll
        for (int i = 0; i < 4; ++i) {
          const float pv = (s[kt][i] > -1e29f) ? __builtin_amdgcn_exp2f(s[kt][i] - mm) * il : 0.f;
          pr[kt][i] = pv;
          ps[kt][i] += pv;
        }
    } else {
      mx = fmaxf(mx, __shfl_xor(mx, 16));
      mx = fmaxf(mx, __shfl_xor(mx, 32));
      const float mnew = fmaxf(m[qt], mx);
      const float alpha = __builtin_amdgcn_exp2f(m[qt] - mnew);
      m[qt] = mnew;
      float rs = 0.f;
      if (MASKED) {
#pragma unroll
        for (int kt = 0; kt < 4; ++kt)
#pragma unroll
          for (int i = 0; i < 4; ++i) {
            const float pv = (s[kt][i] > -1e29f) ? __builtin_amdgcn_exp2f(s[kt][i] - mnew) : 0.f;
            pr[kt][i] = pv;
            rs += pv;
          }
      } else {
        const float me = sel ? mnew : 1e30f;
#pragma unroll
        for (int kt = 0; kt < 4; ++kt)
#pragma unroll
          for (int i = 0; i < 4; ++i) {
            const float pv = __builtin_amdgcn_exp2f(s[kt][i] - me);
            pr[kt][i] = pv;
            rs += pv;
          }
      }
      l[qt] = l[qt] * alpha + rs;
      if (MODE == 2) {
#pragma unroll
        for (int dt = 0; dt < 4; ++dt) O[qt][dt] *= alpha;
      }
    }
    if (MODE != 0) {
#pragma unroll
      for (int ks2 = 0; ks2 < 2; ++ks2) {
        union { unsigned u[4]; bf16x8 v; } pf;
        pf.u[0] = pk2(pr[2 * ks2][0], pr[2 * ks2][1]);
        pf.u[1] = pk2(pr[2 * ks2][2], pr[2 * ks2][3]);
        pf.u[2] = pk2(pr[2 * ks2 + 1][0], pr[2 * ks2 + 1][1]);
        pf.u[3] = pk2(pr[2 * ks2 + 1][2], pr[2 * ks2 + 1][3]);
#pragma unroll
        for (int dt = 0; dt < 4; ++dt) {
          union { uint2 h[2]; bf16x8 v; } vf;
          vf.h[0] = *(const uint2*)(sV + (16 * dt + l15) * 72 + 32 * ks2 + 4 * lg);
          vf.h[1] = *(const uint2*)(sV + (16 * dt + l15) * 72 + 32 * ks2 + 16 + 4 * lg);
          O[qt][dt] = mfma16(vf.v, pf.v, O[qt][dt]);
        }
      }
    }
  }
}

DI void nsa_item(int wv0, PP p, int item, unsigned char* smem) {
  const int tid = my_tid(wv0), lane = tid & 63, wv = wv0, l15 = lane & 15, lg = lane >> 4;
  const int i = 127 - (item >> 3), bg = item & 7, b = bg >> 1, g = bg & 1;
  u16* sK = (u16*)smem;
  u16* sV = sK + 64 * 72;
  float* sImp = (float*)(smem + 18432);
  u64* sUni = (u64*)(smem + 18432 + 64 * 132 * 4);
  const int t0 = i * 64, qloc = 16 * wv + l15, tq = t0 + qloc;
  const unsigned tokq = (unsigned)(b * S_ + tq);
  const float* NGb = (const float*)(p->ws + OFF_NG);
  const unsigned ngoff = tokq * 24 + g * 12;
  float* ACCb = p->out;
  const unsigned aoff = tokq * 512 + g * 256 + 4 * lg;
  const unsigned qoff = tokq * 512 + g * 256 + lg * 8;
  const int lrow = tid >> 3, lpart = tid & 7;
  const unsigned koff = (lrow * 64 + lpart * 8) * 2, voffc = (lrow * 512 + lpart * 8) * 2, voffs = (lrow * S_ + lpart * 8) * 2;

  for (int e = tid; e < 64 * 132; e += 256) sImp[e] = 0.f;

  bf16x8 qf[2][2];
  f32x4 O[2][4];
  float m[2], l[2], ps[4][4];
  u32x4 pk0, pk1, pv0, pv1;
  auto nomask = [](int, int) { return true; };

#define MAKE_RSRC(PTR) __builtin_amdgcn_make_buffer_rsrc((void*)(PTR), 0, 0x7fffffff, 0x00020000)
#define BLOAD(R, VO, SO) __builtin_amdgcn_raw_buffer_load_b128((R), (int)(VO), (int)(SO), 0)
#define ISSUE_TILE(RK, RV, T, LDV)                                                   \
  {                                                                                  \
    const unsigned vo_ = ((LDV) == 512) ? voffc : voffs;                             \
    pk0 = BLOAD(RK, koff, (T)*8192);                                                 \
    pk1 = BLOAD(RK, koff + 32 * 64 * 2, (T)*8192);                                   \
    pv0 = BLOAD(RV, vo_, (T)*128);                                                   \
    pv1 = BLOAD(RV, vo_ + 32 * (LDV)*2, (T)*128);                                    \
  }
#define COMMIT_TILE()                                                                \
  {                                                                                  \
    *(u32x4*)(sK + (lrow)*72 + lpart * 8) = pk0;                                     \
    *(u32x4*)(sK + (lrow + 32) * 72 + lpart * 8) = pk1;                              \
    *(u32x4*)(sV + (lrow)*72 + lpart * 8) = pv0;                                     \
    *(u32x4*)(sV + (lrow + 32) * 72 + lpart * 8) = pv1;                              \
  }
#define LOAD_Q(BASE, HP)                                                             \
  {                                                                                  \
    const u16* Q_ = (const u16*)(p->ws + (BASE));                                     \
    _Pragma("unroll") for (int qt = 0; qt < 2; ++qt)                                 \
      _Pragma("unroll") for (int ks = 0; ks < 2; ++ks)                               \
        qf[qt][ks] = *(const bf16x8*)(Q_ + (qoff + (HP)*128 + qt * 64 + ks * 32));  \
  }
#define RESET_STATE()                                                                \
  {                                                                                  \
    _Pragma("unroll") for (int qt = 0; qt < 2; ++qt) { m[qt] = -1e30f; l[qt] = 0.f; } \
    _Pragma("unroll") for (int a = 0; a < 2; ++a)                                    \
      _Pragma("unroll") for (int c = 0; c < 4; ++c) O[a][c] = f32x4{0.f, 0.f, 0.f, 0.f}; \
  }

  const u16* Kc0 = (const u16*)(p->ws + OFF_KCC) + (size_t)bg * 512 * 64;
  const u16* Vc0 = (const u16*)(p->ws + OFF_VCT) + (size_t)bg * 64 * 512;
  const int nE = (4 * i + 3) < 511 ? (4 * i + 3) : 511;
  const int nkb = (nE + 63) >> 6;
#pragma unroll 1
  for (int hp = 0; hp < 2; ++hp) {
    int zz = 0;
    asm volatile("" : "+s"(zz));
    const __amdgpu_buffer_rsrc_t rK = MAKE_RSRC(Kc0 + zz), rV = MAKE_RSRC(Vc0 + zz);
    LOAD_Q(OFF_QRAW, hp)
    RESET_STATE()
    for (int kb = 0; kb < nkb; ++kb) {
      ISSUE_TILE(rK, rV, kb, 512)
      __syncthreads();
      COMMIT_TILE()
      __syncthreads();
      auto ok = [&](int kt, int ii) { return 16 * (kb * 64 + 16 * kt + 4 * lg + ii) + 31 <= tq; };
      flash_tile<0, true>(sK, sV, qf, O, m, l, ps, ok, true, lane);
    }
#pragma unroll
    for (int qt = 0; qt < 2; ++qt) {
      float s = l[qt];
      s += __shfl_xor(s, 16);
      s += __shfl_xor(s, 32);
      l[qt] = s > 0.f ? 1.f / s : 0.f;
    }
    for (int kb = 0; kb < nkb; ++kb) {
      ISSUE_TILE(rK, rV, kb, 512)
      __syncthreads();
      COMMIT_TILE()
      __syncthreads();
      auto ok = [&](int kt, int ii) { return 16 * (kb * 64 + 16 * kt + 4 * lg + ii) + 31 <= tq; };
      flash_tile<1, true>(sK, sV, qf, O, m, l, ps, ok, true, lane);
#pragma unroll
      for (int kt = 0; kt < 4; ++kt) {
        const int j = kb * 16 + kt * 4 + lg;
        sImp[qloc * 132 + j] += ps[kt][0] + ps[kt][1] + ps[kt][2] + ps[kt][3];
      }
      __syncthreads();
#pragma unroll
      for (int kt = 0; kt < 4; ++kt) {
        const int j1 = kb * 16 + kt * 4 + lg + 1;
        if (j1 < 128) sImp[qloc * 132 + j1] += ps[kt][3];
      }
    }
#pragma unroll
    for (int qt = 0; qt < 2; ++qt) {
      const float gt = NGb[ngoff + (hp * 2 + qt) * 3 + 0];
#pragma unroll
      for (int dt = 0; dt < 4; ++dt) {
        float4 o = make_float4(O[qt][dt][0] * gt, O[qt][dt][1] * gt, O[qt][dt][2] * gt, O[qt][dt][3] * gt);
        *(float4*)(ACCb + (aoff + (hp * 2 + qt) * 64 + 16 * dt)) = o;
      }
    }
  }
  __syncthreads();
  u64 mlo = 0, mhi = 0, wlo = 0, whi = 0;
  if (i < 16) {
    mlo = (1ull << (i + 1)) - 1ull;
    wlo = mlo;
  } else {
    const bool v0 = lane <= i, v1 = (lane + 64) <= i;
    const bool f0 = (lane == 0) || (lane == i) || (lane == i - 1);
    const bool f1 = (lane + 64 == i) || (lane + 64 == i - 1);
    const u64 ltm = (1ull << lane) - 1ull;
    for (int qq = 0; qq < 16; ++qq) {
      const float* ir = sImp + (16 * wv + qq) * 132;
      const unsigned k0 = v0 ? __float_as_uint(ir[lane] + (f0 ? 1000.f : 0.f)) : 0u;
      const unsigned k1 = v1 ? __float_as_uint(ir[lane + 64] + (f1 ? 1000.f : 0.f)) : 0u;
      unsigned T = 0;
      for (int bit = 30; bit >= 0; --bit) {
        const unsigned cand = T | (1u << bit);
        const int cnt = __popcll(__ballot(k0 >= cand)) + __popcll(__ballot(k1 >= cand));
        if (cnt >= 16) T = cand;
      }
      const bool g0 = k0 > T, g1 = k1 > T, e0 = k0 == T, e1 = k1 == T;
      const int need = 16 - (__popcll(__ballot(g0)) + __popcll(__ballot(g1)));
      const u64 be0 = __ballot(e0), be1 = __ballot(e1);
      const int r0 = __popcll(be0 & ltm), r1 = __popcll(be0) + __popcll(be1 & ltm);
      const u64 s0 = __ballot(v0 && (g0 || (e0 && r0 < need)));
      const u64 s1 = __ballot(v1 && (g1 || (e1 && r1 < need)));
      wlo |= s0;
      whi |= s1;
      if (l15 == qq) { mlo = s0; mhi = s1; }
    }
  }
  if (lane == 0) { sUni[wv * 2] = wlo; sUni[wv * 2 + 1] = whi; }
  __syncthreads();
  const u64 blo = sUni[0] | sUni[2] | sUni[4] | sUni[6];
  const u64 bhi = sUni[1] | sUni[3] | sUni[5] | sUni[7];

  const u16* Ks0 = (const u16*)(p->ws + OFF_KS) + (size_t)bg * S_ * 64;
  const u16* Vs0 = (const u16*)(p->ws + OFF_VST) + (size_t)bg * 64 * S_;
  const u16* Kw0 = (const u16*)(p->ws + OFF_KW) + (size_t)bg * S_ * 64;
  const u16* Vw0 = (const u16*)(p->ws + OFF_VWT) + (size_t)bg * 64 * S_;
#pragma unroll 1
  for (int hp = 0; hp < 2; ++hp) {
    int zz = 0;
    asm volatile("" : "+s"(zz));
    LOAD_Q(OFF_QROT, hp)
    RESET_STATE()
    {
      const __amdgpu_buffer_rsrc_t rK = MAKE_RSRC(Ks0 + zz), rV = MAKE_RSRC(Vs0 + zz);
      int jn = next_bit(blo, bhi, 0);
      while (jn >= 0) {
        const int j = jn;
        ISSUE_TILE(rK, rV, j, S_)
        __syncthreads();
        COMMIT_TILE()
        __syncthreads();
        jn = next_bit(blo, bhi, j + 1);
        if (bit128(wlo, whi, j)) {
          const bool sel = bit128(mlo, mhi, j);
          if (j == i) {
            auto ok = [&](int kt, int ii) { return sel && (16 * kt + 4 * lg + ii) <= qloc; };
            flash_tile<2, true>(sK, sV, qf, O, m, l, ps, ok, true, lane);
          } else {
            flash_tile<2, false>(sK, sV, qf, O, m, l, ps, nomask, sel, lane);
          }
        }
      }
    }
#pragma unroll
    for (int qt = 0; qt < 2; ++qt) {
      float s = l[qt];
      s += __shfl_xor(s, 16);
      s += __shfl_xor(s, 32);
      const float sc = NGb[ngoff + (hp * 2 + qt) * 3 + 1] / s;
#pragma unroll
      for (int dt = 0; dt < 4; ++dt) {
        float4* a = (float4*)(ACCb + (aoff + (hp * 2 + qt) * 64 + 16 * dt));
        float4 o = *a;
        o.x += O[qt][dt][0] * sc; o.y += O[qt][dt][1] * sc; o.z += O[qt][dt][2] * sc; o.w += O[qt][dt][3] * sc;
        *a = o;
      }
    }
    RESET_STATE()
    {
      const __amdgpu_buffer_rsrc_t rK = MAKE_RSRC(Kw0 + zz), rV = MAKE_RSRC(Vw0 + zz);
      const int j0 = i >= 8 ? i - 8 : 0;
      for (int j = j0; j <= i; ++j) {
        ISSUE_TILE(rK, rV, j, S_)
        __syncthreads();
        COMMIT_TILE()
        __syncthreads();
        if (j == i || j == i - 8) {
          auto ok = [&](int kt, int ii) {
            const int kp = j * 64 + 16 * kt + 4 * lg + ii;
            return kp <= tq && kp > tq - 512;
          };
          flash_tile<2, true>(sK, sV, qf, O, m, l, ps, ok, true, lane);
        } else {
          flash_tile<2, false>(sK, sV, qf, O, m, l, ps, nomask, true, lane);
        }
      }
    }
    u16* NSAb = (u16*)(p->ws + OFF_NSA);
#pragma unroll
    for (int qt = 0; qt < 2; ++qt) {
      float s = l[qt];
      s += __shfl_xor(s, 16);
      s += __shfl_xor(s, 32);
      const float sc = NGb[ngoff + (hp * 2 + qt) * 3 + 2] / s;
#pragma unroll
      for (int dt = 0; dt < 4; ++dt) {
        const float4 a = *(const float4*)(ACCb + (aoff + (hp * 2 + qt) * 64 + 16 * dt));
        uint2 o;
        o.x = pk2(a.x + O[qt][dt][0] * sc, a.y + O[qt][dt][1] * sc);
        o.y = pk2(a.z + O[qt][dt][2] * sc, a.w + O[qt][dt][3] * sc);
        *(uint2*)(NSAb + (aoff + (hp * 2 + qt) * 64 + 16 * dt)) = o;
      }
    }
  }
  __syncthreads();
}

DI void phaseE(int wv0, PP p, unsigned char* smem) {
  __shared__ int s_item;
  int* ctr = (int*)(p->ws + OFF_CTR);
  for (;;) {
    __syncthreads();
    if (my_tid(wv0) == 0) s_item = atomicAdd(ctr, 1);
    __syncthreads();
    const int item = s_item;
    if (item >= 1024 + 4096) break;
    if (item < 1024) nsa_item(wv0, p, item, smem);
    else s5_pass3(wv0, p, item - 1024, smem);
  }
}

DI void phaseF(int wv0, PP p, unsigned char* smem) {
  const u16* YS = (const u16*)(p->ws + OFF_YS);
  const u16* NSA = (const u16*)(p->ws + OFF_NSA);
  const u16* MG = (const u16*)(p->ws + OFF_MG);
  u16* MR = (u16*)(p->ws + OFF_MERGED);
  for (int id = blockIdx.x; id < 256 * 8; id += gridDim.x) {
    const int tm = id >> 3, tn = id & 7, m0 = tm * 128, n0 = tn * 128;
    f32x4 acc[4][4];
    zero_acc(acc);
    gemm_core(wv0, acc, YS + (size_t)m0 * 512, 512, (const u16*)(p->ws + OFF_WGT) + (size_t)n0 * 512, 512, 512, smem);
    epi_loop(wv0, acc, m0, n0, [&](int mt, int nt, int row0, int col, f32x4& v) {
#pragma unroll
      for (int i = 0; i < 4; ++i) MR[(size_t)(row0 + i) * 1024 + col] = f2bf(sigmoidf_(v[i]));
    });
    zero_acc(acc);
    gemm_core(wv0, acc, YS + (size_t)m0 * 512, 512, (const u16*)(p->ws + OFF_WVT) + (size_t)n0 * 512, 512, 512, smem);
    epi_loop(wv0, acc, m0, n0, [&](int mt, int nt, int row0, int col, f32x4& v) {
#pragma unroll
      for (int i = 0; i < 4; ++i) {
        const size_t o = (size_t)(row0 + i) * 1024 + col;
        const float gb = bf2f(MG[(size_t)(row0 + i) * 2048 + 1024 + col]);
        MR[o] = f2bf(gb * v[i] * bf2f(MR[o]));
      }
    });
    zero_acc(acc);
    gemm_core(wv0, acc, NSA + (size_t)m0 * 512, 512, (const u16*)(p->ws + OFF_WAT) + (size_t)n0 * 512, 512, 512, smem);
    epi_loop(wv0, acc, m0, n0, [&](int mt, int nt, int row0, int col, f32x4& v) {
#pragma unroll
      for (int i = 0; i < 4; ++i) {
        const size_t o = (size_t)(row0 + i) * 1024 + col;
        const float ga = bf2f(MG[(size_t)(row0 + i) * 2048 + col]);
        MR[o] = f2bf(ga * v[i] + bf2f(MR[o]));
      }
    });
  }
}
#define SS_PARTIAL(SSPTR, m0, tn)                                                                       \
  {                                                                                                     \
    const int _lane = my_tid(wv0) & 63, _wv = wv0;                                         \
    _Pragma("unroll") for (int mt = 0; mt < 4; ++mt) {                                                  \
      _Pragma("unroll") for (int i = 0; i < 4; ++i) {                                                   \
        float s = acc[mt][0][i] * acc[mt][0][i] + acc[mt][1][i] * acc[mt][1][i] +                       \
                  acc[mt][2][i] * acc[mt][2][i] + acc[mt][3][i] * acc[mt][3][i];                        \
        s += __shfl_xor(s, 1); s += __shfl_xor(s, 2); s += __shfl_xor(s, 4); s += __shfl_xor(s, 8);     \
        if ((_lane & 15) == 0)                                                                          \
          (SSPTR)[(size_t)((m0) + (_wv >> 1) * 64 + mt * 16 + (_lane >> 4) * 4 + i) * 16 + (tn) * 2 + (_wv & 1)] = s; \
      }                                                                                                 \
    }                                                                                                   \
  }
DI void phaseG(int wv0, PP p, unsigned char* smem) {
  const u16* MR = (const u16*)(p->ws + OFF_MERGED);
  u16* X1B = (u16*)(p->ws + OFF_X1B);
  float* SS1 = (float*)(p->ws + OFF_SS1);
  for (int id = blockIdx.x; id < 256 * 8; id += gridDim.x) {
    const int tm = id >> 3, tn = id & 7, m0 = tm * 128, n0 = tn * 128;
    f32x4 acc[4][4];
    zero_acc(acc);
    gemm_core(wv0, acc, MR + (size_t)m0 * 1024, 1024, (const u16*)(p->ws + OFF_WOT) + (size_t)n0 * 1024, 1024, 1024, smem);
    epi_loop(wv0, acc, m0, n0, [&](int mt, int nt, int row0, int col, f32x4& v) {
#pragma unroll
      for (int i = 0; i < 4; ++i) {
        const size_t o = (size_t)(row0 + i) * 1024 + col;
        const float x1 = v[i] + p->x[o];
        p->out[o] = x1;
        X1B[o] = f2bf(x1);
        v[i] = x1;
      }
    });
    SS_PARTIAL(SS1, m0, tn)
  }
}
DI void phaseH(int wv0, PP p, unsigned char* smem) {
  const u16* X1B = (const u16*)(p->ws + OFF_X1B);
  const float* SS1 = (const float*)(p->ws + OFF_SS1);
  u16* ACT = (u16*)(p->ws + OFF_ACT);
  float* sR = (float*)(smem + 73728);
  for (int id = blockIdx.x; id < 256 * 32; id += gridDim.x) {
    const int tm = id >> 5, tn = id & 31, m0 = tm * 128, n0 = tn * 128;
    if (my_tid(wv0) < 128) {
      const float4* s = (const float4*)(SS1 + (size_t)(m0 + my_tid(wv0)) * 16);
      const float4 a = s[0], b = s[1], c = s[2], d = s[3];
      const float t = a.x + a.y + a.z + a.w + b.x + b.y + b.z + b.w + c.x + c.y + c.z + c.w + d.x + d.y + d.z + d.w;
      sR[my_tid(wv0)] = rsqrtf(t * (1.f / 1024.f) + 1e-6f);
    }
    f32x4 acc[4][4];
    zero_acc(acc);
    gemm_core(wv0, acc, X1B + (size_t)m0 * 1024, 1024, (const u16*)(p->ws + OFF_WUPT) + (size_t)n0 * 1024, 1024, 1024, smem);
    epi_loop(wv0, acc, m0, n0, [&](int mt, int nt, int row0, int col, f32x4& v) {
#pragma unroll
      for (int i = 0; i < 4; ++i) {
        float a = fmaxf(v[i] * sR[row0 + i - m0], 0.f);
        ACT[(size_t)(row0 + i) * 4096 + col] = f2bf(a * a);
      }
    });
    __syncthreads();
  }
}
DI void phaseI(int wv0, PP p, unsigned char* smem) {
  const u16* ACT = (const u16*)(p->ws + OFF_ACT);
  float* SS2 = (float*)(p->ws + OFF_SS2);
  for (int id = blockIdx.x; id < 256 * 8; id += gridDim.x) {
    const int tm = id >> 3, tn = id & 7, m0 = tm * 128, n0 = tn * 128;
    f32x4 acc[4][4];
    zero_acc(acc);
    gemm_core(wv0, acc, ACT + (size_t)m0 * 4096, 4096, (const u16*)(p->ws + OFF_WDT) + (size_t)n0 * 4096, 4096, 4096, smem);
    epi_loop(wv0, acc, m0, n0, [&](int mt, int nt, int row0, int col, f32x4& v) {
#pragma unroll
      for (int i = 0; i < 4; ++i) {
        const size_t o = (size_t)(row0 + i) * 1024 + col;
        const float x2 = v[i] + p->out[o];
        p->out[o] = x2;
        v[i] = x2;
      }
    });
    SS_PARTIAL(SS2, m0, tn)
  }
}
DI void phaseJ(int wv0, PP p) {
  const int lane = my_tid(wv0) & 63, wv = wv0;
  const float* SS2 = (const float*)(p->ws + OFF_SS2);
  for (int row = blockIdx.x * 4 + wv; row < T_; row += gridDim.x * 4) {
    float t = (lane < 16) ? SS2[(size_t)row * 16 + lane] : 0.f;
    t = wave_sum(t);
    const float rinv = rsqrtf(t * (1.f / 1024.f) + 1e-6f);
    float4* xr = (float4*)(p->out + (size_t)row * 1024);
#pragma unroll
    for (int r = 0; r < 4; ++r) {
      float4 v = xr[lane + 64 * r];
      const float4 g = ((const float4*)p->g3)[lane + 64 * r];
      v.x *= rinv * g.x; v.y *= rinv * g.y; v.z *= rinv * g.z; v.w *= rinv * g.w;
      xr[lane + 64 * r] = v;
    }
  }
}

__global__ void __launch_bounds__(256, 2) mega(Params p) {
  __shared__ __attribute__((aligned(16))) unsigned char smem[SMEM_BYTES];
  const int wv0 = __builtin_amdgcn_readfirstlane((int)(threadIdx.x >> 6));
  const int lo = p.lo, hi = p.hi;
  PP kp0 = (PP)__builtin_amdgcn_kernarg_segment_ptr();
#define PH(N, CALL)                                  \
  if (lo <= N && N < hi) {                           \
    if (N > lo) cg::this_grid().sync();              \
    PP kp = kp0;                                     \
    asm volatile("" : "+s"(kp));                     \
    CALL;                                            \
  }
  PH(0, phaseA(wv0, kp, smem))
  PH(1, phaseB(wv0, kp, smem))
  PH(2, phaseC(wv0, kp, smem))
  PH(3, phaseD(wv0, kp, smem))
  PH(4, phaseE(wv0, kp, smem))
  PH(5, phaseF(wv0, kp, smem))
  PH(6, phaseG(wv0, kp, smem))
  PH(7, phaseH(wv0, kp, smem))
  PH(8, phaseI(wv0, kp, smem))
  PH(9, phaseJ(wv0, kp))
}

extern "C" void kernel_launch(void* const* d_in, const int* in_sizes, int n_in, void* d_out, int out_size, void* d_ws,
                              size_t ws_size, hipStream_t stream) {
  static int grid_blocks = 0;
  if (!grid_blocks) {
    int dev = 0, cus = 0, per_cu = 0;
    hipGetDevice(&dev);
    hipDeviceGetAttribute(&cus, hipDeviceAttributeMultiprocessorCount, dev);
    hipOccupancyMaxActiveBlocksPerMultiprocessor(&per_cu, mega, 256, 0);
    if (per_cu > 2) per_cu = 2;
    if (per_cu < 1) per_cu = 1;
    grid_blocks = cus * per_cu;
  }
  if (ws_size < WS_NEED) { fprintf(stderr, "workspace too small: %zu < %zu\n", ws_size, (size_t)WS_NEED); }
  Params p{};
  const float** f = (const float**)&p;
  for (int i = 0; i < 24; ++i) f[i] = (const float*)d_in[i];
  p.out = (float*)d_out;
  p.ws = (unsigned char*)d_ws;
#if MULTI_LAUNCH
  for (int ph = 0; ph < 10; ++ph) {
    p.lo = ph; p.hi = ph + 1;
    hipLaunchKernelGGL(mega, dim3(grid_blocks), dim3(256), 0, stream, p);
  }
#else
  p.lo = 0; p.hi = 10;
  void* args[] = {&p};
  hipError_t e = hipLaunchCooperativeKernel((void*)mega, dim3(grid_blocks), dim3(256), args, 0, stream);
  if (e != hipSuccess) fprintf(stderr, "cooperative launch failed: %s (grid %d)\n", hipGetErrorString(e), grid_blocks);
#endif
}
```

```cpp
#include <hip/hip_runtime.h>
#include <hip/hip_cooperative_groups.h>
#include <cstdio>
namespace cg = cooperative_groups;

#ifndef PROBE_MASK
#define PROBE_MASK 0
#endif

#define DI __device__ __forceinline__
typedef unsigned short u16;
typedef unsigned long long u64;
using bf16x8 = __attribute__((ext_vector_type(8))) short;
using f32x4 = __attribute__((ext_vector_type(4))) float;
using u32x4 = __attribute__((ext_vector_type(4))) unsigned;

constexpr int B_ = 4, S_ = 8192, T_ = B_ * S_;
constexpr int NT_ = 512;
constexpr int NINP = 4096;
constexpr float QSCALE = 0.125f * 1.44269504089f;

constexpr size_t MB = 1024 * 1024;
constexpr size_t OFF_WINT = 0;
constexpr size_t OFF_W1KT = OFF_WINT + (size_t)NINP * 1024 * 2;
constexpr size_t OFF_W1VT = OFF_W1KT + 256 * 2048 * 2;
constexpr size_t OFF_W2KT = OFF_W1VT + 256 * 2048 * 2;
constexpr size_t OFF_W2VT = OFF_W2KT + 256 * 256 * 2;
constexpr size_t OFF_WAT = OFF_W2VT + 256 * 256 * 2;
constexpr size_t OFF_WVT = OFF_WAT + 1024 * 512 * 2;
constexpr size_t OFF_WGT = OFF_WVT + 1024 * 512 * 2;
constexpr size_t OFF_WOT = OFF_WGT + 1024 * 512 * 2;
constexpr size_t OFF_WUPT = OFF_WOT + 1024 * 1024 * 2;
constexpr size_t OFF_WDT = OFF_WUPT + 4096 * 1024 * 2;
constexpr size_t OFF_ROPE = OFF_WDT + 4096 * 1024 * 2;
constexpr size_t OFF_CBP = OFF_ROPE + 8192 * 16 * 4;
constexpr size_t OFF_CTR = OFF_CBP + 2 * 32 * 256 * 4;
constexpr size_t OFF_SS1 = OFF_CTR + 256;
constexpr size_t OFF_SS2 = OFF_SS1 + (size_t)T_ * 16 * 4;
constexpr size_t OFF_NG = OFF_SS2 + (size_t)T_ * 16 * 4;
constexpr size_t OFF_HC = OFF_NG + (size_t)T_ * 24 * 4;
constexpr size_t OFF_KCC = OFF_HC + 2 * 4096 * 256 * 2;
constexpr size_t OFF_VCT = OFF_KCC + 8 * 512 * 64 * 2;
constexpr size_t OFF_HLOC = OFF_VCT + 8 * 512 * 64 * 2;
constexpr size_t OFF_ARENA = OFF_HLOC + (size_t)4 * 128 * 32 * 64 * 8;
constexpr size_t OFF_MG = OFF_ARENA;
constexpr size_t OFF_HN = OFF_ARENA + 128 * MB;
constexpr size_t OFF_QRAW = OFF_ARENA + 192 * MB;
constexpr size_t OFF_QROT = OFF_ARENA + 224 * MB;
constexpr size_t OFF_KCIN = OFF_ARENA + 256 * MB;
constexpr size_t OFF_VCIN = OFF_KCIN + 8 * MB;
constexpr size_t OFF_KS = OFF_VCIN + 8 * MB;
constexpr size_t OFF_VST = OFF_KS + 8 * MB;
constexpr size_t OFF_KW = OFF_VST + 8 * MB;
constexpr size_t OFF_VWT = OFF_KW + 8 * MB;
constexpr size_t OFF_U = OFF_ARENA + 304 * MB;
constexpr size_t OFF_NSA = OFF_ARENA + 336 * MB;
constexpr size_t OFF_YS = OFF_ARENA + 368 * MB;
constexpr size_t WS_NEED = OFF_ARENA + 400 * MB;
constexpr size_t OFF_ACT = OFF_ARENA;
constexpr size_t OFF_X1B = OFF_ARENA + 256 * MB;
constexpr size_t OFF_MERGED = OFF_HN;

constexpr int SMEM_BYTES = 131072 + 1024;

struct Params {
  const float *x, *g1, *w_in, *pe, *kw1, *kw2, *vw1, *vw2, *lam_re, *lam_im, *log_step, *b_re, *b_im, *c_re, *c_im, *dsk,
      *w_attn, *w_val, *w_gate, *w_out, *g2, *w_up, *w_down, *g3;
  float* out;
  unsigned char* ws;
  int lo, hi;
};

typedef const __attribute__((address_space(4))) Params* PP;

DI int my_tid(int wv0) {
  int t = wv0 * 64 + (int)__lane_id();
  asm volatile("" : "+v"(t));
  return t;
}
DI u16 f2bf(float x) { unsigned u = __float_as_uint(x); u += 0x7fffu + ((u >> 16) & 1u); return (u16)(u >> 16); }
DI float bf2f(u16 h) { return __uint_as_float(((unsigned)h) << 16); }
DI unsigned pk2(float a, float b) { return (unsigned)f2bf(a) | ((unsigned)f2bf(b) << 16); }
DI float sigmoidf_(float x) { return 1.f / (1.f + __expf(-x)); }
DI float gelu_t(float x) {
  float u = 0.7978845608f * (x + 0.044715f * x * x * x);
  float e = __expf(2.f * u);
  float th = 1.f - 2.f / (e + 1.f);
  return 0.5f * x * (1.f + th);
}
DI float wave_sum(float v) {
#pragma unroll
  for (int o = 32; o > 0; o >>= 1) v += __shfl_xor(v, o);
  return v;
}
template <class T> DI T* launder(T* p) { asm volatile("" : "+v"(p)); return p; }
DI f32x4 mfma16(bf16x8 a, bf16x8 b, f32x4 c) { return __builtin_amdgcn_mfma_f32_16x16x32_bf16(a, b, c, 0, 0, 0); }

constexpr int G_HT = 128 * 64;
DI int lds_byte(int r, int c) {
  const int st = (r >> 4) * 2 + (c >> 5), rr = r & 15, cc = c & 31, ob = rr * 64 + cc * 2;
  return st * 1024 + (ob ^ (((ob >> 9) & 1) << 5));
}
DI void stage_rc(int b, int& R, int& C) {
  const int st = b / 1024, sb = b % 1024, swz = sb ^ (((sb >> 9) & 1) << 5);
  R = (st >> 1) * 16 + swz / 64;
  C = (st & 1) * 32 + (swz % 64) / 2;
}
typedef __attribute__((address_space(3))) unsigned* lds_u32p;
DI void gemm256(int wv0, f32x4 (&acc)[2][2][4][2], const u16* __restrict__ A, int lda, const u16* __restrict__ Bt, int ldb,
                int K, unsigned char* smem) {
  u16* shm = (u16*)smem;
  const int tid = my_tid(wv0), lane = tid & 63;
  const int wr = wv0 >> 2, wc = wv0 & 3, fr = lane & 15, fq = lane >> 4;
#define SA(b, h) (shm + ((b)*2 + (h)) * G_HT)
#define SB(b, h) (shm + (4 + (b)*2 + (h)) * G_HT)
  int sr0, sc0, sr1, sc1;
  stage_rc(tid * 16, sr0, sc0);
  stage_rc(tid * 16 + 8192, sr1, sc1);
  const u16* a0 = A + (size_t)sr0 * lda + sc0;
  const u16* a1 = A + (size_t)sr1 * lda + sc1;
  const u16* b0 = Bt + (size_t)sr0 * ldb + sc0;
  const u16* b1 = Bt + (size_t)sr1 * ldb + sc1;
#define STAGE_A(P, half, kt)                                                                                              \
  {                                                                                                                       \
    __builtin_amdgcn_global_load_lds((const unsigned*)(a0 + (size_t)((half)*128) * lda + (kt)*64),                        \
                                     (unsigned*)((char*)(P) + tid * 16), 16, 0, 0);                               \
    __builtin_amdgcn_global_load_lds((const unsigned*)(a1 + (size_t)((half)*128) * lda + (kt)*64),                        \
                                     (unsigned*)((char*)(P) + tid * 16 + 8192), 16, 0, 0);                        \
  }
#define STAGE_B(P, half, kt)                                                                                              \
  {                                                                                                                       \
    __builtin_amdgcn_global_load_lds((const unsigned*)(b0 + (size_t)((half)*128) * ldb + (kt)*64),                        \
                                     (unsigned*)((char*)(P) + tid * 16), 16, 0, 0);                               \
    __builtin_amdgcn_global_load_lds((const unsigned*)(b1 + (size_t)((half)*128) * ldb + (kt)*64),                        \
                                     (unsigned*)((char*)(P) + tid * 16 + 8192), 16, 0, 0);                        \
  }
#define LDA(dst, b, h)                                                                                                    \
  _Pragma("unroll") for (int m = 0; m < 4; ++m) _Pragma("unroll") for (int k = 0; k < 2; ++k)                             \
      dst[m][k] = *(const bf16x8*)((const unsigned char*)SA(b, h) + lds_byte(wr * 64 + m * 16 + fr, k * 32 + fq * 8));
#define LDB(dst, b, h)                                                                                                    \
  _Pragma("unroll") for (int n = 0; n < 2; ++n) _Pragma("unroll") for (int k = 0; k < 2; ++k)                             \
      dst[n][k] = *(const bf16x8*)((const unsigned char*)SB(b, h) + lds_byte(wc * 32 + n * 16 + fr, k * 32 + fq * 8));
#define MMA(ai, bj, At_, Bt_)                                                                                             \
  {                                                                                                                       \
    __builtin_amdgcn_s_setprio(1);                                                                                        \
    _Pragma("unroll") for (int m = 0; m < 4; ++m) _Pragma("unroll") for (int n = 0; n < 2; ++n)                           \
        _Pragma("unroll") for (int k = 0; k < 2; ++k) acc[ai][bj][m][n] =                                                 \
            __builtin_amdgcn_mfma_f32_16x16x32_bf16(At_[m][k], Bt_[n][k], acc[ai][bj][m][n], 0, 0, 0);                    \
    __builtin_amdgcn_s_setprio(0);                                                                                        \
  }
#define WAIT_V(n) asm volatile("s_waitcnt vmcnt(" #n ")" ::: "memory")
#define WAIT_L(n) asm volatile("s_waitcnt lgkmcnt(" #n ")" ::: "memory")
#define BAR __builtin_amdgcn_s_barrier()
#define SCHED __builtin_amdgcn_sched_barrier(0)
#pragma unroll
  for (int a = 0; a < 2; ++a)
#pragma unroll
    for (int b = 0; b < 2; ++b)
#pragma unroll
      for (int m = 0; m < 4; ++m)
#pragma unroll
        for (int n = 0; n < 2; ++n) acc[a][b][m][n] = f32x4{0.f, 0.f, 0.f, 0.f};
  bf16x8 At[4][2], B0[2][2], B1[2][2];
  const int nt = K / 64;
  WAIT_V(0);
  __syncthreads();
  STAGE_B(SB(0, 0), 0, 0) STAGE_A(SA(0, 0), 0, 0)
  STAGE_B(SB(0, 1), 1, 0) STAGE_A(SA(0, 1), 1, 0)
  if (wr == 1) BAR;
  WAIT_V(4); BAR;
  STAGE_B(SB(1, 0), 0, 1) STAGE_A(SA(1, 0), 0, 1) STAGE_B(SB(1, 1), 1, 1)
  WAIT_V(6); BAR;
#pragma unroll 1
  for (int t = 0; t < nt - 2; t += 2) {
    LDB(B0, 0, 0) SCHED; LDA(At, 0, 0) STAGE_A(SA(1, 1), 1, t + 1)
    WAIT_L(8); BAR; WAIT_L(0); MMA(0, 0, At, B0) BAR; SCHED;
    LDB(B1, 0, 1) STAGE_B(SB(0, 0), 0, t + 2)
    BAR; WAIT_L(0); MMA(0, 1, At, B1) BAR;
    LDA(At, 0, 1) STAGE_A(SA(0, 0), 0, t + 2)
    BAR; WAIT_L(0); MMA(1, 0, At, B0) BAR; SCHED;
    STAGE_B(SB(0, 1), 1, t + 2)
    WAIT_V(6); BAR; MMA(1, 1, At, B1) BAR;
    LDB(B0, 1, 0) SCHED; LDA(At, 1, 0) STAGE_A(SA(0, 1), 1, t + 2)
    WAIT_L(8); BAR; WAIT_L(0); MMA(0, 0, At, B0) BAR; SCHED;
    LDB(B1, 1, 1) STAGE_B(SB(1, 0), 0, t + 3)
    BAR; WAIT_L(0); MMA(0, 1, At, B1) BAR;
    LDA(At, 1, 1) STAGE_A(SA(1, 0), 0, t + 3)
    BAR; WAIT_L(0); MMA(1, 0, At, B0) BAR; SCHED;
    STAGE_B(SB(1, 1), 1, t + 3)
    WAIT_V(6); BAR; MMA(1, 1, At, B1) BAR;
  }
  {
    LDB(B0, 0, 0) LDA(At, 0, 0) STAGE_A(SA(1, 1), 1, nt - 1)
    BAR; WAIT_L(0); MMA(0, 0, At, B0) BAR;
    LDB(B1, 0, 1) BAR; WAIT_L(0); MMA(0, 1, At, B1) BAR;
    LDA(At, 0, 1) WAIT_V(4); BAR; WAIT_L(0); MMA(1, 0, At, B0) MMA(1, 1, At, B1) BAR;
  }
  {
    LDB(B0, 1, 0) LDA(At, 1, 0) WAIT_V(2); BAR; WAIT_L(0); MMA(0, 0, At, B0) BAR;
    LDB(B1, 1, 1) WAIT_V(0); BAR; WAIT_L(0); MMA(0, 1, At, B1) BAR;
    LDA(At, 1, 1) BAR; WAIT_L(0); MMA(1, 0, At, B0) MMA(1, 1, At, B1) BAR;
  }
  if (wr == 0) BAR;
}
template <class F>
DI void epi256(int wv0, f32x4 (&acc)[2][2][4][2], int brow, int bcol, F f) {
  const int lane = my_tid(wv0) & 63, wr = wv0 >> 2, wc = wv0 & 3;
#pragma unroll
  for (int ai = 0; ai < 2; ++ai)
#pragma unroll
    for (int bj = 0; bj < 2; ++bj)
#pragma unroll
      for (int m = 0; m < 4; ++m)
#pragma unroll
        for (int n = 0; n < 2; ++n) {
          const int row0 = brow + ai * 128 + wr * 64 + m * 16 + (lane >> 4) * 4;
          const int col = bcol + bj * 128 + wc * 32 + n * 16 + (lane & 15);
          f(ai, bj, m, n, row0, col, acc[ai][bj][m][n]);
        }
}

DI void phaseA(int wv0, PP p, unsigned char* smem) {
  const int tid = my_tid(wv0), lane = tid & 63;
  u16* HN = (u16*)(p->ws + OFF_HN);
  for (int row = blockIdx.x * 8 + wv0; row < T_; row += gridDim.x * 8) {
    const float4* xr = (const float4*)(p->x + (size_t)row * 1024);
    float4 v[4];
    float ss = 0.f;
#pragma unroll
    for (int r = 0; r < 4; ++r) {
      v[r] = xr[lane + 64 * r];
      ss += v[r].x * v[r].x + v[r].y * v[r].y + v[r].z * v[r].z + v[r].w * v[r].w;
    }
    ss = wave_sum(ss);
    const float rinv = rsqrtf(ss * (1.f / 1024.f) + 1e-6f);
#pragma unroll
    for (int r = 0; r < 4; ++r) {
      const float4 g = ((const float4*)p->g1)[lane + 64 * r];
      uint2 o;
      o.x = pk2(v[r].x * rinv * g.x, v[r].y * rinv * g.y);
      o.y = pk2(v[r].z * rinv * g.z, v[r].w * rinv * g.w);
      *(uint2*)(HN + (size_t)row * 1024 + (lane + 64 * r) * 4) = o;
    }
  }
  float* tile = (float*)smem;
  constexpr int NXT = 1024 + 128 + 128 + 16 + 16 + 128 * 3 + 256 + 1024 + 1024;
  for (int jt = blockIdx.x; jt < NXT + 32; jt += gridDim.x) {
    if (jt < NXT) {
      int t = jt;
      const float* src;
      u16* dst;
      int K, Nsrc, mode = 0;
      const float* scl = nullptr;
      if (t < 1024) { src = p->w_in; dst = (u16*)(p->ws + OFF_WINT); K = 1024; Nsrc = 3864; mode = 1; }
      else if ((t -= 1024) < 128) { src = p->kw1; dst = (u16*)(p->ws + OFF_W1KT); K = 2048; Nsrc = 256; }
      else if ((t -= 128) < 128) { src = p->vw1; dst = (u16*)(p->ws + OFF_W1VT); K = 2048; Nsrc = 256; }
      else if ((t -= 128) < 16) { src = p->kw2; dst = (u16*)(p->ws + OFF_W2KT); K = 256; Nsrc = 64; mode = 2; }
      else if ((t -= 16) < 16) { src = p->vw2; dst = (u16*)(p->ws + OFF_W2VT); K = 256; Nsrc = 64; mode = 2; }
      else if ((t -= 16) < 128) { src = p->w_attn; dst = (u16*)(p->ws + OFF_WAT); K = 512; Nsrc = 1024; }
      else if ((t -= 128) < 128) { src = p->w_val; dst = (u16*)(p->ws + OFF_WVT); K = 512; Nsrc = 1024; }
      else if ((t -= 128) < 128) { src = p->w_gate; dst = (u16*)(p->ws + OFF_WGT); K = 512; Nsrc = 1024; }
      else if ((t -= 128) < 256) { src = p->w_out; dst = (u16*)(p->ws + OFF_WOT); K = 1024; Nsrc = 1024; }
      else if ((t -= 256) < 1024) { src = p->w_up; dst = (u16*)(p->ws + OFF_WUPT); K = 1024; Nsrc = 4096; scl = p->g2; }
      else { t -= 1024; src = p->w_down; dst = (u16*)(p->ws + OFF_WDT); K = 4096; Nsrc = 1024; }
      const int nkt = K >> 6, tn = t / nkt, tk = t % nkt, n0 = tn * 64, k0 = tk * 64;
      const int tx = tid & 63, ty = tid >> 6;
      const int np = n0 + tx;
      int sc = np;
      if (mode == 1) {
        if (np < 1280) sc = np;
        else if (np < 1792) sc = 1304 + (np - 1280);
        else if (np < 3840) sc = 1816 + (np - 1792);
        else if (np < 3864) sc = 1280 + (np - 3840);
        else sc = -1;
      } else if (mode == 2) {
        sc = np < 64 ? np : -1;
      }
      for (int kk = ty; kk < 64; kk += 8) {
        float val = 0.f;
        if (sc >= 0) val = src[(size_t)(k0 + kk) * Nsrc + sc];
        if (scl) val *= scl[k0 + kk];
        tile[kk * 65 + tx] = val;
      }
      __syncthreads();
      {
        const int n = tid >> 3, kc = tid & 7;
        uint4 o;
        o.x = pk2(tile[(kc * 8 + 0) * 65 + n], tile[(kc * 8 + 1) * 65 + n]);
        o.y = pk2(tile[(kc * 8 + 2) * 65 + n], tile[(kc * 8 + 3) * 65 + n]);
        o.z = pk2(tile[(kc * 8 + 4) * 65 + n], tile[(kc * 8 + 5) * 65 + n]);
        o.w = pk2(tile[(kc * 8 + 6) * 65 + n], tile[(kc * 8 + 7) * 65 + n]);
        *(uint4*)(dst + (size_t)(n0 + n) * K + k0 + kc * 8) = o;
      }
      __syncthreads();
    } else {
      const int item = jt - NXT, kv = item >> 4, slice = item & 15;
      const float* w1 = kv ? p->vw1 : p->kw1;
      const int col = tid & 255, h = tid >> 8, kb = slice * 128 + h * 64;
      float s0 = 0.f, s1 = 0.f, s2 = 0.f, s3 = 0.f;
      for (int k = kb; k < kb + 64; k += 4) {
        s0 += p->pe[k] * w1[(size_t)k * 256 + col];
        s1 += p->pe[k + 1] * w1[(size_t)(k + 1) * 256 + col];
        s2 += p->pe[k + 2] * w1[(size_t)(k + 2) * 256 + col];
        s3 += p->pe[k + 3] * w1[(size_t)(k + 3) * 256 + col];
      }
      ((float*)(p->ws + OFF_CBP))[(kv * 32 + slice * 2 + h) * 256 + col] = (s0 + s1) + (s2 + s3);
    }
  }
  float* rope = (float*)(p->ws + OFF_ROPE);
  for (int i = blockIdx.x * NT_ + tid; i < S_ * 8; i += gridDim.x * NT_) {
    const int pos = i >> 3, k = i & 7;
    const float inv = powf(500000.0f, -(2.0f * (float)k) / 16.0f);
    const float ang = (float)pos * inv;
    rope[pos * 16 + k] = cosf(ang);
    rope[pos * 16 + 8 + k] = sinf(ang);
  }
  if (blockIdx.x == 0 && tid < 16) ((int*)(p->ws + OFF_CTR))[tid] = 0;
}

DI void phaseB(int wv0, PP p, unsigned char* smem) {
  const u16* HN = (const u16*)(p->ws + OFF_HN);
  const u16* WT = (const u16*)(p->ws + OFF_WINT);
  const float* rope = (const float*)(p->ws + OFF_ROPE);
  const int lane = my_tid(wv0) & 63;
  const bool ropewave = (wv0 & 1) == 0;
  for (int id = blockIdx.x; id < 128 * 16; id += gridDim.x) {
    const int pm = id >> 4, pn = id & 15, brow = pm * 256, bcol = pn * 256;
    f32x4 acc[2][2][4][2];
    gemm256(wv0, acc, HN + (size_t)brow * 1024, 1024, WT + (size_t)bcol * 1024, 1024, 1024, smem);
    if (pn < 2) {
      u16* QR = (u16*)(p->ws + OFF_QRAW);
      u16* QO = (u16*)(p->ws + OFF_QROT);
      epi256(wv0, acc, brow, bcol, [&](int ai, int bj, int m, int n, int row0, int col, f32x4& v) {
        f32x4 r = v;
        if (n == 0 && ropewave) {
          const int k = lane & 7;
#pragma unroll
          for (int i = 0; i < 4; ++i) {
            const float pr = __shfl_xor(v[i], 8);
            const int pos = (row0 + i) & (S_ - 1);
            const float c = rope[pos * 16 + k], s = rope[pos * 16 + 8 + k];
            r[i] = (lane & 8) ? (v[i] * c + pr * s) : (v[i] * c - pr * s);
          }
        }
#pragma unroll
        for (int i = 0; i < 4; ++i) {
          QR[(size_t)(row0 + i) * 512 + col] = f2bf(v[i] * QSCALE);
          QO[(size_t)(row0 + i) * 512 + col] = f2bf(r[i] * QSCALE);
        }
      });
    } else if (pn < 5) {
      epi256(wv0, acc, brow, bcol, [&](int ai, int bj, int m, int n, int row0, int col, f32x4& v) {
        const int sub = (pn - 2) * 2 + bj;
        const bool dorope = (sub == 2 || sub == 4), transposed = (sub == 3 || sub == 5);
        u16* dst = (u16*)(p->ws + OFF_KCIN + (size_t)sub * 8 * MB);
        const int c128 = col & 127, g = c128 >> 6, d = c128 & 63;
        const int b = row0 >> 13, s = row0 & (S_ - 1);
        f32x4 r = v;
        if (dorope && n == 0 && ropewave) {
          const int k = lane & 7;
#pragma unroll
          for (int i = 0; i < 4; ++i) {
            const float pr = __shfl_xor(v[i], 8);
            const float c = rope[(s + i) * 16 + k], sn = rope[(s + i) * 16 + 8 + k];
            r[i] = (lane & 8) ? (v[i] * c + pr * sn) : (v[i] * c - pr * sn);
          }
        }
        if (transposed) {
          uint2 o;
          o.x = pk2(r[0], r[1]);
          o.y = pk2(r[2], r[3]);
          *(uint2*)(dst + ((size_t)((b * 2 + g) * 64 + d)) * S_ + s) = o;
        } else {
#pragma unroll
          for (int i = 0; i < 4; ++i) dst[((size_t)(b * 2 + g) * S_ + s + i) * 64 + d] = f2bf(r[i]);
        }
      });
    } else if (pn < 7) {
      u16* U = (u16*)(p->ws + OFF_U);
      epi256(wv0, acc, brow, bcol, [&](int ai, int bj, int m, int n, int row0, int col, f32x4& v) {
#pragma unroll
        for (int i = 0; i < 4; ++i) U[(size_t)(row0 + i) * 512 + (col - 1280)] = f2bf(v[i]);
      });
    } else if (pn < 15) {
      u16* MG = (u16*)(p->ws + OFF_MG);
      epi256(wv0, acc, brow, bcol, [&](int ai, int bj, int m, int n, int row0, int col, f32x4& v) {
#pragma unroll
        for (int i = 0; i < 4; ++i) MG[(size_t)(row0 + i) * 2048 + (col - 1792)] = f2bf(sigmoidf_(v[i]));
      });
    } else {
      float* NG = (float*)(p->ws + OFF_NG);
      epi256(wv0, acc, brow, bcol, [&](int ai, int bj, int m, int n, int row0, int col, f32x4& v) {
        const int cc = col - 3840;
        if (cc < 24) {
#pragma unroll
          for (int i = 0; i < 4; ++i) NG[(size_t)(row0 + i) * 24 + cc] = sigmoidf_(v[i]);
        }
      });
    }
  }
}

struct S5c {
  float lbr, lbi;
  float br[16], bi[16];
};
DI void s5_setup(PP p, int g, int n, S5c& c) {
  const float step = expf(p->log_step[g]);
  const float lr = p->lam_re[g * 64 + n], li = p->lam_im[g * 64 + n];
  const float er = expf(lr * step);
  float sn, cs;
  sincosf(li * step, &sn, &cs);
  c.lbr = er * cs;
  c.lbi = er * sn;
  const float nr = c.lbr - 1.f, ni = c.lbi, den = lr * lr + li * li;
  const float cr = (nr * lr + ni * li) / den, ci = (ni * lr - nr * li) / den;
#pragma unroll
  for (int k = 0; k < 16; ++k) {
    const float bre = p->b_re[(g * 64 + n) * 16 + k], bim = p->b_im[(g * 64 + n) * 16 + k];
    c.br[k] = cr * bre - ci * bim;
    c.bi[k] = cr * bim + ci * bre;
  }
}
DI void s5_load_u(PP p, int b, int ch, int g, float* su, int lane) {
  const u16* U = (const u16*)(p->ws + OFF_U) + ((size_t)(b * S_ + ch * 64 + lane)) * 512 + g * 16;
  const uint4 a = *(const uint4*)U, c = *(const uint4*)(U + 8);
  float* d = su + lane * 16;
  const unsigned w[8] = {a.x, a.y, a.z, a.w, c.x, c.y, c.z, c.w};
#pragma unroll
  for (int k = 0; k < 8; ++k) {
    d[2 * k] = __uint_as_float(w[k] << 16);
    d[2 * k + 1] = __uint_as_float(w[k] & 0xffff0000u);
  }
}
DI void s5_step(const S5c& c, const float* ut, float& hr, float& hi) {
  float bur = 0.f, bui = 0.f;
#pragma unroll
  for (int k4 = 0; k4 < 4; ++k4) {
    const float4 u = *(const float4*)(ut + 4 * k4);
    bur += c.br[4 * k4] * u.x + c.br[4 * k4 + 1] * u.y + c.br[4 * k4 + 2] * u.z + c.br[4 * k4 + 3] * u.w;
    bui += c.bi[4 * k4] * u.x + c.bi[4 * k4 + 1] * u.y + c.bi[4 * k4 + 2] * u.z + c.bi[4 * k4 + 3] * u.w;
  }
  const float nr = c.lbr * hr - c.lbi * hi + bur;
  const float nim = c.lbr * hi + c.lbi * hr + bui;
  hr = nr;
  hi = nim;
}
DI void s5_pass1(int wv0, PP p, int item, unsigned char* smem) {
  const int lane = my_tid(wv0) & 63;
  const int b = item >> 9, g = (item >> 4) & 31, c8 = item & 15, ch = c8 * 8 + wv0;
  float* su = (float*)smem + wv0 * 1024;
  S5c c;
  s5_setup(p, g, lane, c);
  s5_load_u(p, b, ch, g, su, lane);
  __syncthreads();
  float hr = 0.f, hi = 0.f;
  for (int t = 0; t < 64; ++t) s5_step(c, su + t * 16, hr, hi);
  float2* HL = (float2*)(p->ws + OFF_HLOC);
  HL[((size_t)(b * 128 + ch) * 32 + g) * 64 + lane] = make_float2(hr, hi);
  __syncthreads();
}
DI void s5_carry(int wv0, PP p) {
  const int x = blockIdx.x * NT_ + my_tid(wv0);
  if (x >= 8192) return;
  const int b = x >> 11, g = (x >> 6) & 31, n = x & 63;
  const float step = expf(p->log_step[g]);
  const float lr = p->lam_re[g * 64 + n], li = p->lam_im[g * 64 + n];
  const float er = expf(64.f * lr * step);
  float sn, cs;
  sincosf(64.f * li * step, &sn, &cs);
  const float Lr = er * cs, Li = er * sn;
  float2* HL = (float2*)(p->ws + OFF_HLOC) + (size_t)b * 128 * 2048 + g * 64 + n;
  float hr = 0.f, hi = 0.f;
  for (int c0 = 0; c0 < 128; c0 += 16) {
    float2 v[16];
#pragma unroll
    for (int k = 0; k < 16; ++k) v[k] = HL[(size_t)(c0 + k) * 2048];
#pragma unroll
    for (int k = 0; k < 16; ++k) {
      HL[(size_t)(c0 + k) * 2048] = make_float2(hr, hi);
      const float nr = Lr * hr - Li * hi + v[k].x;
      const float nim = Lr * hi + Li * hr + v[k].y;
      hr = nr;
      hi = nim;
    }
  }
}
DI void s5_pass3(int wv0, PP p, int item, unsigned char* smem) {
  const int tid = my_tid(wv0), lane = tid & 63;
  const int b = item >> 9, g = (item >> 4) & 31, c8 = item & 15, ch = c8 * 8 + wv0;
  float* su = (float*)smem + wv0 * 1024;
  float* sh = (float*)smem + 8192 + wv0 * (16 * 130);
  float* sC = (float*)smem + 8192 + 8 * 16 * 130;
  S5c c;
  s5_setup(p, g, lane, c);
  s5_load_u(p, b, ch, g, su, lane);
  for (int e = tid; e < 1024; e += NT_) {
    const int cc = e >> 6, n = e & 63;
    sC[(n * 16 + cc) * 2] = p->c_re[(g * 16 + cc) * 64 + n];
    sC[(n * 16 + cc) * 2 + 1] = p->c_im[(g * 16 + cc) * 64 + n];
  }
  const float2 h0 = ((const float2*)(p->ws + OFF_HLOC))[((size_t)(b * 128 + ch) * 32 + g) * 64 + lane];
  float hr = h0.x, hi = h0.y;
  const int tt = lane >> 2, c4 = lane & 3;
  float dk[4];
#pragma unroll
  for (int k = 0; k < 4; ++k) dk[k] = p->dsk[g * 16 + c4 * 4 + k];
  u16* YS = (u16*)(p->ws + OFF_YS);
  __syncthreads();
  for (int sub = 0; sub < 4; ++sub) {
    for (int t = 0; t < 16; ++t) {
      s5_step(c, su + (sub * 16 + t) * 16, hr, hi);
      *(float2*)(sh + t * 130 + 2 * lane) = make_float2(hr, hi);
    }
    __syncthreads();
    float a0 = 0.f, a1 = 0.f, a2 = 0.f, a3 = 0.f;
    for (int n = 0; n < 64; ++n) {
      const float2 h = *(const float2*)(sh + tt * 130 + 2 * n);
      const float4 c0 = *(const float4*)(sC + (n * 16 + c4 * 4) * 2);
      const float4 c1 = *(const float4*)(sC + (n * 16 + c4 * 4) * 2 + 4);
      a0 += c0.x * h.x - c0.y * h.y;
      a1 += c0.z * h.x - c0.w * h.y;
      a2 += c1.x * h.x - c1.y * h.y;
      a3 += c1.z * h.x - c1.w * h.y;
    }
    const int t = sub * 16 + tt;
    const float4 uu = *(const float4*)(su + t * 16 + c4 * 4);
    uint2 o;
    o.x = pk2(gelu_t(a0 + dk[0] * uu.x), gelu_t(a1 + dk[1] * uu.y));
    o.y = pk2(gelu_t(a2 + dk[2] * uu.z), gelu_t(a3 + dk[3] * uu.w));
    *(uint2*)(YS + ((size_t)(b * S_ + ch * 64 + t)) * 512 + g * 16 + c4 * 4) = o;
    __syncthreads();
  }
}

DI void phaseC(int wv0, PP p, unsigned char* smem) {
  const float* cbp = (const float*)(p->ws + OFF_CBP);
  for (int id = blockIdx.x; id < 32 + 2048; id += gridDim.x) {
    if (id < 32) {
      const int kv = id >> 4, pm = id & 15, brow = pm * 256;
      const u16* A = (const u16*)(p->ws + (kv ? OFF_VCIN : OFF_KCIN)) + (size_t)brow * 1024;
      const u16* Bt = (const u16*)(p->ws + (kv ? OFF_W1VT : OFF_W1KT));
      f32x4 acc[2][2][4][2];
      gemm256(wv0, acc, A, 1024, Bt, 2048, 2048, smem);
      u16* HC = (u16*)(p->ws + OFF_HC) + (size_t)kv * 4096 * 256;
      epi256(wv0, acc, brow, 0, [&](int ai, int bj, int m, int n, int row0, int col, f32x4& v) {
        float bb = 0.f;
#pragma unroll 8
        for (int s = 0; s < 32; ++s) bb += cbp[(kv * 32 + s) * 256 + col];
#pragma unroll
        for (int i = 0; i < 4; ++i) HC[(size_t)(row0 + i) * 256 + col] = f2bf(gelu_t(v[i] + bb));
      });
    } else {
      s5_pass1(wv0, p, id - 32, smem);
    }
  }
}
DI void phaseD(int wv0, PP p, unsigned char* smem) {
  for (int id = blockIdx.x; id < 32; id += gridDim.x) {
    const int kv = id >> 4, pm = id & 15, brow = pm * 256;
    const u16* A = (const u16*)(p->ws + OFF_HC) + (size_t)kv * 4096 * 256 + (size_t)brow * 256;
    const u16* Bt = (const u16*)(p->ws + (kv ? OFF_W2VT : OFF_W2KT));
    f32x4 acc[2][2][4][2];
    gemm256(wv0, acc, A, 256, Bt, 256, 256, smem);
    u16* KCC = (u16*)(p->ws + OFF_KCC);
    u16* VCT = (u16*)(p->ws + OFF_VCT);
    epi256(wv0, acc, brow, 0, [&](int ai, int bj, int m, int n, int row0, int col, f32x4& v) {
      if (col < 64) {
        const int bg = row0 >> 9, nn = row0 & 511;
        f32x4 r = v;
        if (nn + 3 == 511) r[3] = 0.f;
        if (kv == 0) {
#pragma unroll
          for (int i = 0; i < 4; ++i) KCC[((size_t)bg * 512 + nn + i) * 64 + col] = f2bf(r[i]);
        } else {
          uint2 o;
          o.x = pk2(r[0], r[1]);
          o.y = pk2(r[2], r[3]);
          *(uint2*)(VCT + ((size_t)bg * 64 + col) * 512 + nn) = o;
        }
      }
    });
  }
  s5_carry(wv0, p);
}

DI bool bit128(u64 lo, u64 hi, int j) { return j < 64 ? ((lo >> j) & 1ull) : ((hi >> (j - 64)) & 1ull); }
DI int next_bit(u64 lo, u64 hi, int from) {
  if (from < 64) {
    const u64 x = (lo >> from) << from;
    if (x) return __ffsll((long long)x) - 1;
    from = 64;
  }
  if (from >= 128) return -1;
  const u64 y = (hi >> (from - 64)) << (from - 64);
  return y ? 63 + __ffsll((long long)y) : -1;
}

template <int MODE, bool MASKED, class MaskF>
DI void flash_tile(const u16* sK, const u16* sV, const bf16x8 (&qf)[2][2], f32x4 (&O)[2][4], float (&m)[2], float (&l)[2],
                   float (&ps)[4][4], MaskF ok, bool sel, int lane) {
  const int l15 = lane & 15, lg = lane >> 4;
  bf16x8 kf[4][2];
#pragma unroll
  for (int kt = 0; kt < 4; ++kt)
#pragma unroll
    for (int ks = 0; ks < 2; ++ks) kf[kt][ks] = *(const bf16x8*)(sK + (16 * kt + l15) * 72 + ks * 32 + lg * 8);
  if (MODE == 1) {
#pragma unroll
    for (int a = 0; a < 4; ++a)
#pragma unroll
      for (int b = 0; b < 4; ++b) ps[a][b] = 0.f;
  }
#pragma unroll
  for (int qt = 0; qt < 2; ++qt) {
    f32x4 s[4];
#pragma unroll
    for (int kt = 0; kt < 4; ++kt) {
      s[kt] = f32x4{0.f, 0.f, 0.f, 0.f};
#pragma unroll
      for (int ks = 0; ks < 2; ++ks) s[kt] = mfma16(kf[kt][ks], qf[qt][ks], s[kt]);
    }
    float mx = -1e30f;
#pragma unroll
    for (int kt = 0; kt < 4; ++kt)
#pragma unroll
      for (int i = 0; i < 4; ++i) {
        if (MASKED) s[kt][i] = ok(kt, i) ? s[kt][i] : -1e30f;
        mx = fmaxf(mx, s[kt][i]);
      }
    if (!MASKED) mx = sel ? mx : -1e30f;
    float pr[4][4];
    if (MODE == 1) {
      const float mm = m[qt], il = l[qt];
#pragma unroll
      for (int kt = 0; kt < 4; ++kt)
#pragma unroll
        for (int i = 0; i < 4; ++i) {
          const float pv = (s[kt][i] > -1e29f) ? __builtin_amdgcn_exp2f(s[kt][i] - mm) * il : 0.f;
          pr[kt][i] = pv;
          ps[kt][i] += pv;
        }
    } else {
      mx = fmaxf(mx, __shfl_xor(mx, 16));
      mx = fmaxf(mx, __shfl_xor(mx, 32));
      const float mnew = fmaxf(m[qt], mx);
      const float alpha = __builtin_amdgcn_exp2f(m[qt] - mnew);
      m[qt] = mnew;
      float rs = 0.f;
      if (MASKED) {
#pragma unroll
        for (int kt = 0; kt < 4; ++kt)
#pragma unroll
          for (int i = 0; i < 4; ++i) {
            const float pv = (s[kt][i] > -1e29f) ? __builtin_amdgcn_exp2f(s[kt][i] - mnew) : 0.f;
            pr[kt][i] = pv;
            rs += pv;
          }
      } else {
        const float me = sel ? mnew : 1e30f;
#pragma unroll
        for (int kt = 0; kt < 4; ++kt)
#pragma unroll
          for (int i = 0; i < 4; ++i) {
            const float pv = __builtin_amdgcn_exp2f(s[kt][i] - me);
            pr[kt][i] = pv;
            rs += pv;
          }
      }
      l[qt] = l[qt] * alpha + rs;
      if (MODE == 2) {
#pragma unroll
        for (int dt = 0; dt < 4; ++dt) O[qt][dt] *= alpha;
      }
    }
    if (MODE != 0) {
#pragma unroll
      for (int ks2 = 0; ks2 < 2; ++ks2) {
        union { unsigned u[4]; bf16x8 v; } pf;
        pf.u[0] = pk2(pr[2 * ks2][0], pr[2 * ks2][1]);
        pf.u[1] = pk2(pr[2 * ks2][2], pr[2 * ks2][3]);
        pf.u[2] = pk2(pr[2 * ks2 + 1][0], pr[2 * ks2 + 1][1]);
        pf.u[3] = pk2(pr[2 * ks2 + 1][2], pr[2 * ks2 + 1][3]);
#pragma unroll
        for (int dt = 0; dt < 4; ++dt) {
          union { uint2 h[2]; bf16x8 v; } vf;
          vf.h[0] = *(const uint2*)(sV + (16 * dt + l15) * 72 + 32 * ks2 + 4 * lg);
          vf.h[1] = *(const uint2*)(sV + (16 * dt + l15) * 72 + 32 * ks2 + 16 + 4 * lg);
          O[qt][dt] = mfma16(vf.v, pf.v, O[qt][dt]);
        }
      }
    }
    __builtin_amdgcn_sched_barrier(0);
  }
}

DI void nsa_item(int wv0, PP p, int item, unsigned char* smem) {
  const int tid = my_tid(wv0), lane = tid & 63, wv = wv0 & 3, hp = wv0 >> 2, l15 = lane & 15, lg = lane >> 4;
  const int i = 127 - (item >> 3), bg = item & 7, b = bg >> 1, g = bg & 1;
  u16* sK = (u16*)smem;
  u16* sV = sK + 64 * 72;
  float* sImp0 = (float*)(smem + 18432);
  float* sImp = sImp0 + hp * (64 * 132);
  u64* sUni = (u64*)(smem + 18432 + 2 * 64 * 132 * 4);
  u64* sSel = sUni + 16;
  const int t0 = i * 64, qloc = 16 * wv + l15, tq = t0 + qloc;
  const unsigned tokq = (unsigned)(b * S_ + tq);
  const float* NGb = (const float*)(p->ws + OFF_NG);
  const unsigned ngoff = tokq * 24 + g * 12 + hp * 6;
  float* ACCb = p->out;
  const unsigned aoff = tokq * 512 + g * 256 + hp * 128 + 4 * lg;
  const unsigned qoff = tokq * 512 + g * 256 + hp * 128 + lg * 8;
  const int lrow = tid >> 3, lpart = tid & 7;
  const unsigned koff = (lrow * 64 + lpart * 8) * 2, voffc = (lrow * 512 + lpart * 8) * 2, voffs = (lrow * S_ + lpart * 8) * 2;

  for (int e = tid; e < 2 * 64 * 132; e += NT_) sImp0[e] = 0.f;

  bf16x8 qf[2][2];
  f32x4 O[2][4];
  float m[2], l[2], ps[4][4];
  u32x4 pk0, pv0;
  auto nomask = [](int, int) { return true; };

#define MAKE_RSRC(PTR) __builtin_amdgcn_make_buffer_rsrc((void*)(PTR), 0, 0x7fffffff, 0x00020000)
#define BLOAD(R, VO, SO) __builtin_amdgcn_raw_buffer_load_b128((R), (int)(VO), (int)(SO), 0)
#define ISSUE_TILE(RK, RV, T, LDV)                                                   \
  {                                                                                  \
    pk0 = BLOAD(RK, koff, (T)*8192);                                                 \
    pv0 = BLOAD(RV, ((LDV) == 512) ? voffc : voffs, (T)*128);                        \
  }
#define COMMIT_TILE()                                                                \
  {                                                                                  \
    *(u32x4*)(sK + lrow * 72 + lpart * 8) = pk0;                                     \
    *(u32x4*)(sV + lrow * 72 + lpart * 8) = pv0;                                     \
  }
#define LOAD_Q(BASE)                                                                 \
  {                                                                                  \
    const u16* Q_ = (const u16*)(p->ws + (BASE));                                    \
    _Pragma("unroll") for (int qt = 0; qt < 2; ++qt)                                 \
      _Pragma("unroll") for (int ks = 0; ks < 2; ++ks)                               \
        qf[qt][ks] = *(const bf16x8*)(Q_ + (qoff + qt * 64 + ks * 32));             \
  }
#define RESET_STATE()                                                                \
  {                                                                                  \
    _Pragma("unroll") for (int qt = 0; qt < 2; ++qt) { m[qt] = -1e30f; l[qt] = 0.f; } \
    _Pragma("unroll") for (int a = 0; a < 2; ++a)                                    \
      _Pragma("unroll") for (int c = 0; c < 4; ++c) O[a][c] = f32x4{0.f, 0.f, 0.f, 0.f}; \
  }

  {
    const u16* Kc0 = (const u16*)(p->ws + OFF_KCC) + (size_t)bg * 512 * 64;
    const u16* Vc0 = (const u16*)(p->ws + OFF_VCT) + (size_t)bg * 64 * 512;
    const int nE = (4 * i + 3) < 511 ? (4 * i + 3) : 511;
    const int nkb = (nE + 63) >> 6;
    const __amdgpu_buffer_rsrc_t rK = MAKE_RSRC(Kc0), rV = MAKE_RSRC(Vc0);
    LOAD_Q(OFF_QRAW)
    RESET_STATE()
    ISSUE_TILE(rK, rV, 0, 512)
    for (int kb = 0; kb < nkb; ++kb) {
      __syncthreads();
      COMMIT_TILE()
      __syncthreads();
      if (kb + 1 < nkb) ISSUE_TILE(rK, rV, kb + 1, 512)
      auto ok = [&](int kt, int ii) { return 16 * (kb * 64 + 16 * kt + 4 * lg + ii) + 31 <= tq; };
      flash_tile<0, true>(sK, sV, qf, O, m, l, ps, ok, true, lane);
    }
#pragma unroll
    for (int qt = 0; qt < 2; ++qt) {
      float s = l[qt];
      s += __shfl_xor(s, 16);
      s += __shfl_xor(s, 32);
      l[qt] = s > 0.f ? 1.f / s : 0.f;
    }
    ISSUE_TILE(rK, rV, 0, 512)
    for (int kb = 0; kb < nkb; ++kb) {
      __syncthreads();
      COMMIT_TILE()
      __syncthreads();
      if (kb + 1 < nkb) ISSUE_TILE(rK, rV, kb + 1, 512)
      auto ok = [&](int kt, int ii) { return 16 * (kb * 64 + 16 * kt + 4 * lg + ii) + 31 <= tq; };
      flash_tile<1, true>(sK, sV, qf, O, m, l, ps, ok, true, lane);
#pragma unroll
      for (int kt = 0; kt < 4; ++kt) {
        const int j = kb * 16 + kt * 4 + lg;
        sImp[qloc * 132 + j] += ps[kt][0] + ps[kt][1] + ps[kt][2] + ps[kt][3];
      }
      __syncthreads();
#pragma unroll
      for (int kt = 0; kt < 4; ++kt) {
        const int j1 = kb * 16 + kt * 4 + lg + 1;
        if (j1 < 128) sImp[qloc * 132 + j1] += ps[kt][3];
      }
    }
#pragma unroll
    for (int qt = 0; qt < 2; ++qt) {
      const float gt = NGb[ngoff + qt * 3 + 0];
#pragma unroll
      for (int dt = 0; dt < 4; ++dt) {
        float4 o = make_float4(O[qt][dt][0] * gt, O[qt][dt][1] * gt, O[qt][dt][2] * gt, O[qt][dt][3] * gt);
        *(float4*)(ACCb + (aoff + qt * 64 + 16 * dt)) = o;
      }
    }
  }
  __syncthreads();
  u64 mlo = 0, mhi = 0, wlo = 0, whi = 0;
  if (i < 16) {
    mlo = (1ull << (i + 1)) - 1ull;
    wlo = mlo;
  } else {
    const bool v0 = lane <= i, v1 = (lane + 64) <= i;
    const bool f0 = (lane == 0) || (lane == i) || (lane == i - 1);
    const bool f1 = (lane + 64 == i) || (lane + 64 == i - 1);
    const u64 ltm = (1ull << lane) - 1ull;
    for (int qq = hp * 8; qq < hp * 8 + 8; ++qq) {
      const float* ir = sImp0 + (16 * wv + qq) * 132;
      const float i0 = ir[lane] + ir[64 * 132 + lane], i1 = ir[lane + 64] + ir[64 * 132 + lane + 64];
      const unsigned k0 = v0 ? __float_as_uint(i0 + (f0 ? 1000.f : 0.f)) : 0u;
      const unsigned k1 = v1 ? __float_as_uint(i1 + (f1 ? 1000.f : 0.f)) : 0u;
      unsigned T = 0;
      for (int bit = 30; bit >= 0; --bit) {
        const unsigned cand = T | (1u << bit);
        const int cnt = __popcll(__ballot(k0 >= cand)) + __popcll(__ballot(k1 >= cand));
        if (cnt >= 16) T = cand;
      }
      const bool g0 = k0 > T, g1 = k1 > T, e0 = k0 == T, e1 = k1 == T;
      const int need = 16 - (__popcll(__ballot(g0)) + __popcll(__ballot(g1)));
      const u64 be0 = __ballot(e0), be1 = __ballot(e1);
      const int r0 = __popcll(be0 & ltm), r1 = __popcll(be0) + __popcll(be1 & ltm);
      const u64 s0 = __ballot(v0 && (g0 || (e0 && r0 < need)));
      const u64 s1 = __ballot(v1 && (g1 || (e1 && r1 < need)));
      wlo |= s0;
      whi |= s1;
      if (lane == 0) { sSel[(16 * wv + qq) * 2] = s0; sSel[(16 * wv + qq) * 2 + 1] = s1; }
    }
  }
  if (lane == 0) { sUni[wv0 * 2] = wlo; sUni[wv0 * 2 + 1] = whi; }
  __syncthreads();
  if (i >= 16) { mlo = sSel[qloc * 2]; mhi = sSel[qloc * 2 + 1]; }
  wlo = sUni[wv * 2] | sUni[(wv + 4) * 2];
  whi = sUni[wv * 2 + 1] | sUni[(wv + 4) * 2 + 1];
  const u64 blo = sUni[0] | sUni[2] | sUni[4] | sUni[6] | sUni[8] | sUni[10] | sUni[12] | sUni[14];
  const u64 bhi = sUni[1] | sUni[3] | sUni[5] | sUni[7] | sUni[9] | sUni[11] | sUni[13] | sUni[15];

  LOAD_Q(OFF_QROT)
  RESET_STATE()
  {
    const __amdgpu_buffer_rsrc_t rK = MAKE_RSRC((const u16*)(p->ws + OFF_KS) + (size_t)bg * S_ * 64);
    const __amdgpu_buffer_rsrc_t rV = MAKE_RSRC((const u16*)(p->ws + OFF_VST) + (size_t)bg * 64 * S_);
    int jn = next_bit(blo, bhi, 0);
    if (jn >= 0) ISSUE_TILE(rK, rV, jn, S_)
    while (jn >= 0) {
      const int j = jn;
      __syncthreads();
      COMMIT_TILE()
      __syncthreads();
      jn = next_bit(blo, bhi, j + 1);
      if (jn >= 0) ISSUE_TILE(rK, rV, jn, S_)
      if (bit128(wlo, whi, j)) {
        const bool sel = bit128(mlo, mhi, j);
        if (j == i) {
          auto ok = [&](int kt, int ii) { return sel && (16 * kt + 4 * lg + ii) <= qloc; };
          flash_tile<2, true>(sK, sV, qf, O, m, l, ps, ok, true, lane);
        } else {
          flash_tile<2, false>(sK, sV, qf, O, m, l, ps, nomask, sel, lane);
        }
      }
    }
  }
#pragma unroll
  for (int qt = 0; qt < 2; ++qt) {
    float s = l[qt];
    s += __shfl_xor(s, 16);
    s += __shfl_xor(s, 32);
    const float sc = NGb[ngoff + qt * 3 + 1] / s;
#pragma unroll
    for (int dt = 0; dt < 4; ++dt) {
      float4* a = (float4*)(ACCb + (aoff + qt * 64 + 16 * dt));
      float4 o = *a;
      o.x += O[qt][dt][0] * sc; o.y += O[qt][dt][1] * sc; o.z += O[qt][dt][2] * sc; o.w += O[qt][dt][3] * sc;
      *a = o;
    }
  }
  RESET_STATE()
  {
    const __amdgpu_buffer_rsrc_t rK = MAKE_RSRC((const u16*)(p->ws + OFF_KW) + (size_t)bg * S_ * 64);
    const __amdgpu_buffer_rsrc_t rV = MAKE_RSRC((const u16*)(p->ws + OFF_VWT) + (size_t)bg * 64 * S_);
    const int j0 = i >= 8 ? i - 8 : 0;
    ISSUE_TILE(rK, rV, j0, S_)
    for (int j = j0; j <= i; ++j) {
      __syncthreads();
      COMMIT_TILE()
      __syncthreads();
      if (j + 1 <= i) ISSUE_TILE(rK, rV, j + 1, S_)
      if (j == i || j == i - 8) {
        auto ok = [&](int kt, int ii) {
          const int kp = j * 64 + 16 * kt + 4 * lg + ii;
          return kp <= tq && kp > tq - 512;
        };
        flash_tile<2, true>(sK, sV, qf, O, m, l, ps, ok, true, lane);
      } else {
        flash_tile<2, false>(sK, sV, qf, O, m, l, ps, nomask, true, lane);
      }
    }
  }
  u16* NSAb = (u16*)(p->ws + OFF_NSA);
#pragma unroll
  for (int qt = 0; qt < 2; ++qt) {
    float s = l[qt];
    s += __shfl_xor(s, 16);
    s += __shfl_xor(s, 32);
    const float sc = NGb[ngoff + qt * 3 + 2] / s;
#pragma unroll
    for (int dt = 0; dt < 4; ++dt) {
      const float4 a = *(const float4*)(ACCb + (aoff + qt * 64 + 16 * dt));
      uint2 o;
      o.x = pk2(a.x + O[qt][dt][0] * sc, a.y + O[qt][dt][1] * sc);
      o.y = pk2(a.z + O[qt][dt][2] * sc, a.w + O[qt][dt][3] * sc);
      *(uint2*)(NSAb + (aoff + qt * 64 + 16 * dt)) = o;
    }
  }
  __syncthreads();
}

DI void phaseE(int wv0, PP p, unsigned char* smem, int cidx) {
  __shared__ int s_item;
  int* ctr = (int*)(p->ws + OFF_CTR) + cidx;
  for (;;) {
    __syncthreads();
    if (my_tid(wv0) == 0) s_item = atomicAdd(ctr, 1);
    __syncthreads();
    const int item = s_item;
    if (item >= 1024 + 2048) break;
    if (item < 1024) nsa_item(wv0, p, item, smem);
    else s5_pass3(wv0, p, item - 1024, smem);
  }
}

DI void phaseF(int wv0, PP p, unsigned char* smem) {
  const u16* YS = (const u16*)(p->ws + OFF_YS);
  const u16* NSA = (const u16*)(p->ws + OFF_NSA);
  const u16* MG = (const u16*)(p->ws + OFF_MG);
  u16* MR = (u16*)(p->ws + OFF_MERGED);
  for (int id = blockIdx.x; id < 128 * 4; id += gridDim.x) {
    const int pm = id >> 2, pn = id & 3, brow = pm * 256, bcol = pn * 256;
    f32x4 acc[2][2][4][2];
    gemm256(wv0, acc, YS + (size_t)brow * 512, 512, (const u16*)(p->ws + OFF_WGT) + (size_t)bcol * 512, 512, 512, smem);
    epi256(wv0, acc, brow, bcol, [&](int ai, int bj, int m, int n, int row0, int col, f32x4& v) {
#pragma unroll
      for (int i = 0; i < 4; ++i) MR[(size_t)(row0 + i) * 1024 + col] = f2bf(sigmoidf_(v[i]));
    });
    gemm256(wv0, acc, YS + (size_t)brow * 512, 512, (const u16*)(p->ws + OFF_WVT) + (size_t)bcol * 512, 512, 512, smem);
    epi256(wv0, acc, brow, bcol, [&](int ai, int bj, int m, int n, int row0, int col, f32x4& v) {
#pragma unroll
      for (int i = 0; i < 4; ++i) {
        const size_t o = (size_t)(row0 + i) * 1024 + col;
        const float gb = bf2f(MG[(size_t)(row0 + i) * 2048 + 1024 + col]);
        MR[o] = f2bf(gb * v[i] * bf2f(MR[o]));
      }
    });
    gemm256(wv0, acc, NSA + (size_t)brow * 512, 512, (const u16*)(p->ws + OFF_WAT) + (size_t)bcol * 512, 512, 512, smem);
    epi256(wv0, acc, brow, bcol, [&](int ai, int bj, int m, int n, int row0, int col, f32x4& v) {
#pragma unroll
      for (int i = 0; i < 4; ++i) {
        const size_t o = (size_t)(row0 + i) * 1024 + col;
        const float ga = bf2f(MG[(size_t)(row0 + i) * 2048 + col]);
        MR[o] = f2bf(ga * v[i] + bf2f(MR[o]));
      }
    });
  }
}
DI void ss_partial(int wv0, f32x4 (&acc)[2][2][4][2], float* SS, int brow, int pn) {
  const int lane = my_tid(wv0) & 63, wr = wv0 >> 2, wc = wv0 & 3;
#pragma unroll
  for (int ai = 0; ai < 2; ++ai)
#pragma unroll
    for (int m = 0; m < 4; ++m)
#pragma unroll
      for (int i = 0; i < 4; ++i) {
        float s = acc[ai][0][m][0][i] * acc[ai][0][m][0][i] + acc[ai][0][m][1][i] * acc[ai][0][m][1][i] +
                  acc[ai][1][m][0][i] * acc[ai][1][m][0][i] + acc[ai][1][m][1][i] * acc[ai][1][m][1][i];
        s += __shfl_xor(s, 1);
        s += __shfl_xor(s, 2);
        s += __shfl_xor(s, 4);
        s += __shfl_xor(s, 8);
        if ((lane & 15) == 0) SS[(size_t)(brow + ai * 128 + wr * 64 + m * 16 + (lane >> 4) * 4 + i) * 16 + pn * 4 + wc] = s;
      }
}
DI void phaseG(int wv0, PP p, unsigned char* smem) {
  const u16* MR = (const u16*)(p->ws + OFF_MERGED);
  u16* X1B = (u16*)(p->ws + OFF_X1B);
  float* SS1 = (float*)(p->ws + OFF_SS1);
  for (int id = blockIdx.x; id < 128 * 4; id += gridDim.x) {
    const int pm = id >> 2, pn = id & 3, brow = pm * 256, bcol = pn * 256;
    f32x4 acc[2][2][4][2];
    gemm256(wv0, acc, MR + (size_t)brow * 1024, 1024, (const u16*)(p->ws + OFF_WOT) + (size_t)bcol * 1024, 1024, 1024, smem);
    epi256(wv0, acc, brow, bcol, [&](int ai, int bj, int m, int n, int row0, int col, f32x4& v) {
#pragma unroll
      for (int i = 0; i < 4; ++i) {
        const size_t o = (size_t)(row0 + i) * 1024 + col;
        const float x1 = v[i] + p->x[o];
        p->out[o] = x1;
        X1B[o] = f2bf(x1);
        v[i] = x1;
      }
    });
    ss_partial(wv0, acc, SS1, brow, pn);
  }
}
DI void phaseH(int wv0, PP p, unsigned char* smem) {
  const u16* X1B = (const u16*)(p->ws + OFF_X1B);
  const float* SS1 = (const float*)(p->ws + OFF_SS1);
  u16* ACT = (u16*)(p->ws + OFF_ACT);
  float* sR = (float*)(smem + 131072);
  for (int id = blockIdx.x; id < 128 * 16; id += gridDim.x) {
    const int pm = id >> 4, pn = id & 15, brow = pm * 256, bcol = pn * 256;
    const int tid = my_tid(wv0);
    if (tid < 256) {
      const float4* s = (const float4*)(SS1 + (size_t)(brow + tid) * 16);
      const float4 a = s[0], b = s[1], c = s[2], d = s[3];
      const float t = a.x + a.y + a.z + a.w + b.x + b.y + b.z + b.w + c.x + c.y + c.z + c.w + d.x + d.y + d.z + d.w;
      sR[tid] = rsqrtf(t * (1.f / 1024.f) + 1e-6f);
    }
    f32x4 acc[2][2][4][2];
    gemm256(wv0, acc, X1B + (size_t)brow * 1024, 1024, (const u16*)(p->ws + OFF_WUPT) + (size_t)bcol * 1024, 1024, 1024, smem);
    epi256(wv0, acc, brow, bcol, [&](int ai, int bj, int m, int n, int row0, int col, f32x4& v) {
#pragma unroll
      for (int i = 0; i < 4; ++i) {
        float a = fmaxf(v[i] * sR[row0 + i - brow], 0.f);
        ACT[(size_t)(row0 + i) * 4096 + col] = f2bf(a * a);
      }
    });
    __syncthreads();
  }
}
DI void phaseI(int wv0, PP p, unsigned char* smem) {
  const u16* ACT = (const u16*)(p->ws + OFF_ACT);
  float* SS2 = (float*)(p->ws + OFF_SS2);
  for (int id = blockIdx.x; id < 128 * 4; id += gridDim.x) {
    const int pm = id >> 2, pn = id & 3, brow = pm * 256, bcol = pn * 256;
    f32x4 acc[2][2][4][2];
    gemm256(wv0, acc, ACT + (size_t)brow * 4096, 4096, (const u16*)(p->ws + OFF_WDT) + (size_t)bcol * 4096, 4096, 4096, smem);
    epi256(wv0, acc, brow, bcol, [&](int ai, int bj, int m, int n, int row0, int col, f32x4& v) {
#pragma unroll
      for (int i = 0; i < 4; ++i) {
        const size_t o = (size_t)(row0 + i) * 1024 + col;
        const float x2 = v[i] + p->out[o];
        p->out[o] = x2;
        v[i] = x2;
      }
    });
    ss_partial(wv0, acc, SS2, brow, pn);
  }
}
DI void phaseJ(int wv0, PP p) {
  const int lane = my_tid(wv0) & 63;
  const float* SS2 = (const float*)(p->ws + OFF_SS2);
  for (int row = blockIdx.x * 8 + wv0; row < T_; row += gridDim.x * 8) {
    float t = (lane < 16) ? SS2[(size_t)row * 16 + lane] : 0.f;
    t = wave_sum(t);
    const float rinv = rsqrtf(t * (1.f / 1024.f) + 1e-6f);
    float4* xr = (float4*)(p->out + (size_t)row * 1024);
#pragma unroll
    for (int r = 0; r < 4; ++r) {
      float4 v = xr[lane + 64 * r];
      const float4 g = ((const float4*)p->g3)[lane + 64 * r];
      v.x *= rinv * g.x; v.y *= rinv * g.y; v.z *= rinv * g.z; v.w *= rinv * g.w;
      xr[lane + 64 * r] = v;
    }
  }
}

__global__ void __launch_bounds__(512, 2) mega(Params p) {
  extern __shared__ __attribute__((aligned(16))) unsigned char smem[];
  const int wv0 = __builtin_amdgcn_readfirstlane((int)(threadIdx.x >> 6));
  const int lo = p.lo, hi = p.hi;
  PP kp0 = (PP)__builtin_amdgcn_kernarg_segment_ptr();
#define PH(N, CALL)                                  \
  if (lo <= N && N < hi) {                           \
    if (N > lo) cg::this_grid().sync();              \
    PP kp = kp0;                                     \
    asm volatile("" : "+s"(kp));                     \
    CALL;                                            \
    if ((PROBE_MASK >> N) & 1) { CALL; }             \
  }
  PH(0, phaseA(wv0, kp, smem))
  PH(1, phaseB(wv0, kp, smem))
  PH(2, phaseC(wv0, kp, smem))
  PH(3, phaseD(wv0, kp, smem))
  PH(4, phaseE(wv0, kp, smem, 0))
  if ((PROBE_MASK >> 10) & 1) { PP kp = kp0; asm volatile("" : "+s"(kp)); phaseE(wv0, kp, smem, 1); }
  PH(5, phaseF(wv0, kp, smem))
  PH(6, phaseG(wv0, kp, smem))
  PH(7, phaseH(wv0, kp, smem))
  PH(8, phaseI(wv0, kp, smem))
  PH(9, phaseJ(wv0, kp))
}

extern "C" void kernel_launch(void* const* d_in, const int* in_sizes, int n_in, void* d_out, int out_size, void* d_ws,
                              size_t ws_size, hipStream_t stream) {
  static int grid_blocks = 0;
  if (!grid_blocks) {
    int dev = 0, cus = 0, per_cu = 0;
    (void)hipGetDevice(&dev);
    (void)hipDeviceGetAttribute(&cus, hipDeviceAttributeMultiprocessorCount, dev);
    (void)hipFuncSetAttribute((const void*)mega, hipFuncAttributeMaxDynamicSharedMemorySize, SMEM_BYTES);
    (void)hipOccupancyMaxActiveBlocksPerMultiprocessor(&per_cu, mega, NT_, SMEM_BYTES);
    if (per_cu > 1) per_cu = 1;
    if (per_cu < 1) per_cu = 1;
    grid_blocks = cus * per_cu;
  }
  if (ws_size < WS_NEED) { fprintf(stderr, "workspace too small: %zu < %zu\n", ws_size, (size_t)WS_NEED); }
  Params p{};
  const float** f = (const float**)&p;
  for (int i = 0; i < 24; ++i) f[i] = (const float*)d_in[i];
  p.out = (float*)d_out;
  p.ws = (unsigned char*)d_ws;
  p.lo = 0; p.hi = 10;
  void* args[] = {&p};
  hipError_t e = hipLaunchCooperativeKernel((void*)mega, dim3(grid_blocks), dim3(NT_), args, SMEM_BYTES, stream);
  if (e != hipSuccess) fprintf(stderr, "cooperative launch failed: %s (grid %d)\n", hipGetErrorString(e), grid_blocks);
}
```

```cpp
#include <hip/hip_runtime.h>
#include <hip/hip_cooperative_groups.h>
#include <cstdio>
namespace cg = cooperative_groups;

#ifndef PROBE_MASK
#define PROBE_MASK 0
#endif

#define DI __device__ __forceinline__
typedef unsigned short u16;
typedef unsigned long long u64;
using bf16x8 = __attribute__((ext_vector_type(8))) short;
using f32x4 = __attribute__((ext_vector_type(4))) float;
using u32x4 = __attribute__((ext_vector_type(4))) unsigned;

constexpr int B_ = 4, S_ = 8192, T_ = B_ * S_;
constexpr int NT_ = 512;
constexpr int NINP = 4096;
constexpr float QSCALE = 0.125f * 1.44269504089f;

constexpr size_t MB = 1024 * 1024;
constexpr size_t OFF_WINT = 0;
constexpr size_t OFF_W1KT = OFF_WINT + (size_t)NINP * 1024 * 2;
constexpr size_t OFF_W1VT = OFF_W1KT + 256 * 2048 * 2;
constexpr size_t OFF_W2KT = OFF_W1VT + 256 * 2048 * 2;
constexpr size_t OFF_W2VT = OFF_W2KT + 256 * 256 * 2;
constexpr size_t OFF_WAT = OFF_W2VT + 256 * 256 * 2;
constexpr size_t OFF_WVT = OFF_WAT + 1024 * 512 * 2;
constexpr size_t OFF_WGT = OFF_WVT + 1024 * 512 * 2;
constexpr size_t OFF_WOT = OFF_WGT + 1024 * 512 * 2;
constexpr size_t OFF_WUPT = OFF_WOT + 1024 * 1024 * 2;
constexpr size_t OFF_WDT = OFF_WUPT + 4096 * 1024 * 2;
constexpr size_t OFF_ROPE = OFF_WDT + 4096 * 1024 * 2;
constexpr size_t OFF_CBP = OFF_ROPE + 8192 * 16 * 4;
constexpr size_t OFF_CTR = OFF_CBP + 2 * 32 * 256 * 4;
constexpr size_t OFF_KMAX = OFF_CTR + 64;
constexpr size_t OFF_SS1 = OFF_CTR + 256;
constexpr size_t OFF_SS2 = OFF_SS1 + (size_t)T_ * 16 * 4;
constexpr size_t OFF_NG = OFF_SS2 + (size_t)T_ * 16 * 4;
constexpr size_t OFF_HC = OFF_NG + (size_t)T_ * 24 * 4;
constexpr size_t OFF_KCC = OFF_HC + 2 * 4096 * 256 * 2;
constexpr size_t OFF_VCT = OFF_KCC + 8 * 512 * 64 * 2;
constexpr size_t OFF_HLOC = OFF_VCT + 8 * 512 * 64 * 2;
constexpr size_t OFF_ARENA = OFF_HLOC + (size_t)4 * 128 * 32 * 64 * 8;
constexpr size_t OFF_MG = OFF_ARENA;
constexpr size_t OFF_HN = OFF_ARENA + 128 * MB;
constexpr size_t OFF_QRAW = OFF_ARENA + 192 * MB;
constexpr size_t OFF_QROT = OFF_ARENA + 224 * MB;
constexpr size_t OFF_KCIN = OFF_ARENA + 256 * MB;
constexpr size_t OFF_VCIN = OFF_KCIN + 8 * MB;
constexpr size_t OFF_KS = OFF_VCIN + 8 * MB;
constexpr size_t OFF_VST = OFF_KS + 8 * MB;
constexpr size_t OFF_KW = OFF_VST + 8 * MB;
constexpr size_t OFF_VWT = OFF_KW + 8 * MB;
constexpr size_t OFF_U = OFF_ARENA + 304 * MB;
constexpr size_t OFF_NSA = OFF_ARENA + 336 * MB;
constexpr size_t OFF_YS = OFF_ARENA + 368 * MB;
constexpr size_t WS_NEED = OFF_ARENA + 400 * MB;
constexpr size_t OFF_ACT = OFF_ARENA;
constexpr size_t OFF_X1B = OFF_ARENA + 256 * MB;
constexpr size_t OFF_MERGED = OFF_HN;

constexpr int SMEM_BYTES = 131072 + 1024;

struct Params {
  const float *x, *g1, *w_in, *pe, *kw1, *kw2, *vw1, *vw2, *lam_re, *lam_im, *log_step, *b_re, *b_im, *c_re, *c_im, *dsk,
      *w_attn, *w_val, *w_gate, *w_out, *g2, *w_up, *w_down, *g3;
  float* out;
  unsigned char* ws;
  int lo, hi;
};

typedef const __attribute__((address_space(4))) Params* PP;

DI int my_tid(int wv0) {
  int t = wv0 * 64 + (int)__lane_id();
  asm volatile("" : "+v"(t));
  return t;
}
DI u16 f2bf(float x) { unsigned u = __float_as_uint(x); u += 0x7fffu + ((u >> 16) & 1u); return (u16)(u >> 16); }
DI float bf2f(u16 h) { return __uint_as_float(((unsigned)h) << 16); }
DI unsigned pk2(float a, float b) { return (unsigned)f2bf(a) | ((unsigned)f2bf(b) << 16); }
DI float sigmoidf_(float x) { return 1.f / (1.f + __expf(-x)); }
DI float gelu_t(float x) {
  float u = 0.7978845608f * (x + 0.044715f * x * x * x);
  float e = __expf(2.f * u);
  float th = 1.f - 2.f / (e + 1.f);
  return 0.5f * x * (1.f + th);
}
DI float wave_sum(float v) {
#pragma unroll
  for (int o = 32; o > 0; o >>= 1) v += __shfl_xor(v, o);
  return v;
}
template <class T> DI T* launder(T* p) { asm volatile("" : "+v"(p)); return p; }
DI f32x4 mfma16(bf16x8 a, bf16x8 b, f32x4 c) { return __builtin_amdgcn_mfma_f32_16x16x32_bf16(a, b, c, 0, 0, 0); }

constexpr int G_HT = 128 * 64;
DI int lds_byte(int r, int c) {
  const int st = (r >> 4) * 2 + (c >> 5), rr = r & 15, cc = c & 31, ob = rr * 64 + cc * 2;
  return st * 1024 + (ob ^ (((ob >> 9) & 1) << 5));
}
DI void stage_rc(int b, int& R, int& C) {
  const int st = b / 1024, sb = b % 1024, swz = sb ^ (((sb >> 9) & 1) << 5);
  R = (st >> 1) * 16 + swz / 64;
  C = (st & 1) * 32 + (swz % 64) / 2;
}
typedef __attribute__((address_space(3))) unsigned* lds_u32p;
DI void gemm256(int wv0, f32x4 (&acc)[2][2][4][2], const u16* __restrict__ A, int lda, const u16* __restrict__ Bt, int ldb,
                int K, unsigned char* smem) {
  u16* shm = (u16*)smem;
  const int tid = my_tid(wv0), lane = tid & 63;
  const int wr = wv0 >> 2, wc = wv0 & 3, fr = lane & 15, fq = lane >> 4;
#define SA(b, h) (shm + ((b)*2 + (h)) * G_HT)
#define SB(b, h) (shm + (4 + (b)*2 + (h)) * G_HT)
  int sr0, sc0, sr1, sc1;
  stage_rc(tid * 16, sr0, sc0);
  stage_rc(tid * 16 + 8192, sr1, sc1);
  const u16* a0 = A + (size_t)sr0 * lda + sc0;
  const u16* a1 = A + (size_t)sr1 * lda + sc1;
  const u16* b0 = Bt + (size_t)sr0 * ldb + sc0;
  const u16* b1 = Bt + (size_t)sr1 * ldb + sc1;
#define STAGE_A(P, half, kt)                                                                                              \
  {                                                                                                                       \
    __builtin_amdgcn_global_load_lds((const unsigned*)(a0 + (size_t)((half)*128) * lda + (kt)*64),                        \
                                     (unsigned*)((char*)(P) + tid * 16), 16, 0, 0);                               \
    __builtin_amdgcn_global_load_lds((const unsigned*)(a1 + (size_t)((half)*128) * lda + (kt)*64),                        \
                                     (unsigned*)((char*)(P) + tid * 16 + 8192), 16, 0, 0);                        \
  }
#define STAGE_B(P, half, kt)                                                                                              \
  {                                                                                                                       \
    __builtin_amdgcn_global_load_lds((const unsigned*)(b0 + (size_t)((half)*128) * ldb + (kt)*64),                        \
                                     (unsigned*)((char*)(P) + tid * 16), 16, 0, 0);                               \
    __builtin_amdgcn_global_load_lds((const unsigned*)(b1 + (size_t)((half)*128) * ldb + (kt)*64),                        \
                                     (unsigned*)((char*)(P) + tid * 16 + 8192), 16, 0, 0);                        \
  }
#define LDA(dst, b, h)                                                                                                    \
  _Pragma("unroll") for (int m = 0; m < 4; ++m) _Pragma("unroll") for (int k = 0; k < 2; ++k)                             \
      dst[m][k] = *(const bf16x8*)((const unsigned char*)SA(b, h) + lds_byte(wr * 64 + m * 16 + fr, k * 32 + fq * 8));
#define LDB(dst, b, h)                                                                                                    \
  _Pragma("unroll") for (int n = 0; n < 2; ++n) _Pragma("unroll") for (int k = 0; k < 2; ++k)                             \
      dst[n][k] = *(const bf16x8*)((const unsigned char*)SB(b, h) + lds_byte(wc * 32 + n * 16 + fr, k * 32 + fq * 8));
#define MMA(ai, bj, At_, Bt_)                                                                                             \
  {                                                                                                                       \
    __builtin_amdgcn_s_setprio(1);                                                                                        \
    _Pragma("unroll") for (int m = 0; m < 4; ++m) _Pragma("unroll") for (int n = 0; n < 2; ++n)                           \
        _Pragma("unroll") for (int k = 0; k < 2; ++k) acc[ai][bj][m][n] =                                                 \
            __builtin_amdgcn_mfma_f32_16x16x32_bf16(At_[m][k], Bt_[n][k], acc[ai][bj][m][n], 0, 0, 0);                    \
    __builtin_amdgcn_s_setprio(0);                                                                                        \
  }
#define WAIT_V(n) asm volatile("s_waitcnt vmcnt(" #n ")" ::: "memory")
#define WAIT_L(n) asm volatile("s_waitcnt lgkmcnt(" #n ")" ::: "memory")
#define BAR __builtin_amdgcn_s_barrier()
#define SCHED __builtin_amdgcn_sched_barrier(0)
#pragma unroll
  for (int a = 0; a < 2; ++a)
#pragma unroll
    for (int b = 0; b < 2; ++b)
#pragma unroll
      for (int m = 0; m < 4; ++m)
#pragma unroll
        for (int n = 0; n < 2; ++n) acc[a][b][m][n] = f32x4{0.f, 0.f, 0.f, 0.f};
  bf16x8 At[4][2], B0[2][2], B1[2][2];
  const int nt = K / 64;
  WAIT_V(0);
  __syncthreads();
  STAGE_B(SB(0, 0), 0, 0) STAGE_A(SA(0, 0), 0, 0)
  STAGE_B(SB(0, 1), 1, 0) STAGE_A(SA(0, 1), 1, 0)
  if (wr == 1) BAR;
  WAIT_V(4); BAR;
  STAGE_B(SB(1, 0), 0, 1) STAGE_A(SA(1, 0), 0, 1) STAGE_B(SB(1, 1), 1, 1)
  WAIT_V(6); BAR;
#pragma unroll 1
  for (int t = 0; t < nt - 2; t += 2) {
    LDB(B0, 0, 0) SCHED; LDA(At, 0, 0) STAGE_A(SA(1, 1), 1, t + 1)
    WAIT_L(8); BAR; WAIT_L(0); MMA(0, 0, At, B0) BAR; SCHED;
    LDB(B1, 0, 1) STAGE_B(SB(0, 0), 0, t + 2)
    BAR; WAIT_L(0); MMA(0, 1, At, B1) BAR;
    LDA(At, 0, 1) STAGE_A(SA(0, 0), 0, t + 2)
    BAR; WAIT_L(0); MMA(1, 0, At, B0) BAR; SCHED;
    STAGE_B(SB(0, 1), 1, t + 2)
    WAIT_V(6); BAR; MMA(1, 1, At, B1) BAR;
    LDB(B0, 1, 0) SCHED; LDA(At, 1, 0) STAGE_A(SA(0, 1), 1, t + 2)
    WAIT_L(8); BAR; WAIT_L(0); MMA(0, 0, At, B0) BAR; SCHED;
    LDB(B1, 1, 1) STAGE_B(SB(1, 0), 0, t + 3)
    BAR; WAIT_L(0); MMA(0, 1, At, B1) BAR;
    LDA(At, 1, 1) STAGE_A(SA(1, 0), 0, t + 3)
    BAR; WAIT_L(0); MMA(1, 0, At, B0) BAR; SCHED;
    STAGE_B(SB(1, 1), 1, t + 3)
    WAIT_V(6); BAR; MMA(1, 1, At, B1) BAR;
  }
  {
    LDB(B0, 0, 0) LDA(At, 0, 0) STAGE_A(SA(1, 1), 1, nt - 1)
    BAR; WAIT_L(0); MMA(0, 0, At, B0) BAR;
    LDB(B1, 0, 1) BAR; WAIT_L(0); MMA(0, 1, At, B1) BAR;
    LDA(At, 0, 1) WAIT_V(4); BAR; WAIT_L(0); MMA(1, 0, At, B0) MMA(1, 1, At, B1) BAR;
  }
  {
    LDB(B0, 1, 0) LDA(At, 1, 0) WAIT_V(2); BAR; WAIT_L(0); MMA(0, 0, At, B0) BAR;
    LDB(B1, 1, 1) WAIT_V(0); BAR; WAIT_L(0); MMA(0, 1, At, B1) BAR;
    LDA(At, 1, 1) BAR; WAIT_L(0); MMA(1, 0, At, B0) MMA(1, 1, At, B1) BAR;
  }
  if (wr == 0) BAR;
}
template <class F>
DI void epi256(int wv0, f32x4 (&acc)[2][2][4][2], int brow, int bcol, F f) {
  const int lane = my_tid(wv0) & 63, wr = wv0 >> 2, wc = wv0 & 3;
#pragma unroll
  for (int ai = 0; ai < 2; ++ai)
#pragma unroll
    for (int bj = 0; bj < 2; ++bj)
#pragma unroll
      for (int m = 0; m < 4; ++m)
#pragma unroll
        for (int n = 0; n < 2; ++n) {
          const int row0 = brow + ai * 128 + wr * 64 + m * 16 + (lane >> 4) * 4;
          const int col = bcol + bj * 128 + wc * 32 + n * 16 + (lane & 15);
          f(ai, bj, m, n, row0, col, acc[ai][bj][m][n]);
        }
}

DI void phaseA(int wv0, PP p, unsigned char* smem) {
  const int tid = my_tid(wv0), lane = tid & 63;
  u16* HN = (u16*)(p->ws + OFF_HN);
  for (int row = blockIdx.x * 8 + wv0; row < T_; row += gridDim.x * 8) {
    const float4* xr = (const float4*)(p->x + (size_t)row * 1024);
    float4 v[4];
    float ss = 0.f;
#pragma unroll
    for (int r = 0; r < 4; ++r) {
      v[r] = xr[lane + 64 * r];
      ss += v[r].x * v[r].x + v[r].y * v[r].y + v[r].z * v[r].z + v[r].w * v[r].w;
    }
    ss = wave_sum(ss);
    const float rinv = rsqrtf(ss * (1.f / 1024.f) + 1e-6f);
#pragma unroll
    for (int r = 0; r < 4; ++r) {
      const float4 g = ((const float4*)p->g1)[lane + 64 * r];
      uint2 o;
      o.x = pk2(v[r].x * rinv * g.x, v[r].y * rinv * g.y);
      o.y = pk2(v[r].z * rinv * g.z, v[r].w * rinv * g.w);
      *(uint2*)(HN + (size_t)row * 1024 + (lane + 64 * r) * 4) = o;
    }
  }
  float* tile = (float*)smem;
  constexpr int NXT = 1024 + 128 + 128 + 16 + 16 + 128 * 3 + 256 + 1024 + 1024;
  for (int jt = blockIdx.x; jt < NXT + 32; jt += gridDim.x) {
    if (jt < NXT) {
      int t = jt;
      const float* src;
      u16* dst;
      int K, Nsrc, mode = 0;
      const float* scl = nullptr;
      if (t < 1024) { src = p->w_in; dst = (u16*)(p->ws + OFF_WINT); K = 1024; Nsrc = 3864; mode = 1; }
      else if ((t -= 1024) < 128) { src = p->kw1; dst = (u16*)(p->ws + OFF_W1KT); K = 2048; Nsrc = 256; }
      else if ((t -= 128) < 128) { src = p->vw1; dst = (u16*)(p->ws + OFF_W1VT); K = 2048; Nsrc = 256; }
      else if ((t -= 128) < 16) { src = p->kw2; dst = (u16*)(p->ws + OFF_W2KT); K = 256; Nsrc = 64; mode = 2; }
      else if ((t -= 16) < 16) { src = p->vw2; dst = (u16*)(p->ws + OFF_W2VT); K = 256; Nsrc = 64; mode = 2; }
      else if ((t -= 16) < 128) { src = p->w_attn; dst = (u16*)(p->ws + OFF_WAT); K = 512; Nsrc = 1024; }
      else if ((t -= 128) < 128) { src = p->w_val; dst = (u16*)(p->ws + OFF_WVT); K = 512; Nsrc = 1024; }
      else if ((t -= 128) < 128) { src = p->w_gate; dst = (u16*)(p->ws + OFF_WGT); K = 512; Nsrc = 1024; }
      else if ((t -= 128) < 256) { src = p->w_out; dst = (u16*)(p->ws + OFF_WOT); K = 1024; Nsrc = 1024; }
      else if ((t -= 256) < 1024) { src = p->w_up; dst = (u16*)(p->ws + OFF_WUPT); K = 1024; Nsrc = 4096; scl = p->g2; }
      else { t -= 1024; src = p->w_down; dst = (u16*)(p->ws + OFF_WDT); K = 4096; Nsrc = 1024; }
      const int nkt = K >> 6, tn = t / nkt, tk = t % nkt, n0 = tn * 64, k0 = tk * 64;
      const int tx = tid & 63, ty = tid >> 6;
      const int np = n0 + tx;
      int sc = np;
      if (mode == 1) {
        if (np < 1280) sc = np;
        else if (np < 1792) sc = 1304 + (np - 1280);
        else if (np < 3840) sc = 1816 + (np - 1792);
        else if (np < 3864) sc = 1280 + (np - 3840);
        else sc = -1;
      } else if (mode == 2) {
        sc = np < 64 ? np : -1;
      }
      for (int kk = ty; kk < 64; kk += 8) {
        float val = 0.f;
        if (sc >= 0) val = src[(size_t)(k0 + kk) * Nsrc + sc];
        if (scl) val *= scl[k0 + kk];
        tile[kk * 65 + tx] = val;
      }
      __syncthreads();
      {
        const int n = tid >> 3, kc = tid & 7;
        uint4 o;
        o.x = pk2(tile[(kc * 8 + 0) * 65 + n], tile[(kc * 8 + 1) * 65 + n]);
        o.y = pk2(tile[(kc * 8 + 2) * 65 + n], tile[(kc * 8 + 3) * 65 + n]);
        o.z = pk2(tile[(kc * 8 + 4) * 65 + n], tile[(kc * 8 + 5) * 65 + n]);
        o.w = pk2(tile[(kc * 8 + 6) * 65 + n], tile[(kc * 8 + 7) * 65 + n]);
        *(uint4*)(dst + (size_t)(n0 + n) * K + k0 + kc * 8) = o;
      }
      __syncthreads();
    } else {
      const int item = jt - NXT, kv = item >> 4, slice = item & 15;
      const float* w1 = kv ? p->vw1 : p->kw1;
      const int col = tid & 255, h = tid >> 8, kb = slice * 128 + h * 64;
      float s0 = 0.f, s1 = 0.f, s2 = 0.f, s3 = 0.f;
      for (int k = kb; k < kb + 64; k += 4) {
        s0 += p->pe[k] * w1[(size_t)k * 256 + col];
        s1 += p->pe[k + 1] * w1[(size_t)(k + 1) * 256 + col];
        s2 += p->pe[k + 2] * w1[(size_t)(k + 2) * 256 + col];
        s3 += p->pe[k + 3] * w1[(size_t)(k + 3) * 256 + col];
      }
      ((float*)(p->ws + OFF_CBP))[(kv * 32 + slice * 2 + h) * 256 + col] = (s0 + s1) + (s2 + s3);
    }
  }
  float* rope = (float*)(p->ws + OFF_ROPE);
  for (int i = blockIdx.x * NT_ + tid; i < S_ * 8; i += gridDim.x * NT_) {
    const int pos = i >> 3, k = i & 7;
    const float inv = powf(500000.0f, -(2.0f * (float)k) / 16.0f);
    const float ang = (float)pos * inv;
    rope[pos * 16 + k] = cosf(ang);
    rope[pos * 16 + 8 + k] = sinf(ang);
  }
  if (blockIdx.x == 0 && tid < 64) ((int*)(p->ws + OFF_CTR))[tid] = 0;
}

DI void phaseB(int wv0, PP p, unsigned char* smem) {
  const u16* HN = (const u16*)(p->ws + OFF_HN);
  const u16* WT = (const u16*)(p->ws + OFF_WINT);
  const float* rope = (const float*)(p->ws + OFF_ROPE);
  const int lane = my_tid(wv0) & 63;
  const bool ropewave = (wv0 & 1) == 0;
  for (int id = blockIdx.x; id < 128 * 16; id += gridDim.x) {
    const int pm = id >> 4, pn = id & 15, brow = pm * 256, bcol = pn * 256;
    f32x4 acc[2][2][4][2];
    gemm256(wv0, acc, HN + (size_t)brow * 1024, 1024, WT + (size_t)bcol * 1024, 1024, 1024, smem);
    if (pn < 2) {
      u16* QR = (u16*)(p->ws + OFF_QRAW);
      u16* QO = (u16*)(p->ws + OFF_QROT);
      epi256(wv0, acc, brow, bcol, [&](int ai, int bj, int m, int n, int row0, int col, f32x4& v) {
        f32x4 r = v;
        if (n == 0 && ropewave) {
          const int k = lane & 7;
#pragma unroll
          for (int i = 0; i < 4; ++i) {
            const float pr = __shfl_xor(v[i], 8);
            const int pos = (row0 + i) & (S_ - 1);
            const float c = rope[pos * 16 + k], s = rope[pos * 16 + 8 + k];
            r[i] = (lane & 8) ? (v[i] * c + pr * s) : (v[i] * c - pr * s);
          }
        }
#pragma unroll
        for (int i = 0; i < 4; ++i) {
          QR[(size_t)(row0 + i) * 512 + col] = f2bf(v[i] * QSCALE);
          QO[(size_t)(row0 + i) * 512 + col] = f2bf(r[i] * QSCALE);
        }
      });
    } else if (pn < 5) {
      epi256(wv0, acc, brow, bcol, [&](int ai, int bj, int m, int n, int row0, int col, f32x4& v) {
        const int sub = (pn - 2) * 2 + bj;
        const bool dorope = (sub == 2 || sub == 4), transposed = (sub == 3 || sub == 5);
        u16* dst = (u16*)(p->ws + OFF_KCIN + (size_t)sub * 8 * MB);
        const int c128 = col & 127, g = c128 >> 6, d = c128 & 63;
        const int b = row0 >> 13, s = row0 & (S_ - 1);
        f32x4 r = v;
        if (dorope && n == 0 && ropewave) {
          const int k = lane & 7;
#pragma unroll
          for (int i = 0; i < 4; ++i) {
            const float pr = __shfl_xor(v[i], 8);
            const float c = rope[(s + i) * 16 + k], sn = rope[(s + i) * 16 + 8 + k];
            r[i] = (lane & 8) ? (v[i] * c + pr * sn) : (v[i] * c - pr * sn);
          }
        }
        if (transposed) {
          uint2 o;
          o.x = pk2(r[0], r[1]);
          o.y = pk2(r[2], r[3]);
          *(uint2*)(dst + ((size_t)((b * 2 + g) * 64 + d)) * S_ + s) = o;
        } else {
#pragma unroll
          for (int i = 0; i < 4; ++i) dst[((size_t)(b * 2 + g) * S_ + s + i) * 64 + d] = f2bf(r[i]);
        }
      });
    } else if (pn < 7) {
      u16* U = (u16*)(p->ws + OFF_U);
      epi256(wv0, acc, brow, bcol, [&](int ai, int bj, int m, int n, int row0, int col, f32x4& v) {
#pragma unroll
        for (int i = 0; i < 4; ++i) U[(size_t)(row0 + i) * 512 + (col - 1280)] = f2bf(v[i]);
      });
    } else if (pn < 15) {
      u16* MG = (u16*)(p->ws + OFF_MG);
      epi256(wv0, acc, brow, bcol, [&](int ai, int bj, int m, int n, int row0, int col, f32x4& v) {
#pragma unroll
        for (int i = 0; i < 4; ++i) MG[(size_t)(row0 + i) * 2048 + (col - 1792)] = f2bf(sigmoidf_(v[i]));
      });
    } else {
      float* NG = (float*)(p->ws + OFF_NG);
      epi256(wv0, acc, brow, bcol, [&](int ai, int bj, int m, int n, int row0, int col, f32x4& v) {
        const int cc = col - 3840;
        if (cc < 24) {
#pragma unroll
          for (int i = 0; i < 4; ++i) NG[(size_t)(row0 + i) * 24 + cc] = sigmoidf_(v[i]);
        }
      });
    }
  }
}

struct S5c {
  float lbr, lbi;
  float br[16], bi[16];
};
DI void s5_setup(PP p, int g, int n, S5c& c) {
  const float step = expf(p->log_step[g]);
  const float lr = p->lam_re[g * 64 + n], li = p->lam_im[g * 64 + n];
  const float er = expf(lr * step);
  float sn, cs;
  sincosf(li * step, &sn, &cs);
  c.lbr = er * cs;
  c.lbi = er * sn;
  const float nr = c.lbr - 1.f, ni = c.lbi, den = lr * lr + li * li;
  const float cr = (nr * lr + ni * li) / den, ci = (ni * lr - nr * li) / den;
#pragma unroll
  for (int k = 0; k < 16; ++k) {
    const float bre = p->b_re[(g * 64 + n) * 16 + k], bim = p->b_im[(g * 64 + n) * 16 + k];
    c.br[k] = cr * bre - ci * bim;
    c.bi[k] = cr * bim + ci * bre;
  }
}
DI void s5_load_u(PP p, int b, int ch, int g, float* su, int lane) {
  const u16* U = (const u16*)(p->ws + OFF_U) + ((size_t)(b * S_ + ch * 64 + lane)) * 512 + g * 16;
  const uint4 a = *(const uint4*)U, c = *(const uint4*)(U + 8);
  float* d = su + lane * 16;
  const unsigned w[8] = {a.x, a.y, a.z, a.w, c.x, c.y, c.z, c.w};
#pragma unroll
  for (int k = 0; k < 8; ++k) {
    d[2 * k] = __uint_as_float(w[k] << 16);
    d[2 * k + 1] = __uint_as_float(w[k] & 0xffff0000u);
  }
}
DI void s5_step(const S5c& c, const float* ut, float& hr, float& hi) {
  float bur = 0.f, bui = 0.f;
#pragma unroll
  for (int k4 = 0; k4 < 4; ++k4) {
    const float4 u = *(const float4*)(ut + 4 * k4);
    bur += c.br[4 * k4] * u.x + c.br[4 * k4 + 1] * u.y + c.br[4 * k4 + 2] * u.z + c.br[4 * k4 + 3] * u.w;
    bui += c.bi[4 * k4] * u.x + c.bi[4 * k4 + 1] * u.y + c.bi[4 * k4 + 2] * u.z + c.bi[4 * k4 + 3] * u.w;
  }
  const float nr = c.lbr * hr - c.lbi * hi + bur;
  const float nim = c.lbr * hi + c.lbi * hr + bui;
  hr = nr;
  hi = nim;
}
DI void s5_pass1(int wv0, PP p, int item, unsigned char* smem) {
  const int lane = my_tid(wv0) & 63;
  const int b = item >> 9, g = (item >> 4) & 31, c8 = item & 15, ch = c8 * 8 + wv0;
  float* su = (float*)smem + wv0 * 1024;
  S5c c;
  s5_setup(p, g, lane, c);
  s5_load_u(p, b, ch, g, su, lane);
  __syncthreads();
  float hr = 0.f, hi = 0.f;
  for (int t = 0; t < 64; ++t) s5_step(c, su + t * 16, hr, hi);
  float2* HL = (float2*)(p->ws + OFF_HLOC);
  HL[((size_t)(b * 128 + ch) * 32 + g) * 64 + lane] = make_float2(hr, hi);
  __syncthreads();
}
DI void s5_carry(int wv0, PP p) {
  const int x = blockIdx.x * NT_ + my_tid(wv0);
  if (x >= 8192) return;
  const int b = x >> 11, g = (x >> 6) & 31, n = x & 63;
  const float step = expf(p->log_step[g]);
  const float lr = p->lam_re[g * 64 + n], li = p->lam_im[g * 64 + n];
  const float er = expf(64.f * lr * step);
  float sn, cs;
  sincosf(64.f * li * step, &sn, &cs);
  const float Lr = er * cs, Li = er * sn;
  float2* HL = (float2*)(p->ws + OFF_HLOC) + (size_t)b * 128 * 2048 + g * 64 + n;
  float hr = 0.f, hi = 0.f;
  for (int c0 = 0; c0 < 128; c0 += 16) {
    float2 v[16];
#pragma unroll
    for (int k = 0; k < 16; ++k) v[k] = HL[(size_t)(c0 + k) * 2048];
#pragma unroll
    for (int k = 0; k < 16; ++k) {
      HL[(size_t)(c0 + k) * 2048] = make_float2(hr, hi);
      const float nr = Lr * hr - Li * hi + v[k].x;
      const float nim = Lr * hi + Li * hr + v[k].y;
      hr = nr;
      hi = nim;
    }
  }
}
DI void s5_pass3(int wv0, PP p, int item, unsigned char* smem) {
  const int tid = my_tid(wv0), lane = tid & 63;
  const int b = item >> 9, g = (item >> 4) & 31, c8 = item & 15, ch = c8 * 8 + wv0;
  float* su = (float*)smem + wv0 * 1024;
  float* sh = (float*)smem + 8192 + wv0 * (16 * 130);
  float* sC = (float*)smem + 8192 + 8 * 16 * 130;
  S5c c;
  s5_setup(p, g, lane, c);
  s5_load_u(p, b, ch, g, su, lane);
  for (int e = tid; e < 1024; e += NT_) {
    const int cc = e >> 6, n = e & 63;
    sC[(n * 16 + cc) * 2] = p->c_re[(g * 16 + cc) * 64 + n];
    sC[(n * 16 + cc) * 2 + 1] = p->c_im[(g * 16 + cc) * 64 + n];
  }
  const float2 h0 = ((const float2*)(p->ws + OFF_HLOC))[((size_t)(b * 128 + ch) * 32 + g) * 64 + lane];
  float hr = h0.x, hi = h0.y;
  const int tt = lane >> 2, c4 = lane & 3;
  float dk[4];
#pragma unroll
  for (int k = 0; k < 4; ++k) dk[k] = p->dsk[g * 16 + c4 * 4 + k];
  u16* YS = (u16*)(p->ws + OFF_YS);
  __syncthreads();
  for (int sub = 0; sub < 4; ++sub) {
    for (int t = 0; t < 16; ++t) {
      s5_step(c, su + (sub * 16 + t) * 16, hr, hi);
      *(float2*)(sh + t * 130 + 2 * lane) = make_float2(hr, hi);
    }
    __syncthreads();
    float a0 = 0.f, a1 = 0.f, a2 = 0.f, a3 = 0.f;
    for (int n = 0; n < 64; ++n) {
      const float2 h = *(const float2*)(sh + tt * 130 + 2 * n);
      const float4 c0 = *(const float4*)(sC + (n * 16 + c4 * 4) * 2);
      const float4 c1 = *(const float4*)(sC + (n * 16 + c4 * 4) * 2 + 4);
      a0 += c0.x * h.x - c0.y * h.y;
      a1 += c0.z * h.x - c0.w * h.y;
      a2 += c1.x * h.x - c1.y * h.y;
      a3 += c1.z * h.x - c1.w * h.y;
    }
    const int t = sub * 16 + tt;
    const float4 uu = *(const float4*)(su + t * 16 + c4 * 4);
    uint2 o;
    o.x = pk2(gelu_t(a0 + dk[0] * uu.x), gelu_t(a1 + dk[1] * uu.y));
    o.y = pk2(gelu_t(a2 + dk[2] * uu.z), gelu_t(a3 + dk[3] * uu.w));
    *(uint2*)(YS + ((size_t)(b * S_ + ch * 64 + t)) * 512 + g * 16 + c4 * 4) = o;
    __syncthreads();
  }
}

DI void phaseC(int wv0, PP p, unsigned char* smem) {
  const float* cbp = (const float*)(p->ws + OFF_CBP);
  for (int id = blockIdx.x; id < 32 + 2048 + 256; id += gridDim.x) {
    if (id >= 32 + 2048) {
      const int it = id - (32 + 2048), tns = it >> 7, bg = (it >> 4) & 7, part = it & 15;
      const int tid = my_tid(wv0);
      const u16* K = (const u16*)(p->ws + (tns ? OFF_KW : OFF_KS)) + ((size_t)bg * S_ + part * 512 + tid) * 64;
      float q2 = 0.f;
#pragma unroll
      for (int c = 0; c < 8; ++c) {
        const uint4 w = *(const uint4*)(K + c * 8);
        const unsigned ww[4] = {w.x, w.y, w.z, w.w};
#pragma unroll
        for (int e = 0; e < 4; ++e) {
          const float a = __uint_as_float(ww[e] << 16), b2 = __uint_as_float(ww[e] & 0xffff0000u);
          q2 += a * a + b2 * b2;
        }
      }
#pragma unroll
      for (int o = 32; o > 0; o >>= 1) q2 = fmaxf(q2, __shfl_xor(q2, o));
      if ((tid & 63) == 0) atomicMax((unsigned*)(p->ws + OFF_KMAX) + tns * 8 + bg, __float_as_uint(q2));
    } else if (id < 32) {
      const int kv = id >> 4, pm = id & 15, brow = pm * 256;
      const u16* A = (const u16*)(p->ws + (kv ? OFF_VCIN : OFF_KCIN)) + (size_t)brow * 1024;
      const u16* Bt = (const u16*)(p->ws + (kv ? OFF_W1VT : OFF_W1KT));
      f32x4 acc[2][2][4][2];
      gemm256(wv0, acc, A, 1024, Bt, 2048, 2048, smem);
      u16* HC = (u16*)(p->ws + OFF_HC) + (size_t)kv * 4096 * 256;
      epi256(wv0, acc, brow, 0, [&](int ai, int bj, int m, int n, int row0, int col, f32x4& v) {
        float bb = 0.f;
#pragma unroll 8
        for (int s = 0; s < 32; ++s) bb += cbp[(kv * 32 + s) * 256 + col];
#pragma unroll
        for (int i = 0; i < 4; ++i) HC[(size_t)(row0 + i) * 256 + col] = f2bf(gelu_t(v[i] + bb));
      });
    } else {
      s5_pass1(wv0, p, id - 32, smem);
    }
  }
}
DI void phaseD(int wv0, PP p, unsigned char* smem) {
  for (int id = blockIdx.x; id < 32; id += gridDim.x) {
    const int kv = id >> 4, pm = id & 15, brow = pm * 256;
    const u16* A = (const u16*)(p->ws + OFF_HC) + (size_t)kv * 4096 * 256 + (size_t)brow * 256;
    const u16* Bt = (const u16*)(p->ws + (kv ? OFF_W2VT : OFF_W2KT));
    f32x4 acc[2][2][4][2];
    gemm256(wv0, acc, A, 256, Bt, 256, 256, smem);
    u16* KCC = (u16*)(p->ws + OFF_KCC);
    u16* VCT = (u16*)(p->ws + OFF_VCT);
    epi256(wv0, acc, brow, 0, [&](int ai, int bj, int m, int n, int row0, int col, f32x4& v) {
      if (col < 64) {
        const int bg = row0 >> 9, nn = row0 & 511;
        f32x4 r = v;
        if (nn + 3 == 511) r[3] = 0.f;
        if (kv == 0) {
#pragma unroll
          for (int i = 0; i < 4; ++i) KCC[((size_t)bg * 512 + nn + i) * 64 + col] = f2bf(r[i]);
        } else {
          uint2 o;
          o.x = pk2(r[0], r[1]);
          o.y = pk2(r[2], r[3]);
          *(uint2*)(VCT + ((size_t)bg * 64 + col) * 512 + nn) = o;
        }
      }
    });
  }
  s5_carry(wv0, p);
}

DI bool bit128(u64 lo, u64 hi, int j) { return j < 64 ? ((lo >> j) & 1ull) : ((hi >> (j - 64)) & 1ull); }
DI int next_bit(u64 lo, u64 hi, int from) {
  if (from < 64) {
    const u64 x = (lo >> from) << from;
    if (x) return __ffsll((long long)x) - 1;
    from = 64;
  }
  if (from >= 128) return -1;
  const u64 y = (hi >> (from - 64)) << (from - 64);
  return y ? 63 + __ffsll((long long)y) : -1;
}

template <int MODE, bool MASKED, class MaskF>
DI void flash_tile(const u16* sK, const u16* sV, const bf16x8 (&qf)[2][2], f32x4 (&O)[2][4], float (&m)[2], float (&l)[2],
                   float (&ps)[4][4], MaskF ok, bool sel, int lane) {
  const int l15 = lane & 15, lg = lane >> 4;
  bf16x8 kf[4][2];
#pragma unroll
  for (int kt = 0; kt < 4; ++kt)
#pragma unroll
    for (int ks = 0; ks < 2; ++ks) kf[kt][ks] = *(const bf16x8*)(sK + (16 * kt + l15) * 72 + ks * 32 + lg * 8);
  if (MODE == 1) {
#pragma unroll
    for (int a = 0; a < 4; ++a)
#pragma unroll
      for (int b = 0; b < 4; ++b) ps[a][b] = 0.f;
  }
#pragma unroll
  for (int qt = 0; qt < 2; ++qt) {
    f32x4 s[4];
    const float sinit = (MODE == 3) ? ((MASKED || sel) ? m[qt] : -1e30f) : 0.f;
#pragma unroll
    for (int kt = 0; kt < 4; ++kt) {
      s[kt] = f32x4{sinit, sinit, sinit, sinit};
#pragma unroll
      for (int ks = 0; ks < 2; ++ks) s[kt] = mfma16(kf[kt][ks], qf[qt][ks], s[kt]);
    }
    float pr[4][4];
    if (MODE == 3) {
      float rs = 0.f;
#pragma unroll
      for (int kt = 0; kt < 4; ++kt)
#pragma unroll
        for (int i = 0; i < 4; ++i) {
          float pv = __builtin_amdgcn_exp2f(s[kt][i]);
          if (MASKED) pv = ok(kt, i) ? pv : 0.f;
          pr[kt][i] = pv;
          rs += pv;
        }
      l[qt] += rs;
    } else {
    float mx = -1e30f;
#pragma unroll
    for (int kt = 0; kt < 4; ++kt)
#pragma unroll
      for (int i = 0; i < 4; ++i) {
        if (MASKED) s[kt][i] = ok(kt, i) ? s[kt][i] : -1e30f;
        mx = fmaxf(mx, s[kt][i]);
      }
    if (!MASKED) mx = sel ? mx : -1e30f;
    if (MODE == 1) {
      const float mm = m[qt], il = l[qt];
#pragma unroll
      for (int kt = 0; kt < 4; ++kt)
#pragma unroll
        for (int i = 0; i < 4; ++i) {
          const float pv = (s[kt][i] > -1e29f) ? __builtin_amdgcn_exp2f(s[kt][i] - mm) * il : 0.f;
          pr[kt][i] = pv;
          ps[kt][i] += pv;
        }
    } else {
      mx = fmaxf(mx, __shfl_xor(mx, 16));
      mx = fmaxf(mx, __shfl_xor(mx, 32));
      const float mnew = fmaxf(m[qt], mx);
      const float alpha = __builtin_amdgcn_exp2f(m[qt] - mnew);
      m[qt] = mnew;
      float rs = 0.f;
      if (MASKED) {
#pragma unroll
        for (int kt = 0; kt < 4; ++kt)
#pragma unroll
          for (int i = 0; i < 4; ++i) {
            const float pv = (s[kt][i] > -1e29f) ? __builtin_amdgcn_exp2f(s[kt][i] - mnew) : 0.f;
            pr[kt][i] = pv;
            rs += pv;
          }
      } else {
        const float me = sel ? mnew : 1e30f;
#pragma unroll
        for (int kt = 0; kt < 4; ++kt)
#pragma unroll
          for (int i = 0; i < 4; ++i) {
            const float pv = __builtin_amdgcn_exp2f(s[kt][i] - me);
            pr[kt][i] = pv;
            rs += pv;
          }
      }
      l[qt] = l[qt] * alpha + rs;
      if (MODE == 2) {
#pragma unroll
        for (int dt = 0; dt < 4; ++dt) O[qt][dt] *= alpha;
      }
    }
    }
    if (MODE != 0) {
#pragma unroll
      for (int ks2 = 0; ks2 < 2; ++ks2) {
        union { unsigned u[4]; bf16x8 v; } pf;
        pf.u[0] = pk2(pr[2 * ks2][0], pr[2 * ks2][1]);
        pf.u[1] = pk2(pr[2 * ks2][2], pr[2 * ks2][3]);
        pf.u[2] = pk2(pr[2 * ks2 + 1][0], pr[2 * ks2 + 1][1]);
        pf.u[3] = pk2(pr[2 * ks2 + 1][2], pr[2 * ks2 + 1][3]);
#pragma unroll
        for (int dt = 0; dt < 4; ++dt) {
          union { uint2 h[2]; bf16x8 v; } vf;
          vf.h[0] = *(const uint2*)(sV + (16 * dt + l15) * 72 + 32 * ks2 + 4 * lg);
          vf.h[1] = *(const uint2*)(sV + (16 * dt + l15) * 72 + 32 * ks2 + 16 + 4 * lg);
          O[qt][dt] = mfma16(vf.v, pf.v, O[qt][dt]);
        }
      }
    }
    __builtin_amdgcn_sched_barrier(0);
  }
}

DI void nsa_item(int wv0, PP p, int item, unsigned char* smem) {
  const int tid = my_tid(wv0), lane = tid & 63, wv = wv0 & 3, hp = wv0 >> 2, l15 = lane & 15, lg = lane >> 4;
  const int i = 127 - (item >> 3), bg = item & 7, b = bg >> 1, g = bg & 1;
  u16* sK = (u16*)smem;
  u16* sV = sK + 64 * 72;
  float* sImp0 = (float*)(smem + 18432);
  float* sImp = sImp0 + hp * (64 * 132);
  u64* sUni = (u64*)(smem + 18432 + 2 * 64 * 132 * 4);
  u64* sSel = sUni + 16;
  const int t0 = i * 64, qloc = 16 * wv + l15, tq = t0 + qloc;
  const unsigned tokq = (unsigned)(b * S_ + tq);
  const float* NGb = (const float*)(p->ws + OFF_NG);
  const unsigned ngoff = tokq * 24 + g * 12 + hp * 6;
  float* ACCb = p->out;
  const unsigned aoff = tokq * 512 + g * 256 + hp * 128 + 4 * lg;
  const unsigned qoff = tokq * 512 + g * 256 + hp * 128 + lg * 8;
  const int lrow = tid >> 3, lpart = tid & 7;
  const unsigned koff = (lrow * 64 + lpart * 8) * 2, voffc = (lrow * 512 + lpart * 8) * 2, voffs = (lrow * S_ + lpart * 8) * 2;

  for (int e = tid; e < 2 * 64 * 132; e += NT_) sImp0[e] = 0.f;

  bf16x8 qf[2][2];
  f32x4 O[2][4];
  float m[2], l[2], ps[4][4];
  u32x4 pk0, pv0;
  auto nomask = [](int, int) { return true; };

#define MAKE_RSRC(PTR) __builtin_amdgcn_make_buffer_rsrc((void*)(PTR), 0, 0x7fffffff, 0x00020000)
#define BLOAD(R, VO, SO) __builtin_amdgcn_raw_buffer_load_b128((R), (int)(VO), (int)(SO), 0)
#define ISSUE_TILE(RK, RV, T, LDV)                                                   \
  {                                                                                  \
    pk0 = BLOAD(RK, koff, (T)*8192);                                                 \
    pv0 = BLOAD(RV, ((LDV) == 512) ? voffc : voffs, (T)*128);                        \
  }
#define COMMIT_TILE()                                                                \
  {                                                                                  \
    *(u32x4*)(sK + lrow * 72 + lpart * 8) = pk0;                                     \
    *(u32x4*)(sV + lrow * 72 + lpart * 8) = pv0;                                     \
  }
#define LOAD_Q(BASE)                                                                 \
  {                                                                                  \
    const u16* Q_ = (const u16*)(p->ws + (BASE));                                    \
    _Pragma("unroll") for (int qt = 0; qt < 2; ++qt)                                 \
      _Pragma("unroll") for (int ks = 0; ks < 2; ++ks)                               \
        qf[qt][ks] = *(const bf16x8*)(Q_ + (qoff + qt * 64 + ks * 32));             \
  }
#define RESET_STATE()                                                                \
  {                                                                                  \
    _Pragma("unroll") for (int qt = 0; qt < 2; ++qt) { m[qt] = -1e30f; l[qt] = 0.f; } \
    _Pragma("unroll") for (int a = 0; a < 2; ++a)                                    \
      _Pragma("unroll") for (int c = 0; c < 4; ++c) O[a][c] = f32x4{0.f, 0.f, 0.f, 0.f}; \
  }

  {
    const u16* Kc0 = (const u16*)(p->ws + OFF_KCC) + (size_t)bg * 512 * 64;
    const u16* Vc0 = (const u16*)(p->ws + OFF_VCT) + (size_t)bg * 64 * 512;
    const int nE = (4 * i + 3) < 511 ? (4 * i + 3) : 511;
    const int nkb = (nE + 63) >> 6;
    const __amdgpu_buffer_rsrc_t rK = MAKE_RSRC(Kc0), rV = MAKE_RSRC(Vc0);
    LOAD_Q(OFF_QRAW)
    RESET_STATE()
    ISSUE_TILE(rK, rV, 0, 512)
    for (int kb = 0; kb < nkb; ++kb) {
      __syncthreads();
      COMMIT_TILE()
      __syncthreads();
      if (kb + 1 < nkb) ISSUE_TILE(rK, rV, kb + 1, 512)
      auto ok = [&](int kt, int ii) { return 16 * (kb * 64 + 16 * kt + 4 * lg + ii) + 31 <= tq; };
      flash_tile<0, true>(sK, sV, qf, O, m, l, ps, ok, true, lane);
    }
#pragma unroll
    for (int qt = 0; qt < 2; ++qt) {
      float s = l[qt];
      s += __shfl_xor(s, 16);
      s += __shfl_xor(s, 32);
      l[qt] = s > 0.f ? 1.f / s : 0.f;
    }
    ISSUE_TILE(rK, rV, 0, 512)
    for (int kb = 0; kb < nkb; ++kb) {
      __syncthreads();
      COMMIT_TILE()
      __syncthreads();
      if (kb + 1 < nkb) ISSUE_TILE(rK, rV, kb + 1, 512)
      auto ok = [&](int kt, int ii) { return 16 * (kb * 64 + 16 * kt + 4 * lg + ii) + 31 <= tq; };
      flash_tile<1, true>(sK, sV, qf, O, m, l, ps, ok, true, lane);
#pragma unroll
      for (int kt = 0; kt < 4; ++kt) {
        const int j = kb * 16 + kt * 4 + lg;
        sImp[qloc * 132 + j] += ps[kt][0] + ps[kt][1] + ps[kt][2] + ps[kt][3];
      }
      __syncthreads();
#pragma unroll
      for (int kt = 0; kt < 4; ++kt) {
        const int j1 = kb * 16 + kt * 4 + lg + 1;
        if (j1 < 128) sImp[qloc * 132 + j1] += ps[kt][3];
      }
    }
#pragma unroll
    for (int qt = 0; qt < 2; ++qt) {
      const float gt = NGb[ngoff + qt * 3 + 0];
#pragma unroll
      for (int dt = 0; dt < 4; ++dt) {
        float4 o = make_float4(O[qt][dt][0] * gt, O[qt][dt][1] * gt, O[qt][dt][2] * gt, O[qt][dt][3] * gt);
        *(float4*)(ACCb + (aoff + qt * 64 + 16 * dt)) = o;
      }
    }
  }
  __syncthreads();
  u64 mlo = 0, mhi = 0, wlo = 0, whi = 0;
  if (i < 16) {
    mlo = (1ull << (i + 1)) - 1ull;
    wlo = mlo;
  } else {
    const bool v0 = lane <= i, v1 = (lane + 64) <= i;
    const bool f0 = (lane == 0) || (lane == i) || (lane == i - 1);
    const bool f1 = (lane + 64 == i) || (lane + 64 == i - 1);
    const u64 ltm = (1ull << lane) - 1ull;
    for (int qq = hp * 8; qq < hp * 8 + 8; ++qq) {
      const float* ir = sImp0 + (16 * wv + qq) * 132;
      const float i0 = ir[lane] + ir[64 * 132 + lane], i1 = ir[lane + 64] + ir[64 * 132 + lane + 64];
      const unsigned k0 = v0 ? __float_as_uint(i0 + (f0 ? 1000.f : 0.f)) : 0u;
      const unsigned k1 = v1 ? __float_as_uint(i1 + (f1 ? 1000.f : 0.f)) : 0u;
      unsigned T = 0;
      for (int bit = 30; bit >= 0; --bit) {
        const unsigned cand = T | (1u << bit);
        const int cnt = __popcll(__ballot(k0 >= cand)) + __popcll(__ballot(k1 >= cand));
        if (cnt >= 16) T = cand;
      }
      const bool g0 = k0 > T, g1 = k1 > T, e0 = k0 == T, e1 = k1 == T;
      const int need = 16 - (__popcll(__ballot(g0)) + __popcll(__ballot(g1)));
      const u64 be0 = __ballot(e0), be1 = __ballot(e1);
      const int r0 = __popcll(be0 & ltm), r1 = __popcll(be0) + __popcll(be1 & ltm);
      const u64 s0 = __ballot(v0 && (g0 || (e0 && r0 < need)));
      const u64 s1 = __ballot(v1 && (g1 || (e1 && r1 < need)));
      wlo |= s0;
      whi |= s1;
      if (lane == 0) { sSel[(16 * wv + qq) * 2] = s0; sSel[(16 * wv + qq) * 2 + 1] = s1; }
    }
  }
  if (lane == 0) { sUni[wv0 * 2] = wlo; sUni[wv0 * 2 + 1] = whi; }
  __syncthreads();
  if (i >= 16) { mlo = sSel[qloc * 2]; mhi = sSel[qloc * 2 + 1]; }
  wlo = sUni[wv * 2] | sUni[(wv + 4) * 2];
  whi = sUni[wv * 2 + 1] | sUni[(wv + 4) * 2 + 1];
  const u64 blo = sUni[0] | sUni[2] | sUni[4] | sUni[6] | sUni[8] | sUni[10] | sUni[12] | sUni[14];
  const u64 bhi = sUni[1] | sUni[3] | sUni[5] | sUni[7] | sUni[9] | sUni[11] | sUni[13] | sUni[15];

  LOAD_Q(OFF_QROT)
  float nb_s[2], nb_w[2];
  bool usefix;
  {
    const float* KM = (const float*)(p->ws + OFF_KMAX);
    const float kms = KM[bg], kmw = KM[8 + bg];
    float bmax = 0.f;
#pragma unroll
    for (int qt = 0; qt < 2; ++qt) {
      float q2 = 0.f;
#pragma unroll
      for (int ks = 0; ks < 2; ++ks)
#pragma unroll
        for (int e = 0; e < 8; ++e) {
          const float qv = __uint_as_float(((unsigned)(u16)qf[qt][ks][e]) << 16);
          q2 += qv * qv;
        }
      q2 += __shfl_xor(q2, 16);
      q2 += __shfl_xor(q2, 32);
      const float bs = sqrtf(q2 * kms) * 1.001f + 1e-3f, bw = sqrtf(q2 * kmw) * 1.001f + 1e-3f;
      nb_s[qt] = -bs;
      nb_w[qt] = -bw;
      bmax = fmaxf(bmax, fmaxf(bs, bw));
    }
    usefix = __ballot(bmax > 60.f) == 0ull;
  }
  RESET_STATE()
  if (usefix) { m[0] = nb_s[0]; m[1] = nb_s[1]; }
  {
    const __amdgpu_buffer_rsrc_t rK = MAKE_RSRC((const u16*)(p->ws + OFF_KS) + (size_t)bg * S_ * 64);
    const __amdgpu_buffer_rsrc_t rV = MAKE_RSRC((const u16*)(p->ws + OFF_VST) + (size_t)bg * 64 * S_);
    int jn = next_bit(blo, bhi, 0);
    if (jn >= 0) ISSUE_TILE(rK, rV, jn, S_)
    while (jn >= 0) {
      const int j = jn;
      __syncthreads();
      COMMIT_TILE()
      __syncthreads();
      jn = next_bit(blo, bhi, j + 1);
      if (jn >= 0) ISSUE_TILE(rK, rV, jn, S_)
      if (bit128(wlo, whi, j)) {
        const bool sel = bit128(mlo, mhi, j);
        if (j == i) {
          auto ok = [&](int kt, int ii) { return sel && (16 * kt + 4 * lg + ii) <= qloc; };
          if (usefix) flash_tile<3, true>(sK, sV, qf, O, m, l, ps, ok, true, lane);
          else flash_tile<2, true>(sK, sV, qf, O, m, l, ps, ok, true, lane);
        } else {
          if (usefix) flash_tile<3, false>(sK, sV, qf, O, m, l, ps, nomask, sel, lane);
          else flash_tile<2, false>(sK, sV, qf, O, m, l, ps, nomask, sel, lane);
        }
      }
    }
  }
#pragma unroll
  for (int qt = 0; qt < 2; ++qt) {
    float s = l[qt];
    s += __shfl_xor(s, 16);
    s += __shfl_xor(s, 32);
    const float sc = NGb[ngoff + qt * 3 + 1] / s;
#pragma unroll
    for (int dt = 0; dt < 4; ++dt) {
      float4* a = (float4*)(ACCb + (aoff + qt * 64 + 16 * dt));
      float4 o = *a;
      o.x += O[qt][dt][0] * sc; o.y += O[qt][dt][1] * sc; o.z += O[qt][dt][2] * sc; o.w += O[qt][dt][3] * sc;
      *a = o;
    }
  }
  RESET_STATE()
  if (usefix) { m[0] = nb_w[0]; m[1] = nb_w[1]; }
  {
    const __amdgpu_buffer_rsrc_t rK = MAKE_RSRC((const u16*)(p->ws + OFF_KW) + (size_t)bg * S_ * 64);
    const __amdgpu_buffer_rsrc_t rV = MAKE_RSRC((const u16*)(p->ws + OFF_VWT) + (size_t)bg * 64 * S_);
    const int j0 = i >= 8 ? i - 8 : 0;
    ISSUE_TILE(rK, rV, j0, S_)
    for (int j = j0; j <= i; ++j) {
      __syncthreads();
      COMMIT_TILE()
      __syncthreads();
      if (j + 1 <= i) ISSUE_TILE(rK, rV, j + 1, S_)
      if (j == i || j == i - 8) {
        auto ok = [&](int kt, int ii) {
          const int kp = j * 64 + 16 * kt + 4 * lg + ii;
          return kp <= tq && kp > tq - 512;
        };
        if (usefix) flash_tile<3, true>(sK, sV, qf, O, m, l, ps, ok, true, lane);
        else flash_tile<2, true>(sK, sV, qf, O, m, l, ps, ok, true, lane);
      } else {
        if (usefix) flash_tile<3, false>(sK, sV, qf, O, m, l, ps, nomask, true, lane);
        else flash_tile<2, false>(sK, sV, qf, O, m, l, ps, nomask, true, lane);
      }
    }
  }
  u16* NSAb = (u16*)(p->ws + OFF_NSA);
#pragma unroll
  for (int qt = 0; qt < 2; ++qt) {
    float s = l[qt];
    s += __shfl_xor(s, 16);
    s += __shfl_xor(s, 32);
    const float sc = NGb[ngoff + qt * 3 + 2] / s;
#pragma unroll
    for (int dt = 0; dt < 4; ++dt) {
      const float4 a = *(const float4*)(ACCb + (aoff + qt * 64 + 16 * dt));
      uint2 o;
      o.x = pk2(a.x + O[qt][dt][0] * sc, a.y + O[qt][dt][1] * sc);
      o.y = pk2(a.z + O[qt][dt][2] * sc, a.w + O[qt][dt][3] * sc);
      *(uint2*)(NSAb + (aoff + qt * 64 + 16 * dt)) = o;
    }
  }
  __syncthreads();
}

DI void phaseE(int wv0, PP p, unsigned char* smem, int cidx) {
  __shared__ int s_item;
  int* ctr = (int*)(p->ws + OFF_CTR) + cidx;
  for (;;) {
    __syncthreads();
    if (my_tid(wv0) == 0) s_item = atomicAdd(ctr, 1);
    __syncthreads();
    const int item = s_item;
    if (item >= 1024 + 2048) break;
    if (item < 1024) nsa_item(wv0, p, item, smem);
    else s5_pass3(wv0, p, item - 1024, smem);
  }
}

DI void phaseF(int wv0, PP p, unsigned char* smem) {
  const u16* YS = (const u16*)(p->ws + OFF_YS);
  const u16* NSA = (const u16*)(p->ws + OFF_NSA);
  const u16* MG = (const u16*)(p->ws + OFF_MG);
  u16* MR = (u16*)(p->ws + OFF_MERGED);
  for (int id = blockIdx.x; id < 128 * 4; id += gridDim.x) {
    const int pm = id >> 2, pn = id & 3, brow = pm * 256, bcol = pn * 256;
    f32x4 acc[2][2][4][2];
    gemm256(wv0, acc, YS + (size_t)brow * 512, 512, (const u16*)(p->ws + OFF_WGT) + (size_t)bcol * 512, 512, 512, smem);
    epi256(wv0, acc, brow, bcol, [&](int ai, int bj, int m, int n, int row0, int col, f32x4& v) {
#pragma unroll
      for (int i = 0; i < 4; ++i) MR[(size_t)(row0 + i) * 1024 + col] = f2bf(sigmoidf_(v[i]));
    });
    gemm256(wv0, acc, YS + (size_t)brow * 512, 512, (const u16*)(p->ws + OFF_WVT) + (size_t)bcol * 512, 512, 512, smem);
    epi256(wv0, acc, brow, bcol, [&](int ai, int bj, int m, int n, int row0, int col, f32x4& v) {
#pragma unroll
      for (int i = 0; i < 4; ++i) {
        const size_t o = (size_t)(row0 + i) * 1024 + col;
        const float gb = bf2f(MG[(size_t)(row0 + i) * 2048 + 1024 + col]);
        MR[o] = f2bf(gb * v[i] * bf2f(MR[o]));
      }
    });
    gemm256(wv0, acc, NSA + (size_t)brow * 512, 512, (const u16*)(p->ws + OFF_WAT) + (size_t)bcol * 512, 512, 512, smem);
    epi256(wv0, acc, brow, bcol, [&](int ai, int bj, int m, int n, int row0, int col, f32x4& v) {
#pragma unroll
      for (int i = 0; i < 4; ++i) {
        const size_t o = (size_t)(row0 + i) * 1024 + col;
        const float ga = bf2f(MG[(size_t)(row0 + i) * 2048 + col]);
        MR[o] = f2bf(ga * v[i] + bf2f(MR[o]));
      }
    });
  }
}
DI void ss_partial(int wv0, f32x4 (&acc)[2][2][4][2], float* SS, int brow, int pn) {
  const int lane = my_tid(wv0) & 63, wr = wv0 >> 2, wc = wv0 & 3;
#pragma unroll
  for (int ai = 0; ai < 2; ++ai)
#pragma unroll
    for (int m = 0; m < 4; ++m)
#pragma unroll
      for (int i = 0; i < 4; ++i) {
        float s = acc[ai][0][m][0][i] * acc[ai][0][m][0][i] + acc[ai][0][m][1][i] * acc[ai][0][m][1][i] +
                  acc[ai][1][m][0][i] * acc[ai][1][m][0][i] + acc[ai][1][m][1][i] * acc[ai][1][m][1][i];
        s += __shfl_xor(s, 1);
        s += __shfl_xor(s, 2);
        s += __shfl_xor(s, 4);
        s += __shfl_xor(s, 8);
        if ((lane & 15) == 0) SS[(size_t)(brow + ai * 128 + wr * 64 + m * 16 + (lane >> 4) * 4 + i) * 16 + pn * 4 + wc] = s;
      }
}
DI void phaseG(int wv0, PP p, unsigned char* smem) {
  const u16* MR = (const u16*)(p->ws + OFF_MERGED);
  u16* X1B = (u16*)(p->ws + OFF_X1B);
  float* SS1 = (float*)(p->ws + OFF_SS1);
  for (int id = blockIdx.x; id < 128 * 4; id += gridDim.x) {
    const int pm = id >> 2, pn = id & 3, brow = pm * 256, bcol = pn * 256;
    f32x4 acc[2][2][4][2];
    gemm256(wv0, acc, MR + (size_t)brow * 1024, 1024, (const u16*)(p->ws + OFF_WOT) + (size_t)bcol * 1024, 1024, 1024, smem);
    epi256(wv0, acc, brow, bcol, [&](int ai, int bj, int m, int n, int row0, int col, f32x4& v) {
#pragma unroll
      for (int i = 0; i < 4; ++i) {
        const size_t o = (size_t)(row0 + i) * 1024 + col;
        const float x1 = v[i] + p->x[o];
        p->out[o] = x1;
        X1B[o] = f2bf(x1);
        v[i] = x1;
      }
    });
    ss_partial(wv0, acc, SS1, brow, pn);
  }
}
DI void phaseH(int wv0, PP p, unsigned char* smem) {
  const u16* X1B = (const u16*)(p->ws + OFF_X1B);
  const float* SS1 = (const float*)(p->ws + OFF_SS1);
  u16* ACT = (u16*)(p->ws + OFF_ACT);
  float* sR = (float*)(smem + 131072);
  for (int id = blockIdx.x; id < 128 * 16; id += gridDim.x) {
    const int pm = id >> 4, pn = id & 15, brow = pm * 256, bcol = pn * 256;
    const int tid = my_tid(wv0);
    if (tid < 256) {
      const float4* s = (const float4*)(SS1 + (size_t)(brow + tid) * 16);
      const float4 a = s[0], b = s[1], c = s[2], d = s[3];
      const float t = a.x + a.y + a.z + a.w + b.x + b.y + b.z + b.w + c.x + c.y + c.z + c.w + d.x + d.y + d.z + d.w;
      sR[tid] = rsqrtf(t * (1.f / 1024.f) + 1e-6f);
    }
    f32x4 acc[2][2][4][2];
    gemm256(wv0, acc, X1B + (size_t)brow * 1024, 1024, (const u16*)(p->ws + OFF_WUPT) + (size_t)bcol * 1024, 1024, 1024, smem);
    epi256(wv0, acc, brow, bcol, [&](int ai, int bj, int m, int n, int row0, int col, f32x4& v) {
#pragma unroll
      for (int i = 0; i < 4; ++i) {
        float a = fmaxf(v[i] * sR[row0 + i - brow], 0.f);
        ACT[(size_t)(row0 + i) * 4096 + col] = f2bf(a * a);
      }
    });
    __syncthreads();
  }
}
DI void phaseI(int wv0, PP p, unsigned char* smem) {
  const u16* ACT = (const u16*)(p->ws + OFF_ACT);
  float* SS2 = (float*)(p->ws + OFF_SS2);
  for (int id = blockIdx.x; id < 128 * 4; id += gridDim.x) {
    const int pm = id >> 2, pn = id & 3, brow = pm * 256, bcol = pn * 256;
    f32x4 acc[2][2][4][2];
    gemm256(wv0, acc, ACT + (size_t)brow * 4096, 4096, (const u16*)(p->ws + OFF_WDT) + (size_t)bcol * 4096, 4096, 4096, smem);
    epi256(wv0, acc, brow, bcol, [&](int ai, int bj, int m, int n, int row0, int col, f32x4& v) {
#pragma unroll
      for (int i = 0; i < 4; ++i) {
        const size_t o = (size_t)(row0 + i) * 1024 + col;
        const float x2 = v[i] + p->out[o];
        p->out[o] = x2;
        v[i] = x2;
      }
    });
    ss_partial(wv0, acc, SS2, brow, pn);
  }
}
DI void phaseJ(int wv0, PP p) {
  const int lane = my_tid(wv0) & 63;
  const float* SS2 = (const float*)(p->ws + OFF_SS2);
  for (int row = blockIdx.x * 8 + wv0; row < T_; row += gridDim.x * 8) {
    float t = (lane < 16) ? SS2[(size_t)row * 16 + lane] : 0.f;
    t = wave_sum(t);
    const float rinv = rsqrtf(t * (1.f / 1024.f) + 1e-6f);
    float4* xr = (float4*)(p->out + (size_t)row * 1024);
#pragma unroll
    for (int r = 0; r < 4; ++r) {
      float4 v = xr[lane + 64 * r];
      const float4 g = ((const float4*)p->g3)[lane + 64 * r];
      v.x *= rinv * g.x; v.y *= rinv * g.y; v.z *= rinv * g.z; v.w *= rinv * g.w;
      xr[lane + 64 * r] = v;
    }
  }
}

__global__ void __launch_bounds__(512, 2) mega(Params p) {
  extern __shared__ __attribute__((aligned(16))) unsigned char smem[];
  const int wv0 = __builtin_amdgcn_readfirstlane((int)(threadIdx.x >> 6));
  const int lo = p.lo, hi = p.hi;
  PP kp0 = (PP)__builtin_amdgcn_kernarg_segment_ptr();
#define PH(N, CALL)                                  \
  if (lo <= N && N < hi) {                           \
    if (N > lo) cg::this_grid().sync();              \
    PP kp = kp0;                                     \
    asm volatile("" : "+s"(kp));                     \
    CALL;                                            \
    if ((PROBE_MASK >> N) & 1) { CALL; }             \
  }
  PH(0, phaseA(wv0, kp, smem))
  PH(1, phaseB(wv0, kp, smem))
  PH(2, phaseC(wv0, kp, smem))
  PH(3, phaseD(wv0, kp, smem))
  PH(4, phaseE(wv0, kp, smem, 0))
  if ((PROBE_MASK >> 10) & 1) { PP kp = kp0; asm volatile("" : "+s"(kp)); phaseE(wv0, kp, smem, 1); }
  PH(5, phaseF(wv0, kp, smem))
  PH(6, phaseG(wv0, kp, smem))
  PH(7, phaseH(wv0, kp, smem))
  PH(8, phaseI(wv0, kp, smem))
  PH(9, phaseJ(wv0, kp))
}

extern "C" void kernel_launch(void* const* d_in, const int* in_sizes, int n_in, void* d_out, int out_size, void* d_ws,
                              size_t ws_size, hipStream_t stream) {
  static int grid_blocks = 0;
  if (!grid_blocks) {
    int dev = 0, cus = 0, per_cu = 0;
    (void)hipGetDevice(&dev);
    (void)hipDeviceGetAttribute(&cus, hipDeviceAttributeMultiprocessorCount, dev);
    (void)hipFuncSetAttribute((const void*)mega, hipFuncAttributeMaxDynamicSharedMemorySize, SMEM_BYTES);
    (void)hipOccupancyMaxActiveBlocksPerMultiprocessor(&per_cu, mega, NT_, SMEM_BYTES);
    if (per_cu > 1) per_cu = 1;
    if (per_cu < 1) per_cu = 1;
    grid_blocks = cus * per_cu;
  }
  if (ws_size < WS_NEED) { fprintf(stderr, "workspace too small: %zu < %zu\n", ws_size, (size_t)WS_NEED); }
  Params p{};
  const float** f = (const float**)&p;
  for (int i = 0; i < 24; ++i) f[i] = (const float*)d_in[i];
  p.out = (float*)d_out;
  p.ws = (unsigned char*)d_ws;
  p.lo = 0; p.hi = 10;
  void* args[] = {&p};
  hipError_t e = hipLaunchCooperativeKernel((void*)mega, dim3(grid_blocks), dim3(NT_), args, SMEM_BYTES, stream);
  if (e != hipSuccess) fprintf(stderr, "cooperative launch failed: %s (grid %d)\n", hipGetErrorString(e), grid_blocks);
}
```

```cpp
#include <hip/hip_runtime.h>
#include <hip/hip_cooperative_groups.h>
#include <cstdio>
namespace cg = cooperative_groups;

#ifndef PROBE_MASK
#define PROBE_MASK 0
#endif

#define DI __device__ __forceinline__
typedef unsigned short u16;
typedef unsigned long long u64;
using bf16x8 = __attribute__((ext_vector_type(8))) short;
using f32x4 = __attribute__((ext_vector_type(4))) float;
using u32x4 = __attribute__((ext_vector_type(4))) unsigned;

constexpr int B_ = 4, S_ = 8192, T_ = B_ * S_;
constexpr int NT_ = 512;
constexpr int NINP = 4096;
constexpr float QSCALE = 0.125f * 1.44269504089f;

constexpr size_t MB = 1024 * 1024;
constexpr size_t OFF_WINT = 0;
constexpr size_t OFF_W1KT = OFF_WINT + (size_t)NINP * 1024 * 2;
constexpr size_t OFF_W1VT = OFF_W1KT + 256 * 2048 * 2;
constexpr size_t OFF_W2KT = OFF_W1VT + 256 * 2048 * 2;
constexpr size_t OFF_W2VT = OFF_W2KT + 256 * 256 * 2;
constexpr size_t OFF_WAT = OFF_W2VT + 256 * 256 * 2;
constexpr size_t OFF_WVT = OFF_WAT + 1024 * 512 * 2;
constexpr size_t OFF_WGT = OFF_WVT + 1024 * 512 * 2;
constexpr size_t OFF_WOT = OFF_WGT + 1024 * 512 * 2;
constexpr size_t OFF_WUPT = OFF_WOT + 1024 * 1024 * 2;
constexpr size_t OFF_WDT = OFF_WUPT + 4096 * 1024 * 2;
constexpr size_t OFF_ROPE = OFF_WDT + 4096 * 1024 * 2;
constexpr size_t OFF_CBP = OFF_ROPE + 8192 * 16 * 4;
constexpr size_t OFF_CTR = OFF_CBP + 2 * 32 * 256 * 4;
constexpr size_t OFF_KMAX = OFF_CTR + 64;
constexpr size_t OFF_SS1 = OFF_CTR + 256;
constexpr size_t OFF_SS2 = OFF_SS1 + (size_t)T_ * 16 * 4;
constexpr size_t OFF_NG = OFF_SS2 + (size_t)T_ * 16 * 4;
constexpr size_t OFF_HC = OFF_NG + (size_t)T_ * 24 * 4;
constexpr size_t OFF_KCC = OFF_HC + 2 * 4096 * 256 * 2;
constexpr size_t OFF_VCT = OFF_KCC + 8 * 512 * 64 * 2;
constexpr size_t OFF_HLOC = OFF_VCT + 8 * 512 * 64 * 2;
constexpr size_t OFF_ARENA = OFF_HLOC + (size_t)4 * 128 * 32 * 64 * 8;
constexpr size_t OFF_MG = OFF_ARENA;
constexpr size_t OFF_HN = OFF_ARENA + 128 * MB;
constexpr size_t OFF_QRAW = OFF_ARENA + 192 * MB;
constexpr size_t OFF_QROT = OFF_ARENA + 224 * MB;
constexpr size_t OFF_KCIN = OFF_ARENA + 256 * MB;
constexpr size_t OFF_VCIN = OFF_KCIN + 8 * MB;
constexpr size_t OFF_KS = OFF_VCIN + 8 * MB;
constexpr size_t OFF_VST = OFF_KS + 8 * MB;
constexpr size_t OFF_KW = OFF_VST + 8 * MB;
constexpr size_t OFF_VWT = OFF_KW + 8 * MB;
constexpr size_t OFF_U = OFF_ARENA + 304 * MB;
constexpr size_t OFF_NSA = OFF_ARENA + 336 * MB;
constexpr size_t OFF_YS = OFF_ARENA + 368 * MB;
constexpr size_t WS_NEED = OFF_ARENA + 400 * MB;
constexpr size_t OFF_ACT = OFF_ARENA;
constexpr size_t OFF_X1B = OFF_ARENA + 256 * MB;
constexpr size_t OFF_MERGED = OFF_HN;

constexpr int SMEM_BYTES = 131072 + 1024;

struct Params {
  const float *x, *g1, *w_in, *pe, *kw1, *kw2, *vw1, *vw2, *lam_re, *lam_im, *log_step, *b_re, *b_im, *c_re, *c_im, *dsk,
      *w_attn, *w_val, *w_gate, *w_out, *g2, *w_up, *w_down, *g3;
  float* out;
  unsigned char* ws;
  int lo, hi;
};

typedef const __attribute__((address_space(4))) Params* PP;

DI int my_tid(int wv0) {
  int t = wv0 * 64 + (int)__lane_id();
  asm volatile("" : "+v"(t));
  return t;
}
DI u16 f2bf(float x) { unsigned u = __float_as_uint(x); u += 0x7fffu + ((u >> 16) & 1u); return (u16)(u >> 16); }
DI float bf2f(u16 h) { return __uint_as_float(((unsigned)h) << 16); }
DI unsigned pk2(float a, float b) { return (unsigned)f2bf(a) | ((unsigned)f2bf(b) << 16); }
DI float sigmoidf_(float x) { return 1.f / (1.f + __expf(-x)); }
DI float gelu_t(float x) {
  float u = 0.7978845608f * (x + 0.044715f * x * x * x);
  float e = __expf(2.f * u);
  float th = 1.f - 2.f / (e + 1.f);
  return 0.5f * x * (1.f + th);
}
DI float wave_sum(float v) {
#pragma unroll
  for (int o = 32; o > 0; o >>= 1) v += __shfl_xor(v, o);
  return v;
}
template <class T> DI T* launder(T* p) { asm volatile("" : "+v"(p)); return p; }
DI void wave_sync() { asm volatile("s_waitcnt lgkmcnt(0)" ::: "memory"); }
DI f32x4 mfma16(bf16x8 a, bf16x8 b, f32x4 c) { return __builtin_amdgcn_mfma_f32_16x16x32_bf16(a, b, c, 0, 0, 0); }

constexpr int G_HT = 128 * 64;
DI int lds_byte(int r, int c) {
  const int st = (r >> 4) * 2 + (c >> 5), rr = r & 15, cc = c & 31, ob = rr * 64 + cc * 2;
  return st * 1024 + (ob ^ (((ob >> 9) & 1) << 5));
}
DI void stage_rc(int b, int& R, int& C) {
  const int st = b / 1024, sb = b % 1024, swz = sb ^ (((sb >> 9) & 1) << 5);
  R = (st >> 1) * 16 + swz / 64;
  C = (st & 1) * 32 + (swz % 64) / 2;
}
typedef __attribute__((address_space(3))) unsigned* lds_u32p;
DI void gemm256(int wv0, f32x4 (&acc)[2][2][4][2], const u16* __restrict__ A, int lda, const u16* __restrict__ Bt, int ldb,
                int K, unsigned char* smem) {
  u16* shm = (u16*)smem;
  const int tid = my_tid(wv0), lane = tid & 63;
  const int wr = wv0 >> 2, wc = wv0 & 3, fr = lane & 15, fq = lane >> 4;
#define SA(b, h) (shm + ((b)*2 + (h)) * G_HT)
#define SB(b, h) (shm + (4 + (b)*2 + (h)) * G_HT)
  int sr0, sc0, sr1, sc1;
  stage_rc(tid * 16, sr0, sc0);
  stage_rc(tid * 16 + 8192, sr1, sc1);
  const u16* a0 = A + (size_t)sr0 * lda + sc0;
  const u16* a1 = A + (size_t)sr1 * lda + sc1;
  const u16* b0 = Bt + (size_t)sr0 * ldb + sc0;
  const u16* b1 = Bt + (size_t)sr1 * ldb + sc1;
#define STAGE_A(P, half, kt)                                                                                              \
  {                                                                                                                       \
    __builtin_amdgcn_global_load_lds((const unsigned*)(a0 + (size_t)((half)*128) * lda + (kt)*64),                        \
                                     (unsigned*)((char*)(P) + tid * 16), 16, 0, 0);                               \
    __builtin_amdgcn_global_load_lds((const unsigned*)(a1 + (size_t)((half)*128) * lda + (kt)*64),                        \
                                     (unsigned*)((char*)(P) + tid * 16 + 8192), 16, 0, 0);                        \
  }
#define STAGE_B(P, half, kt)                                                                                              \
  {                                                                                                                       \
    __builtin_amdgcn_global_load_lds((const unsigned*)(b0 + (size_t)((half)*128) * ldb + (kt)*64),                        \
                                     (unsigned*)((char*)(P) + tid * 16), 16, 0, 0);                               \
    __builtin_amdgcn_global_load_lds((const unsigned*)(b1 + (size_t)((half)*128) * ldb + (kt)*64),                        \
                                     (unsigned*)((char*)(P) + tid * 16 + 8192), 16, 0, 0);                        \
  }
#define LDA(dst, b, h)                                                                                                    \
  _Pragma("unroll") for (int m = 0; m < 4; ++m) _Pragma("unroll") for (int k = 0; k < 2; ++k)                             \
      dst[m][k] = *(const bf16x8*)((const unsigned char*)SA(b, h) + lds_byte(wr * 64 + m * 16 + fr, k * 32 + fq * 8));
#define LDB(dst, b, h)                                                                                                    \
  _Pragma("unroll") for (int n = 0; n < 2; ++n) _Pragma("unroll") for (int k = 0; k < 2; ++k)                             \
      dst[n][k] = *(const bf16x8*)((const unsigned char*)SB(b, h) + lds_byte(wc * 32 + n * 16 + fr, k * 32 + fq * 8));
#define MMA(ai, bj, At_, Bt_)                                                                                             \
  {                                                                                                                       \
    __builtin_amdgcn_s_setprio(1);                                                                                        \
    _Pragma("unroll") for (int m = 0; m < 4; ++m) _Pragma("unroll") for (int n = 0; n < 2; ++n)                           \
        _Pragma("unroll") for (int k = 0; k < 2; ++k) acc[ai][bj][m][n] =                                                 \
            __builtin_amdgcn_mfma_f32_16x16x32_bf16(At_[m][k], Bt_[n][k], acc[ai][bj][m][n], 0, 0, 0);                    \
    __builtin_amdgcn_s_setprio(0);                                                                                        \
  }
#define WAIT_V(n) asm volatile("s_waitcnt vmcnt(" #n ")" ::: "memory")
#define WAIT_L(n) asm volatile("s_waitcnt lgkmcnt(" #n ")" ::: "memory")
#define BAR __builtin_amdgcn_s_barrier()
#define SCHED __builtin_amdgcn_sched_barrier(0)
#pragma unroll
  for (int a = 0; a < 2; ++a)
#pragma unroll
    for (int b = 0; b < 2; ++b)
#pragma unroll
      for (int m = 0; m < 4; ++m)
#pragma unroll
        for (int n = 0; n < 2; ++n) acc[a][b][m][n] = f32x4{0.f, 0.f, 0.f, 0.f};
  bf16x8 At[4][2], B0[2][2], B1[2][2];
  const int nt = K / 64;
  WAIT_V(0);
  __syncthreads();
  STAGE_B(SB(0, 0), 0, 0) STAGE_A(SA(0, 0), 0, 0)
  STAGE_B(SB(0, 1), 1, 0) STAGE_A(SA(0, 1), 1, 0)
  if (wr == 1) BAR;
  WAIT_V(4); BAR;
  STAGE_B(SB(1, 0), 0, 1) STAGE_A(SA(1, 0), 0, 1) STAGE_B(SB(1, 1), 1, 1)
  WAIT_V(6); BAR;
#pragma unroll 1
  for (int t = 0; t < nt - 2; t += 2) {
    LDB(B0, 0, 0) SCHED; LDA(At, 0, 0) STAGE_A(SA(1, 1), 1, t + 1)
    WAIT_L(8); BAR; WAIT_L(0); MMA(0, 0, At, B0) BAR; SCHED;
    LDB(B1, 0, 1) STAGE_B(SB(0, 0), 0, t + 2)
    BAR; WAIT_L(0); MMA(0, 1, At, B1) BAR;
    LDA(At, 0, 1) STAGE_A(SA(0, 0), 0, t + 2)
    BAR; WAIT_L(0); MMA(1, 0, At, B0) BAR; SCHED;
    STAGE_B(SB(0, 1), 1, t + 2)
    WAIT_V(6); BAR; MMA(1, 1, At, B1) BAR;
    LDB(B0, 1, 0) SCHED; LDA(At, 1, 0) STAGE_A(SA(0, 1), 1, t + 2)
    WAIT_L(8); BAR; WAIT_L(0); MMA(0, 0, At, B0) BAR; SCHED;
    LDB(B1, 1, 1) STAGE_B(SB(1, 0), 0, t + 3)
    BAR; WAIT_L(0); MMA(0, 1, At, B1) BAR;
    LDA(At, 1, 1) STAGE_A(SA(1, 0), 0, t + 3)
    BAR; WAIT_L(0); MMA(1, 0, At, B0) BAR; SCHED;
    STAGE_B(SB(1, 1), 1, t + 3)
    WAIT_V(6); BAR; MMA(1, 1, At, B1) BAR;
  }
  {
    LDB(B0, 0, 0) LDA(At, 0, 0) STAGE_A(SA(1, 1), 1, nt - 1)
    BAR; WAIT_L(0); MMA(0, 0, At, B0) BAR;
    LDB(B1, 0, 1) BAR; WAIT_L(0); MMA(0, 1, At, B1) BAR;
    LDA(At, 0, 1) WAIT_V(4); BAR; WAIT_L(0); MMA(1, 0, At, B0) MMA(1, 1, At, B1) BAR;
  }
  {
    LDB(B0, 1, 0) LDA(At, 1, 0) WAIT_V(2); BAR; WAIT_L(0); MMA(0, 0, At, B0) BAR;
    LDB(B1, 1, 1) WAIT_V(0); BAR; WAIT_L(0); MMA(0, 1, At, B1) BAR;
    LDA(At, 1, 1) BAR; WAIT_L(0); MMA(1, 0, At, B0) MMA(1, 1, At, B1) BAR;
  }
  if (wr == 0) BAR;
}
template <class F>
DI void epi256(int wv0, f32x4 (&acc)[2][2][4][2], int brow, int bcol, F f) {
  const int lane = my_tid(wv0) & 63, wr = wv0 >> 2, wc = wv0 & 3;
#pragma unroll
  for (int ai = 0; ai < 2; ++ai)
#pragma unroll
    for (int bj = 0; bj < 2; ++bj)
#pragma unroll
      for (int m = 0; m < 4; ++m)
#pragma unroll
        for (int n = 0; n < 2; ++n) {
          const int row0 = brow + ai * 128 + wr * 64 + m * 16 + (lane >> 4) * 4;
          const int col = bcol + bj * 128 + wc * 32 + n * 16 + (lane & 15);
          f(ai, bj, m, n, row0, col, acc[ai][bj][m][n]);
        }
}

DI void phaseA(int wv0, PP p, unsigned char* smem) {
  const int tid = my_tid(wv0), lane = tid & 63;
  u16* HN = (u16*)(p->ws + OFF_HN);
  for (int row = blockIdx.x * 8 + wv0; row < T_; row += gridDim.x * 8) {
    const float4* xr = (const float4*)(p->x + (size_t)row * 1024);
    float4 v[4];
    float ss = 0.f;
#pragma unroll
    for (int r = 0; r < 4; ++r) {
      v[r] = xr[lane + 64 * r];
      ss += v[r].x * v[r].x + v[r].y * v[r].y + v[r].z * v[r].z + v[r].w * v[r].w;
    }
    ss = wave_sum(ss);
    const float rinv = rsqrtf(ss * (1.f / 1024.f) + 1e-6f);
#pragma unroll
    for (int r = 0; r < 4; ++r) {
      const float4 g = ((const float4*)p->g1)[lane + 64 * r];
      uint2 o;
      o.x = pk2(v[r].x * rinv * g.x, v[r].y * rinv * g.y);
      o.y = pk2(v[r].z * rinv * g.z, v[r].w * rinv * g.w);
      *(uint2*)(HN + (size_t)row * 1024 + (lane + 64 * r) * 4) = o;
    }
  }
  float* tile = (float*)smem;
  constexpr int NXT = 1024 + 128 + 128 + 16 + 16 + 128 * 3 + 256 + 1024 + 1024;
  for (int jt = blockIdx.x; jt < NXT + 32; jt += gridDim.x) {
    if (jt < NXT) {
      int t = jt;
      const float* src;
      u16* dst;
      int K, Nsrc, mode = 0;
      const float* scl = nullptr;
      if (t < 1024) { src = p->w_in; dst = (u16*)(p->ws + OFF_WINT); K = 1024; Nsrc = 3864; mode = 1; }
      else if ((t -= 1024) < 128) { src = p->kw1; dst = (u16*)(p->ws + OFF_W1KT); K = 2048; Nsrc = 256; }
      else if ((t -= 128) < 128) { src = p->vw1; dst = (u16*)(p->ws + OFF_W1VT); K = 2048; Nsrc = 256; }
      else if ((t -= 128) < 16) { src = p->kw2; dst = (u16*)(p->ws + OFF_W2KT); K = 256; Nsrc = 64; mode = 2; }
      else if ((t -= 16) < 16) { src = p->vw2; dst = (u16*)(p->ws + OFF_W2VT); K = 256; Nsrc = 64; mode = 2; }
      else if ((t -= 16) < 128) { src = p->w_attn; dst = (u16*)(p->ws + OFF_WAT); K = 512; Nsrc = 1024; }
      else if ((t -= 128) < 128) { src = p->w_val; dst = (u16*)(p->ws + OFF_WVT); K = 512; Nsrc = 1024; }
      else if ((t -= 128) < 128) { src = p->w_gate; dst = (u16*)(p->ws + OFF_WGT); K = 512; Nsrc = 1024; }
      else if ((t -= 128) < 256) { src = p->w_out; dst = (u16*)(p->ws + OFF_WOT); K = 1024; Nsrc = 1024; }
      else if ((t -= 256) < 1024) { src = p->w_up; dst = (u16*)(p->ws + OFF_WUPT); K = 1024; Nsrc = 4096; scl = p->g2; }
      else { t -= 1024; src = p->w_down; dst = (u16*)(p->ws + OFF_WDT); K = 4096; Nsrc = 1024; }
      const int nkt = K >> 6, tn = t / nkt, tk = t % nkt, n0 = tn * 64, k0 = tk * 64;
      const int tx = tid & 63, ty = tid >> 6;
      const int np = n0 + tx;
      int sc = np;
      if (mode == 1) {
        if (np < 1280) sc = np;
        else if (np < 1792) sc = 1304 + (np - 1280);
        else if (np < 3840) sc = 1816 + (np - 1792);
        else if (np < 3864) sc = 1280 + (np - 3840);
        else sc = -1;
      } else if (mode == 2) {
        sc = np < 64 ? np : -1;
      }
      for (int kk = ty; kk < 64; kk += 8) {
        float val = 0.f;
        if (sc >= 0) val = src[(size_t)(k0 + kk) * Nsrc + sc];
        if (scl) val *= scl[k0 + kk];
        tile[kk * 65 + tx] = val;
      }
      __syncthreads();
      {
        const int n = tid >> 3, kc = tid & 7;
        uint4 o;
        o.x = pk2(tile[(kc * 8 + 0) * 65 + n], tile[(kc * 8 + 1) * 65 + n]);
        o.y = pk2(tile[(kc * 8 + 2) * 65 + n], tile[(kc * 8 + 3) * 65 + n]);
        o.z = pk2(tile[(kc * 8 + 4) * 65 + n], tile[(kc * 8 + 5) * 65 + n]);
        o.w = pk2(tile[(kc * 8 + 6) * 65 + n], tile[(kc * 8 + 7) * 65 + n]);
        *(uint4*)(dst + (size_t)(n0 + n) * K + k0 + kc * 8) = o;
      }
      __syncthreads();
    } else {
      const int item = jt - NXT, kv = item >> 4, slice = item & 15;
      const float* w1 = kv ? p->vw1 : p->kw1;
      const int col = tid & 255, h = tid >> 8, kb = slice * 128 + h * 64;
      float s0 = 0.f, s1 = 0.f, s2 = 0.f, s3 = 0.f;
      for (int k = kb; k < kb + 64; k += 4) {
        s0 += p->pe[k] * w1[(size_t)k * 256 + col];
        s1 += p->pe[k + 1] * w1[(size_t)(k + 1) * 256 + col];
        s2 += p->pe[k + 2] * w1[(size_t)(k + 2) * 256 + col];
        s3 += p->pe[k + 3] * w1[(size_t)(k + 3) * 256 + col];
      }
      ((float*)(p->ws + OFF_CBP))[(kv * 32 + slice * 2 + h) * 256 + col] = (s0 + s1) + (s2 + s3);
    }
  }
  float* rope = (float*)(p->ws + OFF_ROPE);
  for (int i = blockIdx.x * NT_ + tid; i < S_ * 8; i += gridDim.x * NT_) {
    const int pos = i >> 3, k = i & 7;
    const float inv = powf(500000.0f, -(2.0f * (float)k) / 16.0f);
    const float ang = (float)pos * inv;
    rope[pos * 16 + k] = cosf(ang);
    rope[pos * 16 + 8 + k] = sinf(ang);
  }
  if (blockIdx.x == 0 && tid < 64) ((int*)(p->ws + OFF_CTR))[tid] = 0;
}

DI void phaseB(int wv0, PP p, unsigned char* smem) {
  const u16* HN = (const u16*)(p->ws + OFF_HN);
  const u16* WT = (const u16*)(p->ws + OFF_WINT);
  const float* rope = (const float*)(p->ws + OFF_ROPE);
  const int lane = my_tid(wv0) & 63;
  const bool ropewave = (wv0 & 1) == 0;
  for (int id = blockIdx.x; id < 128 * 16; id += gridDim.x) {
    const int pm = id >> 4, pn = id & 15, brow = pm * 256, bcol = pn * 256;
    f32x4 acc[2][2][4][2];
    gemm256(wv0, acc, HN + (size_t)brow * 1024, 1024, WT + (size_t)bcol * 1024, 1024, 1024, smem);
    if (pn < 2) {
      u16* QR = (u16*)(p->ws + OFF_QRAW);
      u16* QO = (u16*)(p->ws + OFF_QROT);
      epi256(wv0, acc, brow, bcol, [&](int ai, int bj, int m, int n, int row0, int col, f32x4& v) {
        f32x4 r = v;
        if (n == 0 && ropewave) {
          const int k = lane & 7;
#pragma unroll
          for (int i = 0; i < 4; ++i) {
            const float pr = __shfl_xor(v[i], 8);
            const int pos = (row0 + i) & (S_ - 1);
            const float c = rope[pos * 16 + k], s = rope[pos * 16 + 8 + k];
            r[i] = (lane & 8) ? (v[i] * c + pr * s) : (v[i] * c - pr * s);
          }
        }
#pragma unroll
        for (int i = 0; i < 4; ++i) {
          QR[(size_t)(row0 + i) * 512 + col] = f2bf(v[i] * QSCALE);
          QO[(size_t)(row0 + i) * 512 + col] = f2bf(r[i] * QSCALE);
        }
      });
    } else if (pn < 5) {
      epi256(wv0, acc, brow, bcol, [&](int ai, int bj, int m, int n, int row0, int col, f32x4& v) {
        const int sub = (pn - 2) * 2 + bj;
        const bool dorope = (sub == 2 || sub == 4), transposed = (sub == 3 || sub == 5);
        u16* dst = (u16*)(p->ws + OFF_KCIN + (size_t)sub * 8 * MB);
        const int c128 = col & 127, g = c128 >> 6, d = c128 & 63;
        const int b = row0 >> 13, s = row0 & (S_ - 1);
        f32x4 r = v;
        if (dorope && n == 0 && ropewave) {
          const int k = lane & 7;
#pragma unroll
          for (int i = 0; i < 4; ++i) {
            const float pr = __shfl_xor(v[i], 8);
            const float c = rope[(s + i) * 16 + k], sn = rope[(s + i) * 16 + 8 + k];
            r[i] = (lane & 8) ? (v[i] * c + pr * sn) : (v[i] * c - pr * sn);
          }
        }
        if (transposed) {
          uint2 o;
          o.x = pk2(r[0], r[1]);
          o.y = pk2(r[2], r[3]);
          *(uint2*)(dst + ((size_t)((b * 2 + g) * 64 + d)) * S_ + s) = o;
        } else {
#pragma unroll
          for (int i = 0; i < 4; ++i) dst[((size_t)(b * 2 + g) * S_ + s + i) * 64 + d] = f2bf(r[i]);
        }
      });
    } else if (pn < 7) {
      u16* U = (u16*)(p->ws + OFF_U);
      epi256(wv0, acc, brow, bcol, [&](int ai, int bj, int m, int n, int row0, int col, f32x4& v) {
#pragma unroll
        for (int i = 0; i < 4; ++i) U[(size_t)(row0 + i) * 512 + (col - 1280)] = f2bf(v[i]);
      });
    } else if (pn < 15) {
      u16* MG = (u16*)(p->ws + OFF_MG);
      epi256(wv0, acc, brow, bcol, [&](int ai, int bj, int m, int n, int row0, int col, f32x4& v) {
#pragma unroll
        for (int i = 0; i < 4; ++i) MG[(size_t)(row0 + i) * 2048 + (col - 1792)] = f2bf(sigmoidf_(v[i]));
      });
    } else {
      float* NG = (float*)(p->ws + OFF_NG);
      epi256(wv0, acc, brow, bcol, [&](int ai, int bj, int m, int n, int row0, int col, f32x4& v) {
        const int cc = col - 3840;
        if (cc < 24) {
#pragma unroll
          for (int i = 0; i < 4; ++i) NG[(size_t)(row0 + i) * 24 + cc] = sigmoidf_(v[i]);
        }
      });
    }
  }
}

struct S5c {
  float lbr, lbi;
  float br[16], bi[16];
};
DI void s5_setup(PP p, int g, int n, S5c& c) {
  const float step = expf(p->log_step[g]);
  const float lr = p->lam_re[g * 64 + n], li = p->lam_im[g * 64 + n];
  const float er = expf(lr * step);
  float sn, cs;
  sincosf(li * step, &sn, &cs);
  c.lbr = er * cs;
  c.lbi = er * sn;
  const float nr = c.lbr - 1.f, ni = c.lbi, den = lr * lr + li * li;
  const float cr = (nr * lr + ni * li) / den, ci = (ni * lr - nr * li) / den;
#pragma unroll
  for (int k = 0; k < 16; ++k) {
    const float bre = p->b_re[(g * 64 + n) * 16 + k], bim = p->b_im[(g * 64 + n) * 16 + k];
    c.br[k] = cr * bre - ci * bim;
    c.bi[k] = cr * bim + ci * bre;
  }
}
DI void s5_load_u(PP p, int b, int ch, int g, float* su, int lane) {
  const u16* U = (const u16*)(p->ws + OFF_U) + ((size_t)(b * S_ + ch * 64 + lane)) * 512 + g * 16;
  const uint4 a = *(const uint4*)U, c = *(const uint4*)(U + 8);
  float* d = su + lane * 16;
  const unsigned w[8] = {a.x, a.y, a.z, a.w, c.x, c.y, c.z, c.w};
#pragma unroll
  for (int k = 0; k < 8; ++k) {
    d[2 * k] = __uint_as_float(w[k] << 16);
    d[2 * k + 1] = __uint_as_float(w[k] & 0xffff0000u);
  }
}
DI void s5_step(const S5c& c, const float* ut, float& hr, float& hi) {
  float bur = 0.f, bui = 0.f;
#pragma unroll
  for (int k4 = 0; k4 < 4; ++k4) {
    const float4 u = *(const float4*)(ut + 4 * k4);
    bur += c.br[4 * k4] * u.x + c.br[4 * k4 + 1] * u.y + c.br[4 * k4 + 2] * u.z + c.br[4 * k4 + 3] * u.w;
    bui += c.bi[4 * k4] * u.x + c.bi[4 * k4 + 1] * u.y + c.bi[4 * k4 + 2] * u.z + c.bi[4 * k4 + 3] * u.w;
  }
  const float nr = c.lbr * hr - c.lbi * hi + bur;
  const float nim = c.lbr * hi + c.lbi * hr + bui;
  hr = nr;
  hi = nim;
}
template <bool OUT>
DI void s5_item(int wv0, PP p, int item, unsigned char* smem) {
  const int tid = my_tid(wv0), lane = tid & 63, fr = lane & 15, fq = lane >> 4;
  const int b = item >> 9, g = (item >> 4) & 31, c8 = item & 15, ch = c8 * 8 + wv0;
  u16* sBb = (u16*)smem;
  u16* sCm = sBb + 128 * 16;
  float* sBU = (float*)(smem + 8192) + wv0 * (16 * 132);
  u16* sH = (u16*)(smem + 8192 + 8 * 16 * 132 * 4) + wv0 * (16 * 136);
  const float step = expf(p->log_step[g]);
  for (int e = tid; e < 2048; e += NT_) {
    const int np = e >> 4, c = e & 15, n = np & 63;
    const float lr = p->lam_re[g * 64 + n], li = p->lam_im[g * 64 + n];
    const float er = expf(lr * step);
    float sn, cs;
    sincosf(li * step, &sn, &cs);
    const float nr = er * cs - 1.f, ni = er * sn, den = lr * lr + li * li;
    const float cr = (nr * lr + ni * li) / den, ci = (ni * lr - nr * li) / den;
    const float bre = p->b_re[(g * 64 + n) * 16 + c], bim = p->b_im[(g * 64 + n) * 16 + c];
    sBb[np * 16 + c] = f2bf(np < 64 ? (cr * bre - ci * bim) : (cr * bim + ci * bre));
  }
  if (OUT) {
    for (int e = tid; e < 2048; e += NT_) {
      const int cc = e >> 7, k = e & 127;
      sCm[cc * 128 + k] = f2bf(k < 64 ? p->c_re[(g * 16 + cc) * 64 + k] : -p->c_im[(g * 16 + cc) * 64 + (k - 64)]);
    }
  }
  float lbr, lbi;
  {
    const float lr = p->lam_re[g * 64 + lane], li = p->lam_im[g * 64 + lane];
    const float er = expf(lr * step);
    float sn, cs;
    sincosf(li * step, &sn, &cs);
    lbr = er * cs;
    lbi = er * sn;
  }
  float2* HL = (float2*)(p->ws + OFF_HLOC) + ((size_t)(b * 128 + ch) * 32 + g) * 64 + lane;
  float hr = 0.f, hi = 0.f;
  if (OUT) { const float2 h0 = *HL; hr = h0.x; hi = h0.y; }
  const u16* U = (const u16*)(p->ws + OFF_U) + ((size_t)(b * S_ + ch * 64)) * 512 + g * 16;
  u16* YS = (u16*)(p->ws + OFF_YS) + ((size_t)(b * S_ + ch * 64)) * 512 + g * 16;
  const float dk = p->dsk[g * 16 + fr];
  __syncthreads();
  const bf16x8 zero8 = {0, 0, 0, 0, 0, 0, 0, 0};
  bf16x8 bb[8], cf[4];
#pragma unroll
  for (int nt = 0; nt < 8; ++nt) bb[nt] = fq < 2 ? *(const bf16x8*)(sBb + (16 * nt + fr) * 16 + 8 * fq) : zero8;
  if (OUT) {
#pragma unroll
    for (int ks = 0; ks < 4; ++ks) cf[ks] = *(const bf16x8*)(sCm + fr * 128 + 32 * ks + 8 * fq);
  }
#pragma unroll 1
  for (int sub = 0; sub < 4; ++sub) {
    const bf16x8 ua = fq < 2 ? *(const bf16x8*)(U + (size_t)(sub * 16 + fr) * 512 + 8 * fq) : zero8;
#pragma unroll
    for (int nt = 0; nt < 8; ++nt) {
      const f32x4 a = mfma16(ua, bb[nt], f32x4{0.f, 0.f, 0.f, 0.f});
#pragma unroll
      for (int j = 0; j < 4; ++j) sBU[(4 * fq + j) * 132 + 16 * nt + fr] = a[j];
    }
    __syncthreads();
#pragma unroll 4
    for (int t = 0; t < 16; ++t) {
      const float bur = sBU[t * 132 + lane], bui = sBU[t * 132 + 64 + lane];
      const float nr = lbr * hr - lbi * hi + bur;
      const float nim = lbr * hi + lbi * hr + bui;
      hr = nr;
      hi = nim;
      if (OUT) {
        sH[t * 136 + lane] = f2bf(hr);
        sH[t * 136 + 64 + lane] = f2bf(hi);
      }
    }
    __syncthreads();
    if (OUT) {
      f32x4 y = {0.f, 0.f, 0.f, 0.f};
#pragma unroll
      for (int ks = 0; ks < 4; ++ks) y = mfma16(*(const bf16x8*)(sH + fr * 136 + 32 * ks + 8 * fq), cf[ks], y);
#pragma unroll
      for (int j = 0; j < 4; ++j) {
        const size_t o = (size_t)(sub * 16 + 4 * fq + j) * 512 + fr;
        YS[o] = f2bf(gelu_t(y[j] + dk * bf2f(U[o])));
      }
      __syncthreads();
    }
  }
  if (!OUT) *HL = make_float2(hr, hi);
  __syncthreads();
}
DI void s5_carry(int wv0, PP p) {
  const int x = blockIdx.x * NT_ + my_tid(wv0);
  if (x >= 8192) return;
  const int b = x >> 11, g = (x >> 6) & 31, n = x & 63;
  const float step = expf(p->log_step[g]);
  const float lr = p->lam_re[g * 64 + n], li = p->lam_im[g * 64 + n];
  const float er = expf(64.f * lr * step);
  float sn, cs;
  sincosf(64.f * li * step, &sn, &cs);
  const float Lr = er * cs, Li = er * sn;
  float2* HL = (float2*)(p->ws + OFF_HLOC) + (size_t)b * 128 * 2048 + g * 64 + n;
  float hr = 0.f, hi = 0.f;
  for (int c0 = 0; c0 < 128; c0 += 16) {
    float2 v[16];
#pragma unroll
    for (int k = 0; k < 16; ++k) v[k] = HL[(size_t)(c0 + k) * 2048];
#pragma unroll
    for (int k = 0; k < 16; ++k) {
      HL[(size_t)(c0 + k) * 2048] = make_float2(hr, hi);
      const float nr = Lr * hr - Li * hi + v[k].x;
      const float nim = Lr * hi + Li * hr + v[k].y;
      hr = nr;
      hi = nim;
    }
  }
}
DI void phaseC(int wv0, PP p, unsigned char* smem) {
  const float* cbp = (const float*)(p->ws + OFF_CBP);
  for (int id = blockIdx.x; id < 32 + 2048 + 256; id += gridDim.x) {
    if (id >= 32 + 2048) {
      const int it = id - (32 + 2048), tns = it >> 7, bg = (it >> 4) & 7, part = it & 15;
      const int tid = my_tid(wv0);
      const u16* K = (const u16*)(p->ws + (tns ? OFF_KW : OFF_KS)) + ((size_t)bg * S_ + part * 512 + tid) * 64;
      float q2 = 0.f;
#pragma unroll
      for (int c = 0; c < 8; ++c) {
        const uint4 w = *(const uint4*)(K + c * 8);
        const unsigned ww[4] = {w.x, w.y, w.z, w.w};
#pragma unroll
        for (int e = 0; e < 4; ++e) {
          const float a = __uint_as_float(ww[e] << 16), b2 = __uint_as_float(ww[e] & 0xffff0000u);
          q2 += a * a + b2 * b2;
        }
      }
#pragma unroll
      for (int o = 32; o > 0; o >>= 1) q2 = fmaxf(q2, __shfl_xor(q2, o));
      if ((tid & 63) == 0) atomicMax((unsigned*)(p->ws + OFF_KMAX) + tns * 8 + bg, __float_as_uint(q2));
    } else if (id < 32) {
      const int kv = id >> 4, pm = id & 15, brow = pm * 256;
      const u16* A = (const u16*)(p->ws + (kv ? OFF_VCIN : OFF_KCIN)) + (size_t)brow * 1024;
      const u16* Bt = (const u16*)(p->ws + (kv ? OFF_W1VT : OFF_W1KT));
      f32x4 acc[2][2][4][2];
      gemm256(wv0, acc, A, 1024, Bt, 2048, 2048, smem);
      u16* HC = (u16*)(p->ws + OFF_HC) + (size_t)kv * 4096 * 256;
      epi256(wv0, acc, brow, 0, [&](int ai, int bj, int m, int n, int row0, int col, f32x4& v) {
        float bb = 0.f;
#pragma unroll 8
        for (int s = 0; s < 32; ++s) bb += cbp[(kv * 32 + s) * 256 + col];
#pragma unroll
        for (int i = 0; i < 4; ++i) HC[(size_t)(row0 + i) * 256 + col] = f2bf(gelu_t(v[i] + bb));
      });
    } else {
      s5_item<false>(wv0, p, id - 32, smem);
    }
  }
}
DI void phaseD(int wv0, PP p, unsigned char* smem) {
  for (int id = blockIdx.x; id < 32; id += gridDim.x) {
    const int kv = id >> 4, pm = id & 15, brow = pm * 256;
    const u16* A = (const u16*)(p->ws + OFF_HC) + (size_t)kv * 4096 * 256 + (size_t)brow * 256;
    const u16* Bt = (const u16*)(p->ws + (kv ? OFF_W2VT : OFF_W2KT));
    f32x4 acc[2][2][4][2];
    gemm256(wv0, acc, A, 256, Bt, 256, 256, smem);
    u16* KCC = (u16*)(p->ws + OFF_KCC);
    u16* VCT = (u16*)(p->ws + OFF_VCT);
    epi256(wv0, acc, brow, 0, [&](int ai, int bj, int m, int n, int row0, int col, f32x4& v) {
      if (col < 64) {
        const int bg = row0 >> 9, nn = row0 & 511;
        f32x4 r = v;
        if (nn + 3 == 511) r[3] = 0.f;
        if (kv == 0) {
#pragma unroll
          for (int i = 0; i < 4; ++i) KCC[((size_t)bg * 512 + nn + i) * 64 + col] = f2bf(r[i]);
        } else {
          uint2 o;
          o.x = pk2(r[0], r[1]);
          o.y = pk2(r[2], r[3]);
          *(uint2*)(VCT + ((size_t)bg * 64 + col) * 512 + nn) = o;
        }
      }
    });
  }
  s5_carry(wv0, p);
}

DI bool bit128(u64 lo, u64 hi, int j) { return j < 64 ? ((lo >> j) & 1ull) : ((hi >> (j - 64)) & 1ull); }
DI int next_bit(u64 lo, u64 hi, int from) {
  if (from < 64) {
    const u64 x = (lo >> from) << from;
    if (x) return __ffsll((long long)x) - 1;
    from = 64;
  }
  if (from >= 128) return -1;
  const u64 y = (hi >> (from - 64)) << (from - 64);
  return y ? 63 + __ffsll((long long)y) : -1;
}

template <int MODE, bool MASKED, class MaskF>
DI void flash_tile(const u16* sK, const u16* sV, const bf16x8 (&qf)[2][2], f32x4 (&O)[2][4], float (&m)[2], float (&l)[2],
                   float (&ps)[4][4], MaskF ok, bool sel, int lane) {
  const int l15 = lane & 15, lg = lane >> 4;
  bf16x8 kf[4][2];
#pragma unroll
  for (int kt = 0; kt < 4; ++kt)
#pragma unroll
    for (int ks = 0; ks < 2; ++ks) kf[kt][ks] = *(const bf16x8*)(sK + (16 * kt + l15) * 72 + ks * 32 + lg * 8);
  if (MODE == 1) {
#pragma unroll
    for (int a = 0; a < 4; ++a)
#pragma unroll
      for (int b = 0; b < 4; ++b) ps[a][b] = 0.f;
  }
#pragma unroll
  for (int qt = 0; qt < 2; ++qt) {
    f32x4 s[4];
    const float sinit = (MODE == 3) ? ((MASKED || sel) ? m[qt] : -1e30f) : 0.f;
#pragma unroll
    for (int kt = 0; kt < 4; ++kt) {
      s[kt] = f32x4{sinit, sinit, sinit, sinit};
#pragma unroll
      for (int ks = 0; ks < 2; ++ks) s[kt] = mfma16(kf[kt][ks], qf[qt][ks], s[kt]);
    }
    float pr[4][4];
    if (MODE == 3) {
      float rs = 0.f;
#pragma unroll
      for (int kt = 0; kt < 4; ++kt)
#pragma unroll
        for (int i = 0; i < 4; ++i) {
          float pv = __builtin_amdgcn_exp2f(s[kt][i]);
          if (MASKED) pv = ok(kt, i) ? pv : 0.f;
          pr[kt][i] = pv;
          rs += pv;
        }
      l[qt] += rs;
    } else {
    float mx = -1e30f;
#pragma unroll
    for (int kt = 0; kt < 4; ++kt)
#pragma unroll
      for (int i = 0; i < 4; ++i) {
        if (MASKED) s[kt][i] = ok(kt, i) ? s[kt][i] : -1e30f;
        mx = fmaxf(mx, s[kt][i]);
      }
    if (!MASKED) mx = sel ? mx : -1e30f;
    if (MODE == 1) {
      const float mm = m[qt], il = l[qt];
#pragma unroll
      for (int kt = 0; kt < 4; ++kt)
#pragma unroll
        for (int i = 0; i < 4; ++i) {
          const float pv = (s[kt][i] > -1e29f) ? __builtin_amdgcn_exp2f(s[kt][i] - mm) * il : 0.f;
          pr[kt][i] = pv;
          ps[kt][i] += pv;
        }
    } else {
      mx = fmaxf(mx, __shfl_xor(mx, 16));
      mx = fmaxf(mx, __shfl_xor(mx, 32));
      const float mnew = fmaxf(m[qt], mx);
      const float alpha = __builtin_amdgcn_exp2f(m[qt] - mnew);
      m[qt] = mnew;
      float rs = 0.f;
      if (MASKED) {
#pragma unroll
        for (int kt = 0; kt < 4; ++kt)
#pragma unroll
          for (int i = 0; i < 4; ++i) {
            const float pv = (s[kt][i] > -1e29f) ? __builtin_amdgcn_exp2f(s[kt][i] - mnew) : 0.f;
            pr[kt][i] = pv;
            rs += pv;
          }
      } else {
        const float me = sel ? mnew : 1e30f;
#pragma unroll
        for (int kt = 0; kt < 4; ++kt)
#pragma unroll
          for (int i = 0; i < 4; ++i) {
            const float pv = __builtin_amdgcn_exp2f(s[kt][i] - me);
            pr[kt][i] = pv;
            rs += pv;
          }
      }
      l[qt] = l[qt] * alpha + rs;
      if (MODE == 2) {
#pragma unroll
        for (int dt = 0; dt < 4; ++dt) O[qt][dt] *= alpha;
      }
    }
    }
    if (MODE != 0) {
#pragma unroll
      for (int ks2 = 0; ks2 < 2; ++ks2) {
        union { unsigned u[4]; bf16x8 v; } pf;
        pf.u[0] = pk2(pr[2 * ks2][0], pr[2 * ks2][1]);
        pf.u[1] = pk2(pr[2 * ks2][2], pr[2 * ks2][3]);
        pf.u[2] = pk2(pr[2 * ks2 + 1][0], pr[2 * ks2 + 1][1]);
        pf.u[3] = pk2(pr[2 * ks2 + 1][2], pr[2 * ks2 + 1][3]);
#pragma unroll
        for (int dt = 0; dt < 4; ++dt) {
          union { uint2 h[2]; bf16x8 v; } vf;
          vf.h[0] = *(const uint2*)(sV + (16 * dt + l15) * 72 + 32 * ks2 + 4 * lg);
          vf.h[1] = *(const uint2*)(sV + (16 * dt + l15) * 72 + 32 * ks2 + 16 + 4 * lg);
          O[qt][dt] = mfma16(vf.v, pf.v, O[qt][dt]);
        }
      }
    }

  }
}

DI void nsa_item(int wv0, PP p, int item, unsigned char* smem) {
  const int tid = my_tid(wv0), lane = tid & 63, wv = wv0 & 3, hp = wv0 >> 2, l15 = lane & 15, lg = lane >> 4;
  const int i = 127 - (item >> 3), bg = item & 7, b = bg >> 1, g = bg & 1;
  u16* sK = (u16*)smem;
  u16* sV = sK + 64 * 72;
  float* sImp0 = (float*)(smem + 18432);
  float* sImp = sImp0 + hp * (64 * 132);
  u64* sUni = (u64*)(smem + 18432 + 2 * 64 * 132 * 4);
  u64* sSel = sUni + 16;
  const int t0 = i * 64, qloc = 16 * wv + l15, tq = t0 + qloc;
  const unsigned tokq = (unsigned)(b * S_ + tq);
  const float* NGb = (const float*)(p->ws + OFF_NG);
  const unsigned ngoff = tokq * 24 + g * 12 + hp * 6;
  float* ACCb = p->out;
  const unsigned aoff = tokq * 512 + g * 256 + hp * 128 + 4 * lg;
  const unsigned qoff = tokq * 512 + g * 256 + hp * 128 + lg * 8;
  const int lrow = tid >> 3, lpart = tid & 7;
  const unsigned koff = (lrow * 64 + lpart * 8) * 2, voffc = (lrow * 512 + lpart * 8) * 2, voffs = (lrow * S_ + lpart * 8) * 2;

  for (int e = tid; e < 2 * 64 * 132; e += NT_) sImp0[e] = 0.f;

  bf16x8 qf[2][2];
  f32x4 O[2][4];
  float m[2], l[2], ps[4][4];
  u32x4 pk0, pv0;
  auto nomask = [](int, int) { return true; };

#define MAKE_RSRC(PTR) __builtin_amdgcn_make_buffer_rsrc((void*)(PTR), 0, 0x7fffffff, 0x00020000)
#define BLOAD(R, VO, SO) __builtin_amdgcn_raw_buffer_load_b128((R), (int)(VO), (int)(SO), 0)
#define ISSUE_TILE(RK, RV, T, LDV)                                                   \
  {                                                                                  \
    pk0 = BLOAD(RK, koff, (T)*8192);                                                 \
    pv0 = BLOAD(RV, ((LDV) == 512) ? voffc : voffs, (T)*128);                        \
  }
#define COMMIT_TILE()                                                                \
  {                                                                                  \
    *(u32x4*)(sK + lrow * 72 + lpart * 8) = pk0;                                     \
    *(u32x4*)(sV + lrow * 72 + lpart * 8) = pv0;                                     \
  }
#define LOAD_Q(BASE)                                                                 \
  {                                                                                  \
    const u16* Q_ = (const u16*)(p->ws + (BASE));                                    \
    _Pragma("unroll") for (int qt = 0; qt < 2; ++qt)                                 \
      _Pragma("unroll") for (int ks = 0; ks < 2; ++ks)                               \
        qf[qt][ks] = *(const bf16x8*)(Q_ + (qoff + qt * 64 + ks * 32));             \
  }
#define RESET_STATE()                                                                \
  {                                                                                  \
    _Pragma("unroll") for (int qt = 0; qt < 2; ++qt) { m[qt] = -1e30f; l[qt] = 0.f; } \
    _Pragma("unroll") for (int a = 0; a < 2; ++a)                                    \
      _Pragma("unroll") for (int c = 0; c < 4; ++c) O[a][c] = f32x4{0.f, 0.f, 0.f, 0.f}; \
  }

  {
    const u16* Kc0 = (const u16*)(p->ws + OFF_KCC) + (size_t)bg * 512 * 64;
    const u16* Vc0 = (const u16*)(p->ws + OFF_VCT) + (size_t)bg * 64 * 512;
    const int nE = (4 * i + 3) < 511 ? (4 * i + 3) : 511;
    const int nkb = (nE + 63) >> 6;
    const __amdgpu_buffer_rsrc_t rK = MAKE_RSRC(Kc0), rV = MAKE_RSRC(Vc0);
    LOAD_Q(OFF_QRAW)
    RESET_STATE()
    ISSUE_TILE(rK, rV, 0, 512)
    for (int kb = 0; kb < nkb; ++kb) {
      __syncthreads();
      COMMIT_TILE()
      __syncthreads();
      if (kb + 1 < nkb) ISSUE_TILE(rK, rV, kb + 1, 512)
      auto ok = [&](int kt, int ii) { return 16 * (kb * 64 + 16 * kt + 4 * lg + ii) + 31 <= tq; };
      flash_tile<0, true>(sK, sV, qf, O, m, l, ps, ok, true, lane);
    }
#pragma unroll
    for (int qt = 0; qt < 2; ++qt) {
      float s = l[qt];
      s += __shfl_xor(s, 16);
      s += __shfl_xor(s, 32);
      l[qt] = s > 0.f ? 1.f / s : 0.f;
    }
    ISSUE_TILE(rK, rV, 0, 512)
    for (int kb = 0; kb < nkb; ++kb) {
      __syncthreads();
      COMMIT_TILE()
      __syncthreads();
      if (kb + 1 < nkb) ISSUE_TILE(rK, rV, kb + 1, 512)
      auto ok = [&](int kt, int ii) { return 16 * (kb * 64 + 16 * kt + 4 * lg + ii) + 31 <= tq; };
      flash_tile<1, true>(sK, sV, qf, O, m, l, ps, ok, true, lane);
#pragma unroll
      for (int kt = 0; kt < 4; ++kt) {
        const int j = kb * 16 + kt * 4 + lg;
        sImp[qloc * 132 + j] += ps[kt][0] + ps[kt][1] + ps[kt][2] + ps[kt][3];
      }
      __syncthreads();
#pragma unroll
      for (int kt = 0; kt < 4; ++kt) {
        const int j1 = kb * 16 + kt * 4 + lg + 1;
        if (j1 < 128) sImp[qloc * 132 + j1] += ps[kt][3];
      }
    }
#pragma unroll
    for (int qt = 0; qt < 2; ++qt) {
      const float gt = NGb[ngoff + qt * 3 + 0];
#pragma unroll
      for (int dt = 0; dt < 4; ++dt) {
        float4 o = make_float4(O[qt][dt][0] * gt, O[qt][dt][1] * gt, O[qt][dt][2] * gt, O[qt][dt][3] * gt);
        *(float4*)(ACCb + (aoff + qt * 64 + 16 * dt)) = o;
      }
    }
  }
  __syncthreads();
  u64 mlo = 0, mhi = 0, wlo = 0, whi = 0;
  if (i < 16) {
    mlo = (1ull << (i + 1)) - 1ull;
    wlo = mlo;
  } else {
    const bool v0 = lane <= i, v1 = (lane + 64) <= i;
    const bool f0 = (lane == 0) || (lane == i) || (lane == i - 1);
    const bool f1 = (lane + 64 == i) || (lane + 64 == i - 1);
    const u64 ltm = (1ull << lane) - 1ull;
    for (int qq = hp * 8; qq < hp * 8 + 8; ++qq) {
      const float* ir = sImp0 + (16 * wv + qq) * 132;
      const float i0 = ir[lane] + ir[64 * 132 + lane], i1 = ir[lane + 64] + ir[64 * 132 + lane + 64];
      const unsigned k0 = v0 ? __float_as_uint(i0 + (f0 ? 1000.f : 0.f)) : 0u;
      const unsigned k1 = v1 ? __float_as_uint(i1 + (f1 ? 1000.f : 0.f)) : 0u;
      unsigned T = 0;
      for (int bit = 30; bit >= 0; --bit) {
        const unsigned cand = T | (1u << bit);
        const int cnt = __popcll(__ballot(k0 >= cand)) + __popcll(__ballot(k1 >= cand));
        if (cnt >= 16) T = cand;
      }
      const bool g0 = k0 > T, g1 = k1 > T, e0 = k0 == T, e1 = k1 == T;
      const int need = 16 - (__popcll(__ballot(g0)) + __popcll(__ballot(g1)));
      const u64 be0 = __ballot(e0), be1 = __ballot(e1);
      const int r0 = __popcll(be0 & ltm), r1 = __popcll(be0) + __popcll(be1 & ltm);
      const u64 s0 = __ballot(v0 && (g0 || (e0 && r0 < need)));
      const u64 s1 = __ballot(v1 && (g1 || (e1 && r1 < need)));
      wlo |= s0;
      whi |= s1;
      if (lane == 0) { sSel[(16 * wv + qq) * 2] = s0; sSel[(16 * wv + qq) * 2 + 1] = s1; }
    }
  }
  if (lane == 0) { sUni[wv0 * 2] = wlo; sUni[wv0 * 2 + 1] = whi; }
  __syncthreads();
  if (i >= 16) { mlo = sSel[qloc * 2]; mhi = sSel[qloc * 2 + 1]; }
  wlo = sUni[wv * 2] | sUni[(wv + 4) * 2];
  whi = sUni[wv * 2 + 1] | sUni[(wv + 4) * 2 + 1];
  const u64 blo = sUni[0] | sUni[2] | sUni[4] | sUni[6] | sUni[8] | sUni[10] | sUni[12] | sUni[14];
  const u64 bhi = sUni[1] | sUni[3] | sUni[5] | sUni[7] | sUni[9] | sUni[11] | sUni[13] | sUni[15];

  LOAD_Q(OFF_QROT)
  float nb_s[2], nb_w[2];
  bool usefix;
  {
    const float* KM = (const float*)(p->ws + OFF_KMAX);
    const float kms = KM[bg], kmw = KM[8 + bg];
    float bmax = 0.f;
#pragma unroll
    for (int qt = 0; qt < 2; ++qt) {
      float q2 = 0.f;
#pragma unroll
      for (int ks = 0; ks < 2; ++ks)
#pragma unroll
        for (int e = 0; e < 8; ++e) {
          const float qv = __uint_as_float(((unsigned)(u16)qf[qt][ks][e]) << 16);
          q2 += qv * qv;
        }
      q2 += __shfl_xor(q2, 16);
      q2 += __shfl_xor(q2, 32);
      const float bs = sqrtf(q2 * kms) * 1.001f + 1e-3f, bw = sqrtf(q2 * kmw) * 1.001f + 1e-3f;
      nb_s[qt] = -bs;
      nb_w[qt] = -bw;
      bmax = fmaxf(bmax, fmaxf(bs, bw));
    }
    usefix = __ballot(bmax > 60.f) == 0ull;
  }
  RESET_STATE()
  if (usefix) { m[0] = nb_s[0]; m[1] = nb_s[1]; }
  {
    const __amdgpu_buffer_rsrc_t rK = MAKE_RSRC((const u16*)(p->ws + OFF_KS) + (size_t)bg * S_ * 64);
    const __amdgpu_buffer_rsrc_t rV = MAKE_RSRC((const u16*)(p->ws + OFF_VST) + (size_t)bg * 64 * S_);
    int jn = next_bit(blo, bhi, 0);
    if (jn >= 0) ISSUE_TILE(rK, rV, jn, S_)
    while (jn >= 0) {
      const int j = jn;
      __syncthreads();
      COMMIT_TILE()
      __syncthreads();
      jn = next_bit(blo, bhi, j + 1);
      if (jn >= 0) ISSUE_TILE(rK, rV, jn, S_)
      if (bit128(wlo, whi, j)) {
        const bool sel = bit128(mlo, mhi, j);
        if (j == i) {
          auto ok = [&](int kt, int ii) { return sel && (16 * kt + 4 * lg + ii) <= qloc; };
          if (usefix) flash_tile<3, true>(sK, sV, qf, O, m, l, ps, ok, true, lane);
          else flash_tile<2, true>(sK, sV, qf, O, m, l, ps, ok, true, lane);
        } else {
          if (usefix) flash_tile<3, false>(sK, sV, qf, O, m, l, ps, nomask, sel, lane);
          else flash_tile<2, false>(sK, sV, qf, O, m, l, ps, nomask, sel, lane);
        }
      }
    }
  }
#pragma unroll
  for (int qt = 0; qt < 2; ++qt) {
    float s = l[qt];
    s += __shfl_xor(s, 16);
    s += __shfl_xor(s, 32);
    const float sc = NGb[ngoff + qt * 3 + 1] / s;
#pragma unroll
    for (int dt = 0; dt < 4; ++dt) {
      float4* a = (float4*)(ACCb + (aoff + qt * 64 + 16 * dt));
      float4 o = *a;
      o.x += O[qt][dt][0] * sc; o.y += O[qt][dt][1] * sc; o.z += O[qt][dt][2] * sc; o.w += O[qt][dt][3] * sc;
      *a = o;
    }
  }
  RESET_STATE()
  if (usefix) { m[0] = nb_w[0]; m[1] = nb_w[1]; }
  {
    const __amdgpu_buffer_rsrc_t rK = MAKE_RSRC((const u16*)(p->ws + OFF_KW) + (size_t)bg * S_ * 64);
    const __amdgpu_buffer_rsrc_t rV = MAKE_RSRC((const u16*)(p->ws + OFF_VWT) + (size_t)bg * 64 * S_);
    const int j0 = i >= 8 ? i - 8 : 0;
    ISSUE_TILE(rK, rV, j0, S_)
    for (int j = j0; j <= i; ++j) {
      __syncthreads();
      COMMIT_TILE()
      __syncthreads();
      if (j + 1 <= i) ISSUE_TILE(rK, rV, j + 1, S_)
      if (j == i || j == i - 8) {
        auto ok = [&](int kt, int ii) {
          const int kp = j * 64 + 16 * kt + 4 * lg + ii;
          return kp <= tq && kp > tq - 512;
        };
        if (usefix) flash_tile<3, true>(sK, sV, qf, O, m, l, ps, ok, true, lane);
        else flash_tile<2, true>(sK, sV, qf, O, m, l, ps, ok, true, lane);
      } else {
        if (usefix) flash_tile<3, false>(sK, sV, qf, O, m, l, ps, nomask, true, lane);
        else flash_tile<2, false>(sK, sV, qf, O, m, l, ps, nomask, true, lane);
      }
    }
  }
  u16* NSAb = (u16*)(p->ws + OFF_NSA);
#pragma unroll
  for (int qt = 0; qt < 2; ++qt) {
    float s = l[qt];
    s += __shfl_xor(s, 16);
    s += __shfl_xor(s, 32);
    const float sc = NGb[ngoff + qt * 3 + 2] / s;
#pragma unroll
    for (int dt = 0; dt < 4; ++dt) {
      const float4 a = *(const float4*)(ACCb + (aoff + qt * 64 + 16 * dt));
      uint2 o;
      o.x = pk2(a.x + O[qt][dt][0] * sc, a.y + O[qt][dt][1] * sc);
      o.y = pk2(a.z + O[qt][dt][2] * sc, a.w + O[qt][dt][3] * sc);
      *(uint2*)(NSAb + (aoff + qt * 64 + 16 * dt)) = o;
    }
  }
  __syncthreads();
}

DI void phaseE(int wv0, PP p, unsigned char* smem, int cidx) {
  __shared__ int s_item;
  int* ctr = (int*)(p->ws + OFF_CTR) + cidx;
  for (;;) {
    __syncthreads();
    if (my_tid(wv0) == 0) s_item = atomicAdd(ctr, 1);
    __syncthreads();
    const int item = s_item;
    if (item >= 1024 + 2048) break;
    if (item < 1024) nsa_item(wv0, p, item, smem);
    else s5_item<true>(wv0, p, item - 1024, smem);
  }
}

DI void phaseF(int wv0, PP p, unsigned char* smem) {
  const u16* YS = (const u16*)(p->ws + OFF_YS);
  const u16* NSA = (const u16*)(p->ws + OFF_NSA);
  const u16* MG = (const u16*)(p->ws + OFF_MG);
  u16* MR = (u16*)(p->ws + OFF_MERGED);
  for (int id = blockIdx.x; id < 128 * 4; id += gridDim.x) {
    const int pm = id >> 2, pn = id & 3, brow = pm * 256, bcol = pn * 256;
    f32x4 acc[2][2][4][2];
    gemm256(wv0, acc, YS + (size_t)brow * 512, 512, (const u16*)(p->ws + OFF_WGT) + (size_t)bcol * 512, 512, 512, smem);
    epi256(wv0, acc, brow, bcol, [&](int ai, int bj, int m, int n, int row0, int col, f32x4& v) {
#pragma unroll
      for (int i = 0; i < 4; ++i) MR[(size_t)(row0 + i) * 1024 + col] = f2bf(sigmoidf_(v[i]));
    });
    gemm256(wv0, acc, YS + (size_t)brow * 512, 512, (const u16*)(p->ws + OFF_WVT) + (size_t)bcol * 512, 512, 512, smem);
    epi256(wv0, acc, brow, bcol, [&](int ai, int bj, int m, int n, int row0, int col, f32x4& v) {
#pragma unroll
      for (int i = 0; i < 4; ++i) {
        const size_t o = (size_t)(row0 + i) * 1024 + col;
        const float gb = bf2f(MG[(size_t)(row0 + i) * 2048 + 1024 + col]);
        MR[o] = f2bf(gb * v[i] * bf2f(MR[o]));
      }
    });
    gemm256(wv0, acc, NSA + (size_t)brow * 512, 512, (const u16*)(p->ws + OFF_WAT) + (size_t)bcol * 512, 512, 512, smem);
    epi256(wv0, acc, brow, bcol, [&](int ai, int bj, int m, int n, int row0, int col, f32x4& v) {
#pragma unroll
      for (int i = 0; i < 4; ++i) {
        const size_t o = (size_t)(row0 + i) * 1024 + col;
        const float ga = bf2f(MG[(size_t)(row0 + i) * 2048 + col]);
        MR[o] = f2bf(ga * v[i] + bf2f(MR[o]));
      }
    });
  }
}
DI void ss_partial(int wv0, f32x4 (&acc)[2][2][4][2], float* SS, int brow, int pn) {
  const int lane = my_tid(wv0) & 63, wr = wv0 >> 2, wc = wv0 & 3;
#pragma unroll
  for (int ai = 0; ai < 2; ++ai)
#pragma unroll
    for (int m = 0; m < 4; ++m)
#pragma unroll
      for (int i = 0; i < 4; ++i) {
        float s = acc[ai][0][m][0][i] * acc[ai][0][m][0][i] + acc[ai][0][m][1][i] * acc[ai][0][m][1][i] +
                  acc[ai][1][m][0][i] * acc[ai][1][m][0][i] + acc[ai][1][m][1][i] * acc[ai][1][m][1][i];
        s += __shfl_xor(s, 1);
        s += __shfl_xor(s, 2);
        s += __shfl_xor(s, 4);
        s += __shfl_xor(s, 8);
        if ((lane & 15) == 0) SS[(size_t)(brow + ai * 128 + wr * 64 + m * 16 + (lane >> 4) * 4 + i) * 16 + pn * 4 + wc] = s;
      }
}
DI void phaseG(int wv0, PP p, unsigned char* smem) {
  const u16* MR = (const u16*)(p->ws + OFF_MERGED);
  u16* X1B = (u16*)(p->ws + OFF_X1B);
  float* SS1 = (float*)(p->ws + OFF_SS1);
  for (int id = blockIdx.x; id < 128 * 4; id += gridDim.x) {
    const int pm = id >> 2, pn = id & 3, brow = pm * 256, bcol = pn * 256;
    f32x4 acc[2][2][4][2];
    gemm256(wv0, acc, MR + (size_t)brow * 1024, 1024, (const u16*)(p->ws + OFF_WOT) + (size_t)bcol * 1024, 1024, 1024, smem);
    epi256(wv0, acc, brow, bcol, [&](int ai, int bj, int m, int n, int row0, int col, f32x4& v) {
#pragma unroll
      for (int i = 0; i < 4; ++i) {
        const size_t o = (size_t)(row0 + i) * 1024 + col;
        const float x1 = v[i] + p->x[o];
        p->out[o] = x1;
        X1B[o] = f2bf(x1);
        v[i] = x1;
      }
    });
    ss_partial(wv0, acc, SS1, brow, pn);
  }
}
DI void phaseH(int wv0, PP p, unsigned char* smem) {
  const u16* X1B = (const u16*)(p->ws + OFF_X1B);
  const float* SS1 = (const float*)(p->ws + OFF_SS1);
  u16* ACT = (u16*)(p->ws + OFF_ACT);
  float* sR = (float*)(smem + 131072);
  for (int id = blockIdx.x; id < 128 * 16; id += gridDim.x) {
    const int pm = id >> 4, pn = id & 15, brow = pm * 256, bcol = pn * 256;
    const int tid = my_tid(wv0);
    if (tid < 256) {
      const float4* s = (const float4*)(SS1 + (size_t)(brow + tid) * 16);
      const float4 a = s[0], b = s[1], c = s[2], d = s[3];
      const float t = a.x + a.y + a.z + a.w + b.x + b.y + b.z + b.w + c.x + c.y + c.z + c.w + d.x + d.y + d.z + d.w;
      sR[tid] = rsqrtf(t * (1.f / 1024.f) + 1e-6f);
    }
    f32x4 acc[2][2][4][2];
    gemm256(wv0, acc, X1B + (size_t)brow * 1024, 1024, (const u16*)(p->ws + OFF_WUPT) + (size_t)bcol * 1024, 1024, 1024, smem);
    epi256(wv0, acc, brow, bcol, [&](int ai, int bj, int m, int n, int row0, int col, f32x4& v) {
#pragma unroll
      for (int i = 0; i < 4; ++i) {
        float a = fmaxf(v[i] * sR[row0 + i - brow], 0.f);
        ACT[(size_t)(row0 + i) * 4096 + col] = f2bf(a * a);
      }
    });
    __syncthreads();
  }
}
DI void phaseI(int wv0, PP p, unsigned char* smem) {
  const u16* ACT = (const u16*)(p->ws + OFF_ACT);
  float* SS2 = (float*)(p->ws + OFF_SS2);
  for (int id = blockIdx.x; id < 128 * 4; id += gridDim.x) {
    const int pm = id >> 2, pn = id & 3, brow = pm * 256, bcol = pn * 256;
    f32x4 acc[2][2][4][2];
    gemm256(wv0, acc, ACT + (size_t)brow * 4096, 4096, (const u16*)(p->ws + OFF_WDT) + (size_t)bcol * 4096, 4096, 4096, smem);
    epi256(wv0, acc, brow, bcol, [&](int ai, int bj, int m, int n, int row0, int col, f32x4& v) {
#pragma unroll
      for (int i = 0; i < 4; ++i) {
        const size_t o = (size_t)(row0 + i) * 1024 + col;
        const float x2 = v[i] + p->out[o];
        p->out[o] = x2;
        v[i] = x2;
      }
    });
    ss_partial(wv0, acc, SS2, brow, pn);
  }
}
DI void phaseJ(int wv0, PP p) {
  const int lane = my_tid(wv0) & 63;
  const float* SS2 = (const float*)(p->ws + OFF_SS2);
  for (int row = blockIdx.x * 8 + wv0; row < T_; row += gridDim.x * 8) {
    float t = (lane < 16) ? SS2[(size_t)row * 16 + lane] : 0.f;
    t = wave_sum(t);
    const float rinv = rsqrtf(t * (1.f / 1024.f) + 1e-6f);
    float4* xr = (float4*)(p->out + (size_t)row * 1024);
#pragma unroll
    for (int r = 0; r < 4; ++r) {
      float4 v = xr[lane + 64 * r];
      const float4 g = ((const float4*)p->g3)[lane + 64 * r];
      v.x *= rinv * g.x; v.y *= rinv * g.y; v.z *= rinv * g.z; v.w *= rinv * g.w;
      xr[lane + 64 * r] = v;
    }
  }
}

__global__ void __launch_bounds__(512, 2) mega(Params p) {
  extern __shared__ __attribute__((aligned(16))) unsigned char smem[];
  const int wv0 = __builtin_amdgcn_readfirstlane((int)(threadIdx.x >> 6));
  const int lo = p.lo, hi = p.hi;
  PP kp0 = (PP)__builtin_amdgcn_kernarg_segment_ptr();
#define PH(N, CALL)                                  \
  if (lo <= N && N < hi) {                           \
    if (N > lo) cg::this_grid().sync();              \
    PP kp = kp0;                                     \
    asm volatile("" : "+s"(kp));                     \
    CALL;                                            \
    if ((PROBE_MASK >> N) & 1) { CALL; }             \
  }
  PH(0, phaseA(wv0, kp, smem))
  PH(1, phaseB(wv0, kp, smem))
  PH(2, phaseC(wv0, kp, smem))
  PH(3, phaseD(wv0, kp, smem))
  PH(4, phaseE(wv0, kp, smem, 0))
  if ((PROBE_MASK >> 10) & 1) { PP kp = kp0; asm volatile("" : "+s"(kp)); phaseE(wv0, kp, smem, 1); }
  PH(5, phaseF(wv0, kp, smem))
  PH(6, phaseG(wv0, kp, smem))
  PH(7, phaseH(wv0, kp, smem))
  PH(8, phaseI(wv0, kp, smem))
  PH(9, phaseJ(wv0, kp))
}

extern "C" void kernel_launch(void* const* d_in, const int* in_sizes, int n_in, void* d_out, int out_size, void* d_ws,
                              size_t ws_size, hipStream_t stream) {
  static int grid_blocks = 0;
  if (!grid_blocks) {
    int dev = 0, cus = 0, per_cu = 0;
    (void)hipGetDevice(&dev);
    (void)hipDeviceGetAttribute(&cus, hipDeviceAttributeMultiprocessorCount, dev);
    (void)hipFuncSetAttribute((const void*)mega, hipFuncAttributeMaxDynamicSharedMemorySize, SMEM_BYTES);
    (void)hipOccupancyMaxActiveBlocksPerMultiprocessor(&per_cu, mega, NT_, SMEM_BYTES);
    if (per_cu > 1) per_cu = 1;
    if (per_cu < 1) per_cu = 1;
    grid_blocks = cus * per_cu;
  }
  if (ws_size < WS_NEED) { fprintf(stderr, "workspace too small: %zu < %zu\n", ws_size, (size_t)WS_NEED); }
  Params p{};
  const float** f = (const float**)&p;
  for (int i = 0; i < 24; ++i) f[i] = (const float*)d_in[i];
  p.out = (float*)d_out;
  p.ws = (unsigned char*)d_ws;
  p.lo = 0; p.hi = 10;
  void* args[] = {&p};
  hipError_t e = hipLaunchCooperativeKernel((void*)mega, dim3(grid_blocks), dim3(NT_), args, SMEM_BYTES, stream);
  if (e != hipSuccess) fprintf(stderr, "cooperative launch failed: %s (grid %d)\n", hipGetErrorString(e), grid_blocks);
}
```

```cpp
#include <hip/hip_runtime.h>
#include <hip/hip_cooperative_groups.h>
#include <cstdio>
namespace cg = cooperative_groups;

#ifndef PROBE_MASK
#define PROBE_MASK 0
#endif

#define DI __device__ __forceinline__
typedef unsigned short u16;
typedef unsigned long long u64;
using bf16x8 = __attribute__((ext_vector_type(8))) short;
using f32x4 = __attribute__((ext_vector_type(4))) float;
using u32x4 = __attribute__((ext_vector_type(4))) unsigned;

constexpr int B_ = 4, S_ = 8192, T_ = B_ * S_;
constexpr int NT_ = 512;
constexpr int NINP = 4096;
constexpr float QSCALE = 0.125f * 1.44269504089f;

constexpr size_t MB = 1024 * 1024;
constexpr size_t OFF_WINT = 0;
constexpr size_t OFF_W1KT = OFF_WINT + (size_t)NINP * 1024 * 2;
constexpr size_t OFF_W1VT = OFF_W1KT + 256 * 2048 * 2;
constexpr size_t OFF_W2KT = OFF_W1VT + 256 * 2048 * 2;
constexpr size_t OFF_W2VT = OFF_W2KT + 256 * 256 * 2;
constexpr size_t OFF_WAT = OFF_W2VT + 256 * 256 * 2;
constexpr size_t OFF_WVT = OFF_WAT + 1024 * 512 * 2;
constexpr size_t OFF_WGT = OFF_WVT + 1024 * 512 * 2;
constexpr size_t OFF_WOT = OFF_WGT + 1024 * 512 * 2;
constexpr size_t OFF_WUPT = OFF_WOT + 1024 * 1024 * 2;
constexpr size_t OFF_WDT = OFF_WUPT + 4096 * 1024 * 2;
constexpr size_t OFF_ROPE = OFF_WDT + 4096 * 1024 * 2;
constexpr size_t OFF_CBP = OFF_ROPE + 8192 * 16 * 4;
constexpr size_t OFF_CTR = OFF_CBP + 2 * 32 * 256 * 4;
constexpr size_t OFF_KMAX = OFF_CTR + 64;
constexpr size_t OFF_SS1 = OFF_CTR + 256;
constexpr size_t OFF_SS2 = OFF_SS1 + (size_t)T_ * 16 * 4;
constexpr size_t OFF_NG = OFF_SS2 + (size_t)T_ * 16 * 4;
constexpr size_t OFF_HC = OFF_NG + (size_t)T_ * 24 * 4;
constexpr size_t OFF_KCC = OFF_HC + 2 * 4096 * 256 * 2;
constexpr size_t OFF_VCT = OFF_KCC + 8 * 512 * 64 * 2;
constexpr size_t OFF_HLOC = OFF_VCT + 8 * 512 * 64 * 2;
constexpr size_t OFF_ARENA = OFF_HLOC + (size_t)4 * 128 * 32 * 64 * 8;
constexpr size_t OFF_MG = OFF_ARENA;
constexpr size_t OFF_HN = OFF_ARENA + 128 * MB;
constexpr size_t OFF_QRAW = OFF_ARENA + 192 * MB;
constexpr size_t OFF_QROT = OFF_ARENA + 224 * MB;
constexpr size_t OFF_KCIN = OFF_ARENA + 256 * MB;
constexpr size_t OFF_VCIN = OFF_KCIN + 8 * MB;
constexpr size_t OFF_KS = OFF_VCIN + 8 * MB;
constexpr size_t OFF_VST = OFF_KS + 8 * MB;
constexpr size_t OFF_KW = OFF_VST + 8 * MB;
constexpr size_t OFF_VWT = OFF_KW + 8 * MB;
constexpr size_t OFF_U = OFF_ARENA + 304 * MB;
constexpr size_t OFF_NSA = OFF_ARENA + 336 * MB;
constexpr size_t OFF_YS = OFF_ARENA + 368 * MB;
constexpr size_t WS_NEED = OFF_ARENA + 400 * MB;
constexpr size_t OFF_ACT = OFF_ARENA;
constexpr size_t OFF_X1B = OFF_ARENA + 256 * MB;
constexpr size_t OFF_MERGED = OFF_HN;

constexpr int SMEM_BYTES = 131072 + 1024;

struct Params {
  const float *x, *g1, *w_in, *pe, *kw1, *kw2, *vw1, *vw2, *lam_re, *lam_im, *log_step, *b_re, *b_im, *c_re, *c_im, *dsk,
      *w_attn, *w_val, *w_gate, *w_out, *g2, *w_up, *w_down, *g3;
  float* out;
  unsigned char* ws;
  int lo, hi;
};

typedef const __attribute__((address_space(4))) Params* PP;

DI int my_tid(int wv0) {
  int t = wv0 * 64 + (int)__lane_id();
  asm volatile("" : "+v"(t));
  return t;
}
DI u16 f2bf(float x) { unsigned u = __float_as_uint(x); u += 0x7fffu + ((u >> 16) & 1u); return (u16)(u >> 16); }
DI float bf2f(u16 h) { return __uint_as_float(((unsigned)h) << 16); }
DI unsigned pk2(float a, float b) { return (unsigned)f2bf(a) | ((unsigned)f2bf(b) << 16); }
DI uint2 pk4(float a, float b, float c, float d) { uint2 o; o.x = pk2(a, b); o.y = pk2(c, d); return o; }
DI float sigmoidf_(float x) { return 1.f / (1.f + __expf(-x)); }
DI float gelu_t(float x) {
  float u = 0.7978845608f * (x + 0.044715f * x * x * x);
  float e = __expf(2.f * u);
  float th = 1.f - 2.f / (e + 1.f);
  return 0.5f * x * (1.f + th);
}
DI float wave_sum(float v) {
#pragma unroll
  for (int o = 32; o > 0; o >>= 1) v += __shfl_xor(v, o);
  return v;
}
template <class T> DI T* launder(T* p) { asm volatile("" : "+v"(p)); return p; }
DI void wave_sync() { asm volatile("s_waitcnt lgkmcnt(0)" ::: "memory"); }
DI f32x4 mfma16(bf16x8 a, bf16x8 b, f32x4 c) { return __builtin_amdgcn_mfma_f32_16x16x32_bf16(a, b, c, 0, 0, 0); }

constexpr int G_HT = 128 * 64;
DI int lds_byte(int r, int c) {
  const int st = (r >> 4) * 2 + (c >> 5), rr = r & 15, cc = c & 31, ob = rr * 64 + cc * 2;
  return st * 1024 + (ob ^ (((ob >> 9) & 1) << 5));
}
DI void stage_rc(int b, int& R, int& C) {
  const int st = b / 1024, sb = b % 1024, swz = sb ^ (((sb >> 9) & 1) << 5);
  R = (st >> 1) * 16 + swz / 64;
  C = (st & 1) * 32 + (swz % 64) / 2;
}
typedef __attribute__((address_space(3))) unsigned* lds_u32p;
DI void gemm256(int wv0, f32x4 (&acc)[2][2][4][2], const u16* __restrict__ A, int lda, const u16* __restrict__ Bt, int ldb,
                int K, unsigned char* smem) {
  u16* shm = (u16*)smem;
  const int tid = my_tid(wv0), lane = tid & 63;
  const int wr = wv0 >> 2, wc = wv0 & 3, fr = lane & 15, fq = lane >> 4;
#define SA(b, h) (shm + ((b)*2 + (h)) * G_HT)
#define SB(b, h) (shm + (4 + (b)*2 + (h)) * G_HT)
  int sr0, sc0, sr1, sc1;
  stage_rc(tid * 16, sr0, sc0);
  stage_rc(tid * 16 + 8192, sr1, sc1);
  const u16* a0 = A + (size_t)sr0 * lda + sc0;
  const u16* a1 = A + (size_t)sr1 * lda + sc1;
  const u16* b0 = Bt + (size_t)sr0 * ldb + sc0;
  const u16* b1 = Bt + (size_t)sr1 * ldb + sc1;
#define STAGE_A(P, half, kt)                                                                                              \
  {                                                                                                                       \
    __builtin_amdgcn_global_load_lds((const unsigned*)(a0 + (size_t)((half)*128) * lda + (kt)*64),                        \
                                     (unsigned*)((char*)(P) + tid * 16), 16, 0, 0);                               \
    __builtin_amdgcn_global_load_lds((const unsigned*)(a1 + (size_t)((half)*128) * lda + (kt)*64),                        \
                                     (unsigned*)((char*)(P) + tid * 16 + 8192), 16, 0, 0);                        \
  }
#define STAGE_B(P, half, kt)                                                                                              \
  {                                                                                                                       \
    __builtin_amdgcn_global_load_lds((const unsigned*)(b0 + (size_t)((half)*128) * ldb + (kt)*64),                        \
                                     (unsigned*)((char*)(P) + tid * 16), 16, 0, 0);                               \
    __builtin_amdgcn_global_load_lds((const unsigned*)(b1 + (size_t)((half)*128) * ldb + (kt)*64),                        \
                                     (unsigned*)((char*)(P) + tid * 16 + 8192), 16, 0, 0);                        \
  }
#define LDA(dst, b, h)                                                                                                    \
  _Pragma("unroll") for (int m = 0; m < 4; ++m) _Pragma("unroll") for (int k = 0; k < 2; ++k)                             \
      dst[m][k] = *(const bf16x8*)((const unsigned char*)SA(b, h) + lds_byte(wr * 64 + m * 16 + fr, k * 32 + fq * 8));
#define LDB(dst, b, h)                                                                                                    \
  _Pragma("unroll") for (int n = 0; n < 2; ++n) _Pragma("unroll") for (int k = 0; k < 2; ++k)                             \
      dst[n][k] = *(const bf16x8*)((const unsigned char*)SB(b, h) + lds_byte(wc * 32 + n * 16 + fr, k * 32 + fq * 8));
#define MMA(ai, bj, At_, Bt_)                                                                                             \
  {                                                                                                                       \
    __builtin_amdgcn_s_setprio(1);                                                                                        \
    _Pragma("unroll") for (int m = 0; m < 4; ++m) _Pragma("unroll") for (int n = 0; n < 2; ++n)                           \
        _Pragma("unroll") for (int k = 0; k < 2; ++k) acc[ai][bj][m][n] =                                                 \
            __builtin_amdgcn_mfma_f32_16x16x32_bf16(Bt_[n][k], At_[m][k], acc[ai][bj][m][n], 0, 0, 0);                    \
    __builtin_amdgcn_s_setprio(0);                                                                                        \
  }
#define WAIT_V(n) asm volatile("s_waitcnt vmcnt(" #n ")" ::: "memory")
#define WAIT_L(n) asm volatile("s_waitcnt lgkmcnt(" #n ")" ::: "memory")
#define BAR __builtin_amdgcn_s_barrier()
#define SCHED __builtin_amdgcn_sched_barrier(0)
#pragma unroll
  for (int a = 0; a < 2; ++a)
#pragma unroll
    for (int b = 0; b < 2; ++b)
#pragma unroll
      for (int m = 0; m < 4; ++m)
#pragma unroll
        for (int n = 0; n < 2; ++n) acc[a][b][m][n] = f32x4{0.f, 0.f, 0.f, 0.f};
  bf16x8 At[4][2], B0[2][2], B1[2][2];
  const int nt = K / 64;
  WAIT_V(0);
  __syncthreads();
  STAGE_B(SB(0, 0), 0, 0) STAGE_A(SA(0, 0), 0, 0)
  STAGE_B(SB(0, 1), 1, 0) STAGE_A(SA(0, 1), 1, 0)
  if (wr == 1) BAR;
  WAIT_V(4); BAR;
  STAGE_B(SB(1, 0), 0, 1) STAGE_A(SA(1, 0), 0, 1) STAGE_B(SB(1, 1), 1, 1)
  WAIT_V(6); BAR;
#pragma unroll 1
  for (int t = 0; t < nt - 2; t += 2) {
    LDB(B0, 0, 0) SCHED; LDA(At, 0, 0) STAGE_A(SA(1, 1), 1, t + 1)
    WAIT_L(8); BAR; WAIT_L(0); MMA(0, 0, At, B0) BAR; SCHED;
    LDB(B1, 0, 1) STAGE_B(SB(0, 0), 0, t + 2)
    BAR; WAIT_L(0); MMA(0, 1, At, B1) BAR;
    LDA(At, 0, 1) STAGE_A(SA(0, 0), 0, t + 2)
    BAR; WAIT_L(0); MMA(1, 0, At, B0) BAR; SCHED;
    STAGE_B(SB(0, 1), 1, t + 2)
    WAIT_V(6); BAR; MMA(1, 1, At, B1) BAR;
    LDB(B0, 1, 0) SCHED; LDA(At, 1, 0) STAGE_A(SA(0, 1), 1, t + 2)
    WAIT_L(8); BAR; WAIT_L(0); MMA(0, 0, At, B0) BAR; SCHED;
    LDB(B1, 1, 1) STAGE_B(SB(1, 0), 0, t + 3)
    BAR; WAIT_L(0); MMA(0, 1, At, B1) BAR;
    LDA(At, 1, 1) STAGE_A(SA(1, 0), 0, t + 3)
    BAR; WAIT_L(0); MMA(1, 0, At, B0) BAR; SCHED;
    STAGE_B(SB(1, 1), 1, t + 3)
    WAIT_V(6); BAR; MMA(1, 1, At, B1) BAR;
  }
  {
    LDB(B0, 0, 0) LDA(At, 0, 0) STAGE_A(SA(1, 1), 1, nt - 1)
    BAR; WAIT_L(0); MMA(0, 0, At, B0) BAR;
    LDB(B1, 0, 1) BAR; WAIT_L(0); MMA(0, 1, At, B1) BAR;
    LDA(At, 0, 1) WAIT_V(4); BAR; WAIT_L(0); MMA(1, 0, At, B0) MMA(1, 1, At, B1) BAR;
  }
  {
    LDB(B0, 1, 0) LDA(At, 1, 0) WAIT_V(2); BAR; WAIT_L(0); MMA(0, 0, At, B0) BAR;
    LDB(B1, 1, 1) WAIT_V(0); BAR; WAIT_L(0); MMA(0, 1, At, B1) BAR;
    LDA(At, 1, 1) BAR; WAIT_L(0); MMA(1, 0, At, B0) MMA(1, 1, At, B1) BAR;
  }
  if (wr == 0) BAR;
}
template <class F>
DI void epi256(int wv0, f32x4 (&acc)[2][2][4][2], int brow, int bcol, F f) {
  const int lane = my_tid(wv0) & 63, wr = wv0 >> 2, wc = wv0 & 3;
#pragma unroll
  for (int ai = 0; ai < 2; ++ai)
#pragma unroll
    for (int bj = 0; bj < 2; ++bj)
#pragma unroll
      for (int m = 0; m < 4; ++m)
#pragma unroll
        for (int n = 0; n < 2; ++n) {
          const int row = brow + ai * 128 + wr * 64 + m * 16 + (lane & 15);
          const int col0 = bcol + bj * 128 + wc * 32 + n * 16 + (lane >> 4) * 4;
          f(ai, bj, m, n, row, col0, acc[ai][bj][m][n]);
          if (n == 1 && (m & 1)) __builtin_amdgcn_sched_barrier(0);
        }
}

DI void phaseA(int wv0, PP p, unsigned char* smem) {
  const int tid = my_tid(wv0), lane = tid & 63;
  u16* HN = (u16*)(p->ws + OFF_HN);
  for (int row = blockIdx.x * 8 + wv0; row < T_; row += gridDim.x * 8) {
    const float4* xr = (const float4*)(p->x + (size_t)row * 1024);
    float4 v[4];
    float ss = 0.f;
#pragma unroll
    for (int r = 0; r < 4; ++r) {
      v[r] = xr[lane + 64 * r];
      ss += v[r].x * v[r].x + v[r].y * v[r].y + v[r].z * v[r].z + v[r].w * v[r].w;
    }
    ss = wave_sum(ss);
    const float rinv = rsqrtf(ss * (1.f / 1024.f) + 1e-6f);
#pragma unroll
    for (int r = 0; r < 4; ++r) {
      const float4 g = ((const float4*)p->g1)[lane + 64 * r];
      uint2 o;
      o.x = pk2(v[r].x * rinv * g.x, v[r].y * rinv * g.y);
      o.y = pk2(v[r].z * rinv * g.z, v[r].w * rinv * g.w);
      *(uint2*)(HN + (size_t)row * 1024 + (lane + 64 * r) * 4) = o;
    }
  }
  float* tile = (float*)smem;
  constexpr int NXT = 1024 + 128 + 128 + 16 + 16 + 128 * 3 + 256 + 1024 + 1024;
  for (int jt = blockIdx.x; jt < NXT + 32; jt += gridDim.x) {
    if (jt < NXT) {
      int t = jt;
      const float* src;
      u16* dst;
      int K, Nsrc, mode = 0;
      const float* scl = nullptr;
      if (t < 1024) { src = p->w_in; dst = (u16*)(p->ws + OFF_WINT); K = 1024; Nsrc = 3864; mode = 1; }
      else if ((t -= 1024) < 128) { src = p->kw1; dst = (u16*)(p->ws + OFF_W1KT); K = 2048; Nsrc = 256; }
      else if ((t -= 128) < 128) { src = p->vw1; dst = (u16*)(p->ws + OFF_W1VT); K = 2048; Nsrc = 256; }
      else if ((t -= 128) < 16) { src = p->kw2; dst = (u16*)(p->ws + OFF_W2KT); K = 256; Nsrc = 64; mode = 2; }
      else if ((t -= 16) < 16) { src = p->vw2; dst = (u16*)(p->ws + OFF_W2VT); K = 256; Nsrc = 64; mode = 2; }
      else if ((t -= 16) < 128) { src = p->w_attn; dst = (u16*)(p->ws + OFF_WAT); K = 512; Nsrc = 1024; }
      else if ((t -= 128) < 128) { src = p->w_val; dst = (u16*)(p->ws + OFF_WVT); K = 512; Nsrc = 1024; }
      else if ((t -= 128) < 128) { src = p->w_gate; dst = (u16*)(p->ws + OFF_WGT); K = 512; Nsrc = 1024; }
      else if ((t -= 128) < 256) { src = p->w_out; dst = (u16*)(p->ws + OFF_WOT); K = 1024; Nsrc = 1024; }
      else if ((t -= 256) < 1024) { src = p->w_up; dst = (u16*)(p->ws + OFF_WUPT); K = 1024; Nsrc = 4096; scl = p->g2; }
      else { t -= 1024; src = p->w_down; dst = (u16*)(p->ws + OFF_WDT); K = 4096; Nsrc = 1024; }
      const int nkt = K >> 6, tn = t / nkt, tk = t % nkt, n0 = tn * 64, k0 = tk * 64;
      const int tx = tid & 63, ty = tid >> 6;
      const int np = n0 + tx;
      int sc = np;
      if (mode == 1) {
        if (np < 1280) sc = np;
        else if (np < 1792) sc = 1304 + (np - 1280);
        else if (np < 3840) sc = 1816 + (np - 1792);
        else if (np < 3864) sc = 1280 + (np - 3840);
        else sc = -1;
      } else if (mode == 2) {
        sc = np < 64 ? np : -1;
      }
      for (int kk = ty; kk < 64; kk += 8) {
        float val = 0.f;
        if (sc >= 0) val = src[(size_t)(k0 + kk) * Nsrc + sc];
        if (scl) val *= scl[k0 + kk];
        tile[kk * 65 + tx] = val;
      }
      __syncthreads();
      {
        const int n = tid >> 3, kc = tid & 7;
        uint4 o;
        o.x = pk2(tile[(kc * 8 + 0) * 65 + n], tile[(kc * 8 + 1) * 65 + n]);
        o.y = pk2(tile[(kc * 8 + 2) * 65 + n], tile[(kc * 8 + 3) * 65 + n]);
        o.z = pk2(tile[(kc * 8 + 4) * 65 + n], tile[(kc * 8 + 5) * 65 + n]);
        o.w = pk2(tile[(kc * 8 + 6) * 65 + n], tile[(kc * 8 + 7) * 65 + n]);
        *(uint4*)(dst + (size_t)(n0 + n) * K + k0 + kc * 8) = o;
      }
      __syncthreads();
    } else {
      const int item = jt - NXT, kv = item >> 4, slice = item & 15;
      const float* w1 = kv ? p->vw1 : p->kw1;
      const int col = tid & 255, h = tid >> 8, kb = slice * 128 + h * 64;
      float s0 = 0.f, s1 = 0.f, s2 = 0.f, s3 = 0.f;
      for (int k = kb; k < kb + 64; k += 4) {
        s0 += p->pe[k] * w1[(size_t)k * 256 + col];
        s1 += p->pe[k + 1] * w1[(size_t)(k + 1) * 256 + col];
        s2 += p->pe[k + 2] * w1[(size_t)(k + 2) * 256 + col];
        s3 += p->pe[k + 3] * w1[(size_t)(k + 3) * 256 + col];
      }
      ((float*)(p->ws + OFF_CBP))[(kv * 32 + slice * 2 + h) * 256 + col] = (s0 + s1) + (s2 + s3);
    }
  }
  float* rope = (float*)(p->ws + OFF_ROPE);
  for (int i = blockIdx.x * NT_ + tid; i < S_ * 8; i += gridDim.x * NT_) {
    const int pos = i >> 3, k = i & 7;
    const float inv = powf(500000.0f, -(2.0f * (float)k) / 16.0f);
    const float ang = (float)pos * inv;
    rope[pos * 16 + k] = cosf(ang);
    rope[pos * 16 + 8 + k] = sinf(ang);
  }
  if (blockIdx.x == 0 && tid < 64) ((int*)(p->ws + OFF_CTR))[tid] = 0;
}

DI void phaseB(int wv0, PP p, unsigned char* smem) {
  const u16* HN = (const u16*)(p->ws + OFF_HN);
  const u16* WT = (const u16*)(p->ws + OFF_WINT);
  const float* rope = (const float*)(p->ws + OFF_ROPE);
  const int lane = my_tid(wv0) & 63;
  const bool ropewave = (wv0 & 1) == 0;
  for (int id = blockIdx.x; id < 128 * 16; id += gridDim.x) {
    const int pm = id >> 4, pn = id & 15, brow = pm * 256, bcol = pn * 256;
    f32x4 acc[2][2][4][2];
    gemm256(wv0, acc, HN + (size_t)brow * 1024, 1024, WT + (size_t)bcol * 1024, 1024, 1024, smem);
    if (pn < 2) {
      u16* QR = (u16*)(p->ws + OFF_QRAW);
      u16* QO = (u16*)(p->ws + OFF_QROT);
      epi256(wv0, acc, brow, bcol, [&](int ai, int bj, int m, int n, int row, int col0, f32x4& v) {
        f32x4 r = v;
        if (n == 0 && ropewave) {
          const int pos = row & (S_ - 1), kq = ((lane >> 4) & 1) * 4;
          const float4 c4 = *(const float4*)(rope + pos * 16 + kq), s4 = *(const float4*)(rope + pos * 16 + 8 + kq);
          const float cc[4] = {c4.x, c4.y, c4.z, c4.w}, ss[4] = {s4.x, s4.y, s4.z, s4.w};
#pragma unroll
          for (int j = 0; j < 4; ++j) {
            const float pr = __shfl_xor(v[j], 32);
            r[j] = (lane & 32) ? (v[j] * cc[j] + pr * ss[j]) : (v[j] * cc[j] - pr * ss[j]);
          }
        }
        *(uint2*)(QR + (size_t)row * 512 + col0) = pk4(v[0] * QSCALE, v[1] * QSCALE, v[2] * QSCALE, v[3] * QSCALE);
        *(uint2*)(QO + (size_t)row * 512 + col0) = pk4(r[0] * QSCALE, r[1] * QSCALE, r[2] * QSCALE, r[3] * QSCALE);
      });
    } else if (pn < 5) {
      epi256(wv0, acc, brow, bcol, [&](int ai, int bj, int m, int n, int row, int col0, f32x4& v) {
        const int sub = (pn - 2) * 2 + bj;
        const bool dorope = (sub == 2 || sub == 4), transposed = (sub == 3 || sub == 5);
        u16* dst = (u16*)(p->ws + OFF_KCIN + (size_t)sub * 8 * MB);
        const int c128 = col0 & 127, g = c128 >> 6, d0 = c128 & 63;
        const int b = row >> 13, sq = row & (S_ - 1);
        f32x4 r = v;
        if (dorope && n == 0 && ropewave) {
          const int kq = ((lane >> 4) & 1) * 4;
          const float4 c4 = *(const float4*)(rope + sq * 16 + kq), s4 = *(const float4*)(rope + sq * 16 + 8 + kq);
          const float cc[4] = {c4.x, c4.y, c4.z, c4.w}, ss[4] = {s4.x, s4.y, s4.z, s4.w};
#pragma unroll
          for (int j = 0; j < 4; ++j) {
            const float pr = __shfl_xor(v[j], 32);
            r[j] = (lane & 32) ? (v[j] * cc[j] + pr * ss[j]) : (v[j] * cc[j] - pr * ss[j]);
          }
        }
        if (transposed) {
#pragma unroll
          for (int j = 0; j < 4; ++j) dst[((size_t)((b * 2 + g) * 64 + d0 + j)) * S_ + sq] = f2bf(r[j]);
        } else {
          *(uint2*)(dst + ((size_t)(b * 2 + g) * S_ + sq) * 64 + d0) = pk4(r[0], r[1], r[2], r[3]);
        }
      });
    } else if (pn < 7) {
      u16* U = (u16*)(p->ws + OFF_U);
      epi256(wv0, acc, brow, bcol, [&](int ai, int bj, int m, int n, int row, int col0, f32x4& v) {
        *(uint2*)(U + (size_t)row * 512 + (col0 - 1280)) = pk4(v[0], v[1], v[2], v[3]);
      });
    } else if (pn < 15) {
      u16* MG = (u16*)(p->ws + OFF_MG);
      epi256(wv0, acc, brow, bcol, [&](int ai, int bj, int m, int n, int row, int col0, f32x4& v) {
        *(uint2*)(MG + (size_t)row * 2048 + (col0 - 1792)) = pk4(sigmoidf_(v[0]), sigmoidf_(v[1]), sigmoidf_(v[2]), sigmoidf_(v[3]));
      });
    } else {
      float* NG = (float*)(p->ws + OFF_NG);
      epi256(wv0, acc, brow, bcol, [&](int ai, int bj, int m, int n, int row, int col0, f32x4& v) {
        const int cc = col0 - 3840;
        if (cc < 24) *(float4*)(NG + (size_t)row * 24 + cc) = make_float4(sigmoidf_(v[0]), sigmoidf_(v[1]), sigmoidf_(v[2]), sigmoidf_(v[3]));
      });
    }
  }
}

struct S5c {
  float lbr, lbi;
  float br[16], bi[16];
};
DI void s5_setup(PP p, int g, int n, S5c& c) {
  const float step = expf(p->log_step[g]);
  const float lr = p->lam_re[g * 64 + n], li = p->lam_im[g * 64 + n];
  const float er = expf(lr * step);
  float sn, cs;
  sincosf(li * step, &sn, &cs);
  c.lbr = er * cs;
  c.lbi = er * sn;
  const float nr = c.lbr - 1.f, ni = c.lbi, den = lr * lr + li * li;
  const float cr = (nr * lr + ni * li) / den, ci = (ni * lr - nr * li) / den;
#pragma unroll
  for (int k = 0; k < 16; ++k) {
    const float bre = p->b_re[(g * 64 + n) * 16 + k], bim = p->b_im[(g * 64 + n) * 16 + k];
    c.br[k] = cr * bre - ci * bim;
    c.bi[k] = cr * bim + ci * bre;
  }
}
DI void s5_load_u(PP p, int b, int ch, int g, float* su, int lane) {
  const u16* U = (const u16*)(p->ws + OFF_U) + ((size_t)(b * S_ + ch * 64 + lane)) * 512 + g * 16;
  const uint4 a = *(const uint4*)U, c = *(const uint4*)(U + 8);
  float* d = su + lane * 16;
  const unsigned w[8] = {a.x, a.y, a.z, a.w, c.x, c.y, c.z, c.w};
#pragma unroll
  for (int k = 0; k < 8; ++k) {
    d[2 * k] = __uint_as_float(w[k] << 16);
    d[2 * k + 1] = __uint_as_float(w[k] & 0xffff0000u);
  }
}
DI void s5_step(const S5c& c, const float* ut, float& hr, float& hi) {
  float bur = 0.f, bui = 0.f;
#pragma unroll
  for (int k4 = 0; k4 < 4; ++k4) {
    const float4 u = *(const float4*)(ut + 4 * k4);
    bur += c.br[4 * k4] * u.x + c.br[4 * k4 + 1] * u.y + c.br[4 * k4 + 2] * u.z + c.br[4 * k4 + 3] * u.w;
    bui += c.bi[4 * k4] * u.x + c.bi[4 * k4 + 1] * u.y + c.bi[4 * k4 + 2] * u.z + c.bi[4 * k4 + 3] * u.w;
  }
  const float nr = c.lbr * hr - c.lbi * hi + bur;
  const float nim = c.lbr * hi + c.lbi * hr + bui;
  hr = nr;
  hi = nim;
}
template <bool OUT>
DI void s5_item(int wv0, PP p, int item, unsigned char* smem) {
  const int tid = my_tid(wv0), lane = tid & 63, fr = lane & 15, fq = lane >> 4;
  const int b = item >> 9, g = (item >> 4) & 31, c8 = item & 15, ch = c8 * 8 + wv0;
  u16* sBb = (u16*)smem;
  u16* sCm = sBb + 128 * 16;
  float* sBU = (float*)(smem + 8192) + wv0 * (16 * 132);
  u16* sH = (u16*)(smem + 8192 + 8 * 16 * 132 * 4) + wv0 * (16 * 136);
  const float step = expf(p->log_step[g]);
  for (int e = tid; e < 2048; e += NT_) {
    const int np = e >> 4, c = e & 15, n = np & 63;
    const float lr = p->lam_re[g * 64 + n], li = p->lam_im[g * 64 + n];
    const float er = expf(lr * step);
    float sn, cs;
    sincosf(li * step, &sn, &cs);
    const float nr = er * cs - 1.f, ni = er * sn, den = lr * lr + li * li;
    const float cr = (nr * lr + ni * li) / den, ci = (ni * lr - nr * li) / den;
    const float bre = p->b_re[(g * 64 + n) * 16 + c], bim = p->b_im[(g * 64 + n) * 16 + c];
    sBb[np * 16 + c] = f2bf(np < 64 ? (cr * bre - ci * bim) : (cr * bim + ci * bre));
  }
  if (OUT) {
    for (int e = tid; e < 2048; e += NT_) {
      const int cc = e >> 7, k = e & 127;
      sCm[cc * 128 + k] = f2bf(k < 64 ? p->c_re[(g * 16 + cc) * 64 + k] : -p->c_im[(g * 16 + cc) * 64 + (k - 64)]);
    }
  }
  float lbr, lbi;
  {
    const float lr = p->lam_re[g * 64 + lane], li = p->lam_im[g * 64 + lane];
    const float er = expf(lr * step);
    float sn, cs;
    sincosf(li * step, &sn, &cs);
    lbr = er * cs;
    lbi = er * sn;
  }
  float2* HL = (float2*)(p->ws + OFF_HLOC) + ((size_t)(b * 128 + ch) * 32 + g) * 64 + lane;
  float hr = 0.f, hi = 0.f;
  if (OUT) { const float2 h0 = *HL; hr = h0.x; hi = h0.y; }
  const u16* U = (const u16*)(p->ws + OFF_U) + ((size_t)(b * S_ + ch * 64)) * 512 + g * 16;
  u16* YS = (u16*)(p->ws + OFF_YS) + ((size_t)(b * S_ + ch * 64)) * 512 + g * 16;
  const float dk = p->dsk[g * 16 + fr];
  __syncthreads();
  const bf16x8 zero8 = {0, 0, 0, 0, 0, 0, 0, 0};
  bf16x8 bb[8], cf[4];
#pragma unroll
  for (int nt = 0; nt < 8; ++nt) bb[nt] = fq < 2 ? *(const bf16x8*)(sBb + (16 * nt + fr) * 16 + 8 * fq) : zero8;
  if (OUT) {
#pragma unroll
    for (int ks = 0; ks < 4; ++ks) cf[ks] = *(const bf16x8*)(sCm + fr * 128 + 32 * ks + 8 * fq);
  }
#pragma unroll 1
  for (int sub = 0; sub < 4; ++sub) {
    const bf16x8 ua = fq < 2 ? *(const bf16x8*)(U + (size_t)(sub * 16 + fr) * 512 + 8 * fq) : zero8;
#pragma unroll
    for (int nt = 0; nt < 8; ++nt) {
      const f32x4 a = mfma16(ua, bb[nt], f32x4{0.f, 0.f, 0.f, 0.f});
#pragma unroll
      for (int j = 0; j < 4; ++j) sBU[(4 * fq + j) * 132 + 16 * nt + fr] = a[j];
    }
    __syncthreads();
#pragma unroll 4
    for (int t = 0; t < 16; ++t) {
      const float bur = sBU[t * 132 + lane], bui = sBU[t * 132 + 64 + lane];
      const float nr = lbr * hr - lbi * hi + bur;
      const float nim = lbr * hi + lbi * hr + bui;
      hr = nr;
      hi = nim;
      if (OUT) {
        sH[t * 136 + lane] = f2bf(hr);
        sH[t * 136 + 64 + lane] = f2bf(hi);
      }
    }
    __syncthreads();
    if (OUT) {
      f32x4 y = {0.f, 0.f, 0.f, 0.f};
#pragma unroll
      for (int ks = 0; ks < 4; ++ks) y = mfma16(*(const bf16x8*)(sH + fr * 136 + 32 * ks + 8 * fq), cf[ks], y);
#pragma unroll
      for (int j = 0; j < 4; ++j) {
        const size_t o = (size_t)(sub * 16 + 4 * fq + j) * 512 + fr;
        YS[o] = f2bf(gelu_t(y[j] + dk * bf2f(U[o])));
      }
      __syncthreads();
    }
  }
  if (!OUT) *HL = make_float2(hr, hi);
  __syncthreads();
}
DI void s5_carry(int wv0, PP p) {
  const int x = blockIdx.x * NT_ + my_tid(wv0);
  if (x >= 8192) return;
  const int b = x >> 11, g = (x >> 6) & 31, n = x & 63;
  const float step = expf(p->log_step[g]);
  const float lr = p->lam_re[g * 64 + n], li = p->lam_im[g * 64 + n];
  const float er = expf(64.f * lr * step);
  float sn, cs;
  sincosf(64.f * li * step, &sn, &cs);
  const float Lr = er * cs, Li = er * sn;
  float2* HL = (float2*)(p->ws + OFF_HLOC) + (size_t)b * 128 * 2048 + g * 64 + n;
  float hr = 0.f, hi = 0.f;
  for (int c0 = 0; c0 < 128; c0 += 16) {
    float2 v[16];
#pragma unroll
    for (int k = 0; k < 16; ++k) v[k] = HL[(size_t)(c0 + k) * 2048];
#pragma unroll
    for (int k = 0; k < 16; ++k) {
      HL[(size_t)(c0 + k) * 2048] = make_float2(hr, hi);
      const float nr = Lr * hr - Li * hi + v[k].x;
      const float nim = Lr * hi + Li * hr + v[k].y;
      hr = nr;
      hi = nim;
    }
  }
}
DI void phaseC(int wv0, PP p, unsigned char* smem) {
  const float* cbp = (const float*)(p->ws + OFF_CBP);
  for (int id = blockIdx.x; id < 32 + 2048 + 256; id += gridDim.x) {
    if (id >= 32 + 2048) {
      const int it = id - (32 + 2048), tns = it >> 7, bg = (it >> 4) & 7, part = it & 15;
      const int tid = my_tid(wv0);
      const u16* K = (const u16*)(p->ws + (tns ? OFF_KW : OFF_KS)) + ((size_t)bg * S_ + part * 512 + tid) * 64;
      float q2 = 0.f;
#pragma unroll
      for (int c = 0; c < 8; ++c) {
        const uint4 w = *(const uint4*)(K + c * 8);
        const unsigned ww[4] = {w.x, w.y, w.z, w.w};
#pragma unroll
        for (int e = 0; e < 4; ++e) {
          const float a = __uint_as_float(ww[e] << 16), b2 = __uint_as_float(ww[e] & 0xffff0000u);
          q2 += a * a + b2 * b2;
        }
      }
#pragma unroll
      for (int o = 32; o > 0; o >>= 1) q2 = fmaxf(q2, __shfl_xor(q2, o));
      if ((tid & 63) == 0) atomicMax((unsigned*)(p->ws + OFF_KMAX) + tns * 8 + bg, __float_as_uint(q2));
    } else if (id < 32) {
      const int kv = id >> 4, pm = id & 15, brow = pm * 256;
      const u16* A = (const u16*)(p->ws + (kv ? OFF_VCIN : OFF_KCIN)) + (size_t)brow * 1024;
      const u16* Bt = (const u16*)(p->ws + (kv ? OFF_W1VT : OFF_W1KT));
      f32x4 acc[2][2][4][2];
      gemm256(wv0, acc, A, 1024, Bt, 2048, 2048, smem);
      u16* HC = (u16*)(p->ws + OFF_HC) + (size_t)kv * 4096 * 256;
      epi256(wv0, acc, brow, 0, [&](int ai, int bj, int m, int n, int row, int col0, f32x4& v) {
        float4 bb = make_float4(0.f, 0.f, 0.f, 0.f);
#pragma unroll 8
        for (int sl = 0; sl < 32; ++sl) {
          const float4 t = *(const float4*)(cbp + (kv * 32 + sl) * 256 + col0);
          bb.x += t.x; bb.y += t.y; bb.z += t.z; bb.w += t.w;
        }
        *(uint2*)(HC + (size_t)row * 256 + col0) = pk4(gelu_t(v[0] + bb.x), gelu_t(v[1] + bb.y), gelu_t(v[2] + bb.z), gelu_t(v[3] + bb.w));
      });
    } else {
      s5_item<false>(wv0, p, id - 32, smem);
    }
  }
}
DI void phaseD(int wv0, PP p, unsigned char* smem) {
  for (int id = blockIdx.x; id < 32; id += gridDim.x) {
    const int kv = id >> 4, pm = id & 15, brow = pm * 256;
    const u16* A = (const u16*)(p->ws + OFF_HC) + (size_t)kv * 4096 * 256 + (size_t)brow * 256;
    const u16* Bt = (const u16*)(p->ws + (kv ? OFF_W2VT : OFF_W2KT));
    f32x4 acc[2][2][4][2];
    gemm256(wv0, acc, A, 256, Bt, 256, 256, smem);
    u16* KCC = (u16*)(p->ws + OFF_KCC);
    u16* VCT = (u16*)(p->ws + OFF_VCT);
    epi256(wv0, acc, brow, 0, [&](int ai, int bj, int m, int n, int row, int col0, f32x4& v) {
      if (col0 < 64) {
        const int bg = row >> 9, nn = row & 511;
        f32x4 r = v;
        if (nn == 511) r = f32x4{0.f, 0.f, 0.f, 0.f};
        if (kv == 0) {
          *(uint2*)(KCC + ((size_t)bg * 512 + nn) * 64 + col0) = pk4(r[0], r[1], r[2], r[3]);
        } else {
#pragma unroll
          for (int j = 0; j < 4; ++j) VCT[((size_t)bg * 64 + col0 + j) * 512 + nn] = f2bf(r[j]);
        }
      }
    });
  }
  s5_carry(wv0, p);
}

DI bool bit128(u64 lo, u64 hi, int j) { return j < 64 ? ((lo >> j) & 1ull) : ((hi >> (j - 64)) & 1ull); }
DI int next_bit(u64 lo, u64 hi, int from) {
  if (from < 64) {
    const u64 x = (lo >> from) << from;
    if (x) return __ffsll((long long)x) - 1;
    from = 64;
  }
  if (from >= 128) return -1;
  const u64 y = (hi >> (from - 64)) << (from - 64);
  return y ? 63 + __ffsll((long long)y) : -1;
}

template <int MODE, bool MASKED, class MaskF>
DI void flash_tile(const u16* sK, const u16* sV, const bf16x8 (&qf)[2][2], f32x4 (&O)[2][4], float (&m)[2], float (&l)[2],
                   float (&ps)[4][4], MaskF ok, bool sel, int lane) {
  const int l15 = lane & 15, lg = lane >> 4;
  bf16x8 kf[4][2];
#pragma unroll
  for (int kt = 0; kt < 4; ++kt)
#pragma unroll
    for (int ks = 0; ks < 2; ++ks) kf[kt][ks] = *(const bf16x8*)(sK + (16 * kt + l15) * 72 + ks * 32 + lg * 8);
  if (MODE == 1) {
#pragma unroll
    for (int a = 0; a < 4; ++a)
#pragma unroll
      for (int b = 0; b < 4; ++b) ps[a][b] = 0.f;
  }
#pragma unroll
  for (int qt = 0; qt < 2; ++qt) {
    f32x4 s[4];
    const float sinit = (MODE == 3) ? ((MASKED || sel) ? m[qt] : -1e30f) : 0.f;
#pragma unroll
    for (int kt = 0; kt < 4; ++kt) {
      s[kt] = f32x4{sinit, sinit, sinit, sinit};
#pragma unroll
      for (int ks = 0; ks < 2; ++ks) s[kt] = mfma16(kf[kt][ks], qf[qt][ks], s[kt]);
    }
    float pr[4][4];
    if (MODE == 3) {
      float rs = 0.f;
#pragma unroll
      for (int kt = 0; kt < 4; ++kt)
#pragma unroll
        for (int i = 0; i < 4; ++i) {
          float pv = __builtin_amdgcn_exp2f(s[kt][i]);
          if (MASKED) pv = ok(kt, i) ? pv : 0.f;
          pr[kt][i] = pv;
          rs += pv;
        }
      l[qt] += rs;
    } else {
    float mx = -1e30f;
#pragma unroll
    for (int kt = 0; kt < 4; ++kt)
#pragma unroll
      for (int i = 0; i < 4; ++i) {
        if (MASKED) s[kt][i] = ok(kt, i) ? s[kt][i] : -1e30f;
        mx = fmaxf(mx, s[kt][i]);
      }
    if (!MASKED) mx = sel ? mx : -1e30f;
    if (MODE == 1) {
      const float mm = m[qt], il = l[qt];
#pragma unroll
      for (int kt = 0; kt < 4; ++kt)
#pragma unroll
        for (int i = 0; i < 4; ++i) {
          const float pv = (s[kt][i] > -1e29f) ? __builtin_amdgcn_exp2f(s[kt][i] - mm) * il : 0.f;
          pr[kt][i] = pv;
          ps[kt][i] += pv;
        }
    } else {
      mx = fmaxf(mx, __shfl_xor(mx, 16));
      mx = fmaxf(mx, __shfl_xor(mx, 32));
      const float mnew = fmaxf(m[qt], mx);
      const float alpha = __builtin_amdgcn_exp2f(m[qt] - mnew);
      m[qt] = mnew;
      float rs = 0.f;
      if (MASKED) {
#pragma unroll
        for (int kt = 0; kt < 4; ++kt)
#pragma unroll
          for (int i = 0; i < 4; ++i) {
            const float pv = (s[kt][i] > -1e29f) ? __builtin_amdgcn_exp2f(s[kt][i] - mnew) : 0.f;
            pr[kt][i] = pv;
            rs += pv;
          }
      } else {
        const float me = sel ? mnew : 1e30f;
#pragma unroll
        for (int kt = 0; kt < 4; ++kt)
#pragma unroll
          for (int i = 0; i < 4; ++i) {
            const float pv = __builtin_amdgcn_exp2f(s[kt][i] - me);
            pr[kt][i] = pv;
            rs += pv;
          }
      }
      l[qt] = l[qt] * alpha + rs;
      if (MODE == 2) {
#pragma unroll
        for (int dt = 0; dt < 4; ++dt) O[qt][dt] *= alpha;
      }
    }
    }
    if (MODE != 0) {
#pragma unroll
      for (int ks2 = 0; ks2 < 2; ++ks2) {
        union { unsigned u[4]; bf16x8 v; } pf;
        pf.u[0] = pk2(pr[2 * ks2][0], pr[2 * ks2][1]);
        pf.u[1] = pk2(pr[2 * ks2][2], pr[2 * ks2][3]);
        pf.u[2] = pk2(pr[2 * ks2 + 1][0], pr[2 * ks2 + 1][1]);
        pf.u[3] = pk2(pr[2 * ks2 + 1][2], pr[2 * ks2 + 1][3]);
#pragma unroll
        for (int dt = 0; dt < 4; ++dt) {
          union { uint2 h[2]; bf16x8 v; } vf;
          vf.h[0] = *(const uint2*)(sV + (16 * dt + l15) * 72 + 32 * ks2 + 4 * lg);
          vf.h[1] = *(const uint2*)(sV + (16 * dt + l15) * 72 + 32 * ks2 + 16 + 4 * lg);
          O[qt][dt] = mfma16(vf.v, pf.v, O[qt][dt]);
        }
      }
    }

  }
}

DI void nsa_item(int wv0, PP p, int item, unsigned char* smem) {
  const int tid = my_tid(wv0), lane = tid & 63, wv = wv0 & 3, hp = wv0 >> 2, l15 = lane & 15, lg = lane >> 4;
  const int i = 127 - (item >> 3), bg = item & 7, b = bg >> 1, g = bg & 1;
  u16* sK = (u16*)smem;
  u16* sV = sK + 64 * 72;
  float* sImp0 = (float*)(smem + 18432);
  float* sImp = sImp0 + hp * (64 * 132);
  u64* sUni = (u64*)(smem + 18432 + 2 * 64 * 132 * 4);
  u64* sSel = sUni + 16;
  const int t0 = i * 64, qloc = 16 * wv + l15, tq = t0 + qloc;
  const unsigned tokq = (unsigned)(b * S_ + tq);
  const float* NGb = (const float*)(p->ws + OFF_NG);
  const unsigned ngoff = tokq * 24 + g * 12 + hp * 6;
  float* ACCb = p->out;
  const unsigned aoff = tokq * 512 + g * 256 + hp * 128 + 4 * lg;
  const unsigned qoff = tokq * 512 + g * 256 + hp * 128 + lg * 8;
  const int lrow = tid >> 3, lpart = tid & 7;
  const unsigned koff = (lrow * 64 + lpart * 8) * 2, voffc = (lrow * 512 + lpart * 8) * 2, voffs = (lrow * S_ + lpart * 8) * 2;

  for (int e = tid; e < 2 * 64 * 132; e += NT_) sImp0[e] = 0.f;

  bf16x8 qf[2][2];
  f32x4 O[2][4];
  float m[2], l[2], ps[4][4];
  u32x4 pk0, pv0;
  auto nomask = [](int, int) { return true; };

#define MAKE_RSRC(PTR) __builtin_amdgcn_make_buffer_rsrc((void*)(PTR), 0, 0x7fffffff, 0x00020000)
#define BLOAD(R, VO, SO) __builtin_amdgcn_raw_buffer_load_b128((R), (int)(VO), (int)(SO), 0)
#define ISSUE_TILE(RK, RV, T, LDV)                                                   \
  {                                                                                  \
    pk0 = BLOAD(RK, koff, (T)*8192);                                                 \
    pv0 = BLOAD(RV, ((LDV) == 512) ? voffc : voffs, (T)*128);                        \
  }
#define COMMIT_TILE()                                                                \
  {                                                                                  \
    *(u32x4*)(sK + lrow * 72 + lpart * 8) = pk0;                                     \
    *(u32x4*)(sV + lrow * 72 + lpart * 8) = pv0;                                     \
  }
#define LOAD_Q(BASE)                                                                 \
  {                                                                                  \
    const u16* Q_ = (const u16*)(p->ws + (BASE));                                    \
    _Pragma("unroll") for (int qt = 0; qt < 2; ++qt)                                 \
      _Pragma("unroll") for (int ks = 0; ks < 2; ++ks)                               \
        qf[qt][ks] = *(const bf16x8*)(Q_ + (qoff + qt * 64 + ks * 32));             \
  }
#define RESET_STATE()                                                                \
  {                                                                                  \
    _Pragma("unroll") for (int qt = 0; qt < 2; ++qt) { m[qt] = -1e30f; l[qt] = 0.f; } \
    _Pragma("unroll") for (int a = 0; a < 2; ++a)                                    \
      _Pragma("unroll") for (int c = 0; c < 4; ++c) O[a][c] = f32x4{0.f, 0.f, 0.f, 0.f}; \
  }

  {
    const u16* Kc0 = (const u16*)(p->ws + OFF_KCC) + (size_t)bg * 512 * 64;
    const u16* Vc0 = (const u16*)(p->ws + OFF_VCT) + (size_t)bg * 64 * 512;
    const int nE = (4 * i + 3) < 511 ? (4 * i + 3) : 511;
    const int nkb = (nE + 63) >> 6;
    const __amdgpu_buffer_rsrc_t rK = MAKE_RSRC(Kc0), rV = MAKE_RSRC(Vc0);
    LOAD_Q(OFF_QRAW)
    RESET_STATE()
    ISSUE_TILE(rK, rV, 0, 512)
    for (int kb = 0; kb < nkb; ++kb) {
      __syncthreads();
      COMMIT_TILE()
      __syncthreads();
      if (kb + 1 < nkb) ISSUE_TILE(rK, rV, kb + 1, 512)
      auto ok = [&](int kt, int ii) { return 16 * (kb * 64 + 16 * kt + 4 * lg + ii) + 31 <= tq; };
      flash_tile<0, true>(sK, sV, qf, O, m, l, ps, ok, true, lane);
    }
#pragma unroll
    for (int qt = 0; qt < 2; ++qt) {
      float s = l[qt];
      s += __shfl_xor(s, 16);
      s += __shfl_xor(s, 32);
      l[qt] = s > 0.f ? 1.f / s : 0.f;
    }
    ISSUE_TILE(rK, rV, 0, 512)
    for (int kb = 0; kb < nkb; ++kb) {
      __syncthreads();
      COMMIT_TILE()
      __syncthreads();
      if (kb + 1 < nkb) ISSUE_TILE(rK, rV, kb + 1, 512)
      auto ok = [&](int kt, int ii) { return 16 * (kb * 64 + 16 * kt + 4 * lg + ii) + 31 <= tq; };
      flash_tile<1, true>(sK, sV, qf, O, m, l, ps, ok, true, lane);
#pragma unroll
      for (int kt = 0; kt < 4; ++kt) {
        const int j = kb * 16 + kt * 4 + lg;
        sImp[qloc * 132 + j] += ps[kt][0] + ps[kt][1] + ps[kt][2] + ps[kt][3];
      }
      __syncthreads();
#pragma unroll
      for (int kt = 0; kt < 4; ++kt) {
        const int j1 = kb * 16 + kt * 4 + lg + 1;
        if (j1 < 128) sImp[qloc * 132 + j1] += ps[kt][3];
      }
    }
#pragma unroll
    for (int qt = 0; qt < 2; ++qt) {
      const float gt = NGb[ngoff + qt * 3 + 0];
#pragma unroll
      for (int dt = 0; dt < 4; ++dt) {
        float4 o = make_float4(O[qt][dt][0] * gt, O[qt][dt][1] * gt, O[qt][dt][2] * gt, O[qt][dt][3] * gt);
        *(float4*)(ACCb + (aoff + qt * 64 + 16 * dt)) = o;
      }
    }
  }
  __syncthreads();
  u64 mlo = 0, mhi = 0, wlo = 0, whi = 0;
  if (i < 16) {
    mlo = (1ull << (i + 1)) - 1ull;
    wlo = mlo;
  } else {
    const bool v0 = lane <= i, v1 = (lane + 64) <= i;
    const bool f0 = (lane == 0) || (lane == i) || (lane == i - 1);
    const bool f1 = (lane + 64 == i) || (lane + 64 == i - 1);
    const u64 ltm = (1ull << lane) - 1ull;
    for (int qq = hp * 8; qq < hp * 8 + 8; ++qq) {
      const float* ir = sImp0 + (16 * wv + qq) * 132;
      const float i0 = ir[lane] + ir[64 * 132 + lane], i1 = ir[lane + 64] + ir[64 * 132 + lane + 64];
      const unsigned k0 = v0 ? __float_as_uint(i0 + (f0 ? 1000.f : 0.f)) : 0u;
      const unsigned k1 = v1 ? __float_as_uint(i1 + (f1 ? 1000.f : 0.f)) : 0u;
      unsigned T = 0;
      for (int bit = 30; bit >= 0; --bit) {
        const unsigned cand = T | (1u << bit);
        const int cnt = __popcll(__ballot(k0 >= cand)) + __popcll(__ballot(k1 >= cand));
        if (cnt >= 16) T = cand;
      }
      const bool g0 = k0 > T, g1 = k1 > T, e0 = k0 == T, e1 = k1 == T;
      const int need = 16 - (__popcll(__ballot(g0)) + __popcll(__ballot(g1)));
      const u64 be0 = __ballot(e0), be1 = __ballot(e1);
      const int r0 = __popcll(be0 & ltm), r1 = __popcll(be0) + __popcll(be1 & ltm);
      const u64 s0 = __ballot(v0 && (g0 || (e0 && r0 < need)));
      const u64 s1 = __ballot(v1 && (g1 || (e1 && r1 < need)));
      wlo |= s0;
      whi |= s1;
      if (lane == 0) { sSel[(16 * wv + qq) * 2] = s0; sSel[(16 * wv + qq) * 2 + 1] = s1; }
    }
  }
  if (lane == 0) { sUni[wv0 * 2] = wlo; sUni[wv0 * 2 + 1] = whi; }
  __syncthreads();
  if (i >= 16) { mlo = sSel[qloc * 2]; mhi = sSel[qloc * 2 + 1]; }
  wlo = sUni[wv * 2] | sUni[(wv + 4) * 2];
  whi = sUni[wv * 2 + 1] | sUni[(wv + 4) * 2 + 1];
  const u64 blo = sUni[0] | sUni[2] | sUni[4] | sUni[6] | sUni[8] | sUni[10] | sUni[12] | sUni[14];
  const u64 bhi = sUni[1] | sUni[3] | sUni[5] | sUni[7] | sUni[9] | sUni[11] | sUni[13] | sUni[15];

  LOAD_Q(OFF_QROT)
  float nb_s[2], nb_w[2];
  bool usefix;
  {
    const float* KM = (const float*)(p->ws + OFF_KMAX);
    const float kms = KM[bg], kmw = KM[8 + bg];
    float bmax = 0.f;
#pragma unroll
    for (int qt = 0; qt < 2; ++qt) {
      float q2 = 0.f;
#pragma unroll
      for (int ks = 0; ks < 2; ++ks)
#pragma unroll
        for (int e = 0; e < 8; ++e) {
          const float qv = __uint_as_float(((unsigned)(u16)qf[qt][ks][e]) << 16);
          q2 += qv * qv;
        }
      q2 += __shfl_xor(q2, 16);
      q2 += __shfl_xor(q2, 32);
      const float bs = sqrtf(q2 * kms) * 1.001f + 1e-3f, bw = sqrtf(q2 * kmw) * 1.001f + 1e-3f;
      nb_s[qt] = -bs;
      nb_w[qt] = -bw;
      bmax = fmaxf(bmax, fmaxf(bs, bw));
    }
    usefix = __ballot(bmax > 60.f) == 0ull;
  }
  RESET_STATE()
  if (usefix) { m[0] = nb_s[0]; m[1] = nb_s[1]; }
  {
    const __amdgpu_buffer_rsrc_t rK = MAKE_RSRC((const u16*)(p->ws + OFF_KS) + (size_t)bg * S_ * 64);
    const __amdgpu_buffer_rsrc_t rV = MAKE_RSRC((const u16*)(p->ws + OFF_VST) + (size_t)bg * 64 * S_);
    int jn = next_bit(blo, bhi, 0);
    if (jn >= 0) ISSUE_TILE(rK, rV, jn, S_)
    while (jn >= 0) {
      const int j = jn;
      __syncthreads();
      COMMIT_TILE()
      __syncthreads();
      jn = next_bit(blo, bhi, j + 1);
      if (jn >= 0) ISSUE_TILE(rK, rV, jn, S_)
      if (bit128(wlo, whi, j)) {
        const bool sel = bit128(mlo, mhi, j);
        if (j == i) {
          auto ok = [&](int kt, int ii) { return sel && (16 * kt + 4 * lg + ii) <= qloc; };
          if (usefix) flash_tile<3, true>(sK, sV, qf, O, m, l, ps, ok, true, lane);
          else flash_tile<2, true>(sK, sV, qf, O, m, l, ps, ok, true, lane);
        } else {
          if (usefix) flash_tile<3, false>(sK, sV, qf, O, m, l, ps, nomask, sel, lane);
          else flash_tile<2, false>(sK, sV, qf, O, m, l, ps, nomask, sel, lane);
        }
      }
    }
  }
#pragma unroll
  for (int qt = 0; qt < 2; ++qt) {
    float s = l[qt];
    s += __shfl_xor(s, 16);
    s += __shfl_xor(s, 32);
    const float sc = NGb[ngoff + qt * 3 + 1] / s;
#pragma unroll
    for (int dt = 0; dt < 4; ++dt) {
      float4* a = (float4*)(ACCb + (aoff + qt * 64 + 16 * dt));
      float4 o = *a;
      o.x += O[qt][dt][0] * sc; o.y += O[qt][dt][1] * sc; o.z += O[qt][dt][2] * sc; o.w += O[qt][dt][3] * sc;
      *a = o;
    }
  }
  RESET_STATE()
  if (usefix) { m[0] = nb_w[0]; m[1] = nb_w[1]; }
  {
    const __amdgpu_buffer_rsrc_t rK = MAKE_RSRC((const u16*)(p->ws + OFF_KW) + (size_t)bg * S_ * 64);
    const __amdgpu_buffer_rsrc_t rV = MAKE_RSRC((const u16*)(p->ws + OFF_VWT) + (size_t)bg * 64 * S_);
    const int j0 = i >= 8 ? i - 8 : 0;
    ISSUE_TILE(rK, rV, j0, S_)
    for (int j = j0; j <= i; ++j) {
      __syncthreads();
      COMMIT_TILE()
      __syncthreads();
      if (j + 1 <= i) ISSUE_TILE(rK, rV, j + 1, S_)
      if (j == i || j == i - 8) {
        auto ok = [&](int kt, int ii) {
          const int kp = j * 64 + 16 * kt + 4 * lg + ii;
          return kp <= tq && kp > tq - 512;
        };
        if (usefix) flash_tile<3, true>(sK, sV, qf, O, m, l, ps, ok, true, lane);
        else flash_tile<2, true>(sK, sV, qf, O, m, l, ps, ok, true, lane);
      } else {
        if (usefix) flash_tile<3, false>(sK, sV, qf, O, m, l, ps, nomask, true, lane);
        else flash_tile<2, false>(sK, sV, qf, O, m, l, ps, nomask, true, lane);
      }
    }
  }
  u16* NSAb = (u16*)(p->ws + OFF_NSA);
#pragma unroll
  for (int qt = 0; qt < 2; ++qt) {
    float s = l[qt];
    s += __shfl_xor(s, 16);
    s += __shfl_xor(s, 32);
    const float sc = NGb[ngoff + qt * 3 + 2] / s;
#pragma unroll
    for (int dt = 0; dt < 4; ++dt) {
      const float4 a = *(const float4*)(ACCb + (aoff + qt * 64 + 16 * dt));
      uint2 o;
      o.x = pk2(a.x + O[qt][dt][0] * sc, a.y + O[qt][dt][1] * sc);
      o.y = pk2(a.z + O[qt][dt][2] * sc, a.w + O[qt][dt][3] * sc);
      *(uint2*)(NSAb + (aoff + qt * 64 + 16 * dt)) = o;
    }
  }
  __syncthreads();
}

DI void phaseE(int wv0, PP p, unsigned char* smem, int cidx) {
  __shared__ int s_item;
  int* ctr = (int*)(p->ws + OFF_CTR) + cidx;
  for (;;) {
    __syncthreads();
    if (my_tid(wv0) == 0) s_item = atomicAdd(ctr, 1);
    __syncthreads();
    const int item = s_item;
    if (item >= 1024 + 2048) break;
    if (item < 1024) nsa_item(wv0, p, item, smem);
    else s5_item<true>(wv0, p, item - 1024, smem);
  }
}

DI void phaseF(int wv0, PP p, unsigned char* smem) {
  const u16* YS = (const u16*)(p->ws + OFF_YS);
  const u16* NSA = (const u16*)(p->ws + OFF_NSA);
  const u16* MG = (const u16*)(p->ws + OFF_MG);
  u16* MR = (u16*)(p->ws + OFF_MERGED);
  for (int id = blockIdx.x; id < 128 * 4; id += gridDim.x) {
    const int pm = id >> 2, pn = id & 3, brow = pm * 256, bcol = pn * 256;
    f32x4 acc[2][2][4][2];
    gemm256(wv0, acc, YS + (size_t)brow * 512, 512, (const u16*)(p->ws + OFF_WGT) + (size_t)bcol * 512, 512, 512, smem);
    epi256(wv0, acc, brow, bcol, [&](int ai, int bj, int m, int n, int row, int col0, f32x4& v) {
      *(uint2*)(MR + (size_t)row * 1024 + col0) = pk4(sigmoidf_(v[0]), sigmoidf_(v[1]), sigmoidf_(v[2]), sigmoidf_(v[3]));
    });
    gemm256(wv0, acc, YS + (size_t)brow * 512, 512, (const u16*)(p->ws + OFF_WVT) + (size_t)bcol * 512, 512, 512, smem);
    epi256(wv0, acc, brow, bcol, [&](int ai, int bj, int m, int n, int row, int col0, f32x4& v) {
      const uint2 t = *(const uint2*)(MR + (size_t)row * 1024 + col0);
      const uint2 gq = *(const uint2*)(MG + (size_t)row * 2048 + 1024 + col0);
      *(uint2*)(MR + (size_t)row * 1024 + col0) =
          pk4(__uint_as_float(gq.x << 16) * v[0] * __uint_as_float(t.x << 16), __uint_as_float(gq.x & 0xffff0000u) * v[1] * __uint_as_float(t.x & 0xffff0000u),
              __uint_as_float(gq.y << 16) * v[2] * __uint_as_float(t.y << 16), __uint_as_float(gq.y & 0xffff0000u) * v[3] * __uint_as_float(t.y & 0xffff0000u));
    });
    gemm256(wv0, acc, NSA + (size_t)brow * 512, 512, (const u16*)(p->ws + OFF_WAT) + (size_t)bcol * 512, 512, 512, smem);
    epi256(wv0, acc, brow, bcol, [&](int ai, int bj, int m, int n, int row, int col0, f32x4& v) {
      const uint2 t = *(const uint2*)(MR + (size_t)row * 1024 + col0);
      const uint2 gq = *(const uint2*)(MG + (size_t)row * 2048 + col0);
      *(uint2*)(MR + (size_t)row * 1024 + col0) =
          pk4(__uint_as_float(gq.x << 16) * v[0] + __uint_as_float(t.x << 16), __uint_as_float(gq.x & 0xffff0000u) * v[1] + __uint_as_float(t.x & 0xffff0000u),
              __uint_as_float(gq.y << 16) * v[2] + __uint_as_float(t.y << 16), __uint_as_float(gq.y & 0xffff0000u) * v[3] + __uint_as_float(t.y & 0xffff0000u));
    });
  }
}
DI void ss_partial(int wv0, f32x4 (&acc)[2][2][4][2], float* SS, int brow, int pn) {
  const int lane = my_tid(wv0) & 63, wr = wv0 >> 2, wc = wv0 & 3;
#pragma unroll
  for (int ai = 0; ai < 2; ++ai)
#pragma unroll
    for (int m = 0; m < 4; ++m) {
      float s = 0.f;
#pragma unroll
      for (int bj = 0; bj < 2; ++bj)
#pragma unroll
        for (int n = 0; n < 2; ++n)
#pragma unroll
          for (int j = 0; j < 4; ++j) s += acc[ai][bj][m][n][j] * acc[ai][bj][m][n][j];
      s += __shfl_xor(s, 16);
      s += __shfl_xor(s, 32);
      if (lane < 16) SS[(size_t)(brow + ai * 128 + wr * 64 + m * 16 + lane) * 16 + pn * 4 + wc] = s;
    }
}
DI void phaseG(int wv0, PP p, unsigned char* smem) {
  const u16* MR = (const u16*)(p->ws + OFF_MERGED);
  u16* X1B = (u16*)(p->ws + OFF_X1B);
  float* SS1 = (float*)(p->ws + OFF_SS1);
  for (int id = blockIdx.x; id < 128 * 4; id += gridDim.x) {
    const int pm = id >> 2, pn = id & 3, brow = pm * 256, bcol = pn * 256;
    f32x4 acc[2][2][4][2];
    gemm256(wv0, acc, MR + (size_t)brow * 1024, 1024, (const u16*)(p->ws + OFF_WOT) + (size_t)bcol * 1024, 1024, 1024, smem);
    epi256(wv0, acc, brow, bcol, [&](int ai, int bj, int m, int n, int row, int col0, f32x4& v) {
      const size_t o = (size_t)row * 1024 + col0;
      const float4 xv = *(const float4*)(p->x + o);
      v[0] += xv.x; v[1] += xv.y; v[2] += xv.z; v[3] += xv.w;
      *(float4*)(p->out + o) = make_float4(v[0], v[1], v[2], v[3]);
      *(uint2*)(X1B + o) = pk4(v[0], v[1], v[2], v[3]);
    });
    ss_partial(wv0, acc, SS1, brow, pn);
  }
}
DI void phaseH(int wv0, PP p, unsigned char* smem) {
  const u16* X1B = (const u16*)(p->ws + OFF_X1B);
  const float* SS1 = (const float*)(p->ws + OFF_SS1);
  u16* ACT = (u16*)(p->ws + OFF_ACT);
  float* sR = (float*)(smem + 131072);
  for (int id = blockIdx.x; id < 128 * 16; id += gridDim.x) {
    const int pm = id >> 4, pn = id & 15, brow = pm * 256, bcol = pn * 256;
    const int tid = my_tid(wv0);
    if (tid < 256) {
      const float4* s = (const float4*)(SS1 + (size_t)(brow + tid) * 16);
      const float4 a = s[0], b = s[1], c = s[2], d = s[3];
      const float t = a.x + a.y + a.z + a.w + b.x + b.y + b.z + b.w + c.x + c.y + c.z + c.w + d.x + d.y + d.z + d.w;
      sR[tid] = rsqrtf(t * (1.f / 1024.f) + 1e-6f);
    }
    f32x4 acc[2][2][4][2];
    gemm256(wv0, acc, X1B + (size_t)brow * 1024, 1024, (const u16*)(p->ws + OFF_WUPT) + (size_t)bcol * 1024, 1024, 1024, smem);
    epi256(wv0, acc, brow, bcol, [&](int ai, int bj, int m, int n, int row, int col0, f32x4& v) {
      const float ri = sR[row - brow];
      const float a0 = fmaxf(v[0] * ri, 0.f), a1 = fmaxf(v[1] * ri, 0.f), a2 = fmaxf(v[2] * ri, 0.f), a3 = fmaxf(v[3] * ri, 0.f);
      *(uint2*)(ACT + (size_t)row * 4096 + col0) = pk4(a0 * a0, a1 * a1, a2 * a2, a3 * a3);
    });
    __syncthreads();
  }
}
DI void phaseI(int wv0, PP p, unsigned char* smem) {
  const u16* ACT = (const u16*)(p->ws + OFF_ACT);
  float* SS2 = (float*)(p->ws + OFF_SS2);
  for (int id = blockIdx.x; id < 128 * 4; id += gridDim.x) {
    const int pm = id >> 2, pn = id & 3, brow = pm * 256, bcol = pn * 256;
    f32x4 acc[2][2][4][2];
    gemm256(wv0, acc, ACT + (size_t)brow * 4096, 4096, (const u16*)(p->ws + OFF_WDT) + (size_t)bcol * 4096, 4096, 4096, smem);
    epi256(wv0, acc, brow, bcol, [&](int ai, int bj, int m, int n, int row, int col0, f32x4& v) {
      const size_t o = (size_t)row * 1024 + col0;
      const float4 xv = *(const float4*)(p->out + o);
      v[0] += xv.x; v[1] += xv.y; v[2] += xv.z; v[3] += xv.w;
      *(float4*)(p->out + o) = make_float4(v[0], v[1], v[2], v[3]);
    });
    ss_partial(wv0, acc, SS2, brow, pn);
  }
}
DI void phaseJ(int wv0, PP p) {
  const int lane = my_tid(wv0) & 63;
  const float* SS2 = (const float*)(p->ws + OFF_SS2);
  for (int row = blockIdx.x * 8 + wv0; row < T_; row += gridDim.x * 8) {
    float t = (lane < 16) ? SS2[(size_t)row * 16 + lane] : 0.f;
    t = wave_sum(t);
    const float rinv = rsqrtf(t * (1.f / 1024.f) + 1e-6f);
    float4* xr = (float4*)(p->out + (size_t)row * 1024);
#pragma unroll
    for (int r = 0; r < 4; ++r) {
      float4 v = xr[lane + 64 * r];
      const float4 g = ((const float4*)p->g3)[lane + 64 * r];
      v.x *= rinv * g.x; v.y *= rinv * g.y; v.z *= rinv * g.z; v.w *= rinv * g.w;
      xr[lane + 64 * r] = v;
    }
  }
}

__global__ void __launch_bounds__(512, 2) mega(Params p) {
  extern __shared__ __attribute__((aligned(16))) unsigned char smem[];
  const int wv0 = __builtin_amdgcn_readfirstlane((int)(threadIdx.x >> 6));
  const int lo = p.lo, hi = p.hi;
  PP kp0 = (PP)__builtin_amdgcn_kernarg_segment_ptr();
#define PH(N, CALL)                                  \
  if (lo <= N && N < hi) {                           \
    if (N > lo) cg::this_grid().sync();              \
    PP kp = kp0;                                     \
    asm volatile("" : "+s"(kp));                     \
    CALL;                                            \
    if ((PROBE_MASK >> N) & 1) { CALL; }             \
  }
  PH(0, phaseA(wv0, kp, smem))
  PH(1, phaseB(wv0, kp, smem))
  PH(2, phaseC(wv0, kp, smem))
  PH(3, phaseD(wv0, kp, smem))
  PH(4, phaseE(wv0, kp, smem, 0))
  if ((PROBE_MASK >> 10) & 1) { PP kp = kp0; asm volatile("" : "+s"(kp)); phaseE(wv0, kp, smem, 1); }
  PH(5, phaseF(wv0, kp, smem))
  PH(6, phaseG(wv0, kp, smem))
  PH(7, phaseH(wv0, kp, smem))
  PH(8, phaseI(wv0, kp, smem))
  PH(9, phaseJ(wv0, kp))
}

extern "C" void kernel_launch(void* const* d_in, const int* in_sizes, int n_in, void* d_out, int out_size, void* d_ws,
                              size_t ws_size, hipStream_t stream) {
  static int grid_blocks = 0;
  if (!grid_blocks) {
    int dev = 0, cus = 0, per_cu = 0;
    (void)hipGetDevice(&dev);
    (void)hipDeviceGetAttribute(&cus, hipDeviceAttributeMultiprocessorCount, dev);
    (void)hipFuncSetAttribute((const void*)mega, hipFuncAttributeMaxDynamicSharedMemorySize, SMEM_BYTES);
    (void)hipOccupancyMaxActiveBlocksPerMultiprocessor(&per_cu, mega, NT_, SMEM_BYTES);
    if (per_cu > 1) per_cu = 1;
    if (per_cu < 1) per_cu = 1;
    grid_blocks = cus * per_cu;
  }
  if (ws_size < WS_NEED) { fprintf(stderr, "workspace too small: %zu < %zu\n", ws_size, (size_t)WS_NEED); }
  Params p{};
  const float** f = (const float**)&p;
  for (int i = 0; i < 24; ++i) f[i] = (const float*)d_in[i];
  p.out = (float*)d_out;
  p.ws = (unsigned char*)d_ws;
  p.lo = 0; p.hi = 10;
  void* args[] = {&p};
  hipError_t e = hipLaunchCooperativeKernel((void*)mega, dim3(grid_blocks), dim3(NT_), args, SMEM_BYTES, stream);
  if (e != hipSuccess) fprintf(stderr, "cooperative launch failed: %s (grid %d)\n", hipGetErrorString(e), grid_blocks);
}
```

```cpp
#include <hip/hip_runtime.h>
#include <hip/hip_cooperative_groups.h>
#include <cstdio>
namespace cg = cooperative_groups;

#ifndef PROBE_MASK
#define PROBE_MASK 0
#endif

#define DI __device__ __forceinline__
typedef unsigned short u16;
typedef unsigned long long u64;
using bf16x8 = __attribute__((ext_vector_type(8))) short;
using f32x4 = __attribute__((ext_vector_type(4))) float;
using u32x4 = __attribute__((ext_vector_type(4))) unsigned;

constexpr int B_ = 4, S_ = 8192, T_ = B_ * S_;
constexpr int NT_ = 512;
constexpr int NINP = 4096;
constexpr float QSCALE = 0.125f * 1.44269504089f;

constexpr size_t MB = 1024 * 1024;
constexpr size_t OFF_WINT = 0;
constexpr size_t OFF_W1KT = OFF_WINT + (size_t)NINP * 1024 * 2;
constexpr size_t OFF_W1VT = OFF_W1KT + 256 * 2048 * 2;
constexpr size_t OFF_W2KT = OFF_W1VT + 256 * 2048 * 2;
constexpr size_t OFF_W2VT = OFF_W2KT + 256 * 256 * 2;
constexpr size_t OFF_WAT = OFF_W2VT + 256 * 256 * 2;
constexpr size_t OFF_WVT = OFF_WAT + 1024 * 512 * 2;
constexpr size_t OFF_WGT = OFF_WVT + 1024 * 512 * 2;
constexpr size_t OFF_WOT = OFF_WGT + 1024 * 512 * 2;
constexpr size_t OFF_WUPT = OFF_WOT + 1024 * 1024 * 2;
constexpr size_t OFF_WDT = OFF_WUPT + 4096 * 1024 * 2;
constexpr size_t OFF_ROPE = OFF_WDT + 4096 * 1024 * 2;
constexpr size_t OFF_CBP = OFF_ROPE + 8192 * 16 * 4;
constexpr size_t OFF_CTR = OFF_CBP + 2 * 32 * 256 * 4;
constexpr size_t OFF_KMAX = OFF_CTR + 64;
constexpr size_t OFF_BAR = OFF_CTR + 256;
constexpr size_t OFF_SS1 = OFF_BAR + 16384;
constexpr size_t OFF_SS2 = OFF_SS1 + (size_t)T_ * 16 * 4;
constexpr size_t OFF_NG = OFF_SS2 + (size_t)T_ * 16 * 4;
constexpr size_t OFF_HC = OFF_NG + (size_t)T_ * 24 * 4;
constexpr size_t OFF_KCC = OFF_HC + 2 * 4096 * 256 * 2;
constexpr size_t OFF_VCT = OFF_KCC + 8 * 512 * 64 * 2;
constexpr size_t OFF_HLOC = OFF_VCT + 8 * 512 * 64 * 2;
constexpr size_t OFF_ARENA = OFF_HLOC + (size_t)4 * 128 * 32 * 64 * 8;
constexpr size_t OFF_MG = OFF_ARENA;
constexpr size_t OFF_HN = OFF_ARENA + 128 * MB;
constexpr size_t OFF_QRAW = OFF_ARENA + 192 * MB;
constexpr size_t OFF_QROT = OFF_ARENA + 224 * MB;
constexpr size_t OFF_KCIN = OFF_ARENA + 256 * MB;
constexpr size_t OFF_VCIN = OFF_KCIN + 8 * MB;
constexpr size_t OFF_KS = OFF_VCIN + 8 * MB;
constexpr size_t OFF_VST = OFF_KS + 8 * MB;
constexpr size_t OFF_KW = OFF_VST + 8 * MB;
constexpr size_t OFF_VWT = OFF_KW + 8 * MB;
constexpr size_t OFF_U = OFF_ARENA + 304 * MB;
constexpr size_t OFF_NSA = OFF_ARENA + 336 * MB;
constexpr size_t OFF_YS = OFF_ARENA + 368 * MB;
constexpr size_t WS_NEED = OFF_ARENA + 400 * MB;
constexpr size_t OFF_ACT = OFF_ARENA;
constexpr size_t OFF_X1B = OFF_ARENA + 256 * MB;
constexpr size_t OFF_MERGED = OFF_HN;

constexpr int SMEM_BYTES = 131072 + 1024;

struct Params {
  const float *x, *g1, *w_in, *pe, *kw1, *kw2, *vw1, *vw2, *lam_re, *lam_im, *log_step, *b_re, *b_im, *c_re, *c_im, *dsk,
      *w_attn, *w_val, *w_gate, *w_out, *g2, *w_up, *w_down, *g3;
  float* out;
  unsigned char* ws;
  int lo, hi;
};

typedef const __attribute__((address_space(4))) Params* PP;

DI int my_tid(int wv0) {
  int t = wv0 * 64 + (int)__lane_id();
  asm volatile("" : "+v"(t));
  return t;
}
DI u16 f2bf(float x) { unsigned u = __float_as_uint(x); u += 0x7fffu + ((u >> 16) & 1u); return (u16)(u >> 16); }
DI float bf2f(u16 h) { return __uint_as_float(((unsigned)h) << 16); }
DI unsigned pk2(float a, float b) { return (unsigned)f2bf(a) | ((unsigned)f2bf(b) << 16); }
DI uint2 pk4(float a, float b, float c, float d) { uint2 o; o.x = pk2(a, b); o.y = pk2(c, d); return o; }
DI float sigmoidf_(float x) { return 1.f / (1.f + __expf(-x)); }
DI float gelu_t(float x) {
  float u = 0.7978845608f * (x + 0.044715f * x * x * x);
  float e = __expf(2.f * u);
  float th = 1.f - 2.f / (e + 1.f);
  return 0.5f * x * (1.f + th);
}
DI float wave_sum(float v) {
#pragma unroll
  for (int o = 32; o > 0; o >>= 1) v += __shfl_xor(v, o);
  return v;
}
template <class T> DI T* launder(T* p) { asm volatile("" : "+v"(p)); return p; }
DI void wave_sync() { asm volatile("s_waitcnt lgkmcnt(0)" ::: "memory"); }
DI f32x4 mfma16(bf16x8 a, bf16x8 b, f32x4 c) { return __builtin_amdgcn_mfma_f32_16x16x32_bf16(a, b, c, 0, 0, 0); }

constexpr int G_HT = 128 * 64;
DI int lds_byte(int r, int c) {
  const int st = (r >> 4) * 2 + (c >> 5), rr = r & 15, cc = c & 31, ob = rr * 64 + cc * 2;
  return st * 1024 + (ob ^ (((ob >> 9) & 1) << 5));
}
DI void stage_rc(int b, int& R, int& C) {
  const int st = b / 1024, sb = b % 1024, swz = sb ^ (((sb >> 9) & 1) << 5);
  R = (st >> 1) * 16 + swz / 64;
  C = (st & 1) * 32 + (swz % 64) / 2;
}
typedef __attribute__((address_space(3))) unsigned* lds_u32p;
DI void gemm256(int wv0, f32x4 (&acc)[2][2][4][2], const u16* __restrict__ A, int lda, const u16* __restrict__ Bt, int ldb,
                int K, unsigned char* smem) {
  u16* shm = (u16*)smem;
  const int tid = my_tid(wv0), lane = tid & 63;
  const int wr = wv0 >> 2, wc = wv0 & 3, fr = lane & 15, fq = lane >> 4;
#define SA(b, h) (shm + ((b)*2 + (h)) * G_HT)
#define SB(b, h) (shm + (4 + (b)*2 + (h)) * G_HT)
  int sr0, sc0, sr1, sc1;
  stage_rc(tid * 16, sr0, sc0);
  stage_rc(tid * 16 + 8192, sr1, sc1);
  const u16* a0 = A + (size_t)sr0 * lda + sc0;
  const u16* a1 = A + (size_t)sr1 * lda + sc1;
  const u16* b0 = Bt + (size_t)sr0 * ldb + sc0;
  const u16* b1 = Bt + (size_t)sr1 * ldb + sc1;
#define STAGE_A(P, half, kt)                                                                                              \
  {                                                                                                                       \
    __builtin_amdgcn_global_load_lds((const unsigned*)(a0 + (size_t)((half)*128) * lda + (kt)*64),                        \
                                     (unsigned*)((char*)(P) + tid * 16), 16, 0, 0);                               \
    __builtin_amdgcn_global_load_lds((const unsigned*)(a1 + (size_t)((half)*128) * lda + (kt)*64),                        \
                                     (unsigned*)((char*)(P) + tid * 16 + 8192), 16, 0, 0);                        \
  }
#define STAGE_B(P, half, kt)                                                                                              \
  {                                                                                                                       \
    __builtin_amdgcn_global_load_lds((const unsigned*)(b0 + (size_t)((half)*128) * ldb + (kt)*64),                        \
                                     (unsigned*)((char*)(P) + tid * 16), 16, 0, 0);                               \
    __builtin_amdgcn_global_load_lds((const unsigned*)(b1 + (size_t)((half)*128) * ldb + (kt)*64),                        \
                                     (unsigned*)((char*)(P) + tid * 16 + 8192), 16, 0, 0);                        \
  }
#define LDA(dst, b, h)                                                                                                    \
  _Pragma("unroll") for (int m = 0; m < 4; ++m) _Pragma("unroll") for (int k = 0; k < 2; ++k)                             \
      dst[m][k] = *(const bf16x8*)((const unsigned char*)SA(b, h) + lds_byte(wr * 64 + m * 16 + fr, k * 32 + fq * 8));
#define LDB(dst, b, h)                                                                                                    \
  _Pragma("unroll") for (int n = 0; n < 2; ++n) _Pragma("unroll") for (int k = 0; k < 2; ++k)                             \
      dst[n][k] = *(const bf16x8*)((const unsigned char*)SB(b, h) + lds_byte(wc * 32 + n * 16 + fr, k * 32 + fq * 8));
#define MMA(ai, bj, At_, Bt_)                                                                                             \
  {                                                                                                                       \
    __builtin_amdgcn_s_setprio(1);                                                                                        \
    _Pragma("unroll") for (int m = 0; m < 4; ++m) _Pragma("unroll") for (int n = 0; n < 2; ++n)                           \
        _Pragma("unroll") for (int k = 0; k < 2; ++k) acc[ai][bj][m][n] =                                                 \
            __builtin_amdgcn_mfma_f32_16x16x32_bf16(Bt_[n][k], At_[m][k], acc[ai][bj][m][n], 0, 0, 0);                    \
    __builtin_amdgcn_s_setprio(0);                                                                                        \
  }
#define WAIT_V(n) asm volatile("s_waitcnt vmcnt(" #n ")" ::: "memory")
#define WAIT_L(n) asm volatile("s_waitcnt lgkmcnt(" #n ")" ::: "memory")
#define BAR __builtin_amdgcn_s_barrier()
#define SCHED __builtin_amdgcn_sched_barrier(0)
#pragma unroll
  for (int a = 0; a < 2; ++a)
#pragma unroll
    for (int b = 0; b < 2; ++b)
#pragma unroll
      for (int m = 0; m < 4; ++m)
#pragma unroll
        for (int n = 0; n < 2; ++n) acc[a][b][m][n] = f32x4{0.f, 0.f, 0.f, 0.f};
  bf16x8 At[4][2], B0[2][2], B1[2][2];
  const int nt = K / 64;
  WAIT_V(0);
  __syncthreads();
  STAGE_B(SB(0, 0), 0, 0) STAGE_A(SA(0, 0), 0, 0)
  STAGE_B(SB(0, 1), 1, 0) STAGE_A(SA(0, 1), 1, 0)
  if (wr == 1) BAR;
  WAIT_V(4); BAR;
  STAGE_B(SB(1, 0), 0, 1) STAGE_A(SA(1, 0), 0, 1) STAGE_B(SB(1, 1), 1, 1)
  WAIT_V(6); BAR;
#pragma unroll 1
  for (int t = 0; t < nt - 2; t += 2) {
    LDB(B0, 0, 0) SCHED; LDA(At, 0, 0) STAGE_A(SA(1, 1), 1, t + 1)
    WAIT_L(8); BAR; WAIT_L(0); MMA(0, 0, At, B0) BAR; SCHED;
    LDB(B1, 0, 1) STAGE_B(SB(0, 0), 0, t + 2)
    BAR; WAIT_L(0); MMA(0, 1, At, B1) BAR;
    LDA(At, 0, 1) STAGE_A(SA(0, 0), 0, t + 2)
    BAR; WAIT_L(0); MMA(1, 0, At, B0) BAR; SCHED;
    STAGE_B(SB(0, 1), 1, t + 2)
    WAIT_V(6); BAR; MMA(1, 1, At, B1) BAR;
    LDB(B0, 1, 0) SCHED; LDA(At, 1, 0) STAGE_A(SA(0, 1), 1, t + 2)
    WAIT_L(8); BAR; WAIT_L(0); MMA(0, 0, At, B0) BAR; SCHED;
    LDB(B1, 1, 1) STAGE_B(SB(1, 0), 0, t + 3)
    BAR; WAIT_L(0); MMA(0, 1, At, B1) BAR;
    LDA(At, 1, 1) STAGE_A(SA(1, 0), 0, t + 3)
    BAR; WAIT_L(0); MMA(1, 0, At, B0) BAR; SCHED;
    STAGE_B(SB(1, 1), 1, t + 3)
    WAIT_V(6); BAR; MMA(1, 1, At, B1) BAR;
  }
  {
    LDB(B0, 0, 0) LDA(At, 0, 0) STAGE_A(SA(1, 1), 1, nt - 1)
    BAR; WAIT_L(0); MMA(0, 0, At, B0) BAR;
    LDB(B1, 0, 1) BAR; WAIT_L(0); MMA(0, 1, At, B1) BAR;
    LDA(At, 0, 1) WAIT_V(4); BAR; WAIT_L(0); MMA(1, 0, At, B0) MMA(1, 1, At, B1) BAR;
  }
  {
    LDB(B0, 1, 0) LDA(At, 1, 0) WAIT_V(2); BAR; WAIT_L(0); MMA(0, 0, At, B0) BAR;
    LDB(B1, 1, 1) WAIT_V(0); BAR; WAIT_L(0); MMA(0, 1, At, B1) BAR;
    LDA(At, 1, 1) BAR; WAIT_L(0); MMA(1, 0, At, B0) MMA(1, 1, At, B1) BAR;
  }
  if (wr == 0) BAR;
}
DI void tile_map_n16(int id, int& pm, int& pn) {
  const int k = id & 255, rnd = id >> 8, x = k & 7, slot = k >> 3;
  pm = rnd * 16 + 4 * (x >> 1) + (slot >> 3);
  pn = 8 * (x & 1) + (slot & 7);
}
DI void tile_map_n4(int id, int& pm, int& pn) {
  const int k = id & 255, rnd = id >> 8, x = k & 7, slot = k >> 3;
  pm = rnd * 64 + 8 * x + (slot >> 2);
  pn = slot & 3;
}
template <class F>
DI void epi256(int wv0, f32x4 (&acc)[2][2][4][2], int brow, int bcol, F f) {
  const int lane = my_tid(wv0) & 63, wr = wv0 >> 2, wc = wv0 & 3;
#pragma unroll
  for (int ai = 0; ai < 2; ++ai)
#pragma unroll
    for (int bj = 0; bj < 2; ++bj)
#pragma unroll
      for (int m = 0; m < 4; ++m)
#pragma unroll
        for (int n = 0; n < 2; ++n) {
          const int row = brow + ai * 128 + wr * 64 + m * 16 + (lane & 15);
          const int col0 = bcol + bj * 128 + wc * 32 + n * 16 + (lane >> 4) * 4;
          f(ai, bj, m, n, row, col0, acc[ai][bj][m][n]);
          if (n == 1 && (m & 1)) __builtin_amdgcn_sched_barrier(0);
        }
}

constexpr int NXT_A = 1024 + 128 + 128 + 16 + 16;
constexpr int NXT = NXT_A + 128 * 3 + 256 + 1024 + 1024;
DI void xpose_tile(int wv0, PP p, int jt, unsigned char* smem) {
  const int tid = my_tid(wv0);
  float* tile = (float*)smem;
  int t = jt;
  const float* src;
  u16* dst;
  int K, Nsrc, mode = 0;
  const float* scl = nullptr;
  if (t < 1024) { src = p->w_in; dst = (u16*)(p->ws + OFF_WINT); K = 1024; Nsrc = 3864; mode = 1; }
  else if ((t -= 1024) < 128) { src = p->kw1; dst = (u16*)(p->ws + OFF_W1KT); K = 2048; Nsrc = 256; }
  else if ((t -= 128) < 128) { src = p->vw1; dst = (u16*)(p->ws + OFF_W1VT); K = 2048; Nsrc = 256; }
  else if ((t -= 128) < 16) { src = p->kw2; dst = (u16*)(p->ws + OFF_W2KT); K = 256; Nsrc = 64; mode = 2; }
  else if ((t -= 16) < 16) { src = p->vw2; dst = (u16*)(p->ws + OFF_W2VT); K = 256; Nsrc = 64; mode = 2; }
  else if ((t -= 16) < 128) { src = p->w_attn; dst = (u16*)(p->ws + OFF_WAT); K = 512; Nsrc = 1024; }
  else if ((t -= 128) < 128) { src = p->w_val; dst = (u16*)(p->ws + OFF_WVT); K = 512; Nsrc = 1024; }
  else if ((t -= 128) < 128) { src = p->w_gate; dst = (u16*)(p->ws + OFF_WGT); K = 512; Nsrc = 1024; }
  else if ((t -= 128) < 256) { src = p->w_out; dst = (u16*)(p->ws + OFF_WOT); K = 1024; Nsrc = 1024; }
  else if ((t -= 256) < 1024) { src = p->w_up; dst = (u16*)(p->ws + OFF_WUPT); K = 1024; Nsrc = 4096; scl = p->g2; }
  else { t -= 1024; src = p->w_down; dst = (u16*)(p->ws + OFF_WDT); K = 4096; Nsrc = 1024; }
  const int nkt = K >> 6, tn = t / nkt, tk = t % nkt, n0 = tn * 64, k0 = tk * 64;
  const int tx = tid & 63, ty = tid >> 6;
  const int np = n0 + tx;
  int sc = np;
  if (mode == 1) {
    if (np < 1280) sc = np;
    else if (np < 1792) sc = 1304 + (np - 1280);
    else if (np < 3840) sc = 1816 + (np - 1792);
    else if (np < 3864) sc = 1280 + (np - 3840);
    else sc = -1;
  } else if (mode == 2) {
    sc = np < 64 ? np : -1;
  }
  for (int kk = ty; kk < 64; kk += 8) {
    float val = 0.f;
    if (sc >= 0) val = src[(size_t)(k0 + kk) * Nsrc + sc];
    if (scl) val *= scl[k0 + kk];
    tile[kk * 65 + tx] = val;
  }
  __syncthreads();
  {
    const int n = tid >> 3, kc = tid & 7;
    uint4 o;
    o.x = pk2(tile[(kc * 8 + 0) * 65 + n], tile[(kc * 8 + 1) * 65 + n]);
    o.y = pk2(tile[(kc * 8 + 2) * 65 + n], tile[(kc * 8 + 3) * 65 + n]);
    o.z = pk2(tile[(kc * 8 + 4) * 65 + n], tile[(kc * 8 + 5) * 65 + n]);
    o.w = pk2(tile[(kc * 8 + 6) * 65 + n], tile[(kc * 8 + 7) * 65 + n]);
    *(uint4*)(dst + (size_t)(n0 + n) * K + k0 + kc * 8) = o;
  }
  __syncthreads();
}

DI void phaseA(int wv0, PP p, unsigned char* smem) {
  const int tid = my_tid(wv0), lane = tid & 63;
  u16* HN = (u16*)(p->ws + OFF_HN);
  for (int row = blockIdx.x * 8 + wv0; row < T_; row += gridDim.x * 8) {
    const float4* xr = (const float4*)(p->x + (size_t)row * 1024);
    float4 v[4];
    float ss = 0.f;
#pragma unroll
    for (int r = 0; r < 4; ++r) {
      v[r] = xr[lane + 64 * r];
      ss += v[r].x * v[r].x + v[r].y * v[r].y + v[r].z * v[r].z + v[r].w * v[r].w;
    }
    ss = wave_sum(ss);
    const float rinv = rsqrtf(ss * (1.f / 1024.f) + 1e-6f);
#pragma unroll
    for (int r = 0; r < 4; ++r) {
      const float4 g = ((const float4*)p->g1)[lane + 64 * r];
      uint2 o;
      o.x = pk2(v[r].x * rinv * g.x, v[r].y * rinv * g.y);
      o.y = pk2(v[r].z * rinv * g.z, v[r].w * rinv * g.w);
      *(uint2*)(HN + (size_t)row * 1024 + (lane + 64 * r) * 4) = o;
    }
  }
  for (int jt = blockIdx.x; jt < NXT_A + 32; jt += gridDim.x) {
    if (jt < NXT_A) {
      xpose_tile(wv0, p, jt, smem);
    } else {
      const int item = jt - NXT_A, kv = item >> 4, slice = item & 15;
      const float* w1 = kv ? p->vw1 : p->kw1;
      const int col = tid & 255, h = tid >> 8, kb = slice * 128 + h * 64;
      float s0 = 0.f, s1 = 0.f, s2 = 0.f, s3 = 0.f;
      for (int k = kb; k < kb + 64; k += 4) {
        s0 += p->pe[k] * w1[(size_t)k * 256 + col];
        s1 += p->pe[k + 1] * w1[(size_t)(k + 1) * 256 + col];
        s2 += p->pe[k + 2] * w1[(size_t)(k + 2) * 256 + col];
        s3 += p->pe[k + 3] * w1[(size_t)(k + 3) * 256 + col];
      }
      ((float*)(p->ws + OFF_CBP))[(kv * 32 + slice * 2 + h) * 256 + col] = (s0 + s1) + (s2 + s3);
    }
  }
  float* rope = (float*)(p->ws + OFF_ROPE);
  for (int i = blockIdx.x * NT_ + tid; i < S_ * 8; i += gridDim.x * NT_) {
    const int pos = i >> 3, k = i & 7;
    const float inv = powf(500000.0f, -(2.0f * (float)k) / 16.0f);
    const float ang = (float)pos * inv;
    rope[pos * 16 + k] = cosf(ang);
    rope[pos * 16 + 8 + k] = sinf(ang);
  }
  if (blockIdx.x == 0 && tid < 64) ((int*)(p->ws + OFF_CTR))[tid] = 0;
}

DI void phaseB(int wv0, PP p, unsigned char* smem) {
  const u16* HN = (const u16*)(p->ws + OFF_HN);
  const u16* WT = (const u16*)(p->ws + OFF_WINT);
  const float* rope = (const float*)(p->ws + OFF_ROPE);
  const int lane = my_tid(wv0) & 63;
  const bool ropewave = (wv0 & 1) == 0;
  for (int id = blockIdx.x; id < 128 * 16; id += gridDim.x) {
    int pm, pn;
    tile_map_n16(id, pm, pn);
    const int brow = pm * 256, bcol = pn * 256;
    f32x4 acc[2][2][4][2];
    gemm256(wv0, acc, HN + (size_t)brow * 1024, 1024, WT + (size_t)bcol * 1024, 1024, 1024, smem);
    if (pn < 2) {
      u16* QR = (u16*)(p->ws + OFF_QRAW);
      u16* QO = (u16*)(p->ws + OFF_QROT);
      epi256(wv0, acc, brow, bcol, [&](int ai, int bj, int m, int n, int row, int col0, f32x4& v) {
        f32x4 r = v;
        if (n == 0 && ropewave) {
          const int pos = row & (S_ - 1), kq = ((lane >> 4) & 1) * 4;
          const float4 c4 = *(const float4*)(rope + pos * 16 + kq), s4 = *(const float4*)(rope + pos * 16 + 8 + kq);
          const float cc[4] = {c4.x, c4.y, c4.z, c4.w}, ss[4] = {s4.x, s4.y, s4.z, s4.w};
#pragma unroll
          for (int j = 0; j < 4; ++j) {
            const float pr = __shfl_xor(v[j], 32);
            r[j] = (lane & 32) ? (v[j] * cc[j] + pr * ss[j]) : (v[j] * cc[j] - pr * ss[j]);
          }
        }
        *(uint2*)(QR + (size_t)row * 512 + col0) = pk4(v[0] * QSCALE, v[1] * QSCALE, v[2] * QSCALE, v[3] * QSCALE);
        *(uint2*)(QO + (size_t)row * 512 + col0) = pk4(r[0] * QSCALE, r[1] * QSCALE, r[2] * QSCALE, r[3] * QSCALE);
      });
    } else if (pn < 5) {
      epi256(wv0, acc, brow, bcol, [&](int ai, int bj, int m, int n, int row, int col0, f32x4& v) {
        const int sub = (pn - 2) * 2 + bj;
        const bool dorope = (sub == 2 || sub == 4), transposed = (sub == 3 || sub == 5);
        u16* dst = (u16*)(p->ws + OFF_KCIN + (size_t)sub * 8 * MB);
        const int c128 = col0 & 127, g = c128 >> 6, d0 = c128 & 63;
        const int b = row >> 13, sq = row & (S_ - 1);
        f32x4 r = v;
        if (dorope && n == 0 && ropewave) {
          const int kq = ((lane >> 4) & 1) * 4;
          const float4 c4 = *(const float4*)(rope + sq * 16 + kq), s4 = *(const float4*)(rope + sq * 16 + 8 + kq);
          const float cc[4] = {c4.x, c4.y, c4.z, c4.w}, ss[4] = {s4.x, s4.y, s4.z, s4.w};
#pragma unroll
          for (int j = 0; j < 4; ++j) {
            const float pr = __shfl_xor(v[j], 32);
            r[j] = (lane & 32) ? (v[j] * cc[j] + pr * ss[j]) : (v[j] * cc[j] - pr * ss[j]);
          }
        }
        if (transposed) {
#pragma unroll
          for (int j = 0; j < 4; ++j) dst[((size_t)((b * 2 + g) * 64 + d0 + j)) * S_ + sq] = f2bf(r[j]);
        } else {
          *(uint2*)(dst + ((size_t)(b * 2 + g) * S_ + sq) * 64 + d0) = pk4(r[0], r[1], r[2], r[3]);
        }
      });
    } else if (pn < 7) {
      u16* U = (u16*)(p->ws + OFF_U);
      epi256(wv0, acc, brow, bcol, [&](int ai, int bj, int m, int n, int row, int col0, f32x4& v) {
        *(uint2*)(U + (size_t)row * 512 + (col0 - 1280)) = pk4(v[0], v[1], v[2], v[3]);
      });
    } else if (pn < 15) {
      u16* MG = (u16*)(p->ws + OFF_MG);
      epi256(wv0, acc, brow, bcol, [&](int ai, int bj, int m, int n, int row, int col0, f32x4& v) {
        *(uint2*)(MG + (size_t)row * 2048 + (col0 - 1792)) = pk4(sigmoidf_(v[0]), sigmoidf_(v[1]), sigmoidf_(v[2]), sigmoidf_(v[3]));
      });
    } else {
      float* NG = (float*)(p->ws + OFF_NG);
      epi256(wv0, acc, brow, bcol, [&](int ai, int bj, int m, int n, int row, int col0, f32x4& v) {
        const int cc = col0 - 3840;
        if (cc < 24) *(float4*)(NG + (size_t)row * 24 + cc) = make_float4(sigmoidf_(v[0]), sigmoidf_(v[1]), sigmoidf_(v[2]), sigmoidf_(v[3]));
      });
    }
  }
}

struct S5c {
  float lbr, lbi;
  float br[16], bi[16];
};
DI void s5_setup(PP p, int g, int n, S5c& c) {
  const float step = expf(p->log_step[g]);
  const float lr = p->lam_re[g * 64 + n], li = p->lam_im[g * 64 + n];
  const float er = expf(lr * step);
  float sn, cs;
  sincosf(li * step, &sn, &cs);
  c.lbr = er * cs;
  c.lbi = er * sn;
  const float nr = c.lbr - 1.f, ni = c.lbi, den = lr * lr + li * li;
  const float cr = (nr * lr + ni * li) / den, ci = (ni * lr - nr * li) / den;
#pragma unroll
  for (int k = 0; k < 16; ++k) {
    const float bre = p->b_re[(g * 64 + n) * 16 + k], bim = p->b_im[(g * 64 + n) * 16 + k];
    c.br[k] = cr * bre - ci * bim;
    c.bi[k] = cr * bim + ci * bre;
  }
}
DI void s5_load_u(PP p, int b, int ch, int g, float* su, int lane) {
  const u16* U = (const u16*)(p->ws + OFF_U) + ((size_t)(b * S_ + ch * 64 + lane)) * 512 + g * 16;
  const uint4 a = *(const uint4*)U, c = *(const uint4*)(U + 8);
  float* d = su + lane * 16;
  const unsigned w[8] = {a.x, a.y, a.z, a.w, c.x, c.y, c.z, c.w};
#pragma unroll
  for (int k = 0; k < 8; ++k) {
    d[2 * k] = __uint_as_float(w[k] << 16);
    d[2 * k + 1] = __uint_as_float(w[k] & 0xffff0000u);
  }
}
DI void s5_step(const S5c& c, const float* ut, float& hr, float& hi) {
  float bur = 0.f, bui = 0.f;
#pragma unroll
  for (int k4 = 0; k4 < 4; ++k4) {
    const float4 u = *(const float4*)(ut + 4 * k4);
    bur += c.br[4 * k4] * u.x + c.br[4 * k4 + 1] * u.y + c.br[4 * k4 + 2] * u.z + c.br[4 * k4 + 3] * u.w;
    bui += c.bi[4 * k4] * u.x + c.bi[4 * k4 + 1] * u.y + c.bi[4 * k4 + 2] * u.z + c.bi[4 * k4 + 3] * u.w;
  }
  const float nr = c.lbr * hr - c.lbi * hi + bur;
  const float nim = c.lbr * hi + c.lbi * hr + bui;
  hr = nr;
  hi = nim;
}
template <bool OUT>
DI void s5_item(int wv0, PP p, int item, unsigned char* smem) {
  const int tid = my_tid(wv0), lane = tid & 63, fr = lane & 15, fq = lane >> 4;
  const int b = item >> 9, g = (item >> 4) & 31, c8 = item & 15, ch = c8 * 8 + wv0;
  u16* sBb = (u16*)smem;
  u16* sCm = sBb + 128 * 16;
  float* sBU = (float*)(smem + 8192) + wv0 * (16 * 132);
  u16* sH = (u16*)(smem + 8192 + 8 * 16 * 132 * 4) + wv0 * (16 * 136);
  const float step = expf(p->log_step[g]);
  for (int e = tid; e < 2048; e += NT_) {
    const int np = e >> 4, c = e & 15, n = np & 63;
    const float lr = p->lam_re[g * 64 + n], li = p->lam_im[g * 64 + n];
    const float er = expf(lr * step);
    float sn, cs;
    sincosf(li * step, &sn, &cs);
    const float nr = er * cs - 1.f, ni = er * sn, den = lr * lr + li * li;
    const float cr = (nr * lr + ni * li) / den, ci = (ni * lr - nr * li) / den;
    const float bre = p->b_re[(g * 64 + n) * 16 + c], bim = p->b_im[(g * 64 + n) * 16 + c];
    sBb[np * 16 + c] = f2bf(np < 64 ? (cr * bre - ci * bim) : (cr * bim + ci * bre));
  }
  if (OUT) {
    for (int e = tid; e < 2048; e += NT_) {
      const int cc = e >> 7, k = e & 127;
      sCm[cc * 128 + k] = f2bf(k < 64 ? p->c_re[(g * 16 + cc) * 64 + k] : -p->c_im[(g * 16 + cc) * 64 + (k - 64)]);
    }
  }
  float lbr, lbi;
  {
    const float lr = p->lam_re[g * 64 + lane], li = p->lam_im[g * 64 + lane];
    const float er = expf(lr * step);
    float sn, cs;
    sincosf(li * step, &sn, &cs);
    lbr = er * cs;
    lbi = er * sn;
  }
  float2* HL = (float2*)(p->ws + OFF_HLOC) + ((size_t)(b * 128 + ch) * 32 + g) * 64 + lane;
  float hr = 0.f, hi = 0.f;
  if (OUT) { const float2 h0 = *HL; hr = h0.x; hi = h0.y; }
  const u16* U = (const u16*)(p->ws + OFF_U) + ((size_t)(b * S_ + ch * 64)) * 512 + g * 16;
  u16* YS = (u16*)(p->ws + OFF_YS) + ((size_t)(b * S_ + ch * 64)) * 512 + g * 16;
  const float dk = p->dsk[g * 16 + fr];
  __syncthreads();
  const bf16x8 zero8 = {0, 0, 0, 0, 0, 0, 0, 0};
  bf16x8 bb[8], cf[4];
#pragma unroll
  for (int nt = 0; nt < 8; ++nt) bb[nt] = fq < 2 ? *(const bf16x8*)(sBb + (16 * nt + fr) * 16 + 8 * fq) : zero8;
  if (OUT) {
#pragma unroll
    for (int ks = 0; ks < 4; ++ks) cf[ks] = *(const bf16x8*)(sCm + fr * 128 + 32 * ks + 8 * fq);
  }
#pragma unroll 1
  for (int sub = 0; sub < 4; ++sub) {
    const bf16x8 ua = fq < 2 ? *(const bf16x8*)(U + (size_t)(sub * 16 + fr) * 512 + 8 * fq) : zero8;
#pragma unroll
    for (int nt = 0; nt < 8; ++nt) {
      const f32x4 a = mfma16(ua, bb[nt], f32x4{0.f, 0.f, 0.f, 0.f});
#pragma unroll
      for (int j = 0; j < 4; ++j) sBU[(4 * fq + j) * 132 + 16 * nt + fr] = a[j];
    }
    __syncthreads();
#pragma unroll 4
    for (int t = 0; t < 16; ++t) {
      const float bur = sBU[t * 132 + lane], bui = sBU[t * 132 + 64 + lane];
      const float nr = lbr * hr - lbi * hi + bur;
      const float nim = lbr * hi + lbi * hr + bui;
      hr = nr;
      hi = nim;
      if (OUT) {
        sH[t * 136 + lane] = f2bf(hr);
        sH[t * 136 + 64 + lane] = f2bf(hi);
      }
    }
    __syncthreads();
    if (OUT) {
      f32x4 y = {0.f, 0.f, 0.f, 0.f};
#pragma unroll
      for (int ks = 0; ks < 4; ++ks) y = mfma16(*(const bf16x8*)(sH + fr * 136 + 32 * ks + 8 * fq), cf[ks], y);
#pragma unroll
      for (int j = 0; j < 4; ++j) {
        const size_t o = (size_t)(sub * 16 + 4 * fq + j) * 512 + fr;
        YS[o] = f2bf(gelu_t(y[j] + dk * bf2f(U[o])));
      }
      __syncthreads();
    }
  }
  if (!OUT) *HL = make_float2(hr, hi);
  __syncthreads();
}
DI void s5_carry(int wv0, PP p) {
  const int x = blockIdx.x * NT_ + my_tid(wv0);
  if (x >= 8192) return;
  const int b = x >> 11, g = (x >> 6) & 31, n = x & 63;
  const float step = expf(p->log_step[g]);
  const float lr = p->lam_re[g * 64 + n], li = p->lam_im[g * 64 + n];
  const float er = expf(64.f * lr * step);
  float sn, cs;
  sincosf(64.f * li * step, &sn, &cs);
  const float Lr = er * cs, Li = er * sn;
  float2* HL = (float2*)(p->ws + OFF_HLOC) + (size_t)b * 128 * 2048 + g * 64 + n;
  float hr = 0.f, hi = 0.f;
  for (int c0 = 0; c0 < 128; c0 += 16) {
    float2 v[16];
#pragma unroll
    for (int k = 0; k < 16; ++k) v[k] = HL[(size_t)(c0 + k) * 2048];
#pragma unroll
    for (int k = 0; k < 16; ++k) {
      HL[(size_t)(c0 + k) * 2048] = make_float2(hr, hi);
      const float nr = Lr * hr - Li * hi + v[k].x;
      const float nim = Lr * hi + Li * hr + v[k].y;
      hr = nr;
      hi = nim;
    }
  }
}
DI void phaseC(int wv0, PP p, unsigned char* smem) {
  const float* cbp = (const float*)(p->ws + OFF_CBP);
  for (int id = blockIdx.x; id < 32 + 2048 + 256; id += gridDim.x) {
    if (id >= 32 + 2048) {
      const int it = id - (32 + 2048), tns = it >> 7, bg = (it >> 4) & 7, part = it & 15;
      const int tid = my_tid(wv0);
      const u16* K = (const u16*)(p->ws + (tns ? OFF_KW : OFF_KS)) + ((size_t)bg * S_ + part * 512 + tid) * 64;
      float q2 = 0.f;
#pragma unroll
      for (int c = 0; c < 8; ++c) {
        const uint4 w = *(const uint4*)(K + c * 8);
        const unsigned ww[4] = {w.x, w.y, w.z, w.w};
#pragma unroll
        for (int e = 0; e < 4; ++e) {
          const float a = __uint_as_float(ww[e] << 16), b2 = __uint_as_float(ww[e] & 0xffff0000u);
          q2 += a * a + b2 * b2;
        }
      }
#pragma unroll
      for (int o = 32; o > 0; o >>= 1) q2 = fmaxf(q2, __shfl_xor(q2, o));
      if ((tid & 63) == 0) atomicMax((unsigned*)(p->ws + OFF_KMAX) + tns * 8 + bg, __float_as_uint(q2));
    } else if (id < 32) {
      const int kv = id >> 4, pm = id & 15, brow = pm * 256;
      const u16* A = (const u16*)(p->ws + (kv ? OFF_VCIN : OFF_KCIN)) + (size_t)brow * 1024;
      const u16* Bt = (const u16*)(p->ws + (kv ? OFF_W1VT : OFF_W1KT));
      f32x4 acc[2][2][4][2];
      gemm256(wv0, acc, A, 1024, Bt, 2048, 2048, smem);
      u16* HC = (u16*)(p->ws + OFF_HC) + (size_t)kv * 4096 * 256;
      epi256(wv0, acc, brow, 0, [&](int ai, int bj, int m, int n, int row, int col0, f32x4& v) {
        float4 bb = make_float4(0.f, 0.f, 0.f, 0.f);
#pragma unroll 8
        for (int sl = 0; sl < 32; ++sl) {
          const float4 t = *(const float4*)(cbp + (kv * 32 + sl) * 256 + col0);
          bb.x += t.x; bb.y += t.y; bb.z += t.z; bb.w += t.w;
        }
        *(uint2*)(HC + (size_t)row * 256 + col0) = pk4(gelu_t(v[0] + bb.x), gelu_t(v[1] + bb.y), gelu_t(v[2] + bb.z), gelu_t(v[3] + bb.w));
      });
    } else {
      s5_item<false>(wv0, p, id - 32, smem);
    }
  }
}
DI void phaseD(int wv0, PP p, unsigned char* smem) {
  for (int id = blockIdx.x; id < 32; id += gridDim.x) {
    const int kv = id >> 4, pm = id & 15, brow = pm * 256;
    const u16* A = (const u16*)(p->ws + OFF_HC) + (size_t)kv * 4096 * 256 + (size_t)brow * 256;
    const u16* Bt = (const u16*)(p->ws + (kv ? OFF_W2VT : OFF_W2KT));
    f32x4 acc[2][2][4][2];
    gemm256(wv0, acc, A, 256, Bt, 256, 256, smem);
    u16* KCC = (u16*)(p->ws + OFF_KCC);
    u16* VCT = (u16*)(p->ws + OFF_VCT);
    epi256(wv0, acc, brow, 0, [&](int ai, int bj, int m, int n, int row, int col0, f32x4& v) {
      if (col0 < 64) {
        const int bg = row >> 9, nn = row & 511;
        f32x4 r = v;
        if (nn == 511) r = f32x4{0.f, 0.f, 0.f, 0.f};
        if (kv == 0) {
          *(uint2*)(KCC + ((size_t)bg * 512 + nn) * 64 + col0) = pk4(r[0], r[1], r[2], r[3]);
        } else {
#pragma unroll
          for (int j = 0; j < 4; ++j) VCT[((size_t)bg * 64 + col0 + j) * 512 + nn] = f2bf(r[j]);
        }
      }
    });
  }
  s5_carry(wv0, p);
}

DI bool bit128(u64 lo, u64 hi, int j) { return j < 64 ? ((lo >> j) & 1ull) : ((hi >> (j - 64)) & 1ull); }
DI int next_bit(u64 lo, u64 hi, int from) {
  if (from < 64) {
    const u64 x = (lo >> from) << from;
    if (x) return __ffsll((long long)x) - 1;
    from = 64;
  }
  if (from >= 128) return -1;
  const u64 y = (hi >> (from - 64)) << (from - 64);
  return y ? 63 + __ffsll((long long)y) : -1;
}

template <int MODE, bool MASKED, class MaskF>
DI void flash_tile(const u16* sK, const u16* sV, const bf16x8 (&qf)[2][2], f32x4 (&O)[2][4], float (&m)[2], float (&l)[2],
                   float (&ps)[4][4], MaskF ok, bool sel, int lane) {
  const int l15 = lane & 15, lg = lane >> 4;
  bf16x8 kf[4][2];
#pragma unroll
  for (int kt = 0; kt < 4; ++kt)
#pragma unroll
    for (int ks = 0; ks < 2; ++ks) kf[kt][ks] = *(const bf16x8*)(sK + (16 * kt + l15) * 72 + ks * 32 + lg * 8);
  if (MODE == 1) {
#pragma unroll
    for (int a = 0; a < 4; ++a)
#pragma unroll
      for (int b = 0; b < 4; ++b) ps[a][b] = 0.f;
  }
#pragma unroll
  for (int qt = 0; qt < 2; ++qt) {
    f32x4 s[4];
    const float sinit = (MODE == 3) ? ((MASKED || sel) ? m[qt] : -1e30f) : 0.f;
#pragma unroll
    for (int kt = 0; kt < 4; ++kt) {
      s[kt] = f32x4{sinit, sinit, sinit, sinit};
#pragma unroll
      for (int ks = 0; ks < 2; ++ks) s[kt] = mfma16(kf[kt][ks], qf[qt][ks], s[kt]);
    }
    float pr[4][4];
    if (MODE == 3) {
      float rs = 0.f;
#pragma unroll
      for (int kt = 0; kt < 4; ++kt)
#pragma unroll
        for (int i = 0; i < 4; ++i) {
          float pv = __builtin_amdgcn_exp2f(s[kt][i]);
          if (MASKED) pv = ok(kt, i) ? pv : 0.f;
          pr[kt][i] = pv;
          rs += pv;
        }
      l[qt] += rs;
    } else {
    float mx = -1e30f;
#pragma unroll
    for (int kt = 0; kt < 4; ++kt)
#pragma unroll
      for (int i = 0; i < 4; ++i) {
        if (MASKED) s[kt][i] = ok(kt, i) ? s[kt][i] : -1e30f;
        mx = fmaxf(mx, s[kt][i]);
      }
    if (!MASKED) mx = sel ? mx : -1e30f;
    if (MODE == 1) {
      const float mm = m[qt], il = l[qt];
#pragma unroll
      for (int kt = 0; kt < 4; ++kt)
#pragma unroll
        for (int i = 0; i < 4; ++i) {
          const float pv = (s[kt][i] > -1e29f) ? __builtin_amdgcn_exp2f(s[kt][i] - mm) * il : 0.f;
          pr[kt][i] = pv;
          ps[kt][i] += pv;
        }
    } else {
      mx = fmaxf(mx, __shfl_xor(mx, 16));
      mx = fmaxf(mx, __shfl_xor(mx, 32));
      const float mnew = fmaxf(m[qt], mx);
      const float alpha = __builtin_amdgcn_exp2f(m[qt] - mnew);
      m[qt] = mnew;
      float rs = 0.f;
      if (MASKED) {
#pragma unroll
        for (int kt = 0; kt < 4; ++kt)
#pragma unroll
          for (int i = 0; i < 4; ++i) {
            const float pv = (s[kt][i] > -1e29f) ? __builtin_amdgcn_exp2f(s[kt][i] - mnew) : 0.f;
            pr[kt][i] = pv;
            rs += pv;
          }
      } else {
        const float me = sel ? mnew : 1e30f;
#pragma unroll
        for (int kt = 0; kt < 4; ++kt)
#pragma unroll
          for (int i = 0; i < 4; ++i) {
            const float pv = __builtin_amdgcn_exp2f(s[kt][i] - me);
            pr[kt][i] = pv;
            rs += pv;
          }
      }
      l[qt] = l[qt] * alpha + rs;
      if (MODE == 2) {
#pragma unroll
        for (int dt = 0; dt < 4; ++dt) O[qt][dt] *= alpha;
      }
    }
    }
    if (MODE != 0) {
#pragma unroll
      for (int ks2 = 0; ks2 < 2; ++ks2) {
        union { unsigned u[4]; bf16x8 v; } pf;
        pf.u[0] = pk2(pr[2 * ks2][0], pr[2 * ks2][1]);
        pf.u[1] = pk2(pr[2 * ks2][2], pr[2 * ks2][3]);
        pf.u[2] = pk2(pr[2 * ks2 + 1][0], pr[2 * ks2 + 1][1]);
        pf.u[3] = pk2(pr[2 * ks2 + 1][2], pr[2 * ks2 + 1][3]);
#pragma unroll
        for (int dt = 0; dt < 4; ++dt) {
          union { uint2 h[2]; bf16x8 v; } vf;
          vf.h[0] = *(const uint2*)(sV + (16 * dt + l15) * 72 + 32 * ks2 + 4 * lg);
          vf.h[1] = *(const uint2*)(sV + (16 * dt + l15) * 72 + 32 * ks2 + 16 + 4 * lg);
          O[qt][dt] = mfma16(vf.v, pf.v, O[qt][dt]);
        }
      }
    }

  }
}

DI void nsa_item(int wv0, PP p, int item, unsigned char* smem) {
  const int tid = my_tid(wv0), lane = tid & 63, wv = wv0 & 3, hp = wv0 >> 2, l15 = lane & 15, lg = lane >> 4;
  const int i = 127 - (item >> 3), bg = item & 7, b = bg >> 1, g = bg & 1;
  u16* sK = (u16*)smem;
  u16* sV = sK + 64 * 72;
  float* sImp0 = (float*)(smem + 18432);
  float* sImp = sImp0 + hp * (64 * 132);
  u64* sUni = (u64*)(smem + 18432 + 2 * 64 * 132 * 4);
  u64* sSel = sUni + 16;
  const int t0 = i * 64, qloc = 16 * wv + l15, tq = t0 + qloc;
  const unsigned tokq = (unsigned)(b * S_ + tq);
  const float* NGb = (const float*)(p->ws + OFF_NG);
  const unsigned ngoff = tokq * 24 + g * 12 + hp * 6;
  float* ACCb = p->out;
  const unsigned aoff = tokq * 512 + g * 256 + hp * 128 + 4 * lg;
  const unsigned qoff = tokq * 512 + g * 256 + hp * 128 + lg * 8;
  const int lrow = tid >> 3, lpart = tid & 7;
  const unsigned koff = (lrow * 64 + lpart * 8) * 2, voffc = (lrow * 512 + lpart * 8) * 2, voffs = (lrow * S_ + lpart * 8) * 2;

  for (int e = tid; e < 2 * 64 * 132; e += NT_) sImp0[e] = 0.f;

  bf16x8 qf[2][2];
  f32x4 O[2][4];
  float m[2], l[2], ps[4][4];
  u32x4 pk0, pv0;
  auto nomask = [](int, int) { return true; };

#define MAKE_RSRC(PTR) __builtin_amdgcn_make_buffer_rsrc((void*)(PTR), 0, 0x7fffffff, 0x00020000)
#define BLOAD(R, VO, SO) __builtin_amdgcn_raw_buffer_load_b128((R), (int)(VO), (int)(SO), 0)
#define ISSUE_TILE(RK, RV, T, LDV)                                                   \
  {                                                                                  \
    pk0 = BLOAD(RK, koff, (T)*8192);                                                 \
    pv0 = BLOAD(RV, ((LDV) == 512) ? voffc : voffs, (T)*128);                        \
  }
#define COMMIT_TILE()                                                                \
  {                                                                                  \
    *(u32x4*)(sK + lrow * 72 + lpart * 8) = pk0;                                     \
    *(u32x4*)(sV + lrow * 72 + lpart * 8) = pv0;                                     \
  }
#define LOAD_Q(BASE)                                                                 \
  {                                                                                  \
    const u16* Q_ = (const u16*)(p->ws + (BASE));                                    \
    _Pragma("unroll") for (int qt = 0; qt < 2; ++qt)                                 \
      _Pragma("unroll") for (int ks = 0; ks < 2; ++ks)                               \
        qf[qt][ks] = *(const bf16x8*)(Q_ + (qoff + qt * 64 + ks * 32));             \
  }
#define RESET_STATE()                                                                \
  {                                                                                  \
    _Pragma("unroll") for (int qt = 0; qt < 2; ++qt) { m[qt] = -1e30f; l[qt] = 0.f; } \
    _Pragma("unroll") for (int a = 0; a < 2; ++a)                                    \
      _Pragma("unroll") for (int c = 0; c < 4; ++c) O[a][c] = f32x4{0.f, 0.f, 0.f, 0.f}; \
  }

  {
    const u16* Kc0 = (const u16*)(p->ws + OFF_KCC) + (size_t)bg * 512 * 64;
    const u16* Vc0 = (const u16*)(p->ws + OFF_VCT) + (size_t)bg * 64 * 512;
    const int nE = (4 * i + 3) < 511 ? (4 * i + 3) : 511;
    const int nkb = (nE + 63) >> 6;
    const __amdgpu_buffer_rsrc_t rK = MAKE_RSRC(Kc0), rV = MAKE_RSRC(Vc0);
    LOAD_Q(OFF_QRAW)
    RESET_STATE()
    ISSUE_TILE(rK, rV, 0, 512)
    for (int kb = 0; kb < nkb; ++kb) {
      __syncthreads();
      COMMIT_TILE()
      __syncthreads();
      if (kb + 1 < nkb) ISSUE_TILE(rK, rV, kb + 1, 512)
      auto ok = [&](int kt, int ii) { return 16 * (kb * 64 + 16 * kt + 4 * lg + ii) + 31 <= tq; };
      flash_tile<0, true>(sK, sV, qf, O, m, l, ps, ok, true, lane);
    }
#pragma unroll
    for (int qt = 0; qt < 2; ++qt) {
      float s = l[qt];
      s += __shfl_xor(s, 16);
      s += __shfl_xor(s, 32);
      l[qt] = s > 0.f ? 1.f / s : 0.f;
    }
    ISSUE_TILE(rK, rV, 0, 512)
    for (int kb = 0; kb < nkb; ++kb) {
      __syncthreads();
      COMMIT_TILE()
      __syncthreads();
      if (kb + 1 < nkb) ISSUE_TILE(rK, rV, kb + 1, 512)
      auto ok = [&](int kt, int ii) { return 16 * (kb * 64 + 16 * kt + 4 * lg + ii) + 31 <= tq; };
      flash_tile<1, true>(sK, sV, qf, O, m, l, ps, ok, true, lane);
#pragma unroll
      for (int kt = 0; kt < 4; ++kt) {
        const int j = kb * 16 + kt * 4 + lg;
        sImp[qloc * 132 + j] += ps[kt][0] + ps[kt][1] + ps[kt][2] + ps[kt][3];
      }
      __syncthreads();
#pragma unroll
      for (int kt = 0; kt < 4; ++kt) {
        const int j1 = kb * 16 + kt * 4 + lg + 1;
        if (j1 < 128) sImp[qloc * 132 + j1] += ps[kt][3];
      }
    }
#pragma unroll
    for (int qt = 0; qt < 2; ++qt) {
      const float gt = NGb[ngoff + qt * 3 + 0];
#pragma unroll
      for (int dt = 0; dt < 4; ++dt) {
        float4 o = make_float4(O[qt][dt][0] * gt, O[qt][dt][1] * gt, O[qt][dt][2] * gt, O[qt][dt][3] * gt);
        *(float4*)(ACCb + (aoff + qt * 64 + 16 * dt)) = o;
      }
    }
  }
  __syncthreads();
  u64 mlo = 0, mhi = 0, wlo = 0, whi = 0;
  if (i < 16) {
    mlo = (1ull << (i + 1)) - 1ull;
    wlo = mlo;
  } else {
    const bool v0 = lane <= i, v1 = (lane + 64) <= i;
    const bool f0 = (lane == 0) || (lane == i) || (lane == i - 1);
    const bool f1 = (lane + 64 == i) || (lane + 64 == i - 1);
    const u64 ltm = (1ull << lane) - 1ull;
    for (int qq = hp * 8; qq < hp * 8 + 8; ++qq) {
      const float* ir = sImp0 + (16 * wv + qq) * 132;
      const float i0 = ir[lane] + ir[64 * 132 + lane], i1 = ir[lane + 64] + ir[64 * 132 + lane + 64];
      const unsigned k0 = v0 ? __float_as_uint(i0 + (f0 ? 1000.f : 0.f)) : 0u;
      const unsigned k1 = v1 ? __float_as_uint(i1 + (f1 ? 1000.f : 0.f)) : 0u;
      unsigned T = 0;
      for (int bit = 30; bit >= 0; --bit) {
        const unsigned cand = T | (1u << bit);
        const int cnt = __popcll(__ballot(k0 >= cand)) + __popcll(__ballot(k1 >= cand));
        if (cnt >= 16) T = cand;
      }
      const bool g0 = k0 > T, g1 = k1 > T, e0 = k0 == T, e1 = k1 == T;
      const int need = 16 - (__popcll(__ballot(g0)) + __popcll(__ballot(g1)));
      const u64 be0 = __ballot(e0), be1 = __ballot(e1);
      const int r0 = __popcll(be0 & ltm), r1 = __popcll(be0) + __popcll(be1 & ltm);
      const u64 s0 = __ballot(v0 && (g0 || (e0 && r0 < need)));
      const u64 s1 = __ballot(v1 && (g1 || (e1 && r1 < need)));
      wlo |= s0;
      whi |= s1;
      if (lane == 0) { sSel[(16 * wv + qq) * 2] = s0; sSel[(16 * wv + qq) * 2 + 1] = s1; }
    }
  }
  if (lane == 0) { sUni[wv0 * 2] = wlo; sUni[wv0 * 2 + 1] = whi; }
  __syncthreads();
  if (i >= 16) { mlo = sSel[qloc * 2]; mhi = sSel[qloc * 2 + 1]; }
  wlo = sUni[wv * 2] | sUni[(wv + 4) * 2];
  whi = sUni[wv * 2 + 1] | sUni[(wv + 4) * 2 + 1];
  const u64 blo = sUni[0] | sUni[2] | sUni[4] | sUni[6] | sUni[8] | sUni[10] | sUni[12] | sUni[14];
  const u64 bhi = sUni[1] | sUni[3] | sUni[5] | sUni[7] | sUni[9] | sUni[11] | sUni[13] | sUni[15];

  LOAD_Q(OFF_QROT)
  float nb_s[2], nb_w[2];
  bool usefix;
  {
    const float* KM = (const float*)(p->ws + OFF_KMAX);
    const float kms = KM[bg], kmw = KM[8 + bg];
    float bmax = 0.f;
#pragma unroll
    for (int qt = 0; qt < 2; ++qt) {
      float q2 = 0.f;
#pragma unroll
      for (int ks = 0; ks < 2; ++ks)
#pragma unroll
        for (int e = 0; e < 8; ++e) {
          const float qv = __uint_as_float(((unsigned)(u16)qf[qt][ks][e]) << 16);
          q2 += qv * qv;
        }
      q2 += __shfl_xor(q2, 16);
      q2 += __shfl_xor(q2, 32);
      const float bs = sqrtf(q2 * kms) * 1.001f + 1e-3f, bw = sqrtf(q2 * kmw) * 1.001f + 1e-3f;
      nb_s[qt] = -bs;
      nb_w[qt] = -bw;
      bmax = fmaxf(bmax, fmaxf(bs, bw));
    }
    usefix = __ballot(bmax > 60.f) == 0ull;
  }
  RESET_STATE()
  if (usefix) { m[0] = nb_s[0]; m[1] = nb_s[1]; }
  {
    const __amdgpu_buffer_rsrc_t rK = MAKE_RSRC((const u16*)(p->ws + OFF_KS) + (size_t)bg * S_ * 64);
    const __amdgpu_buffer_rsrc_t rV = MAKE_RSRC((const u16*)(p->ws + OFF_VST) + (size_t)bg * 64 * S_);
    int jn = next_bit(blo, bhi, 0);
    if (jn >= 0) ISSUE_TILE(rK, rV, jn, S_)
    while (jn >= 0) {
      const int j = jn;
      __syncthreads();
      COMMIT_TILE()
      __syncthreads();
      jn = next_bit(blo, bhi, j + 1);
      if (jn >= 0) ISSUE_TILE(rK, rV, jn, S_)
      if (bit128(wlo, whi, j)) {
        const bool sel = bit128(mlo, mhi, j);
        if (j == i) {
          auto ok = [&](int kt, int ii) { return sel && (16 * kt + 4 * lg + ii) <= qloc; };
          if (usefix) flash_tile<3, true>(sK, sV, qf, O, m, l, ps, ok, true, lane);
          else flash_tile<2, true>(sK, sV, qf, O, m, l, ps, ok, true, lane);
        } else {
          if (usefix) flash_tile<3, false>(sK, sV, qf, O, m, l, ps, nomask, sel, lane);
          else flash_tile<2, false>(sK, sV, qf, O, m, l, ps, nomask, sel, lane);
        }
      }
    }
  }
#pragma unroll
  for (int qt = 0; qt < 2; ++qt) {
    float s = l[qt];
    s += __shfl_xor(s, 16);
    s += __shfl_xor(s, 32);
    const float sc = NGb[ngoff + qt * 3 + 1] / s;
#pragma unroll
    for (int dt = 0; dt < 4; ++dt) {
      float4* a = (float4*)(ACCb + (aoff + qt * 64 + 16 * dt));
      float4 o = *a;
      o.x += O[qt][dt][0] * sc; o.y += O[qt][dt][1] * sc; o.z += O[qt][dt][2] * sc; o.w += O[qt][dt][3] * sc;
      *a = o;
    }
  }
  RESET_STATE()
  if (usefix) { m[0] = nb_w[0]; m[1] = nb_w[1]; }
  {
    const __amdgpu_buffer_rsrc_t rK = MAKE_RSRC((const u16*)(p->ws + OFF_KW) + (size_t)bg * S_ * 64);
    const __amdgpu_buffer_rsrc_t rV = MAKE_RSRC((const u16*)(p->ws + OFF_VWT) + (size_t)bg * 64 * S_);
    const int j0 = i >= 8 ? i - 8 : 0;
    ISSUE_TILE(rK, rV, j0, S_)
    for (int j = j0; j <= i; ++j) {
      __syncthreads();
      COMMIT_TILE()
      __syncthreads();
      if (j + 1 <= i) ISSUE_TILE(rK, rV, j + 1, S_)
      if (j == i || j == i - 8) {
        auto ok = [&](int kt, int ii) {
          const int kp = j * 64 + 16 * kt + 4 * lg + ii;
          return kp <= tq && kp > tq - 512;
        };
        if (usefix) flash_tile<3, true>(sK, sV, qf, O, m, l, ps, ok, true, lane);
        else flash_tile<2, true>(sK, sV, qf, O, m, l, ps, ok, true, lane);
      } else {
        if (usefix) flash_tile<3, false>(sK, sV, qf, O, m, l, ps, nomask, true, lane);
        else flash_tile<2, false>(sK, sV, qf, O, m, l, ps, nomask, true, lane);
      }
    }
  }
  u16* NSAb = (u16*)(p->ws + OFF_NSA);
#pragma unroll
  for (int qt = 0; qt < 2; ++qt) {
    float s = l[qt];
    s += __shfl_xor(s, 16);
    s += __shfl_xor(s, 32);
    const float sc = NGb[ngoff + qt * 3 + 2] / s;
#pragma unroll
    for (int dt = 0; dt < 4; ++dt) {
      const float4 a = *(const float4*)(ACCb + (aoff + qt * 64 + 16 * dt));
      uint2 o;
      o.x = pk2(a.x + O[qt][dt][0] * sc, a.y + O[qt][dt][1] * sc);
      o.y = pk2(a.z + O[qt][dt][2] * sc, a.w + O[qt][dt][3] * sc);
      *(uint2*)(NSAb + (aoff + qt * 64 + 16 * dt)) = o;
    }
  }
  __syncthreads();
}

DI void phaseE(int wv0, PP p, unsigned char* smem, int cidx) {
  __shared__ int s_item;
  int* ctr = (int*)(p->ws + OFF_CTR) + cidx;
  for (;;) {
    __syncthreads();
    if (my_tid(wv0) == 0) s_item = atomicAdd(ctr, 1);
    __syncthreads();
    const int item = s_item;
    if (item >= 1024 + 2048 + (NXT - NXT_A)) break;
    if (item < 1024) nsa_item(wv0, p, item, smem);
    else if (item < 1024 + 2048) s5_item<true>(wv0, p, item - 1024, smem);
    else xpose_tile(wv0, p, NXT_A + (item - 3072), smem);
  }
}

DI void phaseF(int wv0, PP p, unsigned char* smem) {
  const u16* YS = (const u16*)(p->ws + OFF_YS);
  const u16* NSA = (const u16*)(p->ws + OFF_NSA);
  const u16* MG = (const u16*)(p->ws + OFF_MG);
  u16* MR = (u16*)(p->ws + OFF_MERGED);
  for (int id = blockIdx.x; id < 128 * 4; id += gridDim.x) {
    int pm, pn;
    tile_map_n4(id, pm, pn);
    const int brow = pm * 256, bcol = pn * 256;
    f32x4 acc[2][2][4][2];
    gemm256(wv0, acc, YS + (size_t)brow * 512, 512, (const u16*)(p->ws + OFF_WGT) + (size_t)bcol * 512, 512, 512, smem);
    epi256(wv0, acc, brow, bcol, [&](int ai, int bj, int m, int n, int row, int col0, f32x4& v) {
      *(uint2*)(MR + (size_t)row * 1024 + col0) = pk4(sigmoidf_(v[0]), sigmoidf_(v[1]), sigmoidf_(v[2]), sigmoidf_(v[3]));
    });
    gemm256(wv0, acc, YS + (size_t)brow * 512, 512, (const u16*)(p->ws + OFF_WVT) + (size_t)bcol * 512, 512, 512, smem);
    epi256(wv0, acc, brow, bcol, [&](int ai, int bj, int m, int n, int row, int col0, f32x4& v) {
      const uint2 t = *(const uint2*)(MR + (size_t)row * 1024 + col0);
      const uint2 gq = *(const uint2*)(MG + (size_t)row * 2048 + 1024 + col0);
      *(uint2*)(MR + (size_t)row * 1024 + col0) =
          pk4(__uint_as_float(gq.x << 16) * v[0] * __uint_as_float(t.x << 16), __uint_as_float(gq.x & 0xffff0000u) * v[1] * __uint_as_float(t.x & 0xffff0000u),
              __uint_as_float(gq.y << 16) * v[2] * __uint_as_float(t.y << 16), __uint_as_float(gq.y & 0xffff0000u) * v[3] * __uint_as_float(t.y & 0xffff0000u));
    });
    gemm256(wv0, acc, NSA + (size_t)brow * 512, 512, (const u16*)(p->ws + OFF_WAT) + (size_t)bcol * 512, 512, 512, smem);
    epi256(wv0, acc, brow, bcol, [&](int ai, int bj, int m, int n, int row, int col0, f32x4& v) {
      const uint2 t = *(const uint2*)(MR + (size_t)row * 1024 + col0);
      const uint2 gq = *(const uint2*)(MG + (size_t)row * 2048 + col0);
      *(uint2*)(MR + (size_t)row * 1024 + col0) =
          pk4(__uint_as_float(gq.x << 16) * v[0] + __uint_as_float(t.x << 16), __uint_as_float(gq.x & 0xffff0000u) * v[1] + __uint_as_float(t.x & 0xffff0000u),
              __uint_as_float(gq.y << 16) * v[2] + __uint_as_float(t.y << 16), __uint_as_float(gq.y & 0xffff0000u) * v[3] + __uint_as_float(t.y & 0xffff0000u));
    });
  }
}
DI void ss_partial(int wv0, f32x4 (&acc)[2][2][4][2], float* SS, int brow, int pn) {
  const int lane = my_tid(wv0) & 63, wr = wv0 >> 2, wc = wv0 & 3;
#pragma unroll
  for (int ai = 0; ai < 2; ++ai)
#pragma unroll
    for (int m = 0; m < 4; ++m) {
      float s = 0.f;
#pragma unroll
      for (int bj = 0; bj < 2; ++bj)
#pragma unroll
        for (int n = 0; n < 2; ++n)
#pragma unroll
          for (int j = 0; j < 4; ++j) s += acc[ai][bj][m][n][j] * acc[ai][bj][m][n][j];
      s += __shfl_xor(s, 16);
      s += __shfl_xor(s, 32);
      if (lane < 16) SS[(size_t)(brow + ai * 128 + wr * 64 + m * 16 + lane) * 16 + pn * 4 + wc] = s;
    }
}
DI void phaseG(int wv0, PP p, unsigned char* smem) {
  const u16* MR = (const u16*)(p->ws + OFF_MERGED);
  u16* X1B = (u16*)(p->ws + OFF_X1B);
  float* SS1 = (float*)(p->ws + OFF_SS1);
  for (int id = blockIdx.x; id < 128 * 4; id += gridDim.x) {
    int pm, pn;
    tile_map_n4(id, pm, pn);
    const int brow = pm * 256, bcol = pn * 256;
    f32x4 acc[2][2][4][2];
    gemm256(wv0, acc, MR + (size_t)brow * 1024, 1024, (const u16*)(p->ws + OFF_WOT) + (size_t)bcol * 1024, 1024, 1024, smem);
    epi256(wv0, acc, brow, bcol, [&](int ai, int bj, int m, int n, int row, int col0, f32x4& v) {
      const size_t o = (size_t)row * 1024 + col0;
      const float4 xv = *(const float4*)(p->x + o);
      v[0] += xv.x; v[1] += xv.y; v[2] += xv.z; v[3] += xv.w;
      *(float4*)(p->out + o) = make_float4(v[0], v[1], v[2], v[3]);
      *(uint2*)(X1B + o) = pk4(v[0], v[1], v[2], v[3]);
    });
    ss_partial(wv0, acc, SS1, brow, pn);
  }
}
DI void phaseH(int wv0, PP p, unsigned char* smem) {
  const u16* X1B = (const u16*)(p->ws + OFF_X1B);
  const float* SS1 = (const float*)(p->ws + OFF_SS1);
  u16* ACT = (u16*)(p->ws + OFF_ACT);
  float* sR = (float*)(smem + 131072);
  for (int id = blockIdx.x; id < 128 * 16; id += gridDim.x) {
    int pm, pn;
    tile_map_n16(id, pm, pn);
    const int brow = pm * 256, bcol = pn * 256;
    const int tid = my_tid(wv0);
    if (tid < 256) {
      const float4* s = (const float4*)(SS1 + (size_t)(brow + tid) * 16);
      const float4 a = s[0], b = s[1], c = s[2], d = s[3];
      const float t = a.x + a.y + a.z + a.w + b.x + b.y + b.z + b.w + c.x + c.y + c.z + c.w + d.x + d.y + d.z + d.w;
      sR[tid] = rsqrtf(t * (1.f / 1024.f) + 1e-6f);
    }
    f32x4 acc[2][2][4][2];
    gemm256(wv0, acc, X1B + (size_t)brow * 1024, 1024, (const u16*)(p->ws + OFF_WUPT) + (size_t)bcol * 1024, 1024, 1024, smem);
    epi256(wv0, acc, brow, bcol, [&](int ai, int bj, int m, int n, int row, int col0, f32x4& v) {
      const float ri = sR[row - brow];
      const float a0 = fmaxf(v[0] * ri, 0.f), a1 = fmaxf(v[1] * ri, 0.f), a2 = fmaxf(v[2] * ri, 0.f), a3 = fmaxf(v[3] * ri, 0.f);
      *(uint2*)(ACT + (size_t)row * 4096 + col0) = pk4(a0 * a0, a1 * a1, a2 * a2, a3 * a3);
    });
    __syncthreads();
  }
}
DI void phaseI(int wv0, PP p, unsigned char* smem) {
  const u16* ACT = (const u16*)(p->ws + OFF_ACT);
  float* SS2 = (float*)(p->ws + OFF_SS2);
  for (int id = blockIdx.x; id < 128 * 4; id += gridDim.x) {
    int pm, pn;
    tile_map_n4(id, pm, pn);
    const int brow = pm * 256, bcol = pn * 256;
    f32x4 acc[2][2][4][2];
    gemm256(wv0, acc, ACT + (size_t)brow * 4096, 4096, (const u16*)(p->ws + OFF_WDT) + (size_t)bcol * 4096, 4096, 4096, smem);
    epi256(wv0, acc, brow, bcol, [&](int ai, int bj, int m, int n, int row, int col0, f32x4& v) {
      const size_t o = (size_t)row * 1024 + col0;
      const float4 xv = *(const float4*)(p->out + o);
      v[0] += xv.x; v[1] += xv.y; v[2] += xv.z; v[3] += xv.w;
      *(float4*)(p->out + o) = make_float4(v[0], v[1], v[2], v[3]);
    });
    ss_partial(wv0, acc, SS2, brow, pn);
  }
}
DI void phaseJ(int wv0, PP p) {
  const int lane = my_tid(wv0) & 63;
  const float* SS2 = (const float*)(p->ws + OFF_SS2);
  for (int row = blockIdx.x * 8 + wv0; row < T_; row += gridDim.x * 8) {
    float t = (lane < 16) ? SS2[(size_t)row * 16 + lane] : 0.f;
    t = wave_sum(t);
    const float rinv = rsqrtf(t * (1.f / 1024.f) + 1e-6f);
    float4* xr = (float4*)(p->out + (size_t)row * 1024);
#pragma unroll
    for (int r = 0; r < 4; ++r) {
      float4 v = xr[lane + 64 * r];
      const float4 g = ((const float4*)p->g3)[lane + 64 * r];
      v.x *= rinv * g.x; v.y *= rinv * g.y; v.z *= rinv * g.z; v.w *= rinv * g.w;
      xr[lane + 64 * r] = v;
    }
  }
}


#define XB_TMO      128
#define XB_XCNT(j)  (256  + 64 * (j))
#define XB_XSUB(j)  (1280 + 64 * (j))
#define XB_XGEN(j)  (2304 + 64 * (j))
#define XB_TOP      3328
#define XB_TOPGEN   3392
#define XB_SPIN_CAP (1u << 18)
#define LAS __attribute__((address_space(3)))
DI unsigned xb_ld(unsigned* p) { return __hip_atomic_load(p, __ATOMIC_RELAXED, __HIP_MEMORY_SCOPE_AGENT); }
DI unsigned xb_add(unsigned* p, unsigned v) { return __hip_atomic_fetch_add(p, v, __ATOMIC_RELAXED, __HIP_MEMORY_SCOPE_AGENT); }
DI unsigned xb_xcc_id() { return (unsigned)__builtin_amdgcn_s_getreg((3 << 11) | 20) & 0xFu; }
#define XB_SPIN(cond, bar) do { unsigned _sp = 0; while (cond) { __builtin_amdgcn_s_sleep(1); \
    if ((++_sp & 255u) == 0u) { if (xb_ld(&(bar)[XB_TMO])) break; if (_sp > XB_SPIN_CAP) { atomicAdd(&(bar)[XB_TMO], 1u); break; } } } } while (0)
DI void xcd_barrier_complete(unsigned* bar, unsigned x, unsigned& nloc, unsigned& nx) {
  const unsigned G = gridDim.x * gridDim.y * gridDim.z;
  unsigned sum, cnt, mine, sp = 0u;
  for (;;) {
    sum = 0u; cnt = 0u; mine = 0u;
#pragma unroll
    for (unsigned j = 0; j < 16; ++j) { const unsigned c = xb_ld(&bar[XB_XCNT(j)]); sum += c; cnt += (c > 0u) ? 1u : 0u; mine = (j == x) ? c : mine; }
    if (sum == G) break;
    __builtin_amdgcn_s_sleep(1);
    if ((++sp & 255u) == 0u) { if (xb_ld(&bar[XB_TMO])) break; if (sp > XB_SPIN_CAP) { atomicAdd(&bar[XB_TMO], 1u); break; } }
  }
  nloc = mine > 0u ? mine : 1u; nx = cnt > 0u ? cnt : 1u;
}
DI void xcd_barrier(unsigned* bar, volatile LAS unsigned* st, bool leader) {
  asm volatile("s_waitcnt vmcnt(0)" ::: "memory");
  __syncthreads();
  if (leader) {
    const unsigned x = xb_xcc_id();
    __builtin_amdgcn_s_waitcnt(0);
    unsigned nloc = st[0], nx = st[1];
    if (nloc == 0u) { xcd_barrier_complete(bar, x, nloc, nx); st[0] = nloc; st[1] = nx; }
    const unsigned old = xb_add(&bar[XB_XSUB(x)], 1u);
    const unsigned gen = old / nloc;
    if (old + 1u == (gen + 1u) * nloc) {
      __builtin_amdgcn_fence(__ATOMIC_RELEASE, "agent");
      asm volatile("s_waitcnt vmcnt(0)" ::: "memory");
      const unsigned og = xb_add(&bar[XB_TOP], 1u);
      const unsigned tg = og / nx;
      if (og + 1u == (tg + 1u) * nx) xb_add(&bar[XB_TOPGEN], 1u);
      else XB_SPIN(xb_ld(&bar[XB_TOPGEN]) == tg, bar);
      __builtin_amdgcn_fence(__ATOMIC_ACQUIRE, "agent");
      xb_add(&bar[XB_XGEN(x)], 1u);
      asm volatile("s_waitcnt vmcnt(0)" ::: "memory");
    } else {
      XB_SPIN(xb_ld(&bar[XB_XGEN(x)]) == gen, bar);
      __builtin_amdgcn_fence(__ATOMIC_ACQUIRE, "agent");
      asm volatile("s_waitcnt vmcnt(0)" ::: "memory");
    }
  }
  __syncthreads();
}

__global__ void __launch_bounds__(512, 2) mega(Params p) {
  extern __shared__ __attribute__((aligned(16))) unsigned char smem[];
  const int wv0 = __builtin_amdgcn_readfirstlane((int)(threadIdx.x >> 6));
  const int lo = p.lo, hi = p.hi;
  PP kp0 = (PP)__builtin_amdgcn_kernarg_segment_ptr();
  __shared__ uint4 xb_words;
  if (threadIdx.x == 0) {
    xb_words = make_uint4(0u, 0u, 0u, 0u);
    (void)xb_add((unsigned*)(kp0->ws + OFF_BAR) + XB_XCNT(xb_xcc_id()), 1u);
  }
  __syncthreads();
#define PH(N, CALL)                                  \
  if (lo <= N && N < hi) {                           \
    PP kp = kp0;                                     \
    asm volatile("" : "+s"(kp));                     \
    if (N > lo) {                                    \
      if (N == 1) cg::this_grid().sync();            \
      else xcd_barrier((unsigned*)(kp->ws + OFF_BAR), (volatile LAS unsigned*)&xb_words, my_tid(wv0) == 0); \
    }                                                \
    CALL;                                            \
    if ((PROBE_MASK >> N) & 1) { CALL; }             \
  }
  PH(0, phaseA(wv0, kp, smem))
  PH(1, phaseB(wv0, kp, smem))
  PH(2, phaseC(wv0, kp, smem))
  PH(3, phaseD(wv0, kp, smem))
  PH(4, phaseE(wv0, kp, smem, 0))
  if ((PROBE_MASK >> 10) & 1) { PP kp = kp0; asm volatile("" : "+s"(kp)); phaseE(wv0, kp, smem, 1); }
  PH(5, phaseF(wv0, kp, smem))
  PH(6, phaseG(wv0, kp, smem))
  PH(7, phaseH(wv0, kp, smem))
  PH(8, phaseI(wv0, kp, smem))
  PH(9, phaseJ(wv0, kp))
}

extern "C" void kernel_launch(void* const* d_in, const int* in_sizes, int n_in, void* d_out, int out_size, void* d_ws,
                              size_t ws_size, hipStream_t stream) {
  static int grid_blocks = 0;
  if (!grid_blocks) {
    int dev = 0, cus = 0, per_cu = 0;
    (void)hipGetDevice(&dev);
    (void)hipDeviceGetAttribute(&cus, hipDeviceAttributeMultiprocessorCount, dev);
    (void)hipFuncSetAttribute((const void*)mega, hipFuncAttributeMaxDynamicSharedMemorySize, SMEM_BYTES);
    (void)hipOccupancyMaxActiveBlocksPerMultiprocessor(&per_cu, mega, NT_, SMEM_BYTES);
    if (per_cu > 1) per_cu = 1;
    if (per_cu < 1) per_cu = 1;
    grid_blocks = cus * per_cu;
  }
  if (ws_size < WS_NEED) { fprintf(stderr, "workspace too small: %zu < %zu\n", ws_size, (size_t)WS_NEED); }
  Params p{};
  const float** f = (const float**)&p;
  for (int i = 0; i < 24; ++i) f[i] = (const float*)d_in[i];
  p.out = (float*)d_out;
  p.ws = (unsigned char*)d_ws;
  p.lo = 0; p.hi = 10;
  (void)hipMemsetAsync((unsigned char*)d_ws + OFF_BAR, 0, 16384, stream);
  void* args[] = {&p};
  hipError_t e = hipLaunchCooperativeKernel((void*)mega, dim3(grid_blocks), dim3(NT_), args, SMEM_BYTES, stream);
  if (e != hipSuccess) fprintf(stderr, "cooperative launch failed: %s (grid %d)\n", hipGetErrorString(e), grid_blocks);
}
```

```cpp
#include <hip/hip_runtime.h>
#include <hip/hip_cooperative_groups.h>
#include <cstdio>
namespace cg = cooperative_groups;

#ifndef PROBE_MASK
#define PROBE_MASK 0
#endif

#define DI __device__ __forceinline__
typedef unsigned short u16;
typedef unsigned long long u64;
using bf16x8 = __attribute__((ext_vector_type(8))) short;
using f32x4 = __attribute__((ext_vector_type(4))) float;
using u32x4 = __attribute__((ext_vector_type(4))) unsigned;

constexpr int B_ = 4, S_ = 8192, T_ = B_ * S_;
constexpr int NT_ = 512;
constexpr int NINP = 4096;
constexpr float QSCALE = 0.125f * 1.44269504089f;

constexpr size_t MB = 1024 * 1024;
constexpr size_t OFF_WINT = 0;
constexpr size_t OFF_W1KT = OFF_WINT + (size_t)NINP * 1024 * 2;
constexpr size_t OFF_W1VT = OFF_W1KT + 256 * 2048 * 2;
constexpr size_t OFF_W2KT = OFF_W1VT + 256 * 2048 * 2;
constexpr size_t OFF_W2VT = OFF_W2KT + 256 * 256 * 2;
constexpr size_t OFF_WAT = OFF_W2VT + 256 * 256 * 2;
constexpr size_t OFF_WVT = OFF_WAT + 1024 * 512 * 2;
constexpr size_t OFF_WGT = OFF_WVT + 1024 * 512 * 2;
constexpr size_t OFF_WOT = OFF_WGT + 1024 * 512 * 2;
constexpr size_t OFF_WUPT = OFF_WOT + 1024 * 1024 * 2;
constexpr size_t OFF_WDT = OFF_WUPT + 4096 * 1024 * 2;
constexpr size_t OFF_ROPE = OFF_WDT + 4096 * 1024 * 2;
constexpr size_t OFF_CBP = OFF_ROPE + 8192 * 16 * 4;
constexpr size_t OFF_CTR = OFF_CBP + 2 * 32 * 256 * 4;
constexpr size_t OFF_KMAX = OFF_CTR + 64;
constexpr size_t OFF_BAR = OFF_CTR + 256;
constexpr size_t OFF_SS1 = OFF_BAR + 16384;
constexpr size_t OFF_SS2 = OFF_SS1 + (size_t)T_ * 16 * 4;
constexpr size_t OFF_NG = OFF_SS2 + (size_t)T_ * 16 * 4;
constexpr size_t OFF_HC = OFF_NG + (size_t)T_ * 24 * 4;
constexpr size_t OFF_KCC = OFF_HC + 2 * 4096 * 256 * 2;
constexpr size_t OFF_VCT = OFF_KCC + 8 * 512 * 64 * 2;
constexpr size_t OFF_HLOC = OFF_VCT + 8 * 512 * 64 * 2;
constexpr size_t OFF_ARENA = OFF_HLOC + (size_t)4 * 128 * 32 * 64 * 8;
constexpr size_t OFF_MG = OFF_ARENA;
constexpr size_t OFF_HN = OFF_ARENA + 128 * MB;
constexpr size_t OFF_QRAW = OFF_ARENA + 192 * MB;
constexpr size_t OFF_QROT = OFF_ARENA + 224 * MB;
constexpr size_t OFF_KCIN = OFF_ARENA + 256 * MB;
constexpr size_t OFF_VCIN = OFF_KCIN + 8 * MB;
constexpr size_t OFF_KS = OFF_VCIN + 8 * MB;
constexpr size_t OFF_VST = OFF_KS + 8 * MB;
constexpr size_t OFF_KW = OFF_VST + 8 * MB;
constexpr size_t OFF_VWT = OFF_KW + 8 * MB;
constexpr size_t OFF_U = OFF_ARENA + 304 * MB;
constexpr size_t OFF_NSA = OFF_ARENA + 336 * MB;
constexpr size_t OFF_YS = OFF_ARENA + 368 * MB;
constexpr size_t WS_NEED = OFF_ARENA + 400 * MB;
constexpr size_t OFF_ACT = OFF_ARENA;
constexpr size_t OFF_X1B = OFF_ARENA + 256 * MB;
constexpr size_t OFF_MERGED = OFF_HN;

constexpr int SMEM_BYTES = 131072 + 1024;

struct Params {
  const float *x, *g1, *w_in, *pe, *kw1, *kw2, *vw1, *vw2, *lam_re, *lam_im, *log_step, *b_re, *b_im, *c_re, *c_im, *dsk,
      *w_attn, *w_val, *w_gate, *w_out, *g2, *w_up, *w_down, *g3;
  float* out;
  unsigned char* ws;
  int lo, hi;
};

typedef const __attribute__((address_space(4))) Params* PP;

DI int my_tid(int wv0) {
  int t = wv0 * 64 + (int)__lane_id();
  asm volatile("" : "+v"(t));
  return t;
}
DI u16 f2bf(float x) { unsigned u = __float_as_uint(x); u += 0x7fffu + ((u >> 16) & 1u); return (u16)(u >> 16); }
DI float bf2f(u16 h) { return __uint_as_float(((unsigned)h) << 16); }
DI unsigned pk2(float a, float b) { return (unsigned)f2bf(a) | ((unsigned)f2bf(b) << 16); }
DI uint2 pk4(float a, float b, float c, float d) { uint2 o; o.x = pk2(a, b); o.y = pk2(c, d); return o; }
DI float sigmoidf_(float x) { return 1.f / (1.f + __expf(-x)); }
DI float gelu_t(float x) {
  float u = 0.7978845608f * (x + 0.044715f * x * x * x);
  float e = __expf(2.f * u);
  float th = 1.f - 2.f / (e + 1.f);
  return 0.5f * x * (1.f + th);
}
DI float wave_sum(float v) {
#pragma unroll
  for (int o = 32; o > 0; o >>= 1) v += __shfl_xor(v, o);
  return v;
}
template <class T> DI T* launder(T* p) { asm volatile("" : "+v"(p)); return p; }
DI void wave_sync() { asm volatile("s_waitcnt lgkmcnt(0)" ::: "memory"); }
DI f32x4 mfma16(bf16x8 a, bf16x8 b, f32x4 c) { return __builtin_amdgcn_mfma_f32_16x16x32_bf16(a, b, c, 0, 0, 0); }

constexpr int G_HT = 128 * 64;
DI int lds_byte(int r, int c) {
  const int st = (r >> 4) * 2 + (c >> 5), rr = r & 15, cc = c & 31, ob = rr * 64 + cc * 2;
  return st * 1024 + (ob ^ (((ob >> 9) & 1) << 5));
}
DI void stage_rc(int b, int& R, int& C) {
  const int st = b / 1024, sb = b % 1024, swz = sb ^ (((sb >> 9) & 1) << 5);
  R = (st >> 1) * 16 + swz / 64;
  C = (st & 1) * 32 + (swz % 64) / 2;
}
typedef __attribute__((address_space(3))) unsigned* lds_u32p;
DI void gemm256(int wv0, f32x4 (&acc)[2][2][4][2], const u16* __restrict__ A, int lda, const u16* __restrict__ Bt, int ldb,
                int K, unsigned char* smem) {
  u16* shm = (u16*)smem;
  const int tid = my_tid(wv0), lane = tid & 63;
  const int wr = wv0 >> 2, wc = wv0 & 3, fr = lane & 15, fq = lane >> 4;
#define SA(b, h) (shm + ((b)*2 + (h)) * G_HT)
#define SB(b, h) (shm + (4 + (b)*2 + (h)) * G_HT)
  int sr0, sc0, sr1, sc1;
  stage_rc(tid * 16, sr0, sc0);
  stage_rc(tid * 16 + 8192, sr1, sc1);
  const u16* a0 = A + (size_t)sr0 * lda + sc0;
  const u16* a1 = A + (size_t)sr1 * lda + sc1;
  const u16* b0 = Bt + (size_t)sr0 * ldb + sc0;
  const u16* b1 = Bt + (size_t)sr1 * ldb + sc1;
#define STAGE_A(P, half, kt)                                                                                              \
  {                                                                                                                       \
    __builtin_amdgcn_global_load_lds((const unsigned*)(a0 + (size_t)((half)*128) * lda + (kt)*64),                        \
                                     (unsigned*)((char*)(P) + tid * 16), 16, 0, 0);                               \
    __builtin_amdgcn_global_load_lds((const unsigned*)(a1 + (size_t)((half)*128) * lda + (kt)*64),                        \
                                     (unsigned*)((char*)(P) + tid * 16 + 8192), 16, 0, 0);                        \
  }
#define STAGE_B(P, half, kt)                                                                                              \
  {                                                                                                                       \
    __builtin_amdgcn_global_load_lds((const unsigned*)(b0 + (size_t)((half)*128) * ldb + (kt)*64),                        \
                                     (unsigned*)((char*)(P) + tid * 16), 16, 0, 0);                               \
    __builtin_amdgcn_global_load_lds((const unsigned*)(b1 + (size_t)((half)*128) * ldb + (kt)*64),                        \
                                     (unsigned*)((char*)(P) + tid * 16 + 8192), 16, 0, 0);                        \
  }
#define LDA(dst, b, h)                                                                                                    \
  _Pragma("unroll") for (int m = 0; m < 4; ++m) _Pragma("unroll") for (int k = 0; k < 2; ++k)                             \
      dst[m][k] = *(const bf16x8*)((const unsigned char*)SA(b, h) + lds_byte(wr * 64 + m * 16 + fr, k * 32 + fq * 8));
#define LDB(dst, b, h)                                                                                                    \
  _Pragma("unroll") for (int n = 0; n < 2; ++n) _Pragma("unroll") for (int k = 0; k < 2; ++k)                             \
      dst[n][k] = *(const bf16x8*)((const unsigned char*)SB(b, h) + lds_byte(wc * 32 + n * 16 + fr, k * 32 + fq * 8));
#define MMA(ai, bj, At_, Bt_)                                                                                             \
  {                                                                                                                       \
    __builtin_amdgcn_s_setprio(1);                                                                                        \
    _Pragma("unroll") for (int m = 0; m < 4; ++m) _Pragma("unroll") for (int n = 0; n < 2; ++n)                           \
        _Pragma("unroll") for (int k = 0; k < 2; ++k) acc[ai][bj][m][n] =                                                 \
            __builtin_amdgcn_mfma_f32_16x16x32_bf16(Bt_[n][k], At_[m][k], acc[ai][bj][m][n], 0, 0, 0);                    \
    __builtin_amdgcn_s_setprio(0);                                                                                        \
  }
#define WAIT_V(n) asm volatile("s_waitcnt vmcnt(" #n ")" ::: "memory")
#define WAIT_L(n) asm volatile("s_waitcnt lgkmcnt(" #n ")" ::: "memory")
#define BAR __builtin_amdgcn_s_barrier()
#define SCHED __builtin_amdgcn_sched_barrier(0)
#pragma unroll
  for (int a = 0; a < 2; ++a)
#pragma unroll
    for (int b = 0; b < 2; ++b)
#pragma unroll
      for (int m = 0; m < 4; ++m)
#pragma unroll
        for (int n = 0; n < 2; ++n) acc[a][b][m][n] = f32x4{0.f, 0.f, 0.f, 0.f};
  bf16x8 At[4][2], B0[2][2], B1[2][2];
  const int nt = K / 64;
  WAIT_V(0);
  __syncthreads();
  STAGE_B(SB(0, 0), 0, 0) STAGE_A(SA(0, 0), 0, 0)
  STAGE_B(SB(0, 1), 1, 0) STAGE_A(SA(0, 1), 1, 0)
  if (wr == 1) BAR;
  WAIT_V(4); BAR;
  STAGE_B(SB(1, 0), 0, 1) STAGE_A(SA(1, 0), 0, 1) STAGE_B(SB(1, 1), 1, 1)
  WAIT_V(6); BAR;
#pragma unroll 1
  for (int t = 0; t < nt - 2; t += 2) {
    LDB(B0, 0, 0) SCHED; LDA(At, 0, 0) STAGE_A(SA(1, 1), 1, t + 1)
    WAIT_L(8); BAR; WAIT_L(0); MMA(0, 0, At, B0) BAR; SCHED;
    LDB(B1, 0, 1) STAGE_B(SB(0, 0), 0, t + 2)
    BAR; WAIT_L(0); MMA(0, 1, At, B1) BAR;
    LDA(At, 0, 1) STAGE_A(SA(0, 0), 0, t + 2)
    BAR; WAIT_L(0); MMA(1, 0, At, B0) BAR; SCHED;
    STAGE_B(SB(0, 1), 1, t + 2)
    WAIT_V(6); BAR; MMA(1, 1, At, B1) BAR;
    LDB(B0, 1, 0) SCHED; LDA(At, 1, 0) STAGE_A(SA(0, 1), 1, t + 2)
    WAIT_L(8); BAR; WAIT_L(0); MMA(0, 0, At, B0) BAR; SCHED;
    LDB(B1, 1, 1) STAGE_B(SB(1, 0), 0, t + 3)
    BAR; WAIT_L(0); MMA(0, 1, At, B1) BAR;
    LDA(At, 1, 1) STAGE_A(SA(1, 0), 0, t + 3)
    BAR; WAIT_L(0); MMA(1, 0, At, B0) BAR; SCHED;
    STAGE_B(SB(1, 1), 1, t + 3)
    WAIT_V(6); BAR; MMA(1, 1, At, B1) BAR;
  }
  {
    LDB(B0, 0, 0) LDA(At, 0, 0) STAGE_A(SA(1, 1), 1, nt - 1)
    BAR; WAIT_L(0); MMA(0, 0, At, B0) BAR;
    LDB(B1, 0, 1) BAR; WAIT_L(0); MMA(0, 1, At, B1) BAR;
    LDA(At, 0, 1) WAIT_V(4); BAR; WAIT_L(0); MMA(1, 0, At, B0) MMA(1, 1, At, B1) BAR;
  }
  {
    LDB(B0, 1, 0) LDA(At, 1, 0) WAIT_V(2); BAR; WAIT_L(0); MMA(0, 0, At, B0) BAR;
    LDB(B1, 1, 1) WAIT_V(0); BAR; WAIT_L(0); MMA(0, 1, At, B1) BAR;
    LDA(At, 1, 1) BAR; WAIT_L(0); MMA(1, 0, At, B0) MMA(1, 1, At, B1) BAR;
  }
  if (wr == 0) BAR;
}
DI void tile_map_n16(int id, int& pm, int& pn) {
  const int k = id & 255, rnd = id >> 8, x = k & 7, slot = k >> 3;
  pm = rnd * 16 + 4 * (x >> 1) + (slot >> 3);
  pn = 8 * (x & 1) + (slot & 7);
}
DI void tile_map_n4(int id, int& pm, int& pn) {
  const int k = id & 255, rnd = id >> 8, x = k & 7, slot = k >> 3;
  pm = rnd * 64 + 8 * x + (slot >> 2);
  pn = slot & 3;
}
template <class F>
DI void epi256(int wv0, f32x4 (&acc)[2][2][4][2], int brow, int bcol, F f) {
  const int lane = my_tid(wv0) & 63, wr = wv0 >> 2, wc = wv0 & 3;
#pragma unroll
  for (int ai = 0; ai < 2; ++ai)
#pragma unroll
    for (int bj = 0; bj < 2; ++bj)
#pragma unroll
      for (int m = 0; m < 4; ++m)
#pragma unroll
        for (int n = 0; n < 2; ++n) {
          const int row = brow + ai * 128 + wr * 64 + m * 16 + (lane & 15);
          const int col0 = bcol + bj * 128 + wc * 32 + n * 16 + (lane >> 4) * 4;
          f(ai, bj, m, n, row, col0, acc[ai][bj][m][n]);
          if (n == 1 && (m & 1)) __builtin_amdgcn_sched_barrier(0);
        }
}

constexpr int NXT_A = 1024 + 128 + 128 + 16 + 16;
constexpr int NXT = NXT_A + 128 * 3 + 256 + 1024 + 1024;
DI void xpose_tile(int wv0, PP p, int jt, unsigned char* smem) {
  const int tid = my_tid(wv0);
  float* tile = (float*)smem;
  int t = jt;
  const float* src;
  u16* dst;
  int K, Nsrc, mode = 0;
  const float* scl = nullptr;
  if (t < 1024) { src = p->w_in; dst = (u16*)(p->ws + OFF_WINT); K = 1024; Nsrc = 3864; mode = 1; }
  else if ((t -= 1024) < 128) { src = p->kw1; dst = (u16*)(p->ws + OFF_W1KT); K = 2048; Nsrc = 256; }
  else if ((t -= 128) < 128) { src = p->vw1; dst = (u16*)(p->ws + OFF_W1VT); K = 2048; Nsrc = 256; }
  else if ((t -= 128) < 16) { src = p->kw2; dst = (u16*)(p->ws + OFF_W2KT); K = 256; Nsrc = 64; mode = 2; }
  else if ((t -= 16) < 16) { src = p->vw2; dst = (u16*)(p->ws + OFF_W2VT); K = 256; Nsrc = 64; mode = 2; }
  else if ((t -= 16) < 128) { src = p->w_attn; dst = (u16*)(p->ws + OFF_WAT); K = 512; Nsrc = 1024; }
  else if ((t -= 128) < 128) { src = p->w_val; dst = (u16*)(p->ws + OFF_WVT); K = 512; Nsrc = 1024; }
  else if ((t -= 128) < 128) { src = p->w_gate; dst = (u16*)(p->ws + OFF_WGT); K = 512; Nsrc = 1024; }
  else if ((t -= 128) < 256) { src = p->w_out; dst = (u16*)(p->ws + OFF_WOT); K = 1024; Nsrc = 1024; }
  else if ((t -= 256) < 1024) { src = p->w_up; dst = (u16*)(p->ws + OFF_WUPT); K = 1024; Nsrc = 4096; scl = p->g2; }
  else { t -= 1024; src = p->w_down; dst = (u16*)(p->ws + OFF_WDT); K = 4096; Nsrc = 1024; }
  const int nkt = K >> 6, tn = t / nkt, tk = t % nkt, n0 = tn * 64, k0 = tk * 64;
  const int tx = tid & 63, ty = tid >> 6;
  const int np = n0 + tx;
  int sc = np;
  if (mode == 1) {
    if (np < 1280) sc = np;
    else if (np < 1792) sc = 1304 + (np - 1280);
    else if (np < 3840) sc = 1816 + (np - 1792);
    else if (np < 3864) sc = 1280 + (np - 3840);
    else sc = -1;
  } else if (mode == 2) {
    sc = np < 64 ? np : -1;
  }
  for (int kk = ty; kk < 64; kk += 8) {
    float val = 0.f;
    if (sc >= 0) val = src[(size_t)(k0 + kk) * Nsrc + sc];
    if (scl) val *= scl[k0 + kk];
    tile[kk * 65 + tx] = val;
  }
  __syncthreads();
  {
    const int n = tid >> 3, kc = tid & 7;
    uint4 o;
    o.x = pk2(tile[(kc * 8 + 0) * 65 + n], tile[(kc * 8 + 1) * 65 + n]);
    o.y = pk2(tile[(kc * 8 + 2) * 65 + n], tile[(kc * 8 + 3) * 65 + n]);
    o.z = pk2(tile[(kc * 8 + 4) * 65 + n], tile[(kc * 8 + 5) * 65 + n]);
    o.w = pk2(tile[(kc * 8 + 6) * 65 + n], tile[(kc * 8 + 7) * 65 + n]);
    *(uint4*)(dst + (size_t)(n0 + n) * K + k0 + kc * 8) = o;
  }
  __syncthreads();
}

DI void phaseA(int wv0, PP p, unsigned char* smem) {
  const int tid = my_tid(wv0), lane = tid & 63;
  u16* HN = (u16*)(p->ws + OFF_HN);
  for (int row = blockIdx.x * 8 + wv0; row < T_; row += gridDim.x * 8) {
    const float4* xr = (const float4*)(p->x + (size_t)row * 1024);
    float4 v[4];
    float ss = 0.f;
#pragma unroll
    for (int r = 0; r < 4; ++r) {
      v[r] = xr[lane + 64 * r];
      ss += v[r].x * v[r].x + v[r].y * v[r].y + v[r].z * v[r].z + v[r].w * v[r].w;
    }
    ss = wave_sum(ss);
    const float rinv = rsqrtf(ss * (1.f / 1024.f) + 1e-6f);
#pragma unroll
    for (int r = 0; r < 4; ++r) {
      const float4 g = ((const float4*)p->g1)[lane + 64 * r];
      uint2 o;
      o.x = pk2(v[r].x * rinv * g.x, v[r].y * rinv * g.y);
      o.y = pk2(v[r].z * rinv * g.z, v[r].w * rinv * g.w);
      *(uint2*)(HN + (size_t)row * 1024 + (lane + 64 * r) * 4) = o;
    }
  }
  for (int jt = blockIdx.x; jt < NXT_A + 32; jt += gridDim.x) {
    if (jt < NXT_A) {
      xpose_tile(wv0, p, jt, smem);
    } else {
      const int item = jt - NXT_A, kv = item >> 4, slice = item & 15;
      const float* w1 = kv ? p->vw1 : p->kw1;
      const int col = tid & 255, h = tid >> 8, kb = slice * 128 + h * 64;
      float s0 = 0.f, s1 = 0.f, s2 = 0.f, s3 = 0.f;
      for (int k = kb; k < kb + 64; k += 4) {
        s0 += p->pe[k] * w1[(size_t)k * 256 + col];
        s1 += p->pe[k + 1] * w1[(size_t)(k + 1) * 256 + col];
        s2 += p->pe[k + 2] * w1[(size_t)(k + 2) * 256 + col];
        s3 += p->pe[k + 3] * w1[(size_t)(k + 3) * 256 + col];
      }
      ((float*)(p->ws + OFF_CBP))[(kv * 32 + slice * 2 + h) * 256 + col] = (s0 + s1) + (s2 + s3);
    }
  }
  float* rope = (float*)(p->ws + OFF_ROPE);
  for (int i = blockIdx.x * NT_ + tid; i < S_ * 8; i += gridDim.x * NT_) {
    const int pos = i >> 3, k = i & 7;
    const float inv = powf(500000.0f, -(2.0f * (float)k) / 16.0f);
    const float ang = (float)pos * inv;
    rope[pos * 16 + k] = cosf(ang);
    rope[pos * 16 + 8 + k] = sinf(ang);
  }
  if (blockIdx.x == 0 && tid < 64) ((int*)(p->ws + OFF_CTR))[tid] = 0;
}

DI void phaseB(int wv0, PP p, unsigned char* smem) {
  const u16* HN = (const u16*)(p->ws + OFF_HN);
  const u16* WT = (const u16*)(p->ws + OFF_WINT);
  const float* rope = (const float*)(p->ws + OFF_ROPE);
  const int lane = my_tid(wv0) & 63;
  const bool ropewave = (wv0 & 1) == 0;
  for (int id = blockIdx.x; id < 128 * 16; id += gridDim.x) {
    int pm, pn;
    tile_map_n16(id, pm, pn);
    const int brow = pm * 256, bcol = pn * 256;
    f32x4 acc[2][2][4][2];
    gemm256(wv0, acc, HN + (size_t)brow * 1024, 1024, WT + (size_t)bcol * 1024, 1024, 1024, smem);
    if (pn < 2) {
      u16* QR = (u16*)(p->ws + OFF_QRAW);
      u16* QO = (u16*)(p->ws + OFF_QROT);
      epi256(wv0, acc, brow, bcol, [&](int ai, int bj, int m, int n, int row, int col0, f32x4& v) {
        f32x4 r = v;
        if (n == 0 && ropewave) {
          const int pos = row & (S_ - 1), kq = ((lane >> 4) & 1) * 4;
          const float4 c4 = *(const float4*)(rope + pos * 16 + kq), s4 = *(const float4*)(rope + pos * 16 + 8 + kq);
          const float cc[4] = {c4.x, c4.y, c4.z, c4.w}, ss[4] = {s4.x, s4.y, s4.z, s4.w};
#pragma unroll
          for (int j = 0; j < 4; ++j) {
            const float pr = __shfl_xor(v[j], 32);
            r[j] = (lane & 32) ? (v[j] * cc[j] + pr * ss[j]) : (v[j] * cc[j] - pr * ss[j]);
          }
        }
        *(uint2*)(QR + (size_t)row * 512 + col0) = pk4(v[0] * QSCALE, v[1] * QSCALE, v[2] * QSCALE, v[3] * QSCALE);
        *(uint2*)(QO + (size_t)row * 512 + col0) = pk4(r[0] * QSCALE, r[1] * QSCALE, r[2] * QSCALE, r[3] * QSCALE);
      });
    } else if (pn < 5) {
      epi256(wv0, acc, brow, bcol, [&](int ai, int bj, int m, int n, int row, int col0, f32x4& v) {
        const int sub = (pn - 2) * 2 + bj;
        const bool dorope = (sub == 2 || sub == 4), transposed = (sub == 3 || sub == 5);
        u16* dst = (u16*)(p->ws + OFF_KCIN + (size_t)sub * 8 * MB);
        const int c128 = col0 & 127, g = c128 >> 6, d0 = c128 & 63;
        const int b = row >> 13, sq = row & (S_ - 1);
        f32x4 r = v;
        if (dorope && n == 0 && ropewave) {
          const int kq = ((lane >> 4) & 1) * 4;
          const float4 c4 = *(const float4*)(rope + sq * 16 + kq), s4 = *(const float4*)(rope + sq * 16 + 8 + kq);
          const float cc[4] = {c4.x, c4.y, c4.z, c4.w}, ss[4] = {s4.x, s4.y, s4.z, s4.w};
#pragma unroll
          for (int j = 0; j < 4; ++j) {
            const float pr = __shfl_xor(v[j], 32);
            r[j] = (lane & 32) ? (v[j] * cc[j] + pr * ss[j]) : (v[j] * cc[j] - pr * ss[j]);
          }
        }
        if (transposed) {
#pragma unroll
          for (int j = 0; j < 4; ++j) dst[((size_t)((b * 2 + g) * 64 + d0 + j)) * S_ + sq] = f2bf(r[j]);
        } else {
          *(uint2*)(dst + ((size_t)(b * 2 + g) * S_ + sq) * 64 + d0) = pk4(r[0], r[1], r[2], r[3]);
        }
      });
    } else if (pn < 7) {
      u16* U = (u16*)(p->ws + OFF_U);
      epi256(wv0, acc, brow, bcol, [&](int ai, int bj, int m, int n, int row, int col0, f32x4& v) {
        *(uint2*)(U + (size_t)row * 512 + (col0 - 1280)) = pk4(v[0], v[1], v[2], v[3]);
      });
    } else if (pn < 15) {
      u16* MG = (u16*)(p->ws + OFF_MG);
      epi256(wv0, acc, brow, bcol, [&](int ai, int bj, int m, int n, int row, int col0, f32x4& v) {
        *(uint2*)(MG + (size_t)row * 2048 + (col0 - 1792)) = pk4(sigmoidf_(v[0]), sigmoidf_(v[1]), sigmoidf_(v[2]), sigmoidf_(v[3]));
      });
    } else {
      float* NG = (float*)(p->ws + OFF_NG);
      epi256(wv0, acc, brow, bcol, [&](int ai, int bj, int m, int n, int row, int col0, f32x4& v) {
        const int cc = col0 - 3840;
        if (cc < 24) *(float4*)(NG + (size_t)row * 24 + cc) = make_float4(sigmoidf_(v[0]), sigmoidf_(v[1]), sigmoidf_(v[2]), sigmoidf_(v[3]));
      });
    }
  }
}

struct S5c {
  float lbr, lbi;
  float br[16], bi[16];
};
DI void s5_setup(PP p, int g, int n, S5c& c) {
  const float step = expf(p->log_step[g]);
  const float lr = p->lam_re[g * 64 + n], li = p->lam_im[g * 64 + n];
  const float er = expf(lr * step);
  float sn, cs;
  sincosf(li * step, &sn, &cs);
  c.lbr = er * cs;
  c.lbi = er * sn;
  const float nr = c.lbr - 1.f, ni = c.lbi, den = lr * lr + li * li;
  const float cr = (nr * lr + ni * li) / den, ci = (ni * lr - nr * li) / den;
#pragma unroll
  for (int k = 0; k < 16; ++k) {
    const float bre = p->b_re[(g * 64 + n) * 16 + k], bim = p->b_im[(g * 64 + n) * 16 + k];
    c.br[k] = cr * bre - ci * bim;
    c.bi[k] = cr * bim + ci * bre;
  }
}
DI void s5_load_u(PP p, int b, int ch, int g, float* su, int lane) {
  const u16* U = (const u16*)(p->ws + OFF_U) + ((size_t)(b * S_ + ch * 64 + lane)) * 512 + g * 16;
  const uint4 a = *(const uint4*)U, c = *(const uint4*)(U + 8);
  float* d = su + lane * 16;
  const unsigned w[8] = {a.x, a.y, a.z, a.w, c.x, c.y, c.z, c.w};
#pragma unroll
  for (int k = 0; k < 8; ++k) {
    d[2 * k] = __uint_as_float(w[k] << 16);
    d[2 * k + 1] = __uint_as_float(w[k] & 0xffff0000u);
  }
}
DI void s5_step(const S5c& c, const float* ut, float& hr, float& hi) {
  float bur = 0.f, bui = 0.f;
#pragma unroll
  for (int k4 = 0; k4 < 4; ++k4) {
    const float4 u = *(const float4*)(ut + 4 * k4);
    bur += c.br[4 * k4] * u.x + c.br[4 * k4 + 1] * u.y + c.br[4 * k4 + 2] * u.z + c.br[4 * k4 + 3] * u.w;
    bui += c.bi[4 * k4] * u.x + c.bi[4 * k4 + 1] * u.y + c.bi[4 * k4 + 2] * u.z + c.bi[4 * k4 + 3] * u.w;
  }
  const float nr = c.lbr * hr - c.lbi * hi + bur;
  const float nim = c.lbr * hi + c.lbi * hr + bui;
  hr = nr;
  hi = nim;
}
template <bool OUT>
DI void s5_item(int wv0, PP p, int item, unsigned char* smem) {
  const int tid = my_tid(wv0), lane = tid & 63, fr = lane & 15, fq = lane >> 4;
  const int b = item >> 9, g = (item >> 4) & 31, c8 = item & 15, ch = c8 * 8 + wv0;
  u16* sBb = (u16*)smem;
  u16* sCm = sBb + 128 * 16;
  float* sBU = (float*)(smem + 8192) + wv0 * (16 * 132);
  u16* sH = (u16*)(smem + 8192 + 8 * 16 * 132 * 4) + wv0 * (16 * 136);
  const float step = expf(p->log_step[g]);
  for (int e = tid; e < 2048; e += NT_) {
    const int np = e >> 4, c = e & 15, n = np & 63;
    const float lr = p->lam_re[g * 64 + n], li = p->lam_im[g * 64 + n];
    const float er = expf(lr * step);
    float sn, cs;
    sincosf(li * step, &sn, &cs);
    const float nr = er * cs - 1.f, ni = er * sn, den = lr * lr + li * li;
    const float cr = (nr * lr + ni * li) / den, ci = (ni * lr - nr * li) / den;
    const float bre = p->b_re[(g * 64 + n) * 16 + c], bim = p->b_im[(g * 64 + n) * 16 + c];
    sBb[np * 16 + c] = f2bf(np < 64 ? (cr * bre - ci * bim) : (cr * bim + ci * bre));
  }
  if (OUT) {
    for (int e = tid; e < 2048; e += NT_) {
      const int cc = e >> 7, k = e & 127;
      sCm[cc * 128 + k] = f2bf(k < 64 ? p->c_re[(g * 16 + cc) * 64 + k] : -p->c_im[(g * 16 + cc) * 64 + (k - 64)]);
    }
  }
  float lbr, lbi;
  {
    const float lr = p->lam_re[g * 64 + lane], li = p->lam_im[g * 64 + lane];
    const float er = expf(lr * step);
    float sn, cs;
    sincosf(li * step, &sn, &cs);
    lbr = er * cs;
    lbi = er * sn;
  }
  float2* HL = (float2*)(p->ws + OFF_HLOC) + ((size_t)(b * 128 + ch) * 32 + g) * 64 + lane;
  float hr = 0.f, hi = 0.f;
  if (OUT) { const float2 h0 = *HL; hr = h0.x; hi = h0.y; }
  const u16* U = (const u16*)(p->ws + OFF_U) + ((size_t)(b * S_ + ch * 64)) * 512 + g * 16;
  u16* YS = (u16*)(p->ws + OFF_YS) + ((size_t)(b * S_ + ch * 64)) * 512 + g * 16;
  const float dk = p->dsk[g * 16 + fr];
  __syncthreads();
  const bf16x8 zero8 = {0, 0, 0, 0, 0, 0, 0, 0};
  bf16x8 bb[8], cf[4];
#pragma unroll
  for (int nt = 0; nt < 8; ++nt) bb[nt] = fq < 2 ? *(const bf16x8*)(sBb + (16 * nt + fr) * 16 + 8 * fq) : zero8;
  if (OUT) {
#pragma unroll
    for (int ks = 0; ks < 4; ++ks) cf[ks] = *(const bf16x8*)(sCm + fr * 128 + 32 * ks + 8 * fq);
  }
#pragma unroll 1
  for (int sub = 0; sub < 4; ++sub) {
    const bf16x8 ua = fq < 2 ? *(const bf16x8*)(U + (size_t)(sub * 16 + fr) * 512 + 8 * fq) : zero8;
#pragma unroll
    for (int nt = 0; nt < 8; ++nt) {
      const f32x4 a = mfma16(ua, bb[nt], f32x4{0.f, 0.f, 0.f, 0.f});
#pragma unroll
      for (int j = 0; j < 4; ++j) sBU[(4 * fq + j) * 132 + 16 * nt + fr] = a[j];
    }
    __syncthreads();
#pragma unroll 4
    for (int t = 0; t < 16; ++t) {
      const float bur = sBU[t * 132 + lane], bui = sBU[t * 132 + 64 + lane];
      const float nr = lbr * hr - lbi * hi + bur;
      const float nim = lbr * hi + lbi * hr + bui;
      hr = nr;
      hi = nim;
      if (OUT) {
        sH[t * 136 + lane] = f2bf(hr);
        sH[t * 136 + 64 + lane] = f2bf(hi);
      }
    }
    __syncthreads();
    if (OUT) {
      f32x4 y = {0.f, 0.f, 0.f, 0.f};
#pragma unroll
      for (int ks = 0; ks < 4; ++ks) y = mfma16(*(const bf16x8*)(sH + fr * 136 + 32 * ks + 8 * fq), cf[ks], y);
#pragma unroll
      for (int j = 0; j < 4; ++j) {
        const size_t o = (size_t)(sub * 16 + 4 * fq + j) * 512 + fr;
        YS[o] = f2bf(gelu_t(y[j] + dk * bf2f(U[o])));
      }
      __syncthreads();
    }
  }
  if (!OUT) *HL = make_float2(hr, hi);
  __syncthreads();
}
DI void s5_carry(int wv0, PP p) {
  const int x = blockIdx.x * NT_ + my_tid(wv0);
  if (x >= 8192) return;
  const int b = x >> 11, g = (x >> 6) & 31, n = x & 63;
  const float step = expf(p->log_step[g]);
  const float lr = p->lam_re[g * 64 + n], li = p->lam_im[g * 64 + n];
  const float er = expf(64.f * lr * step);
  float sn, cs;
  sincosf(64.f * li * step, &sn, &cs);
  const float Lr = er * cs, Li = er * sn;
  float2* HL = (float2*)(p->ws + OFF_HLOC) + (size_t)b * 128 * 2048 + g * 64 + n;
  float hr = 0.f, hi = 0.f;
  for (int c0 = 0; c0 < 128; c0 += 16) {
    float2 v[16];
#pragma unroll
    for (int k = 0; k < 16; ++k) v[k] = HL[(size_t)(c0 + k) * 2048];
#pragma unroll
    for (int k = 0; k < 16; ++k) {
      HL[(size_t)(c0 + k) * 2048] = make_float2(hr, hi);
      const float nr = Lr * hr - Li * hi + v[k].x;
      const float nim = Lr * hi + Li * hr + v[k].y;
      hr = nr;
      hi = nim;
    }
  }
}
DI void phaseC(int wv0, PP p, unsigned char* smem) {
  const float* cbp = (const float*)(p->ws + OFF_CBP);
  for (int id = blockIdx.x; id < 32 + 2048 + 256; id += gridDim.x) {
    if (id >= 32 + 2048) {
      const int it = id - (32 + 2048), tns = it >> 7, bg = (it >> 4) & 7, part = it & 15;
      const int tid = my_tid(wv0);
      const u16* K = (const u16*)(p->ws + (tns ? OFF_KW : OFF_KS)) + ((size_t)bg * S_ + part * 512 + tid) * 64;
      float q2 = 0.f;
#pragma unroll
      for (int c = 0; c < 8; ++c) {
        const uint4 w = *(const uint4*)(K + c * 8);
        const unsigned ww[4] = {w.x, w.y, w.z, w.w};
#pragma unroll
        for (int e = 0; e < 4; ++e) {
          const float a = __uint_as_float(ww[e] << 16), b2 = __uint_as_float(ww[e] & 0xffff0000u);
          q2 += a * a + b2 * b2;
        }
      }
#pragma unroll
      for (int o = 32; o > 0; o >>= 1) q2 = fmaxf(q2, __shfl_xor(q2, o));
      if ((tid & 63) == 0) atomicMax((unsigned*)(p->ws + OFF_KMAX) + tns * 8 + bg, __float_as_uint(q2));
    } else if (id < 32) {
      const int kv = id >> 4, pm = id & 15, brow = pm * 256;
      const u16* A = (const u16*)(p->ws + (kv ? OFF_VCIN : OFF_KCIN)) + (size_t)brow * 1024;
      const u16* Bt = (const u16*)(p->ws + (kv ? OFF_W1VT : OFF_W1KT));
      f32x4 acc[2][2][4][2];
      gemm256(wv0, acc, A, 1024, Bt, 2048, 2048, smem);
      u16* HC = (u16*)(p->ws + OFF_HC) + (size_t)kv * 4096 * 256;
      epi256(wv0, acc, brow, 0, [&](int ai, int bj, int m, int n, int row, int col0, f32x4& v) {
        float4 bb = make_float4(0.f, 0.f, 0.f, 0.f);
#pragma unroll 8
        for (int sl = 0; sl < 32; ++sl) {
          const float4 t = *(const float4*)(cbp + (kv * 32 + sl) * 256 + col0);
          bb.x += t.x; bb.y += t.y; bb.z += t.z; bb.w += t.w;
        }
        *(uint2*)(HC + (size_t)row * 256 + col0) = pk4(gelu_t(v[0] + bb.x), gelu_t(v[1] + bb.y), gelu_t(v[2] + bb.z), gelu_t(v[3] + bb.w));
      });
    } else {
      s5_item<false>(wv0, p, id - 32, smem);
    }
  }
}
DI void phaseD(int wv0, PP p, unsigned char* smem) {
  for (int id = blockIdx.x; id < 32; id += gridDim.x) {
    const int kv = id >> 4, pm = id & 15, brow = pm * 256;
    const u16* A = (const u16*)(p->ws + OFF_HC) + (size_t)kv * 4096 * 256 + (size_t)brow * 256;
    const u16* Bt = (const u16*)(p->ws + (kv ? OFF_W2VT : OFF_W2KT));
    f32x4 acc[2][2][4][2];
    gemm256(wv0, acc, A, 256, Bt, 256, 256, smem);
    u16* KCC = (u16*)(p->ws + OFF_KCC);
    u16* VCT = (u16*)(p->ws + OFF_VCT);
    epi256(wv0, acc, brow, 0, [&](int ai, int bj, int m, int n, int row, int col0, f32x4& v) {
      if (col0 < 64) {
        const int bg = row >> 9, nn = row & 511;
        f32x4 r = v;
        if (nn == 511) r = f32x4{0.f, 0.f, 0.f, 0.f};
        if (kv == 0) {
          *(uint2*)(KCC + ((size_t)bg * 512 + nn) * 64 + col0) = pk4(r[0], r[1], r[2], r[3]);
        } else {
#pragma unroll
          for (int j = 0; j < 4; ++j) VCT[((size_t)bg * 64 + col0 + j) * 512 + nn] = f2bf(r[j]);
        }
      }
    });
  }
  s5_carry(wv0, p);
}

DI bool bit128(u64 lo, u64 hi, int j) { return j < 64 ? ((lo >> j) & 1ull) : ((hi >> (j - 64)) & 1ull); }
DI int next_bit(u64 lo, u64 hi, int from) {
  if (from < 64) {
    const u64 x = (lo >> from) << from;
    if (x) return __ffsll((long long)x) - 1;
    from = 64;
  }
  if (from >= 128) return -1;
  const u64 y = (hi >> (from - 64)) << (from - 64);
  return y ? 63 + __ffsll((long long)y) : -1;
}

template <int MODE, bool MASKED, class MaskF>
DI void flash_tile(const u16* sK, const u16* sV, const bf16x8 (&qf)[2][2], f32x4 (&O)[2][4], float (&m)[2], float (&l)[2],
                   float (&ps)[4][4], MaskF ok, bool sel, int lane) {
  const int l15 = lane & 15, lg = lane >> 4;
  bf16x8 kf[4][2];
#pragma unroll
  for (int kt = 0; kt < 4; ++kt)
#pragma unroll
    for (int ks = 0; ks < 2; ++ks) kf[kt][ks] = *(const bf16x8*)(sK + (16 * kt + l15) * 72 + ks * 32 + lg * 8);
  if (MODE == 1) {
#pragma unroll
    for (int a = 0; a < 4; ++a)
#pragma unroll
      for (int b = 0; b < 4; ++b) ps[a][b] = 0.f;
  }
#pragma unroll
  for (int qt = 0; qt < 2; ++qt) {
    f32x4 s[4];
    const float sinit = (MODE == 3) ? ((MASKED || sel) ? m[qt] : -1e30f) : 0.f;
#pragma unroll
    for (int kt = 0; kt < 4; ++kt) {
      s[kt] = f32x4{sinit, sinit, sinit, sinit};
#pragma unroll
      for (int ks = 0; ks < 2; ++ks) s[kt] = mfma16(kf[kt][ks], qf[qt][ks], s[kt]);
    }
    float pr[4][4];
    if (MODE == 3) {
      float rs = 0.f;
#pragma unroll
      for (int kt = 0; kt < 4; ++kt)
#pragma unroll
        for (int i = 0; i < 4; ++i) {
          float pv = __builtin_amdgcn_exp2f(s[kt][i]);
          if (MASKED) pv = ok(kt, i) ? pv : 0.f;
          pr[kt][i] = pv;
          rs += pv;
        }
      l[qt] += rs;
    } else {
    float mx = -1e30f;
#pragma unroll
    for (int kt = 0; kt < 4; ++kt)
#pragma unroll
      for (int i = 0; i < 4; ++i) {
        if (MASKED) s[kt][i] = ok(kt, i) ? s[kt][i] : -1e30f;
        mx = fmaxf(mx, s[kt][i]);
      }
    if (!MASKED) mx = sel ? mx : -1e30f;
    if (MODE == 1) {
      const float mm = m[qt], il = l[qt];
#pragma unroll
      for (int kt = 0; kt < 4; ++kt)
#pragma unroll
        for (int i = 0; i < 4; ++i) {
          const float pv = (s[kt][i] > -1e29f) ? __builtin_amdgcn_exp2f(s[kt][i] - mm) * il : 0.f;
          pr[kt][i] = pv;
          ps[kt][i] += pv;
        }
    } else {
      mx = fmaxf(mx, __shfl_xor(mx, 16));
      mx = fmaxf(mx, __shfl_xor(mx, 32));
      const float mnew = fmaxf(m[qt], mx);
      const float alpha = __builtin_amdgcn_exp2f(m[qt] - mnew);
      m[qt] = mnew;
      float rs = 0.f;
      if (MASKED) {
#pragma unroll
        for (int kt = 0; kt < 4; ++kt)
#pragma unroll
          for (int i = 0; i < 4; ++i) {
            const float pv = (s[kt][i] > -1e29f) ? __builtin_amdgcn_exp2f(s[kt][i] - mnew) : 0.f;
            pr[kt][i] = pv;
            rs += pv;
          }
      } else {
        const float me = sel ? mnew : 1e30f;
#pragma unroll
        for (int kt = 0; kt < 4; ++kt)
#pragma unroll
          for (int i = 0; i < 4; ++i) {
            const float pv = __builtin_amdgcn_exp2f(s[kt][i] - me);
            pr[kt][i] = pv;
            rs += pv;
          }
      }
      l[qt] = l[qt] * alpha + rs;
      if (MODE == 2) {
#pragma unroll
        for (int dt = 0; dt < 4; ++dt) O[qt][dt] *= alpha;
      }
    }
    }
    if (MODE != 0) {
#pragma unroll
      for (int ks2 = 0; ks2 < 2; ++ks2) {
        union { unsigned u[4]; bf16x8 v; } pf;
        pf.u[0] = pk2(pr[2 * ks2][0], pr[2 * ks2][1]);
        pf.u[1] = pk2(pr[2 * ks2][2], pr[2 * ks2][3]);
        pf.u[2] = pk2(pr[2 * ks2 + 1][0], pr[2 * ks2 + 1][1]);
        pf.u[3] = pk2(pr[2 * ks2 + 1][2], pr[2 * ks2 + 1][3]);
#pragma unroll
        for (int dt = 0; dt < 4; ++dt) {
          union { uint2 h[2]; bf16x8 v; } vf;
          vf.h[0] = *(const uint2*)(sV + (16 * dt + l15) * 72 + 32 * ks2 + 4 * lg);
          vf.h[1] = *(const uint2*)(sV + (16 * dt + l15) * 72 + 32 * ks2 + 16 + 4 * lg);
          O[qt][dt] = mfma16(vf.v, pf.v, O[qt][dt]);
        }
      }
    }

  }
}

DI void nsa_item(int wv0, PP p, int item, unsigned char* smem) {
  const int tid = my_tid(wv0), lane = tid & 63, wv = wv0 & 3, hp = wv0 >> 2, l15 = lane & 15, lg = lane >> 4;
  const int i = 127 - (item >> 3), bg = item & 7, b = bg >> 1, g = bg & 1;
  u16* sK = (u16*)smem;
  u16* sV = sK + 64 * 72;
  float* sImp0 = (float*)(smem + 36864);
  float* sImp = sImp0 + hp * (64 * 132);
  u64* sUni = (u64*)(smem + 36864 + 2 * 64 * 132 * 4);
  u64* sSel = sUni + 16;
  const int t0 = i * 64, qloc = 16 * wv + l15, tq = t0 + qloc;
  const unsigned tokq = (unsigned)(b * S_ + tq);
  const float* NGb = (const float*)(p->ws + OFF_NG);
  const unsigned ngoff = tokq * 24 + g * 12 + hp * 6;
  float* ACCb = p->out;
  const unsigned aoff = tokq * 512 + g * 256 + hp * 128 + 4 * lg;
  const unsigned qoff = tokq * 512 + g * 256 + hp * 128 + lg * 8;
  const int lrow = tid >> 3, lpart = tid & 7;
  const unsigned koff = (lrow * 64 + lpart * 8) * 2, voffc = (lrow * 512 + lpart * 8) * 2, voffs = (lrow * S_ + lpart * 8) * 2;

  for (int e = tid; e < 2 * 64 * 132; e += NT_) sImp0[e] = 0.f;

  bf16x8 qf[2][2];
  f32x4 O[2][4];
  float m[2], l[2], ps[4][4];
  u32x4 pk0, pv0;
  auto nomask = [](int, int) { return true; };

#define MAKE_RSRC(PTR) __builtin_amdgcn_make_buffer_rsrc((void*)(PTR), 0, 0x7fffffff, 0x00020000)
#define BLOAD(R, VO, SO) __builtin_amdgcn_raw_buffer_load_b128((R), (int)(VO), (int)(SO), 0)
#define ISSUE_TILE(RK, RV, T, LDV)                                                   \
  {                                                                                  \
    pk0 = BLOAD(RK, koff, (T)*8192);                                                 \
    pv0 = BLOAD(RV, ((LDV) == 512) ? voffc : voffs, (T)*128);                        \
  }
#define COMMIT_TILE()                                                                \
  {                                                                                  \
    *(u32x4*)(sK + lrow * 72 + lpart * 8) = pk0;                                     \
    *(u32x4*)(sV + lrow * 72 + lpart * 8) = pv0;                                     \
  }
#define COMMIT_BUF(BUF)                                                              \
  {                                                                                  \
    *(u32x4*)(sK + (BUF)*9216 + lrow * 72 + lpart * 8) = pk0;                        \
    *(u32x4*)(sV + (BUF)*9216 + lrow * 72 + lpart * 8) = pv0;                        \
  }
#define LOAD_Q(BASE)                                                                 \
  {                                                                                  \
    const u16* Q_ = (const u16*)(p->ws + (BASE));                                    \
    _Pragma("unroll") for (int qt = 0; qt < 2; ++qt)                                 \
      _Pragma("unroll") for (int ks = 0; ks < 2; ++ks)                               \
        qf[qt][ks] = *(const bf16x8*)(Q_ + (qoff + qt * 64 + ks * 32));             \
  }
#define RESET_STATE()                                                                \
  {                                                                                  \
    _Pragma("unroll") for (int qt = 0; qt < 2; ++qt) { m[qt] = -1e30f; l[qt] = 0.f; } \
    _Pragma("unroll") for (int a = 0; a < 2; ++a)                                    \
      _Pragma("unroll") for (int c = 0; c < 4; ++c) O[a][c] = f32x4{0.f, 0.f, 0.f, 0.f}; \
  }

  {
    const u16* Kc0 = (const u16*)(p->ws + OFF_KCC) + (size_t)bg * 512 * 64;
    const u16* Vc0 = (const u16*)(p->ws + OFF_VCT) + (size_t)bg * 64 * 512;
    const int nE = (4 * i + 3) < 511 ? (4 * i + 3) : 511;
    const int nkb = (nE + 63) >> 6;
    const __amdgpu_buffer_rsrc_t rK = MAKE_RSRC(Kc0), rV = MAKE_RSRC(Vc0);
    LOAD_Q(OFF_QRAW)
    RESET_STATE()
    ISSUE_TILE(rK, rV, 0, 512)
    for (int kb = 0; kb < nkb; ++kb) {
      __syncthreads();
      COMMIT_TILE()
      __syncthreads();
      if (kb + 1 < nkb) ISSUE_TILE(rK, rV, kb + 1, 512)
      auto ok = [&](int kt, int ii) { return 16 * (kb * 64 + 16 * kt + 4 * lg + ii) + 31 <= tq; };
      flash_tile<0, true>(sK, sV, qf, O, m, l, ps, ok, true, lane);
    }
#pragma unroll
    for (int qt = 0; qt < 2; ++qt) {
      float s = l[qt];
      s += __shfl_xor(s, 16);
      s += __shfl_xor(s, 32);
      l[qt] = s > 0.f ? 1.f / s : 0.f;
    }
    ISSUE_TILE(rK, rV, 0, 512)
    for (int kb = 0; kb < nkb; ++kb) {
      __syncthreads();
      COMMIT_TILE()
      __syncthreads();
      if (kb + 1 < nkb) ISSUE_TILE(rK, rV, kb + 1, 512)
      auto ok = [&](int kt, int ii) { return 16 * (kb * 64 + 16 * kt + 4 * lg + ii) + 31 <= tq; };
      flash_tile<1, true>(sK, sV, qf, O, m, l, ps, ok, true, lane);
#pragma unroll
      for (int kt = 0; kt < 4; ++kt) {
        const int j = kb * 16 + kt * 4 + lg;
        sImp[qloc * 132 + j] += ps[kt][0] + ps[kt][1] + ps[kt][2] + ps[kt][3];
      }
      __syncthreads();
#pragma unroll
      for (int kt = 0; kt < 4; ++kt) {
        const int j1 = kb * 16 + kt * 4 + lg + 1;
        if (j1 < 128) sImp[qloc * 132 + j1] += ps[kt][3];
      }
    }
#pragma unroll
    for (int qt = 0; qt < 2; ++qt) {
      const float gt = NGb[ngoff + qt * 3 + 0];
#pragma unroll
      for (int dt = 0; dt < 4; ++dt) {
        float4 o = make_float4(O[qt][dt][0] * gt, O[qt][dt][1] * gt, O[qt][dt][2] * gt, O[qt][dt][3] * gt);
        *(float4*)(ACCb + (aoff + qt * 64 + 16 * dt)) = o;
      }
    }
  }
  __syncthreads();
  u64 mlo = 0, mhi = 0, wlo = 0, whi = 0;
  if (i < 16) {
    mlo = (1ull << (i + 1)) - 1ull;
    wlo = mlo;
  } else {
    const bool v0 = lane <= i, v1 = (lane + 64) <= i;
    const bool f0 = (lane == 0) || (lane == i) || (lane == i - 1);
    const bool f1 = (lane + 64 == i) || (lane + 64 == i - 1);
    const u64 ltm = (1ull << lane) - 1ull;
    for (int qq = hp * 8; qq < hp * 8 + 8; ++qq) {
      const float* ir = sImp0 + (16 * wv + qq) * 132;
      const float i0 = ir[lane] + ir[64 * 132 + lane], i1 = ir[lane + 64] + ir[64 * 132 + lane + 64];
      const unsigned k0 = v0 ? __float_as_uint(i0 + (f0 ? 1000.f : 0.f)) : 0u;
      const unsigned k1 = v1 ? __float_as_uint(i1 + (f1 ? 1000.f : 0.f)) : 0u;
      unsigned T = 0;
      for (int bit = 30; bit >= 0; --bit) {
        const unsigned cand = T | (1u << bit);
        const int cnt = __popcll(__ballot(k0 >= cand)) + __popcll(__ballot(k1 >= cand));
        if (cnt >= 16) T = cand;
      }
      const bool g0 = k0 > T, g1 = k1 > T, e0 = k0 == T, e1 = k1 == T;
      const int need = 16 - (__popcll(__ballot(g0)) + __popcll(__ballot(g1)));
      const u64 be0 = __ballot(e0), be1 = __ballot(e1);
      const int r0 = __popcll(be0 & ltm), r1 = __popcll(be0) + __popcll(be1 & ltm);
      const u64 s0 = __ballot(v0 && (g0 || (e0 && r0 < need)));
      const u64 s1 = __ballot(v1 && (g1 || (e1 && r1 < need)));
      wlo |= s0;
      whi |= s1;
      if (lane == 0) { sSel[(16 * wv + qq) * 2] = s0; sSel[(16 * wv + qq) * 2 + 1] = s1; }
    }
  }
  if (lane == 0) { sUni[wv0 * 2] = wlo; sUni[wv0 * 2 + 1] = whi; }
  __syncthreads();
  if (i >= 16) { mlo = sSel[qloc * 2]; mhi = sSel[qloc * 2 + 1]; }
  wlo = sUni[wv * 2] | sUni[(wv + 4) * 2];
  whi = sUni[wv * 2 + 1] | sUni[(wv + 4) * 2 + 1];
  const u64 blo = sUni[0] | sUni[2] | sUni[4] | sUni[6] | sUni[8] | sUni[10] | sUni[12] | sUni[14];
  const u64 bhi = sUni[1] | sUni[3] | sUni[5] | sUni[7] | sUni[9] | sUni[11] | sUni[13] | sUni[15];

  LOAD_Q(OFF_QROT)
  float nb_s[2], nb_w[2];
  bool usefix;
  {
    const float* KM = (const float*)(p->ws + OFF_KMAX);
    const float kms = KM[bg], kmw = KM[8 + bg];
    float bmax = 0.f;
#pragma unroll
    for (int qt = 0; qt < 2; ++qt) {
      float q2 = 0.f;
#pragma unroll
      for (int ks = 0; ks < 2; ++ks)
#pragma unroll
        for (int e = 0; e < 8; ++e) {
          const float qv = __uint_as_float(((unsigned)(u16)qf[qt][ks][e]) << 16);
          q2 += qv * qv;
        }
      q2 += __shfl_xor(q2, 16);
      q2 += __shfl_xor(q2, 32);
      const float bs = sqrtf(q2 * kms) * 1.001f + 1e-3f, bw = sqrtf(q2 * kmw) * 1.001f + 1e-3f;
      nb_s[qt] = -bs;
      nb_w[qt] = -bw;
      bmax = fmaxf(bmax, fmaxf(bs, bw));
    }
    usefix = __ballot(bmax > 60.f) == 0ull;
  }
  RESET_STATE()
  if (usefix) { m[0] = nb_s[0]; m[1] = nb_s[1]; }
  {
    const __amdgpu_buffer_rsrc_t rK = MAKE_RSRC((const u16*)(p->ws + OFF_KS) + (size_t)bg * S_ * 64);
    const __amdgpu_buffer_rsrc_t rV = MAKE_RSRC((const u16*)(p->ws + OFF_VST) + (size_t)bg * 64 * S_);
    int j = next_bit(blo, bhi, 0);
    ISSUE_TILE(rK, rV, j, S_)
    COMMIT_BUF(0)
    __syncthreads();
    int jn = next_bit(blo, bhi, j + 1);
    if (jn >= 0) ISSUE_TILE(rK, rV, jn, S_)
    int cur = 0;
    while (j >= 0) {
      const u16* cK = sK + cur * 9216;
      const u16* cV = sV + cur * 9216;
      if (bit128(wlo, whi, j)) {
        const bool sel = bit128(mlo, mhi, j);
        if (j == i) {
          auto ok = [&](int kt, int ii) { return sel && (16 * kt + 4 * lg + ii) <= qloc; };
          if (usefix) flash_tile<3, true>(cK, cV, qf, O, m, l, ps, ok, true, lane);
          else flash_tile<2, true>(cK, cV, qf, O, m, l, ps, ok, true, lane);
        } else {
          if (usefix) flash_tile<3, false>(cK, cV, qf, O, m, l, ps, nomask, sel, lane);
          else flash_tile<2, false>(cK, cV, qf, O, m, l, ps, nomask, sel, lane);
        }
      }
      cur ^= 1;
      if (jn >= 0) COMMIT_BUF(cur)
      __syncthreads();
      j = jn;
      if (j >= 0) {
        jn = next_bit(blo, bhi, j + 1);
        if (jn >= 0) ISSUE_TILE(rK, rV, jn, S_)
      }
    }
  }
#pragma unroll
  for (int qt = 0; qt < 2; ++qt) {
    float s = l[qt];
    s += __shfl_xor(s, 16);
    s += __shfl_xor(s, 32);
    const float sc = NGb[ngoff + qt * 3 + 1] / s;
#pragma unroll
    for (int dt = 0; dt < 4; ++dt) {
      float4* a = (float4*)(ACCb + (aoff + qt * 64 + 16 * dt));
      float4 o = *a;
      o.x += O[qt][dt][0] * sc; o.y += O[qt][dt][1] * sc; o.z += O[qt][dt][2] * sc; o.w += O[qt][dt][3] * sc;
      *a = o;
    }
  }
  RESET_STATE()
  if (usefix) { m[0] = nb_w[0]; m[1] = nb_w[1]; }
  {
    const __amdgpu_buffer_rsrc_t rK = MAKE_RSRC((const u16*)(p->ws + OFF_KW) + (size_t)bg * S_ * 64);
    const __amdgpu_buffer_rsrc_t rV = MAKE_RSRC((const u16*)(p->ws + OFF_VWT) + (size_t)bg * 64 * S_);
    const int j0 = i >= 8 ? i - 8 : 0;
    ISSUE_TILE(rK, rV, j0, S_)
    COMMIT_BUF(0)
    __syncthreads();
    if (j0 + 1 <= i) ISSUE_TILE(rK, rV, j0 + 1, S_)
    int cur = 0;
    for (int j = j0; j <= i; ++j) {
      const u16* cK = sK + cur * 9216;
      const u16* cV = sV + cur * 9216;
      if (j == i || j == i - 8) {
        auto ok = [&](int kt, int ii) {
          const int kp = j * 64 + 16 * kt + 4 * lg + ii;
          return kp <= tq && kp > tq - 512;
        };
        if (usefix) flash_tile<3, true>(cK, cV, qf, O, m, l, ps, ok, true, lane);
        else flash_tile<2, true>(cK, cV, qf, O, m, l, ps, ok, true, lane);
      } else {
        if (usefix) flash_tile<3, false>(cK, cV, qf, O, m, l, ps, nomask, true, lane);
        else flash_tile<2, false>(cK, cV, qf, O, m, l, ps, nomask, true, lane);
      }
      cur ^= 1;
      if (j + 1 <= i) COMMIT_BUF(cur)
      __syncthreads();
      if (j + 2 <= i) ISSUE_TILE(rK, rV, j + 2, S_)
    }
  }
  u16* NSAb = (u16*)(p->ws + OFF_NSA);
#pragma unroll
  for (int qt = 0; qt < 2; ++qt) {
    float s = l[qt];
    s += __shfl_xor(s, 16);
    s += __shfl_xor(s, 32);
    const float sc = NGb[ngoff + qt * 3 + 2] / s;
#pragma unroll
    for (int dt = 0; dt < 4; ++dt) {
      const float4 a = *(const float4*)(ACCb + (aoff + qt * 64 + 16 * dt));
      uint2 o;
      o.x = pk2(a.x + O[qt][dt][0] * sc, a.y + O[qt][dt][1] * sc);
      o.y = pk2(a.z + O[qt][dt][2] * sc, a.w + O[qt][dt][3] * sc);
      *(uint2*)(NSAb + (aoff + qt * 64 + 16 * dt)) = o;
    }
  }
  __syncthreads();
}

DI void phaseE(int wv0, PP p, unsigned char* smem, int cidx) {
  __shared__ int s_item;
  int* ctr = (int*)(p->ws + OFF_CTR) + cidx;
  for (;;) {
    __syncthreads();
    if (my_tid(wv0) == 0) s_item = atomicAdd(ctr, 1);
    __syncthreads();
    const int item = s_item;
    if (item >= 1024 + 2048 + (NXT - NXT_A)) break;
    if (item < 1024) nsa_item(wv0, p, item, smem);
    else if (item < 1024 + 2048) s5_item<true>(wv0, p, item - 1024, smem);
    else xpose_tile(wv0, p, NXT_A + (item - 3072), smem);
  }
}

DI void phaseF(int wv0, PP p, unsigned char* smem) {
  const u16* YS = (const u16*)(p->ws + OFF_YS);
  const u16* NSA = (const u16*)(p->ws + OFF_NSA);
  const u16* MG = (const u16*)(p->ws + OFF_MG);
  u16* MR = (u16*)(p->ws + OFF_MERGED);
  for (int id = blockIdx.x; id < 128 * 4; id += gridDim.x) {
    int pm, pn;
    tile_map_n4(id, pm, pn);
    const int brow = pm * 256, bcol = pn * 256;
    f32x4 acc[2][2][4][2];
    gemm256(wv0, acc, YS + (size_t)brow * 512, 512, (const u16*)(p->ws + OFF_WGT) + (size_t)bcol * 512, 512, 512, smem);
    epi256(wv0, acc, brow, bcol, [&](int ai, int bj, int m, int n, int row, int col0, f32x4& v) {
      *(uint2*)(MR + (size_t)row * 1024 + col0) = pk4(sigmoidf_(v[0]), sigmoidf_(v[1]), sigmoidf_(v[2]), sigmoidf_(v[3]));
    });
    gemm256(wv0, acc, YS + (size_t)brow * 512, 512, (const u16*)(p->ws + OFF_WVT) + (size_t)bcol * 512, 512, 512, smem);
    epi256(wv0, acc, brow, bcol, [&](int ai, int bj, int m, int n, int row, int col0, f32x4& v) {
      const uint2 t = *(const uint2*)(MR + (size_t)row * 1024 + col0);
      const uint2 gq = *(const uint2*)(MG + (size_t)row * 2048 + 1024 + col0);
      *(uint2*)(MR + (size_t)row * 1024 + col0) =
          pk4(__uint_as_float(gq.x << 16) * v[0] * __uint_as_float(t.x << 16), __uint_as_float(gq.x & 0xffff0000u) * v[1] * __uint_as_float(t.x & 0xffff0000u),
              __uint_as_float(gq.y << 16) * v[2] * __uint_as_float(t.y << 16), __uint_as_float(gq.y & 0xffff0000u) * v[3] * __uint_as_float(t.y & 0xffff0000u));
    });
    gemm256(wv0, acc, NSA + (size_t)brow * 512, 512, (const u16*)(p->ws + OFF_WAT) + (size_t)bcol * 512, 512, 512, smem);
    epi256(wv0, acc, brow, bcol, [&](int ai, int bj, int m, int n, int row, int col0, f32x4& v) {
      const uint2 t = *(const uint2*)(MR + (size_t)row * 1024 + col0);
      const uint2 gq = *(const uint2*)(MG + (size_t)row * 2048 + col0);
      *(uint2*)(MR + (size_t)row * 1024 + col0) =
          pk4(__uint_as_float(gq.x << 16) * v[0] + __uint_as_float(t.x << 16), __uint_as_float(gq.x & 0xffff0000u) * v[1] + __uint_as_float(t.x & 0xffff0000u),
              __uint_as_float(gq.y << 16) * v[2] + __uint_as_float(t.y << 16), __uint_as_float(gq.y & 0xffff0000u) * v[3] + __uint_as_float(t.y & 0xffff0000u));
    });
  }
}
DI void ss_partial(int wv0, f32x4 (&acc)[2][2][4][2], float* SS, int brow, int pn) {
  const int lane = my_tid(wv0) & 63, wr = wv0 >> 2, wc = wv0 & 3;
#pragma unroll
  for (int ai = 0; ai < 2; ++ai)
#pragma unroll
    for (int m = 0; m < 4; ++m) {
      float s = 0.f;
#pragma unroll
      for (int bj = 0; bj < 2; ++bj)
#pragma unroll
        for (int n = 0; n < 2; ++n)
#pragma unroll
          for (int j = 0; j < 4; ++j) s += acc[ai][bj][m][n][j] * acc[ai][bj][m][n][j];
      s += __shfl_xor(s, 16);
      s += __shfl_xor(s, 32);
      if (lane < 16) SS[(size_t)(brow + ai * 128 + wr * 64 + m * 16 + lane) * 16 + pn * 4 + wc] = s;
    }
}
DI void phaseG(int wv0, PP p, unsigned char* smem) {
  const u16* MR = (const u16*)(p->ws + OFF_MERGED);
  u16* X1B = (u16*)(p->ws + OFF_X1B);
  float* SS1 = (float*)(p->ws + OFF_SS1);
  for (int id = blockIdx.x; id < 128 * 4; id += gridDim.x) {
    int pm, pn;
    tile_map_n4(id, pm, pn);
    const int brow = pm * 256, bcol = pn * 256;
    f32x4 acc[2][2][4][2];
    gemm256(wv0, acc, MR + (size_t)brow * 1024, 1024, (const u16*)(p->ws + OFF_WOT) + (size_t)bcol * 1024, 1024, 1024, smem);
    epi256(wv0, acc, brow, bcol, [&](int ai, int bj, int m, int n, int row, int col0, f32x4& v) {
      const size_t o = (size_t)row * 1024 + col0;
      const float4 xv = *(const float4*)(p->x + o);
      v[0] += xv.x; v[1] += xv.y; v[2] += xv.z; v[3] += xv.w;
      *(float4*)(p->out + o) = make_float4(v[0], v[1], v[2], v[3]);
      *(uint2*)(X1B + o) = pk4(v[0], v[1], v[2], v[3]);
    });
    ss_partial(wv0, acc, SS1, brow, pn);
  }
}
DI void phaseH(int wv0, PP p, unsigned char* smem) {
  const u16* X1B = (const u16*)(p->ws + OFF_X1B);
  const float* SS1 = (const float*)(p->ws + OFF_SS1);
  u16* ACT = (u16*)(p->ws + OFF_ACT);
  float* sR = (float*)(smem + 131072);
  for (int id = blockIdx.x; id < 128 * 16; id += gridDim.x) {
    int pm, pn;
    tile_map_n16(id, pm, pn);
    const int brow = pm * 256, bcol = pn * 256;
    const int tid = my_tid(wv0);
    if (tid < 256) {
      const float4* s = (const float4*)(SS1 + (size_t)(brow + tid) * 16);
      const float4 a = s[0], b = s[1], c = s[2], d = s[3];
      const float t = a.x + a.y + a.z + a.w + b.x + b.y + b.z + b.w + c.x + c.y + c.z + c.w + d.x + d.y + d.z + d.w;
      sR[tid] = rsqrtf(t * (1.f / 1024.f) + 1e-6f);
    }
    f32x4 acc[2][2][4][2];
    gemm256(wv0, acc, X1B + (size_t)brow * 1024, 1024, (const u16*)(p->ws + OFF_WUPT) + (size_t)bcol * 1024, 1024, 1024, smem);
    epi256(wv0, acc, brow, bcol, [&](int ai, int bj, int m, int n, int row, int col0, f32x4& v) {
      const float ri = sR[row - brow];
      const float a0 = fmaxf(v[0] * ri, 0.f), a1 = fmaxf(v[1] * ri, 0.f), a2 = fmaxf(v[2] * ri, 0.f), a3 = fmaxf(v[3] * ri, 0.f);
      *(uint2*)(ACT + (size_t)row * 4096 + col0) = pk4(a0 * a0, a1 * a1, a2 * a2, a3 * a3);
    });
    __syncthreads();
  }
}
DI void phaseI(int wv0, PP p, unsigned char* smem) {
  const u16* ACT = (const u16*)(p->ws + OFF_ACT);
  float* SS2 = (float*)(p->ws + OFF_SS2);
  for (int id = blockIdx.x; id < 128 * 4; id += gridDim.x) {
    int pm, pn;
    tile_map_n4(id, pm, pn);
    const int brow = pm * 256, bcol = pn * 256;
    f32x4 acc[2][2][4][2];
    gemm256(wv0, acc, ACT + (size_t)brow * 4096, 4096, (const u16*)(p->ws + OFF_WDT) + (size_t)bcol * 4096, 4096, 4096, smem);
    epi256(wv0, acc, brow, bcol, [&](int ai, int bj, int m, int n, int row, int col0, f32x4& v) {
      const size_t o = (size_t)row * 1024 + col0;
      const float4 xv = *(const float4*)(p->out + o);
      v[0] += xv.x; v[1] += xv.y; v[2] += xv.z; v[3] += xv.w;
      *(float4*)(p->out + o) = make_float4(v[0], v[1], v[2], v[3]);
    });
    ss_partial(wv0, acc, SS2, brow, pn);
  }
}
DI void phaseJ(int wv0, PP p) {
  const int lane = my_tid(wv0) & 63;
  const float* SS2 = (const float*)(p->ws + OFF_SS2);
  for (int row = blockIdx.x * 8 + wv0; row < T_; row += gridDim.x * 8) {
    float t = (lane < 16) ? SS2[(size_t)row * 16 + lane] : 0.f;
    t = wave_sum(t);
    const float rinv = rsqrtf(t * (1.f / 1024.f) + 1e-6f);
    float4* xr = (float4*)(p->out + (size_t)row * 1024);
#pragma unroll
    for (int r = 0; r < 4; ++r) {
      float4 v = xr[lane + 64 * r];
      const float4 g = ((const float4*)p->g3)[lane + 64 * r];
      v.x *= rinv * g.x; v.y *= rinv * g.y; v.z *= rinv * g.z; v.w *= rinv * g.w;
      xr[lane + 64 * r] = v;
    }
  }
}


#define XB_TMO      128
#define XB_XCNT(j)  (256  + 64 * (j))
#define XB_XSUB(j)  (1280 + 64 * (j))
#define XB_XGEN(j)  (2304 + 64 * (j))
#define XB_TOP      3328
#define XB_TOPGEN   3392
#define XB_SPIN_CAP (1u << 18)
#define LAS __attribute__((address_space(3)))
DI unsigned xb_ld(unsigned* p) { return __hip_atomic_load(p, __ATOMIC_RELAXED, __HIP_MEMORY_SCOPE_AGENT); }
DI unsigned xb_add(unsigned* p, unsigned v) { return __hip_atomic_fetch_add(p, v, __ATOMIC_RELAXED, __HIP_MEMORY_SCOPE_AGENT); }
DI unsigned xb_xcc_id() { return (unsigned)__builtin_amdgcn_s_getreg((3 << 11) | 20) & 0xFu; }
#define XB_SPIN(cond, bar) do { unsigned _sp = 0; while (cond) { __builtin_amdgcn_s_sleep(1); \
    if ((++_sp & 255u) == 0u) { if (xb_ld(&(bar)[XB_TMO])) break; if (_sp > XB_SPIN_CAP) { atomicAdd(&(bar)[XB_TMO], 1u); break; } } } } while (0)
DI void xcd_barrier_complete(unsigned* bar, unsigned x, unsigned& nloc, unsigned& nx) {
  const unsigned G = gridDim.x * gridDim.y * gridDim.z;
  unsigned sum, cnt, mine, sp = 0u;
  for (;;) {
    sum = 0u; cnt = 0u; mine = 0u;
#pragma unroll
    for (unsigned j = 0; j < 16; ++j) { const unsigned c = xb_ld(&bar[XB_XCNT(j)]); sum += c; cnt += (c > 0u) ? 1u : 0u; mine = (j == x) ? c : mine; }
    if (sum == G) break;
    __builtin_amdgcn_s_sleep(1);
    if ((++sp & 255u) == 0u) { if (xb_ld(&bar[XB_TMO])) break; if (sp > XB_SPIN_CAP) { atomicAdd(&bar[XB_TMO], 1u); break; } }
  }
  nloc = mine > 0u ? mine : 1u; nx = cnt > 0u ? cnt : 1u;
}
DI void xcd_barrier(unsigned* bar, volatile LAS unsigned* st, bool leader) {
  asm volatile("s_waitcnt vmcnt(0)" ::: "memory");
  __syncthreads();
  if (leader) {
    const unsigned x = xb_xcc_id();
    __builtin_amdgcn_s_waitcnt(0);
    unsigned nloc = st[0], nx = st[1];
    if (nloc == 0u) { xcd_barrier_complete(bar, x, nloc, nx); st[0] = nloc; st[1] = nx; }
    const unsigned old = xb_add(&bar[XB_XSUB(x)], 1u);
    const unsigned gen = old / nloc;
    if (old + 1u == (gen + 1u) * nloc) {
      __builtin_amdgcn_fence(__ATOMIC_RELEASE, "agent");
      asm volatile("s_waitcnt vmcnt(0)" ::: "memory");
      const unsigned og = xb_add(&bar[XB_TOP], 1u);
      const unsigned tg = og / nx;
      if (og + 1u == (tg + 1u) * nx) xb_add(&bar[XB_TOPGEN], 1u);
      else XB_SPIN(xb_ld(&bar[XB_TOPGEN]) == tg, bar);
      __builtin_amdgcn_fence(__ATOMIC_ACQUIRE, "agent");
      xb_add(&bar[XB_XGEN(x)], 1u);
      asm volatile("s_waitcnt vmcnt(0)" ::: "memory");
    } else {
      XB_SPIN(xb_ld(&bar[XB_XGEN(x)]) == gen, bar);
      __builtin_amdgcn_fence(__ATOMIC_ACQUIRE, "agent");
      asm volatile("s_waitcnt vmcnt(0)" ::: "memory");
    }
  }
  __syncthreads();
}

__global__ void __launch_bounds__(512, 2) mega(Params p) {
  extern __shared__ __attribute__((aligned(16))) unsigned char smem[];
  const int wv0 = __builtin_amdgcn_readfirstlane((int)(threadIdx.x >> 6));
  const int lo = p.lo, hi = p.hi;
  PP kp0 = (PP)__builtin_amdgcn_kernarg_segment_ptr();
  __shared__ uint4 xb_words;
  if (threadIdx.x == 0) {
    xb_words = make_uint4(0u, 0u, 0u, 0u);
    (void)xb_add((unsigned*)(kp0->ws + OFF_BAR) + XB_XCNT(xb_xcc_id()), 1u);
  }
  __syncthreads();
#define PH(N, CALL)                                  \
  if (lo <= N && N < hi) {                           \
    PP kp = kp0;                                     \
    asm volatile("" : "+s"(kp));                     \
    if (N > lo) {                                    \
      if (N == 1) cg::this_grid().sync();            \
      else xcd_barrier((unsigned*)(kp->ws + OFF_BAR), (volatile LAS unsigned*)&xb_words, my_tid(wv0) == 0); \
    }                                                \
    CALL;                                            \
    if ((PROBE_MASK >> N) & 1) { CALL; }             \
  }
  PH(0, phaseA(wv0, kp, smem))
  PH(1, phaseB(wv0, kp, smem))
  PH(2, phaseC(wv0, kp, smem))
  PH(3, phaseD(wv0, kp, smem))
  PH(4, phaseE(wv0, kp, smem, 0))
  if ((PROBE_MASK >> 10) & 1) { PP kp = kp0; asm volatile("" : "+s"(kp)); phaseE(wv0, kp, smem, 1); }
  PH(5, phaseF(wv0, kp, smem))
  PH(6, phaseG(wv0, kp, smem))
  PH(7, phaseH(wv0, kp, smem))
  PH(8, phaseI(wv0, kp, smem))
  PH(9, phaseJ(wv0, kp))
}

extern "C" void kernel_launch(void* const* d_in, const int* in_sizes, int n_in, void* d_out, int out_size, void* d_ws,
                              size_t ws_size, hipStream_t stream) {
  static int grid_blocks = 0;
  if (!grid_blocks) {
    int dev = 0, cus = 0, per_cu = 0;
    (void)hipGetDevice(&dev);
    (void)hipDeviceGetAttribute(&cus, hipDeviceAttributeMultiprocessorCount, dev);
    (void)hipFuncSetAttribute((const void*)mega, hipFuncAttributeMaxDynamicSharedMemorySize, SMEM_BYTES);
    (void)hipOccupancyMaxActiveBlocksPerMultiprocessor(&per_cu, mega, NT_, SMEM_BYTES);
    if (per_cu > 1) per_cu = 1;
    if (per_cu < 1) per_cu = 1;
    grid_blocks = cus * per_cu;
  }
  if (ws_size < WS_NEED) { fprintf(stderr, "workspace too small: %zu < %zu\n", ws_size, (size_t)WS_NEED); }
  Params p{};
  const float** f = (const float**)&p;
  for (int i = 0; i < 24; ++i) f[i] = (const float*)d_in[i];
  p.out = (float*)d_out;
  p.ws = (unsigned char*)d_ws;
  p.lo = 0; p.hi = 10;
  (void)hipMemsetAsync((unsigned char*)d_ws + OFF_BAR, 0, 16384, stream);
  void* args[] = {&p};
  hipError_t e = hipLaunchCooperativeKernel((void*)mega, dim3(grid_blocks), dim3(NT_), args, SMEM_BYTES, stream);
  if (e != hipSuccess) fprintf(stderr, "cooperative launch failed: %s (grid %d)\n", hipGetErrorString(e), grid_blocks);
}
```

```cpp
#include <hip/hip_runtime.h>
#include <hip/hip_cooperative_groups.h>
#include <cstdio>
namespace cg = cooperative_groups;

#ifndef PROBE_MASK
#define PROBE_MASK 0
#endif

#define DI __device__ __forceinline__
typedef unsigned short u16;
typedef unsigned long long u64;
using bf16x8 = __attribute__((ext_vector_type(8))) short;
using f32x4 = __attribute__((ext_vector_type(4))) float;
using u32x4 = __attribute__((ext_vector_type(4))) unsigned;

constexpr int B_ = 4, S_ = 8192, T_ = B_ * S_;
constexpr int NT_ = 512;
constexpr int NINP = 4096;
constexpr float QSCALE = 0.125f * 1.44269504089f;

constexpr size_t MB = 1024 * 1024;
constexpr size_t OFF_WINT = 0;
constexpr size_t OFF_W1KT = OFF_WINT + (size_t)NINP * 1024 * 2;
constexpr size_t OFF_W1VT = OFF_W1KT + 256 * 2048 * 2;
constexpr size_t OFF_W2KT = OFF_W1VT + 256 * 2048 * 2;
constexpr size_t OFF_W2VT = OFF_W2KT + 256 * 256 * 2;
constexpr size_t OFF_WAT = OFF_W2VT + 256 * 256 * 2;
constexpr size_t OFF_WVT = OFF_WAT + 1024 * 512 * 2;
constexpr size_t OFF_WGT = OFF_WVT + 1024 * 512 * 2;
constexpr size_t OFF_WOT = OFF_WGT + 1024 * 512 * 2;
constexpr size_t OFF_WUPT = OFF_WOT + 1024 * 1024 * 2;
constexpr size_t OFF_WDT = OFF_WUPT + 4096 * 1024 * 2;
constexpr size_t OFF_ROPE = OFF_WDT + 4096 * 1024 * 2;
constexpr size_t OFF_CBP = OFF_ROPE + 8192 * 16 * 4;
constexpr size_t OFF_CTR = OFF_CBP + 2 * 32 * 256 * 4;
constexpr size_t OFF_KMAX = OFF_CTR + 64;
constexpr size_t OFF_BAR = OFF_CTR + 256;
constexpr size_t OFF_SS1 = OFF_BAR + 16384;
constexpr size_t OFF_SS2 = OFF_SS1 + (size_t)T_ * 16 * 4;
constexpr size_t OFF_NG = OFF_SS2 + (size_t)T_ * 16 * 4;
constexpr size_t OFF_HC = OFF_NG + (size_t)T_ * 24 * 4;
constexpr size_t OFF_KCC = OFF_HC + 2 * 4096 * 256 * 2;
constexpr size_t OFF_VCT = OFF_KCC + 8 * 512 * 64 * 2;
constexpr size_t OFF_HLOC = OFF_VCT + 8 * 512 * 64 * 2;
constexpr size_t OFF_ARENA = OFF_HLOC + (size_t)4 * 128 * 32 * 64 * 8;
constexpr size_t OFF_MG = OFF_ARENA;
constexpr size_t OFF_HN = OFF_ARENA + 128 * MB;
constexpr size_t OFF_QRAW = OFF_ARENA + 192 * MB;
constexpr size_t OFF_QROT = OFF_ARENA + 224 * MB;
constexpr size_t OFF_KCIN = OFF_ARENA + 256 * MB;
constexpr size_t OFF_VCIN = OFF_KCIN + 8 * MB;
constexpr size_t OFF_KS = OFF_VCIN + 8 * MB;
constexpr size_t OFF_VST = OFF_KS + 8 * MB;
constexpr size_t OFF_KW = OFF_VST + 8 * MB;
constexpr size_t OFF_VWT = OFF_KW + 8 * MB;
constexpr size_t OFF_U = OFF_ARENA + 304 * MB;
constexpr size_t OFF_NSA = OFF_ARENA + 336 * MB;
constexpr size_t OFF_YS = OFF_ARENA + 368 * MB;
constexpr size_t WS_NEED = OFF_ARENA + 400 * MB;
constexpr size_t OFF_ACT = OFF_ARENA;
constexpr size_t OFF_X1B = OFF_ARENA + 256 * MB;
constexpr size_t OFF_MERGED = OFF_HN;

constexpr int SMEM_BYTES = 131072 + 1024;

struct Params {
  const float *x, *g1, *w_in, *pe, *kw1, *kw2, *vw1, *vw2, *lam_re, *lam_im, *log_step, *b_re, *b_im, *c_re, *c_im, *dsk,
      *w_attn, *w_val, *w_gate, *w_out, *g2, *w_up, *w_down, *g3;
  float* out;
  unsigned char* ws;
  int lo, hi;
};

typedef const __attribute__((address_space(4))) Params* PP;

DI int my_tid(int wv0) {
  int t = wv0 * 64 + (int)__lane_id();
  asm volatile("" : "+v"(t));
  return t;
}
DI unsigned pk2(float a, float b);
DI u16 f2bf(float x) { return (u16)(pk2(x, 0.f) & 0xffffu); }
DI float bf2f(u16 h) { return __uint_as_float(((unsigned)h) << 16); }
typedef float f32x2_t __attribute__((ext_vector_type(2)));
typedef __bf16 bf16x2_t __attribute__((ext_vector_type(2)));
DI unsigned pk2(float a, float b) {
  const f32x2_t v = {a, b};
  return __builtin_bit_cast(unsigned, __builtin_convertvector(v, bf16x2_t));
}
DI uint2 pk4(float a, float b, float c, float d) { uint2 o; o.x = pk2(a, b); o.y = pk2(c, d); return o; }
DI float sigmoidf_(float x) { return 1.f / (1.f + __expf(-x)); }
DI float gelu_t(float x) {
  float u = 0.7978845608f * (x + 0.044715f * x * x * x);
  float e = __expf(2.f * u);
  float th = 1.f - 2.f / (e + 1.f);
  return 0.5f * x * (1.f + th);
}
DI float wave_sum(float v) {
#pragma unroll
  for (int o = 32; o > 0; o >>= 1) v += __shfl_xor(v, o);
  return v;
}
template <class T> DI T* launder(T* p) { asm volatile("" : "+v"(p)); return p; }
DI void wave_sync() { asm volatile("s_waitcnt lgkmcnt(0)" ::: "memory"); }
DI f32x4 mfma16(bf16x8 a, bf16x8 b, f32x4 c) { return __builtin_amdgcn_mfma_f32_16x16x32_bf16(a, b, c, 0, 0, 0); }

constexpr int G_HT = 128 * 64;
DI int lds_byte(int r, int c) {
  const int st = (r >> 4) * 2 + (c >> 5), rr = r & 15, cc = c & 31, ob = rr * 64 + cc * 2;
  return st * 1024 + (ob ^ (((ob >> 9) & 1) << 5));
}
DI void stage_rc(int b, int& R, int& C) {
  const int st = b / 1024, sb = b % 1024, swz = sb ^ (((sb >> 9) & 1) << 5);
  R = (st >> 1) * 16 + swz / 64;
  C = (st & 1) * 32 + (swz % 64) / 2;
}
typedef __attribute__((address_space(3))) unsigned* lds_u32p;
DI void gemm256(int wv0, f32x4 (&acc)[2][2][4][2], const u16* __restrict__ A, int lda, const u16* __restrict__ Bt, int ldb,
                int K, unsigned char* smem) {
  u16* shm = (u16*)smem;
  const int tid = my_tid(wv0), lane = tid & 63;
  const int wr = wv0 >> 2, wc = wv0 & 3, fr = lane & 15, fq = lane >> 4;
#define SA(b, h) (shm + ((b)*2 + (h)) * G_HT)
#define SB(b, h) (shm + (4 + (b)*2 + (h)) * G_HT)
  int sr0, sc0, sr1, sc1;
  stage_rc(tid * 16, sr0, sc0);
  stage_rc(tid * 16 + 8192, sr1, sc1);
  const u16* a0 = A + (size_t)sr0 * lda + sc0;
  const u16* a1 = A + (size_t)sr1 * lda + sc1;
  const u16* b0 = Bt + (size_t)sr0 * ldb + sc0;
  const u16* b1 = Bt + (size_t)sr1 * ldb + sc1;
#define STAGE_A(P, half, kt)                                                                                              \
  {                                                                                                                       \
    __builtin_amdgcn_global_load_lds((const unsigned*)(a0 + (size_t)((half)*128) * lda + (kt)*64),                        \
                                     (unsigned*)((char*)(P) + tid * 16), 16, 0, 0);                               \
    __builtin_amdgcn_global_load_lds((const unsigned*)(a1 + (size_t)((half)*128) * lda + (kt)*64),                        \
                                     (unsigned*)((char*)(P) + tid * 16 + 8192), 16, 0, 0);                        \
  }
#define STAGE_B(P, half, kt)                                                                                              \
  {                                                                                                                       \
    __builtin_amdgcn_global_load_lds((const unsigned*)(b0 + (size_t)((half)*128) * ldb + (kt)*64),                        \
                                     (unsigned*)((char*)(P) + tid * 16), 16, 0, 0);                               \
    __builtin_amdgcn_global_load_lds((const unsigned*)(b1 + (size_t)((half)*128) * ldb + (kt)*64),                        \
                                     (unsigned*)((char*)(P) + tid * 16 + 8192), 16, 0, 0);                        \
  }
#define LDA(dst, b, h)                                                                                                    \
  _Pragma("unroll") for (int m = 0; m < 4; ++m) _Pragma("unroll") for (int k = 0; k < 2; ++k)                             \
      dst[m][k] = *(const bf16x8*)((const unsigned char*)SA(b, h) + lds_byte(wr * 64 + m * 16 + fr, k * 32 + fq * 8));
#define LDB(dst, b, h)                                                                                                    \
  _Pragma("unroll") for (int n = 0; n < 2; ++n) _Pragma("unroll") for (int k = 0; k < 2; ++k)                             \
      dst[n][k] = *(const bf16x8*)((const unsigned char*)SB(b, h) + lds_byte(wc * 32 + n * 16 + fr, k * 32 + fq * 8));
#define MMA(ai, bj, At_, Bt_)                                                                                             \
  {                                                                                                                       \
    __builtin_amdgcn_s_setprio(1);                                                                                        \
    _Pragma("unroll") for (int m = 0; m < 4; ++m) _Pragma("unroll") for (int n = 0; n < 2; ++n)                           \
        _Pragma("unroll") for (int k = 0; k < 2; ++k) acc[ai][bj][m][n] =                                                 \
            __builtin_amdgcn_mfma_f32_16x16x32_bf16(Bt_[n][k], At_[m][k], acc[ai][bj][m][n], 0, 0, 0);                    \
    __builtin_amdgcn_s_setprio(0);                                                                                        \
  }
#define WAIT_V(n) asm volatile("s_waitcnt vmcnt(" #n ")" ::: "memory")
#define WAIT_L(n) asm volatile("s_waitcnt lgkmcnt(" #n ")" ::: "memory")
#define BAR __builtin_amdgcn_s_barrier()
#define SCHED __builtin_amdgcn_sched_barrier(0)
#pragma unroll
  for (int a = 0; a < 2; ++a)
#pragma unroll
    for (int b = 0; b < 2; ++b)
#pragma unroll
      for (int m = 0; m < 4; ++m)
#pragma unroll
        for (int n = 0; n < 2; ++n) acc[a][b][m][n] = f32x4{0.f, 0.f, 0.f, 0.f};
  bf16x8 At[4][2], B0[2][2], B1[2][2];
  const int nt = K / 64;
  WAIT_V(0);
  __syncthreads();
  STAGE_B(SB(0, 0), 0, 0) STAGE_A(SA(0, 0), 0, 0)
  STAGE_B(SB(0, 1), 1, 0) STAGE_A(SA(0, 1), 1, 0)
  if (wr == 1) BAR;
  WAIT_V(4); BAR;
  STAGE_B(SB(1, 0), 0, 1) STAGE_A(SA(1, 0), 0, 1) STAGE_B(SB(1, 1), 1, 1)
  WAIT_V(6); BAR;
#pragma unroll 1
  for (int t = 0; t < nt - 2; t += 2) {
    LDB(B0, 0, 0) SCHED; LDA(At, 0, 0) STAGE_A(SA(1, 1), 1, t + 1)
    WAIT_L(8); BAR; WAIT_L(0); MMA(0, 0, At, B0) BAR; SCHED;
    LDB(B1, 0, 1) STAGE_B(SB(0, 0), 0, t + 2)
    BAR; WAIT_L(0); MMA(0, 1, At, B1) BAR;
    LDA(At, 0, 1) STAGE_A(SA(0, 0), 0, t + 2)
    BAR; WAIT_L(0); MMA(1, 0, At, B0) BAR; SCHED;
    STAGE_B(SB(0, 1), 1, t + 2)
    WAIT_V(6); BAR; MMA(1, 1, At, B1) BAR;
    LDB(B0, 1, 0) SCHED; LDA(At, 1, 0) STAGE_A(SA(0, 1), 1, t + 2)
    WAIT_L(8); BAR; WAIT_L(0); MMA(0, 0, At, B0) BAR; SCHED;
    LDB(B1, 1, 1) STAGE_B(SB(1, 0), 0, t + 3)
    BAR; WAIT_L(0); MMA(0, 1, At, B1) BAR;
    LDA(At, 1, 1) STAGE_A(SA(1, 0), 0, t + 3)
    BAR; WAIT_L(0); MMA(1, 0, At, B0) BAR; SCHED;
    STAGE_B(SB(1, 1), 1, t + 3)
    WAIT_V(6); BAR; MMA(1, 1, At, B1) BAR;
  }
  {
    LDB(B0, 0, 0) LDA(At, 0, 0) STAGE_A(SA(1, 1), 1, nt - 1)
    BAR; WAIT_L(0); MMA(0, 0, At, B0) BAR;
    LDB(B1, 0, 1) BAR; WAIT_L(0); MMA(0, 1, At, B1) BAR;
    LDA(At, 0, 1) WAIT_V(4); BAR; WAIT_L(0); MMA(1, 0, At, B0) MMA(1, 1, At, B1) BAR;
  }
  {
    LDB(B0, 1, 0) LDA(At, 1, 0) WAIT_V(2); BAR; WAIT_L(0); MMA(0, 0, At, B0) BAR;
    LDB(B1, 1, 1) WAIT_V(0); BAR; WAIT_L(0); MMA(0, 1, At, B1) BAR;
    LDA(At, 1, 1) BAR; WAIT_L(0); MMA(1, 0, At, B0) MMA(1, 1, At, B1) BAR;
  }
  if (wr == 0) BAR;
}
DI void tile_map_n16(int id, int& pm, int& pn) {
  const int k = id & 255, rnd = id >> 8, x = k & 7, slot = k >> 3;
  pm = rnd * 16 + 4 * (x >> 1) + (slot >> 3);
  pn = 8 * (x & 1) + (slot & 7);
}
DI void tile_map_n4(int id, int& pm, int& pn) {
  const int k = id & 255, rnd = id >> 8, x = k & 7, slot = k >> 3;
  pm = rnd * 64 + 8 * x + (slot >> 2);
  pn = slot & 3;
}
template <class F>
DI void epi256(int wv0, f32x4 (&acc)[2][2][4][2], int brow, int bcol, F f) {
  const int lane = my_tid(wv0) & 63, wr = wv0 >> 2, wc = wv0 & 3;
#pragma unroll
  for (int ai = 0; ai < 2; ++ai)
#pragma unroll
    for (int bj = 0; bj < 2; ++bj)
#pragma unroll
      for (int m = 0; m < 4; ++m)
#pragma unroll
        for (int n = 0; n < 2; ++n) {
          const int row = brow + ai * 128 + wr * 64 + m * 16 + (lane & 15);
          const int col0 = bcol + bj * 128 + wc * 32 + n * 16 + (lane >> 4) * 4;
          f(ai, bj, m, n, row, col0, acc[ai][bj][m][n]);
          if (n == 1 && (m & 1)) __builtin_amdgcn_sched_barrier(0);
        }
}

constexpr int NXT_A = 1024 + 128 + 128 + 16 + 16;
constexpr int NXT = NXT_A + 128 * 3 + 256 + 1024 + 1024;
DI void xpose_tile(int wv0, PP p, int jt, unsigned char* smem) {
  const int tid = my_tid(wv0);
  float* tile = (float*)smem;
  int t = jt;
  const float* src;
  u16* dst;
  int K, Nsrc, mode = 0;
  const float* scl = nullptr;
  if (t < 1024) { src = p->w_in; dst = (u16*)(p->ws + OFF_WINT); K = 1024; Nsrc = 3864; mode = 1; }
  else if ((t -= 1024) < 128) { src = p->kw1; dst = (u16*)(p->ws + OFF_W1KT); K = 2048; Nsrc = 256; }
  else if ((t -= 128) < 128) { src = p->vw1; dst = (u16*)(p->ws + OFF_W1VT); K = 2048; Nsrc = 256; }
  else if ((t -= 128) < 16) { src = p->kw2; dst = (u16*)(p->ws + OFF_W2KT); K = 256; Nsrc = 64; mode = 2; }
  else if ((t -= 16) < 16) { src = p->vw2; dst = (u16*)(p->ws + OFF_W2VT); K = 256; Nsrc = 64; mode = 2; }
  else if ((t -= 16) < 128) { src = p->w_attn; dst = (u16*)(p->ws + OFF_WAT); K = 512; Nsrc = 1024; }
  else if ((t -= 128) < 128) { src = p->w_val; dst = (u16*)(p->ws + OFF_WVT); K = 512; Nsrc = 1024; }
  else if ((t -= 128) < 128) { src = p->w_gate; dst = (u16*)(p->ws + OFF_WGT); K = 512; Nsrc = 1024; }
  else if ((t -= 128) < 256) { src = p->w_out; dst = (u16*)(p->ws + OFF_WOT); K = 1024; Nsrc = 1024; }
  else if ((t -= 256) < 1024) { src = p->w_up; dst = (u16*)(p->ws + OFF_WUPT); K = 1024; Nsrc = 4096; scl = p->g2; }
  else { t -= 1024; src = p->w_down; dst = (u16*)(p->ws + OFF_WDT); K = 4096; Nsrc = 1024; }
  const int nkt = K >> 6, tn = t / nkt, tk = t % nkt, n0 = tn * 64, k0 = tk * 64;
  const int tx = tid & 63, ty = tid >> 6;
  const int np = n0 + tx;
  int sc = np;
  if (mode == 1) {
    if (np < 1280) sc = np;
    else if (np < 1792) sc = 1304 + (np - 1280);
    else if (np < 3840) sc = 1816 + (np - 1792);
    else if (np < 3864) sc = 1280 + (np - 3840);
    else sc = -1;
  } else if (mode == 2) {
    sc = np < 64 ? np : -1;
  }
  for (int kk = ty; kk < 64; kk += 8) {
    float val = 0.f;
    if (sc >= 0) val = src[(size_t)(k0 + kk) * Nsrc + sc];
    if (scl) val *= scl[k0 + kk];
    tile[kk * 65 + tx] = val;
  }
  __syncthreads();
  {
    const int n = tid >> 3, kc = tid & 7;
    uint4 o;
    o.x = pk2(tile[(kc * 8 + 0) * 65 + n], tile[(kc * 8 + 1) * 65 + n]);
    o.y = pk2(tile[(kc * 8 + 2) * 65 + n], tile[(kc * 8 + 3) * 65 + n]);
    o.z = pk2(tile[(kc * 8 + 4) * 65 + n], tile[(kc * 8 + 5) * 65 + n]);
    o.w = pk2(tile[(kc * 8 + 6) * 65 + n], tile[(kc * 8 + 7) * 65 + n]);
    *(uint4*)(dst + (size_t)(n0 + n) * K + k0 + kc * 8) = o;
  }
  __syncthreads();
}

DI void phaseA(int wv0, PP p, unsigned char* smem) {
  const int tid = my_tid(wv0), lane = tid & 63;
  u16* HN = (u16*)(p->ws + OFF_HN);
  for (int row = blockIdx.x * 8 + wv0; row < T_; row += gridDim.x * 8) {
    const float4* xr = (const float4*)(p->x + (size_t)row * 1024);
    float4 v[4];
    float ss = 0.f;
#pragma unroll
    for (int r = 0; r < 4; ++r) {
      v[r] = xr[lane + 64 * r];
      ss += v[r].x * v[r].x + v[r].y * v[r].y + v[r].z * v[r].z + v[r].w * v[r].w;
    }
    ss = wave_sum(ss);
    const float rinv = rsqrtf(ss * (1.f / 1024.f) + 1e-6f);
#pragma unroll
    for (int r = 0; r < 4; ++r) {
      const float4 g = ((const float4*)p->g1)[lane + 64 * r];
      uint2 o;
      o.x = pk2(v[r].x * rinv * g.x, v[r].y * rinv * g.y);
      o.y = pk2(v[r].z * rinv * g.z, v[r].w * rinv * g.w);
      *(uint2*)(HN + (size_t)row * 1024 + (lane + 64 * r) * 4) = o;
    }
  }
  for (int jt = blockIdx.x; jt < NXT_A + 32; jt += gridDim.x) {
    if (jt < NXT_A) {
      xpose_tile(wv0, p, jt, smem);
    } else {
      const int item = jt - NXT_A, kv = item >> 4, slice = item & 15;
      const float* w1 = kv ? p->vw1 : p->kw1;
      const int col = tid & 255, h = tid >> 8, kb = slice * 128 + h * 64;
      float s0 = 0.f, s1 = 0.f, s2 = 0.f, s3 = 0.f;
      for (int k = kb; k < kb + 64; k += 4) {
        s0 += p->pe[k] * w1[(size_t)k * 256 + col];
        s1 += p->pe[k + 1] * w1[(size_t)(k + 1) * 256 + col];
        s2 += p->pe[k + 2] * w1[(size_t)(k + 2) * 256 + col];
        s3 += p->pe[k + 3] * w1[(size_t)(k + 3) * 256 + col];
      }
      ((float*)(p->ws + OFF_CBP))[(kv * 32 + slice * 2 + h) * 256 + col] = (s0 + s1) + (s2 + s3);
    }
  }
  float* rope = (float*)(p->ws + OFF_ROPE);
  for (int i = blockIdx.x * NT_ + tid; i < S_ * 8; i += gridDim.x * NT_) {
    const int pos = i >> 3, k = i & 7;
    const float inv = powf(500000.0f, -(2.0f * (float)k) / 16.0f);
    const float ang = (float)pos * inv;
    rope[pos * 16 + k] = cosf(ang);
    rope[pos * 16 + 8 + k] = sinf(ang);
  }
  if (blockIdx.x == 0 && tid < 64) ((int*)(p->ws + OFF_CTR))[tid] = 0;
}

DI void phaseB(int wv0, PP p, unsigned char* smem) {
  const u16* HN = (const u16*)(p->ws + OFF_HN);
  const u16* WT = (const u16*)(p->ws + OFF_WINT);
  const float* rope = (const float*)(p->ws + OFF_ROPE);
  const int lane = my_tid(wv0) & 63;
  const bool ropewave = (wv0 & 1) == 0;
  for (int id = blockIdx.x; id < 128 * 16; id += gridDim.x) {
    int pm, pn;
    tile_map_n16(id, pm, pn);
    const int brow = pm * 256, bcol = pn * 256;
    f32x4 acc[2][2][4][2];
    gemm256(wv0, acc, HN + (size_t)brow * 1024, 1024, WT + (size_t)bcol * 1024, 1024, 1024, smem);
    if (pn < 2) {
      u16* QR = (u16*)(p->ws + OFF_QRAW);
      u16* QO = (u16*)(p->ws + OFF_QROT);
      epi256(wv0, acc, brow, bcol, [&](int ai, int bj, int m, int n, int row, int col0, f32x4& v) {
        f32x4 r = v;
        if (n == 0 && ropewave) {
          const int pos = row & (S_ - 1), kq = ((lane >> 4) & 1) * 4;
          const float4 c4 = *(const float4*)(rope + pos * 16 + kq), s4 = *(const float4*)(rope + pos * 16 + 8 + kq);
          const float cc[4] = {c4.x, c4.y, c4.z, c4.w}, ss[4] = {s4.x, s4.y, s4.z, s4.w};
#pragma unroll
          for (int j = 0; j < 4; ++j) {
            const float pr = __shfl_xor(v[j], 32);
            r[j] = (lane & 32) ? (v[j] * cc[j] + pr * ss[j]) : (v[j] * cc[j] - pr * ss[j]);
          }
        }
        *(uint2*)(QR + (size_t)row * 512 + col0) = pk4(v[0] * QSCALE, v[1] * QSCALE, v[2] * QSCALE, v[3] * QSCALE);
        *(uint2*)(QO + (size_t)row * 512 + col0) = pk4(r[0] * QSCALE, r[1] * QSCALE, r[2] * QSCALE, r[3] * QSCALE);
      });
    } else if (pn < 5) {
      epi256(wv0, acc, brow, bcol, [&](int ai, int bj, int m, int n, int row, int col0, f32x4& v) {
        const int sub = (pn - 2) * 2 + bj;
        const bool dorope = (sub == 2 || sub == 4), transposed = (sub == 3 || sub == 5);
        u16* dst = (u16*)(p->ws + OFF_KCIN + (size_t)sub * 8 * MB);
        const int c128 = col0 & 127, g = c128 >> 6, d0 = c128 & 63;
        const int b = row >> 13, sq = row & (S_ - 1);
        f32x4 r = v;
        if (dorope && n == 0 && ropewave) {
          const int kq = ((lane >> 4) & 1) * 4;
          const float4 c4 = *(const float4*)(rope + sq * 16 + kq), s4 = *(const float4*)(rope + sq * 16 + 8 + kq);
          const float cc[4] = {c4.x, c4.y, c4.z, c4.w}, ss[4] = {s4.x, s4.y, s4.z, s4.w};
#pragma unroll
          for (int j = 0; j < 4; ++j) {
            const float pr = __shfl_xor(v[j], 32);
            r[j] = (lane & 32) ? (v[j] * cc[j] + pr * ss[j]) : (v[j] * cc[j] - pr * ss[j]);
          }
        }
        if (transposed) {
#pragma unroll
          for (int j = 0; j < 4; ++j) dst[((size_t)((b * 2 + g) * 64 + d0 + j)) * S_ + sq] = f2bf(r[j]);
        } else {
          *(uint2*)(dst + ((size_t)(b * 2 + g) * S_ + sq) * 64 + d0) = pk4(r[0], r[1], r[2], r[3]);
        }
      });
    } else if (pn < 7) {
      u16* U = (u16*)(p->ws + OFF_U);
      epi256(wv0, acc, brow, bcol, [&](int ai, int bj, int m, int n, int row, int col0, f32x4& v) {
        *(uint2*)(U + (size_t)row * 512 + (col0 - 1280)) = pk4(v[0], v[1], v[2], v[3]);
      });
    } else if (pn < 15) {
      u16* MG = (u16*)(p->ws + OFF_MG);
      epi256(wv0, acc, brow, bcol, [&](int ai, int bj, int m, int n, int row, int col0, f32x4& v) {
        *(uint2*)(MG + (size_t)row * 2048 + (col0 - 1792)) = pk4(sigmoidf_(v[0]), sigmoidf_(v[1]), sigmoidf_(v[2]), sigmoidf_(v[3]));
      });
    } else {
      float* NG = (float*)(p->ws + OFF_NG);
      epi256(wv0, acc, brow, bcol, [&](int ai, int bj, int m, int n, int row, int col0, f32x4& v) {
        const int cc = col0 - 3840;
        if (cc < 24) *(float4*)(NG + (size_t)row * 24 + cc) = make_float4(sigmoidf_(v[0]), sigmoidf_(v[1]), sigmoidf_(v[2]), sigmoidf_(v[3]));
      });
    }
  }
}

struct S5c {
  float lbr, lbi;
  float br[16], bi[16];
};
DI void s5_setup(PP p, int g, int n, S5c& c) {
  const float step = expf(p->log_step[g]);
  const float lr = p->lam_re[g * 64 + n], li = p->lam_im[g * 64 + n];
  const float er = expf(lr * step);
  float sn, cs;
  sincosf(li * step, &sn, &cs);
  c.lbr = er * cs;
  c.lbi = er * sn;
  const float nr = c.lbr - 1.f, ni = c.lbi, den = lr * lr + li * li;
  const float cr = (nr * lr + ni * li) / den, ci = (ni * lr - nr * li) / den;
#pragma unroll
  for (int k = 0; k < 16; ++k) {
    const float bre = p->b_re[(g * 64 + n) * 16 + k], bim = p->b_im[(g * 64 + n) * 16 + k];
    c.br[k] = cr * bre - ci * bim;
    c.bi[k] = cr * bim + ci * bre;
  }
}
DI void s5_load_u(PP p, int b, int ch, int g, float* su, int lane) {
  const u16* U = (const u16*)(p->ws + OFF_U) + ((size_t)(b * S_ + ch * 64 + lane)) * 512 + g * 16;
  const uint4 a = *(const uint4*)U, c = *(const uint4*)(U + 8);
  float* d = su + lane * 16;
  const unsigned w[8] = {a.x, a.y, a.z, a.w, c.x, c.y, c.z, c.w};
#pragma unroll
  for (int k = 0; k < 8; ++k) {
    d[2 * k] = __uint_as_float(w[k] << 16);
    d[2 * k + 1] = __uint_as_float(w[k] & 0xffff0000u);
  }
}
DI void s5_step(const S5c& c, const float* ut, float& hr, float& hi) {
  float bur = 0.f, bui = 0.f;
#pragma unroll
  for (int k4 = 0; k4 < 4; ++k4) {
    const float4 u = *(const float4*)(ut + 4 * k4);
    bur += c.br[4 * k4] * u.x + c.br[4 * k4 + 1] * u.y + c.br[4 * k4 + 2] * u.z + c.br[4 * k4 + 3] * u.w;
    bui += c.bi[4 * k4] * u.x + c.bi[4 * k4 + 1] * u.y + c.bi[4 * k4 + 2] * u.z + c.bi[4 * k4 + 3] * u.w;
  }
  const float nr = c.lbr * hr - c.lbi * hi + bur;
  const float nim = c.lbr * hi + c.lbi * hr + bui;
  hr = nr;
  hi = nim;
}
template <bool OUT>
DI void s5_item(int wv0, PP p, int item, unsigned char* smem) {
  const int tid = my_tid(wv0), lane = tid & 63, fr = lane & 15, fq = lane >> 4;
  const int b = item >> 9, g = (item >> 4) & 31, c8 = item & 15, ch = c8 * 8 + wv0;
  u16* sBb = (u16*)smem;
  u16* sCm = sBb + 128 * 16;
  float* sBU = (float*)(smem + 8192) + wv0 * (16 * 132);
  u16* sH = (u16*)(smem + 8192 + 8 * 16 * 132 * 4) + wv0 * (16 * 136);
  const float step = expf(p->log_step[g]);
  for (int e = tid; e < 2048; e += NT_) {
    const int np = e >> 4, c = e & 15, n = np & 63;
    const float lr = p->lam_re[g * 64 + n], li = p->lam_im[g * 64 + n];
    const float er = expf(lr * step);
    float sn, cs;
    sincosf(li * step, &sn, &cs);
    const float nr = er * cs - 1.f, ni = er * sn, den = lr * lr + li * li;
    const float cr = (nr * lr + ni * li) / den, ci = (ni * lr - nr * li) / den;
    const float bre = p->b_re[(g * 64 + n) * 16 + c], bim = p->b_im[(g * 64 + n) * 16 + c];
    sBb[np * 16 + c] = f2bf(np < 64 ? (cr * bre - ci * bim) : (cr * bim + ci * bre));
  }
  if (OUT) {
    for (int e = tid; e < 2048; e += NT_) {
      const int cc = e >> 7, k = e & 127;
      sCm[cc * 128 + k] = f2bf(k < 64 ? p->c_re[(g * 16 + cc) * 64 + k] : -p->c_im[(g * 16 + cc) * 64 + (k - 64)]);
    }
  }
  float lbr, lbi;
  {
    const float lr = p->lam_re[g * 64 + lane], li = p->lam_im[g * 64 + lane];
    const float er = expf(lr * step);
    float sn, cs;
    sincosf(li * step, &sn, &cs);
    lbr = er * cs;
    lbi = er * sn;
  }
  float2* HL = (float2*)(p->ws + OFF_HLOC) + ((size_t)(b * 128 + ch) * 32 + g) * 64 + lane;
  float hr = 0.f, hi = 0.f;
  if (OUT) { const float2 h0 = *HL; hr = h0.x; hi = h0.y; }
  const u16* U = (const u16*)(p->ws + OFF_U) + ((size_t)(b * S_ + ch * 64)) * 512 + g * 16;
  u16* YS = (u16*)(p->ws + OFF_YS) + ((size_t)(b * S_ + ch * 64)) * 512 + g * 16;
  const float dk = p->dsk[g * 16 + fr];
  __syncthreads();
  const bf16x8 zero8 = {0, 0, 0, 0, 0, 0, 0, 0};
  bf16x8 bb[8], cf[4];
#pragma unroll
  for (int nt = 0; nt < 8; ++nt) bb[nt] = fq < 2 ? *(const bf16x8*)(sBb + (16 * nt + fr) * 16 + 8 * fq) : zero8;
  if (OUT) {
#pragma unroll
    for (int ks = 0; ks < 4; ++ks) cf[ks] = *(const bf16x8*)(sCm + fr * 128 + 32 * ks + 8 * fq);
  }
#pragma unroll 1
  for (int sub = 0; sub < 4; ++sub) {
    const bf16x8 ua = fq < 2 ? *(const bf16x8*)(U + (size_t)(sub * 16 + fr) * 512 + 8 * fq) : zero8;
#pragma unroll
    for (int nt = 0; nt < 8; ++nt) {
      const f32x4 a = mfma16(ua, bb[nt], f32x4{0.f, 0.f, 0.f, 0.f});
#pragma unroll
      for (int j = 0; j < 4; ++j) sBU[(4 * fq + j) * 132 + 16 * nt + fr] = a[j];
    }
    __syncthreads();
#pragma unroll 4
    for (int t = 0; t < 16; ++t) {
      const float bur = sBU[t * 132 + lane], bui = sBU[t * 132 + 64 + lane];
      const float nr = lbr * hr - lbi * hi + bur;
      const float nim = lbr * hi + lbi * hr + bui;
      hr = nr;
      hi = nim;
      if (OUT) {
        sH[t * 136 + lane] = f2bf(hr);
        sH[t * 136 + 64 + lane] = f2bf(hi);
      }
    }
    __syncthreads();
    if (OUT) {
      f32x4 y = {0.f, 0.f, 0.f, 0.f};
#pragma unroll
      for (int ks = 0; ks < 4; ++ks) y = mfma16(*(const bf16x8*)(sH + fr * 136 + 32 * ks + 8 * fq), cf[ks], y);
#pragma unroll
      for (int j = 0; j < 4; ++j) {
        const size_t o = (size_t)(sub * 16 + 4 * fq + j) * 512 + fr;
        YS[o] = f2bf(gelu_t(y[j] + dk * bf2f(U[o])));
      }
      __syncthreads();
    }
  }
  if (!OUT) *HL = make_float2(hr, hi);
  __syncthreads();
}
DI void s5_carry(int wv0, PP p) {
  const int x = blockIdx.x * NT_ + my_tid(wv0);
  if (x >= 8192) return;
  const int b = x >> 11, g = (x >> 6) & 31, n = x & 63;
  const float step = expf(p->log_step[g]);
  const float lr = p->lam_re[g * 64 + n], li = p->lam_im[g * 64 + n];
  const float er = expf(64.f * lr * step);
  float sn, cs;
  sincosf(64.f * li * step, &sn, &cs);
  const float Lr = er * cs, Li = er * sn;
  float2* HL = (float2*)(p->ws + OFF_HLOC) + (size_t)b * 128 * 2048 + g * 64 + n;
  float hr = 0.f, hi = 0.f;
  for (int c0 = 0; c0 < 128; c0 += 16) {
    float2 v[16];
#pragma unroll
    for (int k = 0; k < 16; ++k) v[k] = HL[(size_t)(c0 + k) * 2048];
#pragma unroll
    for (int k = 0; k < 16; ++k) {
      HL[(size_t)(c0 + k) * 2048] = make_float2(hr, hi);
      const float nr = Lr * hr - Li * hi + v[k].x;
      const float nim = Lr * hi + Li * hr + v[k].y;
      hr = nr;
      hi = nim;
    }
  }
}
DI void phaseC(int wv0, PP p, unsigned char* smem) {
  const float* cbp = (const float*)(p->ws + OFF_CBP);
  for (int id = blockIdx.x; id < 32 + 2048 + 256; id += gridDim.x) {
    if (id >= 32 + 2048) {
      const int it = id - (32 + 2048), tns = it >> 7, bg = (it >> 4) & 7, part = it & 15;
      const int tid = my_tid(wv0);
      const u16* K = (const u16*)(p->ws + (tns ? OFF_KW : OFF_KS)) + ((size_t)bg * S_ + part * 512 + tid) * 64;
      float q2 = 0.f;
#pragma unroll
      for (int c = 0; c < 8; ++c) {
        const uint4 w = *(const uint4*)(K + c * 8);
        const unsigned ww[4] = {w.x, w.y, w.z, w.w};
#pragma unroll
        for (int e = 0; e < 4; ++e) {
          const float a = __uint_as_float(ww[e] << 16), b2 = __uint_as_float(ww[e] & 0xffff0000u);
          q2 += a * a + b2 * b2;
        }
      }
#pragma unroll
      for (int o = 32; o > 0; o >>= 1) q2 = fmaxf(q2, __shfl_xor(q2, o));
      if ((tid & 63) == 0) atomicMax((unsigned*)(p->ws + OFF_KMAX) + tns * 8 + bg, __float_as_uint(q2));
    } else if (id < 32) {
      const int kv = id >> 4, pm = id & 15, brow = pm * 256;
      const u16* A = (const u16*)(p->ws + (kv ? OFF_VCIN : OFF_KCIN)) + (size_t)brow * 1024;
      const u16* Bt = (const u16*)(p->ws + (kv ? OFF_W1VT : OFF_W1KT));
      f32x4 acc[2][2][4][2];
      gemm256(wv0, acc, A, 1024, Bt, 2048, 2048, smem);
      u16* HC = (u16*)(p->ws + OFF_HC) + (size_t)kv * 4096 * 256;
      epi256(wv0, acc, brow, 0, [&](int ai, int bj, int m, int n, int row, int col0, f32x4& v) {
        float4 bb = make_float4(0.f, 0.f, 0.f, 0.f);
#pragma unroll 8
        for (int sl = 0; sl < 32; ++sl) {
          const float4 t = *(const float4*)(cbp + (kv * 32 + sl) * 256 + col0);
          bb.x += t.x; bb.y += t.y; bb.z += t.z; bb.w += t.w;
        }
        *(uint2*)(HC + (size_t)row * 256 + col0) = pk4(gelu_t(v[0] + bb.x), gelu_t(v[1] + bb.y), gelu_t(v[2] + bb.z), gelu_t(v[3] + bb.w));
      });
    } else {
      s5_item<false>(wv0, p, id - 32, smem);
    }
  }
}
DI void phaseD(int wv0, PP p, unsigned char* smem) {
  for (int id = blockIdx.x; id < 32; id += gridDim.x) {
    const int kv = id >> 4, pm = id & 15, brow = pm * 256;
    const u16* A = (const u16*)(p->ws + OFF_HC) + (size_t)kv * 4096 * 256 + (size_t)brow * 256;
    const u16* Bt = (const u16*)(p->ws + (kv ? OFF_W2VT : OFF_W2KT));
    f32x4 acc[2][2][4][2];
    gemm256(wv0, acc, A, 256, Bt, 256, 256, smem);
    u16* KCC = (u16*)(p->ws + OFF_KCC);
    u16* VCT = (u16*)(p->ws + OFF_VCT);
    epi256(wv0, acc, brow, 0, [&](int ai, int bj, int m, int n, int row, int col0, f32x4& v) {
      if (col0 < 64) {
        const int bg = row >> 9, nn = row & 511;
        f32x4 r = v;
        if (nn == 511) r = f32x4{0.f, 0.f, 0.f, 0.f};
        if (kv == 0) {
          *(uint2*)(KCC + ((size_t)bg * 512 + nn) * 64 + col0) = pk4(r[0], r[1], r[2], r[3]);
        } else {
#pragma unroll
          for (int j = 0; j < 4; ++j) VCT[((size_t)bg * 64 + col0 + j) * 512 + nn] = f2bf(r[j]);
        }
      }
    });
  }
  s5_carry(wv0, p);
}

DI bool bit128(u64 lo, u64 hi, int j) { return j < 64 ? ((lo >> j) & 1ull) : ((hi >> (j - 64)) & 1ull); }
DI int next_bit(u64 lo, u64 hi, int from) {
  if (from < 64) {
    const u64 x = (lo >> from) << from;
    if (x) return __ffsll((long long)x) - 1;
    from = 64;
  }
  if (from >= 128) return -1;
  const u64 y = (hi >> (from - 64)) << (from - 64);
  return y ? 63 + __ffsll((long long)y) : -1;
}

template <int MODE, bool MASKED, class MaskF>
DI void flash_tile(const u16* sK, const u16* sV, const bf16x8 (&qf)[2][2], f32x4 (&O)[2][4], float (&m)[2], float (&l)[2],
                   float (&ps)[4][4], MaskF ok, bool sel, int lane) {
  const int l15 = lane & 15, lg = lane >> 4;
  bf16x8 kf[4][2];
#pragma unroll
  for (int kt = 0; kt < 4; ++kt)
#pragma unroll
    for (int ks = 0; ks < 2; ++ks) kf[kt][ks] = *(const bf16x8*)(sK + (16 * kt + l15) * 72 + ks * 32 + lg * 8);
  if (MODE == 1) {
#pragma unroll
    for (int a = 0; a < 4; ++a)
#pragma unroll
      for (int b = 0; b < 4; ++b) ps[a][b] = 0.f;
  }
  union PFrag { unsigned u[4]; bf16x8 v; };
  PFrag pf[2][2];
#pragma unroll
  for (int qt = 0; qt < 2; ++qt) {
    f32x4 s[4];
    const float sinit = (MODE == 3) ? ((MASKED || sel) ? m[qt] : -1e30f) : 0.f;
#pragma unroll
    for (int kt = 0; kt < 4; ++kt) {
      s[kt] = f32x4{sinit, sinit, sinit, sinit};
#pragma unroll
      for (int ks = 0; ks < 2; ++ks) s[kt] = mfma16(kf[kt][ks], qf[qt][ks], s[kt]);
    }
    float pr[4][4];
    if (MODE == 3) {
      float rs = 0.f;
#pragma unroll
      for (int kt = 0; kt < 4; ++kt)
#pragma unroll
        for (int i = 0; i < 4; ++i) {
          float pv = __builtin_amdgcn_exp2f(s[kt][i]);
          if (MASKED) pv = ok(kt, i) ? pv : 0.f;
          pr[kt][i] = pv;
          rs += pv;
        }
      l[qt] += rs;
    } else {
    float mx = -1e30f;
#pragma unroll
    for (int kt = 0; kt < 4; ++kt)
#pragma unroll
      for (int i = 0; i < 4; ++i) {
        if (MASKED) s[kt][i] = ok(kt, i) ? s[kt][i] : -1e30f;
        mx = fmaxf(mx, s[kt][i]);
      }
    if (!MASKED) mx = sel ? mx : -1e30f;
    if (MODE == 1) {
      const float mm = m[qt], il = l[qt];
#pragma unroll
      for (int kt = 0; kt < 4; ++kt)
#pragma unroll
        for (int i = 0; i < 4; ++i) {
          const float pv = (s[kt][i] > -1e29f) ? __builtin_amdgcn_exp2f(s[kt][i] - mm) * il : 0.f;
          pr[kt][i] = pv;
          ps[kt][i] += pv;
        }
    } else {
      mx = fmaxf(mx, __shfl_xor(mx, 16));
      mx = fmaxf(mx, __shfl_xor(mx, 32));
      const float mnew = fmaxf(m[qt], mx);
      const float alpha = __builtin_amdgcn_exp2f(m[qt] - mnew);
      m[qt] = mnew;
      float rs = 0.f;
      if (MASKED) {
#pragma unroll
        for (int kt = 0; kt < 4; ++kt)
#pragma unroll
          for (int i = 0; i < 4; ++i) {
            const float pv = (s[kt][i] > -1e29f) ? __builtin_amdgcn_exp2f(s[kt][i] - mnew) : 0.f;
            pr[kt][i] = pv;
            rs += pv;
          }
      } else {
        const float me = sel ? mnew : 1e30f;
#pragma unroll
        for (int kt = 0; kt < 4; ++kt)
#pragma unroll
          for (int i = 0; i < 4; ++i) {
            const float pv = __builtin_amdgcn_exp2f(s[kt][i] - me);
            pr[kt][i] = pv;
            rs += pv;
          }
      }
      l[qt] = l[qt] * alpha + rs;
      if (MODE == 2) {
#pragma unroll
        for (int dt = 0; dt < 4; ++dt) O[qt][dt] *= alpha;
      }
    }
    }
    if (MODE != 0) {
#pragma unroll
      for (int ks2 = 0; ks2 < 2; ++ks2) {
        pf[qt][ks2].u[0] = pk2(pr[2 * ks2][0], pr[2 * ks2][1]);
        pf[qt][ks2].u[1] = pk2(pr[2 * ks2][2], pr[2 * ks2][3]);
        pf[qt][ks2].u[2] = pk2(pr[2 * ks2 + 1][0], pr[2 * ks2 + 1][1]);
        pf[qt][ks2].u[3] = pk2(pr[2 * ks2 + 1][2], pr[2 * ks2 + 1][3]);
      }
    }
  }
  if (MODE != 0) {
#pragma unroll
    for (int ks2 = 0; ks2 < 2; ++ks2) {
#pragma unroll
      for (int dt = 0; dt < 4; ++dt) {
        union { uint2 h[2]; bf16x8 v; } vf;
        vf.h[0] = *(const uint2*)(sV + (16 * dt + l15) * 72 + 32 * ks2 + 4 * lg);
        vf.h[1] = *(const uint2*)(sV + (16 * dt + l15) * 72 + 32 * ks2 + 16 + 4 * lg);
        O[0][dt] = mfma16(vf.v, pf[0][ks2].v, O[0][dt]);
        O[1][dt] = mfma16(vf.v, pf[1][ks2].v, O[1][dt]);
      }
    }
  }
}

DI void nsa_item(int wv0, PP p, int item, unsigned char* smem) {
  const int tid = my_tid(wv0), lane = tid & 63, wv = wv0 & 3, hp = wv0 >> 2, l15 = lane & 15, lg = lane >> 4;
  const int i = 127 - (item >> 3), bg = item & 7, b = bg >> 1, g = bg & 1;
  u16* sK = (u16*)smem;
  u16* sV = sK + 64 * 72;
  float* sImp0 = (float*)(smem + 36864);
  float* sImp = sImp0 + hp * (64 * 132);
  u64* sUni = (u64*)(smem + 36864 + 2 * 64 * 132 * 4);
  u64* sSel = sUni + 16;
  const int t0 = i * 64, qloc = 16 * wv + l15, tq = t0 + qloc;
  const unsigned tokq = (unsigned)(b * S_ + tq);
  const float* NGb = (const float*)(p->ws + OFF_NG);
  const unsigned ngoff = tokq * 24 + g * 12 + hp * 6;
  float* ACCb = p->out;
  const unsigned aoff = tokq * 512 + g * 256 + hp * 128 + 4 * lg;
  const unsigned qoff = tokq * 512 + g * 256 + hp * 128 + lg * 8;
  const int lrow = tid >> 3, lpart = tid & 7;
  const unsigned koff = (lrow * 64 + lpart * 8) * 2, voffc = (lrow * 512 + lpart * 8) * 2, voffs = (lrow * S_ + lpart * 8) * 2;

  for (int e = tid; e < 2 * 64 * 132; e += NT_) sImp0[e] = 0.f;

  bf16x8 qf[2][2];
  f32x4 O[2][4];
  float m[2], l[2], ps[4][4];
  u32x4 pk0, pv0;
  auto nomask = [](int, int) { return true; };

#define MAKE_RSRC(PTR) __builtin_amdgcn_make_buffer_rsrc((void*)(PTR), 0, 0x7fffffff, 0x00020000)
#define BLOAD(R, VO, SO) __builtin_amdgcn_raw_buffer_load_b128((R), (int)(VO), (int)(SO), 0)
#define ISSUE_TILE(RK, RV, T, LDV)                                                   \
  {                                                                                  \
    pk0 = BLOAD(RK, koff, (T)*8192);                                                 \
    pv0 = BLOAD(RV, ((LDV) == 512) ? voffc : voffs, (T)*128);                        \
  }
#define COMMIT_TILE()                                                                \
  {                                                                                  \
    *(u32x4*)(sK + lrow * 72 + lpart * 8) = pk0;                                     \
    *(u32x4*)(sV + lrow * 72 + lpart * 8) = pv0;                                     \
  }
#define COMMIT_BUF(BUF)                                                              \
  {                                                                                  \
    *(u32x4*)(sK + (BUF)*9216 + lrow * 72 + lpart * 8) = pk0;                        \
    *(u32x4*)(sV + (BUF)*9216 + lrow * 72 + lpart * 8) = pv0;                        \
  }
#define LOAD_Q(BASE)                                                                 \
  {                                                                                  \
    const u16* Q_ = (const u16*)(p->ws + (BASE));                                    \
    _Pragma("unroll") for (int qt = 0; qt < 2; ++qt)                                 \
      _Pragma("unroll") for (int ks = 0; ks < 2; ++ks)                               \
        qf[qt][ks] = *(const bf16x8*)(Q_ + (qoff + qt * 64 + ks * 32));             \
  }
#define RESET_STATE()                                                                \
  {                                                                                  \
    _Pragma("unroll") for (int qt = 0; qt < 2; ++qt) { m[qt] = -1e30f; l[qt] = 0.f; } \
    _Pragma("unroll") for (int a = 0; a < 2; ++a)                                    \
      _Pragma("unroll") for (int c = 0; c < 4; ++c) O[a][c] = f32x4{0.f, 0.f, 0.f, 0.f}; \
  }

  {
    const u16* Kc0 = (const u16*)(p->ws + OFF_KCC) + (size_t)bg * 512 * 64;
    const u16* Vc0 = (const u16*)(p->ws + OFF_VCT) + (size_t)bg * 64 * 512;
    const int nE = (4 * i + 3) < 511 ? (4 * i + 3) : 511;
    const int nkb = (nE + 63) >> 6;
    const __amdgpu_buffer_rsrc_t rK = MAKE_RSRC(Kc0), rV = MAKE_RSRC(Vc0);
    LOAD_Q(OFF_QRAW)
    RESET_STATE()
    ISSUE_TILE(rK, rV, 0, 512)
    for (int kb = 0; kb < nkb; ++kb) {
      __syncthreads();
      COMMIT_TILE()
      __syncthreads();
      if (kb + 1 < nkb) ISSUE_TILE(rK, rV, kb + 1, 512)
      auto ok = [&](int kt, int ii) { return 16 * (kb * 64 + 16 * kt + 4 * lg + ii) + 31 <= tq; };
      flash_tile<0, true>(sK, sV, qf, O, m, l, ps, ok, true, lane);
    }
#pragma unroll
    for (int qt = 0; qt < 2; ++qt) {
      float s = l[qt];
      s += __shfl_xor(s, 16);
      s += __shfl_xor(s, 32);
      l[qt] = s > 0.f ? 1.f / s : 0.f;
    }
    ISSUE_TILE(rK, rV, 0, 512)
    for (int kb = 0; kb < nkb; ++kb) {
      __syncthreads();
      COMMIT_TILE()
      __syncthreads();
      if (kb + 1 < nkb) ISSUE_TILE(rK, rV, kb + 1, 512)
      auto ok = [&](int kt, int ii) { return 16 * (kb * 64 + 16 * kt + 4 * lg + ii) + 31 <= tq; };
      flash_tile<1, true>(sK, sV, qf, O, m, l, ps, ok, true, lane);
#pragma unroll
      for (int kt = 0; kt < 4; ++kt) {
        const int j = kb * 16 + kt * 4 + lg;
        sImp[qloc * 132 + j] += ps[kt][0] + ps[kt][1] + ps[kt][2] + ps[kt][3];
      }
      __syncthreads();
#pragma unroll
      for (int kt = 0; kt < 4; ++kt) {
        const int j1 = kb * 16 + kt * 4 + lg + 1;
        if (j1 < 128) sImp[qloc * 132 + j1] += ps[kt][3];
      }
    }
#pragma unroll
    for (int qt = 0; qt < 2; ++qt) {
      const float gt = NGb[ngoff + qt * 3 + 0];
#pragma unroll
      for (int dt = 0; dt < 4; ++dt) {
        float4 o = make_float4(O[qt][dt][0] * gt, O[qt][dt][1] * gt, O[qt][dt][2] * gt, O[qt][dt][3] * gt);
        *(float4*)(ACCb + (aoff + qt * 64 + 16 * dt)) = o;
      }
    }
  }
  __syncthreads();
  u64 mlo = 0, mhi = 0, wlo = 0, whi = 0;
  if (i < 16) {
    mlo = (1ull << (i + 1)) - 1ull;
    wlo = mlo;
  } else {
    const bool v0 = lane <= i, v1 = (lane + 64) <= i;
    const bool f0 = (lane == 0) || (lane == i) || (lane == i - 1);
    const bool f1 = (lane + 64 == i) || (lane + 64 == i - 1);
    const u64 ltm = (1ull << lane) - 1ull;
    for (int qq = hp * 8; qq < hp * 8 + 8; ++qq) {
      const float* ir = sImp0 + (16 * wv + qq) * 132;
      const float i0 = ir[lane] + ir[64 * 132 + lane], i1 = ir[lane + 64] + ir[64 * 132 + lane + 64];
      const unsigned k0 = v0 ? __float_as_uint(i0 + (f0 ? 1000.f : 0.f)) : 0u;
      const unsigned k1 = v1 ? __float_as_uint(i1 + (f1 ? 1000.f : 0.f)) : 0u;
      unsigned T = 0;
      for (int bit = 30; bit >= 0; --bit) {
        const unsigned cand = T | (1u << bit);
        const int cnt = __popcll(__ballot(k0 >= cand)) + __popcll(__ballot(k1 >= cand));
        if (cnt >= 16) T = cand;
      }
      const bool g0 = k0 > T, g1 = k1 > T, e0 = k0 == T, e1 = k1 == T;
      const int need = 16 - (__popcll(__ballot(g0)) + __popcll(__ballot(g1)));
      const u64 be0 = __ballot(e0), be1 = __ballot(e1);
      const int r0 = __popcll(be0 & ltm), r1 = __popcll(be0) + __popcll(be1 & ltm);
      const u64 s0 = __ballot(v0 && (g0 || (e0 && r0 < need)));
      const u64 s1 = __ballot(v1 && (g1 || (e1 && r1 < need)));
      wlo |= s0;
      whi |= s1;
      if (lane == 0) { sSel[(16 * wv + qq) * 2] = s0; sSel[(16 * wv + qq) * 2 + 1] = s1; }
    }
  }
  if (lane == 0) { sUni[wv0 * 2] = wlo; sUni[wv0 * 2 + 1] = whi; }
  __syncthreads();
  if (i >= 16) { mlo = sSel[qloc * 2]; mhi = sSel[qloc * 2 + 1]; }
  wlo = sUni[wv * 2] | sUni[(wv + 4) * 2];
  whi = sUni[wv * 2 + 1] | sUni[(wv + 4) * 2 + 1];
  const u64 blo = sUni[0] | sUni[2] | sUni[4] | sUni[6] | sUni[8] | sUni[10] | sUni[12] | sUni[14];
  const u64 bhi = sUni[1] | sUni[3] | sUni[5] | sUni[7] | sUni[9] | sUni[11] | sUni[13] | sUni[15];

  LOAD_Q(OFF_QROT)
  float nb_s[2], nb_w[2];
  bool usefix;
  {
    const float* KM = (const float*)(p->ws + OFF_KMAX);
    const float kms = KM[bg], kmw = KM[8 + bg];
    float bmax = 0.f;
#pragma unroll
    for (int qt = 0; qt < 2; ++qt) {
      float q2 = 0.f;
#pragma unroll
      for (int ks = 0; ks < 2; ++ks)
#pragma unroll
        for (int e = 0; e < 8; ++e) {
          const float qv = __uint_as_float(((unsigned)(u16)qf[qt][ks][e]) << 16);
          q2 += qv * qv;
        }
      q2 += __shfl_xor(q2, 16);
      q2 += __shfl_xor(q2, 32);
      const float bs = sqrtf(q2 * kms) * 1.001f + 1e-3f, bw = sqrtf(q2 * kmw) * 1.001f + 1e-3f;
      nb_s[qt] = -bs;
      nb_w[qt] = -bw;
      bmax = fmaxf(bmax, fmaxf(bs, bw));
    }
    usefix = __ballot(bmax > 60.f) == 0ull;
  }
  RESET_STATE()
  if (usefix) { m[0] = nb_s[0]; m[1] = nb_s[1]; }
  {
    const __amdgpu_buffer_rsrc_t rK = MAKE_RSRC((const u16*)(p->ws + OFF_KS) + (size_t)bg * S_ * 64);
    const __amdgpu_buffer_rsrc_t rV = MAKE_RSRC((const u16*)(p->ws + OFF_VST) + (size_t)bg * 64 * S_);
    int j = next_bit(blo, bhi, 0);
    ISSUE_TILE(rK, rV, j, S_)
    COMMIT_BUF(0)
    __syncthreads();
    int jn = next_bit(blo, bhi, j + 1);
    if (jn >= 0) ISSUE_TILE(rK, rV, jn, S_)
    int cur = 0;
    while (j >= 0) {
      const u16* cK = sK + cur * 9216;
      const u16* cV = sV + cur * 9216;
      if (bit128(wlo, whi, j)) {
        const bool sel = bit128(mlo, mhi, j);
        if (j == i) {
          auto ok = [&](int kt, int ii) { return sel && (16 * kt + 4 * lg + ii) <= qloc; };
          if (usefix) flash_tile<3, true>(cK, cV, qf, O, m, l, ps, ok, true, lane);
          else flash_tile<2, true>(cK, cV, qf, O, m, l, ps, ok, true, lane);
        } else {
          if (usefix) flash_tile<3, false>(cK, cV, qf, O, m, l, ps, nomask, sel, lane);
          else flash_tile<2, false>(cK, cV, qf, O, m, l, ps, nomask, sel, lane);
        }
      }
      cur ^= 1;
      if (jn >= 0) COMMIT_BUF(cur)
      __syncthreads();
      j = jn;
      if (j >= 0) {
        jn = next_bit(blo, bhi, j + 1);
        if (jn >= 0) ISSUE_TILE(rK, rV, jn, S_)
      }
    }
  }
#pragma unroll
  for (int qt = 0; qt < 2; ++qt) {
    float s = l[qt];
    s += __shfl_xor(s, 16);
    s += __shfl_xor(s, 32);
    const float sc = NGb[ngoff + qt * 3 + 1] / s;
#pragma unroll
    for (int dt = 0; dt < 4; ++dt) {
      float4* a = (float4*)(ACCb + (aoff + qt * 64 + 16 * dt));
      float4 o = *a;
      o.x += O[qt][dt][0] * sc; o.y += O[qt][dt][1] * sc; o.z += O[qt][dt][2] * sc; o.w += O[qt][dt][3] * sc;
      *a = o;
    }
  }
  RESET_STATE()
  if (usefix) { m[0] = nb_w[0]; m[1] = nb_w[1]; }
  {
    const __amdgpu_buffer_rsrc_t rK = MAKE_RSRC((const u16*)(p->ws + OFF_KW) + (size_t)bg * S_ * 64);
    const __amdgpu_buffer_rsrc_t rV = MAKE_RSRC((const u16*)(p->ws + OFF_VWT) + (size_t)bg * 64 * S_);
    const int j0 = i >= 8 ? i - 8 : 0;
    ISSUE_TILE(rK, rV, j0, S_)
    COMMIT_BUF(0)
    __syncthreads();
    if (j0 + 1 <= i) ISSUE_TILE(rK, rV, j0 + 1, S_)
    int cur = 0;
    for (int j = j0; j <= i; ++j) {
      const u16* cK = sK + cur * 9216;
      const u16* cV = sV + cur * 9216;
      if (j == i || j == i - 8) {
        auto ok = [&](int kt, int ii) {
          const int kp = j * 64 + 16 * kt + 4 * lg + ii;
          return kp <= tq && kp > tq - 512;
        };
        if (usefix) flash_tile<3, true>(cK, cV, qf, O, m, l, ps, ok, true, lane);
        else flash_tile<2, true>(cK, cV, qf, O, m, l, ps, ok, true, lane);
      } else {
        if (usefix) flash_tile<3, false>(cK, cV, qf, O, m, l, ps, nomask, true, lane);
        else flash_tile<2, false>(cK, cV, qf, O, m, l, ps, nomask, true, lane);
      }
      cur ^= 1;
      if (j + 1 <= i) COMMIT_BUF(cur)
      __syncthreads();
      if (j + 2 <= i) ISSUE_TILE(rK, rV, j + 2, S_)
    }
  }
  u16* NSAb = (u16*)(p->ws + OFF_NSA);
#pragma unroll
  for (int qt = 0; qt < 2; ++qt) {
    float s = l[qt];
    s += __shfl_xor(s, 16);
    s += __shfl_xor(s, 32);
    const float sc = NGb[ngoff + qt * 3 + 2] / s;
#pragma unroll
    for (int dt = 0; dt < 4; ++dt) {
      const float4 a = *(const float4*)(ACCb + (aoff + qt * 64 + 16 * dt));
      uint2 o;
      o.x = pk2(a.x + O[qt][dt][0] * sc, a.y + O[qt][dt][1] * sc);
      o.y = pk2(a.z + O[qt][dt][2] * sc, a.w + O[qt][dt][3] * sc);
      *(uint2*)(NSAb + (aoff + qt * 64 + 16 * dt)) = o;
    }
  }
  __syncthreads();
}

DI void phaseE(int wv0, PP p, unsigned char* smem, int cidx) {
  __shared__ int s_item;
  int* ctr = (int*)(p->ws + OFF_CTR) + cidx;
  for (;;) {
    __syncthreads();
    if (my_tid(wv0) == 0) s_item = atomicAdd(ctr, 1);
    __syncthreads();
    const int item = s_item;
    if (item >= 1024 + 2048 + (NXT - NXT_A)) break;
    if (item < 1024) nsa_item(wv0, p, item, smem);
    else if (item < 1024 + 2048) s5_item<true>(wv0, p, item - 1024, smem);
    else xpose_tile(wv0, p, NXT_A + (item - 3072), smem);
  }
}

DI void phaseF(int wv0, PP p, unsigned char* smem) {
  const u16* YS = (const u16*)(p->ws + OFF_YS);
  const u16* NSA = (const u16*)(p->ws + OFF_NSA);
  const u16* MG = (const u16*)(p->ws + OFF_MG);
  u16* MR = (u16*)(p->ws + OFF_MERGED);
  for (int id = blockIdx.x; id < 128 * 4; id += gridDim.x) {
    int pm, pn;
    tile_map_n4(id, pm, pn);
    const int brow = pm * 256, bcol = pn * 256;
    f32x4 acc[2][2][4][2];
    gemm256(wv0, acc, YS + (size_t)brow * 512, 512, (const u16*)(p->ws + OFF_WGT) + (size_t)bcol * 512, 512, 512, smem);
    epi256(wv0, acc, brow, bcol, [&](int ai, int bj, int m, int n, int row, int col0, f32x4& v) {
      *(uint2*)(MR + (size_t)row * 1024 + col0) = pk4(sigmoidf_(v[0]), sigmoidf_(v[1]), sigmoidf_(v[2]), sigmoidf_(v[3]));
    });
    gemm256(wv0, acc, YS + (size_t)brow * 512, 512, (const u16*)(p->ws + OFF_WVT) + (size_t)bcol * 512, 512, 512, smem);
    epi256(wv0, acc, brow, bcol, [&](int ai, int bj, int m, int n, int row, int col0, f32x4& v) {
      const uint2 t = *(const uint2*)(MR + (size_t)row * 1024 + col0);
      const uint2 gq = *(const uint2*)(MG + (size_t)row * 2048 + 1024 + col0);
      *(uint2*)(MR + (size_t)row * 1024 + col0) =
          pk4(__uint_as_float(gq.x << 16) * v[0] * __uint_as_float(t.x << 16), __uint_as_float(gq.x & 0xffff0000u) * v[1] * __uint_as_float(t.x & 0xffff0000u),
              __uint_as_float(gq.y << 16) * v[2] * __uint_as_float(t.y << 16), __uint_as_float(gq.y & 0xffff0000u) * v[3] * __uint_as_float(t.y & 0xffff0000u));
    });
    gemm256(wv0, acc, NSA + (size_t)brow * 512, 512, (const u16*)(p->ws + OFF_WAT) + (size_t)bcol * 512, 512, 512, smem);
    epi256(wv0, acc, brow, bcol, [&](int ai, int bj, int m, int n, int row, int col0, f32x4& v) {
      const uint2 t = *(const uint2*)(MR + (size_t)row * 1024 + col0);
      const uint2 gq = *(const uint2*)(MG + (size_t)row * 2048 + col0);
      *(uint2*)(MR + (size_t)row * 1024 + col0) =
          pk4(__uint_as_float(gq.x << 16) * v[0] + __uint_as_float(t.x << 16), __uint_as_float(gq.x & 0xffff0000u) * v[1] + __uint_as_float(t.x & 0xffff0000u),
              __uint_as_float(gq.y << 16) * v[2] + __uint_as_float(t.y << 16), __uint_as_float(gq.y & 0xffff0000u) * v[3] + __uint_as_float(t.y & 0xffff0000u));
    });
  }
}
DI void ss_partial(int wv0, f32x4 (&acc)[2][2][4][2], float* SS, int brow, int pn) {
  const int lane = my_tid(wv0) & 63, wr = wv0 >> 2, wc = wv0 & 3;
#pragma unroll
  for (int ai = 0; ai < 2; ++ai)
#pragma unroll
    for (int m = 0; m < 4; ++m) {
      float s = 0.f;
#pragma unroll
      for (int bj = 0; bj < 2; ++bj)
#pragma unroll
        for (int n = 0; n < 2; ++n)
#pragma unroll
          for (int j = 0; j < 4; ++j) s += acc[ai][bj][m][n][j] * acc[ai][bj][m][n][j];
      s += __shfl_xor(s, 16);
      s += __shfl_xor(s, 32);
      if (lane < 16) SS[(size_t)(brow + ai * 128 + wr * 64 + m * 16 + lane) * 16 + pn * 4 + wc] = s;
    }
}
DI void phaseG(int wv0, PP p, unsigned char* smem) {
  const u16* MR = (const u16*)(p->ws + OFF_MERGED);
  u16* X1B = (u16*)(p->ws + OFF_X1B);
  float* SS1 = (float*)(p->ws + OFF_SS1);
  for (int id = blockIdx.x; id < 128 * 4; id += gridDim.x) {
    int pm, pn;
    tile_map_n4(id, pm, pn);
    const int brow = pm * 256, bcol = pn * 256;
    f32x4 acc[2][2][4][2];
    gemm256(wv0, acc, MR + (size_t)brow * 1024, 1024, (const u16*)(p->ws + OFF_WOT) + (size_t)bcol * 1024, 1024, 1024, smem);
    epi256(wv0, acc, brow, bcol, [&](int ai, int bj, int m, int n, int row, int col0, f32x4& v) {
      const size_t o = (size_t)row * 1024 + col0;
      const float4 xv = *(const float4*)(p->x + o);
      v[0] += xv.x; v[1] += xv.y; v[2] += xv.z; v[3] += xv.w;
      *(float4*)(p->out + o) = make_float4(v[0], v[1], v[2], v[3]);
      *(uint2*)(X1B + o) = pk4(v[0], v[1], v[2], v[3]);
    });
    ss_partial(wv0, acc, SS1, brow, pn);
  }
}
DI void phaseH(int wv0, PP p, unsigned char* smem) {
  const u16* X1B = (const u16*)(p->ws + OFF_X1B);
  const float* SS1 = (const float*)(p->ws + OFF_SS1);
  u16* ACT = (u16*)(p->ws + OFF_ACT);
  float* sR = (float*)(smem + 131072);
  for (int id = blockIdx.x; id < 128 * 16; id += gridDim.x) {
    int pm, pn;
    tile_map_n16(id, pm, pn);
    const int brow = pm * 256, bcol = pn * 256;
    const int tid = my_tid(wv0);
    if (tid < 256) {
      const float4* s = (const float4*)(SS1 + (size_t)(brow + tid) * 16);
      const float4 a = s[0], b = s[1], c = s[2], d = s[3];
      const float t = a.x + a.y + a.z + a.w + b.x + b.y + b.z + b.w + c.x + c.y + c.z + c.w + d.x + d.y + d.z + d.w;
      sR[tid] = rsqrtf(t * (1.f / 1024.f) + 1e-6f);
    }
    f32x4 acc[2][2][4][2];
    gemm256(wv0, acc, X1B + (size_t)brow * 1024, 1024, (const u16*)(p->ws + OFF_WUPT) + (size_t)bcol * 1024, 1024, 1024, smem);
    epi256(wv0, acc, brow, bcol, [&](int ai, int bj, int m, int n, int row, int col0, f32x4& v) {
      const float ri = sR[row - brow];
      const float a0 = fmaxf(v[0] * ri, 0.f), a1 = fmaxf(v[1] * ri, 0.f), a2 = fmaxf(v[2] * ri, 0.f), a3 = fmaxf(v[3] * ri, 0.f);
      *(uint2*)(ACT + (size_t)row * 4096 + col0) = pk4(a0 * a0, a1 * a1, a2 * a2, a3 * a3);
    });
    __syncthreads();
  }
}
DI void phaseI(int wv0, PP p, unsigned char* smem) {
  const u16* ACT = (const u16*)(p->ws + OFF_ACT);
  float* SS2 = (float*)(p->ws + OFF_SS2);
  for (int id = blockIdx.x; id < 128 * 4; id += gridDim.x) {
    int pm, pn;
    tile_map_n4(id, pm, pn);
    const int brow = pm * 256, bcol = pn * 256;
    f32x4 acc[2][2][4][2];
    gemm256(wv0, acc, ACT + (size_t)brow * 4096, 4096, (const u16*)(p->ws + OFF_WDT) + (size_t)bcol * 4096, 4096, 4096, smem);
    epi256(wv0, acc, brow, bcol, [&](int ai, int bj, int m, int n, int row, int col0, f32x4& v) {
      const size_t o = (size_t)row * 1024 + col0;
      const float4 xv = *(const float4*)(p->out + o);
      v[0] += xv.x; v[1] += xv.y; v[2] += xv.z; v[3] += xv.w;
      *(float4*)(p->out + o) = make_float4(v[0], v[1], v[2], v[3]);
    });
    ss_partial(wv0, acc, SS2, brow, pn);
  }
}
DI void phaseJ(int wv0, PP p) {
  const int lane = my_tid(wv0) & 63;
  const float* SS2 = (const float*)(p->ws + OFF_SS2);
  for (int row = blockIdx.x * 8 + wv0; row < T_; row += gridDim.x * 8) {
    float t = (lane < 16) ? SS2[(size_t)row * 16 + lane] : 0.f;
    t = wave_sum(t);
    const float rinv = rsqrtf(t * (1.f / 1024.f) + 1e-6f);
    float4* xr = (float4*)(p->out + (size_t)row * 1024);
#pragma unroll
    for (int r = 0; r < 4; ++r) {
      float4 v = xr[lane + 64 * r];
      const float4 g = ((const float4*)p->g3)[lane + 64 * r];
      v.x *= rinv * g.x; v.y *= rinv * g.y; v.z *= rinv * g.z; v.w *= rinv * g.w;
      xr[lane + 64 * r] = v;
    }
  }
}


#define XB_TMO      128
#define XB_XCNT(j)  (256  + 64 * (j))
#define XB_XSUB(j)  (1280 + 64 * (j))
#define XB_XGEN(j)  (2304 + 64 * (j))
#define XB_TOP      3328
#define XB_TOPGEN   3392
#define XB_SPIN_CAP (1u << 18)
#define LAS __attribute__((address_space(3)))
DI unsigned xb_ld(unsigned* p) { return __hip_atomic_load(p, __ATOMIC_RELAXED, __HIP_MEMORY_SCOPE_AGENT); }
DI unsigned xb_add(unsigned* p, unsigned v) { return __hip_atomic_fetch_add(p, v, __ATOMIC_RELAXED, __HIP_MEMORY_SCOPE_AGENT); }
DI unsigned xb_xcc_id() { return (unsigned)__builtin_amdgcn_s_getreg((3 << 11) | 20) & 0xFu; }
#define XB_SPIN(cond, bar) do { unsigned _sp = 0; while (cond) { __builtin_amdgcn_s_sleep(1); \
    if ((++_sp & 255u) == 0u) { if (xb_ld(&(bar)[XB_TMO])) break; if (_sp > XB_SPIN_CAP) { atomicAdd(&(bar)[XB_TMO], 1u); break; } } } } while (0)
DI void xcd_barrier_complete(unsigned* bar, unsigned x, unsigned& nloc, unsigned& nx) {
  const unsigned G = gridDim.x * gridDim.y * gridDim.z;
  unsigned sum, cnt, mine, sp = 0u;
  for (;;) {
    sum = 0u; cnt = 0u; mine = 0u;
#pragma unroll
    for (unsigned j = 0; j < 16; ++j) { const unsigned c = xb_ld(&bar[XB_XCNT(j)]); sum += c; cnt += (c > 0u) ? 1u : 0u; mine = (j == x) ? c : mine; }
    if (sum == G) break;
    __builtin_amdgcn_s_sleep(1);
    if ((++sp & 255u) == 0u) { if (xb_ld(&bar[XB_TMO])) break; if (sp > XB_SPIN_CAP) { atomicAdd(&bar[XB_TMO], 1u); break; } }
  }
  nloc = mine > 0u ? mine : 1u; nx = cnt > 0u ? cnt : 1u;
}
DI void xcd_barrier(unsigned* bar, volatile LAS unsigned* st, bool leader) {
  asm volatile("s_waitcnt vmcnt(0)" ::: "memory");
  __syncthreads();
  if (leader) {
    const unsigned x = xb_xcc_id();
    __builtin_amdgcn_s_waitcnt(0);
    unsigned nloc = st[0], nx = st[1];
    if (nloc == 0u) { xcd_barrier_complete(bar, x, nloc, nx); st[0] = nloc; st[1] = nx; }
    const unsigned old = xb_add(&bar[XB_XSUB(x)], 1u);
    const unsigned gen = old / nloc;
    if (old + 1u == (gen + 1u) * nloc) {
      __builtin_amdgcn_fence(__ATOMIC_RELEASE, "agent");
      asm volatile("s_waitcnt vmcnt(0)" ::: "memory");
      const unsigned og = xb_add(&bar[XB_TOP], 1u);
      const unsigned tg = og / nx;
      if (og + 1u == (tg + 1u) * nx) xb_add(&bar[XB_TOPGEN], 1u);
      else XB_SPIN(xb_ld(&bar[XB_TOPGEN]) == tg, bar);
      __builtin_amdgcn_fence(__ATOMIC_ACQUIRE, "agent");
      xb_add(&bar[XB_XGEN(x)], 1u);
      asm volatile("s_waitcnt vmcnt(0)" ::: "memory");
    } else {
      XB_SPIN(xb_ld(&bar[XB_XGEN(x)]) == gen, bar);
      __builtin_amdgcn_fence(__ATOMIC_ACQUIRE, "agent");
      asm volatile("s_waitcnt vmcnt(0)" ::: "memory");
    }
  }
  __syncthreads();
}

__global__ void __launch_bounds__(512, 2) mega(Params p) {
  extern __shared__ __attribute__((aligned(16))) unsigned char smem[];
  const int wv0 = __builtin_amdgcn_readfirstlane((int)(threadIdx.x >> 6));
  const int lo = p.lo, hi = p.hi;
  PP kp0 = (PP)__builtin_amdgcn_kernarg_segment_ptr();
  __shared__ uint4 xb_words;
  if (threadIdx.x == 0) {
    xb_words = make_uint4(0u, 0u, 0u, 0u);
    (void)xb_add((unsigned*)(kp0->ws + OFF_BAR) + XB_XCNT(xb_xcc_id()), 1u);
  }
  __syncthreads();
#define PH(N, CALL)                                  \
  if (lo <= N && N < hi) {                           \
    PP kp = kp0;                                     \
    asm volatile("" : "+s"(kp));                     \
    if (N > lo) {                                    \
      if (N == 1) cg::this_grid().sync();            \
      else xcd_barrier((unsigned*)(kp->ws + OFF_BAR), (volatile LAS unsigned*)&xb_words, my_tid(wv0) == 0); \
    }                                                \
    CALL;                                            \
    if ((PROBE_MASK >> N) & 1) { CALL; }             \
  }
  PH(0, phaseA(wv0, kp, smem))
  PH(1, phaseB(wv0, kp, smem))
  PH(2, phaseC(wv0, kp, smem))
  PH(3, phaseD(wv0, kp, smem))
  PH(4, phaseE(wv0, kp, smem, 0))
  if ((PROBE_MASK >> 10) & 1) { PP kp = kp0; asm volatile("" : "+s"(kp)); phaseE(wv0, kp, smem, 1); }
  PH(5, phaseF(wv0, kp, smem))
  PH(6, phaseG(wv0, kp, smem))
  PH(7, phaseH(wv0, kp, smem))
  PH(8, phaseI(wv0, kp, smem))
  PH(9, phaseJ(wv0, kp))
}

extern "C" void kernel_launch(void* const* d_in, const int* in_sizes, int n_in, void* d_out, int out_size, void* d_ws,
                              size_t ws_size, hipStream_t stream) {
  static int grid_blocks = 0;
  if (!grid_blocks) {
    int dev = 0, cus = 0, per_cu = 0;
    (void)hipGetDevice(&dev);
    (void)hipDeviceGetAttribute(&cus, hipDeviceAttributeMultiprocessorCount, dev);
    (void)hipFuncSetAttribute((const void*)mega, hipFuncAttributeMaxDynamicSharedMemorySize, SMEM_BYTES);
    (void)hipOccupancyMaxActiveBlocksPerMultiprocessor(&per_cu, mega, NT_, SMEM_BYTES);
    if (per_cu > 1) per_cu = 1;
    if (per_cu < 1) per_cu = 1;
    grid_blocks = cus * per_cu;
  }
  if (ws_size < WS_NEED) { fprintf(stderr, "workspace too small: %zu < %zu\n", ws_size, (size_t)WS_NEED); }
  Params p{};
  const float** f = (const float**)&p;
  for (int i = 0; i < 24; ++i) f[i] = (const float*)d_in[i];
  p.out = (float*)d_out;
  p.ws = (unsigned char*)d_ws;
  p.lo = 0; p.hi = 10;
  (void)hipMemsetAsync((unsigned char*)d_ws + OFF_BAR, 0, 16384, stream);
  void* args[] = {&p};
  hipError_t e = hipLaunchCooperativeKernel((void*)mega, dim3(grid_blocks), dim3(NT_), args, SMEM_BYTES, stream);
  if (e != hipSuccess) fprintf(stderr, "cooperative launch failed: %s (grid %d)\n", hipGetErrorString(e), grid_blocks);
}
```

```cpp
#include <hip/hip_runtime.h>
#include <hip/hip_cooperative_groups.h>
#include <cstdio>
namespace cg = cooperative_groups;

#ifndef PROBE_MASK
#define PROBE_MASK 0
#endif

#define DI __device__ __forceinline__
typedef unsigned short u16;
typedef unsigned long long u64;
using bf16x8 = __attribute__((ext_vector_type(8))) short;
using f32x4 = __attribute__((ext_vector_type(4))) float;
using u32x4 = __attribute__((ext_vector_type(4))) unsigned;

constexpr int B_ = 4, S_ = 8192, T_ = B_ * S_;
constexpr int NT_ = 512;
constexpr int NINP = 4096;
constexpr float QSCALE = 0.125f * 1.44269504089f;

constexpr size_t MB = 1024 * 1024;
constexpr size_t OFF_WINT = 0;
constexpr size_t OFF_W1KT = OFF_WINT + (size_t)NINP * 1024 * 2;
constexpr size_t OFF_W1VT = OFF_W1KT + 256 * 2048 * 2;
constexpr size_t OFF_W2KT = OFF_W1VT + 256 * 2048 * 2;
constexpr size_t OFF_W2VT = OFF_W2KT + 256 * 256 * 2;
constexpr size_t OFF_WAT = OFF_W2VT + 256 * 256 * 2;
constexpr size_t OFF_WVT = OFF_WAT + 1024 * 512 * 2;
constexpr size_t OFF_WGT = OFF_WVT + 1024 * 512 * 2;
constexpr size_t OFF_WOT = OFF_WGT + 1024 * 512 * 2;
constexpr size_t OFF_WUPT = OFF_WOT + 1024 * 1024 * 2;
constexpr size_t OFF_WDT = OFF_WUPT + 4096 * 1024 * 2;
constexpr size_t OFF_ROPE = OFF_WDT + 4096 * 1024 * 2;
constexpr size_t OFF_CBP = OFF_ROPE + 8192 * 16 * 4;
constexpr size_t OFF_CTR = OFF_CBP + 2 * 32 * 256 * 4;
constexpr size_t OFF_KMAX = OFF_CTR + 64;
constexpr size_t OFF_BAR = OFF_CTR + 256;
constexpr size_t OFF_SS1 = OFF_BAR + 16384;
constexpr size_t OFF_SS2 = OFF_SS1 + (size_t)T_ * 16 * 4;
constexpr size_t OFF_NG = OFF_SS2 + (size_t)T_ * 16 * 4;
constexpr size_t OFF_HC = OFF_NG + (size_t)T_ * 24 * 4;
constexpr size_t OFF_KCC = OFF_HC + 2 * 4096 * 256 * 2;
constexpr size_t OFF_VCT = OFF_KCC + 8 * 512 * 64 * 2;
constexpr size_t OFF_HLOC = OFF_VCT + 8 * 512 * 64 * 2;
constexpr size_t OFF_ARENA = OFF_HLOC + (size_t)4 * 128 * 32 * 64 * 8;
constexpr size_t OFF_MG = OFF_ARENA;
constexpr size_t OFF_HN = OFF_ARENA + 128 * MB;
constexpr size_t OFF_QRAW = OFF_ARENA + 192 * MB;
constexpr size_t OFF_QROT = OFF_ARENA + 224 * MB;
constexpr size_t OFF_KCIN = OFF_ARENA + 256 * MB;
constexpr size_t OFF_VCIN = OFF_KCIN + 8 * MB;
constexpr size_t OFF_KS = OFF_VCIN + 8 * MB;
constexpr size_t OFF_VST = OFF_KS + 8 * MB;
constexpr size_t OFF_KW = OFF_VST + 8 * MB;
constexpr size_t OFF_VWT = OFF_KW + 8 * MB;
constexpr size_t OFF_U = OFF_ARENA + 304 * MB;
constexpr size_t OFF_NSA = OFF_ARENA + 336 * MB;
constexpr size_t OFF_YS = OFF_ARENA + 368 * MB;
constexpr size_t OFF_CPART = OFF_ARENA + 400 * MB;
constexpr size_t OFF_S5T = OFF_CPART + 32 * MB;
constexpr size_t OFF_S5L = OFF_S5T + 32 * 8192;
constexpr size_t WS_NEED = OFF_S5L + 32 * 64 * 8;
constexpr size_t OFF_ACT = OFF_ARENA;
constexpr size_t OFF_X1B = OFF_ARENA + 256 * MB;
constexpr size_t OFF_MERGED = OFF_HN;

constexpr int SMEM_BYTES = 131072 + 1024;

struct Params {
  const float *x, *g1, *w_in, *pe, *kw1, *kw2, *vw1, *vw2, *lam_re, *lam_im, *log_step, *b_re, *b_im, *c_re, *c_im, *dsk,
      *w_attn, *w_val, *w_gate, *w_out, *g2, *w_up, *w_down, *g3;
  float* out;
  unsigned char* ws;
  int lo, hi;
};

typedef const __attribute__((address_space(4))) Params* PP;

DI int my_tid(int wv0) {
  int t = wv0 * 64 + (int)__lane_id();
  asm volatile("" : "+v"(t));
  return t;
}
DI unsigned pk2(float a, float b);
DI u16 f2bf(float x) { return (u16)(pk2(x, 0.f) & 0xffffu); }
DI float bf2f(u16 h) { return __uint_as_float(((unsigned)h) << 16); }
typedef float f32x2_t __attribute__((ext_vector_type(2)));
typedef __bf16 bf16x2_t __attribute__((ext_vector_type(2)));
DI unsigned pk2(float a, float b) {
  const f32x2_t v = {a, b};
  return __builtin_bit_cast(unsigned, __builtin_convertvector(v, bf16x2_t));
}
DI uint2 pk4(float a, float b, float c, float d) { uint2 o; o.x = pk2(a, b); o.y = pk2(c, d); return o; }
DI float sigmoidf_(float x) { return 1.f / (1.f + __expf(-x)); }
DI float gelu_t(float x) {
  float u = 0.7978845608f * (x + 0.044715f * x * x * x);
  float e = __expf(2.f * u);
  float th = 1.f - 2.f / (e + 1.f);
  return 0.5f * x * (1.f + th);
}
DI float wave_sum(float v) {
#pragma unroll
  for (int o = 32; o > 0; o >>= 1) v += __shfl_xor(v, o);
  return v;
}
DI f32x4 mfma16(bf16x8 a, bf16x8 b, f32x4 c) { return __builtin_amdgcn_mfma_f32_16x16x32_bf16(a, b, c, 0, 0, 0); }

constexpr int G_HT = 128 * 64;
DI int lds_byte(int r, int c) {
  const int st = (r >> 4) * 2 + (c >> 5), rr = r & 15, cc = c & 31, ob = rr * 64 + cc * 2;
  return st * 1024 + (ob ^ (((ob >> 9) & 1) << 5));
}
DI void stage_rc(int b, int& R, int& C) {
  const int st = b / 1024, sb = b % 1024, swz = sb ^ (((sb >> 9) & 1) << 5);
  R = (st >> 1) * 16 + swz / 64;
  C = (st & 1) * 32 + (swz % 64) / 2;
}
typedef __attribute__((address_space(3))) unsigned* lds_u32p;
DI void gemm256(int wv0, f32x4 (&acc)[2][2][4][2], const u16* __restrict__ A, int lda, const u16* __restrict__ Bt, int ldb,
                int K, unsigned char* smem) {
  u16* shm = (u16*)smem;
  const int tid = my_tid(wv0), lane = tid & 63;
  const int wr = wv0 >> 2, wc = wv0 & 3, fr = lane & 15, fq = lane >> 4;
#define SA(b, h) (shm + ((b)*2 + (h)) * G_HT)
#define SB(b, h) (shm + (4 + (b)*2 + (h)) * G_HT)
  int sr0, sc0, sr1, sc1;
  stage_rc(tid * 16, sr0, sc0);
  stage_rc(tid * 16 + 8192, sr1, sc1);
  const u16* a0 = A + (size_t)sr0 * lda + sc0;
  const u16* a1 = A + (size_t)sr1 * lda + sc1;
  const u16* b0 = Bt + (size_t)sr0 * ldb + sc0;
  const u16* b1 = Bt + (size_t)sr1 * ldb + sc1;
#define STAGE_A(P, half, kt)                                                                                              \
  {                                                                                                                       \
    __builtin_amdgcn_global_load_lds((const unsigned*)(a0 + (size_t)((half)*128) * lda + (kt)*64),                        \
                                     (unsigned*)((char*)(P) + tid * 16), 16, 0, 0);                               \
    __builtin_amdgcn_global_load_lds((const unsigned*)(a1 + (size_t)((half)*128) * lda + (kt)*64),                        \
                                     (unsigned*)((char*)(P) + tid * 16 + 8192), 16, 0, 0);                        \
  }
#define STAGE_B(P, half, kt)                                                                                              \
  {                                                                                                                       \
    __builtin_amdgcn_global_load_lds((const unsigned*)(b0 + (size_t)((half)*128) * ldb + (kt)*64),                        \
                                     (unsigned*)((char*)(P) + tid * 16), 16, 0, 0);                               \
    __builtin_amdgcn_global_load_lds((const unsigned*)(b1 + (size_t)((half)*128) * ldb + (kt)*64),                        \
                                     (unsigned*)((char*)(P) + tid * 16 + 8192), 16, 0, 0);                        \
  }
#define LDA(dst, b, h)                                                                                                    \
  _Pragma("unroll") for (int m = 0; m < 4; ++m) _Pragma("unroll") for (int k = 0; k < 2; ++k)                             \
      dst[m][k] = *(const bf16x8*)((const unsigned char*)SA(b, h) + lds_byte(wr * 64 + m * 16 + fr, k * 32 + fq * 8));
#define LDB(dst, b, h)                                                                                                    \
  _Pragma("unroll") for (int n = 0; n < 2; ++n) _Pragma("unroll") for (int k = 0; k < 2; ++k)                             \
      dst[n][k] = *(const bf16x8*)((const unsigned char*)SB(b, h) + lds_byte(wc * 32 + n * 16 + fr, k * 32 + fq * 8));
#define MMA(ai, bj, At_, Bt_)                                                                                             \
  {                                                                                                                       \
    __builtin_amdgcn_s_setprio(1);                                                                                        \
    _Pragma("unroll") for (int m = 0; m < 4; ++m) _Pragma("unroll") for (int n = 0; n < 2; ++n)                           \
        _Pragma("unroll") for (int k = 0; k < 2; ++k) acc[ai][bj][m][n] =                                                 \
            __builtin_amdgcn_mfma_f32_16x16x32_bf16(Bt_[n][k], At_[m][k], acc[ai][bj][m][n], 0, 0, 0);                    \
    __builtin_amdgcn_s_setprio(0);                                                                                        \
  }
#define WAIT_V(n) asm volatile("s_waitcnt vmcnt(" #n ")" ::: "memory")
#define WAIT_L(n) asm volatile("s_waitcnt lgkmcnt(" #n ")" ::: "memory")
#define BAR __builtin_amdgcn_s_barrier()
#define SCHED __builtin_amdgcn_sched_barrier(0)
#pragma unroll
  for (int a = 0; a < 2; ++a)
#pragma unroll
    for (int b = 0; b < 2; ++b)
#pragma unroll
      for (int m = 0; m < 4; ++m)
#pragma unroll
        for (int n = 0; n < 2; ++n) acc[a][b][m][n] = f32x4{0.f, 0.f, 0.f, 0.f};
  bf16x8 At[4][2], B0[2][2], B1[2][2];
  const int nt = K / 64;
  WAIT_V(0);
  __syncthreads();
  STAGE_B(SB(0, 0), 0, 0) STAGE_A(SA(0, 0), 0, 0)
  STAGE_B(SB(0, 1), 1, 0) STAGE_A(SA(0, 1), 1, 0)
  if (wr == 1) BAR;
  WAIT_V(4); BAR;
  STAGE_B(SB(1, 0), 0, 1) STAGE_A(SA(1, 0), 0, 1) STAGE_B(SB(1, 1), 1, 1)
  WAIT_V(6); BAR;
#pragma unroll 1
  for (int t = 0; t < nt - 2; t += 2) {
    LDB(B0, 0, 0) SCHED; LDA(At, 0, 0) STAGE_A(SA(1, 1), 1, t + 1)
    WAIT_L(8); BAR; WAIT_L(0); MMA(0, 0, At, B0) BAR; SCHED;
    LDB(B1, 0, 1) STAGE_B(SB(0, 0), 0, t + 2)
    BAR; WAIT_L(0); MMA(0, 1, At, B1) BAR;
    LDA(At, 0, 1) STAGE_A(SA(0, 0), 0, t + 2)
    BAR; WAIT_L(0); MMA(1, 0, At, B0) BAR; SCHED;
    STAGE_B(SB(0, 1), 1, t + 2)
    WAIT_V(6); BAR; MMA(1, 1, At, B1) BAR;
    LDB(B0, 1, 0) SCHED; LDA(At, 1, 0) STAGE_A(SA(0, 1), 1, t + 2)
    WAIT_L(8); BAR; WAIT_L(0); MMA(0, 0, At, B0) BAR; SCHED;
    LDB(B1, 1, 1) STAGE_B(SB(1, 0), 0, t + 3)
    BAR; WAIT_L(0); MMA(0, 1, At, B1) BAR;
    LDA(At, 1, 1) STAGE_A(SA(1, 0), 0, t + 3)
    BAR; WAIT_L(0); MMA(1, 0, At, B0) BAR; SCHED;
    STAGE_B(SB(1, 1), 1, t + 3)
    WAIT_V(6); BAR; MMA(1, 1, At, B1) BAR;
  }
  {
    LDB(B0, 0, 0) LDA(At, 0, 0) STAGE_A(SA(1, 1), 1, nt - 1)
    BAR; WAIT_L(0); MMA(0, 0, At, B0) BAR;
    LDB(B1, 0, 1) BAR; WAIT_L(0); MMA(0, 1, At, B1) BAR;
    LDA(At, 0, 1) WAIT_V(4); BAR; WAIT_L(0); MMA(1, 0, At, B0) MMA(1, 1, At, B1) BAR;
  }
  {
    LDB(B0, 1, 0) LDA(At, 1, 0) WAIT_V(2); BAR; WAIT_L(0); MMA(0, 0, At, B0) BAR;
    LDB(B1, 1, 1) WAIT_V(0); BAR; WAIT_L(0); MMA(0, 1, At, B1) BAR;
    LDA(At, 1, 1) BAR; WAIT_L(0); MMA(1, 0, At, B0) MMA(1, 1, At, B1) BAR;
  }
  if (wr == 0) BAR;
}
DI void tile_map_n16(int id, int& pm, int& pn) {
  const int k = id & 255, rnd = id >> 8, x = k & 7, slot = k >> 3;
  pm = rnd * 16 + 4 * (x >> 1) + (slot >> 3);
  pn = 8 * (x & 1) + (slot & 7);
}
DI void tile_map_n4(int id, int& pm, int& pn) {
  const int k = id & 255, rnd = id >> 8, x = k & 7, slot = k >> 3;
  pm = rnd * 64 + 8 * x + (slot >> 2);
  pn = slot & 3;
}
template <class F>
DI void epi256(int wv0, f32x4 (&acc)[2][2][4][2], int brow, int bcol, F f) {
  const int lane = my_tid(wv0) & 63, wr = wv0 >> 2, wc = wv0 & 3;
#pragma unroll
  for (int ai = 0; ai < 2; ++ai)
#pragma unroll
    for (int bj = 0; bj < 2; ++bj)
#pragma unroll
      for (int m = 0; m < 4; ++m)
#pragma unroll
        for (int n = 0; n < 2; ++n) {
          const int row = brow + ai * 128 + wr * 64 + m * 16 + (lane & 15);
          const int col0 = bcol + bj * 128 + wc * 32 + n * 16 + (lane >> 4) * 4;
          f(ai, bj, m, n, row, col0, acc[ai][bj][m][n]);
          if (n == 1 && (m & 1)) __builtin_amdgcn_sched_barrier(0);
        }
}

constexpr int NXT_A = 1024 + 128 + 128 + 16 + 16;
constexpr int NXT = NXT_A + 128 * 3 + 256 + 1024 + 1024;
DI void xpose_tile(int wv0, PP p, int jt, unsigned char* smem) {
  const int tid = my_tid(wv0);
  float* tile = (float*)smem;
  int t = jt;
  const float* src;
  u16* dst;
  int K, Nsrc, mode = 0;
  const float* scl = nullptr;
  if (t < 1024) { src = p->w_in; dst = (u16*)(p->ws + OFF_WINT); K = 1024; Nsrc = 3864; mode = 1; }
  else if ((t -= 1024) < 128) { src = p->kw1; dst = (u16*)(p->ws + OFF_W1KT); K = 2048; Nsrc = 256; }
  else if ((t -= 128) < 128) { src = p->vw1; dst = (u16*)(p->ws + OFF_W1VT); K = 2048; Nsrc = 256; }
  else if ((t -= 128) < 16) { src = p->kw2; dst = (u16*)(p->ws + OFF_W2KT); K = 256; Nsrc = 64; mode = 2; }
  else if ((t -= 16) < 16) { src = p->vw2; dst = (u16*)(p->ws + OFF_W2VT); K = 256; Nsrc = 64; mode = 2; }
  else if ((t -= 16) < 128) { src = p->w_attn; dst = (u16*)(p->ws + OFF_WAT); K = 512; Nsrc = 1024; }
  else if ((t -= 128) < 128) { src = p->w_val; dst = (u16*)(p->ws + OFF_WVT); K = 512; Nsrc = 1024; }
  else if ((t -= 128) < 128) { src = p->w_gate; dst = (u16*)(p->ws + OFF_WGT); K = 512; Nsrc = 1024; }
  else if ((t -= 128) < 256) { src = p->w_out; dst = (u16*)(p->ws + OFF_WOT); K = 1024; Nsrc = 1024; }
  else if ((t -= 256) < 1024) { src = p->w_up; dst = (u16*)(p->ws + OFF_WUPT); K = 1024; Nsrc = 4096; scl = p->g2; }
  else { t -= 1024; src = p->w_down; dst = (u16*)(p->ws + OFF_WDT); K = 4096; Nsrc = 1024; }
  const int nkt = K >> 6, tn = t / nkt, tk = t % nkt, n0 = tn * 64, k0 = tk * 64;
  const int tx = tid & 63, ty = tid >> 6;
  const int np = n0 + tx;
  int sc = np;
  if (mode == 1) {
    if (np < 1280) sc = np;
    else if (np < 1792) sc = 1304 + (np - 1280);
    else if (np < 3840) sc = 1816 + (np - 1792);
    else if (np < 3864) sc = 1280 + (np - 3840);
    else sc = -1;
  } else if (mode == 2) {
    sc = np < 64 ? np : -1;
  }
  for (int kk = ty; kk < 64; kk += 8) {
    float val = 0.f;
    if (sc >= 0) val = src[(size_t)(k0 + kk) * Nsrc + sc];
    if (scl) val *= scl[k0 + kk];
    tile[kk * 65 + tx] = val;
  }
  __syncthreads();
  {
    const int n = tid >> 3, kc = tid & 7;
    uint4 o;
    o.x = pk2(tile[(kc * 8 + 0) * 65 + n], tile[(kc * 8 + 1) * 65 + n]);
    o.y = pk2(tile[(kc * 8 + 2) * 65 + n], tile[(kc * 8 + 3) * 65 + n]);
    o.z = pk2(tile[(kc * 8 + 4) * 65 + n], tile[(kc * 8 + 5) * 65 + n]);
    o.w = pk2(tile[(kc * 8 + 6) * 65 + n], tile[(kc * 8 + 7) * 65 + n]);
    *(uint4*)(dst + (size_t)(n0 + n) * K + k0 + kc * 8) = o;
  }
  __syncthreads();
}

DI void phaseA(int wv0, PP p, unsigned char* smem) {
  const int tid = my_tid(wv0), lane = tid & 63;
  u16* HN = (u16*)(p->ws + OFF_HN);
  for (int row = blockIdx.x * 8 + wv0; row < T_; row += gridDim.x * 8) {
    const float4* xr = (const float4*)(p->x + (size_t)row * 1024);
    float4 v[4];
    float ss = 0.f;
#pragma unroll
    for (int r = 0; r < 4; ++r) {
      v[r] = xr[lane + 64 * r];
      ss += v[r].x * v[r].x + v[r].y * v[r].y + v[r].z * v[r].z + v[r].w * v[r].w;
    }
    ss = wave_sum(ss);
    const float rinv = rsqrtf(ss * (1.f / 1024.f) + 1e-6f);
#pragma unroll
    for (int r = 0; r < 4; ++r) {
      const float4 g = ((const float4*)p->g1)[lane + 64 * r];
      uint2 o;
      o.x = pk2(v[r].x * rinv * g.x, v[r].y * rinv * g.y);
      o.y = pk2(v[r].z * rinv * g.z, v[r].w * rinv * g.w);
      *(uint2*)(HN + (size_t)row * 1024 + (lane + 64 * r) * 4) = o;
    }
  }
  for (int jt = blockIdx.x; jt < NXT_A + 32 + 32; jt += gridDim.x) {
    if (jt < NXT_A) {
      xpose_tile(wv0, p, jt, smem);
    } else if (jt >= NXT_A + 32) {
      const int g = jt - (NXT_A + 32);
      u16* TB = (u16*)(p->ws + OFF_S5T + (size_t)g * 8192);
      const float step = expf(p->log_step[g]);
      for (int e = tid; e < 2048; e += NT_) {
        const int np = e >> 4, c = e & 15, n = np & 63;
        const float lr = p->lam_re[g * 64 + n], li = p->lam_im[g * 64 + n];
        const float er = expf(lr * step);
        float sn, cs;
        sincosf(li * step, &sn, &cs);
        const float nr = er * cs - 1.f, ni = er * sn, den = lr * lr + li * li;
        const float cr = (nr * lr + ni * li) / den, ci = (ni * lr - nr * li) / den;
        const float bre = p->b_re[(g * 64 + n) * 16 + c], bim = p->b_im[(g * 64 + n) * 16 + c];
        TB[np * 16 + c] = f2bf(np < 64 ? (cr * bre - ci * bim) : (cr * bim + ci * bre));
        const int cc = e >> 7, k = e & 127;
        TB[2048 + cc * 128 + k] = f2bf(k < 64 ? p->c_re[(g * 16 + cc) * 64 + k] : -p->c_im[(g * 16 + cc) * 64 + (k - 64)]);
      }
      if (tid < 64) {
        const float lr = p->lam_re[g * 64 + tid], li = p->lam_im[g * 64 + tid];
        const float er = expf(lr * step);
        float sn, cs;
        sincosf(li * step, &sn, &cs);
        ((float2*)(p->ws + OFF_S5L))[g * 64 + tid] = make_float2(er * cs, er * sn);
      }
    } else {
      const int item = jt - NXT_A, kv = item >> 4, slice = item & 15;
      const float* w1 = kv ? p->vw1 : p->kw1;
      const int col = tid & 255, h = tid >> 8, kb = slice * 128 + h * 64;
      float s0 = 0.f, s1 = 0.f, s2 = 0.f, s3 = 0.f;
      for (int k = kb; k < kb + 64; k += 4) {
        s0 += p->pe[k] * w1[(size_t)k * 256 + col];
        s1 += p->pe[k + 1] * w1[(size_t)(k + 1) * 256 + col];
        s2 += p->pe[k + 2] * w1[(size_t)(k + 2) * 256 + col];
        s3 += p->pe[k + 3] * w1[(size_t)(k + 3) * 256 + col];
      }
      ((float*)(p->ws + OFF_CBP))[(kv * 32 + slice * 2 + h) * 256 + col] = (s0 + s1) + (s2 + s3);
    }
  }
  float* rope = (float*)(p->ws + OFF_ROPE);
  for (int i = blockIdx.x * NT_ + tid; i < S_ * 8; i += gridDim.x * NT_) {
    const int pos = i >> 3, k = i & 7;
    const float inv = powf(500000.0f, -(2.0f * (float)k) / 16.0f);
    const float ang = (float)pos * inv;
    rope[pos * 16 + k] = cosf(ang);
    rope[pos * 16 + 8 + k] = sinf(ang);
  }
  if (blockIdx.x == 0 && tid < 64) ((int*)(p->ws + OFF_CTR))[tid] = 0;
}

DI void phaseB(int wv0, PP p, unsigned char* smem) {
  const u16* HN = (const u16*)(p->ws + OFF_HN);
  const u16* WT = (const u16*)(p->ws + OFF_WINT);
  const float* rope = (const float*)(p->ws + OFF_ROPE);
  const int lane = my_tid(wv0) & 63;
  const bool ropewave = (wv0 & 1) == 0;
  for (int id = blockIdx.x; id < 128 * 16; id += gridDim.x) {
    int pm, pn;
    tile_map_n16(id, pm, pn);
    const int brow = pm * 256, bcol = pn * 256;
    f32x4 acc[2][2][4][2];
    gemm256(wv0, acc, HN + (size_t)brow * 1024, 1024, WT + (size_t)bcol * 1024, 1024, 1024, smem);
    if (pn < 2) {
      u16* QR = (u16*)(p->ws + OFF_QRAW);
      u16* QO = (u16*)(p->ws + OFF_QROT);
      epi256(wv0, acc, brow, bcol, [&](int ai, int bj, int m, int n, int row, int col0, f32x4& v) {
        f32x4 r = v;
        if (n == 0 && ropewave) {
          const int pos = row & (S_ - 1), kq = ((lane >> 4) & 1) * 4;
          const float4 c4 = *(const float4*)(rope + pos * 16 + kq), s4 = *(const float4*)(rope + pos * 16 + 8 + kq);
          const float cc[4] = {c4.x, c4.y, c4.z, c4.w}, ss[4] = {s4.x, s4.y, s4.z, s4.w};
#pragma unroll
          for (int j = 0; j < 4; ++j) {
            const float pr = __shfl_xor(v[j], 32);
            r[j] = (lane & 32) ? (v[j] * cc[j] + pr * ss[j]) : (v[j] * cc[j] - pr * ss[j]);
          }
        }
        *(uint2*)(QR + (size_t)row * 512 + col0) = pk4(v[0] * QSCALE, v[1] * QSCALE, v[2] * QSCALE, v[3] * QSCALE);
        *(uint2*)(QO + (size_t)row * 512 + col0) = pk4(r[0] * QSCALE, r[1] * QSCALE, r[2] * QSCALE, r[3] * QSCALE);
      });
    } else if (pn < 5) {
      epi256(wv0, acc, brow, bcol, [&](int ai, int bj, int m, int n, int row, int col0, f32x4& v) {
        const int sub = (pn - 2) * 2 + bj;
        const bool dorope = (sub == 2 || sub == 4), transposed = (sub == 3 || sub == 5);
        u16* dst = (u16*)(p->ws + OFF_KCIN + (size_t)sub * 8 * MB);
        const int c128 = col0 & 127, g = c128 >> 6, d0 = c128 & 63;
        const int b = row >> 13, sq = row & (S_ - 1);
        f32x4 r = v;
        if (dorope && n == 0 && ropewave) {
          const int kq = ((lane >> 4) & 1) * 4;
          const float4 c4 = *(const float4*)(rope + sq * 16 + kq), s4 = *(const float4*)(rope + sq * 16 + 8 + kq);
          const float cc[4] = {c4.x, c4.y, c4.z, c4.w}, ss[4] = {s4.x, s4.y, s4.z, s4.w};
#pragma unroll
          for (int j = 0; j < 4; ++j) {
            const float pr = __shfl_xor(v[j], 32);
            r[j] = (lane & 32) ? (v[j] * cc[j] + pr * ss[j]) : (v[j] * cc[j] - pr * ss[j]);
          }
        }
        if (transposed) {
#pragma unroll
          for (int j = 0; j < 4; ++j) dst[((size_t)((b * 2 + g) * 64 + d0 + j)) * S_ + sq] = f2bf(r[j]);
        } else {
          *(uint2*)(dst + ((size_t)(b * 2 + g) * S_ + sq) * 64 + d0) = pk4(r[0], r[1], r[2], r[3]);
        }
      });
    } else if (pn < 7) {
      u16* U = (u16*)(p->ws + OFF_U);
      epi256(wv0, acc, brow, bcol, [&](int ai, int bj, int m, int n, int row, int col0, f32x4& v) {
        *(uint2*)(U + (size_t)row * 512 + (col0 - 1280)) = pk4(v[0], v[1], v[2], v[3]);
      });
    } else if (pn < 15) {
      u16* MG = (u16*)(p->ws + OFF_MG);
      epi256(wv0, acc, brow, bcol, [&](int ai, int bj, int m, int n, int row, int col0, f32x4& v) {
        *(uint2*)(MG + (size_t)row * 2048 + (col0 - 1792)) = pk4(sigmoidf_(v[0]), sigmoidf_(v[1]), sigmoidf_(v[2]), sigmoidf_(v[3]));
      });
    } else {
      float* NG = (float*)(p->ws + OFF_NG);
      epi256(wv0, acc, brow, bcol, [&](int ai, int bj, int m, int n, int row, int col0, f32x4& v) {
        const int cc = col0 - 3840;
        if (cc < 24) *(float4*)(NG + (size_t)row * 24 + cc) = make_float4(sigmoidf_(v[0]), sigmoidf_(v[1]), sigmoidf_(v[2]), sigmoidf_(v[3]));
      });
    }
  }
}

template <bool OUT>
DI void s5_item(int wv0, PP p, int item, unsigned char* smem) {
  const int tid = my_tid(wv0), lane = tid & 63, fr = lane & 15, fq = lane >> 4;
  const int b = item >> 9, g = (item >> 4) & 31, c8 = item & 15, ch = c8 * 8 + wv0;
  u16* sBb = (u16*)smem;
  u16* sCm = sBb + 128 * 16;
  float* sBU = (float*)(smem + 8192) + wv0 * (16 * 132);
  u16* sH = (u16*)(smem + 8192 + 8 * 16 * 132 * 4) + wv0 * (16 * 136);
  *(uint4*)(smem + tid * 16) = *(const uint4*)(p->ws + OFF_S5T + (size_t)g * 8192 + tid * 16);
  const float2 lb = ((const float2*)(p->ws + OFF_S5L))[g * 64 + lane];
  const float lbr = lb.x, lbi = lb.y;
  float2* HL = (float2*)(p->ws + OFF_HLOC) + ((size_t)(b * 128 + ch) * 32 + g) * 64 + lane;
  float hr = 0.f, hi = 0.f;
  if (OUT) { const float2 h0 = *HL; hr = h0.x; hi = h0.y; }
  const u16* U = (const u16*)(p->ws + OFF_U) + ((size_t)(b * S_ + ch * 64)) * 512 + g * 16;
  u16* YS = (u16*)(p->ws + OFF_YS) + ((size_t)(b * S_ + ch * 64)) * 512 + g * 16;
  const float dk = p->dsk[g * 16 + fr];
  const bf16x8 zero8 = {0, 0, 0, 0, 0, 0, 0, 0};
  bf16x8 uall[4];
  u16 usk[4][4];
#pragma unroll
  for (int sub = 0; sub < 4; ++sub) {
    uall[sub] = fq < 2 ? *(const bf16x8*)(U + (size_t)(sub * 16 + fr) * 512 + 8 * fq) : zero8;
    if (OUT) {
#pragma unroll
      for (int j = 0; j < 4; ++j) usk[sub][j] = U[(size_t)(sub * 16 + 4 * fq + j) * 512 + fr];
    }
  }
  __syncthreads();
  bf16x8 bb[8], cf[4];
#pragma unroll
  for (int nt = 0; nt < 8; ++nt) bb[nt] = fq < 2 ? *(const bf16x8*)(sBb + (16 * nt + fr) * 16 + 8 * fq) : zero8;
  if (OUT) {
#pragma unroll
    for (int ks = 0; ks < 4; ++ks) cf[ks] = *(const bf16x8*)(sCm + fr * 128 + 32 * ks + 8 * fq);
  }
#pragma unroll
  for (int sub = 0; sub < 4; ++sub) {
    const bf16x8 ua = uall[sub];
#pragma unroll
    for (int nt = 0; nt < 8; ++nt) {
      const f32x4 a = mfma16(ua, bb[nt], f32x4{0.f, 0.f, 0.f, 0.f});
#pragma unroll
      for (int j = 0; j < 4; ++j) sBU[(4 * fq + j) * 132 + 16 * nt + fr] = a[j];
    }
    __syncthreads();
#pragma unroll 4
    for (int t = 0; t < 16; ++t) {
      const float bur = sBU[t * 132 + lane], bui = sBU[t * 132 + 64 + lane];
      const float nr = lbr * hr - lbi * hi + bur;
      const float nim = lbr * hi + lbi * hr + bui;
      hr = nr;
      hi = nim;
      if (OUT) {
        sH[t * 136 + lane] = f2bf(hr);
        sH[t * 136 + 64 + lane] = f2bf(hi);
      }
    }
    __syncthreads();
    if (OUT) {
      f32x4 y = {0.f, 0.f, 0.f, 0.f};
#pragma unroll
      for (int ks = 0; ks < 4; ++ks) y = mfma16(*(const bf16x8*)(sH + fr * 136 + 32 * ks + 8 * fq), cf[ks], y);
#pragma unroll
      for (int j = 0; j < 4; ++j) {
        const size_t o = (size_t)(sub * 16 + 4 * fq + j) * 512 + fr;
        YS[o] = f2bf(gelu_t(y[j] + dk * bf2f(usk[sub][j])));
      }
      __syncthreads();
    }
  }
  if (!OUT) *HL = make_float2(hr, hi);
  __syncthreads();
}
DI void s5_carry(int wv0, PP p) {
  const int x = blockIdx.x * NT_ + my_tid(wv0);
  if (x >= 8192) return;
  const int b = x >> 11, g = (x >> 6) & 31, n = x & 63;
  const float step = expf(p->log_step[g]);
  const float lr = p->lam_re[g * 64 + n], li = p->lam_im[g * 64 + n];
  const float er = expf(64.f * lr * step);
  float sn, cs;
  sincosf(64.f * li * step, &sn, &cs);
  const float Lr = er * cs, Li = er * sn;
  float2* HL = (float2*)(p->ws + OFF_HLOC) + (size_t)b * 128 * 2048 + g * 64 + n;
  float hr = 0.f, hi = 0.f;
  for (int c0 = 0; c0 < 128; c0 += 16) {
    float2 v[16];
#pragma unroll
    for (int k = 0; k < 16; ++k) v[k] = HL[(size_t)(c0 + k) * 2048];
#pragma unroll
    for (int k = 0; k < 16; ++k) {
      HL[(size_t)(c0 + k) * 2048] = make_float2(hr, hi);
      const float nr = Lr * hr - Li * hi + v[k].x;
      const float nim = Lr * hi + Li * hr + v[k].y;
      hr = nr;
      hi = nim;
    }
  }
}
DI void phaseC(int wv0, PP p, unsigned char* smem) {
  for (int id = blockIdx.x; id < 128 + 2048 + 256; id += gridDim.x) {
    if (id >= 128 + 2048) {
      const int it = id - (128 + 2048), tns = it >> 7, bg = (it >> 4) & 7, part = it & 15;
      const int tid = my_tid(wv0);
      const u16* K = (const u16*)(p->ws + (tns ? OFF_KW : OFF_KS)) + ((size_t)bg * S_ + part * 512 + tid) * 64;
      float q2 = 0.f;
#pragma unroll
      for (int c = 0; c < 8; ++c) {
        const uint4 w = *(const uint4*)(K + c * 8);
        const unsigned ww[4] = {w.x, w.y, w.z, w.w};
#pragma unroll
        for (int e = 0; e < 4; ++e) {
          const float a = __uint_as_float(ww[e] << 16), b2 = __uint_as_float(ww[e] & 0xffff0000u);
          q2 += a * a + b2 * b2;
        }
      }
#pragma unroll
      for (int o = 32; o > 0; o >>= 1) q2 = fmaxf(q2, __shfl_xor(q2, o));
      if ((tid & 63) == 0) atomicMax((unsigned*)(p->ws + OFF_KMAX) + tns * 8 + bg, __float_as_uint(q2));
    } else if (id < 128) {
      const int kv = id >> 6, pm = (id >> 2) & 15, ks = id & 3, brow = pm * 256;
      const u16* A = (const u16*)(p->ws + (kv ? OFF_VCIN : OFF_KCIN)) + (size_t)brow * 1024 + ks * 512;
      const u16* Bt = (const u16*)(p->ws + (kv ? OFF_W1VT : OFF_W1KT)) + ks * 512;
      f32x4 acc[2][2][4][2];
      gemm256(wv0, acc, A, 1024, Bt, 2048, 512, smem);
      float* PART = (float*)(p->ws + OFF_CPART) + (size_t)(ks * 2 + kv) * 4096 * 256;
      epi256(wv0, acc, brow, 0, [&](int ai, int bj, int m, int n, int row, int col0, f32x4& v) {
        *(float4*)(PART + (size_t)row * 256 + col0) = make_float4(v[0], v[1], v[2], v[3]);
      });
    } else {
      s5_item<false>(wv0, p, id - 128, smem);
    }
  }
}
DI void phaseD1(int wv0, PP p, unsigned char* smem) {
  const int tid = my_tid(wv0);
  float* sB = (float*)smem;
  {
    const float* cbp = (const float*)(p->ws + OFF_CBP);
    float bb = 0.f;
    for (int sl = 0; sl < 32; ++sl) bb += cbp[((tid >> 8) * 32 + sl) * 256 + (tid & 255)];
    sB[tid] = bb;
  }
  __syncthreads();
  const float* PART = (const float*)(p->ws + OFF_CPART);
  u16* HC = (u16*)(p->ws + OFF_HC);
  for (int e = blockIdx.x * NT_ + tid; e < 2 * 4096 * 64; e += gridDim.x * NT_) {
    const int kv = e >> 18, rc = e & 262143, c4 = (rc & 63) * 4;
    const size_t o = (size_t)kv * 4096 * 256 + (size_t)rc * 4;
    float4 a = *(const float4*)(PART + o);
#pragma unroll
    for (int ks = 1; ks < 4; ++ks) {
      const float4 t = *(const float4*)(PART + (size_t)ks * 2 * 4096 * 256 + o);
      a.x += t.x; a.y += t.y; a.z += t.z; a.w += t.w;
    }
    const float* bv = sB + kv * 256 + c4;
    *(uint2*)(HC + o) = pk4(gelu_t(a.x + bv[0]), gelu_t(a.y + bv[1]), gelu_t(a.z + bv[2]), gelu_t(a.w + bv[3]));
  }
}
DI void phaseD(int wv0, PP p, unsigned char* smem) {
  for (int id = blockIdx.x; id < 32; id += gridDim.x) {
    const int kv = id >> 4, pm = id & 15, brow = pm * 256;
    const u16* A = (const u16*)(p->ws + OFF_HC) + (size_t)kv * 4096 * 256 + (size_t)brow * 256;
    const u16* Bt = (const u16*)(p->ws + (kv ? OFF_W2VT : OFF_W2KT));
    f32x4 acc[2][2][4][2];
    gemm256(wv0, acc, A, 256, Bt, 256, 256, smem);
    u16* KCC = (u16*)(p->ws + OFF_KCC);
    u16* VCT = (u16*)(p->ws + OFF_VCT);
    epi256(wv0, acc, brow, 0, [&](int ai, int bj, int m, int n, int row, int col0, f32x4& v) {
      if (col0 < 64) {
        const int bg = row >> 9, nn = row & 511;
        f32x4 r = v;
        if (nn == 511) r = f32x4{0.f, 0.f, 0.f, 0.f};
        if (kv == 0) {
          *(uint2*)(KCC + ((size_t)bg * 512 + nn) * 64 + col0) = pk4(r[0], r[1], r[2], r[3]);
        } else {
#pragma unroll
          for (int j = 0; j < 4; ++j) VCT[((size_t)bg * 64 + col0 + j) * 512 + nn] = f2bf(r[j]);
        }
      }
    });
  }
  s5_carry(wv0, p);
}

DI bool bit128(u64 lo, u64 hi, int j) { return j < 64 ? ((lo >> j) & 1ull) : ((hi >> (j - 64)) & 1ull); }
DI int next_bit(u64 lo, u64 hi, int from) {
  if (from < 64) {
    const u64 x = (lo >> from) << from;
    if (x) return __ffsll((long long)x) - 1;
    from = 64;
  }
  if (from >= 128) return -1;
  const u64 y = (hi >> (from - 64)) << (from - 64);
  return y ? 63 + __ffsll((long long)y) : -1;
}

template <int MODE, bool MASKED, class MaskF>
DI void flash_tile(const u16* sK, const u16* sV, const bf16x8 (&qf)[2][2], f32x4 (&O)[2][4], float (&m)[2], float (&l)[2],
                   float (&ps)[4][4], MaskF ok, bool sel, int lane) {
  const int l15 = lane & 15, lg = lane >> 4;
  bf16x8 kf[4][2];
#pragma unroll
  for (int kt = 0; kt < 4; ++kt)
#pragma unroll
    for (int ks = 0; ks < 2; ++ks) kf[kt][ks] = *(const bf16x8*)(sK + (16 * kt + l15) * 72 + ks * 32 + lg * 8);
  if (MODE == 1) {
#pragma unroll
    for (int a = 0; a < 4; ++a)
#pragma unroll
      for (int b = 0; b < 4; ++b) ps[a][b] = 0.f;
  }
  union PFrag { unsigned u[4]; bf16x8 v; };
  PFrag pf[2][2];
#pragma unroll
  for (int qt = 0; qt < 2; ++qt) {
    f32x4 s[4];
    const float sinit = (MODE == 3) ? ((MASKED || sel) ? m[qt] : -1e30f) : 0.f;
#pragma unroll
    for (int kt = 0; kt < 4; ++kt) {
      s[kt] = f32x4{sinit, sinit, sinit, sinit};
#pragma unroll
      for (int ks = 0; ks < 2; ++ks) s[kt] = mfma16(kf[kt][ks], qf[qt][ks], s[kt]);
    }
    float pr[4][4];
    if (MODE == 3) {
      float rs = 0.f;
#pragma unroll
      for (int kt = 0; kt < 4; ++kt)
#pragma unroll
        for (int i = 0; i < 4; ++i) {
          float pv = __builtin_amdgcn_exp2f(s[kt][i]);
          if (MASKED) pv = ok(kt, i) ? pv : 0.f;
          pr[kt][i] = pv;
          rs += pv;
        }
      l[qt] += rs;
    } else {
    float mx = -1e30f;
#pragma unroll
    for (int kt = 0; kt < 4; ++kt)
#pragma unroll
      for (int i = 0; i < 4; ++i) {
        if (MASKED) s[kt][i] = ok(kt, i) ? s[kt][i] : -1e30f;
        mx = fmaxf(mx, s[kt][i]);
      }
    if (!MASKED) mx = sel ? mx : -1e30f;
    if (MODE == 1) {
      const float mm = m[qt], il = l[qt];
#pragma unroll
      for (int kt = 0; kt < 4; ++kt)
#pragma unroll
        for (int i = 0; i < 4; ++i) {
          const float pv = (s[kt][i] > -1e29f) ? __builtin_amdgcn_exp2f(s[kt][i] - mm) * il : 0.f;
          pr[kt][i] = pv;
          ps[kt][i] += pv;
        }
    } else {
      mx = fmaxf(mx, __shfl_xor(mx, 16));
      mx = fmaxf(mx, __shfl_xor(mx, 32));
      const float mnew = fmaxf(m[qt], mx);
      const float alpha = __builtin_amdgcn_exp2f(m[qt] - mnew);
      m[qt] = mnew;
      float rs = 0.f;
      if (MASKED) {
#pragma unroll
        for (int kt = 0; kt < 4; ++kt)
#pragma unroll
          for (int i = 0; i < 4; ++i) {
            const float pv = (s[kt][i] > -1e29f) ? __builtin_amdgcn_exp2f(s[kt][i] - mnew) : 0.f;
            pr[kt][i] = pv;
            rs += pv;
          }
      } else {
        const float me = sel ? mnew : 1e30f;
#pragma unroll
        for (int kt = 0; kt < 4; ++kt)
#pragma unroll
          for (int i = 0; i < 4; ++i) {
            const float pv = __builtin_amdgcn_exp2f(s[kt][i] - me);
            pr[kt][i] = pv;
            rs += pv;
          }
      }
      l[qt] = l[qt] * alpha + rs;
      if (MODE == 2) {
#pragma unroll
        for (int dt = 0; dt < 4; ++dt) O[qt][dt] *= alpha;
      }
    }
    }
    if (MODE != 0) {
#pragma unroll
      for (int ks2 = 0; ks2 < 2; ++ks2) {
        pf[qt][ks2].u[0] = pk2(pr[2 * ks2][0], pr[2 * ks2][1]);
        pf[qt][ks2].u[1] = pk2(pr[2 * ks2][2], pr[2 * ks2][3]);
        pf[qt][ks2].u[2] = pk2(pr[2 * ks2 + 1][0], pr[2 * ks2 + 1][1]);
        pf[qt][ks2].u[3] = pk2(pr[2 * ks2 + 1][2], pr[2 * ks2 + 1][3]);
      }
    }
  }
  if (MODE != 0) {
#pragma unroll
    for (int ks2 = 0; ks2 < 2; ++ks2) {
#pragma unroll
      for (int dt = 0; dt < 4; ++dt) {
        union { uint2 h[2]; bf16x8 v; } vf;
        vf.h[0] = *(const uint2*)(sV + (16 * dt + l15) * 72 + 32 * ks2 + 4 * lg);
        vf.h[1] = *(const uint2*)(sV + (16 * dt + l15) * 72 + 32 * ks2 + 16 + 4 * lg);
        O[0][dt] = mfma16(vf.v, pf[0][ks2].v, O[0][dt]);
        O[1][dt] = mfma16(vf.v, pf[1][ks2].v, O[1][dt]);
      }
    }
  }
}

DI void nsa_item(int wv0, PP p, int item, unsigned char* smem) {
  const int tid = my_tid(wv0), lane = tid & 63, wv = wv0 & 3, hp = wv0 >> 2, l15 = lane & 15, lg = lane >> 4;
  const int i = 127 - (item >> 3), bg = item & 7, b = bg >> 1, g = bg & 1;
  u16* sK = (u16*)smem;
  u16* sV = sK + 64 * 72;
  float* sImp0 = (float*)(smem + 36864);
  float* sImp = sImp0 + hp * (64 * 132);
  u64* sUni = (u64*)(smem + 36864 + 2 * 64 * 132 * 4);
  u64* sSel = sUni + 16;
  const int t0 = i * 64, qloc = 16 * wv + l15, tq = t0 + qloc;
  const unsigned tokq = (unsigned)(b * S_ + tq);
  const float* NGb = (const float*)(p->ws + OFF_NG);
  const unsigned ngoff = tokq * 24 + g * 12 + hp * 6;
  float* ACCb = p->out;
  const unsigned aoff = tokq * 512 + g * 256 + hp * 128 + 4 * lg;
  const unsigned qoff = tokq * 512 + g * 256 + hp * 128 + lg * 8;
  const int lrow = tid >> 3, lpart = tid & 7;
  const unsigned koff = (lrow * 64 + lpart * 8) * 2, voffc = (lrow * 512 + lpart * 8) * 2, voffs = (lrow * S_ + lpart * 8) * 2;

  for (int e = tid; e < 2 * 64 * 132; e += NT_) sImp0[e] = 0.f;

  bf16x8 qf[2][2];
  f32x4 O[2][4];
  float m[2], l[2], ps[4][4];
  u32x4 pk0, pv0;
  auto nomask = [](int, int) { return true; };

#define MAKE_RSRC(PTR) __builtin_amdgcn_make_buffer_rsrc((void*)(PTR), 0, 0x7fffffff, 0x00020000)
#define BLOAD(R, VO, SO) __builtin_amdgcn_raw_buffer_load_b128((R), (int)(VO), (int)(SO), 0)
#define ISSUE_TILE(RK, RV, T, LDV)                                                   \
  {                                                                                  \
    pk0 = BLOAD(RK, koff, (T)*8192);                                                 \
    pv0 = BLOAD(RV, ((LDV) == 512) ? voffc : voffs, (T)*128);                        \
  }
#define COMMIT_TILE()                                                                \
  {                                                                                  \
    *(u32x4*)(sK + lrow * 72 + lpart * 8) = pk0;                                     \
    *(u32x4*)(sV + lrow * 72 + lpart * 8) = pv0;                                     \
  }
#define COMMIT_BUF(BUF)                                                              \
  {                                                                                  \
    *(u32x4*)(sK + (BUF)*9216 + lrow * 72 + lpart * 8) = pk0;                        \
    *(u32x4*)(sV + (BUF)*9216 + lrow * 72 + lpart * 8) = pv0;                        \
  }
#define LOAD_Q(BASE)                                                                 \
  {                                                                                  \
    const u16* Q_ = (const u16*)(p->ws + (BASE));                                    \
    _Pragma("unroll") for (int qt = 0; qt < 2; ++qt)                                 \
      _Pragma("unroll") for (int ks = 0; ks < 2; ++ks)                               \
        qf[qt][ks] = *(const bf16x8*)(Q_ + (qoff + qt * 64 + ks * 32));             \
  }
#define RESET_STATE()                                                                \
  {                                                                                  \
    _Pragma("unroll") for (int qt = 0; qt < 2; ++qt) { m[qt] = -1e30f; l[qt] = 0.f; } \
    _Pragma("unroll") for (int a = 0; a < 2; ++a)                                    \
      _Pragma("unroll") for (int c = 0; c < 4; ++c) O[a][c] = f32x4{0.f, 0.f, 0.f, 0.f}; \
  }

  {
    const u16* Kc0 = (const u16*)(p->ws + OFF_KCC) + (size_t)bg * 512 * 64;
    const u16* Vc0 = (const u16*)(p->ws + OFF_VCT) + (size_t)bg * 64 * 512;
    const int nE = (4 * i + 3) < 511 ? (4 * i + 3) : 511;
    const int nkb = (nE + 63) >> 6;
    const __amdgpu_buffer_rsrc_t rK = MAKE_RSRC(Kc0), rV = MAKE_RSRC(Vc0);
    LOAD_Q(OFF_QRAW)
    RESET_STATE()
    ISSUE_TILE(rK, rV, 0, 512)
    for (int kb = 0; kb < nkb; ++kb) {
      __syncthreads();
      COMMIT_TILE()
      __syncthreads();
      if (kb + 1 < nkb) ISSUE_TILE(rK, rV, kb + 1, 512)
      auto ok = [&](int kt, int ii) { return 16 * (kb * 64 + 16 * kt + 4 * lg + ii) + 31 <= tq; };
      flash_tile<0, true>(sK, sV, qf, O, m, l, ps, ok, true, lane);
    }
#pragma unroll
    for (int qt = 0; qt < 2; ++qt) {
      float s = l[qt];
      s += __shfl_xor(s, 16);
      s += __shfl_xor(s, 32);
      l[qt] = s > 0.f ? 1.f / s : 0.f;
    }
    ISSUE_TILE(rK, rV, 0, 512)
    for (int kb = 0; kb < nkb; ++kb) {
      __syncthreads();
      COMMIT_TILE()
      __syncthreads();
      if (kb + 1 < nkb) ISSUE_TILE(rK, rV, kb + 1, 512)
      auto ok = [&](int kt, int ii) { return 16 * (kb * 64 + 16 * kt + 4 * lg + ii) + 31 <= tq; };
      flash_tile<1, true>(sK, sV, qf, O, m, l, ps, ok, true, lane);
#pragma unroll
      for (int kt = 0; kt < 4; ++kt) {
        const int j = kb * 16 + kt * 4 + lg;
        sImp[qloc * 132 + j] += ps[kt][0] + ps[kt][1] + ps[kt][2] + ps[kt][3];
      }
      __syncthreads();
#pragma unroll
      for (int kt = 0; kt < 4; ++kt) {
        const int j1 = kb * 16 + kt * 4 + lg + 1;
        if (j1 < 128) sImp[qloc * 132 + j1] += ps[kt][3];
      }
    }
#pragma unroll
    for (int qt = 0; qt < 2; ++qt) {
      const float gt = NGb[ngoff + qt * 3 + 0];
#pragma unroll
      for (int dt = 0; dt < 4; ++dt) {
        float4 o = make_float4(O[qt][dt][0] * gt, O[qt][dt][1] * gt, O[qt][dt][2] * gt, O[qt][dt][3] * gt);
        *(float4*)(ACCb + (aoff + qt * 64 + 16 * dt)) = o;
      }
    }
  }
  __syncthreads();
  u64 mlo = 0, mhi = 0, wlo = 0, whi = 0;
  if (i < 16) {
    mlo = (1ull << (i + 1)) - 1ull;
    wlo = mlo;
  } else {
    const bool v0 = lane <= i, v1 = (lane + 64) <= i;
    const bool f0 = (lane == 0) || (lane == i) || (lane == i - 1);
    const bool f1 = (lane + 64 == i) || (lane + 64 == i - 1);
    const u64 ltm = (1ull << lane) - 1ull;
    for (int qq = hp * 8; qq < hp * 8 + 8; ++qq) {
      const float* ir = sImp0 + (16 * wv + qq) * 132;
      const float i0 = ir[lane] + ir[64 * 132 + lane], i1 = ir[lane + 64] + ir[64 * 132 + lane + 64];
      const unsigned k0 = v0 ? __float_as_uint(i0 + (f0 ? 1000.f : 0.f)) : 0u;
      const unsigned k1 = v1 ? __float_as_uint(i1 + (f1 ? 1000.f : 0.f)) : 0u;
      unsigned T = 0;
      for (int bit = 30; bit >= 0; --bit) {
        const unsigned cand = T | (1u << bit);
        const int cnt = __popcll(__ballot(k0 >= cand)) + __popcll(__ballot(k1 >= cand));
        if (cnt >= 16) T = cand;
      }
      const bool g0 = k0 > T, g1 = k1 > T, e0 = k0 == T, e1 = k1 == T;
      const int need = 16 - (__popcll(__ballot(g0)) + __popcll(__ballot(g1)));
      const u64 be0 = __ballot(e0), be1 = __ballot(e1);
      const int r0 = __popcll(be0 & ltm), r1 = __popcll(be0) + __popcll(be1 & ltm);
      const u64 s0 = __ballot(v0 && (g0 || (e0 && r0 < need)));
      const u64 s1 = __ballot(v1 && (g1 || (e1 && r1 < need)));
      wlo |= s0;
      whi |= s1;
      if (lane == 0) { sSel[(16 * wv + qq) * 2] = s0; sSel[(16 * wv + qq) * 2 + 1] = s1; }
    }
  }
  if (lane == 0) { sUni[wv0 * 2] = wlo; sUni[wv0 * 2 + 1] = whi; }
  __syncthreads();
  if (i >= 16) { mlo = sSel[qloc * 2]; mhi = sSel[qloc * 2 + 1]; }
  wlo = sUni[wv * 2] | sUni[(wv + 4) * 2];
  whi = sUni[wv * 2 + 1] | sUni[(wv + 4) * 2 + 1];
  const u64 blo = sUni[0] | sUni[2] | sUni[4] | sUni[6] | sUni[8] | sUni[10] | sUni[12] | sUni[14];
  const u64 bhi = sUni[1] | sUni[3] | sUni[5] | sUni[7] | sUni[9] | sUni[11] | sUni[13] | sUni[15];

  LOAD_Q(OFF_QROT)
  float nb_s[2], nb_w[2];
  bool usefix;
  {
    const float* KM = (const float*)(p->ws + OFF_KMAX);
    const float kms = KM[bg], kmw = KM[8 + bg];
    float bmax = 0.f;
#pragma unroll
    for (int qt = 0; qt < 2; ++qt) {
      float q2 = 0.f;
#pragma unroll
      for (int ks = 0; ks < 2; ++ks)
#pragma unroll
        for (int e = 0; e < 8; ++e) {
          const float qv = __uint_as_float(((unsigned)(u16)qf[qt][ks][e]) << 16);
          q2 += qv * qv;
        }
      q2 += __shfl_xor(q2, 16);
      q2 += __shfl_xor(q2, 32);
      const float bs = sqrtf(q2 * kms) * 1.001f + 1e-3f, bw = sqrtf(q2 * kmw) * 1.001f + 1e-3f;
      nb_s[qt] = -bs;
      nb_w[qt] = -bw;
      bmax = fmaxf(bmax, fmaxf(bs, bw));
    }
    usefix = __ballot(bmax > 60.f) == 0ull;
  }
  RESET_STATE()
  if (usefix) { m[0] = nb_s[0]; m[1] = nb_s[1]; }
  {
    const __amdgpu_buffer_rsrc_t rK = MAKE_RSRC((const u16*)(p->ws + OFF_KS) + (size_t)bg * S_ * 64);
    const __amdgpu_buffer_rsrc_t rV = MAKE_RSRC((const u16*)(p->ws + OFF_VST) + (size_t)bg * 64 * S_);
    int j = next_bit(blo, bhi, 0);
    ISSUE_TILE(rK, rV, j, S_)
    COMMIT_BUF(0)
    __syncthreads();
    int jn = next_bit(blo, bhi, j + 1);
    if (jn >= 0) ISSUE_TILE(rK, rV, jn, S_)
    int cur = 0;
    while (j >= 0) {
      const u16* cK = sK + cur * 9216;
      const u16* cV = sV + cur * 9216;
      if (bit128(wlo, whi, j)) {
        const bool sel = bit128(mlo, mhi, j);
        if (j == i) {
          auto ok = [&](int kt, int ii) { return sel && (16 * kt + 4 * lg + ii) <= qloc; };
          if (usefix) flash_tile<3, true>(cK, cV, qf, O, m, l, ps, ok, true, lane);
          else flash_tile<2, true>(cK, cV, qf, O, m, l, ps, ok, true, lane);
        } else {
          if (usefix) flash_tile<3, false>(cK, cV, qf, O, m, l, ps, nomask, sel, lane);
          else flash_tile<2, false>(cK, cV, qf, O, m, l, ps, nomask, sel, lane);
        }
      }
      cur ^= 1;
      if (jn >= 0) COMMIT_BUF(cur)
      __syncthreads();
      j = jn;
      if (j >= 0) {
        jn = next_bit(blo, bhi, j + 1);
        if (jn >= 0) ISSUE_TILE(rK, rV, jn, S_)
      }
    }
  }
#pragma unroll
  for (int qt = 0; qt < 2; ++qt) {
    float s = l[qt];
    s += __shfl_xor(s, 16);
    s += __shfl_xor(s, 32);
    const float sc = NGb[ngoff + qt * 3 + 1] / s;
#pragma unroll
    for (int dt = 0; dt < 4; ++dt) {
      float4* a = (float4*)(ACCb + (aoff + qt * 64 + 16 * dt));
      float4 o = *a;
      o.x += O[qt][dt][0] * sc; o.y += O[qt][dt][1] * sc; o.z += O[qt][dt][2] * sc; o.w += O[qt][dt][3] * sc;
      *a = o;
    }
  }
  RESET_STATE()
  if (usefix) { m[0] = nb_w[0]; m[1] = nb_w[1]; }
  {
    const __amdgpu_buffer_rsrc_t rK = MAKE_RSRC((const u16*)(p->ws + OFF_KW) + (size_t)bg * S_ * 64);
    const __amdgpu_buffer_rsrc_t rV = MAKE_RSRC((const u16*)(p->ws + OFF_VWT) + (size_t)bg * 64 * S_);
    const int j0 = i >= 8 ? i - 8 : 0;
    ISSUE_TILE(rK, rV, j0, S_)
    COMMIT_BUF(0)
    __syncthreads();
    if (j0 + 1 <= i) ISSUE_TILE(rK, rV, j0 + 1, S_)
    int cur = 0;
    for (int j = j0; j <= i; ++j) {
      const u16* cK = sK + cur * 9216;
      const u16* cV = sV + cur * 9216;
      if (j == i || j == i - 8) {
        auto ok = [&](int kt, int ii) {
          const int kp = j * 64 + 16 * kt + 4 * lg + ii;
          return kp <= tq && kp > tq - 512;
        };
        if (usefix) flash_tile<3, true>(cK, cV, qf, O, m, l, ps, ok, true, lane);
        else flash_tile<2, true>(cK, cV, qf, O, m, l, ps, ok, true, lane);
      } else {
        if (usefix) flash_tile<3, false>(cK, cV, qf, O, m, l, ps, nomask, true, lane);
        else flash_tile<2, false>(cK, cV, qf, O, m, l, ps, nomask, true, lane);
      }
      cur ^= 1;
      if (j + 1 <= i) COMMIT_BUF(cur)
      __syncthreads();
      if (j + 2 <= i) ISSUE_TILE(rK, rV, j + 2, S_)
    }
  }
  u16* NSAb = (u16*)(p->ws + OFF_NSA);
#pragma unroll
  for (int qt = 0; qt < 2; ++qt) {
    float s = l[qt];
    s += __shfl_xor(s, 16);
    s += __shfl_xor(s, 32);
    const float sc = NGb[ngoff + qt * 3 + 2] / s;
#pragma unroll
    for (int dt = 0; dt < 4; ++dt) {
      const float4 a = *(const float4*)(ACCb + (aoff + qt * 64 + 16 * dt));
      uint2 o;
      o.x = pk2(a.x + O[qt][dt][0] * sc, a.y + O[qt][dt][1] * sc);
      o.y = pk2(a.z + O[qt][dt][2] * sc, a.w + O[qt][dt][3] * sc);
      *(uint2*)(NSAb + (aoff + qt * 64 + 16 * dt)) = o;
    }
  }
  __syncthreads();
}

DI void phaseE(int wv0, PP p, unsigned char* smem, int cidx) {
  __shared__ int s_item;
  int* ctr = (int*)(p->ws + OFF_CTR) + cidx;
  for (;;) {
    __syncthreads();
    if (my_tid(wv0) == 0) s_item = atomicAdd(ctr, 1);
    __syncthreads();
    const int item = s_item;
    if (item >= 1024 + 2048 + (NXT - NXT_A)) break;
    if (item < 1024) nsa_item(wv0, p, item, smem);
    else if (item < 1024 + 2048) s5_item<true>(wv0, p, item - 1024, smem);
    else xpose_tile(wv0, p, NXT_A + (item - 3072), smem);
  }
}

DI void phaseF(int wv0, PP p, unsigned char* smem) {
  const u16* YS = (const u16*)(p->ws + OFF_YS);
  const u16* NSA = (const u16*)(p->ws + OFF_NSA);
  const u16* MG = (const u16*)(p->ws + OFF_MG);
  u16* MR = (u16*)(p->ws + OFF_MERGED);
  for (int id = blockIdx.x; id < 128 * 4; id += gridDim.x) {
    int pm, pn;
    tile_map_n4(id, pm, pn);
    const int brow = pm * 256, bcol = pn * 256;
    f32x4 acc[2][2][4][2];
    gemm256(wv0, acc, YS + (size_t)brow * 512, 512, (const u16*)(p->ws + OFF_WGT) + (size_t)bcol * 512, 512, 512, smem);
    epi256(wv0, acc, brow, bcol, [&](int ai, int bj, int m, int n, int row, int col0, f32x4& v) {
      *(uint2*)(MR + (size_t)row * 1024 + col0) = pk4(sigmoidf_(v[0]), sigmoidf_(v[1]), sigmoidf_(v[2]), sigmoidf_(v[3]));
    });
    gemm256(wv0, acc, YS + (size_t)brow * 512, 512, (const u16*)(p->ws + OFF_WVT) + (size_t)bcol * 512, 512, 512, smem);
    epi256(wv0, acc, brow, bcol, [&](int ai, int bj, int m, int n, int row, int col0, f32x4& v) {
      const uint2 t = *(const uint2*)(MR + (size_t)row * 1024 + col0);
      const uint2 gq = *(const uint2*)(MG + (size_t)row * 2048 + 1024 + col0);
      *(uint2*)(MR + (size_t)row * 1024 + col0) =
          pk4(__uint_as_float(gq.x << 16) * v[0] * __uint_as_float(t.x << 16), __uint_as_float(gq.x & 0xffff0000u) * v[1] * __uint_as_float(t.x & 0xffff0000u),
              __uint_as_float(gq.y << 16) * v[2] * __uint_as_float(t.y << 16), __uint_as_float(gq.y & 0xffff0000u) * v[3] * __uint_as_float(t.y & 0xffff0000u));
    });
    gemm256(wv0, acc, NSA + (size_t)brow * 512, 512, (const u16*)(p->ws + OFF_WAT) + (size_t)bcol * 512, 512, 512, smem);
    epi256(wv0, acc, brow, bcol, [&](int ai, int bj, int m, int n, int row, int col0, f32x4& v) {
      const uint2 t = *(const uint2*)(MR + (size_t)row * 1024 + col0);
      const uint2 gq = *(const uint2*)(MG + (size_t)row * 2048 + col0);
      *(uint2*)(MR + (size_t)row * 1024 + col0) =
          pk4(__uint_as_float(gq.x << 16) * v[0] + __uint_as_float(t.x << 16), __uint_as_float(gq.x & 0xffff0000u) * v[1] + __uint_as_float(t.x & 0xffff0000u),
              __uint_as_float(gq.y << 16) * v[2] + __uint_as_float(t.y << 16), __uint_as_float(gq.y & 0xffff0000u) * v[3] + __uint_as_float(t.y & 0xffff0000u));
    });
  }
}
DI void ss_partial(int wv0, f32x4 (&acc)[2][2][4][2], float* SS, int brow, int pn) {
  const int lane = my_tid(wv0) & 63, wr = wv0 >> 2, wc = wv0 & 3;
#pragma unroll
  for (int ai = 0; ai < 2; ++ai)
#pragma unroll
    for (int m = 0; m < 4; ++m) {
      float s = 0.f;
#pragma unroll
      for (int bj = 0; bj < 2; ++bj)
#pragma unroll
        for (int n = 0; n < 2; ++n)
#pragma unroll
          for (int j = 0; j < 4; ++j) s += acc[ai][bj][m][n][j] * acc[ai][bj][m][n][j];
      s += __shfl_xor(s, 16);
      s += __shfl_xor(s, 32);
      if (lane < 16) SS[(size_t)(brow + ai * 128 + wr * 64 + m * 16 + lane) * 16 + pn * 4 + wc] = s;
    }
}
DI void phaseG(int wv0, PP p, unsigned char* smem) {
  const u16* MR = (const u16*)(p->ws + OFF_MERGED);
  u16* X1B = (u16*)(p->ws + OFF_X1B);
  float* SS1 = (float*)(p->ws + OFF_SS1);
  for (int id = blockIdx.x; id < 128 * 4; id += gridDim.x) {
    int pm, pn;
    tile_map_n4(id, pm, pn);
    const int brow = pm * 256, bcol = pn * 256;
    f32x4 acc[2][2][4][2];
    gemm256(wv0, acc, MR + (size_t)brow * 1024, 1024, (const u16*)(p->ws + OFF_WOT) + (size_t)bcol * 1024, 1024, 1024, smem);
    epi256(wv0, acc, brow, bcol, [&](int ai, int bj, int m, int n, int row, int col0, f32x4& v) {
      const size_t o = (size_t)row * 1024 + col0;
      const float4 xv = *(const float4*)(p->x + o);
      v[0] += xv.x; v[1] += xv.y; v[2] += xv.z; v[3] += xv.w;
      *(float4*)(p->out + o) = make_float4(v[0], v[1], v[2], v[3]);
      *(uint2*)(X1B + o) = pk4(v[0], v[1], v[2], v[3]);
    });
    ss_partial(wv0, acc, SS1, brow, pn);
  }
}
DI void phaseH(int wv0, PP p, unsigned char* smem) {
  const u16* X1B = (const u16*)(p->ws + OFF_X1B);
  const float* SS1 = (const float*)(p->ws + OFF_SS1);
  u16* ACT = (u16*)(p->ws + OFF_ACT);
  float* sR = (float*)(smem + 131072);
  for (int id = blockIdx.x; id < 128 * 16; id += gridDim.x) {
    int pm, pn;
    tile_map_n16(id, pm, pn);
    const int brow = pm * 256, bcol = pn * 256;
    const int tid = my_tid(wv0);
    if (tid < 256) {
      const float4* s = (const float4*)(SS1 + (size_t)(brow + tid) * 16);
      const float4 a = s[0], b = s[1], c = s[2], d = s[3];
      const float t = a.x + a.y + a.z + a.w + b.x + b.y + b.z + b.w + c.x + c.y + c.z + c.w + d.x + d.y + d.z + d.w;
      sR[tid] = rsqrtf(t * (1.f / 1024.f) + 1e-6f);
    }
    f32x4 acc[2][2][4][2];
    gemm256(wv0, acc, X1B + (size_t)brow * 1024, 1024, (const u16*)(p->ws + OFF_WUPT) + (size_t)bcol * 1024, 1024, 1024, smem);
    epi256(wv0, acc, brow, bcol, [&](int ai, int bj, int m, int n, int row, int col0, f32x4& v) {
      const float ri = sR[row - brow];
      const float a0 = fmaxf(v[0] * ri, 0.f), a1 = fmaxf(v[1] * ri, 0.f), a2 = fmaxf(v[2] * ri, 0.f), a3 = fmaxf(v[3] * ri, 0.f);
      *(uint2*)(ACT + (size_t)row * 4096 + col0) = pk4(a0 * a0, a1 * a1, a2 * a2, a3 * a3);
    });
    __syncthreads();
  }
}
DI void phaseI(int wv0, PP p, unsigned char* smem) {
  const u16* ACT = (const u16*)(p->ws + OFF_ACT);
  float* SS2 = (float*)(p->ws + OFF_SS2);
  for (int id = blockIdx.x; id < 128 * 4; id += gridDim.x) {
    int pm, pn;
    tile_map_n4(id, pm, pn);
    const int brow = pm * 256, bcol = pn * 256;
    f32x4 acc[2][2][4][2];
    gemm256(wv0, acc, ACT + (size_t)brow * 4096, 4096, (const u16*)(p->ws + OFF_WDT) + (size_t)bcol * 4096, 4096, 4096, smem);
    epi256(wv0, acc, brow, bcol, [&](int ai, int bj, int m, int n, int row, int col0, f32x4& v) {
      const size_t o = (size_t)row * 1024 + col0;
      const float4 xv = *(const float4*)(p->out + o);
      v[0] += xv.x; v[1] += xv.y; v[2] += xv.z; v[3] += xv.w;
      *(float4*)(p->out + o) = make_float4(v[0], v[1], v[2], v[3]);
    });
    ss_partial(wv0, acc, SS2, brow, pn);
  }
}
DI void phaseJ(int wv0, PP p) {
  const int lane = my_tid(wv0) & 63;
  const float* SS2 = (const float*)(p->ws + OFF_SS2);
  for (int row = blockIdx.x * 8 + wv0; row < T_; row += gridDim.x * 8) {
    float t = (lane < 16) ? SS2[(size_t)row * 16 + lane] : 0.f;
    t = wave_sum(t);
    const float rinv = rsqrtf(t * (1.f / 1024.f) + 1e-6f);
    float4* xr = (float4*)(p->out + (size_t)row * 1024);
#pragma unroll
    for (int r = 0; r < 4; ++r) {
      float4 v = xr[lane + 64 * r];
      const float4 g = ((const float4*)p->g3)[lane + 64 * r];
      v.x *= rinv * g.x; v.y *= rinv * g.y; v.z *= rinv * g.z; v.w *= rinv * g.w;
      xr[lane + 64 * r] = v;
    }
  }
}


#define XB_TMO      128
#define XB_XCNT(j)  (256  + 64 * (j))
#define XB_XSUB(j)  (1280 + 64 * (j))
#define XB_XGEN(j)  (2304 + 64 * (j))
#define XB_TOP      3328
#define XB_TOPGEN   3392
#define XB_SPIN_CAP (1u << 18)
#define LAS __attribute__((address_space(3)))
DI unsigned xb_ld(unsigned* p) { return __hip_atomic_load(p, __ATOMIC_RELAXED, __HIP_MEMORY_SCOPE_AGENT); }
DI unsigned xb_add(unsigned* p, unsigned v) { return __hip_atomic_fetch_add(p, v, __ATOMIC_RELAXED, __HIP_MEMORY_SCOPE_AGENT); }
DI unsigned xb_xcc_id() { return (unsigned)__builtin_amdgcn_s_getreg((3 << 11) | 20) & 0xFu; }
#define XB_SPIN(cond, bar) do { unsigned _sp = 0; while (cond) { __builtin_amdgcn_s_sleep(1); \
    if ((++_sp & 255u) == 0u) { if (xb_ld(&(bar)[XB_TMO])) break; if (_sp > XB_SPIN_CAP) { atomicAdd(&(bar)[XB_TMO], 1u); break; } } } } while (0)
DI void xcd_barrier_complete(unsigned* bar, unsigned x, unsigned& nloc, unsigned& nx) {
  const unsigned G = gridDim.x * gridDim.y * gridDim.z;
  unsigned sum, cnt, mine, sp = 0u;
  for (;;) {
    sum = 0u; cnt = 0u; mine = 0u;
#pragma unroll
    for (unsigned j = 0; j < 16; ++j) { const unsigned c = xb_ld(&bar[XB_XCNT(j)]); sum += c; cnt += (c > 0u) ? 1u : 0u; mine = (j == x) ? c : mine; }
    if (sum == G) break;
    __builtin_amdgcn_s_sleep(1);
    if ((++sp & 255u) == 0u) { if (xb_ld(&bar[XB_TMO])) break; if (sp > XB_SPIN_CAP) { atomicAdd(&bar[XB_TMO], 1u); break; } }
  }
  nloc = mine > 0u ? mine : 1u; nx = cnt > 0u ? cnt : 1u;
}
DI void xcd_barrier(unsigned* bar, volatile LAS unsigned* st, bool leader) {
  asm volatile("s_waitcnt vmcnt(0)" ::: "memory");
  __syncthreads();
  if (leader) {
    const unsigned x = xb_xcc_id();
    __builtin_amdgcn_s_waitcnt(0);
    unsigned nloc = st[0], nx = st[1];
    if (nloc == 0u) { xcd_barrier_complete(bar, x, nloc, nx); st[0] = nloc; st[1] = nx; }
    const unsigned old = xb_add(&bar[XB_XSUB(x)], 1u);
    const unsigned gen = old / nloc;
    if (old + 1u == (gen + 1u) * nloc) {
      __builtin_amdgcn_fence(__ATOMIC_RELEASE, "agent");
      asm volatile("s_waitcnt vmcnt(0)" ::: "memory");
      const unsigned og = xb_add(&bar[XB_TOP], 1u);
      const unsigned tg = og / nx;
      if (og + 1u == (tg + 1u) * nx) xb_add(&bar[XB_TOPGEN], 1u);
      else XB_SPIN(xb_ld(&bar[XB_TOPGEN]) == tg, bar);
      __builtin_amdgcn_fence(__ATOMIC_ACQUIRE, "agent");
      xb_add(&bar[XB_XGEN(x)], 1u);
      asm volatile("s_waitcnt vmcnt(0)" ::: "memory");
    } else {
      XB_SPIN(xb_ld(&bar[XB_XGEN(x)]) == gen, bar);
      __builtin_amdgcn_fence(__ATOMIC_ACQUIRE, "agent");
      asm volatile("s_waitcnt vmcnt(0)" ::: "memory");
    }
  }
  __syncthreads();
}

__global__ void __launch_bounds__(512, 2) mega(Params p) {
  extern __shared__ __attribute__((aligned(16))) unsigned char smem[];
  const int wv0 = __builtin_amdgcn_readfirstlane((int)(threadIdx.x >> 6));
  const int lo = p.lo, hi = p.hi;
  PP kp0 = (PP)__builtin_amdgcn_kernarg_segment_ptr();
  __shared__ uint4 xb_words;
  if (threadIdx.x == 0) {
    xb_words = make_uint4(0u, 0u, 0u, 0u);
    (void)xb_add((unsigned*)(kp0->ws + OFF_BAR) + XB_XCNT(xb_xcc_id()), 1u);
  }
  __syncthreads();
#define PH(N, CALL)                                  \
  if (lo <= N && N < hi) {                           \
    PP kp = kp0;                                     \
    asm volatile("" : "+s"(kp));                     \
    if (N > lo) {                                    \
      if (N == 1) cg::this_grid().sync();            \
      else xcd_barrier((unsigned*)(kp->ws + OFF_BAR), (volatile LAS unsigned*)&xb_words, my_tid(wv0) == 0); \
    }                                                \
    CALL;                                            \
    if ((PROBE_MASK >> N) & 1) { CALL; }             \
  }
  PH(0, phaseA(wv0, kp, smem))
  PH(1, phaseB(wv0, kp, smem))
  PH(2, phaseC(wv0, kp, smem))
  PH(3, phaseD1(wv0, kp, smem))
  PH(4, phaseD(wv0, kp, smem))
  PH(5, phaseE(wv0, kp, smem, 0))
  PH(6, phaseF(wv0, kp, smem))
  PH(7, phaseG(wv0, kp, smem))
  PH(8, phaseH(wv0, kp, smem))
  PH(9, phaseI(wv0, kp, smem))
  PH(10, phaseJ(wv0, kp))
}

extern "C" void kernel_launch(void* const* d_in, const int* in_sizes, int n_in, void* d_out, int out_size, void* d_ws,
                              size_t ws_size, hipStream_t stream) {
  static int grid_blocks = 0;
  if (!grid_blocks) {
    int dev = 0, cus = 0, per_cu = 0;
    (void)hipGetDevice(&dev);
    (void)hipDeviceGetAttribute(&cus, hipDeviceAttributeMultiprocessorCount, dev);
    (void)hipFuncSetAttribute((const void*)mega, hipFuncAttributeMaxDynamicSharedMemorySize, SMEM_BYTES);
    (void)hipOccupancyMaxActiveBlocksPerMultiprocessor(&per_cu, mega, NT_, SMEM_BYTES);
    if (per_cu > 1) per_cu = 1;
    if (per_cu < 1) per_cu = 1;
    grid_blocks = cus * per_cu;
  }
  if (ws_size < WS_NEED) { fprintf(stderr, "workspace too small: %zu < %zu\n", ws_size, (size_t)WS_NEED); }
  Params p{};
  const float** f = (const float**)&p;
  for (int i = 0; i < 24; ++i) f[i] = (const float*)d_in[i];
  p.out = (float*)d_out;
  p.ws = (unsigned char*)d_ws;
  p.lo = 0; p.hi = 11;
  (void)hipMemsetAsync((unsigned char*)d_ws + OFF_BAR, 0, 16384, stream);
  void* args[] = {&p};
  hipError_t e = hipLaunchCooperativeKernel((void*)mega, dim3(grid_blocks), dim3(NT_), args, SMEM_BYTES, stream);
  if (e != hipSuccess) fprintf(stderr, "cooperative launch failed: %s (grid %d)\n", hipGetErrorString(e), grid_blocks);
}
```

```cpp
#include <hip/hip_runtime.h>
#include <hip/hip_cooperative_groups.h>
#include <cstdio>
namespace cg = cooperative_groups;

#ifndef PROBE_MASK
#define PROBE_MASK 0
#endif

#define DI __device__ __forceinline__
typedef unsigned short u16;
typedef unsigned long long u64;
using bf16x8 = __attribute__((ext_vector_type(8))) short;
using f32x4 = __attribute__((ext_vector_type(4))) float;
using u32x4 = __attribute__((ext_vector_type(4))) unsigned;

constexpr int B_ = 4, S_ = 8192, T_ = B_ * S_;
constexpr int NT_ = 512;
constexpr int NINP = 4096;
constexpr float QSCALE = 0.125f * 1.44269504089f;

constexpr size_t MB = 1024 * 1024;
constexpr size_t OFF_WINT = 0;
constexpr size_t OFF_W1KT = OFF_WINT + (size_t)NINP * 1024 * 2;
constexpr size_t OFF_W1VT = OFF_W1KT + 256 * 2048 * 2;
constexpr size_t OFF_W2KT = OFF_W1VT + 256 * 2048 * 2;
constexpr size_t OFF_W2VT = OFF_W2KT + 256 * 256 * 2;
constexpr size_t OFF_WAT = OFF_W2VT + 256 * 256 * 2;
constexpr size_t OFF_WVT = OFF_WAT + 1024 * 512 * 2;
constexpr size_t OFF_WGT = OFF_WVT + 1024 * 512 * 2;
constexpr size_t OFF_WOT = OFF_WGT + 1024 * 512 * 2;
constexpr size_t OFF_WUPT = OFF_WOT + 1024 * 1024 * 2;
constexpr size_t OFF_WDT = OFF_WUPT + 4096 * 1024 * 2;
constexpr size_t OFF_ROPE = OFF_WDT + 4096 * 1024 * 2;
constexpr size_t OFF_CBP = OFF_ROPE + 8192 * 16 * 4;
constexpr size_t OFF_CTR = OFF_CBP + 2 * 32 * 256 * 4;
constexpr size_t OFF_KMAX = OFF_CTR + 64;
constexpr size_t OFF_BAR = OFF_CTR + 256;
constexpr size_t OFF_SS1 = OFF_BAR + 16384;
constexpr size_t OFF_SS2 = OFF_SS1 + (size_t)T_ * 16 * 4;
constexpr size_t OFF_NG = OFF_SS2 + (size_t)T_ * 16 * 4;
constexpr size_t OFF_HC = OFF_NG + (size_t)T_ * 24 * 4;
constexpr size_t OFF_KCC = OFF_HC + 2 * 4096 * 256 * 2;
constexpr size_t OFF_VCT = OFF_KCC + 8 * 512 * 64 * 2;
constexpr size_t OFF_HLOC = OFF_VCT + 8 * 512 * 64 * 2;
constexpr size_t OFF_ARENA = OFF_HLOC + (size_t)4 * 128 * 32 * 64 * 8;
constexpr size_t OFF_MG = OFF_ARENA;
constexpr size_t OFF_HN = OFF_ARENA + 128 * MB;
constexpr size_t OFF_QRAW = OFF_ARENA + 192 * MB;
constexpr size_t OFF_QROT = OFF_ARENA + 224 * MB;
constexpr size_t OFF_KCIN = OFF_ARENA + 256 * MB;
constexpr size_t OFF_VCIN = OFF_KCIN + 8 * MB;
constexpr size_t OFF_KS = OFF_VCIN + 8 * MB;
constexpr size_t OFF_VST = OFF_KS + 8 * MB;
constexpr size_t OFF_KW = OFF_VST + 8 * MB;
constexpr size_t OFF_VWT = OFF_KW + 8 * MB;
constexpr size_t OFF_U = OFF_ARENA + 304 * MB;
constexpr size_t OFF_NSA = OFF_ARENA + 336 * MB;
constexpr size_t OFF_YS = OFF_ARENA + 368 * MB;
constexpr size_t OFF_CPART = OFF_ARENA + 400 * MB;
constexpr size_t OFF_S5T = OFF_CPART + 32 * MB;
constexpr size_t OFF_S5L = OFF_S5T + 32 * 8192;
constexpr size_t WS_NEED = OFF_S5L + 32 * 64 * 8;
constexpr size_t OFF_ACT = OFF_ARENA;
constexpr size_t OFF_X1B = OFF_ARENA + 256 * MB;
constexpr size_t OFF_MERGED = OFF_HN;

constexpr int SMEM_BYTES = 131072 + 1024;

struct Params {
  const float *x, *g1, *w_in, *pe, *kw1, *kw2, *vw1, *vw2, *lam_re, *lam_im, *log_step, *b_re, *b_im, *c_re, *c_im, *dsk,
      *w_attn, *w_val, *w_gate, *w_out, *g2, *w_up, *w_down, *g3;
  float* out;
  unsigned char* ws;
  int lo, hi;
};

typedef const __attribute__((address_space(4))) Params* PP;

DI int my_tid(int wv0) {
  int t = wv0 * 64 + (int)__lane_id();
  asm volatile("" : "+v"(t));
  return t;
}
DI unsigned pk2(float a, float b);
DI u16 f2bf(float x) { return (u16)(pk2(x, 0.f) & 0xffffu); }
DI float bf2f(u16 h) { return __uint_as_float(((unsigned)h) << 16); }
typedef float f32x2_t __attribute__((ext_vector_type(2)));
typedef __bf16 bf16x2_t __attribute__((ext_vector_type(2)));
DI unsigned pk2(float a, float b) {
  const f32x2_t v = {a, b};
  return __builtin_bit_cast(unsigned, __builtin_convertvector(v, bf16x2_t));
}
DI uint2 pk4(float a, float b, float c, float d) { uint2 o; o.x = pk2(a, b); o.y = pk2(c, d); return o; }
DI float sigmoidf_(float x) { return 1.f / (1.f + __expf(-x)); }
DI float gelu_t(float x) {
  float u = 0.7978845608f * (x + 0.044715f * x * x * x);
  float e = __expf(2.f * u);
  float th = 1.f - 2.f / (e + 1.f);
  return 0.5f * x * (1.f + th);
}
DI float wave_sum(float v) {
#pragma unroll
  for (int o = 32; o > 0; o >>= 1) v += __shfl_xor(v, o);
  return v;
}
DI f32x4 mfma16(bf16x8 a, bf16x8 b, f32x4 c) { return __builtin_amdgcn_mfma_f32_16x16x32_bf16(a, b, c, 0, 0, 0); }

constexpr int G_HT = 128 * 64;
DI int lds_byte(int r, int c) {
  const int st = (r >> 4) * 2 + (c >> 5), rr = r & 15, cc = c & 31, ob = rr * 64 + cc * 2;
  return st * 1024 + (ob ^ (((ob >> 9) & 1) << 5));
}
DI void stage_rc(int b, int& R, int& C) {
  const int st = b / 1024, sb = b % 1024, swz = sb ^ (((sb >> 9) & 1) << 5);
  R = (st >> 1) * 16 + swz / 64;
  C = (st & 1) * 32 + (swz % 64) / 2;
}
typedef __attribute__((address_space(3))) unsigned* lds_u32p;
DI void gemm256(int wv0, f32x4 (&acc)[2][2][4][2], const u16* __restrict__ A, int lda, const u16* __restrict__ Bt, int ldb,
                int K, unsigned char* smem) {
  u16* shm = (u16*)smem;
  const int tid = my_tid(wv0), lane = tid & 63;
  const int wr = wv0 >> 2, wc = wv0 & 3, fr = lane & 15, fq = lane >> 4;
#define SA(b, h) (shm + ((b)*2 + (h)) * G_HT)
#define SB(b, h) (shm + (4 + (b)*2 + (h)) * G_HT)
  int sr0, sc0, sr1, sc1;
  stage_rc(tid * 16, sr0, sc0);
  stage_rc(tid * 16 + 8192, sr1, sc1);
  const u16* a0 = A + (size_t)sr0 * lda + sc0;
  const u16* a1 = A + (size_t)sr1 * lda + sc1;
  const u16* b0 = Bt + (size_t)sr0 * ldb + sc0;
  const u16* b1 = Bt + (size_t)sr1 * ldb + sc1;
#define STAGE_A(P, half, kt)                                                                                              \
  {                                                                                                                       \
    __builtin_amdgcn_global_load_lds((const unsigned*)(a0 + (size_t)((half)*128) * lda + (kt)*64),                        \
                                     (unsigned*)((char*)(P) + tid * 16), 16, 0, 0);                               \
    __builtin_amdgcn_global_load_lds((const unsigned*)(a1 + (size_t)((half)*128) * lda + (kt)*64),                        \
                                     (unsigned*)((char*)(P) + tid * 16 + 8192), 16, 0, 0);                        \
  }
#define STAGE_B(P, half, kt)                                                                                              \
  {                                                                                                                       \
    __builtin_amdgcn_global_load_lds((const unsigned*)(b0 + (size_t)((half)*128) * ldb + (kt)*64),                        \
                                     (unsigned*)((char*)(P) + tid * 16), 16, 0, 0);                               \
    __builtin_amdgcn_global_load_lds((const unsigned*)(b1 + (size_t)((half)*128) * ldb + (kt)*64),                        \
                                     (unsigned*)((char*)(P) + tid * 16 + 8192), 16, 0, 0);                        \
  }
#define LDA(dst, b, h)                                                                                                    \
  _Pragma("unroll") for (int m = 0; m < 4; ++m) _Pragma("unroll") for (int k = 0; k < 2; ++k)                             \
      dst[m][k] = *(const bf16x8*)((const unsigned char*)SA(b, h) + lds_byte(wr * 64 + m * 16 + fr, k * 32 + fq * 8));
#define LDB(dst, b, h)                                                                                                    \
  _Pragma("unroll") for (int n = 0; n < 2; ++n) _Pragma("unroll") for (int k = 0; k < 2; ++k)                             \
      dst[n][k] = *(const bf16x8*)((const unsigned char*)SB(b, h) + lds_byte(wc * 32 + n * 16 + fr, k * 32 + fq * 8));
#define MMA(ai, bj, At_, Bt_)                                                                                             \
  {                                                                                                                       \
    __builtin_amdgcn_s_setprio(1);                                                                                        \
    _Pragma("unroll") for (int m = 0; m < 4; ++m) _Pragma("unroll") for (int n = 0; n < 2; ++n)                           \
        _Pragma("unroll") for (int k = 0; k < 2; ++k) acc[ai][bj][m][n] =                                                 \
            __builtin_amdgcn_mfma_f32_16x16x32_bf16(Bt_[n][k], At_[m][k], acc[ai][bj][m][n], 0, 0, 0);                    \
    __builtin_amdgcn_s_setprio(0);                                                                                        \
  }
#define WAIT_V(n) asm volatile("s_waitcnt vmcnt(" #n ")" ::: "memory")
#define WAIT_L(n) asm volatile("s_waitcnt lgkmcnt(" #n ")" ::: "memory")
#define BAR __builtin_amdgcn_s_barrier()
#define SCHED __builtin_amdgcn_sched_barrier(0)
#pragma unroll
  for (int a = 0; a < 2; ++a)
#pragma unroll
    for (int b = 0; b < 2; ++b)
#pragma unroll
      for (int m = 0; m < 4; ++m)
#pragma unroll
        for (int n = 0; n < 2; ++n) acc[a][b][m][n] = f32x4{0.f, 0.f, 0.f, 0.f};
  bf16x8 At[4][2], B0[2][2], B1[2][2];
  const int nt = K / 64;
  WAIT_V(0);
  __syncthreads();
  STAGE_B(SB(0, 0), 0, 0) STAGE_A(SA(0, 0), 0, 0)
  STAGE_B(SB(0, 1), 1, 0) STAGE_A(SA(0, 1), 1, 0)
  if (wr == 1) BAR;
  WAIT_V(4); BAR;
  STAGE_B(SB(1, 0), 0, 1) STAGE_A(SA(1, 0), 0, 1) STAGE_B(SB(1, 1), 1, 1)
  WAIT_V(6); BAR;
#pragma unroll 1
  for (int t = 0; t < nt - 2; t += 2) {
    LDB(B0, 0, 0) SCHED; LDA(At, 0, 0) STAGE_A(SA(1, 1), 1, t + 1)
    WAIT_L(8); BAR; WAIT_L(0); MMA(0, 0, At, B0) BAR; SCHED;
    LDB(B1, 0, 1) STAGE_B(SB(0, 0), 0, t + 2)
    BAR; WAIT_L(0); MMA(0, 1, At, B1) BAR;
    LDA(At, 0, 1) STAGE_A(SA(0, 0), 0, t + 2)
    BAR; WAIT_L(0); MMA(1, 0, At, B0) BAR; SCHED;
    STAGE_B(SB(0, 1), 1, t + 2)
    WAIT_V(6); BAR; MMA(1, 1, At, B1) BAR;
    LDB(B0, 1, 0) SCHED; LDA(At, 1, 0) STAGE_A(SA(0, 1), 1, t + 2)
    WAIT_L(8); BAR; WAIT_L(0); MMA(0, 0, At, B0) BAR; SCHED;
    LDB(B1, 1, 1) STAGE_B(SB(1, 0), 0, t + 3)
    BAR; WAIT_L(0); MMA(0, 1, At, B1) BAR;
    LDA(At, 1, 1) STAGE_A(SA(1, 0), 0, t + 3)
    BAR; WAIT_L(0); MMA(1, 0, At, B0) BAR; SCHED;
    STAGE_B(SB(1, 1), 1, t + 3)
    WAIT_V(6); BAR; MMA(1, 1, At, B1) BAR;
  }
  {
    LDB(B0, 0, 0) LDA(At, 0, 0) STAGE_A(SA(1, 1), 1, nt - 1)
    BAR; WAIT_L(0); MMA(0, 0, At, B0) BAR;
    LDB(B1, 0, 1) BAR; WAIT_L(0); MMA(0, 1, At, B1) BAR;
    LDA(At, 0, 1) WAIT_V(4); BAR; WAIT_L(0); MMA(1, 0, At, B0) MMA(1, 1, At, B1) BAR;
  }
  {
    LDB(B0, 1, 0) LDA(At, 1, 0) WAIT_V(2); BAR; WAIT_L(0); MMA(0, 0, At, B0) BAR;
    LDB(B1, 1, 1) WAIT_V(0); BAR; WAIT_L(0); MMA(0, 1, At, B1) BAR;
    LDA(At, 1, 1) BAR; WAIT_L(0); MMA(1, 0, At, B0) MMA(1, 1, At, B1) BAR;
  }
  if (wr == 0) BAR;
}
DI void tile_map_n16(int id, int& pm, int& pn) {
  const int k = id & 255, rnd = id >> 8, x = k & 7, slot = k >> 3;
  pm = rnd * 16 + 4 * (x >> 1) + (slot >> 3);
  pn = 8 * (x & 1) + (slot & 7);
}
DI void tile_map_n4(int id, int& pm, int& pn) {
  const int k = id & 255, rnd = id >> 8, x = k & 7, slot = k >> 3;
  pm = rnd * 64 + 8 * x + (slot >> 2);
  pn = slot & 3;
}
template <class F>
DI void epi256(int wv0, f32x4 (&acc)[2][2][4][2], int brow, int bcol, F f) {
  const int lane = my_tid(wv0) & 63, wr = wv0 >> 2, wc = wv0 & 3;
#pragma unroll
  for (int ai = 0; ai < 2; ++ai)
#pragma unroll
    for (int bj = 0; bj < 2; ++bj)
#pragma unroll
      for (int m = 0; m < 4; ++m)
#pragma unroll
        for (int n = 0; n < 2; ++n) {
          const int row = brow + ai * 128 + wr * 64 + m * 16 + (lane & 15);
          const int col0 = bcol + bj * 128 + wc * 32 + n * 16 + (lane >> 4) * 4;
          f(ai, bj, m, n, row, col0, acc[ai][bj][m][n]);
          if (n == 1 && (m & 1)) __builtin_amdgcn_sched_barrier(0);
        }
}

constexpr int NXT_A = 1024 + 128 + 128 + 16 + 16;
constexpr int NXT = NXT_A + 128 * 3 + 256 + 1024 + 1024;
DI void xpose_tile(int wv0, PP p, int jt, unsigned char* smem) {
  const int tid = my_tid(wv0);
  float* tile = (float*)smem;
  int t = jt;
  const float* src;
  u16* dst;
  int K, Nsrc, mode = 0;
  const float* scl = nullptr;
  if (t < 1024) { src = p->w_in; dst = (u16*)(p->ws + OFF_WINT); K = 1024; Nsrc = 3864; mode = 1; }
  else if ((t -= 1024) < 128) { src = p->kw1; dst = (u16*)(p->ws + OFF_W1KT); K = 2048; Nsrc = 256; }
  else if ((t -= 128) < 128) { src = p->vw1; dst = (u16*)(p->ws + OFF_W1VT); K = 2048; Nsrc = 256; }
  else if ((t -= 128) < 16) { src = p->kw2; dst = (u16*)(p->ws + OFF_W2KT); K = 256; Nsrc = 64; mode = 2; }
  else if ((t -= 16) < 16) { src = p->vw2; dst = (u16*)(p->ws + OFF_W2VT); K = 256; Nsrc = 64; mode = 2; }
  else if ((t -= 16) < 128) { src = p->w_attn; dst = (u16*)(p->ws + OFF_WAT); K = 512; Nsrc = 1024; }
  else if ((t -= 128) < 128) { src = p->w_val; dst = (u16*)(p->ws + OFF_WVT); K = 512; Nsrc = 1024; }
  else if ((t -= 128) < 128) { src = p->w_gate; dst = (u16*)(p->ws + OFF_WGT); K = 512; Nsrc = 1024; }
  else if ((t -= 128) < 256) { src = p->w_out; dst = (u16*)(p->ws + OFF_WOT); K = 1024; Nsrc = 1024; }
  else if ((t -= 256) < 1024) { src = p->w_up; dst = (u16*)(p->ws + OFF_WUPT); K = 1024; Nsrc = 4096; scl = p->g2; }
  else { t -= 1024; src = p->w_down; dst = (u16*)(p->ws + OFF_WDT); K = 4096; Nsrc = 1024; }
  const int nkt = K >> 6, tn = t / nkt, tk = t % nkt, n0 = tn * 64, k0 = tk * 64;
  const int tx = tid & 63, ty = tid >> 6;
  const int np = n0 + tx;
  int sc = np;
  if (mode == 1) {
    if (np < 1280) sc = np;
    else if (np < 1792) sc = 1304 + (np - 1280);
    else if (np < 3840) sc = 1816 + (np - 1792);
    else if (np < 3864) sc = 1280 + (np - 3840);
    else sc = -1;
  } else if (mode == 2) {
    sc = np < 64 ? np : -1;
  }
  for (int kk = ty; kk < 64; kk += 8) {
    float val = 0.f;
    if (sc >= 0) val = src[(size_t)(k0 + kk) * Nsrc + sc];
    if (scl) val *= scl[k0 + kk];
    tile[kk * 65 + tx] = val;
  }
  __syncthreads();
  {
    const int n = tid >> 3, kc = tid & 7;
    uint4 o;
    o.x = pk2(tile[(kc * 8 + 0) * 65 + n], tile[(kc * 8 + 1) * 65 + n]);
    o.y = pk2(tile[(kc * 8 + 2) * 65 + n], tile[(kc * 8 + 3) * 65 + n]);
    o.z = pk2(tile[(kc * 8 + 4) * 65 + n], tile[(kc * 8 + 5) * 65 + n]);
    o.w = pk2(tile[(kc * 8 + 6) * 65 + n], tile[(kc * 8 + 7) * 65 + n]);
    *(uint4*)(dst + (size_t)(n0 + n) * K + k0 + kc * 8) = o;
  }
  __syncthreads();
}

DI void phaseA(int wv0, PP p, unsigned char* smem) {
  const int tid = my_tid(wv0), lane = tid & 63;
  u16* HN = (u16*)(p->ws + OFF_HN);
  for (int row = blockIdx.x * 8 + wv0; row < T_; row += gridDim.x * 8) {
    const float4* xr = (const float4*)(p->x + (size_t)row * 1024);
    float4 v[4];
    float ss = 0.f;
#pragma unroll
    for (int r = 0; r < 4; ++r) {
      v[r] = xr[lane + 64 * r];
      ss += v[r].x * v[r].x + v[r].y * v[r].y + v[r].z * v[r].z + v[r].w * v[r].w;
    }
    ss = wave_sum(ss);
    const float rinv = rsqrtf(ss * (1.f / 1024.f) + 1e-6f);
#pragma unroll
    for (int r = 0; r < 4; ++r) {
      const float4 g = ((const float4*)p->g1)[lane + 64 * r];
      uint2 o;
      o.x = pk2(v[r].x * rinv * g.x, v[r].y * rinv * g.y);
      o.y = pk2(v[r].z * rinv * g.z, v[r].w * rinv * g.w);
      *(uint2*)(HN + (size_t)row * 1024 + (lane + 64 * r) * 4) = o;
    }
  }
  for (int jt = blockIdx.x; jt < NXT_A + 32 + 32; jt += gridDim.x) {
    if (jt < NXT_A) {
      xpose_tile(wv0, p, jt, smem);
    } else if (jt >= NXT_A + 32) {
      const int g = jt - (NXT_A + 32);
      u16* TB = (u16*)(p->ws + OFF_S5T + (size_t)g * 8192);
      const float step = expf(p->log_step[g]);
      for (int e = tid; e < 2048; e += NT_) {
        const int np = e >> 4, c = e & 15, n = np & 63;
        const float lr = p->lam_re[g * 64 + n], li = p->lam_im[g * 64 + n];
        const float er = expf(lr * step);
        float sn, cs;
        sincosf(li * step, &sn, &cs);
        const float nr = er * cs - 1.f, ni = er * sn, den = lr * lr + li * li;
        const float cr = (nr * lr + ni * li) / den, ci = (ni * lr - nr * li) / den;
        const float bre = p->b_re[(g * 64 + n) * 16 + c], bim = p->b_im[(g * 64 + n) * 16 + c];
        TB[np * 16 + c] = f2bf(np < 64 ? (cr * bre - ci * bim) : (cr * bim + ci * bre));
        const int cc = e >> 7, k = e & 127;
        TB[2048 + cc * 128 + k] = f2bf(k < 64 ? p->c_re[(g * 16 + cc) * 64 + k] : -p->c_im[(g * 16 + cc) * 64 + (k - 64)]);
      }
      if (tid < 64) {
        const float lr = p->lam_re[g * 64 + tid], li = p->lam_im[g * 64 + tid];
        const float er = expf(lr * step);
        float sn, cs;
        sincosf(li * step, &sn, &cs);
        ((float2*)(p->ws + OFF_S5L))[g * 64 + tid] = make_float2(er * cs, er * sn);
      }
    } else {
      const int item = jt - NXT_A, kv = item >> 4, slice = item & 15;
      const float* w1 = kv ? p->vw1 : p->kw1;
      const int col = tid & 255, h = tid >> 8, kb = slice * 128 + h * 64;
      float s0 = 0.f, s1 = 0.f, s2 = 0.f, s3 = 0.f;
      for (int k = kb; k < kb + 64; k += 4) {
        s0 += p->pe[k] * w1[(size_t)k * 256 + col];
        s1 += p->pe[k + 1] * w1[(size_t)(k + 1) * 256 + col];
        s2 += p->pe[k + 2] * w1[(size_t)(k + 2) * 256 + col];
        s3 += p->pe[k + 3] * w1[(size_t)(k + 3) * 256 + col];
      }
      ((float*)(p->ws + OFF_CBP))[(kv * 32 + slice * 2 + h) * 256 + col] = (s0 + s1) + (s2 + s3);
    }
  }
  float* rope = (float*)(p->ws + OFF_ROPE);
  for (int i = blockIdx.x * NT_ + tid; i < S_ * 8; i += gridDim.x * NT_) {
    const int pos = i >> 3, k = i & 7;
    const float inv = powf(500000.0f, -(2.0f * (float)k) / 16.0f);
    const float ang = (float)pos * inv;
    rope[pos * 16 + k] = cosf(ang);
    rope[pos * 16 + 8 + k] = sinf(ang);
  }
  if (blockIdx.x == 0 && tid < 64) ((int*)(p->ws + OFF_CTR))[tid] = 0;
}

DI void phaseB(int wv0, PP p, unsigned char* smem) {
  const u16* HN = (const u16*)(p->ws + OFF_HN);
  const u16* WT = (const u16*)(p->ws + OFF_WINT);
  const float* rope = (const float*)(p->ws + OFF_ROPE);
  const int lane = my_tid(wv0) & 63;
  const bool ropewave = (wv0 & 1) == 0;
  for (int id = blockIdx.x; id < 128 * 16; id += gridDim.x) {
    int pm, pn;
    tile_map_n16(id, pm, pn);
    const int brow = pm * 256, bcol = pn * 256;
    f32x4 acc[2][2][4][2];
    gemm256(wv0, acc, HN + (size_t)brow * 1024, 1024, WT + (size_t)bcol * 1024, 1024, 1024, smem);
    if (pn < 2) {
      u16* QR = (u16*)(p->ws + OFF_QRAW);
      u16* QO = (u16*)(p->ws + OFF_QROT);
      epi256(wv0, acc, brow, bcol, [&](int ai, int bj, int m, int n, int row, int col0, f32x4& v) {
        f32x4 r = v;
        if (n == 0 && ropewave) {
          const int pos = row & (S_ - 1), kq = ((lane >> 4) & 1) * 4;
          const float4 c4 = *(const float4*)(rope + pos * 16 + kq), s4 = *(const float4*)(rope + pos * 16 + 8 + kq);
          const float cc[4] = {c4.x, c4.y, c4.z, c4.w}, ss[4] = {s4.x, s4.y, s4.z, s4.w};
#pragma unroll
          for (int j = 0; j < 4; ++j) {
            const float pr = __shfl_xor(v[j], 32);
            r[j] = (lane & 32) ? (v[j] * cc[j] + pr * ss[j]) : (v[j] * cc[j] - pr * ss[j]);
          }
        }
        *(uint2*)(QR + (size_t)row * 512 + col0) = pk4(v[0] * QSCALE, v[1] * QSCALE, v[2] * QSCALE, v[3] * QSCALE);
        *(uint2*)(QO + (size_t)row * 512 + col0) = pk4(r[0] * QSCALE, r[1] * QSCALE, r[2] * QSCALE, r[3] * QSCALE);
      });
    } else if (pn < 5) {
      epi256(wv0, acc, brow, bcol, [&](int ai, int bj, int m, int n, int row, int col0, f32x4& v) {
        const int sub = (pn - 2) * 2 + bj;
        const bool dorope = (sub == 2 || sub == 4), transposed = (sub == 3 || sub == 5);
        u16* dst = (u16*)(p->ws + OFF_KCIN + (size_t)sub * 8 * MB);
        const int c128 = col0 & 127, g = c128 >> 6, d0 = c128 & 63;
        const int b = row >> 13, sq = row & (S_ - 1);
        f32x4 r = v;
        if (dorope && n == 0 && ropewave) {
          const int kq = ((lane >> 4) & 1) * 4;
          const float4 c4 = *(const float4*)(rope + sq * 16 + kq), s4 = *(const float4*)(rope + sq * 16 + 8 + kq);
          const float cc[4] = {c4.x, c4.y, c4.z, c4.w}, ss[4] = {s4.x, s4.y, s4.z, s4.w};
#pragma unroll
          for (int j = 0; j < 4; ++j) {
            const float pr = __shfl_xor(v[j], 32);
            r[j] = (lane & 32) ? (v[j] * cc[j] + pr * ss[j]) : (v[j] * cc[j] - pr * ss[j]);
          }
        }
        if (transposed) {
#pragma unroll
          for (int j = 0; j < 4; ++j) dst[((size_t)((b * 2 + g) * 64 + d0 + j)) * S_ + sq] = f2bf(r[j]);
        } else {
          *(uint2*)(dst + ((size_t)(b * 2 + g) * S_ + sq) * 64 + d0) = pk4(r[0], r[1], r[2], r[3]);
        }
      });
    } else if (pn < 7) {
      u16* U = (u16*)(p->ws + OFF_U);
      epi256(wv0, acc, brow, bcol, [&](int ai, int bj, int m, int n, int row, int col0, f32x4& v) {
        *(uint2*)(U + (size_t)row * 512 + (col0 - 1280)) = pk4(v[0], v[1], v[2], v[3]);
      });
    } else if (pn < 15) {
      u16* MG = (u16*)(p->ws + OFF_MG);
      epi256(wv0, acc, brow, bcol, [&](int ai, int bj, int m, int n, int row, int col0, f32x4& v) {
        *(uint2*)(MG + (size_t)row * 2048 + (col0 - 1792)) = pk4(sigmoidf_(v[0]), sigmoidf_(v[1]), sigmoidf_(v[2]), sigmoidf_(v[3]));
      });
    } else {
      float* NG = (float*)(p->ws + OFF_NG);
      epi256(wv0, acc, brow, bcol, [&](int ai, int bj, int m, int n, int row, int col0, f32x4& v) {
        const int cc = col0 - 3840;
        if (cc < 24) *(float4*)(NG + (size_t)row * 24 + cc) = make_float4(sigmoidf_(v[0]), sigmoidf_(v[1]), sigmoidf_(v[2]), sigmoidf_(v[3]));
      });
    }
  }
}

template <bool OUT>
DI void s5_item(int wv0, PP p, int item, unsigned char* smem) {
  const int tid = my_tid(wv0), lane = tid & 63, fr = lane & 15, fq = lane >> 4;
  const int b = item >> 9, g = (item >> 4) & 31, c8 = item & 15, ch = c8 * 8 + wv0;
  u16* sBb = (u16*)smem;
  u16* sCm = sBb + 128 * 16;
  float* sBU = (float*)(smem + 8192) + wv0 * (16 * 132);
  u16* sH = (u16*)(smem + 8192 + 8 * 16 * 132 * 4) + wv0 * (16 * 136);
  *(uint4*)(smem + tid * 16) = *(const uint4*)(p->ws + OFF_S5T + (size_t)g * 8192 + tid * 16);
  const float2 lb = ((const float2*)(p->ws + OFF_S5L))[g * 64 + lane];
  const float lbr = lb.x, lbi = lb.y;
  float2* HL = (float2*)(p->ws + OFF_HLOC) + ((size_t)(b * 128 + ch) * 32 + g) * 64 + lane;
  float hr = 0.f, hi = 0.f;
  if (OUT) { const float2 h0 = *HL; hr = h0.x; hi = h0.y; }
  const u16* U = (const u16*)(p->ws + OFF_U) + ((size_t)(b * S_ + ch * 64)) * 512 + g * 16;
  u16* YS = (u16*)(p->ws + OFF_YS) + ((size_t)(b * S_ + ch * 64)) * 512 + g * 16;
  const float dk = p->dsk[g * 16 + fr];
  const bf16x8 zero8 = {0, 0, 0, 0, 0, 0, 0, 0};
  bf16x8 uall[4];
  u16 usk[4][4];
#pragma unroll
  for (int sub = 0; sub < 4; ++sub) {
    uall[sub] = fq < 2 ? *(const bf16x8*)(U + (size_t)(sub * 16 + fr) * 512 + 8 * fq) : zero8;
    if (OUT) {
#pragma unroll
      for (int j = 0; j < 4; ++j) usk[sub][j] = U[(size_t)(sub * 16 + 4 * fq + j) * 512 + fr];
    }
  }
  __syncthreads();
  bf16x8 bb[8], cf[4];
#pragma unroll
  for (int nt = 0; nt < 8; ++nt) bb[nt] = fq < 2 ? *(const bf16x8*)(sBb + (16 * nt + fr) * 16 + 8 * fq) : zero8;
  if (OUT) {
#pragma unroll
    for (int ks = 0; ks < 4; ++ks) cf[ks] = *(const bf16x8*)(sCm + fr * 128 + 32 * ks + 8 * fq);
  }
#pragma unroll
  for (int sub = 0; sub < 4; ++sub) {
    const bf16x8 ua = uall[sub];
#pragma unroll
    for (int nt = 0; nt < 8; ++nt) {
      const f32x4 a = mfma16(ua, bb[nt], f32x4{0.f, 0.f, 0.f, 0.f});
#pragma unroll
      for (int j = 0; j < 4; ++j) sBU[(4 * fq + j) * 132 + 16 * nt + fr] = a[j];
    }
    __syncthreads();
#pragma unroll 4
    for (int t = 0; t < 16; ++t) {
      const float bur = sBU[t * 132 + lane], bui = sBU[t * 132 + 64 + lane];
      const float nr = lbr * hr - lbi * hi + bur;
      const float nim = lbr * hi + lbi * hr + bui;
      hr = nr;
      hi = nim;
      if (OUT) {
        sH[t * 136 + lane] = f2bf(hr);
        sH[t * 136 + 64 + lane] = f2bf(hi);
      }
    }
    __syncthreads();
    if (OUT) {
      f32x4 y = {0.f, 0.f, 0.f, 0.f};
#pragma unroll
      for (int ks = 0; ks < 4; ++ks) y = mfma16(*(const bf16x8*)(sH + fr * 136 + 32 * ks + 8 * fq), cf[ks], y);
#pragma unroll
      for (int j = 0; j < 4; ++j) {
        const size_t o = (size_t)(sub * 16 + 4 * fq + j) * 512 + fr;
        YS[o] = f2bf(gelu_t(y[j] + dk * bf2f(usk[sub][j])));
      }
      __syncthreads();
    }
  }
  if (!OUT) *HL = make_float2(hr, hi);
  __syncthreads();
}
DI void s5_carry(int wv0, PP p) {
  const int x = blockIdx.x * NT_ + my_tid(wv0);
  if (x >= 8192) return;
  const int b = x >> 11, g = (x >> 6) & 31, n = x & 63;
  const float step = expf(p->log_step[g]);
  const float lr = p->lam_re[g * 64 + n], li = p->lam_im[g * 64 + n];
  const float er = expf(64.f * lr * step);
  float sn, cs;
  sincosf(64.f * li * step, &sn, &cs);
  const float Lr = er * cs, Li = er * sn;
  float2* HL = (float2*)(p->ws + OFF_HLOC) + (size_t)b * 128 * 2048 + g * 64 + n;
  float hr = 0.f, hi = 0.f;
  for (int c0 = 0; c0 < 128; c0 += 16) {
    float2 v[16];
#pragma unroll
    for (int k = 0; k < 16; ++k) v[k] = HL[(size_t)(c0 + k) * 2048];
#pragma unroll
    for (int k = 0; k < 16; ++k) {
      HL[(size_t)(c0 + k) * 2048] = make_float2(hr, hi);
      const float nr = Lr * hr - Li * hi + v[k].x;
      const float nim = Lr * hi + Li * hr + v[k].y;
      hr = nr;
      hi = nim;
    }
  }
}
DI void phaseC(int wv0, PP p, unsigned char* smem) {
  for (int id = blockIdx.x; id < 128 + 2048 + 256; id += gridDim.x) {
    if (id >= 128 + 2048) {
      const int it = id - (128 + 2048), tns = it >> 7, bg = (it >> 4) & 7, part = it & 15;
      const int tid = my_tid(wv0);
      const u16* K = (const u16*)(p->ws + (tns ? OFF_KW : OFF_KS)) + ((size_t)bg * S_ + part * 512 + tid) * 64;
      float q2 = 0.f;
#pragma unroll
      for (int c = 0; c < 8; ++c) {
        const uint4 w = *(const uint4*)(K + c * 8);
        const unsigned ww[4] = {w.x, w.y, w.z, w.w};
#pragma unroll
        for (int e = 0; e < 4; ++e) {
          const float a = __uint_as_float(ww[e] << 16), b2 = __uint_as_float(ww[e] & 0xffff0000u);
          q2 += a * a + b2 * b2;
        }
      }
#pragma unroll
      for (int o = 32; o > 0; o >>= 1) q2 = fmaxf(q2, __shfl_xor(q2, o));
      if ((tid & 63) == 0) atomicMax((unsigned*)(p->ws + OFF_KMAX) + tns * 8 + bg, __float_as_uint(q2));
    } else if (id < 128) {
      const int kv = id >> 6, pm = (id >> 2) & 15, ks = id & 3, brow = pm * 256;
      const u16* A = (const u16*)(p->ws + (kv ? OFF_VCIN : OFF_KCIN)) + (size_t)brow * 1024 + ks * 512;
      const u16* Bt = (const u16*)(p->ws + (kv ? OFF_W1VT : OFF_W1KT)) + ks * 512;
      f32x4 acc[2][2][4][2];
      gemm256(wv0, acc, A, 1024, Bt, 2048, 512, smem);
      float* PART = (float*)(p->ws + OFF_CPART) + (size_t)(ks * 2 + kv) * 4096 * 256;
      epi256(wv0, acc, brow, 0, [&](int ai, int bj, int m, int n, int row, int col0, f32x4& v) {
        *(float4*)(PART + (size_t)row * 256 + col0) = make_float4(v[0], v[1], v[2], v[3]);
      });
    } else {
      s5_item<false>(wv0, p, id - 128, smem);
    }
  }
}
DI void phaseD1(int wv0, PP p, unsigned char* smem) {
  const int tid = my_tid(wv0);
  float* sB = (float*)smem;
  {
    const float* cbp = (const float*)(p->ws + OFF_CBP);
    float bb = 0.f;
    for (int sl = 0; sl < 32; ++sl) bb += cbp[((tid >> 8) * 32 + sl) * 256 + (tid & 255)];
    sB[tid] = bb;
  }
  __syncthreads();
  const float* PART = (const float*)(p->ws + OFF_CPART);
  u16* HC = (u16*)(p->ws + OFF_HC);
  for (int e = blockIdx.x * NT_ + tid; e < 2 * 4096 * 64; e += gridDim.x * NT_) {
    const int kv = e >> 18, rc = e & 262143, c4 = (rc & 63) * 4;
    const size_t o = (size_t)kv * 4096 * 256 + (size_t)rc * 4;
    float4 a = *(const float4*)(PART + o);
#pragma unroll
    for (int ks = 1; ks < 4; ++ks) {
      const float4 t = *(const float4*)(PART + (size_t)ks * 2 * 4096 * 256 + o);
      a.x += t.x; a.y += t.y; a.z += t.z; a.w += t.w;
    }
    const float* bv = sB + kv * 256 + c4;
    *(uint2*)(HC + o) = pk4(gelu_t(a.x + bv[0]), gelu_t(a.y + bv[1]), gelu_t(a.z + bv[2]), gelu_t(a.w + bv[3]));
  }
}
DI void phaseD(int wv0, PP p, unsigned char* smem) {
  for (int id = blockIdx.x; id < 32; id += gridDim.x) {
    const int kv = id >> 4, pm = id & 15, brow = pm * 256;
    const u16* A = (const u16*)(p->ws + OFF_HC) + (size_t)kv * 4096 * 256 + (size_t)brow * 256;
    const u16* Bt = (const u16*)(p->ws + (kv ? OFF_W2VT : OFF_W2KT));
    f32x4 acc[2][2][4][2];
    gemm256(wv0, acc, A, 256, Bt, 256, 256, smem);
    u16* KCC = (u16*)(p->ws + OFF_KCC);
    u16* VCT = (u16*)(p->ws + OFF_VCT);
    epi256(wv0, acc, brow, 0, [&](int ai, int bj, int m, int n, int row, int col0, f32x4& v) {
      if (col0 < 64) {
        const int bg = row >> 9, nn = row & 511;
        f32x4 r = v;
        if (nn == 511) r = f32x4{0.f, 0.f, 0.f, 0.f};
        if (kv == 0) {
          *(uint2*)(KCC + ((size_t)bg * 512 + nn) * 64 + col0) = pk4(r[0], r[1], r[2], r[3]);
        } else {
#pragma unroll
          for (int j = 0; j < 4; ++j) VCT[((size_t)bg * 64 + col0 + j) * 512 + nn] = f2bf(r[j]);
        }
      }
    });
  }
  s5_carry(wv0, p);
}

DI bool bit128(u64 lo, u64 hi, int j) { return j < 64 ? ((lo >> j) & 1ull) : ((hi >> (j - 64)) & 1ull); }
DI int next_bit(u64 lo, u64 hi, int from) {
  if (from < 64) {
    const u64 x = (lo >> from) << from;
    if (x) return __ffsll((long long)x) - 1;
    from = 64;
  }
  if (from >= 128) return -1;
  const u64 y = (hi >> (from - 64)) << (from - 64);
  return y ? 63 + __ffsll((long long)y) : -1;
}

template <int MODE, bool MASKED, class MaskF>
DI void flash_tile(const u16* sK, const u16* sV, const bf16x8 (&qf)[2][2], f32x4 (&O)[2][4], float (&m)[2], float (&l)[2],
                   float (&ps)[4][4], MaskF ok, bool sel, int lane) {
  const int l15 = lane & 15, lg = lane >> 4;
  bf16x8 kf[4][2];
#pragma unroll
  for (int kt = 0; kt < 4; ++kt)
#pragma unroll
    for (int ks = 0; ks < 2; ++ks) kf[kt][ks] = *(const bf16x8*)(sK + (16 * kt + l15) * 72 + ks * 32 + lg * 8);
  if (MODE == 1) {
#pragma unroll
    for (int a = 0; a < 4; ++a)
#pragma unroll
      for (int b = 0; b < 4; ++b) ps[a][b] = 0.f;
  }
  union PFrag { unsigned u[4]; bf16x8 v; };
  PFrag pf[2][2];
#pragma unroll
  for (int qt = 0; qt < 2; ++qt) {
    f32x4 s[4];
    const float sinit = (MODE == 3) ? ((MASKED || sel) ? m[qt] : -1e30f) : 0.f;
#pragma unroll
    for (int kt = 0; kt < 4; ++kt) {
      s[kt] = f32x4{sinit, sinit, sinit, sinit};
#pragma unroll
      for (int ks = 0; ks < 2; ++ks) s[kt] = mfma16(kf[kt][ks], qf[qt][ks], s[kt]);
    }
    float pr[4][4];
    if (MODE == 3) {
      float rs = 0.f;
#pragma unroll
      for (int kt = 0; kt < 4; ++kt)
#pragma unroll
        for (int i = 0; i < 4; ++i) {
          float pv = __builtin_amdgcn_exp2f(s[kt][i]);
          if (MASKED) pv = ok(kt, i) ? pv : 0.f;
          pr[kt][i] = pv;
          rs += pv;
        }
      l[qt] += rs;
    } else {
    float mx = -1e30f;
#pragma unroll
    for (int kt = 0; kt < 4; ++kt)
#pragma unroll
      for (int i = 0; i < 4; ++i) {
        if (MASKED) s[kt][i] = ok(kt, i) ? s[kt][i] : -1e30f;
        mx = fmaxf(mx, s[kt][i]);
      }
    if (!MASKED) mx = sel ? mx : -1e30f;
    if (MODE == 1) {
      const float mm = m[qt], il = l[qt];
#pragma unroll
      for (int kt = 0; kt < 4; ++kt)
#pragma unroll
        for (int i = 0; i < 4; ++i) {
          const float pv = (s[kt][i] > -1e29f) ? __builtin_amdgcn_exp2f(s[kt][i] - mm) * il : 0.f;
          pr[kt][i] = pv;
          ps[kt][i] += pv;
        }
    } else {
      mx = fmaxf(mx, __shfl_xor(mx, 16));
      mx = fmaxf(mx, __shfl_xor(mx, 32));
      const float mnew = fmaxf(m[qt], mx);
      const float alpha = __builtin_amdgcn_exp2f(m[qt] - mnew);
      m[qt] = mnew;
      float rs = 0.f;
      if (MASKED) {
#pragma unroll
        for (int kt = 0; kt < 4; ++kt)
#pragma unroll
          for (int i = 0; i < 4; ++i) {
            const float pv = (s[kt][i] > -1e29f) ? __builtin_amdgcn_exp2f(s[kt][i] - mnew) : 0.f;
            pr[kt][i] = pv;
            rs += pv;
          }
      } else {
        const float me = sel ? mnew : 1e30f;
#pragma unroll
        for (int kt = 0; kt < 4; ++kt)
#pragma unroll
          for (int i = 0; i < 4; ++i) {
            const float pv = __builtin_amdgcn_exp2f(s[kt][i] - me);
            pr[kt][i] = pv;
            rs += pv;
          }
      }
      l[qt] = l[qt] * alpha + rs;
      if (MODE == 2) {
#pragma unroll
        for (int dt = 0; dt < 4; ++dt) O[qt][dt] *= alpha;
      }
    }
    }
    if (MODE != 0) {
#pragma unroll
      for (int ks2 = 0; ks2 < 2; ++ks2) {
        pf[qt][ks2].u[0] = pk2(pr[2 * ks2][0], pr[2 * ks2][1]);
        pf[qt][ks2].u[1] = pk2(pr[2 * ks2][2], pr[2 * ks2][3]);
        pf[qt][ks2].u[2] = pk2(pr[2 * ks2 + 1][0], pr[2 * ks2 + 1][1]);
        pf[qt][ks2].u[3] = pk2(pr[2 * ks2 + 1][2], pr[2 * ks2 + 1][3]);
      }
    }
  }
  if (MODE != 0) {
#pragma unroll
    for (int ks2 = 0; ks2 < 2; ++ks2) {
#pragma unroll
      for (int dt = 0; dt < 4; ++dt) {
        union { uint2 h[2]; bf16x8 v; } vf;
        vf.h[0] = *(const uint2*)(sV + (16 * dt + l15) * 72 + 32 * ks2 + 4 * lg);
        vf.h[1] = *(const uint2*)(sV + (16 * dt + l15) * 72 + 32 * ks2 + 16 + 4 * lg);
        O[0][dt] = mfma16(vf.v, pf[0][ks2].v, O[0][dt]);
        O[1][dt] = mfma16(vf.v, pf[1][ks2].v, O[1][dt]);
      }
    }
  }
}

DI void flash_s3(const u16* sK, const bf16x8 (&qf)[2][2], float si0, float si1, f32x4 (&s)[2][4], int lane) {
  const int l15 = lane & 15, lg = lane >> 4;
  bf16x8 kf[4][2];
#pragma unroll
  for (int kt = 0; kt < 4; ++kt)
#pragma unroll
    for (int ks = 0; ks < 2; ++ks) kf[kt][ks] = *(const bf16x8*)(sK + (16 * kt + l15) * 72 + ks * 32 + lg * 8);
#pragma unroll
  for (int qt = 0; qt < 2; ++qt) {
    const float si = qt ? si1 : si0;
#pragma unroll
    for (int kt = 0; kt < 4; ++kt) {
      s[qt][kt] = f32x4{si, si, si, si};
#pragma unroll
      for (int ks = 0; ks < 2; ++ks) s[qt][kt] = mfma16(kf[kt][ks], qf[qt][ks], s[qt][kt]);
    }
  }
}
template <bool MASKED, class MaskF>
DI void flash_pv3(const u16* sV, const f32x4 (&s)[2][4], f32x4 (&O)[2][4], float (&l)[2], MaskF ok, int lane) {
  const int l15 = lane & 15, lg = lane >> 4;
  union PFrag { unsigned u[4]; bf16x8 v; };
  PFrag pf[2][2];
#pragma unroll
  for (int qt = 0; qt < 2; ++qt) {
    float pr[4][4];
    float rs = 0.f;
#pragma unroll
    for (int kt = 0; kt < 4; ++kt)
#pragma unroll
      for (int i = 0; i < 4; ++i) {
        float pv = __builtin_amdgcn_exp2f(s[qt][kt][i]);
        if (MASKED) pv = ok(kt, i) ? pv : 0.f;
        pr[kt][i] = pv;
        rs += pv;
      }
    l[qt] += rs;
#pragma unroll
    for (int ks2 = 0; ks2 < 2; ++ks2) {
      pf[qt][ks2].u[0] = pk2(pr[2 * ks2][0], pr[2 * ks2][1]);
      pf[qt][ks2].u[1] = pk2(pr[2 * ks2][2], pr[2 * ks2][3]);
      pf[qt][ks2].u[2] = pk2(pr[2 * ks2 + 1][0], pr[2 * ks2 + 1][1]);
      pf[qt][ks2].u[3] = pk2(pr[2 * ks2 + 1][2], pr[2 * ks2 + 1][3]);
    }
  }
#pragma unroll
  for (int ks2 = 0; ks2 < 2; ++ks2) {
#pragma unroll
    for (int dt = 0; dt < 4; ++dt) {
      union { uint2 h[2]; bf16x8 v; } vf;
      vf.h[0] = *(const uint2*)(sV + (16 * dt + l15) * 72 + 32 * ks2 + 4 * lg);
      vf.h[1] = *(const uint2*)(sV + (16 * dt + l15) * 72 + 32 * ks2 + 16 + 4 * lg);
      O[0][dt] = mfma16(vf.v, pf[0][ks2].v, O[0][dt]);
      O[1][dt] = mfma16(vf.v, pf[1][ks2].v, O[1][dt]);
    }
  }
}

DI void nsa_item(int wv0, PP p, int item, unsigned char* smem) {
  const int tid = my_tid(wv0), lane = tid & 63, wv = wv0 & 3, hp = wv0 >> 2, l15 = lane & 15, lg = lane >> 4;
  const int i = 127 - (item >> 3), bg = item & 7, b = bg >> 1, g = bg & 1;
  u16* sK = (u16*)smem;
  u16* sV = sK + 64 * 72;
  float* sImp0 = (float*)(smem + 55296);
  float* sImp = sImp0 + hp * (64 * 132);
  u64* sUni = (u64*)(smem + 55296 + 2 * 64 * 132 * 4);
  u64* sSel = sUni + 16;
  const int t0 = i * 64, qloc = 16 * wv + l15, tq = t0 + qloc;
  const unsigned tokq = (unsigned)(b * S_ + tq);
  const float* NGb = (const float*)(p->ws + OFF_NG);
  const unsigned ngoff = tokq * 24 + g * 12 + hp * 6;
  float* ACCb = p->out;
  const unsigned aoff = tokq * 512 + g * 256 + hp * 128 + 4 * lg;
  const unsigned qoff = tokq * 512 + g * 256 + hp * 128 + lg * 8;
  const int lrow = tid >> 3, lpart = tid & 7;
  const unsigned koff = (lrow * 64 + lpart * 8) * 2, voffc = (lrow * 512 + lpart * 8) * 2, voffs = (lrow * S_ + lpart * 8) * 2;

  for (int e = tid; e < 2 * 64 * 132; e += NT_) sImp0[e] = 0.f;

  bf16x8 qf[2][2];
  f32x4 O[2][4];
  float m[2], l[2], ps[4][4];
  u32x4 pk0, pv0;
  auto nomask = [](int, int) { return true; };

#define MAKE_RSRC(PTR) __builtin_amdgcn_make_buffer_rsrc((void*)(PTR), 0, 0x7fffffff, 0x00020000)
#define BLOAD(R, VO, SO) __builtin_amdgcn_raw_buffer_load_b128((R), (int)(VO), (int)(SO), 0)
#define ISSUE_TILE(RK, RV, T, LDV)                                                   \
  {                                                                                  \
    pk0 = BLOAD(RK, koff, (T)*8192);                                                 \
    pv0 = BLOAD(RV, ((LDV) == 512) ? voffc : voffs, (T)*128);                        \
  }
#define COMMIT_TILE()                                                                \
  {                                                                                  \
    *(u32x4*)(sK + lrow * 72 + lpart * 8) = pk0;                                     \
    *(u32x4*)(sV + lrow * 72 + lpart * 8) = pv0;                                     \
  }
#define COMMIT_BUF(BUF)                                                              \
  {                                                                                  \
    *(u32x4*)(sK + (BUF)*9216 + lrow * 72 + lpart * 8) = pk0;                        \
    *(u32x4*)(sV + (BUF)*9216 + lrow * 72 + lpart * 8) = pv0;                        \
  }
#define LOAD_Q(BASE)                                                                 \
  {                                                                                  \
    const u16* Q_ = (const u16*)(p->ws + (BASE));                                    \
    _Pragma("unroll") for (int qt = 0; qt < 2; ++qt)                                 \
      _Pragma("unroll") for (int ks = 0; ks < 2; ++ks)                               \
        qf[qt][ks] = *(const bf16x8*)(Q_ + (qoff + qt * 64 + ks * 32));             \
  }
#define RESET_STATE()                                                                \
  {                                                                                  \
    _Pragma("unroll") for (int qt = 0; qt < 2; ++qt) { m[qt] = -1e30f; l[qt] = 0.f; } \
    _Pragma("unroll") for (int a = 0; a < 2; ++a)                                    \
      _Pragma("unroll") for (int c = 0; c < 4; ++c) O[a][c] = f32x4{0.f, 0.f, 0.f, 0.f}; \
  }

  {
    const u16* Kc0 = (const u16*)(p->ws + OFF_KCC) + (size_t)bg * 512 * 64;
    const u16* Vc0 = (const u16*)(p->ws + OFF_VCT) + (size_t)bg * 64 * 512;
    const int nE = (4 * i + 3) < 511 ? (4 * i + 3) : 511;
    const int nkb = (nE + 63) >> 6;
    const __amdgpu_buffer_rsrc_t rK = MAKE_RSRC(Kc0), rV = MAKE_RSRC(Vc0);
    LOAD_Q(OFF_QRAW)
    RESET_STATE()
    ISSUE_TILE(rK, rV, 0, 512)
    for (int kb = 0; kb < nkb; ++kb) {
      __syncthreads();
      COMMIT_TILE()
      __syncthreads();
      if (kb + 1 < nkb) ISSUE_TILE(rK, rV, kb + 1, 512)
      auto ok = [&](int kt, int ii) { return 16 * (kb * 64 + 16 * kt + 4 * lg + ii) + 31 <= tq; };
      flash_tile<0, true>(sK, sV, qf, O, m, l, ps, ok, true, lane);
    }
#pragma unroll
    for (int qt = 0; qt < 2; ++qt) {
      float s = l[qt];
      s += __shfl_xor(s, 16);
      s += __shfl_xor(s, 32);
      l[qt] = s > 0.f ? 1.f / s : 0.f;
    }
    ISSUE_TILE(rK, rV, 0, 512)
    for (int kb = 0; kb < nkb; ++kb) {
      __syncthreads();
      COMMIT_TILE()
      __syncthreads();
      if (kb + 1 < nkb) ISSUE_TILE(rK, rV, kb + 1, 512)
      auto ok = [&](int kt, int ii) { return 16 * (kb * 64 + 16 * kt + 4 * lg + ii) + 31 <= tq; };
      flash_tile<1, true>(sK, sV, qf, O, m, l, ps, ok, true, lane);
#pragma unroll
      for (int kt = 0; kt < 4; ++kt) {
        const int j = kb * 16 + kt * 4 + lg;
        sImp[qloc * 132 + j] += ps[kt][0] + ps[kt][1] + ps[kt][2] + ps[kt][3];
      }
      __syncthreads();
#pragma unroll
      for (int kt = 0; kt < 4; ++kt) {
        const int j1 = kb * 16 + kt * 4 + lg + 1;
        if (j1 < 128) sImp[qloc * 132 + j1] += ps[kt][3];
      }
    }
#pragma unroll
    for (int qt = 0; qt < 2; ++qt) {
      const float gt = NGb[ngoff + qt * 3 + 0];
#pragma unroll
      for (int dt = 0; dt < 4; ++dt) {
        float4 o = make_float4(O[qt][dt][0] * gt, O[qt][dt][1] * gt, O[qt][dt][2] * gt, O[qt][dt][3] * gt);
        *(float4*)(ACCb + (aoff + qt * 64 + 16 * dt)) = o;
      }
    }
  }
  __syncthreads();
  u64 mlo = 0, mhi = 0, wlo = 0, whi = 0;
  if (i < 16) {
    mlo = (1ull << (i + 1)) - 1ull;
    wlo = mlo;
  } else {
    const bool v0 = lane <= i, v1 = (lane + 64) <= i;
    const bool f0 = (lane == 0) || (lane == i) || (lane == i - 1);
    const bool f1 = (lane + 64 == i) || (lane + 64 == i - 1);
    const u64 ltm = (1ull << lane) - 1ull;
    for (int qq = hp * 8; qq < hp * 8 + 8; ++qq) {
      const float* ir = sImp0 + (16 * wv + qq) * 132;
      const float i0 = ir[lane] + ir[64 * 132 + lane], i1 = ir[lane + 64] + ir[64 * 132 + lane + 64];
      const unsigned k0 = v0 ? __float_as_uint(i0 + (f0 ? 1000.f : 0.f)) : 0u;
      const unsigned k1 = v1 ? __float_as_uint(i1 + (f1 ? 1000.f : 0.f)) : 0u;
      unsigned T = 0;
      for (int bit = 30; bit >= 0; --bit) {
        const unsigned cand = T | (1u << bit);
        const int cnt = __popcll(__ballot(k0 >= cand)) + __popcll(__ballot(k1 >= cand));
        if (cnt >= 16) T = cand;
      }
      const bool g0 = k0 > T, g1 = k1 > T, e0 = k0 == T, e1 = k1 == T;
      const int need = 16 - (__popcll(__ballot(g0)) + __popcll(__ballot(g1)));
      const u64 be0 = __ballot(e0), be1 = __ballot(e1);
      const int r0 = __popcll(be0 & ltm), r1 = __popcll(be0) + __popcll(be1 & ltm);
      const u64 s0 = __ballot(v0 && (g0 || (e0 && r0 < need)));
      const u64 s1 = __ballot(v1 && (g1 || (e1 && r1 < need)));
      wlo |= s0;
      whi |= s1;
      if (lane == 0) { sSel[(16 * wv + qq) * 2] = s0; sSel[(16 * wv + qq) * 2 + 1] = s1; }
    }
  }
  if (lane == 0) { sUni[wv0 * 2] = wlo; sUni[wv0 * 2 + 1] = whi; }
  __syncthreads();
  if (i >= 16) { mlo = sSel[qloc * 2]; mhi = sSel[qloc * 2 + 1]; }
  wlo = sUni[wv * 2] | sUni[(wv + 4) * 2];
  whi = sUni[wv * 2 + 1] | sUni[(wv + 4) * 2 + 1];
  const u64 blo = sUni[0] | sUni[2] | sUni[4] | sUni[6] | sUni[8] | sUni[10] | sUni[12] | sUni[14];
  const u64 bhi = sUni[1] | sUni[3] | sUni[5] | sUni[7] | sUni[9] | sUni[11] | sUni[13] | sUni[15];

  LOAD_Q(OFF_QROT)
  float nb_s[2], nb_w[2];
  bool usefix;
  {
    const float* KM = (const float*)(p->ws + OFF_KMAX);
    const float kms = KM[bg], kmw = KM[8 + bg];
    float bmax = 0.f;
#pragma unroll
    for (int qt = 0; qt < 2; ++qt) {
      float q2 = 0.f;
#pragma unroll
      for (int ks = 0; ks < 2; ++ks)
#pragma unroll
        for (int e = 0; e < 8; ++e) {
          const float qv = __uint_as_float(((unsigned)(u16)qf[qt][ks][e]) << 16);
          q2 += qv * qv;
        }
      q2 += __shfl_xor(q2, 16);
      q2 += __shfl_xor(q2, 32);
      const float bs = sqrtf(q2 * kms) * 1.001f + 1e-3f, bw = sqrtf(q2 * kmw) * 1.001f + 1e-3f;
      nb_s[qt] = -bs;
      nb_w[qt] = -bw;
      bmax = fmaxf(bmax, fmaxf(bs, bw));
    }
    usefix = __ballot(bmax > 60.f) == 0ull;
  }
  RESET_STATE()
  if (usefix) { m[0] = nb_s[0]; m[1] = nb_s[1]; }
  {
    const __amdgpu_buffer_rsrc_t rK = MAKE_RSRC((const u16*)(p->ws + OFF_KS) + (size_t)bg * S_ * 64);
    const __amdgpu_buffer_rsrc_t rV = MAKE_RSRC((const u16*)(p->ws + OFF_VST) + (size_t)bg * 64 * S_);
    if (usefix) {
      int jc = next_bit(blo, bhi, 0);
      int j1 = next_bit(blo, bhi, jc + 1);
      ISSUE_TILE(rK, rV, jc, S_)
      COMMIT_BUF(0)
      if (j1 >= 0) {
        ISSUE_TILE(rK, rV, j1, S_)
        COMMIT_BUF(1)
      }
      __syncthreads();
      int j2 = j1 >= 0 ? next_bit(blo, bhi, j1 + 1) : -1;
      if (j2 >= 0) ISSUE_TILE(rK, rV, j2, S_)
      f32x4 sc_[2][4], sn_[2][4];
      {
        const bool selc = bit128(mlo, mhi, jc);
        flash_s3(sK, qf, (selc || jc == i) ? m[0] : -1e30f, (selc || jc == i) ? m[1] : -1e30f, sc_, lane);
      }
      int bc = 0;
      while (jc >= 0) {
        const int bn = bc == 2 ? 0 : bc + 1, bn2 = bn == 2 ? 0 : bn + 1;
        const bool needn = j1 >= 0 && bit128(wlo, whi, j1);
        if (needn) {
          const bool seln = bit128(mlo, mhi, j1);
          const bool on = seln || j1 == i;
          flash_s3(sK + bn * 9216, qf, on ? m[0] : -1e30f, on ? m[1] : -1e30f, sn_, lane);
        }
        if (bit128(wlo, whi, jc)) {
          if (jc == i) {
            const bool sel = bit128(mlo, mhi, jc);
            auto ok = [&](int kt, int ii) { return sel && (16 * kt + 4 * lg + ii) <= qloc; };
            flash_pv3<true>(sV + bc * 9216, sc_, O, l, ok, lane);
          } else {
            flash_pv3<false>(sV + bc * 9216, sc_, O, l, nomask, lane);
          }
        }
        if (j2 >= 0) COMMIT_BUF(bn2)
        __syncthreads();
        jc = j1;
        j1 = j2;
        bc = bn;
        if (j1 >= 0) {
          j2 = next_bit(blo, bhi, j1 + 1);
          if (j2 >= 0) ISSUE_TILE(rK, rV, j2, S_)
        } else {
          j2 = -1;
        }
#pragma unroll
        for (int a = 0; a < 2; ++a)
#pragma unroll
          for (int c = 0; c < 4; ++c) sc_[a][c] = sn_[a][c];
      }
    } else {
      int j = next_bit(blo, bhi, 0);
      ISSUE_TILE(rK, rV, j, S_)
      COMMIT_BUF(0)
      __syncthreads();
      int jn = next_bit(blo, bhi, j + 1);
      if (jn >= 0) ISSUE_TILE(rK, rV, jn, S_)
      int cur = 0;
      while (j >= 0) {
        const u16* cK = sK + cur * 9216;
        const u16* cV = sV + cur * 9216;
        if (bit128(wlo, whi, j)) {
          const bool sel = bit128(mlo, mhi, j);
          if (j == i) {
            auto ok = [&](int kt, int ii) { return sel && (16 * kt + 4 * lg + ii) <= qloc; };
            if (usefix) flash_tile<3, true>(cK, cV, qf, O, m, l, ps, ok, true, lane);
            else flash_tile<2, true>(cK, cV, qf, O, m, l, ps, ok, true, lane);
          } else {
            if (usefix) flash_tile<3, false>(cK, cV, qf, O, m, l, ps, nomask, sel, lane);
            else flash_tile<2, false>(cK, cV, qf, O, m, l, ps, nomask, sel, lane);
          }
        }
        cur ^= 1;
        if (jn >= 0) COMMIT_BUF(cur)
        __syncthreads();
        j = jn;
        if (j >= 0) {
          jn = next_bit(blo, bhi, j + 1);
          if (jn >= 0) ISSUE_TILE(rK, rV, jn, S_)
        }
      }
    }
  }
#pragma unroll
  for (int qt = 0; qt < 2; ++qt) {
    float s = l[qt];
    s += __shfl_xor(s, 16);
    s += __shfl_xor(s, 32);
    const float sc = NGb[ngoff + qt * 3 + 1] / s;
#pragma unroll
    for (int dt = 0; dt < 4; ++dt) {
      float4* a = (float4*)(ACCb + (aoff + qt * 64 + 16 * dt));
      float4 o = *a;
      o.x += O[qt][dt][0] * sc; o.y += O[qt][dt][1] * sc; o.z += O[qt][dt][2] * sc; o.w += O[qt][dt][3] * sc;
      *a = o;
    }
  }
  RESET_STATE()
  if (usefix) { m[0] = nb_w[0]; m[1] = nb_w[1]; }
  {
    const __amdgpu_buffer_rsrc_t rK = MAKE_RSRC((const u16*)(p->ws + OFF_KW) + (size_t)bg * S_ * 64);
    const __amdgpu_buffer_rsrc_t rV = MAKE_RSRC((const u16*)(p->ws + OFF_VWT) + (size_t)bg * 64 * S_);
    const int j0 = i >= 8 ? i - 8 : 0;
    ISSUE_TILE(rK, rV, j0, S_)
    COMMIT_BUF(0)
    __syncthreads();
    if (j0 + 1 <= i) ISSUE_TILE(rK, rV, j0 + 1, S_)
    int cur = 0;
    for (int j = j0; j <= i; ++j) {
      const u16* cK = sK + cur * 9216;
      const u16* cV = sV + cur * 9216;
      if (j == i || j == i - 8) {
        auto ok = [&](int kt, int ii) {
          const int kp = j * 64 + 16 * kt + 4 * lg + ii;
          return kp <= tq && kp > tq - 512;
        };
        if (usefix) flash_tile<3, true>(cK, cV, qf, O, m, l, ps, ok, true, lane);
        else flash_tile<2, true>(cK, cV, qf, O, m, l, ps, ok, true, lane);
      } else {
        if (usefix) flash_tile<3, false>(cK, cV, qf, O, m, l, ps, nomask, true, lane);
        else flash_tile<2, false>(cK, cV, qf, O, m, l, ps, nomask, true, lane);
      }
      cur ^= 1;
      if (j + 1 <= i) COMMIT_BUF(cur)
      __syncthreads();
      if (j + 2 <= i) ISSUE_TILE(rK, rV, j + 2, S_)
    }
  }
  u16* NSAb = (u16*)(p->ws + OFF_NSA);
#pragma unroll
  for (int qt = 0; qt < 2; ++qt) {
    float s = l[qt];
    s += __shfl_xor(s, 16);
    s += __shfl_xor(s, 32);
    const float sc = NGb[ngoff + qt * 3 + 2] / s;
#pragma unroll
    for (int dt = 0; dt < 4; ++dt) {
      const float4 a = *(const float4*)(ACCb + (aoff + qt * 64 + 16 * dt));
      uint2 o;
      o.x = pk2(a.x + O[qt][dt][0] * sc, a.y + O[qt][dt][1] * sc);
      o.y = pk2(a.z + O[qt][dt][2] * sc, a.w + O[qt][dt][3] * sc);
      *(uint2*)(NSAb + (aoff + qt * 64 + 16 * dt)) = o;
    }
  }
  __syncthreads();
}

DI void phaseE(int wv0, PP p, unsigned char* smem, int cidx) {
  __shared__ int s_item;
  int* ctr = (int*)(p->ws + OFF_CTR) + cidx;
  for (;;) {
    __syncthreads();
    if (my_tid(wv0) == 0) s_item = atomicAdd(ctr, 1);
    __syncthreads();
    const int item = s_item;
    if (item >= 1024 + 2048 + (NXT - NXT_A)) break;
    if (item < 1024) nsa_item(wv0, p, item, smem);
    else if (item < 1024 + 2048) s5_item<true>(wv0, p, item - 1024, smem);
    else xpose_tile(wv0, p, NXT_A + (item - 3072), smem);
  }
}

DI void phaseF(int wv0, PP p, unsigned char* smem) {
  const u16* YS = (const u16*)(p->ws + OFF_YS);
  const u16* NSA = (const u16*)(p->ws + OFF_NSA);
  const u16* MG = (const u16*)(p->ws + OFF_MG);
  u16* MR = (u16*)(p->ws + OFF_MERGED);
  for (int id = blockIdx.x; id < 128 * 4; id += gridDim.x) {
    int pm, pn;
    tile_map_n4(id, pm, pn);
    const int brow = pm * 256, bcol = pn * 256;
    f32x4 acc[2][2][4][2];
    gemm256(wv0, acc, YS + (size_t)brow * 512, 512, (const u16*)(p->ws + OFF_WGT) + (size_t)bcol * 512, 512, 512, smem);
    epi256(wv0, acc, brow, bcol, [&](int ai, int bj, int m, int n, int row, int col0, f32x4& v) {
      *(uint2*)(MR + (size_t)row * 1024 + col0) = pk4(sigmoidf_(v[0]), sigmoidf_(v[1]), sigmoidf_(v[2]), sigmoidf_(v[3]));
    });
    gemm256(wv0, acc, YS + (size_t)brow * 512, 512, (const u16*)(p->ws + OFF_WVT) + (size_t)bcol * 512, 512, 512, smem);
    epi256(wv0, acc, brow, bcol, [&](int ai, int bj, int m, int n, int row, int col0, f32x4& v) {
      const uint2 t = *(const uint2*)(MR + (size_t)row * 1024 + col0);
      const uint2 gq = *(const uint2*)(MG + (size_t)row * 2048 + 1024 + col0);
      *(uint2*)(MR + (size_t)row * 1024 + col0) =
          pk4(__uint_as_float(gq.x << 16) * v[0] * __uint_as_float(t.x << 16), __uint_as_float(gq.x & 0xffff0000u) * v[1] * __uint_as_float(t.x & 0xffff0000u),
              __uint_as_float(gq.y << 16) * v[2] * __uint_as_float(t.y << 16), __uint_as_float(gq.y & 0xffff0000u) * v[3] * __uint_as_float(t.y & 0xffff0000u));
    });
    gemm256(wv0, acc, NSA + (size_t)brow * 512, 512, (const u16*)(p->ws + OFF_WAT) + (size_t)bcol * 512, 512, 512, smem);
    epi256(wv0, acc, brow, bcol, [&](int ai, int bj, int m, int n, int row, int col0, f32x4& v) {
      const uint2 t = *(const uint2*)(MR + (size_t)row * 1024 + col0);
      const uint2 gq = *(const uint2*)(MG + (size_t)row * 2048 + col0);
      *(uint2*)(MR + (size_t)row * 1024 + col0) =
          pk4(__uint_as_float(gq.x << 16) * v[0] + __uint_as_float(t.x << 16), __uint_as_float(gq.x & 0xffff0000u) * v[1] + __uint_as_float(t.x & 0xffff0000u),
              __uint_as_float(gq.y << 16) * v[2] + __uint_as_float(t.y << 16), __uint_as_float(gq.y & 0xffff0000u) * v[3] + __uint_as_float(t.y & 0xffff0000u));
    });
  }
}
DI void ss_partial(int wv0, f32x4 (&acc)[2][2][4][2], float* SS, int brow, int pn) {
  const int lane = my_tid(wv0) & 63, wr = wv0 >> 2, wc = wv0 & 3;
#pragma unroll
  for (int ai = 0; ai < 2; ++ai)
#pragma unroll
    for (int m = 0; m < 4; ++m) {
      float s = 0.f;
#pragma unroll
      for (int bj = 0; bj < 2; ++bj)
#pragma unroll
        for (int n = 0; n < 2; ++n)
#pragma unroll
          for (int j = 0; j < 4; ++j) s += acc[ai][bj][m][n][j] * acc[ai][bj][m][n][j];
      s += __shfl_xor(s, 16);
      s += __shfl_xor(s, 32);
      if (lane < 16) SS[(size_t)(brow + ai * 128 + wr * 64 + m * 16 + lane) * 16 + pn * 4 + wc] = s;
    }
}
DI void phaseG(int wv0, PP p, unsigned char* smem) {
  const u16* MR = (const u16*)(p->ws + OFF_MERGED);
  u16* X1B = (u16*)(p->ws + OFF_X1B);
  float* SS1 = (float*)(p->ws + OFF_SS1);
  for (int id = blockIdx.x; id < 128 * 4; id += gridDim.x) {
    int pm, pn;
    tile_map_n4(id, pm, pn);
    const int brow = pm * 256, bcol = pn * 256;
    f32x4 acc[2][2][4][2];
    gemm256(wv0, acc, MR + (size_t)brow * 1024, 1024, (const u16*)(p->ws + OFF_WOT) + (size_t)bcol * 1024, 1024, 1024, smem);
    epi256(wv0, acc, brow, bcol, [&](int ai, int bj, int m, int n, int row, int col0, f32x4& v) {
      const size_t o = (size_t)row * 1024 + col0;
      const float4 xv = *(const float4*)(p->x + o);
      v[0] += xv.x; v[1] += xv.y; v[2] += xv.z; v[3] += xv.w;
      *(float4*)(p->out + o) = make_float4(v[0], v[1], v[2], v[3]);
      *(uint2*)(X1B + o) = pk4(v[0], v[1], v[2], v[3]);
    });
    ss_partial(wv0, acc, SS1, brow, pn);
  }
}
DI void phaseH(int wv0, PP p, unsigned char* smem) {
  const u16* X1B = (const u16*)(p->ws + OFF_X1B);
  const float* SS1 = (const float*)(p->ws + OFF_SS1);
  u16* ACT = (u16*)(p->ws + OFF_ACT);
  float* sR = (float*)(smem + 131072);
  for (int id = blockIdx.x; id < 128 * 16; id += gridDim.x) {
    int pm, pn;
    tile_map_n16(id, pm, pn);
    const int brow = pm * 256, bcol = pn * 256;
    const int tid = my_tid(wv0);
    if (tid < 256) {
      const float4* s = (const float4*)(SS1 + (size_t)(brow + tid) * 16);
      const float4 a = s[0], b = s[1], c = s[2], d = s[3];
      const float t = a.x + a.y + a.z + a.w + b.x + b.y + b.z + b.w + c.x + c.y + c.z + c.w + d.x + d.y + d.z + d.w;
      sR[tid] = rsqrtf(t * (1.f / 1024.f) + 1e-6f);
    }
    f32x4 acc[2][2][4][2];
    gemm256(wv0, acc, X1B + (size_t)brow * 1024, 1024, (const u16*)(p->ws + OFF_WUPT) + (size_t)bcol * 1024, 1024, 1024, smem);
    epi256(wv0, acc, brow, bcol, [&](int ai, int bj, int m, int n, int row, int col0, f32x4& v) {
      const float ri = sR[row - brow];
      const float a0 = fmaxf(v[0] * ri, 0.f), a1 = fmaxf(v[1] * ri, 0.f), a2 = fmaxf(v[2] * ri, 0.f), a3 = fmaxf(v[3] * ri, 0.f);
      *(uint2*)(ACT + (size_t)row * 4096 + col0) = pk4(a0 * a0, a1 * a1, a2 * a2, a3 * a3);
    });
    __syncthreads();
  }
}
DI void phaseI(int wv0, PP p, unsigned char* smem) {
  const u16* ACT = (const u16*)(p->ws + OFF_ACT);
  float* SS2 = (float*)(p->ws + OFF_SS2);
  for (int id = blockIdx.x; id < 128 * 4; id += gridDim.x) {
    int pm, pn;
    tile_map_n4(id, pm, pn);
    const int brow = pm * 256, bcol = pn * 256;
    f32x4 acc[2][2][4][2];
    gemm256(wv0, acc, ACT + (size_t)brow * 4096, 4096, (const u16*)(p->ws + OFF_WDT) + (size_t)bcol * 4096, 4096, 4096, smem);
    epi256(wv0, acc, brow, bcol, [&](int ai, int bj, int m, int n, int row, int col0, f32x4& v) {
      const size_t o = (size_t)row * 1024 + col0;
      const float4 xv = *(const float4*)(p->out + o);
      v[0] += xv.x; v[1] += xv.y; v[2] += xv.z; v[3] += xv.w;
      *(float4*)(p->out + o) = make_float4(v[0], v[1], v[2], v[3]);
    });
    ss_partial(wv0, acc, SS2, brow, pn);
  }
}
DI void phaseJ(int wv0, PP p) {
  const int lane = my_tid(wv0) & 63;
  const float* SS2 = (const float*)(p->ws + OFF_SS2);
  for (int row = blockIdx.x * 8 + wv0; row < T_; row += gridDim.x * 8) {
    float t = (lane < 16) ? SS2[(size_t)row * 16 + lane] : 0.f;
    t = wave_sum(t);
    const float rinv = rsqrtf(t * (1.f / 1024.f) + 1e-6f);
    float4* xr = (float4*)(p->out + (size_t)row * 1024);
#pragma unroll
    for (int r = 0; r < 4; ++r) {
      float4 v = xr[lane + 64 * r];
      const float4 g = ((const float4*)p->g3)[lane + 64 * r];
      v.x *= rinv * g.x; v.y *= rinv * g.y; v.z *= rinv * g.z; v.w *= rinv * g.w;
      xr[lane + 64 * r] = v;
    }
  }
}


#define XB_TMO      128
#define XB_XCNT(j)  (256  + 64 * (j))
#define XB_XSUB(j)  (1280 + 64 * (j))
#define XB_XGEN(j)  (2304 + 64 * (j))
#define XB_TOP      3328
#define XB_TOPGEN   3392
#define XB_SPIN_CAP (1u << 18)
#define LAS __attribute__((address_space(3)))
DI unsigned xb_ld(unsigned* p) { return __hip_atomic_load(p, __ATOMIC_RELAXED, __HIP_MEMORY_SCOPE_AGENT); }
DI unsigned xb_add(unsigned* p, unsigned v) { return __hip_atomic_fetch_add(p, v, __ATOMIC_RELAXED, __HIP_MEMORY_SCOPE_AGENT); }
DI unsigned xb_xcc_id() { return (unsigned)__builtin_amdgcn_s_getreg((3 << 11) | 20) & 0xFu; }
#define XB_SPIN(cond, bar) do { unsigned _sp = 0; while (cond) { __builtin_amdgcn_s_sleep(1); \
    if ((++_sp & 255u) == 0u) { if (xb_ld(&(bar)[XB_TMO])) break; if (_sp > XB_SPIN_CAP) { atomicAdd(&(bar)[XB_TMO], 1u); break; } } } } while (0)
DI void xcd_barrier_complete(unsigned* bar, unsigned x, unsigned& nloc, unsigned& nx) {
  const unsigned G = gridDim.x * gridDim.y * gridDim.z;
  unsigned sum, cnt, mine, sp = 0u;
  for (;;) {
    sum = 0u; cnt = 0u; mine = 0u;
#pragma unroll
    for (unsigned j = 0; j < 16; ++j) { const unsigned c = xb_ld(&bar[XB_XCNT(j)]); sum += c; cnt += (c > 0u) ? 1u : 0u; mine = (j == x) ? c : mine; }
    if (sum == G) break;
    __builtin_amdgcn_s_sleep(1);
    if ((++sp & 255u) == 0u) { if (xb_ld(&bar[XB_TMO])) break; if (sp > XB_SPIN_CAP) { atomicAdd(&bar[XB_TMO], 1u); break; } }
  }
  nloc = mine > 0u ? mine : 1u; nx = cnt > 0u ? cnt : 1u;
}
DI void xcd_barrier(unsigned* bar, volatile LAS unsigned* st, bool leader) {
  asm volatile("s_waitcnt vmcnt(0)" ::: "memory");
  __syncthreads();
  if (leader) {
    const unsigned x = xb_xcc_id();
    __builtin_amdgcn_s_waitcnt(0);
    unsigned nloc = st[0], nx = st[1];
    if (nloc == 0u) { xcd_barrier_complete(bar, x, nloc, nx); st[0] = nloc; st[1] = nx; }
    const unsigned old = xb_add(&bar[XB_XSUB(x)], 1u);
    const unsigned gen = old / nloc;
    if (old + 1u == (gen + 1u) * nloc) {
      __builtin_amdgcn_fence(__ATOMIC_RELEASE, "agent");
      asm volatile("s_waitcnt vmcnt(0)" ::: "memory");
      const unsigned og = xb_add(&bar[XB_TOP], 1u);
      const unsigned tg = og / nx;
      if (og + 1u == (tg + 1u) * nx) xb_add(&bar[XB_TOPGEN], 1u);
      else XB_SPIN(xb_ld(&bar[XB_TOPGEN]) == tg, bar);
      __builtin_amdgcn_fence(__ATOMIC_ACQUIRE, "agent");
      xb_add(&bar[XB_XGEN(x)], 1u);
      asm volatile("s_waitcnt vmcnt(0)" ::: "memory");
    } else {
      XB_SPIN(xb_ld(&bar[XB_XGEN(x)]) == gen, bar);
      __builtin_amdgcn_fence(__ATOMIC_ACQUIRE, "agent");
      asm volatile("s_waitcnt vmcnt(0)" ::: "memory");
    }
  }
  __syncthreads();
}

__global__ void __launch_bounds__(512, 2) mega(Params p) {
  extern __shared__ __attribute__((aligned(16))) unsigned char smem[];
  const int wv0 = __builtin_amdgcn_readfirstlane((int)(threadIdx.x >> 6));
  const int lo = p.lo, hi = p.hi;
  PP kp0 = (PP)__builtin_amdgcn_kernarg_segment_ptr();
  __shared__ uint4 xb_words;
  if (threadIdx.x == 0) {
    xb_words = make_uint4(0u, 0u, 0u, 0u);
    (void)xb_add((unsigned*)(kp0->ws + OFF_BAR) + XB_XCNT(xb_xcc_id()), 1u);
  }
  __syncthreads();
#define PH(N, CALL)                                  \
  if (lo <= N && N < hi) {                           \
    PP kp = kp0;                                     \
    asm volatile("" : "+s"(kp));                     \
    if (N > lo) {                                    \
      if (N == 1) cg::this_grid().sync();            \
      else xcd_barrier((unsigned*)(kp->ws + OFF_BAR), (volatile LAS unsigned*)&xb_words, my_tid(wv0) == 0); \
    }                                                \
    CALL;                                            \
    if ((PROBE_MASK >> N) & 1) { CALL; }             \
  }
  PH(0, phaseA(wv0, kp, smem))
  PH(1, phaseB(wv0, kp, smem))
  PH(2, phaseC(wv0, kp, smem))
  PH(3, phaseD1(wv0, kp, smem))
  PH(4, phaseD(wv0, kp, smem))
  PH(5, phaseE(wv0, kp, smem, 0))
  PH(6, phaseF(wv0, kp, smem))
  PH(7, phaseG(wv0, kp, smem))
  PH(8, phaseH(wv0, kp, smem))
  PH(9, phaseI(wv0, kp, smem))
  PH(10, phaseJ(wv0, kp))
}

extern "C" void kernel_launch(void* const* d_in, const int* in_sizes, int n_in, void* d_out, int out_size, void* d_ws,
                              size_t ws_size, hipStream_t stream) {
  static int grid_blocks = 0;
  if (!grid_blocks) {
    int dev = 0, cus = 0, per_cu = 0;
    (void)hipGetDevice(&dev);
    (void)hipDeviceGetAttribute(&cus, hipDeviceAttributeMultiprocessorCount, dev);
    (void)hipFuncSetAttribute((const void*)mega, hipFuncAttributeMaxDynamicSharedMemorySize, SMEM_BYTES);
    (void)hipOccupancyMaxActiveBlocksPerMultiprocessor(&per_cu, mega, NT_, SMEM_BYTES);
    if (per_cu > 1) per_cu = 1;
    if (per_cu < 1) per_cu = 1;
    grid_blocks = cus * per_cu;
  }
  if (ws_size < WS_NEED) { fprintf(stderr, "workspace too small: %zu < %zu\n", ws_size, (size_t)WS_NEED); }
  Params p{};
  const float** f = (const float**)&p;
  for (int i = 0; i < 24; ++i) f[i] = (const float*)d_in[i];
  p.out = (float*)d_out;
  p.ws = (unsigned char*)d_ws;
  p.lo = 0; p.hi = 11;
  (void)hipMemsetAsync((unsigned char*)d_ws + OFF_BAR, 0, 16384, stream);
  void* args[] = {&p};
  hipError_t e = hipLaunchCooperativeKernel((void*)mega, dim3(grid_blocks), dim3(NT_), args, SMEM_BYTES, stream);
  if (e != hipSuccess) fprintf(stderr, "cooperative launch failed: %s (grid %d)\n", hipGetErrorString(e), grid_blocks);
}
```

```cpp
#include <hip/hip_runtime.h>
#include <hip/hip_cooperative_groups.h>
#include <cstdio>
namespace cg = cooperative_groups;

#ifndef PROBE_MASK
#define PROBE_MASK 0
#endif

#define DI __device__ __forceinline__
typedef unsigned short u16;
typedef unsigned long long u64;
using bf16x8 = __attribute__((ext_vector_type(8))) short;
using f32x4 = __attribute__((ext_vector_type(4))) float;
using u32x4 = __attribute__((ext_vector_type(4))) unsigned;

constexpr int B_ = 4, S_ = 8192, T_ = B_ * S_;
constexpr int NT_ = 512;
constexpr int NINP = 4096;
constexpr float QSCALE = 0.125f * 1.44269504089f;

constexpr size_t MB = 1024 * 1024;
constexpr size_t OFF_WINT = 0;
constexpr size_t OFF_W1KT = OFF_WINT + (size_t)NINP * 1024 * 2;
constexpr size_t OFF_W1VT = OFF_W1KT + 256 * 2048 * 2;
constexpr size_t OFF_W2KT = OFF_W1VT + 256 * 2048 * 2;
constexpr size_t OFF_W2VT = OFF_W2KT + 256 * 256 * 2;
constexpr size_t OFF_WAT = OFF_W2VT + 256 * 256 * 2;
constexpr size_t OFF_WVT = OFF_WAT + 1024 * 512 * 2;
constexpr size_t OFF_WGT = OFF_WVT + 1024 * 512 * 2;
constexpr size_t OFF_WOT = OFF_WGT + 1024 * 512 * 2;
constexpr size_t OFF_WUPT = OFF_WOT + 1024 * 1024 * 2;
constexpr size_t OFF_WDT = OFF_WUPT + 4096 * 1024 * 2;
constexpr size_t OFF_ROPE = OFF_WDT + 4096 * 1024 * 2;
constexpr size_t OFF_CBP = OFF_ROPE + 8192 * 16 * 4;
constexpr size_t OFF_CTR = OFF_CBP + 2 * 32 * 256 * 4;
constexpr size_t OFF_KMAX = OFF_CTR + 64;
constexpr size_t OFF_BAR = OFF_CTR + 256;
constexpr size_t OFF_SS1 = OFF_BAR + 16384;
constexpr size_t OFF_SS2 = OFF_SS1 + (size_t)T_ * 16 * 4;
constexpr size_t OFF_NG = OFF_SS2 + (size_t)T_ * 16 * 4;
constexpr size_t OFF_HC = OFF_NG + (size_t)T_ * 24 * 4;
constexpr size_t OFF_KCC = OFF_HC + 2 * 4096 * 256 * 2;
constexpr size_t OFF_VCT = OFF_KCC + 8 * 512 * 64 * 2;
constexpr size_t OFF_HLOC = OFF_VCT + 8 * 512 * 64 * 2;
constexpr size_t OFF_ARENA = OFF_HLOC + (size_t)4 * 128 * 32 * 64 * 8;
constexpr size_t OFF_MG = OFF_ARENA;
constexpr size_t OFF_HN = OFF_ARENA + 128 * MB;
constexpr size_t OFF_QRAW = OFF_ARENA + 192 * MB;
constexpr size_t OFF_QROT = OFF_ARENA + 224 * MB;
constexpr size_t OFF_KCIN = OFF_ARENA + 256 * MB;
constexpr size_t OFF_VCIN = OFF_KCIN + 8 * MB;
constexpr size_t OFF_KS = OFF_VCIN + 8 * MB;
constexpr size_t OFF_VST = OFF_KS + 8 * MB;
constexpr size_t OFF_KW = OFF_VST + 8 * MB;
constexpr size_t OFF_VWT = OFF_KW + 8 * MB;
constexpr size_t OFF_U = OFF_ARENA + 304 * MB;
constexpr size_t OFF_NSA = OFF_ARENA + 336 * MB;
constexpr size_t OFF_YS = OFF_ARENA + 368 * MB;
constexpr size_t OFF_CPART = OFF_ARENA + 400 * MB;
constexpr size_t OFF_S5T = OFF_CPART + 32 * MB;
constexpr size_t OFF_S5L = OFF_S5T + 32 * 8192;
constexpr size_t WS_NEED = OFF_S5L + 32 * 64 * 8;
constexpr size_t OFF_ACT = OFF_ARENA;
constexpr size_t OFF_X1B = OFF_ARENA + 256 * MB;
constexpr size_t OFF_MERGED = OFF_HN;

constexpr int SMEM_BYTES = 131072 + 1024;

struct Params {
  const float *x, *g1, *w_in, *pe, *kw1, *kw2, *vw1, *vw2, *lam_re, *lam_im, *log_step, *b_re, *b_im, *c_re, *c_im, *dsk,
      *w_attn, *w_val, *w_gate, *w_out, *g2, *w_up, *w_down, *g3;
  float* out;
  unsigned char* ws;
  int lo, hi;
};

typedef const __attribute__((address_space(4))) Params* PP;

DI int my_tid(int wv0) {
  int t = wv0 * 64 + (int)__lane_id();
  asm volatile("" : "+v"(t));
  return t;
}
DI unsigned pk2(float a, float b);
DI u16 f2bf(float x) { return (u16)(pk2(x, 0.f) & 0xffffu); }
DI float bf2f(u16 h) { return __uint_as_float(((unsigned)h) << 16); }
typedef float f32x2_t __attribute__((ext_vector_type(2)));
typedef __bf16 bf16x2_t __attribute__((ext_vector_type(2)));
DI unsigned pk2(float a, float b) {
  const f32x2_t v = {a, b};
  return __builtin_bit_cast(unsigned, __builtin_convertvector(v, bf16x2_t));
}
DI uint2 pk4(float a, float b, float c, float d) { uint2 o; o.x = pk2(a, b); o.y = pk2(c, d); return o; }
DI float sigmoidf_(float x) { return 1.f / (1.f + __expf(-x)); }
DI float gelu_t(float x) {
  float u = 0.7978845608f * (x + 0.044715f * x * x * x);
  float e = __expf(2.f * u);
  float th = 1.f - 2.f / (e + 1.f);
  return 0.5f * x * (1.f + th);
}
DI float wave_sum(float v) {
#pragma unroll
  for (int o = 32; o > 0; o >>= 1) v += __shfl_xor(v, o);
  return v;
}
DI f32x4 mfma16(bf16x8 a, bf16x8 b, f32x4 c) { return __builtin_amdgcn_mfma_f32_16x16x32_bf16(a, b, c, 0, 0, 0); }

constexpr int G_HT = 128 * 64;
DI int lds_byte(int r, int c) {
  const int st = (r >> 4) * 2 + (c >> 5), rr = r & 15, cc = c & 31, ob = rr * 64 + cc * 2;
  return st * 1024 + (ob ^ (((ob >> 9) & 1) << 5));
}
DI void stage_rc(int b, int& R, int& C) {
  const int st = b / 1024, sb = b % 1024, swz = sb ^ (((sb >> 9) & 1) << 5);
  R = (st >> 1) * 16 + swz / 64;
  C = (st & 1) * 32 + (swz % 64) / 2;
}
typedef __attribute__((address_space(3))) unsigned* lds_u32p;
DI void gemm256(int wv0, f32x4 (&acc)[2][2][4][2], const u16* __restrict__ A, int lda, const u16* __restrict__ Bt, int ldb,
                int K, unsigned char* smem) {
  u16* shm = (u16*)smem;
  const int tid = my_tid(wv0), lane = tid & 63;
  const int wr = wv0 >> 2, wc = wv0 & 3, fr = lane & 15, fq = lane >> 4;
#define SA(b, h) (shm + ((b)*2 + (h)) * G_HT)
#define SB(b, h) (shm + (4 + (b)*2 + (h)) * G_HT)
  int sr0, sc0, sr1, sc1;
  stage_rc(tid * 16, sr0, sc0);
  stage_rc(tid * 16 + 8192, sr1, sc1);
  const u16* a0 = A + (size_t)sr0 * lda + sc0;
  const u16* a1 = A + (size_t)sr1 * lda + sc1;
  const u16* b0 = Bt + (size_t)sr0 * ldb + sc0;
  const u16* b1 = Bt + (size_t)sr1 * ldb + sc1;
#define STAGE_A(P, half, kt)                                                                                              \
  {                                                                                                                       \
    __builtin_amdgcn_global_load_lds((const unsigned*)(a0 + (size_t)((half)*128) * lda + (kt)*64),                        \
                                     (unsigned*)((char*)(P) + tid * 16), 16, 0, 0);                               \
    __builtin_amdgcn_global_load_lds((const unsigned*)(a1 + (size_t)((half)*128) * lda + (kt)*64),                        \
                                     (unsigned*)((char*)(P) + tid * 16 + 8192), 16, 0, 0);                        \
  }
#define STAGE_B(P, half, kt)                                                                                              \
  {                                                                                                                       \
    __builtin_amdgcn_global_load_lds((const unsigned*)(b0 + (size_t)((half)*128) * ldb + (kt)*64),                        \
                                     (unsigned*)((char*)(P) + tid * 16), 16, 0, 0);                               \
    __builtin_amdgcn_global_load_lds((const unsigned*)(b1 + (size_t)((half)*128) * ldb + (kt)*64),                        \
                                     (unsigned*)((char*)(P) + tid * 16 + 8192), 16, 0, 0);                        \
  }
#define LDA(dst, b, h)                                                                                                    \
  _Pragma("unroll") for (int m = 0; m < 4; ++m) _Pragma("unroll") for (int k = 0; k < 2; ++k)                             \
      dst[m][k] = *(const bf16x8*)((const unsigned char*)SA(b, h) + lds_byte(wr * 64 + m * 16 + fr, k * 32 + fq * 8));
#define LDB(dst, b, h)                                                                                                    \
  _Pragma("unroll") for (int n = 0; n < 2; ++n) _Pragma("unroll") for (int k = 0; k < 2; ++k)                             \
      dst[n][k] = *(const bf16x8*)((const unsigned char*)SB(b, h) + lds_byte(wc * 32 + n * 16 + fr, k * 32 + fq * 8));
#define MMA(ai, bj, At_, Bt_)                                                                                             \
  {                                                                                                                       \
    __builtin_amdgcn_s_setprio(1);                                                                                        \
    _Pragma("unroll") for (int m = 0; m < 4; ++m) _Pragma("unroll") for (int n = 0; n < 2; ++n)                           \
        _Pragma("unroll") for (int k = 0; k < 2; ++k) acc[ai][bj][m][n] =                                                 \
            __builtin_amdgcn_mfma_f32_16x16x32_bf16(Bt_[n][k], At_[m][k], acc[ai][bj][m][n], 0, 0, 0);                    \
    __builtin_amdgcn_s_setprio(0);                                                                                        \
  }
#define WAIT_V(n) asm volatile("s_waitcnt vmcnt(" #n ")" ::: "memory")
#define WAIT_L(n) asm volatile("s_waitcnt lgkmcnt(" #n ")" ::: "memory")
#define BAR __builtin_amdgcn_s_barrier()
#define SCHED __builtin_amdgcn_sched_barrier(0)
#pragma unroll
  for (int a = 0; a < 2; ++a)
#pragma unroll
    for (int b = 0; b < 2; ++b)
#pragma unroll
      for (int m = 0; m < 4; ++m)
#pragma unroll
        for (int n = 0; n < 2; ++n) acc[a][b][m][n] = f32x4{0.f, 0.f, 0.f, 0.f};
  bf16x8 At[4][2], B0[2][2], B1[2][2];
  const int nt = K / 64;
  WAIT_V(0);
  __syncthreads();
  STAGE_B(SB(0, 0), 0, 0) STAGE_A(SA(0, 0), 0, 0)
  STAGE_B(SB(0, 1), 1, 0) STAGE_A(SA(0, 1), 1, 0)
  if (wr == 1) BAR;
  WAIT_V(4); BAR;
  STAGE_B(SB(1, 0), 0, 1) STAGE_A(SA(1, 0), 0, 1) STAGE_B(SB(1, 1), 1, 1)
  WAIT_V(6); BAR;
#pragma unroll 1
  for (int t = 0; t < nt - 2; t += 2) {
    LDB(B0, 0, 0) SCHED; LDA(At, 0, 0) STAGE_A(SA(1, 1), 1, t + 1)
    WAIT_L(8); BAR; WAIT_L(0); MMA(0, 0, At, B0) BAR; SCHED;
    LDB(B1, 0, 1) STAGE_B(SB(0, 0), 0, t + 2)
    BAR; WAIT_L(0); MMA(0, 1, At, B1) BAR;
    LDA(At, 0, 1) STAGE_A(SA(0, 0), 0, t + 2)
    BAR; WAIT_L(0); MMA(1, 0, At, B0) BAR; SCHED;
    STAGE_B(SB(0, 1), 1, t + 2)
    WAIT_V(6); BAR; MMA(1, 1, At, B1) BAR;
    LDB(B0, 1, 0) SCHED; LDA(At, 1, 0) STAGE_A(SA(0, 1), 1, t + 2)
    WAIT_L(8); BAR; WAIT_L(0); MMA(0, 0, At, B0) BAR; SCHED;
    LDB(B1, 1, 1) STAGE_B(SB(1, 0), 0, t + 3)
    BAR; WAIT_L(0); MMA(0, 1, At, B1) BAR;
    LDA(At, 1, 1) STAGE_A(SA(1, 0), 0, t + 3)
    BAR; WAIT_L(0); MMA(1, 0, At, B0) BAR; SCHED;
    STAGE_B(SB(1, 1), 1, t + 3)
    WAIT_V(6); BAR; MMA(1, 1, At, B1) BAR;
  }
  {
    LDB(B0, 0, 0) LDA(At, 0, 0) STAGE_A(SA(1, 1), 1, nt - 1)
    BAR; WAIT_L(0); MMA(0, 0, At, B0) BAR;
    LDB(B1, 0, 1) BAR; WAIT_L(0); MMA(0, 1, At, B1) BAR;
    LDA(At, 0, 1) WAIT_V(4); BAR; WAIT_L(0); MMA(1, 0, At, B0) MMA(1, 1, At, B1) BAR;
  }
  {
    LDB(B0, 1, 0) LDA(At, 1, 0) WAIT_V(2); BAR; WAIT_L(0); MMA(0, 0, At, B0) BAR;
    LDB(B1, 1, 1) WAIT_V(0); BAR; WAIT_L(0); MMA(0, 1, At, B1) BAR;
    LDA(At, 1, 1) BAR; WAIT_L(0); MMA(1, 0, At, B0) MMA(1, 1, At, B1) BAR;
  }
  if (wr == 0) BAR;
}
DI void tile_map_n16(int id, int& pm, int& pn) {
  const int k = id & 255, rnd = id >> 8, x = k & 7, slot = k >> 3;
  pm = rnd * 16 + 4 * (x >> 1) + (slot >> 3);
  pn = 8 * (x & 1) + (slot & 7);
}
DI void tile_map_n4(int id, int& pm, int& pn) {
  const int k = id & 255, rnd = id >> 8, x = k & 7, slot = k >> 3;
  pm = rnd * 64 + 8 * x + (slot >> 2);
  pn = slot & 3;
}
template <class F>
DI void epi256(int wv0, f32x4 (&acc)[2][2][4][2], int brow, int bcol, F f) {
  const int lane = my_tid(wv0) & 63, wr = wv0 >> 2, wc = wv0 & 3;
#pragma unroll
  for (int ai = 0; ai < 2; ++ai)
#pragma unroll
    for (int bj = 0; bj < 2; ++bj)
#pragma unroll
      for (int m = 0; m < 4; ++m)
#pragma unroll
        for (int n = 0; n < 2; ++n) {
          const int row = brow + ai * 128 + wr * 64 + m * 16 + (lane & 15);
          const int col0 = bcol + bj * 128 + wc * 32 + n * 16 + (lane >> 4) * 4;
          f(ai, bj, m, n, row, col0, acc[ai][bj][m][n]);
          if (n == 1 && (m & 1)) __builtin_amdgcn_sched_barrier(0);
        }
}

constexpr int NXT_A = 1024 + 128 + 128 + 16 + 16;
constexpr int NXT = NXT_A + 128 * 3 + 256 + 1024 + 1024;
DI void xpose_tile(int wv0, PP p, int jt, unsigned char* smem) {
  const int tid = my_tid(wv0);
  float* tile = (float*)smem;
  int t = jt;
  const float* src;
  u16* dst;
  int K, Nsrc, mode = 0;
  const float* scl = nullptr;
  if (t < 1024) { src = p->w_in; dst = (u16*)(p->ws + OFF_WINT); K = 1024; Nsrc = 3864; mode = 1; }
  else if ((t -= 1024) < 128) { src = p->kw1; dst = (u16*)(p->ws + OFF_W1KT); K = 2048; Nsrc = 256; }
  else if ((t -= 128) < 128) { src = p->vw1; dst = (u16*)(p->ws + OFF_W1VT); K = 2048; Nsrc = 256; }
  else if ((t -= 128) < 16) { src = p->kw2; dst = (u16*)(p->ws + OFF_W2KT); K = 256; Nsrc = 64; mode = 2; }
  else if ((t -= 16) < 16) { src = p->vw2; dst = (u16*)(p->ws + OFF_W2VT); K = 256; Nsrc = 64; mode = 2; }
  else if ((t -= 16) < 128) { src = p->w_attn; dst = (u16*)(p->ws + OFF_WAT); K = 512; Nsrc = 1024; }
  else if ((t -= 128) < 128) { src = p->w_val; dst = (u16*)(p->ws + OFF_WVT); K = 512; Nsrc = 1024; }
  else if ((t -= 128) < 128) { src = p->w_gate; dst = (u16*)(p->ws + OFF_WGT); K = 512; Nsrc = 1024; }
  else if ((t -= 128) < 256) { src = p->w_out; dst = (u16*)(p->ws + OFF_WOT); K = 1024; Nsrc = 1024; }
  else if ((t -= 256) < 1024) { src = p->w_up; dst = (u16*)(p->ws + OFF_WUPT); K = 1024; Nsrc = 4096; scl = p->g2; }
  else { t -= 1024; src = p->w_down; dst = (u16*)(p->ws + OFF_WDT); K = 4096; Nsrc = 1024; }
  const int nkt = K >> 6, tn = t / nkt, tk = t % nkt, n0 = tn * 64, k0 = tk * 64;
  const int tx = tid & 63, ty = tid >> 6;
  const int np = n0 + tx;
  int sc = np;
  if (mode == 1) {
    if (np < 1280) sc = np;
    else if (np < 1792) sc = 1304 + (np - 1280);
    else if (np < 3840) sc = 1816 + (np - 1792);
    else if (np < 3864) sc = 1280 + (np - 3840);
    else sc = -1;
  } else if (mode == 2) {
    sc = np < 64 ? np : -1;
  }
  for (int kk = ty; kk < 64; kk += 8) {
    float val = 0.f;
    if (sc >= 0) val = src[(size_t)(k0 + kk) * Nsrc + sc];
    if (scl) val *= scl[k0 + kk];
    tile[kk * 65 + tx] = val;
  }
  __syncthreads();
  {
    const int n = tid >> 3, kc = tid & 7;
    uint4 o;
    o.x = pk2(tile[(kc * 8 + 0) * 65 + n], tile[(kc * 8 + 1) * 65 + n]);
    o.y = pk2(tile[(kc * 8 + 2) * 65 + n], tile[(kc * 8 + 3) * 65 + n]);
    o.z = pk2(tile[(kc * 8 + 4) * 65 + n], tile[(kc * 8 + 5) * 65 + n]);
    o.w = pk2(tile[(kc * 8 + 6) * 65 + n], tile[(kc * 8 + 7) * 65 + n]);
    *(uint4*)(dst + (size_t)(n0 + n) * K + k0 + kc * 8) = o;
  }
  __syncthreads();
}

DI void phaseA(int wv0, PP p, unsigned char* smem) {
  const int tid = my_tid(wv0), lane = tid & 63;
  u16* HN = (u16*)(p->ws + OFF_HN);
  for (int row = blockIdx.x * 8 + wv0; row < T_; row += gridDim.x * 8) {
    const float4* xr = (const float4*)(p->x + (size_t)row * 1024);
    float4 v[4];
    float ss = 0.f;
#pragma unroll
    for (int r = 0; r < 4; ++r) {
      v[r] = xr[lane + 64 * r];
      ss += v[r].x * v[r].x + v[r].y * v[r].y + v[r].z * v[r].z + v[r].w * v[r].w;
    }
    ss = wave_sum(ss);
    const float rinv = rsqrtf(ss * (1.f / 1024.f) + 1e-6f);
#pragma unroll
    for (int r = 0; r < 4; ++r) {
      const float4 g = ((const float4*)p->g1)[lane + 64 * r];
      uint2 o;
      o.x = pk2(v[r].x * rinv * g.x, v[r].y * rinv * g.y);
      o.y = pk2(v[r].z * rinv * g.z, v[r].w * rinv * g.w);
      *(uint2*)(HN + (size_t)row * 1024 + (lane + 64 * r) * 4) = o;
    }
  }
  for (int jt = blockIdx.x; jt < NXT_A + 32 + 32; jt += gridDim.x) {
    if (jt < NXT_A) {
      xpose_tile(wv0, p, jt, smem);
    } else if (jt >= NXT_A + 32) {
      const int g = jt - (NXT_A + 32);
      u16* TB = (u16*)(p->ws + OFF_S5T + (size_t)g * 8192);
      const float step = expf(p->log_step[g]);
      for (int e = tid; e < 2048; e += NT_) {
        const int np = e >> 4, c = e & 15, n = np & 63;
        const float lr = p->lam_re[g * 64 + n], li = p->lam_im[g * 64 + n];
        const float er = expf(lr * step);
        float sn, cs;
        sincosf(li * step, &sn, &cs);
        const float nr = er * cs - 1.f, ni = er * sn, den = lr * lr + li * li;
        const float cr = (nr * lr + ni * li) / den, ci = (ni * lr - nr * li) / den;
        const float bre = p->b_re[(g * 64 + n) * 16 + c], bim = p->b_im[(g * 64 + n) * 16 + c];
        TB[np * 16 + c] = f2bf(np < 64 ? (cr * bre - ci * bim) : (cr * bim + ci * bre));
        const int cc = e >> 7, k = e & 127;
        TB[2048 + cc * 128 + k] = f2bf(k < 64 ? p->c_re[(g * 16 + cc) * 64 + k] : -p->c_im[(g * 16 + cc) * 64 + (k - 64)]);
      }
      if (tid < 64) {
        const float lr = p->lam_re[g * 64 + tid], li = p->lam_im[g * 64 + tid];
        const float er = expf(lr * step);
        float sn, cs;
        sincosf(li * step, &sn, &cs);
        ((float2*)(p->ws + OFF_S5L))[g * 64 + tid] = make_float2(er * cs, er * sn);
      }
    } else {
      const int item = jt - NXT_A, kv = item >> 4, slice = item & 15;
      const float* w1 = kv ? p->vw1 : p->kw1;
      const int col = tid & 255, h = tid >> 8, kb = slice * 128 + h * 64;
      float s0 = 0.f, s1 = 0.f, s2 = 0.f, s3 = 0.f;
      for (int k = kb; k < kb + 64; k += 4) {
        s0 += p->pe[k] * w1[(size_t)k * 256 + col];
        s1 += p->pe[k + 1] * w1[(size_t)(k + 1) * 256 + col];
        s2 += p->pe[k + 2] * w1[(size_t)(k + 2) * 256 + col];
        s3 += p->pe[k + 3] * w1[(size_t)(k + 3) * 256 + col];
      }
      ((float*)(p->ws + OFF_CBP))[(kv * 32 + slice * 2 + h) * 256 + col] = (s0 + s1) + (s2 + s3);
    }
  }
  float* rope = (float*)(p->ws + OFF_ROPE);
  for (int i = blockIdx.x * NT_ + tid; i < S_ * 8; i += gridDim.x * NT_) {
    const int pos = i >> 3, k = i & 7;
    const float inv = powf(500000.0f, -(2.0f * (float)k) / 16.0f);
    const float ang = (float)pos * inv;
    rope[pos * 16 + k] = cosf(ang);
    rope[pos * 16 + 8 + k] = sinf(ang);
  }
  if (blockIdx.x == 0 && tid < 64) ((int*)(p->ws + OFF_CTR))[tid] = 0;
}

DI void phaseB(int wv0, PP p, unsigned char* smem) {
  const u16* HN = (const u16*)(p->ws + OFF_HN);
  const u16* WT = (const u16*)(p->ws + OFF_WINT);
  const float* rope = (const float*)(p->ws + OFF_ROPE);
  const int lane = my_tid(wv0) & 63;
  const bool ropewave = (wv0 & 1) == 0;
  for (int id = blockIdx.x; id < 128 * 16; id += gridDim.x) {
    int pm, pn;
    tile_map_n16(id, pm, pn);
    const int brow = pm * 256, bcol = pn * 256;
    f32x4 acc[2][2][4][2];
    gemm256(wv0, acc, HN + (size_t)brow * 1024, 1024, WT + (size_t)bcol * 1024, 1024, 1024, smem);
    if (pn < 2) {
      u16* QR = (u16*)(p->ws + OFF_QRAW);
      u16* QO = (u16*)(p->ws + OFF_QROT);
      epi256(wv0, acc, brow, bcol, [&](int ai, int bj, int m, int n, int row, int col0, f32x4& v) {
        f32x4 r = v;
        if (n == 0 && ropewave) {
          const int pos = row & (S_ - 1), kq = ((lane >> 4) & 1) * 4;
          const float4 c4 = *(const float4*)(rope + pos * 16 + kq), s4 = *(const float4*)(rope + pos * 16 + 8 + kq);
          const float cc[4] = {c4.x, c4.y, c4.z, c4.w}, ss[4] = {s4.x, s4.y, s4.z, s4.w};
#pragma unroll
          for (int j = 0; j < 4; ++j) {
            const float pr = __shfl_xor(v[j], 32);
            r[j] = (lane & 32) ? (v[j] * cc[j] + pr * ss[j]) : (v[j] * cc[j] - pr * ss[j]);
          }
        }
        *(uint2*)(QR + (size_t)row * 512 + col0) = pk4(v[0] * QSCALE, v[1] * QSCALE, v[2] * QSCALE, v[3] * QSCALE);
        *(uint2*)(QO + (size_t)row * 512 + col0) = pk4(r[0] * QSCALE, r[1] * QSCALE, r[2] * QSCALE, r[3] * QSCALE);
      });
    } else if (pn < 5) {
      epi256(wv0, acc, brow, bcol, [&](int ai, int bj, int m, int n, int row, int col0, f32x4& v) {
        const int sub = (pn - 2) * 2 + bj;
        const bool dorope = (sub == 2 || sub == 4), transposed = (sub == 3 || sub == 5);
        u16* dst = (u16*)(p->ws + OFF_KCIN + (size_t)sub * 8 * MB);
        const int c128 = col0 & 127, g = c128 >> 6, d0 = c128 & 63;
        const int b = row >> 13, sq = row & (S_ - 1);
        f32x4 r = v;
        if (dorope && n == 0 && ropewave) {
          const int kq = ((lane >> 4) & 1) * 4;
          const float4 c4 = *(const float4*)(rope + sq * 16 + kq), s4 = *(const float4*)(rope + sq * 16 + 8 + kq);
          const float cc[4] = {c4.x, c4.y, c4.z, c4.w}, ss[4] = {s4.x, s4.y, s4.z, s4.w};
#pragma unroll
          for (int j = 0; j < 4; ++j) {
            const float pr = __shfl_xor(v[j], 32);
            r[j] = (lane & 32) ? (v[j] * cc[j] + pr * ss[j]) : (v[j] * cc[j] - pr * ss[j]);
          }
        }
        if (transposed) {
#pragma unroll
          for (int j = 0; j < 4; ++j) dst[((size_t)((b * 2 + g) * 64 + d0 + j)) * S_ + sq] = f2bf(r[j]);
        } else {
          *(uint2*)(dst + ((size_t)(b * 2 + g) * S_ + sq) * 64 + d0) = pk4(r[0], r[1], r[2], r[3]);
        }
      });
    } else if (pn < 7) {
      u16* U = (u16*)(p->ws + OFF_U);
      epi256(wv0, acc, brow, bcol, [&](int ai, int bj, int m, int n, int row, int col0, f32x4& v) {
        *(uint2*)(U + (size_t)row * 512 + (col0 - 1280)) = pk4(v[0], v[1], v[2], v[3]);
      });
    } else if (pn < 15) {
      u16* MG = (u16*)(p->ws + OFF_MG);
      epi256(wv0, acc, brow, bcol, [&](int ai, int bj, int m, int n, int row, int col0, f32x4& v) {
        *(uint2*)(MG + (size_t)row * 2048 + (col0 - 1792)) = pk4(sigmoidf_(v[0]), sigmoidf_(v[1]), sigmoidf_(v[2]), sigmoidf_(v[3]));
      });
    } else {
      float* NG = (float*)(p->ws + OFF_NG);
      epi256(wv0, acc, brow, bcol, [&](int ai, int bj, int m, int n, int row, int col0, f32x4& v) {
        const int cc = col0 - 3840;
        if (cc < 24) *(float4*)(NG + (size_t)row * 24 + cc) = make_float4(sigmoidf_(v[0]), sigmoidf_(v[1]), sigmoidf_(v[2]), sigmoidf_(v[3]));
      });
    }
  }
}

template <bool OUT>
DI void s5_item(int wv0, PP p, int item, unsigned char* smem) {
  const int tid = my_tid(wv0), lane = tid & 63, fr = lane & 15, fq = lane >> 4;
  const int b = item >> 9, g = (item >> 4) & 31, c8 = item & 15, ch = c8 * 8 + wv0;
  u16* sBb = (u16*)smem;
  u16* sCm = sBb + 128 * 16;
  float* sBU = (float*)(smem + 8192) + wv0 * (16 * 132);
  u16* sH = (u16*)(smem + 8192 + 8 * 16 * 132 * 4) + wv0 * (16 * 136);
  *(uint4*)(smem + tid * 16) = *(const uint4*)(p->ws + OFF_S5T + (size_t)g * 8192 + tid * 16);
  const float2 lb = ((const float2*)(p->ws + OFF_S5L))[g * 64 + lane];
  const float lbr = lb.x, lbi = lb.y;
  float2* HL = (float2*)(p->ws + OFF_HLOC) + ((size_t)(b * 128 + ch) * 32 + g) * 64 + lane;
  float hr = 0.f, hi = 0.f;
  if (OUT) { const float2 h0 = *HL; hr = h0.x; hi = h0.y; }
  const u16* U = (const u16*)(p->ws + OFF_U) + ((size_t)(b * S_ + ch * 64)) * 512 + g * 16;
  u16* YS = (u16*)(p->ws + OFF_YS) + ((size_t)(b * S_ + ch * 64)) * 512 + g * 16;
  const float dk = p->dsk[g * 16 + fr];
  const bf16x8 zero8 = {0, 0, 0, 0, 0, 0, 0, 0};
  bf16x8 uall[4];
  u16 usk[4][4];
#pragma unroll
  for (int sub = 0; sub < 4; ++sub) {
    uall[sub] = fq < 2 ? *(const bf16x8*)(U + (size_t)(sub * 16 + fr) * 512 + 8 * fq) : zero8;
    if (OUT) {
#pragma unroll
      for (int j = 0; j < 4; ++j) usk[sub][j] = U[(size_t)(sub * 16 + 4 * fq + j) * 512 + fr];
    }
  }
  __syncthreads();
  bf16x8 bb[8], cf[4];
#pragma unroll
  for (int nt = 0; nt < 8; ++nt) bb[nt] = fq < 2 ? *(const bf16x8*)(sBb + (16 * nt + fr) * 16 + 8 * fq) : zero8;
  if (OUT) {
#pragma unroll
    for (int ks = 0; ks < 4; ++ks) cf[ks] = *(const bf16x8*)(sCm + fr * 128 + 32 * ks + 8 * fq);
  }
#pragma unroll
  for (int sub = 0; sub < 4; ++sub) {
    const bf16x8 ua = uall[sub];
#pragma unroll
    for (int nt = 0; nt < 8; ++nt) {
      const f32x4 a = mfma16(ua, bb[nt], f32x4{0.f, 0.f, 0.f, 0.f});
#pragma unroll
      for (int j = 0; j < 4; ++j) sBU[(4 * fq + j) * 132 + 16 * nt + fr] = a[j];
    }
    __syncthreads();
#pragma unroll 4
    for (int t = 0; t < 16; ++t) {
      const float bur = sBU[t * 132 + lane], bui = sBU[t * 132 + 64 + lane];
      const float nr = lbr * hr - lbi * hi + bur;
      const float nim = lbr * hi + lbi * hr + bui;
      hr = nr;
      hi = nim;
      if (OUT) {
        sH[t * 136 + lane] = f2bf(hr);
        sH[t * 136 + 64 + lane] = f2bf(hi);
      }
    }
    __syncthreads();
    if (OUT) {
      f32x4 y = {0.f, 0.f, 0.f, 0.f};
#pragma unroll
      for (int ks = 0; ks < 4; ++ks) y = mfma16(*(const bf16x8*)(sH + fr * 136 + 32 * ks + 8 * fq), cf[ks], y);
#pragma unroll
      for (int j = 0; j < 4; ++j) {
        const size_t o = (size_t)(sub * 16 + 4 * fq + j) * 512 + fr;
        YS[o] = f2bf(gelu_t(y[j] + dk * bf2f(usk[sub][j])));
      }
      __syncthreads();
    }
  }
  if (!OUT) *HL = make_float2(hr, hi);
  __syncthreads();
}
DI void s5_carry(int wv0, PP p) {
  const int x = blockIdx.x * NT_ + my_tid(wv0);
  if (x >= 8192) return;
  const int b = x >> 11, g = (x >> 6) & 31, n = x & 63;
  const float step = expf(p->log_step[g]);
  const float lr = p->lam_re[g * 64 + n], li = p->lam_im[g * 64 + n];
  const float er = expf(64.f * lr * step);
  float sn, cs;
  sincosf(64.f * li * step, &sn, &cs);
  const float Lr = er * cs, Li = er * sn;
  float2* HL = (float2*)(p->ws + OFF_HLOC) + (size_t)b * 128 * 2048 + g * 64 + n;
  float hr = 0.f, hi = 0.f;
  for (int c0 = 0; c0 < 128; c0 += 16) {
    float2 v[16];
#pragma unroll
    for (int k = 0; k < 16; ++k) v[k] = HL[(size_t)(c0 + k) * 2048];
#pragma unroll
    for (int k = 0; k < 16; ++k) {
      HL[(size_t)(c0 + k) * 2048] = make_float2(hr, hi);
      const float nr = Lr * hr - Li * hi + v[k].x;
      const float nim = Lr * hi + Li * hr + v[k].y;
      hr = nr;
      hi = nim;
    }
  }
}
DI void phaseC(int wv0, PP p, unsigned char* smem) {
  for (int id = blockIdx.x; id < 128 + 2048 + 256; id += gridDim.x) {
    if (id >= 128 + 2048) {
      const int it = id - (128 + 2048), tns = it >> 7, bg = (it >> 4) & 7, part = it & 15;
      const int tid = my_tid(wv0);
      const u16* K = (const u16*)(p->ws + (tns ? OFF_KW : OFF_KS)) + ((size_t)bg * S_ + part * 512 + tid) * 64;
      float q2 = 0.f;
#pragma unroll
      for (int c = 0; c < 8; ++c) {
        const uint4 w = *(const uint4*)(K + c * 8);
        const unsigned ww[4] = {w.x, w.y, w.z, w.w};
#pragma unroll
        for (int e = 0; e < 4; ++e) {
          const float a = __uint_as_float(ww[e] << 16), b2 = __uint_as_float(ww[e] & 0xffff0000u);
          q2 += a * a + b2 * b2;
        }
      }
#pragma unroll
      for (int o = 32; o > 0; o >>= 1) q2 = fmaxf(q2, __shfl_xor(q2, o));
      if ((tid & 63) == 0) atomicMax((unsigned*)(p->ws + OFF_KMAX) + tns * 8 + bg, __float_as_uint(q2));
    } else if (id < 128) {
      const int kv = id >> 6, pm = (id >> 2) & 15, ks = id & 3, brow = pm * 256;
      const u16* A = (const u16*)(p->ws + (kv ? OFF_VCIN : OFF_KCIN)) + (size_t)brow * 1024 + ks * 512;
      const u16* Bt = (const u16*)(p->ws + (kv ? OFF_W1VT : OFF_W1KT)) + ks * 512;
      f32x4 acc[2][2][4][2];
      gemm256(wv0, acc, A, 1024, Bt, 2048, 512, smem);
      float* PART = (float*)(p->ws + OFF_CPART) + (size_t)(ks * 2 + kv) * 4096 * 256;
      epi256(wv0, acc, brow, 0, [&](int ai, int bj, int m, int n, int row, int col0, f32x4& v) {
        *(float4*)(PART + (size_t)row * 256 + col0) = make_float4(v[0], v[1], v[2], v[3]);
      });
    } else {
      s5_item<false>(wv0, p, id - 128, smem);
    }
  }
}
DI void phaseD1(int wv0, PP p, unsigned char* smem) {
  const int tid = my_tid(wv0);
  float* sB = (float*)smem;
  {
    const float* cbp = (const float*)(p->ws + OFF_CBP);
    float bb = 0.f;
    for (int sl = 0; sl < 32; ++sl) bb += cbp[((tid >> 8) * 32 + sl) * 256 + (tid & 255)];
    sB[tid] = bb;
  }
  __syncthreads();
  const float* PART = (const float*)(p->ws + OFF_CPART);
  u16* HC = (u16*)(p->ws + OFF_HC);
  for (int e = blockIdx.x * NT_ + tid; e < 2 * 4096 * 64; e += gridDim.x * NT_) {
    const int kv = e >> 18, rc = e & 262143, c4 = (rc & 63) * 4;
    const size_t o = (size_t)kv * 4096 * 256 + (size_t)rc * 4;
    float4 a = *(const float4*)(PART + o);
#pragma unroll
    for (int ks = 1; ks < 4; ++ks) {
      const float4 t = *(const float4*)(PART + (size_t)ks * 2 * 4096 * 256 + o);
      a.x += t.x; a.y += t.y; a.z += t.z; a.w += t.w;
    }
    const float* bv = sB + kv * 256 + c4;
    *(uint2*)(HC + o) = pk4(gelu_t(a.x + bv[0]), gelu_t(a.y + bv[1]), gelu_t(a.z + bv[2]), gelu_t(a.w + bv[3]));
  }
}
DI void phaseD(int wv0, PP p, unsigned char* smem) {
  for (int id = blockIdx.x; id < 32; id += gridDim.x) {
    const int kv = id >> 4, pm = id & 15, brow = pm * 256;
    const u16* A = (const u16*)(p->ws + OFF_HC) + (size_t)kv * 4096 * 256 + (size_t)brow * 256;
    const u16* Bt = (const u16*)(p->ws + (kv ? OFF_W2VT : OFF_W2KT));
    f32x4 acc[2][2][4][2];
    gemm256(wv0, acc, A, 256, Bt, 256, 256, smem);
    u16* KCC = (u16*)(p->ws + OFF_KCC);
    u16* VCT = (u16*)(p->ws + OFF_VCT);
    epi256(wv0, acc, brow, 0, [&](int ai, int bj, int m, int n, int row, int col0, f32x4& v) {
      if (col0 < 64) {
        const int bg = row >> 9, nn = row & 511;
        f32x4 r = v;
        if (nn == 511) r = f32x4{0.f, 0.f, 0.f, 0.f};
        if (kv == 0) {
          *(uint2*)(KCC + ((size_t)bg * 512 + nn) * 64 + col0) = pk4(r[0], r[1], r[2], r[3]);
        } else {
#pragma unroll
          for (int j = 0; j < 4; ++j) VCT[((size_t)bg * 64 + col0 + j) * 512 + nn] = f2bf(r[j]);
        }
      }
    });
  }
  s5_carry(wv0, p);
}

DI bool bit128(u64 lo, u64 hi, int j) { return j < 64 ? ((lo >> j) & 1ull) : ((hi >> (j - 64)) & 1ull); }
DI int next_bit(u64 lo, u64 hi, int from) {
  if (from < 64) {
    const u64 x = (lo >> from) << from;
    if (x) return __ffsll((long long)x) - 1;
    from = 64;
  }
  if (from >= 128) return -1;
  const u64 y = (hi >> (from - 64)) << (from - 64);
  return y ? 63 + __ffsll((long long)y) : -1;
}

template <int MODE, bool MASKED, class MaskF>
DI void flash_tile(const u16* sK, const u16* sV, const bf16x8 (&qf)[2][2], f32x4 (&O)[2][4], float (&m)[2], float (&l)[2],
                   float (&ps)[4][4], MaskF ok, bool sel, int lane) {
  const int l15 = lane & 15, lg = lane >> 4;
  bf16x8 kf[4][2];
#pragma unroll
  for (int kt = 0; kt < 4; ++kt)
#pragma unroll
    for (int ks = 0; ks < 2; ++ks) kf[kt][ks] = *(const bf16x8*)(sK + (16 * kt + l15) * 72 + ks * 32 + lg * 8);
  if (MODE == 1) {
#pragma unroll
    for (int a = 0; a < 4; ++a)
#pragma unroll
      for (int b = 0; b < 4; ++b) ps[a][b] = 0.f;
  }
  union PFrag { unsigned u[4]; bf16x8 v; };
  PFrag pf[2][2];
#pragma unroll
  for (int qt = 0; qt < 2; ++qt) {
    f32x4 s[4];
    const float sinit = (MODE == 3) ? ((MASKED || sel) ? m[qt] : -1e30f) : 0.f;
#pragma unroll
    for (int kt = 0; kt < 4; ++kt) {
      s[kt] = f32x4{sinit, sinit, sinit, sinit};
#pragma unroll
      for (int ks = 0; ks < 2; ++ks) s[kt] = mfma16(kf[kt][ks], qf[qt][ks], s[kt]);
    }
    float pr[4][4];
    if (MODE == 3) {
      float rs = 0.f;
#pragma unroll
      for (int kt = 0; kt < 4; ++kt)
#pragma unroll
        for (int i = 0; i < 4; ++i) {
          float pv = __builtin_amdgcn_exp2f(s[kt][i]);
          if (MASKED) pv = ok(kt, i) ? pv : 0.f;
          pr[kt][i] = pv;
          rs += pv;
        }
      l[qt] += rs;
    } else {
    float mx = -1e30f;
#pragma unroll
    for (int kt = 0; kt < 4; ++kt)
#pragma unroll
      for (int i = 0; i < 4; ++i) {
        if (MASKED) s[kt][i] = ok(kt, i) ? s[kt][i] : -1e30f;
        mx = fmaxf(mx, s[kt][i]);
      }
    if (!MASKED) mx = sel ? mx : -1e30f;
    if (MODE == 1) {
      const float mm = m[qt], il = l[qt];
#pragma unroll
      for (int kt = 0; kt < 4; ++kt)
#pragma unroll
        for (int i = 0; i < 4; ++i) {
          const float pv = (s[kt][i] > -1e29f) ? __builtin_amdgcn_exp2f(s[kt][i] - mm) * il : 0.f;
          pr[kt][i] = pv;
          ps[kt][i] += pv;
        }
    } else {
      mx = fmaxf(mx, __shfl_xor(mx, 16));
      mx = fmaxf(mx, __shfl_xor(mx, 32));
      const float mnew = fmaxf(m[qt], mx);
      const float alpha = __builtin_amdgcn_exp2f(m[qt] - mnew);
      m[qt] = mnew;
      float rs = 0.f;
      if (MASKED) {
#pragma unroll
        for (int kt = 0; kt < 4; ++kt)
#pragma unroll
          for (int i = 0; i < 4; ++i) {
            const float pv = (s[kt][i] > -1e29f) ? __builtin_amdgcn_exp2f(s[kt][i] - mnew) : 0.f;
            pr[kt][i] = pv;
            rs += pv;
          }
      } else {
        const float me = sel ? mnew : 1e30f;
#pragma unroll
        for (int kt = 0; kt < 4; ++kt)
#pragma unroll
          for (int i = 0; i < 4; ++i) {
            const float pv = __builtin_amdgcn_exp2f(s[kt][i] - me);
            pr[kt][i] = pv;
            rs += pv;
          }
      }
      l[qt] = l[qt] * alpha + rs;
      if (MODE == 2) {
#pragma unroll
        for (int dt = 0; dt < 4; ++dt) O[qt][dt] *= alpha;
      }
    }
    }
    if (MODE != 0) {
#pragma unroll
      for (int ks2 = 0; ks2 < 2; ++ks2) {
        pf[qt][ks2].u[0] = pk2(pr[2 * ks2][0], pr[2 * ks2][1]);
        pf[qt][ks2].u[1] = pk2(pr[2 * ks2][2], pr[2 * ks2][3]);
        pf[qt][ks2].u[2] = pk2(pr[2 * ks2 + 1][0], pr[2 * ks2 + 1][1]);
        pf[qt][ks2].u[3] = pk2(pr[2 * ks2 + 1][2], pr[2 * ks2 + 1][3]);
      }
    }
  }
  if (MODE != 0) {
#pragma unroll
    for (int ks2 = 0; ks2 < 2; ++ks2) {
#pragma unroll
      for (int dt = 0; dt < 4; ++dt) {
        union { uint2 h[2]; bf16x8 v; } vf;
        vf.h[0] = *(const uint2*)(sV + (16 * dt + l15) * 72 + 32 * ks2 + 4 * lg);
        vf.h[1] = *(const uint2*)(sV + (16 * dt + l15) * 72 + 32 * ks2 + 16 + 4 * lg);
        O[0][dt] = mfma16(vf.v, pf[0][ks2].v, O[0][dt]);
        O[1][dt] = mfma16(vf.v, pf[1][ks2].v, O[1][dt]);
      }
    }
  }
}

DI void flash_s3(const u16* sK, const bf16x8 (&qf)[2][2], float si0, float si1, f32x4 (&s)[2][4], int lane) {
  const int l15 = lane & 15, lg = lane >> 4;
  bf16x8 kf[4][2];
#pragma unroll
  for (int kt = 0; kt < 4; ++kt)
#pragma unroll
    for (int ks = 0; ks < 2; ++ks) kf[kt][ks] = *(const bf16x8*)(sK + (16 * kt + l15) * 72 + ks * 32 + lg * 8);
#pragma unroll
  for (int qt = 0; qt < 2; ++qt) {
    const float si = qt ? si1 : si0;
#pragma unroll
    for (int kt = 0; kt < 4; ++kt) {
      s[qt][kt] = f32x4{si, si, si, si};
#pragma unroll
      for (int ks = 0; ks < 2; ++ks) s[qt][kt] = mfma16(kf[kt][ks], qf[qt][ks], s[qt][kt]);
    }
  }
}
template <bool MASKED, class MaskF>
DI void flash_pv3(const u16* sV, const f32x4 (&s)[2][4], f32x4 (&O)[2][4], float (&l)[2], MaskF ok, int lane) {
  const int l15 = lane & 15, lg = lane >> 4;
  union PFrag { unsigned u[4]; bf16x8 v; };
  PFrag pf[2][2];
#pragma unroll
  for (int qt = 0; qt < 2; ++qt) {
    float pr[4][4];
    float rs = 0.f;
#pragma unroll
    for (int kt = 0; kt < 4; ++kt)
#pragma unroll
      for (int i = 0; i < 4; ++i) {
        float pv = __builtin_amdgcn_exp2f(s[qt][kt][i]);
        if (MASKED) pv = ok(kt, i) ? pv : 0.f;
        pr[kt][i] = pv;
        rs += pv;
      }
    l[qt] += rs;
#pragma unroll
    for (int ks2 = 0; ks2 < 2; ++ks2) {
      pf[qt][ks2].u[0] = pk2(pr[2 * ks2][0], pr[2 * ks2][1]);
      pf[qt][ks2].u[1] = pk2(pr[2 * ks2][2], pr[2 * ks2][3]);
      pf[qt][ks2].u[2] = pk2(pr[2 * ks2 + 1][0], pr[2 * ks2 + 1][1]);
      pf[qt][ks2].u[3] = pk2(pr[2 * ks2 + 1][2], pr[2 * ks2 + 1][3]);
    }
  }
#pragma unroll
  for (int ks2 = 0; ks2 < 2; ++ks2) {
#pragma unroll
    for (int dt = 0; dt < 4; ++dt) {
      union { uint2 h[2]; bf16x8 v; } vf;
      vf.h[0] = *(const uint2*)(sV + (16 * dt + l15) * 72 + 32 * ks2 + 4 * lg);
      vf.h[1] = *(const uint2*)(sV + (16 * dt + l15) * 72 + 32 * ks2 + 16 + 4 * lg);
      O[0][dt] = mfma16(vf.v, pf[0][ks2].v, O[0][dt]);
      O[1][dt] = mfma16(vf.v, pf[1][ks2].v, O[1][dt]);
    }
  }
}

DI void nsa_item(int wv0, PP p, int item, unsigned char* smem) {
  const int tid = my_tid(wv0), lane = tid & 63, wv = wv0 & 3, hp = wv0 >> 2, l15 = lane & 15, lg = lane >> 4;
  const int i = 127 - (item >> 3), bg = item & 7, b = bg >> 1, g = bg & 1;
  u16* sK = (u16*)smem;
  u16* sV = sK + 64 * 72;
  float* sImp0 = (float*)(smem + 55296);
  float* sImp = sImp0 + hp * (64 * 132);
  u64* sUni = (u64*)(smem + 55296 + 2 * 64 * 132 * 4);
  u64* sSel = sUni + 16;
  const int t0 = i * 64, qloc = 16 * wv + l15, tq = t0 + qloc;
  const unsigned tokq = (unsigned)(b * S_ + tq);
  const float* NGb = (const float*)(p->ws + OFF_NG);
  const unsigned ngoff = tokq * 24 + g * 12 + hp * 6;
  float* ACCb = p->out;
  const unsigned aoff = tokq * 512 + g * 256 + hp * 128 + 4 * lg;
  const unsigned qoff = tokq * 512 + g * 256 + hp * 128 + lg * 8;
  const int lrow = tid >> 3, lpart = tid & 7;
  const unsigned koff = (lrow * 64 + lpart * 8) * 2, voffc = (lrow * 512 + lpart * 8) * 2, voffs = (lrow * S_ + lpart * 8) * 2;

  for (int e = tid; e < 2 * 64 * 132; e += NT_) sImp0[e] = 0.f;

  bf16x8 qf[2][2];
  f32x4 O[2][4];
  float m[2], l[2], ps[4][4];
  u32x4 pk0, pv0;
  auto nomask = [](int, int) { return true; };

#define MAKE_RSRC(PTR) __builtin_amdgcn_make_buffer_rsrc((void*)(PTR), 0, 0x7fffffff, 0x00020000)
#define BLOAD(R, VO, SO) __builtin_amdgcn_raw_buffer_load_b128((R), (int)(VO), (int)(SO), 0)
#define ISSUE_TILE(RK, RV, T, LDV)                                                   \
  {                                                                                  \
    pk0 = BLOAD(RK, koff, (T)*8192);                                                 \
    pv0 = BLOAD(RV, ((LDV) == 512) ? voffc : voffs, (T)*128);                        \
  }
#define COMMIT_TILE()                                                                \
  {                                                                                  \
    *(u32x4*)(sK + lrow * 72 + lpart * 8) = pk0;                                     \
    *(u32x4*)(sV + lrow * 72 + lpart * 8) = pv0;                                     \
  }
#define COMMIT_BUF(BUF)                                                              \
  {                                                                                  \
    *(u32x4*)(sK + (BUF)*9216 + lrow * 72 + lpart * 8) = pk0;                        \
    *(u32x4*)(sV + (BUF)*9216 + lrow * 72 + lpart * 8) = pv0;                        \
  }
#define LOAD_Q(BASE)                                                                 \
  {                                                                                  \
    const u16* Q_ = (const u16*)(p->ws + (BASE));                                    \
    _Pragma("unroll") for (int qt = 0; qt < 2; ++qt)                                 \
      _Pragma("unroll") for (int ks = 0; ks < 2; ++ks)                               \
        qf[qt][ks] = *(const bf16x8*)(Q_ + (qoff + qt * 64 + ks * 32));             \
  }
#define RESET_STATE()                                                                \
  {                                                                                  \
    _Pragma("unroll") for (int qt = 0; qt < 2; ++qt) { m[qt] = -1e30f; l[qt] = 0.f; } \
    _Pragma("unroll") for (int a = 0; a < 2; ++a)                                    \
      _Pragma("unroll") for (int c = 0; c < 4; ++c) O[a][c] = f32x4{0.f, 0.f, 0.f, 0.f}; \
  }

  {
    const u16* Kc0 = (const u16*)(p->ws + OFF_KCC) + (size_t)bg * 512 * 64;
    const u16* Vc0 = (const u16*)(p->ws + OFF_VCT) + (size_t)bg * 64 * 512;
    const int nE = (4 * i + 3) < 511 ? (4 * i + 3) : 511;
    const int nkb = (nE + 63) >> 6;
    const __amdgpu_buffer_rsrc_t rK = MAKE_RSRC(Kc0), rV = MAKE_RSRC(Vc0);
    LOAD_Q(OFF_QRAW)
    RESET_STATE()
    ISSUE_TILE(rK, rV, 0, 512)
    for (int kb = 0; kb < nkb; ++kb) {
      __syncthreads();
      COMMIT_TILE()
      __syncthreads();
      if (kb + 1 < nkb) ISSUE_TILE(rK, rV, kb + 1, 512)
      auto ok = [&](int kt, int ii) { return 16 * (kb * 64 + 16 * kt + 4 * lg + ii) + 31 <= tq; };
      flash_tile<0, true>(sK, sV, qf, O, m, l, ps, ok, true, lane);
    }
#pragma unroll
    for (int qt = 0; qt < 2; ++qt) {
      float s = l[qt];
      s += __shfl_xor(s, 16);
      s += __shfl_xor(s, 32);
      l[qt] = s > 0.f ? 1.f / s : 0.f;
    }
    ISSUE_TILE(rK, rV, 0, 512)
    for (int kb = 0; kb < nkb; ++kb) {
      __syncthreads();
      COMMIT_TILE()
      __syncthreads();
      if (kb + 1 < nkb) ISSUE_TILE(rK, rV, kb + 1, 512)
      auto ok = [&](int kt, int ii) { return 16 * (kb * 64 + 16 * kt + 4 * lg + ii) + 31 <= tq; };
      flash_tile<1, true>(sK, sV, qf, O, m, l, ps, ok, true, lane);
#pragma unroll
      for (int kt = 0; kt < 4; ++kt) {
        const int j = kb * 16 + kt * 4 + lg;
        sImp[qloc * 132 + j] += ps[kt][0] + ps[kt][1] + ps[kt][2] + ps[kt][3];
      }
      __syncthreads();
#pragma unroll
      for (int kt = 0; kt < 4; ++kt) {
        const int j1 = kb * 16 + kt * 4 + lg + 1;
        if (j1 < 128) sImp[qloc * 132 + j1] += ps[kt][3];
      }
    }
#pragma unroll
    for (int qt = 0; qt < 2; ++qt) {
      const float gt = NGb[ngoff + qt * 3 + 0];
#pragma unroll
      for (int dt = 0; dt < 4; ++dt) {
        float4 o = make_float4(O[qt][dt][0] * gt, O[qt][dt][1] * gt, O[qt][dt][2] * gt, O[qt][dt][3] * gt);
        *(float4*)(ACCb + (aoff + qt * 64 + 16 * dt)) = o;
      }
    }
  }
  __syncthreads();
  u64 mlo = 0, mhi = 0, wlo = 0, whi = 0;
  if (i < 16) {
    mlo = (1ull << (i + 1)) - 1ull;
    wlo = mlo;
  } else {
    const bool v0 = lane <= i, v1 = (lane + 64) <= i;
    const bool f0 = (lane == 0) || (lane == i) || (lane == i - 1);
    const bool f1 = (lane + 64 == i) || (lane + 64 == i - 1);
    const u64 ltm = (1ull << lane) - 1ull;
    for (int qq = hp * 8; qq < hp * 8 + 8; ++qq) {
      const float* ir = sImp0 + (16 * wv + qq) * 132;
      const float i0 = ir[lane] + ir[64 * 132 + lane], i1 = ir[lane + 64] + ir[64 * 132 + lane + 64];
      const unsigned k0 = v0 ? __float_as_uint(i0 + (f0 ? 1000.f : 0.f)) : 0u;
      const unsigned k1 = v1 ? __float_as_uint(i1 + (f1 ? 1000.f : 0.f)) : 0u;
      unsigned T = 0;
      for (int bit = 30; bit >= 0; --bit) {
        const unsigned cand = T | (1u << bit);
        const int cnt = __popcll(__ballot(k0 >= cand)) + __popcll(__ballot(k1 >= cand));
        if (cnt >= 16) T = cand;
      }
      const bool g0 = k0 > T, g1 = k1 > T, e0 = k0 == T, e1 = k1 == T;
      const int need = 16 - (__popcll(__ballot(g0)) + __popcll(__ballot(g1)));
      const u64 be0 = __ballot(e0), be1 = __ballot(e1);
      const int r0 = __popcll(be0 & ltm), r1 = __popcll(be0) + __popcll(be1 & ltm);
      const u64 s0 = __ballot(v0 && (g0 || (e0 && r0 < need)));
      const u64 s1 = __ballot(v1 && (g1 || (e1 && r1 < need)));
      wlo |= s0;
      whi |= s1;
      if (lane == 0) { sSel[(16 * wv + qq) * 2] = s0; sSel[(16 * wv + qq) * 2 + 1] = s1; }
    }
  }
  if (lane == 0) { sUni[wv0 * 2] = wlo; sUni[wv0 * 2 + 1] = whi; }
  __syncthreads();
  if (i >= 16) { mlo = sSel[qloc * 2]; mhi = sSel[qloc * 2 + 1]; }
  wlo = sUni[wv * 2] | sUni[(wv + 4) * 2];
  whi = sUni[wv * 2 + 1] | sUni[(wv + 4) * 2 + 1];
  const u64 blo = sUni[0] | sUni[2] | sUni[4] | sUni[6] | sUni[8] | sUni[10] | sUni[12] | sUni[14];
  const u64 bhi = sUni[1] | sUni[3] | sUni[5] | sUni[7] | sUni[9] | sUni[11] | sUni[13] | sUni[15];

  LOAD_Q(OFF_QROT)
  float nb_s[2], nb_w[2];
  bool usefix;
  {
    const float* KM = (const float*)(p->ws + OFF_KMAX);
    const float kms = KM[bg], kmw = KM[8 + bg];
    float bmax = 0.f;
#pragma unroll
    for (int qt = 0; qt < 2; ++qt) {
      float q2 = 0.f;
#pragma unroll
      for (int ks = 0; ks < 2; ++ks)
#pragma unroll
        for (int e = 0; e < 8; ++e) {
          const float qv = __uint_as_float(((unsigned)(u16)qf[qt][ks][e]) << 16);
          q2 += qv * qv;
        }
      q2 += __shfl_xor(q2, 16);
      q2 += __shfl_xor(q2, 32);
      const float bs = sqrtf(q2 * kms) * 1.001f + 1e-3f, bw = sqrtf(q2 * kmw) * 1.001f + 1e-3f;
      nb_s[qt] = -bs;
      nb_w[qt] = -bw;
      bmax = fmaxf(bmax, fmaxf(bs, bw));
    }
    usefix = __ballot(bmax > 60.f) == 0ull;
  }
  RESET_STATE()
  if (usefix) { m[0] = nb_s[0]; m[1] = nb_s[1]; }
  {
    const __amdgpu_buffer_rsrc_t rK = MAKE_RSRC((const u16*)(p->ws + OFF_KS) + (size_t)bg * S_ * 64);
    const __amdgpu_buffer_rsrc_t rV = MAKE_RSRC((const u16*)(p->ws + OFF_VST) + (size_t)bg * 64 * S_);
    if (usefix) {
      int jc = next_bit(blo, bhi, 0);
      int j1 = next_bit(blo, bhi, jc + 1);
      ISSUE_TILE(rK, rV, jc, S_)
      COMMIT_BUF(0)
      if (j1 >= 0) {
        ISSUE_TILE(rK, rV, j1, S_)
        COMMIT_BUF(1)
      }
      __syncthreads();
      int j2 = j1 >= 0 ? next_bit(blo, bhi, j1 + 1) : -1;
      if (j2 >= 0) ISSUE_TILE(rK, rV, j2, S_)
      f32x4 sc_[2][4], sn_[2][4];
      {
        const bool selc = bit128(mlo, mhi, jc);
        flash_s3(sK, qf, (selc || jc == i) ? m[0] : -1e30f, (selc || jc == i) ? m[1] : -1e30f, sc_, lane);
      }
      int bc = 0;
      while (jc >= 0) {
        const int bn = bc == 2 ? 0 : bc + 1, bn2 = bn == 2 ? 0 : bn + 1;
        const bool needn = j1 >= 0 && bit128(wlo, whi, j1);
        if (needn) {
          const bool seln = bit128(mlo, mhi, j1);
          const bool on = seln || j1 == i;
          flash_s3(sK + bn * 9216, qf, on ? m[0] : -1e30f, on ? m[1] : -1e30f, sn_, lane);
        }
        if (bit128(wlo, whi, jc)) {
          if (jc == i) {
            const bool sel = bit128(mlo, mhi, jc);
            auto ok = [&](int kt, int ii) { return sel && (16 * kt + 4 * lg + ii) <= qloc; };
            flash_pv3<true>(sV + bc * 9216, sc_, O, l, ok, lane);
          } else {
            flash_pv3<false>(sV + bc * 9216, sc_, O, l, nomask, lane);
          }
        }
        if (j2 >= 0) COMMIT_BUF(bn2)
        __syncthreads();
        jc = j1;
        j1 = j2;
        bc = bn;
        if (j1 >= 0) {
          j2 = next_bit(blo, bhi, j1 + 1);
          if (j2 >= 0) ISSUE_TILE(rK, rV, j2, S_)
        } else {
          j2 = -1;
        }
#pragma unroll
        for (int a = 0; a < 2; ++a)
#pragma unroll
          for (int c = 0; c < 4; ++c) sc_[a][c] = sn_[a][c];
      }
    } else {
      int j = next_bit(blo, bhi, 0);
      ISSUE_TILE(rK, rV, j, S_)
      COMMIT_BUF(0)
      __syncthreads();
      int jn = next_bit(blo, bhi, j + 1);
      if (jn >= 0) ISSUE_TILE(rK, rV, jn, S_)
      int cur = 0;
      while (j >= 0) {
        const u16* cK = sK + cur * 9216;
        const u16* cV = sV + cur * 9216;
        if (bit128(wlo, whi, j)) {
          const bool sel = bit128(mlo, mhi, j);
          if (j == i) {
            auto ok = [&](int kt, int ii) { return sel && (16 * kt + 4 * lg + ii) <= qloc; };
            if (usefix) flash_tile<3, true>(cK, cV, qf, O, m, l, ps, ok, true, lane);
            else flash_tile<2, true>(cK, cV, qf, O, m, l, ps, ok, true, lane);
          } else {
            if (usefix) flash_tile<3, false>(cK, cV, qf, O, m, l, ps, nomask, sel, lane);
            else flash_tile<2, false>(cK, cV, qf, O, m, l, ps, nomask, sel, lane);
          }
        }
        cur ^= 1;
        if (jn >= 0) COMMIT_BUF(cur)
        __syncthreads();
        j = jn;
        if (j >= 0) {
          jn = next_bit(blo, bhi, j + 1);
          if (jn >= 0) ISSUE_TILE(rK, rV, jn, S_)
        }
      }
    }
  }
#pragma unroll
  for (int qt = 0; qt < 2; ++qt) {
    float s = l[qt];
    s += __shfl_xor(s, 16);
    s += __shfl_xor(s, 32);
    const float sc = NGb[ngoff + qt * 3 + 1] / s;
#pragma unroll
    for (int dt = 0; dt < 4; ++dt) {
      float4* a = (float4*)(ACCb + (aoff + qt * 64 + 16 * dt));
      float4 o = *a;
      o.x += O[qt][dt][0] * sc; o.y += O[qt][dt][1] * sc; o.z += O[qt][dt][2] * sc; o.w += O[qt][dt][3] * sc;
      *a = o;
    }
  }
  RESET_STATE()
  if (usefix) { m[0] = nb_w[0]; m[1] = nb_w[1]; }
  {
    const __amdgpu_buffer_rsrc_t rK = MAKE_RSRC((const u16*)(p->ws + OFF_KW) + (size_t)bg * S_ * 64);
    const __amdgpu_buffer_rsrc_t rV = MAKE_RSRC((const u16*)(p->ws + OFF_VWT) + (size_t)bg * 64 * S_);
    const int j0 = i >= 8 ? i - 8 : 0;
    ISSUE_TILE(rK, rV, j0, S_)
    COMMIT_BUF(0)
    __syncthreads();
    if (j0 + 1 <= i) ISSUE_TILE(rK, rV, j0 + 1, S_)
    int cur = 0;
    for (int j = j0; j <= i; ++j) {
      const u16* cK = sK + cur * 9216;
      const u16* cV = sV + cur * 9216;
      if (j == i || j == i - 8) {
        auto ok = [&](int kt, int ii) {
          const int kp = j * 64 + 16 * kt + 4 * lg + ii;
          return kp <= tq && kp > tq - 512;
        };
        if (usefix) flash_tile<3, true>(cK, cV, qf, O, m, l, ps, ok, true, lane);
        else flash_tile<2, true>(cK, cV, qf, O, m, l, ps, ok, true, lane);
      } else {
        if (usefix) flash_tile<3, false>(cK, cV, qf, O, m, l, ps, nomask, true, lane);
        else flash_tile<2, false>(cK, cV, qf, O, m, l, ps, nomask, true, lane);
      }
      cur ^= 1;
      if (j + 1 <= i) COMMIT_BUF(cur)
      __syncthreads();
      if (j + 2 <= i) ISSUE_TILE(rK, rV, j + 2, S_)
    }
  }
  u16* NSAb = (u16*)(p->ws + OFF_NSA);
#pragma unroll
  for (int qt = 0; qt < 2; ++qt) {
    float s = l[qt];
    s += __shfl_xor(s, 16);
    s += __shfl_xor(s, 32);
    const float sc = NGb[ngoff + qt * 3 + 2] / s;
#pragma unroll
    for (int dt = 0; dt < 4; ++dt) {
      const float4 a = *(const float4*)(ACCb + (aoff + qt * 64 + 16 * dt));
      uint2 o;
      o.x = pk2(a.x + O[qt][dt][0] * sc, a.y + O[qt][dt][1] * sc);
      o.y = pk2(a.z + O[qt][dt][2] * sc, a.w + O[qt][dt][3] * sc);
      *(uint2*)(NSAb + (aoff + qt * 64 + 16 * dt)) = o;
    }
  }
  __syncthreads();
}

DI void phaseE(int wv0, PP p, unsigned char* smem, int cidx) {
  __shared__ int s_item;
  int* ctr = (int*)(p->ws + OFF_CTR) + cidx;
  for (;;) {
    __syncthreads();
    if (my_tid(wv0) == 0) s_item = atomicAdd(ctr, 1);
    __syncthreads();
    const int item = s_item;
    if (item >= 1024 + 2048 + (NXT - NXT_A)) break;
    if (item < 1024) nsa_item(wv0, p, item, smem);
    else if (item < 1024 + 2048) s5_item<true>(wv0, p, item - 1024, smem);
    else xpose_tile(wv0, p, NXT_A + (item - 3072), smem);
  }
}

DI void phaseF(int wv0, PP p, unsigned char* smem) {
  const u16* YS = (const u16*)(p->ws + OFF_YS);
  const u16* NSA = (const u16*)(p->ws + OFF_NSA);
  const u16* MG = (const u16*)(p->ws + OFF_MG);
  u16* MR = (u16*)(p->ws + OFF_MERGED);
  for (int id = blockIdx.x; id < 128 * 4; id += gridDim.x) {
    int pm, pn;
    tile_map_n4(id, pm, pn);
    const int brow = pm * 256, bcol = pn * 256;
    f32x4 acc[2][2][4][2];
    gemm256(wv0, acc, YS + (size_t)brow * 512, 512, (const u16*)(p->ws + OFF_WGT) + (size_t)bcol * 512, 512, 512, smem);
    epi256(wv0, acc, brow, bcol, [&](int ai, int bj, int m, int n, int row, int col0, f32x4& v) {
      *(uint2*)(MR + (size_t)row * 1024 + col0) = pk4(sigmoidf_(v[0]), sigmoidf_(v[1]), sigmoidf_(v[2]), sigmoidf_(v[3]));
    });
    gemm256(wv0, acc, YS + (size_t)brow * 512, 512, (const u16*)(p->ws + OFF_WVT) + (size_t)bcol * 512, 512, 512, smem);
    epi256(wv0, acc, brow, bcol, [&](int ai, int bj, int m, int n, int row, int col0, f32x4& v) {
      const uint2 t = *(const uint2*)(MR + (size_t)row * 1024 + col0);
      const uint2 gq = *(const uint2*)(MG + (size_t)row * 2048 + 1024 + col0);
      *(uint2*)(MR + (size_t)row * 1024 + col0) =
          pk4(__uint_as_float(gq.x << 16) * v[0] * __uint_as_float(t.x << 16), __uint_as_float(gq.x & 0xffff0000u) * v[1] * __uint_as_float(t.x & 0xffff0000u),
              __uint_as_float(gq.y << 16) * v[2] * __uint_as_float(t.y << 16), __uint_as_float(gq.y & 0xffff0000u) * v[3] * __uint_as_float(t.y & 0xffff0000u));
    });
    gemm256(wv0, acc, NSA + (size_t)brow * 512, 512, (const u16*)(p->ws + OFF_WAT) + (size_t)bcol * 512, 512, 512, smem);
    epi256(wv0, acc, brow, bcol, [&](int ai, int bj, int m, int n, int row, int col0, f32x4& v) {
      const uint2 t = *(const uint2*)(MR + (size_t)row * 1024 + col0);
      const uint2 gq = *(const uint2*)(MG + (size_t)row * 2048 + col0);
      *(uint2*)(MR + (size_t)row * 1024 + col0) =
          pk4(__uint_as_float(gq.x << 16) * v[0] + __uint_as_float(t.x << 16), __uint_as_float(gq.x & 0xffff0000u) * v[1] + __uint_as_float(t.x & 0xffff0000u),
              __uint_as_float(gq.y << 16) * v[2] + __uint_as_float(t.y << 16), __uint_as_float(gq.y & 0xffff0000u) * v[3] + __uint_as_float(t.y & 0xffff0000u));
    });
  }
}
DI void ss_partial(int wv0, f32x4 (&acc)[2][2][4][2], float* SS, int brow, int pn) {
  const int lane = my_tid(wv0) & 63, wr = wv0 >> 2, wc = wv0 & 3;
#pragma unroll
  for (int ai = 0; ai < 2; ++ai)
#pragma unroll
    for (int m = 0; m < 4; ++m) {
      float s = 0.f;
#pragma unroll
      for (int bj = 0; bj < 2; ++bj)
#pragma unroll
        for (int n = 0; n < 2; ++n)
#pragma unroll
          for (int j = 0; j < 4; ++j) s += acc[ai][bj][m][n][j] * acc[ai][bj][m][n][j];
      s += __shfl_xor(s, 16);
      s += __shfl_xor(s, 32);
      if (lane < 16) SS[(size_t)(brow + ai * 128 + wr * 64 + m * 16 + lane) * 16 + pn * 4 + wc] = s;
    }
}
DI void phaseG(int wv0, PP p, unsigned char* smem) {
  const u16* MR = (const u16*)(p->ws + OFF_MERGED);
  u16* X1B = (u16*)(p->ws + OFF_X1B);
  float* SS1 = (float*)(p->ws + OFF_SS1);
  for (int id = blockIdx.x; id < 128 * 4; id += gridDim.x) {
    int pm, pn;
    tile_map_n4(id, pm, pn);
    const int brow = pm * 256, bcol = pn * 256;
    f32x4 acc[2][2][4][2];
    gemm256(wv0, acc, MR + (size_t)brow * 1024, 1024, (const u16*)(p->ws + OFF_WOT) + (size_t)bcol * 1024, 1024, 1024, smem);
    epi256(wv0, acc, brow, bcol, [&](int ai, int bj, int m, int n, int row, int col0, f32x4& v) {
      const size_t o = (size_t)row * 1024 + col0;
      const float4 xv = *(const float4*)(p->x + o);
      v[0] += xv.x; v[1] += xv.y; v[2] += xv.z; v[3] += xv.w;
      *(uint2*)(X1B + o) = pk4(v[0], v[1], v[2], v[3]);
    });
    ss_partial(wv0, acc, SS1, brow, pn);
  }
}
DI void phaseH(int wv0, PP p, unsigned char* smem) {
  const u16* X1B = (const u16*)(p->ws + OFF_X1B);
  const float* SS1 = (const float*)(p->ws + OFF_SS1);
  u16* ACT = (u16*)(p->ws + OFF_ACT);
  float* sR = (float*)(smem + 131072);
  for (int id = blockIdx.x; id < 128 * 16; id += gridDim.x) {
    int pm, pn;
    tile_map_n16(id, pm, pn);
    const int brow = pm * 256, bcol = pn * 256;
    const int tid = my_tid(wv0);
    if (tid < 256) {
      const float4* s = (const float4*)(SS1 + (size_t)(brow + tid) * 16);
      const float4 a = s[0], b = s[1], c = s[2], d = s[3];
      const float t = a.x + a.y + a.z + a.w + b.x + b.y + b.z + b.w + c.x + c.y + c.z + c.w + d.x + d.y + d.z + d.w;
      sR[tid] = rsqrtf(t * (1.f / 1024.f) + 1e-6f);
    }
    f32x4 acc[2][2][4][2];
    gemm256(wv0, acc, X1B + (size_t)brow * 1024, 1024, (const u16*)(p->ws + OFF_WUPT) + (size_t)bcol * 1024, 1024, 1024, smem);
    epi256(wv0, acc, brow, bcol, [&](int ai, int bj, int m, int n, int row, int col0, f32x4& v) {
      const float ri = sR[row - brow];
      const float a0 = fmaxf(v[0] * ri, 0.f), a1 = fmaxf(v[1] * ri, 0.f), a2 = fmaxf(v[2] * ri, 0.f), a3 = fmaxf(v[3] * ri, 0.f);
      *(uint2*)(ACT + (size_t)row * 4096 + col0) = pk4(a0 * a0, a1 * a1, a2 * a2, a3 * a3);
    });
    __syncthreads();
  }
}
DI void phaseI(int wv0, PP p, unsigned char* smem) {
  const u16* ACT = (const u16*)(p->ws + OFF_ACT);
  const u16* X1B = (const u16*)(p->ws + OFF_X1B);
  float* SS2 = (float*)(p->ws + OFF_SS2);
  for (int id = blockIdx.x; id < 128 * 4; id += gridDim.x) {
    int pm, pn;
    tile_map_n4(id, pm, pn);
    const int brow = pm * 256, bcol = pn * 256;
    f32x4 acc[2][2][4][2];
    gemm256(wv0, acc, ACT + (size_t)brow * 4096, 4096, (const u16*)(p->ws + OFF_WDT) + (size_t)bcol * 4096, 4096, 4096, smem);
    epi256(wv0, acc, brow, bcol, [&](int ai, int bj, int m, int n, int row, int col0, f32x4& v) {
      const size_t o = (size_t)row * 1024 + col0;
      const uint2 xb = *(const uint2*)(X1B + o);
      v[0] += __uint_as_float(xb.x << 16); v[1] += __uint_as_float(xb.x & 0xffff0000u);
      v[2] += __uint_as_float(xb.y << 16); v[3] += __uint_as_float(xb.y & 0xffff0000u);
      *(float4*)(p->out + o) = make_float4(v[0], v[1], v[2], v[3]);
    });
    ss_partial(wv0, acc, SS2, brow, pn);
  }
}
DI void phaseJ(int wv0, PP p) {
  const int lane = my_tid(wv0) & 63;
  const float* SS2 = (const float*)(p->ws + OFF_SS2);
  for (int row = blockIdx.x * 8 + wv0; row < T_; row += gridDim.x * 8) {
    float t = (lane < 16) ? SS2[(size_t)row * 16 + lane] : 0.f;
    t = wave_sum(t);
    const float rinv = rsqrtf(t * (1.f / 1024.f) + 1e-6f);
    float4* xr = (float4*)(p->out + (size_t)row * 1024);
#pragma unroll
    for (int r = 0; r < 4; ++r) {
      float4 v = xr[lane + 64 * r];
      const float4 g = ((const float4*)p->g3)[lane + 64 * r];
      v.x *= rinv * g.x; v.y *= rinv * g.y; v.z *= rinv * g.z; v.w *= rinv * g.w;
      xr[lane + 64 * r] = v;
    }
  }
}


#define XB_TMO      128
#define XB_XCNT(j)  (256  + 64 * (j))
#define XB_XSUB(j)  (1280 + 64 * (j))
#define XB_XGEN(j)  (2304 + 64 * (j))
#define XB_TOP      3328
#define XB_TOPGEN   3392
#define XB_SPIN_CAP (1u << 18)
#define LAS __attribute__((address_space(3)))
DI unsigned xb_ld(unsigned* p) { return __hip_atomic_load(p, __ATOMIC_RELAXED, __HIP_MEMORY_SCOPE_AGENT); }
DI unsigned xb_add(unsigned* p, unsigned v) { return __hip_atomic_fetch_add(p, v, __ATOMIC_RELAXED, __HIP_MEMORY_SCOPE_AGENT); }
DI unsigned xb_xcc_id() { return (unsigned)__builtin_amdgcn_s_getreg((3 << 11) | 20) & 0xFu; }
#define XB_SPIN(cond, bar) do { unsigned _sp = 0; while (cond) { __builtin_amdgcn_s_sleep(1); \
    if ((++_sp & 255u) == 0u) { if (xb_ld(&(bar)[XB_TMO])) break; if (_sp > XB_SPIN_CAP) { atomicAdd(&(bar)[XB_TMO], 1u); break; } } } } while (0)
DI void xcd_barrier_complete(unsigned* bar, unsigned x, unsigned& nloc, unsigned& nx) {
  const unsigned G = gridDim.x * gridDim.y * gridDim.z;
  unsigned sum, cnt, mine, sp = 0u;
  for (;;) {
    sum = 0u; cnt = 0u; mine = 0u;
#pragma unroll
    for (unsigned j = 0; j < 16; ++j) { const unsigned c = xb_ld(&bar[XB_XCNT(j)]); sum += c; cnt += (c > 0u) ? 1u : 0u; mine = (j == x) ? c : mine; }
    if (sum == G) break;
    __builtin_amdgcn_s_sleep(1);
    if ((++sp & 255u) == 0u) { if (xb_ld(&bar[XB_TMO])) break; if (sp > XB_SPIN_CAP) { atomicAdd(&bar[XB_TMO], 1u); break; } }
  }
  nloc = mine > 0u ? mine : 1u; nx = cnt > 0u ? cnt : 1u;
}
DI void xcd_barrier(unsigned* bar, volatile LAS unsigned* st, bool leader) {
  asm volatile("s_waitcnt vmcnt(0)" ::: "memory");
  __syncthreads();
  if (leader) {
    const unsigned x = xb_xcc_id();
    __builtin_amdgcn_s_waitcnt(0);
    unsigned nloc = st[0], nx = st[1];
    if (nloc == 0u) { xcd_barrier_complete(bar, x, nloc, nx); st[0] = nloc; st[1] = nx; }
    const unsigned old = xb_add(&bar[XB_XSUB(x)], 1u);
    const unsigned gen = old / nloc;
    if (old + 1u == (gen + 1u) * nloc) {
      __builtin_amdgcn_fence(__ATOMIC_RELEASE, "agent");
      asm volatile("s_waitcnt vmcnt(0)" ::: "memory");
      const unsigned og = xb_add(&bar[XB_TOP], 1u);
      const unsigned tg = og / nx;
      if (og + 1u == (tg + 1u) * nx) xb_add(&bar[XB_TOPGEN], 1u);
      else XB_SPIN(xb_ld(&bar[XB_TOPGEN]) == tg, bar);
      __builtin_amdgcn_fence(__ATOMIC_ACQUIRE, "agent");
      xb_add(&bar[XB_XGEN(x)], 1u);
      asm volatile("s_waitcnt vmcnt(0)" ::: "memory");
    } else {
      XB_SPIN(xb_ld(&bar[XB_XGEN(x)]) == gen, bar);
      __builtin_amdgcn_fence(__ATOMIC_ACQUIRE, "agent");
      asm volatile("s_waitcnt vmcnt(0)" ::: "memory");
    }
  }
  __syncthreads();
}

__global__ void __launch_bounds__(512, 2) mega(Params p) {
  extern __shared__ __attribute__((aligned(16))) unsigned char smem[];
  const int wv0 = __builtin_amdgcn_readfirstlane((int)(threadIdx.x >> 6));
  const int lo = p.lo, hi = p.hi;
  PP kp0 = (PP)__builtin_amdgcn_kernarg_segment_ptr();
  __shared__ uint4 xb_words;
  if (threadIdx.x == 0) {
    xb_words = make_uint4(0u, 0u, 0u, 0u);
    (void)xb_add((unsigned*)(kp0->ws + OFF_BAR) + XB_XCNT(xb_xcc_id()), 1u);
  }
  __syncthreads();
#define PH(N, CALL)                                  \
  if (lo <= N && N < hi) {                           \
    PP kp = kp0;                                     \
    asm volatile("" : "+s"(kp));                     \
    if (N > lo) {                                    \
      if (N == 1) cg::this_grid().sync();            \
      else xcd_barrier((unsigned*)(kp->ws + OFF_BAR), (volatile LAS unsigned*)&xb_words, my_tid(wv0) == 0); \
    }                                                \
    CALL;                                            \
    if ((PROBE_MASK >> N) & 1) { CALL; }             \
  }
  PH(0, phaseA(wv0, kp, smem))
  PH(1, phaseB(wv0, kp, smem))
  PH(2, phaseC(wv0, kp, smem))
  PH(3, phaseD1(wv0, kp, smem))
  PH(4, phaseD(wv0, kp, smem))
  PH(5, phaseE(wv0, kp, smem, 0))
  PH(6, phaseF(wv0, kp, smem))
  PH(7, phaseG(wv0, kp, smem))
  PH(8, phaseH(wv0, kp, smem))
  PH(9, phaseI(wv0, kp, smem))
  PH(10, phaseJ(wv0, kp))
}

extern "C" void kernel_launch(void* const* d_in, const int* in_sizes, int n_in, void* d_out, int out_size, void* d_ws,
                              size_t ws_size, hipStream_t stream) {
  static int grid_blocks = 0;
  if (!grid_blocks) {
    int dev = 0, cus = 0, per_cu = 0;
    (void)hipGetDevice(&dev);
    (void)hipDeviceGetAttribute(&cus, hipDeviceAttributeMultiprocessorCount, dev);
    (void)hipFuncSetAttribute((const void*)mega, hipFuncAttributeMaxDynamicSharedMemorySize, SMEM_BYTES);
    (void)hipOccupancyMaxActiveBlocksPerMultiprocessor(&per_cu, mega, NT_, SMEM_BYTES);
    if (per_cu > 1) per_cu = 1;
    if (per_cu < 1) per_cu = 1;
    grid_blocks = cus * per_cu;
  }
  if (ws_size < WS_NEED) { fprintf(stderr, "workspace too small: %zu < %zu\n", ws_size, (size_t)WS_NEED); }
  Params p{};
  const float** f = (const float**)&p;
  for (int i = 0; i < 24; ++i) f[i] = (const float*)d_in[i];
  p.out = (float*)d_out;
  p.ws = (unsigned char*)d_ws;
  p.lo = 0; p.hi = 11;
  (void)hipMemsetAsync((unsigned char*)d_ws + OFF_BAR, 0, 16384, stream);
  void* args[] = {&p};
  hipError_t e = hipLaunchCooperativeKernel((void*)mega, dim3(grid_blocks), dim3(NT_), args, SMEM_BYTES, stream);
  if (e != hipSuccess) fprintf(stderr, "cooperative launch failed: %s (grid %d)\n", hipGetErrorString(e), grid_blocks);
}
```

```cpp
#include <hip/hip_runtime.h>
#include <hip/hip_cooperative_groups.h>
#include <cstdio>
namespace cg = cooperative_groups;

#ifndef PROBE_MASK
#define PROBE_MASK 0
#endif

#define DI __device__ __forceinline__
typedef unsigned short u16;
typedef unsigned long long u64;
using bf16x8 = __attribute__((ext_vector_type(8))) short;
using f32x4 = __attribute__((ext_vector_type(4))) float;
using u32x4 = __attribute__((ext_vector_type(4))) unsigned;

constexpr int B_ = 4, S_ = 8192, T_ = B_ * S_;
constexpr int NT_ = 512;
constexpr int NINP = 4096;
constexpr float QSCALE = 0.125f * 1.44269504089f;

constexpr size_t MB = 1024 * 1024;
constexpr size_t OFF_WINT = 0;
constexpr size_t OFF_W1KT = OFF_WINT + (size_t)NINP * 1024 * 2;
constexpr size_t OFF_W1VT = OFF_W1KT + 256 * 2048 * 2;
constexpr size_t OFF_W2KT = OFF_W1VT + 256 * 2048 * 2;
constexpr size_t OFF_W2VT = OFF_W2KT + 256 * 256 * 2;
constexpr size_t OFF_WAT = OFF_W2VT + 256 * 256 * 2;
constexpr size_t OFF_WVT = OFF_WAT + 1024 * 512 * 2;
constexpr size_t OFF_WGT = OFF_WVT + 1024 * 512 * 2;
constexpr size_t OFF_WOT = OFF_WGT + 1024 * 512 * 2;
constexpr size_t OFF_WUPT = OFF_WOT + 1024 * 1024 * 2;
constexpr size_t OFF_WDT = OFF_WUPT + 4096 * 1024 * 2;
constexpr size_t OFF_ROPE = OFF_WDT + 4096 * 1024 * 2;
constexpr size_t OFF_CBP = OFF_ROPE + 8192 * 16 * 4;
constexpr size_t OFF_CTR = OFF_CBP + 2 * 32 * 256 * 4;
constexpr size_t OFF_KMAX = OFF_CTR + 64;
constexpr size_t OFF_BAR = OFF_CTR + 256;
constexpr size_t OFF_SS1 = OFF_BAR + 16384;
constexpr size_t OFF_SS2 = OFF_SS1 + (size_t)T_ * 16 * 4;
constexpr size_t OFF_NG = OFF_SS2 + (size_t)T_ * 16 * 4;
constexpr size_t OFF_HC = OFF_NG + (size_t)T_ * 24 * 4;
constexpr size_t OFF_KCC = OFF_HC + 2 * 4096 * 256 * 2;
constexpr size_t OFF_VCT = OFF_KCC + 8 * 512 * 64 * 2;
constexpr size_t OFF_HLOC = OFF_VCT + 8 * 512 * 64 * 2;
constexpr size_t OFF_ARENA = OFF_HLOC + (size_t)4 * 128 * 32 * 64 * 8;
constexpr size_t OFF_MG = OFF_ARENA;
constexpr size_t OFF_HN = OFF_ARENA + 128 * MB;
constexpr size_t OFF_QRAW = OFF_ARENA + 192 * MB;
constexpr size_t OFF_QROT = OFF_ARENA + 224 * MB;
constexpr size_t OFF_KCIN = OFF_ARENA + 256 * MB;
constexpr size_t OFF_VCIN = OFF_KCIN + 8 * MB;
constexpr size_t OFF_KS = OFF_VCIN + 8 * MB;
constexpr size_t OFF_VST = OFF_KS + 8 * MB;
constexpr size_t OFF_KW = OFF_VST + 8 * MB;
constexpr size_t OFF_VWT = OFF_KW + 8 * MB;
constexpr size_t OFF_U = OFF_ARENA + 304 * MB;
constexpr size_t OFF_NSA = OFF_ARENA + 336 * MB;
constexpr size_t OFF_YS = OFF_ARENA + 368 * MB;
constexpr size_t OFF_CPART = OFF_ARENA + 400 * MB;
constexpr size_t OFF_S5T = OFF_CPART + 32 * MB;
constexpr size_t OFF_S5L = OFF_S5T + 32 * 8192;
constexpr size_t WS_NEED = OFF_S5L + 32 * 64 * 8;
constexpr size_t OFF_ACT = OFF_ARENA;
constexpr size_t OFF_X1B = OFF_ARENA + 256 * MB;
constexpr size_t OFF_MERGED = OFF_HN;

constexpr int SMEM_BYTES = 131072 + 1024;

struct Params {
  const float *x, *g1, *w_in, *pe, *kw1, *kw2, *vw1, *vw2, *lam_re, *lam_im, *log_step, *b_re, *b_im, *c_re, *c_im, *dsk,
      *w_attn, *w_val, *w_gate, *w_out, *g2, *w_up, *w_down, *g3;
  float* out;
  unsigned char* ws;
  int lo, hi;
};

typedef const __attribute__((address_space(4))) Params* PP;

DI int my_tid(int wv0) {
  int t = wv0 * 64 + (int)__lane_id();
  asm volatile("" : "+v"(t));
  return t;
}
DI unsigned pk2(float a, float b);
DI u16 f2bf(float x) { return (u16)(pk2(x, 0.f) & 0xffffu); }
DI float bf2f(u16 h) { return __uint_as_float(((unsigned)h) << 16); }
typedef float f32x2_t __attribute__((ext_vector_type(2)));
typedef __bf16 bf16x2_t __attribute__((ext_vector_type(2)));
DI unsigned pk2(float a, float b) {
  const f32x2_t v = {a, b};
  return __builtin_bit_cast(unsigned, __builtin_convertvector(v, bf16x2_t));
}
DI uint2 pk4(float a, float b, float c, float d) { uint2 o; o.x = pk2(a, b); o.y = pk2(c, d); return o; }
DI float sigmoidf_(float x) { return 1.f / (1.f + __expf(-x)); }
DI float gelu_t(float x) {
  float u = 0.7978845608f * (x + 0.044715f * x * x * x);
  float e = __expf(2.f * u);
  float th = 1.f - 2.f / (e + 1.f);
  return 0.5f * x * (1.f + th);
}
DI float wave_sum(float v) {
#pragma unroll
  for (int o = 32; o > 0; o >>= 1) v += __shfl_xor(v, o);
  return v;
}
DI f32x4 mfma16(bf16x8 a, bf16x8 b, f32x4 c) { return __builtin_amdgcn_mfma_f32_16x16x32_bf16(a, b, c, 0, 0, 0); }

constexpr int G_HT = 128 * 64;
DI int lds_byte(int r, int c) {
  const int st = (r >> 4) * 2 + (c >> 5), rr = r & 15, cc = c & 31, ob = rr * 64 + cc * 2;
  return st * 1024 + (ob ^ (((ob >> 9) & 1) << 5));
}
DI void stage_rc(int b, int& R, int& C) {
  const int st = b / 1024, sb = b % 1024, swz = sb ^ (((sb >> 9) & 1) << 5);
  R = (st >> 1) * 16 + swz / 64;
  C = (st & 1) * 32 + (swz % 64) / 2;
}
typedef __attribute__((address_space(3))) unsigned* lds_u32p;
DI void gemm256(int wv0, f32x4 (&acc)[2][2][4][2], const u16* __restrict__ A, int lda, const u16* __restrict__ Bt, int ldb,
                int K, unsigned char* smem) {
  u16* shm = (u16*)smem;
  const int tid = my_tid(wv0), lane = tid & 63;
  const int wr = wv0 >> 2, wc = wv0 & 3, fr = lane & 15, fq = lane >> 4;
#define SA(b, h) (shm + ((b)*2 + (h)) * G_HT)
#define SB(b, h) (shm + (4 + (b)*2 + (h)) * G_HT)
  int sr0, sc0, sr1, sc1;
  stage_rc(tid * 16, sr0, sc0);
  stage_rc(tid * 16 + 8192, sr1, sc1);
  const u16* a0 = A + (size_t)sr0 * lda + sc0;
  const u16* a1 = A + (size_t)sr1 * lda + sc1;
  const u16* b0 = Bt + (size_t)sr0 * ldb + sc0;
  const u16* b1 = Bt + (size_t)sr1 * ldb + sc1;
#define STAGE_A(P, half, kt)                                                                                              \
  {                                                                                                                       \
    __builtin_amdgcn_global_load_lds((const unsigned*)(a0 + (size_t)((half)*128) * lda + (kt)*64),                        \
                                     (unsigned*)((char*)(P) + tid * 16), 16, 0, 0);                               \
    __builtin_amdgcn_global_load_lds((const unsigned*)(a1 + (size_t)((half)*128) * lda + (kt)*64),                        \
                                     (unsigned*)((char*)(P) + tid * 16 + 8192), 16, 0, 0);                        \
  }
#define STAGE_B(P, half, kt)                                                                                              \
  {                                                                                                                       \
    __builtin_amdgcn_global_load_lds((const unsigned*)(b0 + (size_t)((half)*128) * ldb + (kt)*64),                        \
                                     (unsigned*)((char*)(P) + tid * 16), 16, 0, 0);                               \
    __builtin_amdgcn_global_load_lds((const unsigned*)(b1 + (size_t)((half)*128) * ldb + (kt)*64),                        \
                                     (unsigned*)((char*)(P) + tid * 16 + 8192), 16, 0, 0);                        \
  }
#define LDA(dst, b, h)                                                                                                    \
  _Pragma("unroll") for (int m = 0; m < 4; ++m) _Pragma("unroll") for (int k = 0; k < 2; ++k)                             \
      dst[m][k] = *(const bf16x8*)((const unsigned char*)SA(b, h) + lds_byte(wr * 64 + m * 16 + fr, k * 32 + fq * 8));
#define LDB(dst, b, h)                                                                                                    \
  _Pragma("unroll") for (int n = 0; n < 2; ++n) _Pragma("unroll") for (int k = 0; k < 2; ++k)                             \
      dst[n][k] = *(const bf16x8*)((const unsigned char*)SB(b, h) + lds_byte(wc * 32 + n * 16 + fr, k * 32 + fq * 8));
#define MMA(ai, bj, At_, Bt_)                                                                                             \
  {                                                                                                                       \
    __builtin_amdgcn_s_setprio(1);                                                                                        \
    _Pragma("unroll") for (int m = 0; m < 4; ++m) _Pragma("unroll") for (int n = 0; n < 2; ++n)                           \
        _Pragma("unroll") for (int k = 0; k < 2; ++k) acc[ai][bj][m][n] =                                                 \
            __builtin_amdgcn_mfma_f32_16x16x32_bf16(Bt_[n][k], At_[m][k], acc[ai][bj][m][n], 0, 0, 0);                    \
    __builtin_amdgcn_s_setprio(0);                                                                                        \
  }
#define WAIT_V(n) asm volatile("s_waitcnt vmcnt(" #n ")" ::: "memory")
#define WAIT_L(n) asm volatile("s_waitcnt lgkmcnt(" #n ")" ::: "memory")
#define BAR __builtin_amdgcn_s_barrier()
#define SCHED __builtin_amdgcn_sched_barrier(0)
#pragma unroll
  for (int a = 0; a < 2; ++a)
#pragma unroll
    for (int b = 0; b < 2; ++b)
#pragma unroll
      for (int m = 0; m < 4; ++m)
#pragma unroll
        for (int n = 0; n < 2; ++n) acc[a][b][m][n] = f32x4{0.f, 0.f, 0.f, 0.f};
  bf16x8 At[4][2], B0[2][2], B1[2][2];
  const int nt = K / 64;
  WAIT_V(0);
  __syncthreads();
  STAGE_B(SB(0, 0), 0, 0) STAGE_A(SA(0, 0), 0, 0)
  STAGE_B(SB(0, 1), 1, 0) STAGE_A(SA(0, 1), 1, 0)
  if (wr == 1) BAR;
  WAIT_V(4); BAR;
  STAGE_B(SB(1, 0), 0, 1) STAGE_A(SA(1, 0), 0, 1) STAGE_B(SB(1, 1), 1, 1)
  WAIT_V(6); BAR;
#pragma unroll 1
  for (int t = 0; t < nt - 2; t += 2) {
    LDB(B0, 0, 0) SCHED; LDA(At, 0, 0) STAGE_A(SA(1, 1), 1, t + 1)
    WAIT_L(8); BAR; WAIT_L(0); MMA(0, 0, At, B0) BAR; SCHED;
    LDB(B1, 0, 1) STAGE_B(SB(0, 0), 0, t + 2)
    BAR; WAIT_L(0); MMA(0, 1, At, B1) BAR;
    LDA(At, 0, 1) STAGE_A(SA(0, 0), 0, t + 2)
    BAR; WAIT_L(0); MMA(1, 0, At, B0) BAR; SCHED;
    STAGE_B(SB(0, 1), 1, t + 2)
    WAIT_V(6); BAR; MMA(1, 1, At, B1) BAR;
    LDB(B0, 1, 0) SCHED; LDA(At, 1, 0) STAGE_A(SA(0, 1), 1, t + 2)
    WAIT_L(8); BAR; WAIT_L(0); MMA(0, 0, At, B0) BAR; SCHED;
    LDB(B1, 1, 1) STAGE_B(SB(1, 0), 0, t + 3)
    BAR; WAIT_L(0); MMA(0, 1, At, B1) BAR;
    LDA(At, 1, 1) STAGE_A(SA(1, 0), 0, t + 3)
    BAR; WAIT_L(0); MMA(1, 0, At, B0) BAR; SCHED;
    STAGE_B(SB(1, 1), 1, t + 3)
    WAIT_V(6); BAR; MMA(1, 1, At, B1) BAR;
  }
  {
    LDB(B0, 0, 0) LDA(At, 0, 0) STAGE_A(SA(1, 1), 1, nt - 1)
    BAR; WAIT_L(0); MMA(0, 0, At, B0) BAR;
    LDB(B1, 0, 1) BAR; WAIT_L(0); MMA(0, 1, At, B1) BAR;
    LDA(At, 0, 1) WAIT_V(4); BAR; WAIT_L(0); MMA(1, 0, At, B0) MMA(1, 1, At, B1) BAR;
  }
  {
    LDB(B0, 1, 0) LDA(At, 1, 0) WAIT_V(2); BAR; WAIT_L(0); MMA(0, 0, At, B0) BAR;
    LDB(B1, 1, 1) WAIT_V(0); BAR; WAIT_L(0); MMA(0, 1, At, B1) BAR;
    LDA(At, 1, 1) BAR; WAIT_L(0); MMA(1, 0, At, B0) MMA(1, 1, At, B1) BAR;
  }
  if (wr == 0) BAR;
}
DI void tile_map_n16(int id, int& pm, int& pn) {
  const int k = id & 255, rnd = id >> 8, x = k & 7, slot = k >> 3;
  pm = rnd * 16 + 4 * (x >> 1) + (slot >> 3);
  pn = 8 * (x & 1) + (slot & 7);
}
DI void tile_map_n4(int id, int& pm, int& pn) {
  const int k = id & 255, rnd = id >> 8, x = k & 7, slot = k >> 3;
  pm = rnd * 64 + 8 * x + (slot >> 2);
  pn = slot & 3;
}
template <class F>
DI void epi256(int wv0, f32x4 (&acc)[2][2][4][2], int brow, int bcol, F f) {
  const int lane = my_tid(wv0) & 63, wr = wv0 >> 2, wc = wv0 & 3;
#pragma unroll
  for (int ai = 0; ai < 2; ++ai)
#pragma unroll
    for (int bj = 0; bj < 2; ++bj)
#pragma unroll
      for (int m = 0; m < 4; ++m)
#pragma unroll
        for (int n = 0; n < 2; ++n) {
          const int row = brow + ai * 128 + wr * 64 + m * 16 + (lane & 15);
          const int col0 = bcol + bj * 128 + wc * 32 + n * 16 + (lane >> 4) * 4;
          f(ai, bj, m, n, row, col0, acc[ai][bj][m][n]);
          if (n == 1 && (m & 1)) __builtin_amdgcn_sched_barrier(0);
        }
}

constexpr int NXT_A = 1024 + 128 + 128 + 16 + 16;
constexpr int NXT = NXT_A + 128 * 3 + 256 + 1024 + 1024;
DI void xpose_tile(int wv0, PP p, int jt, unsigned char* smem) {
  const int tid = my_tid(wv0);
  float* tile = (float*)smem;
  int t = jt;
  const float* src;
  u16* dst;
  int K, Nsrc, mode = 0, rowil = -1;
  const float* scl = nullptr;
  if (t < 1024) { src = p->w_in; dst = (u16*)(p->ws + OFF_WINT); K = 1024; Nsrc = 3864; mode = 1; }
  else if ((t -= 1024) < 128) { src = p->kw1; dst = (u16*)(p->ws + OFF_W1KT); K = 2048; Nsrc = 256; }
  else if ((t -= 128) < 128) { src = p->vw1; dst = (u16*)(p->ws + OFF_W1VT); K = 2048; Nsrc = 256; }
  else if ((t -= 128) < 16) { src = p->kw2; dst = (u16*)(p->ws + OFF_W2KT); K = 256; Nsrc = 64; mode = 2; }
  else if ((t -= 16) < 16) { src = p->vw2; dst = (u16*)(p->ws + OFF_W2VT); K = 256; Nsrc = 64; mode = 2; }
  else if ((t -= 16) < 128) { src = p->w_attn; dst = (u16*)(p->ws + OFF_WAT); K = 512; Nsrc = 1024; }
  else if ((t -= 128) < 128) { src = p->w_val; dst = (u16*)(p->ws + OFF_WVT); K = 512; Nsrc = 1024; rowil = 0; }
  else if ((t -= 128) < 128) { src = p->w_gate; dst = (u16*)(p->ws + OFF_WVT); K = 512; Nsrc = 1024; rowil = 128; }
  else if ((t -= 128) < 256) { src = p->w_out; dst = (u16*)(p->ws + OFF_WOT); K = 1024; Nsrc = 1024; }
  else if ((t -= 256) < 1024) { src = p->w_up; dst = (u16*)(p->ws + OFF_WUPT); K = 1024; Nsrc = 4096; scl = p->g2; }
  else { t -= 1024; src = p->w_down; dst = (u16*)(p->ws + OFF_WDT); K = 4096; Nsrc = 1024; }
  const int nkt = K >> 6, tn = t / nkt, tk = t % nkt, n0 = tn * 64, k0 = tk * 64;
  const int tx = tid & 63, ty = tid >> 6;
  const int np = n0 + tx;
  int sc = np;
  if (mode == 1) {
    if (np < 1280) sc = np;
    else if (np < 1792) sc = 1304 + (np - 1280);
    else if (np < 3840) sc = 1816 + (np - 1792);
    else if (np < 3864) sc = 1280 + (np - 3840);
    else sc = -1;
  } else if (mode == 2) {
    sc = np < 64 ? np : -1;
  }
  for (int kk = ty; kk < 64; kk += 8) {
    float val = 0.f;
    if (sc >= 0) val = src[(size_t)(k0 + kk) * Nsrc + sc];
    if (scl) val *= scl[k0 + kk];
    tile[kk * 65 + tx] = val;
  }
  __syncthreads();
  {
    const int n = tid >> 3, kc = tid & 7;
    uint4 o;
    o.x = pk2(tile[(kc * 8 + 0) * 65 + n], tile[(kc * 8 + 1) * 65 + n]);
    o.y = pk2(tile[(kc * 8 + 2) * 65 + n], tile[(kc * 8 + 3) * 65 + n]);
    o.z = pk2(tile[(kc * 8 + 4) * 65 + n], tile[(kc * 8 + 5) * 65 + n]);
    o.w = pk2(tile[(kc * 8 + 6) * 65 + n], tile[(kc * 8 + 7) * 65 + n]);
    const int drow = rowil < 0 ? (n0 + n) : (((n0 + n) >> 7) * 256 + ((n0 + n) & 127) + rowil);
    *(uint4*)(dst + (size_t)drow * K + k0 + kc * 8) = o;
  }
  __syncthreads();
}

DI void phaseA(int wv0, PP p, unsigned char* smem) {
  const int tid = my_tid(wv0), lane = tid & 63;
  u16* HN = (u16*)(p->ws + OFF_HN);
  for (int row = blockIdx.x * 8 + wv0; row < T_; row += gridDim.x * 8) {
    const float4* xr = (const float4*)(p->x + (size_t)row * 1024);
    float4 v[4];
    float ss = 0.f;
#pragma unroll
    for (int r = 0; r < 4; ++r) {
      v[r] = xr[lane + 64 * r];
      ss += v[r].x * v[r].x + v[r].y * v[r].y + v[r].z * v[r].z + v[r].w * v[r].w;
    }
    ss = wave_sum(ss);
    const float rinv = rsqrtf(ss * (1.f / 1024.f) + 1e-6f);
#pragma unroll
    for (int r = 0; r < 4; ++r) {
      const float4 g = ((const float4*)p->g1)[lane + 64 * r];
      uint2 o;
      o.x = pk2(v[r].x * rinv * g.x, v[r].y * rinv * g.y);
      o.y = pk2(v[r].z * rinv * g.z, v[r].w * rinv * g.w);
      *(uint2*)(HN + (size_t)row * 1024 + (lane + 64 * r) * 4) = o;
    }
  }
  for (int jt = blockIdx.x; jt < NXT_A + 32 + 32; jt += gridDim.x) {
    if (jt < NXT_A) {
      xpose_tile(wv0, p, jt, smem);
    } else if (jt >= NXT_A + 32) {
      const int g = jt - (NXT_A + 32);
      u16* TB = (u16*)(p->ws + OFF_S5T + (size_t)g * 8192);
      const float step = expf(p->log_step[g]);
      for (int e = tid; e < 2048; e += NT_) {
        const int np = e >> 4, c = e & 15, n = np & 63;
        const float lr = p->lam_re[g * 64 + n], li = p->lam_im[g * 64 + n];
        const float er = expf(lr * step);
        float sn, cs;
        sincosf(li * step, &sn, &cs);
        const float nr = er * cs - 1.f, ni = er * sn, den = lr * lr + li * li;
        const float cr = (nr * lr + ni * li) / den, ci = (ni * lr - nr * li) / den;
        const float bre = p->b_re[(g * 64 + n) * 16 + c], bim = p->b_im[(g * 64 + n) * 16 + c];
        TB[np * 16 + c] = f2bf(np < 64 ? (cr * bre - ci * bim) : (cr * bim + ci * bre));
        const int cc = e >> 7, k = e & 127;
        TB[2048 + cc * 128 + k] = f2bf(k < 64 ? p->c_re[(g * 16 + cc) * 64 + k] : -p->c_im[(g * 16 + cc) * 64 + (k - 64)]);
      }
      if (tid < 64) {
        const float lr = p->lam_re[g * 64 + tid], li = p->lam_im[g * 64 + tid];
        const float er = expf(lr * step);
        float sn, cs;
        sincosf(li * step, &sn, &cs);
        ((float2*)(p->ws + OFF_S5L))[g * 64 + tid] = make_float2(er * cs, er * sn);
      }
    } else {
      const int item = jt - NXT_A, kv = item >> 4, slice = item & 15;
      const float* w1 = kv ? p->vw1 : p->kw1;
      const int col = tid & 255, h = tid >> 8, kb = slice * 128 + h * 64;
      float s0 = 0.f, s1 = 0.f, s2 = 0.f, s3 = 0.f;
      for (int k = kb; k < kb + 64; k += 4) {
        s0 += p->pe[k] * w1[(size_t)k * 256 + col];
        s1 += p->pe[k + 1] * w1[(size_t)(k + 1) * 256 + col];
        s2 += p->pe[k + 2] * w1[(size_t)(k + 2) * 256 + col];
        s3 += p->pe[k + 3] * w1[(size_t)(k + 3) * 256 + col];
      }
      ((float*)(p->ws + OFF_CBP))[(kv * 32 + slice * 2 + h) * 256 + col] = (s0 + s1) + (s2 + s3);
    }
  }
  float* rope = (float*)(p->ws + OFF_ROPE);
  for (int i = blockIdx.x * NT_ + tid; i < S_ * 8; i += gridDim.x * NT_) {
    const int pos = i >> 3, k = i & 7;
    const float inv = powf(500000.0f, -(2.0f * (float)k) / 16.0f);
    const float ang = (float)pos * inv;
    rope[pos * 16 + k] = cosf(ang);
    rope[pos * 16 + 8 + k] = sinf(ang);
  }
  if (blockIdx.x == 0 && tid < 64) ((int*)(p->ws + OFF_CTR))[tid] = 0;
}

DI void phaseB(int wv0, PP p, unsigned char* smem) {
  const u16* HN = (const u16*)(p->ws + OFF_HN);
  const u16* WT = (const u16*)(p->ws + OFF_WINT);
  const float* rope = (const float*)(p->ws + OFF_ROPE);
  const int lane = my_tid(wv0) & 63;
  const bool ropewave = (wv0 & 1) == 0;
  for (int id = blockIdx.x; id < 128 * 16; id += gridDim.x) {
    int pm, pn;
    tile_map_n16(id, pm, pn);
    const int brow = pm * 256, bcol = pn * 256;
    f32x4 acc[2][2][4][2];
    gemm256(wv0, acc, HN + (size_t)brow * 1024, 1024, WT + (size_t)bcol * 1024, 1024, 1024, smem);
    if (pn < 2) {
      u16* QR = (u16*)(p->ws + OFF_QRAW);
      u16* QO = (u16*)(p->ws + OFF_QROT);
      epi256(wv0, acc, brow, bcol, [&](int ai, int bj, int m, int n, int row, int col0, f32x4& v) {
        f32x4 r = v;
        if (n == 0 && ropewave) {
          const int pos = row & (S_ - 1), kq = ((lane >> 4) & 1) * 4;
          const float4 c4 = *(const float4*)(rope + pos * 16 + kq), s4 = *(const float4*)(rope + pos * 16 + 8 + kq);
          const float cc[4] = {c4.x, c4.y, c4.z, c4.w}, ss[4] = {s4.x, s4.y, s4.z, s4.w};
#pragma unroll
          for (int j = 0; j < 4; ++j) {
            const float pr = __shfl_xor(v[j], 32);
            r[j] = (lane & 32) ? (v[j] * cc[j] + pr * ss[j]) : (v[j] * cc[j] - pr * ss[j]);
          }
        }
        *(uint2*)(QR + (size_t)row * 512 + col0) = pk4(v[0] * QSCALE, v[1] * QSCALE, v[2] * QSCALE, v[3] * QSCALE);
        *(uint2*)(QO + (size_t)row * 512 + col0) = pk4(r[0] * QSCALE, r[1] * QSCALE, r[2] * QSCALE, r[3] * QSCALE);
      });
    } else if (pn < 5) {
      epi256(wv0, acc, brow, bcol, [&](int ai, int bj, int m, int n, int row, int col0, f32x4& v) {
        const int sub = (pn - 2) * 2 + bj;
        const bool dorope = (sub == 2 || sub == 4), transposed = (sub == 3 || sub == 5);
        u16* dst = (u16*)(p->ws + OFF_KCIN + (size_t)sub * 8 * MB);
        const int c128 = col0 & 127, g = c128 >> 6, d0 = c128 & 63;
        const int b = row >> 13, sq = row & (S_ - 1);
        f32x4 r = v;
        if (dorope && n == 0 && ropewave) {
          const int kq = ((lane >> 4) & 1) * 4;
          const float4 c4 = *(const float4*)(rope + sq * 16 + kq), s4 = *(const float4*)(rope + sq * 16 + 8 + kq);
          const float cc[4] = {c4.x, c4.y, c4.z, c4.w}, ss[4] = {s4.x, s4.y, s4.z, s4.w};
#pragma unroll
          for (int j = 0; j < 4; ++j) {
            const float pr = __shfl_xor(v[j], 32);
            r[j] = (lane & 32) ? (v[j] * cc[j] + pr * ss[j]) : (v[j] * cc[j] - pr * ss[j]);
          }
        }
        if (transposed) {
#pragma unroll
          for (int j = 0; j < 4; ++j) dst[((size_t)((b * 2 + g) * 64 + d0 + j)) * S_ + sq] = f2bf(r[j]);
        } else {
          *(uint2*)(dst + ((size_t)(b * 2 + g) * S_ + sq) * 64 + d0) = pk4(r[0], r[1], r[2], r[3]);
        }
      });
    } else if (pn < 7) {
      u16* U = (u16*)(p->ws + OFF_U);
      epi256(wv0, acc, brow, bcol, [&](int ai, int bj, int m, int n, int row, int col0, f32x4& v) {
        *(uint2*)(U + (size_t)row * 512 + (col0 - 1280)) = pk4(v[0], v[1], v[2], v[3]);
      });
    } else if (pn < 15) {
      u16* MG = (u16*)(p->ws + OFF_MG);
      epi256(wv0, acc, brow, bcol, [&](int ai, int bj, int m, int n, int row, int col0, f32x4& v) {
        *(uint2*)(MG + (size_t)row * 2048 + (col0 - 1792)) = pk4(sigmoidf_(v[0]), sigmoidf_(v[1]), sigmoidf_(v[2]), sigmoidf_(v[3]));
      });
    } else {
      float* NG = (float*)(p->ws + OFF_NG);
      epi256(wv0, acc, brow, bcol, [&](int ai, int bj, int m, int n, int row, int col0, f32x4& v) {
        const int cc = col0 - 3840;
        if (cc < 24) *(float4*)(NG + (size_t)row * 24 + cc) = make_float4(sigmoidf_(v[0]), sigmoidf_(v[1]), sigmoidf_(v[2]), sigmoidf_(v[3]));
      });
    }
  }
}

template <bool OUT>
DI void s5_item(int wv0, PP p, int item, unsigned char* smem) {
  const int tid = my_tid(wv0), lane = tid & 63, fr = lane & 15, fq = lane >> 4;
  const int b = item >> 9, g = (item >> 4) & 31, c8 = item & 15, ch = c8 * 8 + wv0;
  u16* sBb = (u16*)smem;
  u16* sCm = sBb + 128 * 16;
  float* sBU = (float*)(smem + 8192) + wv0 * (16 * 132);
  u16* sH = (u16*)(smem + 8192 + 8 * 16 * 132 * 4) + wv0 * (16 * 136);
  *(uint4*)(smem + tid * 16) = *(const uint4*)(p->ws + OFF_S5T + (size_t)g * 8192 + tid * 16);
  const float2 lb = ((const float2*)(p->ws + OFF_S5L))[g * 64 + lane];
  const float lbr = lb.x, lbi = lb.y;
  float2* HL = (float2*)(p->ws + OFF_HLOC) + ((size_t)(b * 128 + ch) * 32 + g) * 64 + lane;
  float hr = 0.f, hi = 0.f;
  if (OUT) { const float2 h0 = *HL; hr = h0.x; hi = h0.y; }
  const u16* U = (const u16*)(p->ws + OFF_U) + ((size_t)(b * S_ + ch * 64)) * 512 + g * 16;
  u16* YS = (u16*)(p->ws + OFF_YS) + ((size_t)(b * S_ + ch * 64)) * 512 + g * 16;
  const float dk = p->dsk[g * 16 + fr];
  const bf16x8 zero8 = {0, 0, 0, 0, 0, 0, 0, 0};
  bf16x8 uall[4];
  u16 usk[4][4];
#pragma unroll
  for (int sub = 0; sub < 4; ++sub) {
    uall[sub] = fq < 2 ? *(const bf16x8*)(U + (size_t)(sub * 16 + fr) * 512 + 8 * fq) : zero8;
    if (OUT) {
#pragma unroll
      for (int j = 0; j < 4; ++j) usk[sub][j] = U[(size_t)(sub * 16 + 4 * fq + j) * 512 + fr];
    }
  }
  __syncthreads();
  bf16x8 bb[8], cf[4];
#pragma unroll
  for (int nt = 0; nt < 8; ++nt) bb[nt] = fq < 2 ? *(const bf16x8*)(sBb + (16 * nt + fr) * 16 + 8 * fq) : zero8;
  if (OUT) {
#pragma unroll
    for (int ks = 0; ks < 4; ++ks) cf[ks] = *(const bf16x8*)(sCm + fr * 128 + 32 * ks + 8 * fq);
  }
#pragma unroll
  for (int sub = 0; sub < 4; ++sub) {
    const bf16x8 ua = uall[sub];
#pragma unroll
    for (int nt = 0; nt < 8; ++nt) {
      const f32x4 a = mfma16(ua, bb[nt], f32x4{0.f, 0.f, 0.f, 0.f});
#pragma unroll
      for (int j = 0; j < 4; ++j) sBU[(4 * fq + j) * 132 + 16 * nt + fr] = a[j];
    }
    __syncthreads();
#pragma unroll 4
    for (int t = 0; t < 16; ++t) {
      const float bur = sBU[t * 132 + lane], bui = sBU[t * 132 + 64 + lane];
      const float nr = lbr * hr - lbi * hi + bur;
      const float nim = lbr * hi + lbi * hr + bui;
      hr = nr;
      hi = nim;
      if (OUT) {
        sH[t * 136 + lane] = f2bf(hr);
        sH[t * 136 + 64 + lane] = f2bf(hi);
      }
    }
    __syncthreads();
    if (OUT) {
      f32x4 y = {0.f, 0.f, 0.f, 0.f};
#pragma unroll
      for (int ks = 0; ks < 4; ++ks) y = mfma16(*(const bf16x8*)(sH + fr * 136 + 32 * ks + 8 * fq), cf[ks], y);
#pragma unroll
      for (int j = 0; j < 4; ++j) {
        const size_t o = (size_t)(sub * 16 + 4 * fq + j) * 512 + fr;
        YS[o] = f2bf(gelu_t(y[j] + dk * bf2f(usk[sub][j])));
      }
      __syncthreads();
    }
  }
  if (!OUT) *HL = make_float2(hr, hi);
  __syncthreads();
}
DI void s5_carry(int wv0, PP p) {
  const int x = blockIdx.x * NT_ + my_tid(wv0);
  if (x >= 8192) return;
  const int b = x >> 11, g = (x >> 6) & 31, n = x & 63;
  const float step = expf(p->log_step[g]);
  const float lr = p->lam_re[g * 64 + n], li = p->lam_im[g * 64 + n];
  const float er = expf(64.f * lr * step);
  float sn, cs;
  sincosf(64.f * li * step, &sn, &cs);
  const float Lr = er * cs, Li = er * sn;
  float2* HL = (float2*)(p->ws + OFF_HLOC) + (size_t)b * 128 * 2048 + g * 64 + n;
  float hr = 0.f, hi = 0.f;
  for (int c0 = 0; c0 < 128; c0 += 16) {
    float2 v[16];
#pragma unroll
    for (int k = 0; k < 16; ++k) v[k] = HL[(size_t)(c0 + k) * 2048];
#pragma unroll
    for (int k = 0; k < 16; ++k) {
      HL[(size_t)(c0 + k) * 2048] = make_float2(hr, hi);
      const float nr = Lr * hr - Li * hi + v[k].x;
      const float nim = Lr * hi + Li * hr + v[k].y;
      hr = nr;
      hi = nim;
    }
  }
}
DI void phaseC(int wv0, PP p, unsigned char* smem) {
  for (int id = blockIdx.x; id < 128 + 2048 + 256; id += gridDim.x) {
    if (id >= 128 + 2048) {
      const int it = id - (128 + 2048), tns = it >> 7, bg = (it >> 4) & 7, part = it & 15;
      const int tid = my_tid(wv0);
      const u16* K = (const u16*)(p->ws + (tns ? OFF_KW : OFF_KS)) + ((size_t)bg * S_ + part * 512 + tid) * 64;
      float q2 = 0.f;
#pragma unroll
      for (int c = 0; c < 8; ++c) {
        const uint4 w = *(const uint4*)(K + c * 8);
        const unsigned ww[4] = {w.x, w.y, w.z, w.w};
#pragma unroll
        for (int e = 0; e < 4; ++e) {
          const float a = __uint_as_float(ww[e] << 16), b2 = __uint_as_float(ww[e] & 0xffff0000u);
          q2 += a * a + b2 * b2;
        }
      }
#pragma unroll
      for (int o = 32; o > 0; o >>= 1) q2 = fmaxf(q2, __shfl_xor(q2, o));
      if ((tid & 63) == 0) atomicMax((unsigned*)(p->ws + OFF_KMAX) + tns * 8 + bg, __float_as_uint(q2));
    } else if (id < 128) {
      const int kv = id >> 6, pm = (id >> 2) & 15, ks = id & 3, brow = pm * 256;
      const u16* A = (const u16*)(p->ws + (kv ? OFF_VCIN : OFF_KCIN)) + (size_t)brow * 1024 + ks * 512;
      const u16* Bt = (const u16*)(p->ws + (kv ? OFF_W1VT : OFF_W1KT)) + ks * 512;
      f32x4 acc[2][2][4][2];
      gemm256(wv0, acc, A, 1024, Bt, 2048, 512, smem);
      float* PART = (float*)(p->ws + OFF_CPART) + (size_t)(ks * 2 + kv) * 4096 * 256;
      epi256(wv0, acc, brow, 0, [&](int ai, int bj, int m, int n, int row, int col0, f32x4& v) {
        *(float4*)(PART + (size_t)row * 256 + col0) = make_float4(v[0], v[1], v[2], v[3]);
      });
    } else {
      s5_item<false>(wv0, p, id - 128, smem);
    }
  }
}
DI void phaseD1(int wv0, PP p, unsigned char* smem) {
  const int tid = my_tid(wv0);
  float* sB = (float*)smem;
  {
    const float* cbp = (const float*)(p->ws + OFF_CBP);
    float bb = 0.f;
    for (int sl = 0; sl < 32; ++sl) bb += cbp[((tid >> 8) * 32 + sl) * 256 + (tid & 255)];
    sB[tid] = bb;
  }
  __syncthreads();
  const float* PART = (const float*)(p->ws + OFF_CPART);
  u16* HC = (u16*)(p->ws + OFF_HC);
  for (int e = blockIdx.x * NT_ + tid; e < 2 * 4096 * 64; e += gridDim.x * NT_) {
    const int kv = e >> 18, rc = e & 262143, c4 = (rc & 63) * 4;
    const size_t o = (size_t)kv * 4096 * 256 + (size_t)rc * 4;
    float4 a = *(const float4*)(PART + o);
#pragma unroll
    for (int ks = 1; ks < 4; ++ks) {
      const float4 t = *(const float4*)(PART + (size_t)ks * 2 * 4096 * 256 + o);
      a.x += t.x; a.y += t.y; a.z += t.z; a.w += t.w;
    }
    const float* bv = sB + kv * 256 + c4;
    *(uint2*)(HC + o) = pk4(gelu_t(a.x + bv[0]), gelu_t(a.y + bv[1]), gelu_t(a.z + bv[2]), gelu_t(a.w + bv[3]));
  }
}
DI void phaseD(int wv0, PP p, unsigned char* smem) {
  for (int id = blockIdx.x; id < 32; id += gridDim.x) {
    const int kv = id >> 4, pm = id & 15, brow = pm * 256;
    const u16* A = (const u16*)(p->ws + OFF_HC) + (size_t)kv * 4096 * 256 + (size_t)brow * 256;
    const u16* Bt = (const u16*)(p->ws + (kv ? OFF_W2VT : OFF_W2KT));
    f32x4 acc[2][2][4][2];
    gemm256(wv0, acc, A, 256, Bt, 256, 256, smem);
    u16* KCC = (u16*)(p->ws + OFF_KCC);
    u16* VCT = (u16*)(p->ws + OFF_VCT);
    epi256(wv0, acc, brow, 0, [&](int ai, int bj, int m, int n, int row, int col0, f32x4& v) {
      if (col0 < 64) {
        const int bg = row >> 9, nn = row & 511;
        f32x4 r = v;
        if (nn == 511) r = f32x4{0.f, 0.f, 0.f, 0.f};
        if (kv == 0) {
          *(uint2*)(KCC + ((size_t)bg * 512 + nn) * 64 + col0) = pk4(r[0], r[1], r[2], r[3]);
        } else {
#pragma unroll
          for (int j = 0; j < 4; ++j) VCT[((size_t)bg * 64 + col0 + j) * 512 + nn] = f2bf(r[j]);
        }
      }
    });
  }
  s5_carry(wv0, p);
}

DI bool bit128(u64 lo, u64 hi, int j) { return j < 64 ? ((lo >> j) & 1ull) : ((hi >> (j - 64)) & 1ull); }
DI int next_bit(u64 lo, u64 hi, int from) {
  if (from < 64) {
    const u64 x = (lo >> from) << from;
    if (x) return __ffsll((long long)x) - 1;
    from = 64;
  }
  if (from >= 128) return -1;
  const u64 y = (hi >> (from - 64)) << (from - 64);
  return y ? 63 + __ffsll((long long)y) : -1;
}

template <int MODE, bool MASKED, class MaskF>
DI void flash_tile(const u16* sK, const u16* sV, const bf16x8 (&qf)[2][2], f32x4 (&O)[2][4], float (&m)[2], float (&l)[2],
                   float (&ps)[4][4], MaskF ok, bool sel, int lane) {
  const int l15 = lane & 15, lg = lane >> 4;
  bf16x8 kf[4][2];
#pragma unroll
  for (int kt = 0; kt < 4; ++kt)
#pragma unroll
    for (int ks = 0; ks < 2; ++ks) kf[kt][ks] = *(const bf16x8*)(sK + (16 * kt + l15) * 72 + ks * 32 + lg * 8);
  if (MODE == 1) {
#pragma unroll
    for (int a = 0; a < 4; ++a)
#pragma unroll
      for (int b = 0; b < 4; ++b) ps[a][b] = 0.f;
  }
  union PFrag { unsigned u[4]; bf16x8 v; };
  PFrag pf[2][2];
#pragma unroll
  for (int qt = 0; qt < 2; ++qt) {
    f32x4 s[4];
    const float sinit = (MODE == 3) ? ((MASKED || sel) ? m[qt] : -1e30f) : 0.f;
#pragma unroll
    for (int kt = 0; kt < 4; ++kt) {
      s[kt] = f32x4{sinit, sinit, sinit, sinit};
#pragma unroll
      for (int ks = 0; ks < 2; ++ks) s[kt] = mfma16(kf[kt][ks], qf[qt][ks], s[kt]);
    }
    float pr[4][4];
    if (MODE == 3) {
      float rs = 0.f;
#pragma unroll
      for (int kt = 0; kt < 4; ++kt)
#pragma unroll
        for (int i = 0; i < 4; ++i) {
          float pv = __builtin_amdgcn_exp2f(s[kt][i]);
          if (MASKED) pv = ok(kt, i) ? pv : 0.f;
          pr[kt][i] = pv;
          rs += pv;
        }
      l[qt] += rs;
    } else {
    float mx = -1e30f;
#pragma unroll
    for (int kt = 0; kt < 4; ++kt)
#pragma unroll
      for (int i = 0; i < 4; ++i) {
        if (MASKED) s[kt][i] = ok(kt, i) ? s[kt][i] : -1e30f;
        mx = fmaxf(mx, s[kt][i]);
      }
    if (!MASKED) mx = sel ? mx : -1e30f;
    if (MODE == 1) {
      const float mm = m[qt], il = l[qt];
#pragma unroll
      for (int kt = 0; kt < 4; ++kt)
#pragma unroll
        for (int i = 0; i < 4; ++i) {
          const float pv = (s[kt][i] > -1e29f) ? __builtin_amdgcn_exp2f(s[kt][i] - mm) * il : 0.f;
          pr[kt][i] = pv;
          ps[kt][i] += pv;
        }
    } else {
      mx = fmaxf(mx, __shfl_xor(mx, 16));
      mx = fmaxf(mx, __shfl_xor(mx, 32));
      const float mnew = fmaxf(m[qt], mx);
      const float alpha = __builtin_amdgcn_exp2f(m[qt] - mnew);
      m[qt] = mnew;
      float rs = 0.f;
      if (MASKED) {
#pragma unroll
        for (int kt = 0; kt < 4; ++kt)
#pragma unroll
          for (int i = 0; i < 4; ++i) {
            const float pv = (s[kt][i] > -1e29f) ? __builtin_amdgcn_exp2f(s[kt][i] - mnew) : 0.f;
            pr[kt][i] = pv;
            rs += pv;
          }
      } else {
        const float me = sel ? mnew : 1e30f;
#pragma unroll
        for (int kt = 0; kt < 4; ++kt)
#pragma unroll
          for (int i = 0; i < 4; ++i) {
            const float pv = __builtin_amdgcn_exp2f(s[kt][i] - me);
            pr[kt][i] = pv;
            rs += pv;
          }
      }
      l[qt] = l[qt] * alpha + rs;
      if (MODE == 2) {
#pragma unroll
        for (int dt = 0; dt < 4; ++dt) O[qt][dt] *= alpha;
      }
    }
    }
    if (MODE != 0) {
#pragma unroll
      for (int ks2 = 0; ks2 < 2; ++ks2) {
        pf[qt][ks2].u[0] = pk2(pr[2 * ks2][0], pr[2 * ks2][1]);
        pf[qt][ks2].u[1] = pk2(pr[2 * ks2][2], pr[2 * ks2][3]);
        pf[qt][ks2].u[2] = pk2(pr[2 * ks2 + 1][0], pr[2 * ks2 + 1][1]);
        pf[qt][ks2].u[3] = pk2(pr[2 * ks2 + 1][2], pr[2 * ks2 + 1][3]);
      }
    }
  }
  if (MODE != 0) {
#pragma unroll
    for (int ks2 = 0; ks2 < 2; ++ks2) {
#pragma unroll
      for (int dt = 0; dt < 4; ++dt) {
        union { uint2 h[2]; bf16x8 v; } vf;
        vf.h[0] = *(const uint2*)(sV + (16 * dt + l15) * 72 + 32 * ks2 + 4 * lg);
        vf.h[1] = *(const uint2*)(sV + (16 * dt + l15) * 72 + 32 * ks2 + 16 + 4 * lg);
        O[0][dt] = mfma16(vf.v, pf[0][ks2].v, O[0][dt]);
        O[1][dt] = mfma16(vf.v, pf[1][ks2].v, O[1][dt]);
      }
    }
  }
}

DI void flash_s3(const u16* sK, const bf16x8 (&qf)[2][2], float si0, float si1, f32x4 (&s)[2][4], int lane) {
  const int l15 = lane & 15, lg = lane >> 4;
  bf16x8 kf[4][2];
#pragma unroll
  for (int kt = 0; kt < 4; ++kt)
#pragma unroll
    for (int ks = 0; ks < 2; ++ks) kf[kt][ks] = *(const bf16x8*)(sK + (16 * kt + l15) * 72 + ks * 32 + lg * 8);
#pragma unroll
  for (int qt = 0; qt < 2; ++qt) {
    const float si = qt ? si1 : si0;
#pragma unroll
    for (int kt = 0; kt < 4; ++kt) {
      s[qt][kt] = f32x4{si, si, si, si};
#pragma unroll
      for (int ks = 0; ks < 2; ++ks) s[qt][kt] = mfma16(kf[kt][ks], qf[qt][ks], s[qt][kt]);
    }
  }
}
template <bool MASKED, class MaskF>
DI void flash_pv3(const u16* sV, const f32x4 (&s)[2][4], f32x4 (&O)[2][4], float (&l)[2], MaskF ok, int lane) {
  const int l15 = lane & 15, lg = lane >> 4;
  union PFrag { unsigned u[4]; bf16x8 v; };
  PFrag pf[2][2];
#pragma unroll
  for (int qt = 0; qt < 2; ++qt) {
    float pr[4][4];
    float rs = 0.f;
#pragma unroll
    for (int kt = 0; kt < 4; ++kt)
#pragma unroll
      for (int i = 0; i < 4; ++i) {
        float pv = __builtin_amdgcn_exp2f(s[qt][kt][i]);
        if (MASKED) pv = ok(kt, i) ? pv : 0.f;
        pr[kt][i] = pv;
        rs += pv;
      }
    l[qt] += rs;
#pragma unroll
    for (int ks2 = 0; ks2 < 2; ++ks2) {
      pf[qt][ks2].u[0] = pk2(pr[2 * ks2][0], pr[2 * ks2][1]);
      pf[qt][ks2].u[1] = pk2(pr[2 * ks2][2], pr[2 * ks2][3]);
      pf[qt][ks2].u[2] = pk2(pr[2 * ks2 + 1][0], pr[2 * ks2 + 1][1]);
      pf[qt][ks2].u[3] = pk2(pr[2 * ks2 + 1][2], pr[2 * ks2 + 1][3]);
    }
  }
#pragma unroll
  for (int ks2 = 0; ks2 < 2; ++ks2) {
#pragma unroll
    for (int dt = 0; dt < 4; ++dt) {
      union { uint2 h[2]; bf16x8 v; } vf;
      vf.h[0] = *(const uint2*)(sV + (16 * dt + l15) * 72 + 32 * ks2 + 4 * lg);
      vf.h[1] = *(const uint2*)(sV + (16 * dt + l15) * 72 + 32 * ks2 + 16 + 4 * lg);
      O[0][dt] = mfma16(vf.v, pf[0][ks2].v, O[0][dt]);
      O[1][dt] = mfma16(vf.v, pf[1][ks2].v, O[1][dt]);
    }
  }
}

DI void nsa_item(int wv0, PP p, int item, unsigned char* smem) {
  const int tid = my_tid(wv0), lane = tid & 63, wv = wv0 & 3, hp = wv0 >> 2, l15 = lane & 15, lg = lane >> 4;
  const int i = 127 - (item >> 3), bg = item & 7, b = bg >> 1, g = bg & 1;
  u16* sK = (u16*)smem;
  u16* sV = sK + 64 * 72;
  float* sImp0 = (float*)(smem + 55296);
  float* sImp = sImp0 + hp * (64 * 132);
  u64* sUni = (u64*)(smem + 55296 + 2 * 64 * 132 * 4);
  u64* sSel = sUni + 16;
  const int t0 = i * 64, qloc = 16 * wv + l15, tq = t0 + qloc;
  const unsigned tokq = (unsigned)(b * S_ + tq);
  const float* NGb = (const float*)(p->ws + OFF_NG);
  const unsigned ngoff = tokq * 24 + g * 12 + hp * 6;
  float* ACCb = p->out;
  const unsigned aoff = tokq * 512 + g * 256 + hp * 128 + 4 * lg;
  const unsigned qoff = tokq * 512 + g * 256 + hp * 128 + lg * 8;
  const int lrow = tid >> 3, lpart = tid & 7;
  const unsigned koff = (lrow * 64 + lpart * 8) * 2, voffc = (lrow * 512 + lpart * 8) * 2, voffs = (lrow * S_ + lpart * 8) * 2;

  for (int e = tid; e < 2 * 64 * 132; e += NT_) sImp0[e] = 0.f;

  bf16x8 qf[2][2];
  f32x4 O[2][4];
  float m[2], l[2], ps[4][4];
  u32x4 pk0, pv0;
  auto nomask = [](int, int) { return true; };

#define MAKE_RSRC(PTR) __builtin_amdgcn_make_buffer_rsrc((void*)(PTR), 0, 0x7fffffff, 0x00020000)
#define BLOAD(R, VO, SO) __builtin_amdgcn_raw_buffer_load_b128((R), (int)(VO), (int)(SO), 0)
#define ISSUE_TILE(RK, RV, T, LDV)                                                   \
  {                                                                                  \
    pk0 = BLOAD(RK, koff, (T)*8192);                                                 \
    pv0 = BLOAD(RV, ((LDV) == 512) ? voffc : voffs, (T)*128);                        \
  }
#define COMMIT_TILE()                                                                \
  {                                                                                  \
    *(u32x4*)(sK + lrow * 72 + lpart * 8) = pk0;                                     \
    *(u32x4*)(sV + lrow * 72 + lpart * 8) = pv0;                                     \
  }
#define COMMIT_BUF(BUF)                                                              \
  {                                                                                  \
    *(u32x4*)(sK + (BUF)*9216 + lrow * 72 + lpart * 8) = pk0;                        \
    *(u32x4*)(sV + (BUF)*9216 + lrow * 72 + lpart * 8) = pv0;                        \
  }
#define LOAD_Q(BASE)                                                                 \
  {                                                                                  \
    const u16* Q_ = (const u16*)(p->ws + (BASE));                                    \
    _Pragma("unroll") for (int qt = 0; qt < 2; ++qt)                                 \
      _Pragma("unroll") for (int ks = 0; ks < 2; ++ks)                               \
        qf[qt][ks] = *(const bf16x8*)(Q_ + (qoff + qt * 64 + ks * 32));             \
  }
#define RESET_STATE()                                                                \
  {                                                                                  \
    _Pragma("unroll") for (int qt = 0; qt < 2; ++qt) { m[qt] = -1e30f; l[qt] = 0.f; } \
    _Pragma("unroll") for (int a = 0; a < 2; ++a)                                    \
      _Pragma("unroll") for (int c = 0; c < 4; ++c) O[a][c] = f32x4{0.f, 0.f, 0.f, 0.f}; \
  }

  {
    const u16* Kc0 = (const u16*)(p->ws + OFF_KCC) + (size_t)bg * 512 * 64;
    const u16* Vc0 = (const u16*)(p->ws + OFF_VCT) + (size_t)bg * 64 * 512;
    const int nE = (4 * i + 3) < 511 ? (4 * i + 3) : 511;
    const int nkb = (nE + 63) >> 6;
    const __amdgpu_buffer_rsrc_t rK = MAKE_RSRC(Kc0), rV = MAKE_RSRC(Vc0);
    LOAD_Q(OFF_QRAW)
    RESET_STATE()
    ISSUE_TILE(rK, rV, 0, 512)
    for (int kb = 0; kb < nkb; ++kb) {
      __syncthreads();
      COMMIT_TILE()
      __syncthreads();
      if (kb + 1 < nkb) ISSUE_TILE(rK, rV, kb + 1, 512)
      auto ok = [&](int kt, int ii) { return 16 * (kb * 64 + 16 * kt + 4 * lg + ii) + 31 <= tq; };
      flash_tile<0, true>(sK, sV, qf, O, m, l, ps, ok, true, lane);
    }
#pragma unroll
    for (int qt = 0; qt < 2; ++qt) {
      float s = l[qt];
      s += __shfl_xor(s, 16);
      s += __shfl_xor(s, 32);
      l[qt] = s > 0.f ? 1.f / s : 0.f;
    }
    ISSUE_TILE(rK, rV, 0, 512)
    for (int kb = 0; kb < nkb; ++kb) {
      __syncthreads();
      COMMIT_TILE()
      __syncthreads();
      if (kb + 1 < nkb) ISSUE_TILE(rK, rV, kb + 1, 512)
      auto ok = [&](int kt, int ii) { return 16 * (kb * 64 + 16 * kt + 4 * lg + ii) + 31 <= tq; };
      flash_tile<1, true>(sK, sV, qf, O, m, l, ps, ok, true, lane);
#pragma unroll
      for (int kt = 0; kt < 4; ++kt) {
        const int j = kb * 16 + kt * 4 + lg;
        sImp[qloc * 132 + j] += ps[kt][0] + ps[kt][1] + ps[kt][2] + ps[kt][3];
      }
      __syncthreads();
#pragma unroll
      for (int kt = 0; kt < 4; ++kt) {
        const int j1 = kb * 16 + kt * 4 + lg + 1;
        if (j1 < 128) sImp[qloc * 132 + j1] += ps[kt][3];
      }
    }
#pragma unroll
    for (int qt = 0; qt < 2; ++qt) {
      const float gt = NGb[ngoff + qt * 3 + 0];
#pragma unroll
      for (int dt = 0; dt < 4; ++dt) {
        float4 o = make_float4(O[qt][dt][0] * gt, O[qt][dt][1] * gt, O[qt][dt][2] * gt, O[qt][dt][3] * gt);
        *(float4*)(ACCb + (aoff + qt * 64 + 16 * dt)) = o;
      }
    }
  }
  __syncthreads();
  u64 mlo = 0, mhi = 0, wlo = 0, whi = 0;
  if (i < 16) {
    mlo = (1ull << (i + 1)) - 1ull;
    wlo = mlo;
  } else {
    const bool v0 = lane <= i, v1 = (lane + 64) <= i;
    const bool f0 = (lane == 0) || (lane == i) || (lane == i - 1);
    const bool f1 = (lane + 64 == i) || (lane + 64 == i - 1);
    const u64 ltm = (1ull << lane) - 1ull;
    for (int qq = hp * 8; qq < hp * 8 + 8; ++qq) {
      const float* ir = sImp0 + (16 * wv + qq) * 132;
      const float i0 = ir[lane] + ir[64 * 132 + lane], i1 = ir[lane + 64] + ir[64 * 132 + lane + 64];
      const unsigned k0 = v0 ? __float_as_uint(i0 + (f0 ? 1000.f : 0.f)) : 0u;
      const unsigned k1 = v1 ? __float_as_uint(i1 + (f1 ? 1000.f : 0.f)) : 0u;
      unsigned T = 0;
      for (int bit = 30; bit >= 0; --bit) {
        const unsigned cand = T | (1u << bit);
        const int cnt = __popcll(__ballot(k0 >= cand)) + __popcll(__ballot(k1 >= cand));
        if (cnt >= 16) T = cand;
      }
      const bool g0 = k0 > T, g1 = k1 > T, e0 = k0 == T, e1 = k1 == T;
      const int need = 16 - (__popcll(__ballot(g0)) + __popcll(__ballot(g1)));
      const u64 be0 = __ballot(e0), be1 = __ballot(e1);
      const int r0 = __popcll(be0 & ltm), r1 = __popcll(be0) + __popcll(be1 & ltm);
      const u64 s0 = __ballot(v0 && (g0 || (e0 && r0 < need)));
      const u64 s1 = __ballot(v1 && (g1 || (e1 && r1 < need)));
      wlo |= s0;
      whi |= s1;
      if (lane == 0) { sSel[(16 * wv + qq) * 2] = s0; sSel[(16 * wv + qq) * 2 + 1] = s1; }
    }
  }
  if (lane == 0) { sUni[wv0 * 2] = wlo; sUni[wv0 * 2 + 1] = whi; }
  __syncthreads();
  if (i >= 16) { mlo = sSel[qloc * 2]; mhi = sSel[qloc * 2 + 1]; }
  wlo = sUni[wv * 2] | sUni[(wv + 4) * 2];
  whi = sUni[wv * 2 + 1] | sUni[(wv + 4) * 2 + 1];
  const u64 blo = sUni[0] | sUni[2] | sUni[4] | sUni[6] | sUni[8] | sUni[10] | sUni[12] | sUni[14];
  const u64 bhi = sUni[1] | sUni[3] | sUni[5] | sUni[7] | sUni[9] | sUni[11] | sUni[13] | sUni[15];

  LOAD_Q(OFF_QROT)
  float nb_s[2], nb_w[2];
  bool usefix;
  {
    const float* KM = (const float*)(p->ws + OFF_KMAX);
    const float kms = KM[bg], kmw = KM[8 + bg];
    float bmax = 0.f;
#pragma unroll
    for (int qt = 0; qt < 2; ++qt) {
      float q2 = 0.f;
#pragma unroll
      for (int ks = 0; ks < 2; ++ks)
#pragma unroll
        for (int e = 0; e < 8; ++e) {
          const float qv = __uint_as_float(((unsigned)(u16)qf[qt][ks][e]) << 16);
          q2 += qv * qv;
        }
      q2 += __shfl_xor(q2, 16);
      q2 += __shfl_xor(q2, 32);
      const float bs = sqrtf(q2 * kms) * 1.001f + 1e-3f, bw = sqrtf(q2 * kmw) * 1.001f + 1e-3f;
      nb_s[qt] = -bs;
      nb_w[qt] = -bw;
      bmax = fmaxf(bmax, fmaxf(bs, bw));
    }
    usefix = __ballot(bmax > 60.f) == 0ull;
  }
  RESET_STATE()
  if (usefix) { m[0] = nb_s[0]; m[1] = nb_s[1]; }
  {
    const __amdgpu_buffer_rsrc_t rK = MAKE_RSRC((const u16*)(p->ws + OFF_KS) + (size_t)bg * S_ * 64);
    const __amdgpu_buffer_rsrc_t rV = MAKE_RSRC((const u16*)(p->ws + OFF_VST) + (size_t)bg * 64 * S_);
    if (usefix) {
      int jc = next_bit(blo, bhi, 0);
      int j1 = next_bit(blo, bhi, jc + 1);
      ISSUE_TILE(rK, rV, jc, S_)
      COMMIT_BUF(0)
      if (j1 >= 0) {
        ISSUE_TILE(rK, rV, j1, S_)
        COMMIT_BUF(1)
      }
      __syncthreads();
      int j2 = j1 >= 0 ? next_bit(blo, bhi, j1 + 1) : -1;
      if (j2 >= 0) ISSUE_TILE(rK, rV, j2, S_)
      f32x4 sc_[2][4], sn_[2][4];
      {
        const bool selc = bit128(mlo, mhi, jc);
        flash_s3(sK, qf, (selc || jc == i) ? m[0] : -1e30f, (selc || jc == i) ? m[1] : -1e30f, sc_, lane);
      }
      int bc = 0;
      while (jc >= 0) {
        const int bn = bc == 2 ? 0 : bc + 1, bn2 = bn == 2 ? 0 : bn + 1;
        const bool needn = j1 >= 0 && bit128(wlo, whi, j1);
        if (needn) {
          const bool seln = bit128(mlo, mhi, j1);
          const bool on = seln || j1 == i;
          flash_s3(sK + bn * 9216, qf, on ? m[0] : -1e30f, on ? m[1] : -1e30f, sn_, lane);
        }
        if (bit128(wlo, whi, jc)) {
          if (jc == i) {
            const bool sel = bit128(mlo, mhi, jc);
            auto ok = [&](int kt, int ii) { return sel && (16 * kt + 4 * lg + ii) <= qloc; };
            flash_pv3<true>(sV + bc * 9216, sc_, O, l, ok, lane);
          } else {
            flash_pv3<false>(sV + bc * 9216, sc_, O, l, nomask, lane);
          }
        }
        if (j2 >= 0) COMMIT_BUF(bn2)
        __syncthreads();
        jc = j1;
        j1 = j2;
        bc = bn;
        if (j1 >= 0) {
          j2 = next_bit(blo, bhi, j1 + 1);
          if (j2 >= 0) ISSUE_TILE(rK, rV, j2, S_)
        } else {
          j2 = -1;
        }
#pragma unroll
        for (int a = 0; a < 2; ++a)
#pragma unroll
          for (int c = 0; c < 4; ++c) sc_[a][c] = sn_[a][c];
      }
    } else {
      int j = next_bit(blo, bhi, 0);
      ISSUE_TILE(rK, rV, j, S_)
      COMMIT_BUF(0)
      __syncthreads();
      int jn = next_bit(blo, bhi, j + 1);
      if (jn >= 0) ISSUE_TILE(rK, rV, jn, S_)
      int cur = 0;
      while (j >= 0) {
        const u16* cK = sK + cur * 9216;
        const u16* cV = sV + cur * 9216;
        if (bit128(wlo, whi, j)) {
          const bool sel = bit128(mlo, mhi, j);
          if (j == i) {
            auto ok = [&](int kt, int ii) { return sel && (16 * kt + 4 * lg + ii) <= qloc; };
            if (usefix) flash_tile<3, true>(cK, cV, qf, O, m, l, ps, ok, true, lane);
            else flash_tile<2, true>(cK, cV, qf, O, m, l, ps, ok, true, lane);
          } else {
            if (usefix) flash_tile<3, false>(cK, cV, qf, O, m, l, ps, nomask, sel, lane);
            else flash_tile<2, false>(cK, cV, qf, O, m, l, ps, nomask, sel, lane);
          }
        }
        cur ^= 1;
        if (jn >= 0) COMMIT_BUF(cur)
        __syncthreads();
        j = jn;
        if (j >= 0) {
          jn = next_bit(blo, bhi, j + 1);
          if (jn >= 0) ISSUE_TILE(rK, rV, jn, S_)
        }
      }
    }
  }
#pragma unroll
  for (int qt = 0; qt < 2; ++qt) {
    float s = l[qt];
    s += __shfl_xor(s, 16);
    s += __shfl_xor(s, 32);
    const float sc = NGb[ngoff + qt * 3 + 1] / s;
#pragma unroll
    for (int dt = 0; dt < 4; ++dt) {
      float4* a = (float4*)(ACCb + (aoff + qt * 64 + 16 * dt));
      float4 o = *a;
      o.x += O[qt][dt][0] * sc; o.y += O[qt][dt][1] * sc; o.z += O[qt][dt][2] * sc; o.w += O[qt][dt][3] * sc;
      *a = o;
    }
  }
  RESET_STATE()
  if (usefix) { m[0] = nb_w[0]; m[1] = nb_w[1]; }
  {
    const __amdgpu_buffer_rsrc_t rK = MAKE_RSRC((const u16*)(p->ws + OFF_KW) + (size_t)bg * S_ * 64);
    const __amdgpu_buffer_rsrc_t rV = MAKE_RSRC((const u16*)(p->ws + OFF_VWT) + (size_t)bg * 64 * S_);
    const int j0 = i >= 8 ? i - 8 : 0;
    ISSUE_TILE(rK, rV, j0, S_)
    COMMIT_BUF(0)
    __syncthreads();
    if (j0 + 1 <= i) ISSUE_TILE(rK, rV, j0 + 1, S_)
    int cur = 0;
    for (int j = j0; j <= i; ++j) {
      const u16* cK = sK + cur * 9216;
      const u16* cV = sV + cur * 9216;
      if (j == i || j == i - 8) {
        auto ok = [&](int kt, int ii) {
          const int kp = j * 64 + 16 * kt + 4 * lg + ii;
          return kp <= tq && kp > tq - 512;
        };
        if (usefix) flash_tile<3, true>(cK, cV, qf, O, m, l, ps, ok, true, lane);
        else flash_tile<2, true>(cK, cV, qf, O, m, l, ps, ok, true, lane);
      } else {
        if (usefix) flash_tile<3, false>(cK, cV, qf, O, m, l, ps, nomask, true, lane);
        else flash_tile<2, false>(cK, cV, qf, O, m, l, ps, nomask, true, lane);
      }
      cur ^= 1;
      if (j + 1 <= i) COMMIT_BUF(cur)
      __syncthreads();
      if (j + 2 <= i) ISSUE_TILE(rK, rV, j + 2, S_)
    }
  }
  u16* NSAb = (u16*)(p->ws + OFF_NSA);
#pragma unroll
  for (int qt = 0; qt < 2; ++qt) {
    float s = l[qt];
    s += __shfl_xor(s, 16);
    s += __shfl_xor(s, 32);
    const float sc = NGb[ngoff + qt * 3 + 2] / s;
#pragma unroll
    for (int dt = 0; dt < 4; ++dt) {
      const float4 a = *(const float4*)(ACCb + (aoff + qt * 64 + 16 * dt));
      uint2 o;
      o.x = pk2(a.x + O[qt][dt][0] * sc, a.y + O[qt][dt][1] * sc);
      o.y = pk2(a.z + O[qt][dt][2] * sc, a.w + O[qt][dt][3] * sc);
      *(uint2*)(NSAb + (aoff + qt * 64 + 16 * dt)) = o;
    }
  }
  __syncthreads();
}

DI void phaseE(int wv0, PP p, unsigned char* smem, int cidx) {
  __shared__ int s_item;
  int* ctr = (int*)(p->ws + OFF_CTR) + cidx;
  for (;;) {
    __syncthreads();
    if (my_tid(wv0) == 0) s_item = atomicAdd(ctr, 1);
    __syncthreads();
    const int item = s_item;
    if (item >= 1024 + 2048 + (NXT - NXT_A)) break;
    if (item < 1024) nsa_item(wv0, p, item, smem);
    else if (item < 1024 + 2048) s5_item<true>(wv0, p, item - 1024, smem);
    else xpose_tile(wv0, p, NXT_A + (item - 3072), smem);
  }
}

DI void phaseF(int wv0, PP p, unsigned char* smem) {
  const u16* YS = (const u16*)(p->ws + OFF_YS);
  const u16* NSA = (const u16*)(p->ws + OFF_NSA);
  const u16* MG = (const u16*)(p->ws + OFF_MG);
  u16* MR = (u16*)(p->ws + OFF_MERGED);
  for (int id = blockIdx.x; id < 128 * 4; id += gridDim.x) {
    int pm, pn;
    tile_map_n4(id, pm, pn);
    const int brow = pm * 256, bcol = pn * 256;
    f32x4 acc[2][2][4][2];
#pragma unroll 1
    for (int h = 0; h < 2; ++h) {
      const int grp = pn * 2 + h;
      gemm256(wv0, acc, YS + (size_t)brow * 512, 512, (const u16*)(p->ws + OFF_WVT) + (size_t)grp * 256 * 512, 512, 512, smem);
#pragma unroll
      for (int ai = 0; ai < 2; ++ai)
#pragma unroll
        for (int m = 0; m < 4; ++m)
#pragma unroll
          for (int n = 0; n < 2; ++n)
#pragma unroll
            for (int j = 0; j < 4; ++j) acc[ai][0][m][n][j] *= sigmoidf_(acc[ai][1][m][n][j]);
      __builtin_amdgcn_sched_barrier(0);
      epi256(wv0, acc, brow, grp * 128, [&](int ai, int bj, int m, int n, int row, int col0, f32x4& v) {
        if (bj == 0) {
          const unsigned og = (unsigned)row * 2048u + 1024u + (unsigned)col0, om = (unsigned)row * 1024u + (unsigned)col0;
          const uint2 gq = *(const uint2*)(MG + og);
          *(uint2*)(MR + om) = pk4(__uint_as_float(gq.x << 16) * v[0], __uint_as_float(gq.x & 0xffff0000u) * v[1],
                                   __uint_as_float(gq.y << 16) * v[2], __uint_as_float(gq.y & 0xffff0000u) * v[3]);
        }
      });
    }
    gemm256(wv0, acc, NSA + (size_t)brow * 512, 512, (const u16*)(p->ws + OFF_WAT) + (size_t)bcol * 512, 512, 512, smem);
    epi256(wv0, acc, brow, bcol, [&](int ai, int bj, int m, int n, int row, int col0, f32x4& v) {
      const unsigned og = (unsigned)row * 2048u + (unsigned)col0, om = (unsigned)row * 1024u + (unsigned)col0;
      const uint2 t = *(const uint2*)(MR + om);
      const uint2 gq = *(const uint2*)(MG + og);
      *(uint2*)(MR + om) =
          pk4(__uint_as_float(gq.x << 16) * v[0] + __uint_as_float(t.x << 16), __uint_as_float(gq.x & 0xffff0000u) * v[1] + __uint_as_float(t.x & 0xffff0000u),
              __uint_as_float(gq.y << 16) * v[2] + __uint_as_float(t.y << 16), __uint_as_float(gq.y & 0xffff0000u) * v[3] + __uint_as_float(t.y & 0xffff0000u));
    });
  }
}
DI void ss_partial(int wv0, f32x4 (&acc)[2][2][4][2], float* SS, int brow, int pn) {
  const int lane = my_tid(wv0) & 63, wr = wv0 >> 2, wc = wv0 & 3;
#pragma unroll
  for (int ai = 0; ai < 2; ++ai)
#pragma unroll
    for (int m = 0; m < 4; ++m) {
      float s = 0.f;
#pragma unroll
      for (int bj = 0; bj < 2; ++bj)
#pragma unroll
        for (int n = 0; n < 2; ++n)
#pragma unroll
          for (int j = 0; j < 4; ++j) s += acc[ai][bj][m][n][j] * acc[ai][bj][m][n][j];
      s += __shfl_xor(s, 16);
      s += __shfl_xor(s, 32);
      if (lane < 16) SS[(size_t)(brow + ai * 128 + wr * 64 + m * 16 + lane) * 16 + pn * 4 + wc] = s;
    }
}
DI void phaseG(int wv0, PP p, unsigned char* smem) {
  const u16* MR = (const u16*)(p->ws + OFF_MERGED);
  u16* X1B = (u16*)(p->ws + OFF_X1B);
  float* SS1 = (float*)(p->ws + OFF_SS1);
  for (int id = blockIdx.x; id < 128 * 4; id += gridDim.x) {
    int pm, pn;
    tile_map_n4(id, pm, pn);
    const int brow = pm * 256, bcol = pn * 256;
    f32x4 acc[2][2][4][2];
    gemm256(wv0, acc, MR + (size_t)brow * 1024, 1024, (const u16*)(p->ws + OFF_WOT) + (size_t)bcol * 1024, 1024, 1024, smem);
    epi256(wv0, acc, brow, bcol, [&](int ai, int bj, int m, int n, int row, int col0, f32x4& v) {
      const size_t o = (size_t)row * 1024 + col0;
      const float4 xv = *(const float4*)(p->x + o);
      v[0] += xv.x; v[1] += xv.y; v[2] += xv.z; v[3] += xv.w;
      *(uint2*)(X1B + o) = pk4(v[0], v[1], v[2], v[3]);
    });
    ss_partial(wv0, acc, SS1, brow, pn);
  }
}
DI void phaseH(int wv0, PP p, unsigned char* smem) {
  const u16* X1B = (const u16*)(p->ws + OFF_X1B);
  const float* SS1 = (const float*)(p->ws + OFF_SS1);
  u16* ACT = (u16*)(p->ws + OFF_ACT);
  float* sR = (float*)(smem + 131072);
  for (int id = blockIdx.x; id < 128 * 16; id += gridDim.x) {
    int pm, pn;
    tile_map_n16(id, pm, pn);
    const int brow = pm * 256, bcol = pn * 256;
    const int tid = my_tid(wv0);
    if (tid < 256) {
      const float4* s = (const float4*)(SS1 + (size_t)(brow + tid) * 16);
      const float4 a = s[0], b = s[1], c = s[2], d = s[3];
      const float t = a.x + a.y + a.z + a.w + b.x + b.y + b.z + b.w + c.x + c.y + c.z + c.w + d.x + d.y + d.z + d.w;
      sR[tid] = rsqrtf(t * (1.f / 1024.f) + 1e-6f);
    }
    f32x4 acc[2][2][4][2];
    gemm256(wv0, acc, X1B + (size_t)brow * 1024, 1024, (const u16*)(p->ws + OFF_WUPT) + (size_t)bcol * 1024, 1024, 1024, smem);
    epi256(wv0, acc, brow, bcol, [&](int ai, int bj, int m, int n, int row, int col0, f32x4& v) {
      const float ri = sR[row - brow];
      const float a0 = fmaxf(v[0] * ri, 0.f), a1 = fmaxf(v[1] * ri, 0.f), a2 = fmaxf(v[2] * ri, 0.f), a3 = fmaxf(v[3] * ri, 0.f);
      *(uint2*)(ACT + (size_t)row * 4096 + col0) = pk4(a0 * a0, a1 * a1, a2 * a2, a3 * a3);
    });
    __syncthreads();
  }
}
DI void phaseI(int wv0, PP p, unsigned char* smem) {
  const u16* ACT = (const u16*)(p->ws + OFF_ACT);
  const u16* X1B = (const u16*)(p->ws + OFF_X1B);
  float* SS2 = (float*)(p->ws + OFF_SS2);
  for (int id = blockIdx.x; id < 128 * 4; id += gridDim.x) {
    int pm, pn;
    tile_map_n4(id, pm, pn);
    const int brow = pm * 256, bcol = pn * 256;
    f32x4 acc[2][2][4][2];
    gemm256(wv0, acc, ACT + (size_t)brow * 4096, 4096, (const u16*)(p->ws + OFF_WDT) + (size_t)bcol * 4096, 4096, 4096, smem);
    epi256(wv0, acc, brow, bcol, [&](int ai, int bj, int m, int n, int row, int col0, f32x4& v) {
      const size_t o = (size_t)row * 1024 + col0;
      const uint2 xb = *(const uint2*)(X1B + o);
      v[0] += __uint_as_float(xb.x << 16); v[1] += __uint_as_float(xb.x & 0xffff0000u);
      v[2] += __uint_as_float(xb.y << 16); v[3] += __uint_as_float(xb.y & 0xffff0000u);
      *(float4*)(p->out + o) = make_float4(v[0], v[1], v[2], v[3]);
    });
    ss_partial(wv0, acc, SS2, brow, pn);
  }
}
DI void phaseJ(int wv0, PP p) {
  const int lane = my_tid(wv0) & 63;
  const float* SS2 = (const float*)(p->ws + OFF_SS2);
  for (int row = blockIdx.x * 8 + wv0; row < T_; row += gridDim.x * 8) {
    float t = (lane < 16) ? SS2[(size_t)row * 16 + lane] : 0.f;
    t = wave_sum(t);
    const float rinv = rsqrtf(t * (1.f / 1024.f) + 1e-6f);
    float4* xr = (float4*)(p->out + (size_t)row * 1024);
#pragma unroll
    for (int r = 0; r < 4; ++r) {
      float4 v = xr[lane + 64 * r];
      const float4 g = ((const float4*)p->g3)[lane + 64 * r];
      v.x *= rinv * g.x; v.y *= rinv * g.y; v.z *= rinv * g.z; v.w *= rinv * g.w;
      xr[lane + 64 * r] = v;
    }
  }
}


#define XB_TMO      128
#define XB_XCNT(j)  (256  + 64 * (j))
#define XB_XSUB(j)  (1280 + 64 * (j))
#define XB_XGEN(j)  (2304 + 64 * (j))
#define XB_TOP      3328
#define XB_TOPGEN   3392
#define XB_SPIN_CAP (1u << 18)
#define LAS __attribute__((address_space(3)))
DI unsigned xb_ld(unsigned* p) { return __hip_atomic_load(p, __ATOMIC_RELAXED, __HIP_MEMORY_SCOPE_AGENT); }
DI unsigned xb_add(unsigned* p, unsigned v) { return __hip_atomic_fetch_add(p, v, __ATOMIC_RELAXED, __HIP_MEMORY_SCOPE_AGENT); }
DI unsigned xb_xcc_id() { return (unsigned)__builtin_amdgcn_s_getreg((3 << 11) | 20) & 0xFu; }
#define XB_SPIN(cond, bar) do { unsigned _sp = 0; while (cond) { __builtin_amdgcn_s_sleep(1); \
    if ((++_sp & 255u) == 0u) { if (xb_ld(&(bar)[XB_TMO])) break; if (_sp > XB_SPIN_CAP) { atomicAdd(&(bar)[XB_TMO], 1u); break; } } } } while (0)
DI void xcd_barrier_complete(unsigned* bar, unsigned x, unsigned& nloc, unsigned& nx) {
  const unsigned G = gridDim.x * gridDim.y * gridDim.z;
  unsigned sum, cnt, mine, sp = 0u;
  for (;;) {
    sum = 0u; cnt = 0u; mine = 0u;
#pragma unroll
    for (unsigned j = 0; j < 16; ++j) { const unsigned c = xb_ld(&bar[XB_XCNT(j)]); sum += c; cnt += (c > 0u) ? 1u : 0u; mine = (j == x) ? c : mine; }
    if (sum == G) break;
    __builtin_amdgcn_s_sleep(1);
    if ((++sp & 255u) == 0u) { if (xb_ld(&bar[XB_TMO])) break; if (sp > XB_SPIN_CAP) { atomicAdd(&bar[XB_TMO], 1u); break; } }
  }
  nloc = mine > 0u ? mine : 1u; nx = cnt > 0u ? cnt : 1u;
}
DI void xcd_barrier(unsigned* bar, volatile LAS unsigned* st, bool leader) {
  asm volatile("s_waitcnt vmcnt(0)" ::: "memory");
  __syncthreads();
  if (leader) {
    const unsigned x = xb_xcc_id();
    __builtin_amdgcn_s_waitcnt(0);
    unsigned nloc = st[0], nx = st[1];
    if (nloc == 0u) { xcd_barrier_complete(bar, x, nloc, nx); st[0] = nloc; st[1] = nx; }
    const unsigned old = xb_add(&bar[XB_XSUB(x)], 1u);
    const unsigned gen = old / nloc;
    if (old + 1u == (gen + 1u) * nloc) {
      __builtin_amdgcn_fence(__ATOMIC_RELEASE, "agent");
      asm volatile("s_waitcnt vmcnt(0)" ::: "memory");
      const unsigned og = xb_add(&bar[XB_TOP], 1u);
      const unsigned tg = og / nx;
      if (og + 1u == (tg + 1u) * nx) xb_add(&bar[XB_TOPGEN], 1u);
      else XB_SPIN(xb_ld(&bar[XB_TOPGEN]) == tg, bar);
      __builtin_amdgcn_fence(__ATOMIC_ACQUIRE, "agent");
      xb_add(&bar[XB_XGEN(x)], 1u);
      asm volatile("s_waitcnt vmcnt(0)" ::: "memory");
    } else {
      XB_SPIN(xb_ld(&bar[XB_XGEN(x)]) == gen, bar);
      __builtin_amdgcn_fence(__ATOMIC_ACQUIRE, "agent");
      asm volatile("s_waitcnt vmcnt(0)" ::: "memory");
    }
  }
  __syncthreads();
}

__global__ void __launch_bounds__(512, 2) mega(Params p) {
  extern __shared__ __attribute__((aligned(16))) unsigned char smem[];
  const int wv0 = __builtin_amdgcn_readfirstlane((int)(threadIdx.x >> 6));
  const int lo = p.lo, hi = p.hi;
  PP kp0 = (PP)__builtin_amdgcn_kernarg_segment_ptr();
  __shared__ uint4 xb_words;
  if (threadIdx.x == 0) {
    xb_words = make_uint4(0u, 0u, 0u, 0u);
    (void)xb_add((unsigned*)(kp0->ws + OFF_BAR) + XB_XCNT(xb_xcc_id()), 1u);
  }
  __syncthreads();
#define PH(N, CALL)                                  \
  if (lo <= N && N < hi) {                           \
    PP kp = kp0;                                     \
    asm volatile("" : "+s"(kp));                     \
    if (N > lo) {                                    \
      if (N == 1) cg::this_grid().sync();            \
      else xcd_barrier((unsigned*)(kp->ws + OFF_BAR), (volatile LAS unsigned*)&xb_words, my_tid(wv0) == 0); \
    }                                                \
    CALL;                                            \
    if ((PROBE_MASK >> N) & 1) { CALL; }             \
  }
  PH(0, phaseA(wv0, kp, smem))
  PH(1, phaseB(wv0, kp, smem))
  PH(2, phaseC(wv0, kp, smem))
  PH(3, phaseD1(wv0, kp, smem))
  PH(4, phaseD(wv0, kp, smem))
  PH(5, phaseE(wv0, kp, smem, 0))
  PH(6, phaseF(wv0, kp, smem))
  PH(7, phaseG(wv0, kp, smem))
  PH(8, phaseH(wv0, kp, smem))
  PH(9, phaseI(wv0, kp, smem))
  PH(10, phaseJ(wv0, kp))
}

extern "C" void kernel_launch(void* const* d_in, const int* in_sizes, int n_in, void* d_out, int out_size, void* d_ws,
                              size_t ws_size, hipStream_t stream) {
  static int grid_blocks = 0;
  if (!grid_blocks) {
    int dev = 0, cus = 0, per_cu = 0;
    (void)hipGetDevice(&dev);
    (void)hipDeviceGetAttribute(&cus, hipDeviceAttributeMultiprocessorCount, dev);
    (void)hipFuncSetAttribute((const void*)mega, hipFuncAttributeMaxDynamicSharedMemorySize, SMEM_BYTES);
    (void)hipOccupancyMaxActiveBlocksPerMultiprocessor(&per_cu, mega, NT_, SMEM_BYTES);
    if (per_cu > 1) per_cu = 1;
    if (per_cu < 1) per_cu = 1;
    grid_blocks = cus * per_cu;
  }
  if (ws_size < WS_NEED) { fprintf(stderr, "workspace too small: %zu < %zu\n", ws_size, (size_t)WS_NEED); }
  Params p{};
  const float** f = (const float**)&p;
  for (int i = 0; i < 24; ++i) f[i] = (const float*)d_in[i];
  p.out = (float*)d_out;
  p.ws = (unsigned char*)d_ws;
  p.lo = 0; p.hi = 11;
  (void)hipMemsetAsync((unsigned char*)d_ws + OFF_BAR, 0, 16384, stream);
  void* args[] = {&p};
  hipError_t e = hipLaunchCooperativeKernel((void*)mega, dim3(grid_blocks), dim3(NT_), args, SMEM_BYTES, stream);
  if (e != hipSuccess) fprintf(stderr, "cooperative launch failed: %s (grid %d)\n", hipGetErrorString(e), grid_blocks);
}
```

```cpp
#include <hip/hip_runtime.h>
#include <hip/hip_cooperative_groups.h>
#include <cstdio>
namespace cg = cooperative_groups;

#ifndef PROBE_MASK
#define PROBE_MASK 0
#endif

#define DI __device__ __forceinline__
typedef unsigned short u16;
typedef unsigned long long u64;
using bf16x8 = __attribute__((ext_vector_type(8))) short;
using f32x4 = __attribute__((ext_vector_type(4))) float;
using u32x4 = __attribute__((ext_vector_type(4))) unsigned;

constexpr int B_ = 4, S_ = 8192, T_ = B_ * S_;
constexpr int NT_ = 512;
constexpr int NINP = 4096;
constexpr float QSCALE = 0.125f * 1.44269504089f;

constexpr size_t MB = 1024 * 1024;
constexpr size_t OFF_WINT = 0;
constexpr size_t OFF_W1KT = OFF_WINT + (size_t)NINP * 1024 * 2;
constexpr size_t OFF_W1VT = OFF_W1KT + 256 * 2048 * 2;
constexpr size_t OFF_W2KT = OFF_W1VT + 256 * 2048 * 2;
constexpr size_t OFF_W2VT = OFF_W2KT + 256 * 256 * 2;
constexpr size_t OFF_WAT = OFF_W2VT + 256 * 256 * 2;
constexpr size_t OFF_WVT = OFF_WAT + 1024 * 512 * 2;
constexpr size_t OFF_WGT = OFF_WVT + 1024 * 512 * 2;
constexpr size_t OFF_WOT = OFF_WGT + 1024 * 512 * 2;
constexpr size_t OFF_WUPT = OFF_WOT + 1024 * 1024 * 2;
constexpr size_t OFF_WDT = OFF_WUPT + 4096 * 1024 * 2;
constexpr size_t OFF_ROPE = OFF_WDT + 4096 * 1024 * 2;
constexpr size_t OFF_CBP = OFF_ROPE + 8192 * 16 * 4;
constexpr size_t OFF_CTR = OFF_CBP + 2 * 32 * 256 * 4;
constexpr size_t OFF_KMAX = OFF_CTR + 64;
constexpr size_t OFF_BAR = OFF_CTR + 256;
constexpr size_t OFF_SS1 = OFF_BAR + 16384;
constexpr size_t OFF_SS2 = OFF_SS1 + (size_t)T_ * 16 * 4;
constexpr size_t OFF_NG = OFF_SS2 + (size_t)T_ * 16 * 4;
constexpr size_t OFF_HC = OFF_NG + (size_t)T_ * 24 * 4;
constexpr size_t OFF_KCC = OFF_HC + 2 * 4096 * 256 * 2;
constexpr size_t OFF_VCT = OFF_KCC + 8 * 512 * 64 * 2;
constexpr size_t OFF_HLOC = OFF_VCT + 8 * 512 * 64 * 2;
constexpr size_t OFF_ARENA = OFF_HLOC + (size_t)4 * 128 * 32 * 64 * 8;
constexpr size_t OFF_MG = OFF_ARENA;
constexpr size_t OFF_HN = OFF_ARENA + 128 * MB;
constexpr size_t OFF_QRAW = OFF_ARENA + 192 * MB;
constexpr size_t OFF_QROT = OFF_ARENA + 224 * MB;
constexpr size_t OFF_KCIN = OFF_ARENA + 256 * MB;
constexpr size_t OFF_VCIN = OFF_KCIN + 8 * MB;
constexpr size_t OFF_KS = OFF_VCIN + 8 * MB;
constexpr size_t OFF_VST = OFF_KS + 8 * MB;
constexpr size_t OFF_KW = OFF_VST + 8 * MB;
constexpr size_t OFF_VWT = OFF_KW + 8 * MB;
constexpr size_t OFF_U = OFF_ARENA + 304 * MB;
constexpr size_t OFF_NSA = OFF_ARENA + 336 * MB;
constexpr size_t OFF_YS = OFF_ARENA + 368 * MB;
constexpr size_t OFF_CPART = OFF_ARENA + 400 * MB;
constexpr size_t OFF_S5T = OFF_CPART + 32 * MB;
constexpr size_t OFF_S5L = OFF_S5T + 32 * 8192;
constexpr size_t WS_NEED = OFF_S5L + 32 * 64 * 8;
constexpr size_t OFF_ACT = OFF_ARENA;
constexpr size_t OFF_X1B = OFF_ARENA + 256 * MB;
constexpr size_t OFF_MERGED = OFF_HN;

constexpr int SMEM_BYTES = 131072 + 1024;

struct Params {
  const float *x, *g1, *w_in, *pe, *kw1, *kw2, *vw1, *vw2, *lam_re, *lam_im, *log_step, *b_re, *b_im, *c_re, *c_im, *dsk,
      *w_attn, *w_val, *w_gate, *w_out, *g2, *w_up, *w_down, *g3;
  float* out;
  unsigned char* ws;
  int lo, hi;
};

typedef const __attribute__((address_space(4))) Params* PP;

DI int my_tid(int wv0) {
  int t = wv0 * 64 + (int)__lane_id();
  asm volatile("" : "+v"(t));
  return t;
}
DI unsigned pk2(float a, float b);
DI u16 f2bf(float x) { return (u16)(pk2(x, 0.f) & 0xffffu); }
DI float bf2f(u16 h) { return __uint_as_float(((unsigned)h) << 16); }
typedef float f32x2_t __attribute__((ext_vector_type(2)));
typedef __bf16 bf16x2_t __attribute__((ext_vector_type(2)));
DI unsigned pk2(float a, float b) {
  const f32x2_t v = {a, b};
  return __builtin_bit_cast(unsigned, __builtin_convertvector(v, bf16x2_t));
}
DI uint2 pk4(float a, float b, float c, float d) { uint2 o; o.x = pk2(a, b); o.y = pk2(c, d); return o; }
DI float sigmoidf_(float x) { return 1.f / (1.f + __expf(-x)); }
DI float gelu_t(float x) {
  float u = 0.7978845608f * (x + 0.044715f * x * x * x);
  float e = __expf(2.f * u);
  float th = 1.f - 2.f / (e + 1.f);
  return 0.5f * x * (1.f + th);
}
DI float wave_sum(float v) {
#pragma unroll
  for (int o = 32; o > 0; o >>= 1) v += __shfl_xor(v, o);
  return v;
}
DI f32x4 mfma16(bf16x8 a, bf16x8 b, f32x4 c) { return __builtin_amdgcn_mfma_f32_16x16x32_bf16(a, b, c, 0, 0, 0); }

constexpr int G_HT = 128 * 64;
DI int lds_byte(int r, int c) {
  const int st = (r >> 4) * 2 + (c >> 5), rr = r & 15, cc = c & 31, ob = rr * 64 + cc * 2;
  return st * 1024 + (ob ^ (((ob >> 9) & 1) << 5));
}
DI void stage_rc(int b, int& R, int& C) {
  const int st = b / 1024, sb = b % 1024, swz = sb ^ (((sb >> 9) & 1) << 5);
  R = (st >> 1) * 16 + swz / 64;
  C = (st & 1) * 32 + (swz % 64) / 2;
}
typedef __attribute__((address_space(3))) unsigned* lds_u32p;
DI void gemm256(int wv0, f32x4 (&acc)[2][2][4][2], const u16* __restrict__ A, int lda, const u16* __restrict__ Bt, int ldb,
                int K, unsigned char* smem) {
  u16* shm = (u16*)smem;
  const int tid = my_tid(wv0), lane = tid & 63;
  const int wr = wv0 >> 2, wc = wv0 & 3, fr = lane & 15, fq = lane >> 4;
#define SA(b, h) (shm + ((b)*2 + (h)) * G_HT)
#define SB(b, h) (shm + (4 + (b)*2 + (h)) * G_HT)
  int sr0, sc0, sr1, sc1;
  stage_rc(tid * 16, sr0, sc0);
  stage_rc(tid * 16 + 8192, sr1, sc1);
  const u16* a0 = A + (size_t)sr0 * lda + sc0;
  const u16* a1 = A + (size_t)sr1 * lda + sc1;
  const u16* b0 = Bt + (size_t)sr0 * ldb + sc0;
  const u16* b1 = Bt + (size_t)sr1 * ldb + sc1;
#define STAGE_A(P, half, kt)                                                                                              \
  {                                                                                                                       \
    __builtin_amdgcn_global_load_lds((const unsigned*)(a0 + (size_t)((half)*128) * lda + (kt)*64),                        \
                                     (unsigned*)((char*)(P) + tid * 16), 16, 0, 0);                               \
    __builtin_amdgcn_global_load_lds((const unsigned*)(a1 + (size_t)((half)*128) * lda + (kt)*64),                        \
                                     (unsigned*)((char*)(P) + tid * 16 + 8192), 16, 0, 0);                        \
  }
#define STAGE_B(P, half, kt)                                                                                              \
  {                                                                                                                       \
    __builtin_amdgcn_global_load_lds((const unsigned*)(b0 + (size_t)((half)*128) * ldb + (kt)*64),                        \
                                     (unsigned*)((char*)(P) + tid * 16), 16, 0, 0);                               \
    __builtin_amdgcn_global_load_lds((const unsigned*)(b1 + (size_t)((half)*128) * ldb + (kt)*64),                        \
                                     (unsigned*)((char*)(P) + tid * 16 + 8192), 16, 0, 0);                        \
  }
#define LDA(dst, b, h)                                                                                                    \
  _Pragma("unroll") for (int m = 0; m < 4; ++m) _Pragma("unroll") for (int k = 0; k < 2; ++k)                             \
      dst[m][k] = *(const bf16x8*)((const unsigned char*)SA(b, h) + lds_byte(wr * 64 + m * 16 + fr, k * 32 + fq * 8));
#define LDB(dst, b, h)                                                                                                    \
  _Pragma("unroll") for (int n = 0; n < 2; ++n) _Pragma("unroll") for (int k = 0; k < 2; ++k)                             \
      dst[n][k] = *(const bf16x8*)((const unsigned char*)SB(b, h) + lds_byte(wc * 32 + n * 16 + fr, k * 32 + fq * 8));
#define MMA(ai, bj, At_, Bt_)                                                                                             \
  {                                                                                                                       \
    __builtin_amdgcn_s_setprio(1);                                                                                        \
    _Pragma("unroll") for (int m = 0; m < 4; ++m) _Pragma("unroll") for (int n = 0; n < 2; ++n)                           \
        _Pragma("unroll") for (int k = 0; k < 2; ++k) acc[ai][bj][m][n] =                                                 \
            __builtin_amdgcn_mfma_f32_16x16x32_bf16(Bt_[n][k], At_[m][k], acc[ai][bj][m][n], 0, 0, 0);                    \
    __builtin_amdgcn_s_setprio(0);                                                                                        \
  }
#define WAIT_V(n) asm volatile("s_waitcnt vmcnt(" #n ")" ::: "memory")
#define WAIT_L(n) asm volatile("s_waitcnt lgkmcnt(" #n ")" ::: "memory")
#define BAR __builtin_amdgcn_s_barrier()
#define SCHED __builtin_amdgcn_sched_barrier(0)
#pragma unroll
  for (int a = 0; a < 2; ++a)
#pragma unroll
    for (int b = 0; b < 2; ++b)
#pragma unroll
      for (int m = 0; m < 4; ++m)
#pragma unroll
        for (int n = 0; n < 2; ++n) acc[a][b][m][n] = f32x4{0.f, 0.f, 0.f, 0.f};
  bf16x8 At[4][2], B0[2][2], B1[2][2];
  const int nt = K / 64;
  WAIT_V(0);
  __syncthreads();
  STAGE_B(SB(0, 0), 0, 0) STAGE_A(SA(0, 0), 0, 0)
  STAGE_B(SB(0, 1), 1, 0) STAGE_A(SA(0, 1), 1, 0)
  if (wr == 1) BAR;
  WAIT_V(4); BAR;
  STAGE_B(SB(1, 0), 0, 1) STAGE_A(SA(1, 0), 0, 1) STAGE_B(SB(1, 1), 1, 1)
  WAIT_V(6); BAR;
#pragma unroll 1
  for (int t = 0; t < nt - 2; t += 2) {
    LDB(B0, 0, 0) SCHED; LDA(At, 0, 0) STAGE_A(SA(1, 1), 1, t + 1)
    WAIT_L(8); BAR; WAIT_L(0); MMA(0, 0, At, B0) BAR; SCHED;
    LDB(B1, 0, 1) STAGE_B(SB(0, 0), 0, t + 2)
    BAR; WAIT_L(0); MMA(0, 1, At, B1) BAR;
    LDA(At, 0, 1) STAGE_A(SA(0, 0), 0, t + 2)
    BAR; WAIT_L(0); MMA(1, 0, At, B0) BAR; SCHED;
    STAGE_B(SB(0, 1), 1, t + 2)
    WAIT_V(6); BAR; MMA(1, 1, At, B1) BAR;
    LDB(B0, 1, 0) SCHED; LDA(At, 1, 0) STAGE_A(SA(0, 1), 1, t + 2)
    WAIT_L(8); BAR; WAIT_L(0); MMA(0, 0, At, B0) BAR; SCHED;
    LDB(B1, 1, 1) STAGE_B(SB(1, 0), 0, t + 3)
    BAR; WAIT_L(0); MMA(0, 1, At, B1) BAR;
    LDA(At, 1, 1) STAGE_A(SA(1, 0), 0, t + 3)
    BAR; WAIT_L(0); MMA(1, 0, At, B0) BAR; SCHED;
    STAGE_B(SB(1, 1), 1, t + 3)
    WAIT_V(6); BAR; MMA(1, 1, At, B1) BAR;
  }
  {
    LDB(B0, 0, 0) LDA(At, 0, 0) STAGE_A(SA(1, 1), 1, nt - 1)
    BAR; WAIT_L(0); MMA(0, 0, At, B0) BAR;
    LDB(B1, 0, 1) BAR; WAIT_L(0); MMA(0, 1, At, B1) BAR;
    LDA(At, 0, 1) WAIT_V(4); BAR; WAIT_L(0); MMA(1, 0, At, B0) MMA(1, 1, At, B1) BAR;
  }
  {
    LDB(B0, 1, 0) LDA(At, 1, 0) WAIT_V(2); BAR; WAIT_L(0); MMA(0, 0, At, B0) BAR;
    LDB(B1, 1, 1) WAIT_V(0); BAR; WAIT_L(0); MMA(0, 1, At, B1) BAR;
    LDA(At, 1, 1) BAR; WAIT_L(0); MMA(1, 0, At, B0) MMA(1, 1, At, B1) BAR;
  }
  if (wr == 0) BAR;
}
DI void tile_map_n16(int id, int& pm, int& pn) {
  const int k = id & 255, rnd = id >> 8, x = k & 7, slot = k >> 3;
  pm = rnd * 16 + 4 * (x >> 1) + (slot >> 3);
  pn = 8 * (x & 1) + (slot & 7);
}
DI void tile_map_n4(int id, int& pm, int& pn) {
  const int k = id & 255, rnd = id >> 8, x = k & 7, slot = k >> 3;
  pm = rnd * 64 + 8 * x + (slot >> 2);
  pn = slot & 3;
}
template <class F>
DI void epi256(int wv0, f32x4 (&acc)[2][2][4][2], int brow, int bcol, F f) {
  const int lane = my_tid(wv0) & 63, wr = wv0 >> 2, wc = wv0 & 3;
#pragma unroll
  for (int ai = 0; ai < 2; ++ai)
#pragma unroll
    for (int bj = 0; bj < 2; ++bj)
#pragma unroll
      for (int m = 0; m < 4; ++m)
#pragma unroll
        for (int n = 0; n < 2; ++n) {
          const int row = brow + ai * 128 + wr * 64 + m * 16 + (lane & 15);
          const int col0 = bcol + bj * 128 + wc * 32 + n * 16 + (lane >> 4) * 4;
          f(ai, bj, m, n, row, col0, acc[ai][bj][m][n]);
          if (n == 1 && (m & 1)) __builtin_amdgcn_sched_barrier(0);
        }
}

constexpr int NXT_A = 1024 + 128 + 128 + 16 + 16;
constexpr int NXT = NXT_A + 128 * 3 + 256 + 1024 + 1024;
DI void xpose_tile(int wv0, PP p, int jt, unsigned char* smem) {
  const int tid = my_tid(wv0);
  float* tile = (float*)smem;
  int t = jt;
  const float* src;
  u16* dst;
  int K, Nsrc, mode = 0, rowil = -1;
  const float* scl = nullptr;
  if (t < 1024) { src = p->w_in; dst = (u16*)(p->ws + OFF_WINT); K = 1024; Nsrc = 3864; mode = 1; }
  else if ((t -= 1024) < 128) { src = p->kw1; dst = (u16*)(p->ws + OFF_W1KT); K = 2048; Nsrc = 256; }
  else if ((t -= 128) < 128) { src = p->vw1; dst = (u16*)(p->ws + OFF_W1VT); K = 2048; Nsrc = 256; }
  else if ((t -= 128) < 16) { src = p->kw2; dst = (u16*)(p->ws + OFF_W2KT); K = 256; Nsrc = 64; mode = 2; }
  else if ((t -= 16) < 16) { src = p->vw2; dst = (u16*)(p->ws + OFF_W2VT); K = 256; Nsrc = 64; mode = 2; }
  else if ((t -= 16) < 128) { src = p->w_attn; dst = (u16*)(p->ws + OFF_WAT); K = 512; Nsrc = 1024; }
  else if ((t -= 128) < 128) { src = p->w_val; dst = (u16*)(p->ws + OFF_WVT); K = 512; Nsrc = 1024; rowil = 0; }
  else if ((t -= 128) < 128) { src = p->w_gate; dst = (u16*)(p->ws + OFF_WVT); K = 512; Nsrc = 1024; rowil = 128; }
  else if ((t -= 128) < 256) { src = p->w_out; dst = (u16*)(p->ws + OFF_WOT); K = 1024; Nsrc = 1024; }
  else if ((t -= 256) < 1024) { src = p->w_up; dst = (u16*)(p->ws + OFF_WUPT); K = 1024; Nsrc = 4096; scl = p->g2; }
  else { t -= 1024; src = p->w_down; dst = (u16*)(p->ws + OFF_WDT); K = 4096; Nsrc = 1024; }
  const int nkt = K >> 6, tn = t / nkt, tk = t % nkt, n0 = tn * 64, k0 = tk * 64;
  const int tx = tid & 63, ty = tid >> 6;
  const int np = n0 + tx;
  int sc = np;
  if (mode == 1) {
    if (np < 1280) sc = np;
    else if (np < 1792) sc = 1304 + (np - 1280);
    else if (np < 3840) sc = 1816 + (np - 1792);
    else if (np < 3864) sc = 1280 + (np - 3840);
    else sc = -1;
  } else if (mode == 2) {
    sc = np < 64 ? np : -1;
  }
  for (int kk = ty; kk < 64; kk += 8) {
    float val = 0.f;
    if (sc >= 0) val = src[(size_t)(k0 + kk) * Nsrc + sc];
    if (scl) val *= scl[k0 + kk];
    tile[kk * 65 + tx] = val;
  }
  __syncthreads();
  {
    const int n = tid >> 3, kc = tid & 7;
    uint4 o;
    o.x = pk2(tile[(kc * 8 + 0) * 65 + n], tile[(kc * 8 + 1) * 65 + n]);
    o.y = pk2(tile[(kc * 8 + 2) * 65 + n], tile[(kc * 8 + 3) * 65 + n]);
    o.z = pk2(tile[(kc * 8 + 4) * 65 + n], tile[(kc * 8 + 5) * 65 + n]);
    o.w = pk2(tile[(kc * 8 + 6) * 65 + n], tile[(kc * 8 + 7) * 65 + n]);
    const int drow = rowil < 0 ? (n0 + n) : (((n0 + n) >> 7) * 256 + ((n0 + n) & 127) + rowil);
    *(uint4*)(dst + (size_t)drow * K + k0 + kc * 8) = o;
  }
  __syncthreads();
}

DI void phaseA(int wv0, PP p, unsigned char* smem) {
  const int tid = my_tid(wv0), lane = tid & 63;
  u16* HN = (u16*)(p->ws + OFF_HN);
  for (int row = blockIdx.x * 8 + wv0; row < T_; row += gridDim.x * 8) {
    const float4* xr = (const float4*)(p->x + (size_t)row * 1024);
    float4 v[4];
    float ss = 0.f;
#pragma unroll
    for (int r = 0; r < 4; ++r) {
      v[r] = xr[lane + 64 * r];
      ss += v[r].x * v[r].x + v[r].y * v[r].y + v[r].z * v[r].z + v[r].w * v[r].w;
    }
    ss = wave_sum(ss);
    const float rinv = rsqrtf(ss * (1.f / 1024.f) + 1e-6f);
#pragma unroll
    for (int r = 0; r < 4; ++r) {
      const float4 g = ((const float4*)p->g1)[lane + 64 * r];
      uint2 o;
      o.x = pk2(v[r].x * rinv * g.x, v[r].y * rinv * g.y);
      o.y = pk2(v[r].z * rinv * g.z, v[r].w * rinv * g.w);
      *(uint2*)(HN + (size_t)row * 1024 + (lane + 64 * r) * 4) = o;
    }
  }
  for (int jt = blockIdx.x; jt < NXT_A + 32 + 32; jt += gridDim.x) {
    if (jt < NXT_A) {
      xpose_tile(wv0, p, jt, smem);
    } else if (jt >= NXT_A + 32) {
      const int g = jt - (NXT_A + 32);
      u16* TB = (u16*)(p->ws + OFF_S5T + (size_t)g * 8192);
      const float step = expf(p->log_step[g]);
      for (int e = tid; e < 2048; e += NT_) {
        const int np = e >> 4, c = e & 15, n = np & 63;
        const float lr = p->lam_re[g * 64 + n], li = p->lam_im[g * 64 + n];
        const float er = expf(lr * step);
        float sn, cs;
        sincosf(li * step, &sn, &cs);
        const float nr = er * cs - 1.f, ni = er * sn, den = lr * lr + li * li;
        const float cr = (nr * lr + ni * li) / den, ci = (ni * lr - nr * li) / den;
        const float bre = p->b_re[(g * 64 + n) * 16 + c], bim = p->b_im[(g * 64 + n) * 16 + c];
        TB[np * 16 + c] = f2bf(np < 64 ? (cr * bre - ci * bim) : (cr * bim + ci * bre));
        const int cc = e >> 7, k = e & 127;
        TB[2048 + cc * 128 + k] = f2bf(k < 64 ? p->c_re[(g * 16 + cc) * 64 + k] : -p->c_im[(g * 16 + cc) * 64 + (k - 64)]);
      }
      if (tid < 64) {
        const float lr = p->lam_re[g * 64 + tid], li = p->lam_im[g * 64 + tid];
        const float er = expf(lr * step);
        float sn, cs;
        sincosf(li * step, &sn, &cs);
        ((float2*)(p->ws + OFF_S5L))[g * 64 + tid] = make_float2(er * cs, er * sn);
      }
    } else {
      const int item = jt - NXT_A, kv = item >> 4, slice = item & 15;
      const float* w1 = kv ? p->vw1 : p->kw1;
      const int col = tid & 255, h = tid >> 8, kb = slice * 128 + h * 64;
      float s0 = 0.f, s1 = 0.f, s2 = 0.f, s3 = 0.f;
      for (int k = kb; k < kb + 64; k += 4) {
        s0 += p->pe[k] * w1[(size_t)k * 256 + col];
        s1 += p->pe[k + 1] * w1[(size_t)(k + 1) * 256 + col];
        s2 += p->pe[k + 2] * w1[(size_t)(k + 2) * 256 + col];
        s3 += p->pe[k + 3] * w1[(size_t)(k + 3) * 256 + col];
      }
      ((float*)(p->ws + OFF_CBP))[(kv * 32 + slice * 2 + h) * 256 + col] = (s0 + s1) + (s2 + s3);
    }
  }
  float* rope = (float*)(p->ws + OFF_ROPE);
  for (int i = blockIdx.x * NT_ + tid; i < S_ * 8; i += gridDim.x * NT_) {
    const int pos = i >> 3, k = i & 7;
    const float inv = powf(500000.0f, -(2.0f * (float)k) / 16.0f);
    const float ang = (float)pos * inv;
    rope[pos * 16 + k] = cosf(ang);
    rope[pos * 16 + 8 + k] = sinf(ang);
  }
  if (blockIdx.x == 0 && tid < 64) ((int*)(p->ws + OFF_CTR))[tid] = 0;
}

DI void phaseB(int wv0, PP p, unsigned char* smem) {
  const u16* HN = (const u16*)(p->ws + OFF_HN);
  const u16* WT = (const u16*)(p->ws + OFF_WINT);
  const float* rope = (const float*)(p->ws + OFF_ROPE);
  const int lane = my_tid(wv0) & 63;
  const bool ropewave = (wv0 & 1) == 0;
  for (int id = blockIdx.x; id < 128 * 16; id += gridDim.x) {
    int pm, pn;
    tile_map_n16(id, pm, pn);
    const int brow = pm * 256, bcol = pn * 256;
    f32x4 acc[2][2][4][2];
    gemm256(wv0, acc, HN + (size_t)brow * 1024, 1024, WT + (size_t)bcol * 1024, 1024, 1024, smem);
    if (pn < 2) {
      u16* QR = (u16*)(p->ws + OFF_QRAW);
      u16* QO = (u16*)(p->ws + OFF_QROT);
      epi256(wv0, acc, brow, bcol, [&](int ai, int bj, int m, int n, int row, int col0, f32x4& v) {
        f32x4 r = v;
        if (n == 0 && ropewave) {
          const int pos = row & (S_ - 1), kq = ((lane >> 4) & 1) * 4;
          const float4 c4 = *(const float4*)(rope + pos * 16 + kq), s4 = *(const float4*)(rope + pos * 16 + 8 + kq);
          const float cc[4] = {c4.x, c4.y, c4.z, c4.w}, ss[4] = {s4.x, s4.y, s4.z, s4.w};
#pragma unroll
          for (int j = 0; j < 4; ++j) {
            const float pr = __shfl_xor(v[j], 32);
            r[j] = (lane & 32) ? (v[j] * cc[j] + pr * ss[j]) : (v[j] * cc[j] - pr * ss[j]);
          }
        }
        *(uint2*)(QR + (size_t)row * 512 + col0) = pk4(v[0] * QSCALE, v[1] * QSCALE, v[2] * QSCALE, v[3] * QSCALE);
        *(uint2*)(QO + (size_t)row * 512 + col0) = pk4(r[0] * QSCALE, r[1] * QSCALE, r[2] * QSCALE, r[3] * QSCALE);
      });
    } else if (pn < 5) {
      epi256(wv0, acc, brow, bcol, [&](int ai, int bj, int m, int n, int row, int col0, f32x4& v) {
        const int sub = (pn - 2) * 2 + bj;
        const bool dorope = (sub == 2 || sub == 4), transposed = (sub == 3 || sub == 5);
        u16* dst = (u16*)(p->ws + OFF_KCIN + (size_t)sub * 8 * MB);
        const int c128 = col0 & 127, g = c128 >> 6, d0 = c128 & 63;
        const int b = row >> 13, sq = row & (S_ - 1);
        f32x4 r = v;
        if (dorope && n == 0 && ropewave) {
          const int kq = ((lane >> 4) & 1) * 4;
          const float4 c4 = *(const float4*)(rope + sq * 16 + kq), s4 = *(const float4*)(rope + sq * 16 + 8 + kq);
          const float cc[4] = {c4.x, c4.y, c4.z, c4.w}, ss[4] = {s4.x, s4.y, s4.z, s4.w};
#pragma unroll
          for (int j = 0; j < 4; ++j) {
            const float pr = __shfl_xor(v[j], 32);
            r[j] = (lane & 32) ? (v[j] * cc[j] + pr * ss[j]) : (v[j] * cc[j] - pr * ss[j]);
          }
        }
        if (transposed) {
#pragma unroll
          for (int j = 0; j < 4; ++j) dst[((size_t)((b * 2 + g) * 64 + d0 + j)) * S_ + sq] = f2bf(r[j]);
        } else {
          *(uint2*)(dst + ((size_t)(b * 2 + g) * S_ + sq) * 64 + d0) = pk4(r[0], r[1], r[2], r[3]);
        }
      });
    } else if (pn < 7) {
      u16* U = (u16*)(p->ws + OFF_U);
      epi256(wv0, acc, brow, bcol, [&](int ai, int bj, int m, int n, int row, int col0, f32x4& v) {
        *(uint2*)(U + (size_t)row * 512 + (col0 - 1280)) = pk4(v[0], v[1], v[2], v[3]);
      });
    } else if (pn < 15) {
      u16* MG = (u16*)(p->ws + OFF_MG);
      epi256(wv0, acc, brow, bcol, [&](int ai, int bj, int m, int n, int row, int col0, f32x4& v) {
        *(uint2*)(MG + (size_t)row * 2048 + (col0 - 1792)) = pk4(sigmoidf_(v[0]), sigmoidf_(v[1]), sigmoidf_(v[2]), sigmoidf_(v[3]));
      });
    } else {
      float* NG = (float*)(p->ws + OFF_NG);
      epi256(wv0, acc, brow, bcol, [&](int ai, int bj, int m, int n, int row, int col0, f32x4& v) {
        const int cc = col0 - 3840;
        if (cc < 24) *(float4*)(NG + (size_t)row * 24 + cc) = make_float4(sigmoidf_(v[0]), sigmoidf_(v[1]), sigmoidf_(v[2]), sigmoidf_(v[3]));
      });
    }
  }
}

template <bool OUT>
DI void s5_item(int wv0, PP p, int item, unsigned char* smem) {
  const int tid = my_tid(wv0), lane = tid & 63, fr = lane & 15, fq = lane >> 4;
  const int b = item >> 9, g = (item >> 4) & 31, c8 = item & 15, ch = c8 * 8 + wv0;
  u16* sBb = (u16*)smem;
  u16* sCm = sBb + 128 * 16;
  float* sBU = (float*)(smem + 8192) + wv0 * (16 * 132);
  u16* sH = (u16*)(smem + 8192 + 8 * 16 * 132 * 4) + wv0 * (16 * 136);
  *(uint4*)(smem + tid * 16) = *(const uint4*)(p->ws + OFF_S5T + (size_t)g * 8192 + tid * 16);
  const float2 lb = ((const float2*)(p->ws + OFF_S5L))[g * 64 + lane];
  const float lbr = lb.x, lbi = lb.y;
  float2* HL = (float2*)(p->ws + OFF_HLOC) + ((size_t)(b * 128 + ch) * 32 + g) * 64 + lane;
  float hr = 0.f, hi = 0.f;
  if (OUT) { const float2 h0 = *HL; hr = h0.x; hi = h0.y; }
  const u16* U = (const u16*)(p->ws + OFF_U) + ((size_t)(b * S_ + ch * 64)) * 512 + g * 16;
  u16* YS = (u16*)(p->ws + OFF_YS) + ((size_t)(b * S_ + ch * 64)) * 512 + g * 16;
  const float dk = p->dsk[g * 16 + fr];
  const bf16x8 zero8 = {0, 0, 0, 0, 0, 0, 0, 0};
  bf16x8 uall[4];
  u16 usk[4][4];
#pragma unroll
  for (int sub = 0; sub < 4; ++sub) {
    uall[sub] = fq < 2 ? *(const bf16x8*)(U + (size_t)(sub * 16 + fr) * 512 + 8 * fq) : zero8;
    if (OUT) {
#pragma unroll
      for (int j = 0; j < 4; ++j) usk[sub][j] = U[(size_t)(sub * 16 + 4 * fq + j) * 512 + fr];
    }
  }
  __syncthreads();
  bf16x8 bb[8], cf[4];
#pragma unroll
  for (int nt = 0; nt < 8; ++nt) bb[nt] = fq < 2 ? *(const bf16x8*)(sBb + (16 * nt + fr) * 16 + 8 * fq) : zero8;
  if (OUT) {
#pragma unroll
    for (int ks = 0; ks < 4; ++ks) cf[ks] = *(const bf16x8*)(sCm + fr * 128 + 32 * ks + 8 * fq);
  }
#pragma unroll
  for (int sub = 0; sub < 4; ++sub) {
    const bf16x8 ua = uall[sub];
#pragma unroll
    for (int nt = 0; nt < 8; ++nt) {
      const f32x4 a = mfma16(ua, bb[nt], f32x4{0.f, 0.f, 0.f, 0.f});
#pragma unroll
      for (int j = 0; j < 4; ++j) sBU[(4 * fq + j) * 132 + 16 * nt + fr] = a[j];
    }
    __syncthreads();
#pragma unroll 4
    for (int t = 0; t < 16; ++t) {
      const float bur = sBU[t * 132 + lane], bui = sBU[t * 132 + 64 + lane];
      const float nr = lbr * hr - lbi * hi + bur;
      const float nim = lbr * hi + lbi * hr + bui;
      hr = nr;
      hi = nim;
      if (OUT) {
        sH[t * 136 + lane] = f2bf(hr);
        sH[t * 136 + 64 + lane] = f2bf(hi);
      }
    }
    __syncthreads();
    if (OUT) {
      f32x4 y = {0.f, 0.f, 0.f, 0.f};
#pragma unroll
      for (int ks = 0; ks < 4; ++ks) y = mfma16(*(const bf16x8*)(sH + fr * 136 + 32 * ks + 8 * fq), cf[ks], y);
#pragma unroll
      for (int j = 0; j < 4; ++j) {
        const size_t o = (size_t)(sub * 16 + 4 * fq + j) * 512 + fr;
        YS[o] = f2bf(gelu_t(y[j] + dk * bf2f(usk[sub][j])));
      }
      __syncthreads();
    }
  }
  if (!OUT) *HL = make_float2(hr, hi);
  __syncthreads();
}
DI void s5_carry(int wv0, PP p) {
  const int x = blockIdx.x * NT_ + my_tid(wv0);
  if (x >= 8192) return;
  const int b = x >> 11, g = (x >> 6) & 31, n = x & 63;
  const float step = expf(p->log_step[g]);
  const float lr = p->lam_re[g * 64 + n], li = p->lam_im[g * 64 + n];
  const float er = expf(64.f * lr * step);
  float sn, cs;
  sincosf(64.f * li * step, &sn, &cs);
  const float Lr = er * cs, Li = er * sn;
  float2* HL = (float2*)(p->ws + OFF_HLOC) + (size_t)b * 128 * 2048 + g * 64 + n;
  float hr = 0.f, hi = 0.f;
  for (int c0 = 0; c0 < 128; c0 += 16) {
    float2 v[16];
#pragma unroll
    for (int k = 0; k < 16; ++k) v[k] = HL[(size_t)(c0 + k) * 2048];
#pragma unroll
    for (int k = 0; k < 16; ++k) {
      HL[(size_t)(c0 + k) * 2048] = make_float2(hr, hi);
      const float nr = Lr * hr - Li * hi + v[k].x;
      const float nim = Lr * hi + Li * hr + v[k].y;
      hr = nr;
      hi = nim;
    }
  }
}
DI void phaseC(int wv0, PP p, unsigned char* smem) {
  for (int id = blockIdx.x; id < 128 + 2048 + 256; id += gridDim.x) {
    if (id >= 128 + 2048) {
      const int it = id - (128 + 2048), tns = it >> 7, bg = (it >> 4) & 7, part = it & 15;
      const int tid = my_tid(wv0);
      const u16* K = (const u16*)(p->ws + (tns ? OFF_KW : OFF_KS)) + ((size_t)bg * S_ + part * 512 + tid) * 64;
      float q2 = 0.f;
#pragma unroll
      for (int c = 0; c < 8; ++c) {
        const uint4 w = *(const uint4*)(K + c * 8);
        const unsigned ww[4] = {w.x, w.y, w.z, w.w};
#pragma unroll
        for (int e = 0; e < 4; ++e) {
          const float a = __uint_as_float(ww[e] << 16), b2 = __uint_as_float(ww[e] & 0xffff0000u);
          q2 += a * a + b2 * b2;
        }
      }
#pragma unroll
      for (int o = 32; o > 0; o >>= 1) q2 = fmaxf(q2, __shfl_xor(q2, o));
      if ((tid & 63) == 0) atomicMax((unsigned*)(p->ws + OFF_KMAX) + tns * 8 + bg, __float_as_uint(q2));
    } else if (id < 128) {
      const int kv = id >> 6, pm = (id >> 2) & 15, ks = id & 3, brow = pm * 256;
      const u16* A = (const u16*)(p->ws + (kv ? OFF_VCIN : OFF_KCIN)) + (size_t)brow * 1024 + ks * 512;
      const u16* Bt = (const u16*)(p->ws + (kv ? OFF_W1VT : OFF_W1KT)) + ks * 512;
      f32x4 acc[2][2][4][2];
      gemm256(wv0, acc, A, 1024, Bt, 2048, 512, smem);
      float* PART = (float*)(p->ws + OFF_CPART) + (size_t)(ks * 2 + kv) * 4096 * 256;
      epi256(wv0, acc, brow, 0, [&](int ai, int bj, int m, int n, int row, int col0, f32x4& v) {
        *(float4*)(PART + (size_t)row * 256 + col0) = make_float4(v[0], v[1], v[2], v[3]);
      });
    } else {
      s5_item<false>(wv0, p, id - 128, smem);
    }
  }
}
DI void phaseD1(int wv0, PP p, unsigned char* smem) {
  const int tid = my_tid(wv0);
  float* sB = (float*)smem;
  {
    const float* cbp = (const float*)(p->ws + OFF_CBP);
    float bb = 0.f;
    for (int sl = 0; sl < 32; ++sl) bb += cbp[((tid >> 8) * 32 + sl) * 256 + (tid & 255)];
    sB[tid] = bb;
  }
  __syncthreads();
  const float* PART = (const float*)(p->ws + OFF_CPART);
  u16* HC = (u16*)(p->ws + OFF_HC);
  for (int e = blockIdx.x * NT_ + tid; e < 2 * 4096 * 64; e += gridDim.x * NT_) {
    const int kv = e >> 18, rc = e & 262143, c4 = (rc & 63) * 4;
    const size_t o = (size_t)kv * 4096 * 256 + (size_t)rc * 4;
    float4 a = *(const float4*)(PART + o);
#pragma unroll
    for (int ks = 1; ks < 4; ++ks) {
      const float4 t = *(const float4*)(PART + (size_t)ks * 2 * 4096 * 256 + o);
      a.x += t.x; a.y += t.y; a.z += t.z; a.w += t.w;
    }
    const float* bv = sB + kv * 256 + c4;
    *(uint2*)(HC + o) = pk4(gelu_t(a.x + bv[0]), gelu_t(a.y + bv[1]), gelu_t(a.z + bv[2]), gelu_t(a.w + bv[3]));
  }
}
DI void phaseD(int wv0, PP p, unsigned char* smem) {
  for (int id = blockIdx.x; id < 32; id += gridDim.x) {
    const int kv = id >> 4, pm = id & 15, brow = pm * 256;
    const u16* A = (const u16*)(p->ws + OFF_HC) + (size_t)kv * 4096 * 256 + (size_t)brow * 256;
    const u16* Bt = (const u16*)(p->ws + (kv ? OFF_W2VT : OFF_W2KT));
    f32x4 acc[2][2][4][2];
    gemm256(wv0, acc, A, 256, Bt, 256, 256, smem);
    u16* KCC = (u16*)(p->ws + OFF_KCC);
    u16* VCT = (u16*)(p->ws + OFF_VCT);
    epi256(wv0, acc, brow, 0, [&](int ai, int bj, int m, int n, int row, int col0, f32x4& v) {
      if (col0 < 64) {
        const int bg = row >> 9, nn = row & 511;
        f32x4 r = v;
        if (nn == 511) r = f32x4{0.f, 0.f, 0.f, 0.f};
        if (kv == 0) {
          *(uint2*)(KCC + ((size_t)bg * 512 + nn) * 64 + col0) = pk4(r[0], r[1], r[2], r[3]);
        } else {
#pragma unroll
          for (int j = 0; j < 4; ++j) VCT[((size_t)bg * 64 + col0 + j) * 512 + nn] = f2bf(r[j]);
        }
      }
    });
  }
  s5_carry(wv0, p);
}

DI bool bit128(u64 lo, u64 hi, int j) { return j < 64 ? ((lo >> j) & 1ull) : ((hi >> (j - 64)) & 1ull); }
DI int next_bit(u64 lo, u64 hi, int from) {
  if (from < 64) {
    const u64 x = (lo >> from) << from;
    if (x) return __ffsll((long long)x) - 1;
    from = 64;
  }
  if (from >= 128) return -1;
  const u64 y = (hi >> (from - 64)) << (from - 64);
  return y ? 63 + __ffsll((long long)y) : -1;
}

template <int MODE, bool MASKED, class MaskF>
DI void flash_tile(const u16* sK, const u16* sV, const bf16x8 (&qf)[2][2], f32x4 (&O)[2][4], float (&m)[2], float (&l)[2],
                   float (&ps)[4][4], MaskF ok, bool sel, int lane) {
  const int l15 = lane & 15, lg = lane >> 4;
  bf16x8 kf[4][2];
#pragma unroll
  for (int kt = 0; kt < 4; ++kt)
#pragma unroll
    for (int ks = 0; ks < 2; ++ks) kf[kt][ks] = *(const bf16x8*)(sK + (16 * kt + l15) * 72 + ks * 32 + lg * 8);
  if (MODE == 1) {
#pragma unroll
    for (int a = 0; a < 4; ++a)
#pragma unroll
      for (int b = 0; b < 4; ++b) ps[a][b] = 0.f;
  }
  union PFrag { unsigned u[4]; bf16x8 v; };
  PFrag pf[2][2];
#pragma unroll
  for (int qt = 0; qt < 2; ++qt) {
    f32x4 s[4];
    const float sinit = (MODE == 3) ? ((MASKED || sel) ? m[qt] : -1e30f) : 0.f;
#pragma unroll
    for (int kt = 0; kt < 4; ++kt) {
      s[kt] = f32x4{sinit, sinit, sinit, sinit};
#pragma unroll
      for (int ks = 0; ks < 2; ++ks) s[kt] = mfma16(kf[kt][ks], qf[qt][ks], s[kt]);
    }
    float pr[4][4];
    if (MODE == 3) {
      float rs = 0.f;
#pragma unroll
      for (int kt = 0; kt < 4; ++kt)
#pragma unroll
        for (int i = 0; i < 4; ++i) {
          float pv = __builtin_amdgcn_exp2f(s[kt][i]);
          if (MASKED) pv = ok(kt, i) ? pv : 0.f;
          pr[kt][i] = pv;
          rs += pv;
        }
      l[qt] += rs;
    } else {
    float mx = -1e30f;
#pragma unroll
    for (int kt = 0; kt < 4; ++kt)
#pragma unroll
      for (int i = 0; i < 4; ++i) {
        if (MASKED) s[kt][i] = ok(kt, i) ? s[kt][i] : -1e30f;
        mx = fmaxf(mx, s[kt][i]);
      }
    if (!MASKED) mx = sel ? mx : -1e30f;
    if (MODE == 1) {
      const float mm = m[qt], il = l[qt];
#pragma unroll
      for (int kt = 0; kt < 4; ++kt)
#pragma unroll
        for (int i = 0; i < 4; ++i) {
          const float pv = (s[kt][i] > -1e29f) ? __builtin_amdgcn_exp2f(s[kt][i] - mm) * il : 0.f;
          pr[kt][i] = pv;
          ps[kt][i] += pv;
        }
    } else {
      mx = fmaxf(mx, __shfl_xor(mx, 16));
      mx = fmaxf(mx, __shfl_xor(mx, 32));
      const float mnew = fmaxf(m[qt], mx);
      const float alpha = __builtin_amdgcn_exp2f(m[qt] - mnew);
      m[qt] = mnew;
      float rs = 0.f;
      if (MASKED) {
#pragma unroll
        for (int kt = 0; kt < 4; ++kt)
#pragma unroll
          for (int i = 0; i < 4; ++i) {
            const float pv = (s[kt][i] > -1e29f) ? __builtin_amdgcn_exp2f(s[kt][i] - mnew) : 0.f;
            pr[kt][i] = pv;
            rs += pv;
          }
      } else {
        const float me = sel ? mnew : 1e30f;
#pragma unroll
        for (int kt = 0; kt < 4; ++kt)
#pragma unroll
          for (int i = 0; i < 4; ++i) {
            const float pv = __builtin_amdgcn_exp2f(s[kt][i] - me);
            pr[kt][i] = pv;
            rs += pv;
          }
      }
      l[qt] = l[qt] * alpha + rs;
      if (MODE == 2) {
#pragma unroll
        for (int dt = 0; dt < 4; ++dt) O[qt][dt] *= alpha;
      }
    }
    }
    if (MODE != 0) {
#pragma unroll
      for (int ks2 = 0; ks2 < 2; ++ks2) {
        pf[qt][ks2].u[0] = pk2(pr[2 * ks2][0], pr[2 * ks2][1]);
        pf[qt][ks2].u[1] = pk2(pr[2 * ks2][2], pr[2 * ks2][3]);
        pf[qt][ks2].u[2] = pk2(pr[2 * ks2 + 1][0], pr[2 * ks2 + 1][1]);
        pf[qt][ks2].u[3] = pk2(pr[2 * ks2 + 1][2], pr[2 * ks2 + 1][3]);
      }
    }
  }
  if (MODE != 0) {
#pragma unroll
    for (int ks2 = 0; ks2 < 2; ++ks2) {
#pragma unroll
      for (int dt = 0; dt < 4; ++dt) {
        union { uint2 h[2]; bf16x8 v; } vf;
        vf.h[0] = *(const uint2*)(sV + (16 * dt + l15) * 72 + 32 * ks2 + 4 * lg);
        vf.h[1] = *(const uint2*)(sV + (16 * dt + l15) * 72 + 32 * ks2 + 16 + 4 * lg);
        O[0][dt] = mfma16(vf.v, pf[0][ks2].v, O[0][dt]);
        O[1][dt] = mfma16(vf.v, pf[1][ks2].v, O[1][dt]);
      }
    }
  }
}

DI void flash_s3(const u16* sK, const bf16x8 (&qf)[2][2], float si0, float si1, f32x4 (&s)[2][4], int lane) {
  const int l15 = lane & 15, lg = lane >> 4;
  bf16x8 kf[4][2];
#pragma unroll
  for (int kt = 0; kt < 4; ++kt)
#pragma unroll
    for (int ks = 0; ks < 2; ++ks) kf[kt][ks] = *(const bf16x8*)(sK + (16 * kt + l15) * 72 + ks * 32 + lg * 8);
#pragma unroll
  for (int qt = 0; qt < 2; ++qt) {
    const float si = qt ? si1 : si0;
#pragma unroll
    for (int kt = 0; kt < 4; ++kt) {
      s[qt][kt] = f32x4{si, si, si, si};
#pragma unroll
      for (int ks = 0; ks < 2; ++ks) s[qt][kt] = mfma16(kf[kt][ks], qf[qt][ks], s[qt][kt]);
    }
  }
}
template <bool MASKED, class MaskF>
DI void flash_pv3(const u16* sV, const f32x4 (&s)[2][4], f32x4 (&O)[2][4], float (&l)[2], MaskF ok, int lane) {
  const int l15 = lane & 15, lg = lane >> 4;
  union PFrag { unsigned u[4]; bf16x8 v; };
  PFrag pf[2][2];
#pragma unroll
  for (int qt = 0; qt < 2; ++qt) {
    float pr[4][4];
    float rs = 0.f;
#pragma unroll
    for (int kt = 0; kt < 4; ++kt)
#pragma unroll
      for (int i = 0; i < 4; ++i) {
        float pv = __builtin_amdgcn_exp2f(s[qt][kt][i]);
        if (MASKED) pv = ok(kt, i) ? pv : 0.f;
        pr[kt][i] = pv;
        rs += pv;
      }
    l[qt] += rs;
#pragma unroll
    for (int ks2 = 0; ks2 < 2; ++ks2) {
      pf[qt][ks2].u[0] = pk2(pr[2 * ks2][0], pr[2 * ks2][1]);
      pf[qt][ks2].u[1] = pk2(pr[2 * ks2][2], pr[2 * ks2][3]);
      pf[qt][ks2].u[2] = pk2(pr[2 * ks2 + 1][0], pr[2 * ks2 + 1][1]);
      pf[qt][ks2].u[3] = pk2(pr[2 * ks2 + 1][2], pr[2 * ks2 + 1][3]);
    }
  }
#pragma unroll
  for (int ks2 = 0; ks2 < 2; ++ks2) {
#pragma unroll
    for (int dt = 0; dt < 4; ++dt) {
      union { uint2 h[2]; bf16x8 v; } vf;
      vf.h[0] = *(const uint2*)(sV + (16 * dt + l15) * 72 + 32 * ks2 + 4 * lg);
      vf.h[1] = *(const uint2*)(sV + (16 * dt + l15) * 72 + 32 * ks2 + 16 + 4 * lg);
      O[0][dt] = mfma16(vf.v, pf[0][ks2].v, O[0][dt]);
      O[1][dt] = mfma16(vf.v, pf[1][ks2].v, O[1][dt]);
    }
  }
}

DI void nsa_item(int wv0, PP p, int item, unsigned char* smem) {
  const int tid = my_tid(wv0), lane = tid & 63, wv = wv0 & 3, hp = wv0 >> 2, l15 = lane & 15, lg = lane >> 4;
  const int i = 127 - (item >> 3), bg = item & 7, b = bg >> 1, g = bg & 1;
  u16* sK = (u16*)smem;
  u16* sV = sK + 64 * 72;
  float* sImp0 = (float*)(smem + 55296);
  float* sImp = sImp0 + hp * (64 * 132);
  u64* sUni = (u64*)(smem + 55296 + 2 * 64 * 132 * 4);
  u64* sSel = sUni + 16;
  const int t0 = i * 64, qloc = 16 * wv + l15, tq = t0 + qloc;
  const unsigned tokq = (unsigned)(b * S_ + tq);
  const float* NGb = (const float*)(p->ws + OFF_NG);
  const unsigned ngoff = tokq * 24 + g * 12 + hp * 6;
  float* ACCb = p->out;
  const unsigned aoff = tokq * 512 + g * 256 + hp * 128 + 4 * lg;
  const unsigned qoff = tokq * 512 + g * 256 + hp * 128 + lg * 8;
  const int lrow = tid >> 3, lpart = tid & 7;
  const unsigned koff = (lrow * 64 + lpart * 8) * 2, voffc = (lrow * 512 + lpart * 8) * 2, voffs = (lrow * S_ + lpart * 8) * 2;

  for (int e = tid; e < 2 * 64 * 132; e += NT_) sImp0[e] = 0.f;

  bf16x8 qf[2][2];
  f32x4 O[2][4];
  float m[2], l[2], ps[4][4];
  u32x4 pk0, pv0;
  auto nomask = [](int, int) { return true; };

#define MAKE_RSRC(PTR) __builtin_amdgcn_make_buffer_rsrc((void*)(PTR), 0, 0x7fffffff, 0x00020000)
#define BLOAD(R, VO, SO) __builtin_amdgcn_raw_buffer_load_b128((R), (int)(VO), (int)(SO), 0)
#define ISSUE_TILE(RK, RV, T, LDV)                                                   \
  {                                                                                  \
    pk0 = BLOAD(RK, koff, (T)*8192);                                                 \
    pv0 = BLOAD(RV, ((LDV) == 512) ? voffc : voffs, (T)*128);                        \
  }
#define COMMIT_TILE()                                                                \
  {                                                                                  \
    *(u32x4*)(sK + lrow * 72 + lpart * 8) = pk0;                                     \
    *(u32x4*)(sV + lrow * 72 + lpart * 8) = pv0;                                     \
  }
#define COMMIT_BUF(BUF)                                                              \
  {                                                                                  \
    *(u32x4*)(sK + (BUF)*9216 + lrow * 72 + lpart * 8) = pk0;                        \
    *(u32x4*)(sV + (BUF)*9216 + lrow * 72 + lpart * 8) = pv0;                        \
  }
#define LOAD_Q(BASE)                                                                 \
  {                                                                                  \
    const u16* Q_ = (const u16*)(p->ws + (BASE));                                    \
    _Pragma("unroll") for (int qt = 0; qt < 2; ++qt)                                 \
      _Pragma("unroll") for (int ks = 0; ks < 2; ++ks)                               \
        qf[qt][ks] = *(const bf16x8*)(Q_ + (qoff + qt * 64 + ks * 32));             \
  }
#define RESET_STATE()                                                                \
  {                                                                                  \
    _Pragma("unroll") for (int qt = 0; qt < 2; ++qt) { m[qt] = -1e30f; l[qt] = 0.f; } \
    _Pragma("unroll") for (int a = 0; a < 2; ++a)                                    \
      _Pragma("unroll") for (int c = 0; c < 4; ++c) O[a][c] = f32x4{0.f, 0.f, 0.f, 0.f}; \
  }

  {
    const u16* Kc0 = (const u16*)(p->ws + OFF_KCC) + (size_t)bg * 512 * 64;
    const u16* Vc0 = (const u16*)(p->ws + OFF_VCT) + (size_t)bg * 64 * 512;
    const int nE = (4 * i + 3) < 511 ? (4 * i + 3) : 511;
    const int nkb = (nE + 63) >> 6;
    const __amdgpu_buffer_rsrc_t rK = MAKE_RSRC(Kc0), rV = MAKE_RSRC(Vc0);
    LOAD_Q(OFF_QRAW)
    RESET_STATE()
    ISSUE_TILE(rK, rV, 0, 512)
    for (int kb = 0; kb < nkb; ++kb) {
      __syncthreads();
      COMMIT_TILE()
      __syncthreads();
      if (kb + 1 < nkb) ISSUE_TILE(rK, rV, kb + 1, 512)
      auto ok = [&](int kt, int ii) { return 16 * (kb * 64 + 16 * kt + 4 * lg + ii) + 31 <= tq; };
      flash_tile<0, true>(sK, sV, qf, O, m, l, ps, ok, true, lane);
    }
#pragma unroll
    for (int qt = 0; qt < 2; ++qt) {
      float s = l[qt];
      s += __shfl_xor(s, 16);
      s += __shfl_xor(s, 32);
      l[qt] = s > 0.f ? 1.f / s : 0.f;
    }
    ISSUE_TILE(rK, rV, 0, 512)
    for (int kb = 0; kb < nkb; ++kb) {
      __syncthreads();
      COMMIT_TILE()
      __syncthreads();
      if (kb + 1 < nkb) ISSUE_TILE(rK, rV, kb + 1, 512)
      auto ok = [&](int kt, int ii) { return 16 * (kb * 64 + 16 * kt + 4 * lg + ii) + 31 <= tq; };
      flash_tile<1, true>(sK, sV, qf, O, m, l, ps, ok, true, lane);
#pragma unroll
      for (int kt = 0; kt < 4; ++kt) {
        const int j = kb * 16 + kt * 4 + lg;
        sImp[qloc * 132 + j] += ps[kt][0] + ps[kt][1] + ps[kt][2] + ps[kt][3];
      }
      __syncthreads();
#pragma unroll
      for (int kt = 0; kt < 4; ++kt) {
        const int j1 = kb * 16 + kt * 4 + lg + 1;
        if (j1 < 128) sImp[qloc * 132 + j1] += ps[kt][3];
      }
    }
#pragma unroll
    for (int qt = 0; qt < 2; ++qt) {
      const float gt = NGb[ngoff + qt * 3 + 0];
#pragma unroll
      for (int dt = 0; dt < 4; ++dt) {
        float4 o = make_float4(O[qt][dt][0] * gt, O[qt][dt][1] * gt, O[qt][dt][2] * gt, O[qt][dt][3] * gt);
        *(float4*)(ACCb + (aoff + qt * 64 + 16 * dt)) = o;
      }
    }
  }
  __syncthreads();
  u64 mlo = 0, mhi = 0, wlo = 0, whi = 0;
  if (i < 16) {
    mlo = (1ull << (i + 1)) - 1ull;
    wlo = mlo;
  } else {
    const bool v0 = lane <= i, v1 = (lane + 64) <= i;
    const bool f0 = (lane == 0) || (lane == i) || (lane == i - 1);
    const bool f1 = (lane + 64 == i) || (lane + 64 == i - 1);
    const u64 ltm = (1ull << lane) - 1ull;
    for (int qq = hp * 8; qq < hp * 8 + 8; ++qq) {
      const float* ir = sImp0 + (16 * wv + qq) * 132;
      const float i0 = ir[lane] + ir[64 * 132 + lane], i1 = ir[lane + 64] + ir[64 * 132 + lane + 64];
      const unsigned k0 = v0 ? __float_as_uint(i0 + (f0 ? 1000.f : 0.f)) : 0u;
      const unsigned k1 = v1 ? __float_as_uint(i1 + (f1 ? 1000.f : 0.f)) : 0u;
      unsigned T = 0;
      for (int bit = 30; bit >= 0; --bit) {
        const unsigned cand = T | (1u << bit);
        const int cnt = __popcll(__ballot(k0 >= cand)) + __popcll(__ballot(k1 >= cand));
        if (cnt >= 16) T = cand;
      }
      const bool g0 = k0 > T, g1 = k1 > T, e0 = k0 == T, e1 = k1 == T;
      const int need = 16 - (__popcll(__ballot(g0)) + __popcll(__ballot(g1)));
      const u64 be0 = __ballot(e0), be1 = __ballot(e1);
      const int r0 = __popcll(be0 & ltm), r1 = __popcll(be0) + __popcll(be1 & ltm);
      const u64 s0 = __ballot(v0 && (g0 || (e0 && r0 < need)));
      const u64 s1 = __ballot(v1 && (g1 || (e1 && r1 < need)));
      wlo |= s0;
      whi |= s1;
      if (lane == 0) { sSel[(16 * wv + qq) * 2] = s0; sSel[(16 * wv + qq) * 2 + 1] = s1; }
    }
  }
  if (lane == 0) { sUni[wv0 * 2] = wlo; sUni[wv0 * 2 + 1] = whi; }
  __syncthreads();
  if (i >= 16) { mlo = sSel[qloc * 2]; mhi = sSel[qloc * 2 + 1]; }
  wlo = sUni[wv * 2] | sUni[(wv + 4) * 2];
  whi = sUni[wv * 2 + 1] | sUni[(wv + 4) * 2 + 1];
  const u64 blo = sUni[0] | sUni[2] | sUni[4] | sUni[6] | sUni[8] | sUni[10] | sUni[12] | sUni[14];
  const u64 bhi = sUni[1] | sUni[3] | sUni[5] | sUni[7] | sUni[9] | sUni[11] | sUni[13] | sUni[15];

  LOAD_Q(OFF_QROT)
  float nb_s[2], nb_w[2];
  bool usefix;
  {
    const float* KM = (const float*)(p->ws + OFF_KMAX);
    const float kms = KM[bg], kmw = KM[8 + bg];
    float bmax = 0.f;
#pragma unroll
    for (int qt = 0; qt < 2; ++qt) {
      float q2 = 0.f;
#pragma unroll
      for (int ks = 0; ks < 2; ++ks)
#pragma unroll
        for (int e = 0; e < 8; ++e) {
          const float qv = __uint_as_float(((unsigned)(u16)qf[qt][ks][e]) << 16);
          q2 += qv * qv;
        }
      q2 += __shfl_xor(q2, 16);
      q2 += __shfl_xor(q2, 32);
      const float bs = sqrtf(q2 * kms) * 1.001f + 1e-3f, bw = sqrtf(q2 * kmw) * 1.001f + 1e-3f;
      nb_s[qt] = -bs;
      nb_w[qt] = -bw;
      bmax = fmaxf(bmax, fmaxf(bs, bw));
    }
    usefix = __ballot(bmax > 60.f) == 0ull;
  }
  RESET_STATE()
  if (usefix) { m[0] = nb_s[0]; m[1] = nb_s[1]; }
  {
    const __amdgpu_buffer_rsrc_t rK = MAKE_RSRC((const u16*)(p->ws + OFF_KS) + (size_t)bg * S_ * 64);
    const __amdgpu_buffer_rsrc_t rV = MAKE_RSRC((const u16*)(p->ws + OFF_VST) + (size_t)bg * 64 * S_);
    if (usefix) {
      int jc = next_bit(blo, bhi, 0);
      int j1 = next_bit(blo, bhi, jc + 1);
      ISSUE_TILE(rK, rV, jc, S_)
      COMMIT_BUF(0)
      if (j1 >= 0) {
        ISSUE_TILE(rK, rV, j1, S_)
        COMMIT_BUF(1)
      }
      __syncthreads();
      int j2 = j1 >= 0 ? next_bit(blo, bhi, j1 + 1) : -1;
      if (j2 >= 0) ISSUE_TILE(rK, rV, j2, S_)
      f32x4 sc_[2][4], sn_[2][4];
      {
        const bool selc = bit128(mlo, mhi, jc);
        flash_s3(sK, qf, (selc || jc == i) ? m[0] : -1e30f, (selc || jc == i) ? m[1] : -1e30f, sc_, lane);
      }
      int bc = 0;
      while (jc >= 0) {
        const int bn = bc == 2 ? 0 : bc + 1, bn2 = bn == 2 ? 0 : bn + 1;
        const bool needn = j1 >= 0 && bit128(wlo, whi, j1);
        if (needn) {
          const bool seln = bit128(mlo, mhi, j1);
          const bool on = seln || j1 == i;
          flash_s3(sK + bn * 9216, qf, on ? m[0] : -1e30f, on ? m[1] : -1e30f, sn_, lane);
        }
        if (bit128(wlo, whi, jc)) {
          if (jc == i) {
            const bool sel = bit128(mlo, mhi, jc);
            auto ok = [&](int kt, int ii) { return sel && (16 * kt + 4 * lg + ii) <= qloc; };
            flash_pv3<true>(sV + bc * 9216, sc_, O, l, ok, lane);
          } else {
            flash_pv3<false>(sV + bc * 9216, sc_, O, l, nomask, lane);
          }
        }
        if (j2 >= 0) COMMIT_BUF(bn2)
        __syncthreads();
        jc = j1;
        j1 = j2;
        bc = bn;
        if (j1 >= 0) {
          j2 = next_bit(blo, bhi, j1 + 1);
          if (j2 >= 0) ISSUE_TILE(rK, rV, j2, S_)
        } else {
          j2 = -1;
        }
#pragma unroll
        for (int a = 0; a < 2; ++a)
#pragma unroll
          for (int c = 0; c < 4; ++c) sc_[a][c] = sn_[a][c];
      }
    } else {
      int j = next_bit(blo, bhi, 0);
      ISSUE_TILE(rK, rV, j, S_)
      COMMIT_BUF(0)
      __syncthreads();
      int jn = next_bit(blo, bhi, j + 1);
      if (jn >= 0) ISSUE_TILE(rK, rV, jn, S_)
      int cur = 0;
      while (j >= 0) {
        const u16* cK = sK + cur * 9216;
        const u16* cV = sV + cur * 9216;
        if (bit128(wlo, whi, j)) {
          const bool sel = bit128(mlo, mhi, j);
          if (j == i) {
            auto ok = [&](int kt, int ii) { return sel && (16 * kt + 4 * lg + ii) <= qloc; };
            if (usefix) flash_tile<3, true>(cK, cV, qf, O, m, l, ps, ok, true, lane);
            else flash_tile<2, true>(cK, cV, qf, O, m, l, ps, ok, true, lane);
          } else {
            if (usefix) flash_tile<3, false>(cK, cV, qf, O, m, l, ps, nomask, sel, lane);
            else flash_tile<2, false>(cK, cV, qf, O, m, l, ps, nomask, sel, lane);
          }
        }
        cur ^= 1;
        if (jn >= 0) COMMIT_BUF(cur)
        __syncthreads();
        j = jn;
        if (j >= 0) {
          jn = next_bit(blo, bhi, j + 1);
          if (jn >= 0) ISSUE_TILE(rK, rV, jn, S_)
        }
      }
    }
  }
#pragma unroll
  for (int qt = 0; qt < 2; ++qt) {
    float s = l[qt];
    s += __shfl_xor(s, 16);
    s += __shfl_xor(s, 32);
    const float sc = NGb[ngoff + qt * 3 + 1] / s;
#pragma unroll
    for (int dt = 0; dt < 4; ++dt) {
      float4* a = (float4*)(ACCb + (aoff + qt * 64 + 16 * dt));
      float4 o = *a;
      o.x += O[qt][dt][0] * sc; o.y += O[qt][dt][1] * sc; o.z += O[qt][dt][2] * sc; o.w += O[qt][dt][3] * sc;
      *a = o;
    }
  }
  RESET_STATE()
  if (usefix) { m[0] = nb_w[0]; m[1] = nb_w[1]; }
  {
    const __amdgpu_buffer_rsrc_t rK = MAKE_RSRC((const u16*)(p->ws + OFF_KW) + (size_t)bg * S_ * 64);
    const __amdgpu_buffer_rsrc_t rV = MAKE_RSRC((const u16*)(p->ws + OFF_VWT) + (size_t)bg * 64 * S_);
    const int j0 = i >= 8 ? i - 8 : 0;
    ISSUE_TILE(rK, rV, j0, S_)
    COMMIT_BUF(0)
    __syncthreads();
    if (j0 + 1 <= i) ISSUE_TILE(rK, rV, j0 + 1, S_)
    int cur = 0;
    for (int j = j0; j <= i; ++j) {
      const u16* cK = sK + cur * 9216;
      const u16* cV = sV + cur * 9216;
      if (j == i || j == i - 8) {
        auto ok = [&](int kt, int ii) {
          const int kp = j * 64 + 16 * kt + 4 * lg + ii;
          return kp <= tq && kp > tq - 512;
        };
        if (usefix) flash_tile<3, true>(cK, cV, qf, O, m, l, ps, ok, true, lane);
        else flash_tile<2, true>(cK, cV, qf, O, m, l, ps, ok, true, lane);
      } else {
        if (usefix) flash_tile<3, false>(cK, cV, qf, O, m, l, ps, nomask, true, lane);
        else flash_tile<2, false>(cK, cV, qf, O, m, l, ps, nomask, true, lane);
      }
      cur ^= 1;
      if (j + 1 <= i) COMMIT_BUF(cur)
      __syncthreads();
      if (j + 2 <= i) ISSUE_TILE(rK, rV, j + 2, S_)
    }
  }
  u16* NSAb = (u16*)(p->ws + OFF_NSA);
#pragma unroll
  for (int qt = 0; qt < 2; ++qt) {
    float s = l[qt];
    s += __shfl_xor(s, 16);
    s += __shfl_xor(s, 32);
    const float sc = NGb[ngoff + qt * 3 + 2] / s;
#pragma unroll
    for (int dt = 0; dt < 4; ++dt) {
      const float4 a = *(const float4*)(ACCb + (aoff + qt * 64 + 16 * dt));
      uint2 o;
      o.x = pk2(a.x + O[qt][dt][0] * sc, a.y + O[qt][dt][1] * sc);
      o.y = pk2(a.z + O[qt][dt][2] * sc, a.w + O[qt][dt][3] * sc);
      *(uint2*)(NSAb + (aoff + qt * 64 + 16 * dt)) = o;
    }
  }
  __syncthreads();
}

DI void phaseE(int wv0, PP p, unsigned char* smem, int cidx) {
  __shared__ int s_item;
  int* ctr = (int*)(p->ws + OFF_CTR) + cidx;
  for (;;) {
    __syncthreads();
    if (my_tid(wv0) == 0) s_item = atomicAdd(ctr, 1);
    __syncthreads();
    const int item = s_item;
    if (item >= 1024 + 2048 + (NXT - NXT_A)) break;
    if (item < 1024) nsa_item(wv0, p, item, smem);
    else if (item < 1024 + 2048) s5_item<true>(wv0, p, item - 1024, smem);
    else xpose_tile(wv0, p, NXT_A + (item - 3072), smem);
  }
}

DI void phaseF(int wv0, PP p, unsigned char* smem) {
  const u16* YS = (const u16*)(p->ws + OFF_YS);
  const u16* NSA = (const u16*)(p->ws + OFF_NSA);
  const u16* MG = (const u16*)(p->ws + OFF_MG);
  u16* MR = (u16*)(p->ws + OFF_MERGED);
  for (int id = blockIdx.x; id < 128 * 4; id += gridDim.x) {
    int pm, pn;
    tile_map_n4(id, pm, pn);
    const int brow = pm * 256, bcol = pn * 256;
    f32x4 acc[2][2][4][2];
#pragma unroll 1
    for (int h = 0; h < 2; ++h) {
      const int grp = pn * 2 + h;
      gemm256(wv0, acc, YS + (size_t)brow * 512, 512, (const u16*)(p->ws + OFF_WVT) + (size_t)grp * 256 * 512, 512, 512, smem);
#pragma unroll
      for (int ai = 0; ai < 2; ++ai)
#pragma unroll
        for (int m = 0; m < 4; ++m)
#pragma unroll
          for (int n = 0; n < 2; ++n)
#pragma unroll
            for (int j = 0; j < 4; ++j) acc[ai][0][m][n][j] *= sigmoidf_(acc[ai][1][m][n][j]);
      __builtin_amdgcn_sched_barrier(0);
      epi256(wv0, acc, brow, grp * 128, [&](int ai, int bj, int m, int n, int row, int col0, f32x4& v) {
        if (bj == 0) {
          const unsigned og = (unsigned)row * 2048u + 1024u + (unsigned)col0, om = (unsigned)row * 1024u + (unsigned)col0;
          const uint2 gq = *(const uint2*)(MG + og);
          *(uint2*)(MR + om) = pk4(__uint_as_float(gq.x << 16) * v[0], __uint_as_float(gq.x & 0xffff0000u) * v[1],
                                   __uint_as_float(gq.y << 16) * v[2], __uint_as_float(gq.y & 0xffff0000u) * v[3]);
        }
      });
    }
    gemm256(wv0, acc, NSA + (size_t)brow * 512, 512, (const u16*)(p->ws + OFF_WAT) + (size_t)bcol * 512, 512, 512, smem);
    epi256(wv0, acc, brow, bcol, [&](int ai, int bj, int m, int n, int row, int col0, f32x4& v) {
      const unsigned og = (unsigned)row * 2048u + (unsigned)col0, om = (unsigned)row * 1024u + (unsigned)col0;
      const uint2 t = *(const uint2*)(MR + om);
      const uint2 gq = *(const uint2*)(MG + og);
      *(uint2*)(MR + om) =
          pk4(__uint_as_float(gq.x << 16) * v[0] + __uint_as_float(t.x << 16), __uint_as_float(gq.x & 0xffff0000u) * v[1] + __uint_as_float(t.x & 0xffff0000u),
              __uint_as_float(gq.y << 16) * v[2] + __uint_as_float(t.y << 16), __uint_as_float(gq.y & 0xffff0000u) * v[3] + __uint_as_float(t.y & 0xffff0000u));
    });
  }
}
DI void ss_partial(int wv0, f32x4 (&acc)[2][2][4][2], float* SS, int brow, int pn) {
  const int lane = my_tid(wv0) & 63, wr = wv0 >> 2, wc = wv0 & 3;
#pragma unroll
  for (int ai = 0; ai < 2; ++ai)
#pragma unroll
    for (int m = 0; m < 4; ++m) {
      float s = 0.f;
#pragma unroll
      for (int bj = 0; bj < 2; ++bj)
#pragma unroll
        for (int n = 0; n < 2; ++n)
#pragma unroll
          for (int j = 0; j < 4; ++j) s += acc[ai][bj][m][n][j] * acc[ai][bj][m][n][j];
      s += __shfl_xor(s, 16);
      s += __shfl_xor(s, 32);
      if (lane < 16) SS[(size_t)(brow + ai * 128 + wr * 64 + m * 16 + lane) * 16 + pn * 4 + wc] = s;
    }
}
DI void phaseG(int wv0, PP p, unsigned char* smem) {
  const u16* MR = (const u16*)(p->ws + OFF_MERGED);
  u16* X1B = (u16*)(p->ws + OFF_X1B);
  float* SS1 = (float*)(p->ws + OFF_SS1);
  for (int id = blockIdx.x; id < 128 * 4; id += gridDim.x) {
    int pm, pn;
    tile_map_n4(id, pm, pn);
    const int brow = pm * 256, bcol = pn * 256;
    f32x4 acc[2][2][4][2];
    gemm256(wv0, acc, MR + (size_t)brow * 1024, 1024, (const u16*)(p->ws + OFF_WOT) + (size_t)bcol * 1024, 1024, 1024, smem);
    epi256(wv0, acc, brow, bcol, [&](int ai, int bj, int m, int n, int row, int col0, f32x4& v) {
      const size_t o = (size_t)row * 1024 + col0;
      const float4 xv = *(const float4*)(p->x + o);
      v[0] += xv.x; v[1] += xv.y; v[2] += xv.z; v[3] += xv.w;
      *(uint2*)(X1B + o) = pk4(v[0], v[1], v[2], v[3]);
    });
    ss_partial(wv0, acc, SS1, brow, pn);
  }
}
DI void phaseH(int wv0, PP p, unsigned char* smem) {
  const u16* X1B = (const u16*)(p->ws + OFF_X1B);
  const float* SS1 = (const float*)(p->ws + OFF_SS1);
  u16* ACT = (u16*)(p->ws + OFF_ACT);
  float* sR = (float*)(smem + 131072);
  for (int id = blockIdx.x; id < 128 * 16; id += gridDim.x) {
    int pm, pn;
    tile_map_n16(id, pm, pn);
    const int brow = pm * 256, bcol = pn * 256;
    const int tid = my_tid(wv0);
    if (tid < 256) {
      const float4* s = (const float4*)(SS1 + (size_t)(brow + tid) * 16);
      const float4 a = s[0], b = s[1], c = s[2], d = s[3];
      const float t = a.x + a.y + a.z + a.w + b.x + b.y + b.z + b.w + c.x + c.y + c.z + c.w + d.x + d.y + d.z + d.w;
      sR[tid] = rsqrtf(t * (1.f / 1024.f) + 1e-6f);
    }
    f32x4 acc[2][2][4][2];
    gemm256(wv0, acc, X1B + (size_t)brow * 1024, 1024, (const u16*)(p->ws + OFF_WUPT) + (size_t)bcol * 1024, 1024, 1024, smem);
    epi256(wv0, acc, brow, bcol, [&](int ai, int bj, int m, int n, int row, int col0, f32x4& v) {
      const float ri = sR[row - brow];
      const float a0 = fmaxf(v[0] * ri, 0.f), a1 = fmaxf(v[1] * ri, 0.f), a2 = fmaxf(v[2] * ri, 0.f), a3 = fmaxf(v[3] * ri, 0.f);
      *(uint2*)(ACT + (size_t)row * 4096 + col0) = pk4(a0 * a0, a1 * a1, a2 * a2, a3 * a3);
    });
    __syncthreads();
  }
}
DI void phaseI(int wv0, PP p, unsigned char* smem) {
  const u16* ACT = (const u16*)(p->ws + OFF_ACT);
  const u16* X1B = (const u16*)(p->ws + OFF_X1B);
  float* SS2 = (float*)(p->ws + OFF_SS2);
  for (int id = blockIdx.x; id < 128 * 4; id += gridDim.x) {
    int pm, pn;
    tile_map_n4(id, pm, pn);
    pm = 127 - pm;
    const int brow = pm * 256, bcol = pn * 256;
    f32x4 acc[2][2][4][2];
    gemm256(wv0, acc, ACT + (size_t)brow * 4096, 4096, (const u16*)(p->ws + OFF_WDT) + (size_t)bcol * 4096, 4096, 4096, smem);
    epi256(wv0, acc, brow, bcol, [&](int ai, int bj, int m, int n, int row, int col0, f32x4& v) {
      const size_t o = (size_t)row * 1024 + col0;
      const uint2 xb = *(const uint2*)(X1B + o);
      v[0] += __uint_as_float(xb.x << 16); v[1] += __uint_as_float(xb.x & 0xffff0000u);
      v[2] += __uint_as_float(xb.y << 16); v[3] += __uint_as_float(xb.y & 0xffff0000u);
      *(float4*)(p->out + o) = make_float4(v[0], v[1], v[2], v[3]);
    });
    ss_partial(wv0, acc, SS2, brow, pn);
  }
}
DI void phaseJ(int wv0, PP p) {
  const int lane = my_tid(wv0) & 63;
  const float* SS2 = (const float*)(p->ws + OFF_SS2);
  for (int row = blockIdx.x * 8 + wv0; row < T_; row += gridDim.x * 8) {
    float t = (lane < 16) ? SS2[(size_t)row * 16 + lane] : 0.f;
    t = wave_sum(t);
    const float rinv = rsqrtf(t * (1.f / 1024.f) + 1e-6f);
    float4* xr = (float4*)(p->out + (size_t)row * 1024);
#pragma unroll
    for (int r = 0; r < 4; ++r) {
      float4 v = xr[lane + 64 * r];
      const float4 g = ((const float4*)p->g3)[lane + 64 * r];
      v.x *= rinv * g.x; v.y *= rinv * g.y; v.z *= rinv * g.z; v.w *= rinv * g.w;
      xr[lane + 64 * r] = v;
    }
  }
}


#define XB_TMO      128
#define XB_XCNT(j)  (256  + 64 * (j))
#define XB_XSUB(j)  (1280 + 64 * (j))
#define XB_XGEN(j)  (2304 + 64 * (j))
#define XB_TOP      3328
#define XB_TOPGEN   3392
#define XB_SPIN_CAP (1u << 18)
#define LAS __attribute__((address_space(3)))
DI unsigned xb_ld(unsigned* p) { return __hip_atomic_load(p, __ATOMIC_RELAXED, __HIP_MEMORY_SCOPE_AGENT); }
DI unsigned xb_add(unsigned* p, unsigned v) { return __hip_atomic_fetch_add(p, v, __ATOMIC_RELAXED, __HIP_MEMORY_SCOPE_AGENT); }
DI unsigned xb_xcc_id() { return (unsigned)__builtin_amdgcn_s_getreg((3 << 11) | 20) & 0xFu; }
#define XB_SPIN(cond, bar) do { unsigned _sp = 0; while (cond) { __builtin_amdgcn_s_sleep(1); \
    if ((++_sp & 255u) == 0u) { if (xb_ld(&(bar)[XB_TMO])) break; if (_sp > XB_SPIN_CAP) { atomicAdd(&(bar)[XB_TMO], 1u); break; } } } } while (0)
DI void xcd_barrier_complete(unsigned* bar, unsigned x, unsigned& nloc, unsigned& nx) {
  const unsigned G = gridDim.x * gridDim.y * gridDim.z;
  unsigned sum, cnt, mine, sp = 0u;
  for (;;) {
    sum = 0u; cnt = 0u; mine = 0u;
#pragma unroll
    for (unsigned j = 0; j < 16; ++j) { const unsigned c = xb_ld(&bar[XB_XCNT(j)]); sum += c; cnt += (c > 0u) ? 1u : 0u; mine = (j == x) ? c : mine; }
    if (sum == G) break;
    __builtin_amdgcn_s_sleep(1);
    if ((++sp & 255u) == 0u) { if (xb_ld(&bar[XB_TMO])) break; if (sp > XB_SPIN_CAP) { atomicAdd(&bar[XB_TMO], 1u); break; } }
  }
  nloc = mine > 0u ? mine : 1u; nx = cnt > 0u ? cnt : 1u;
}
DI void xcd_barrier(unsigned* bar, volatile LAS unsigned* st, bool leader) {
  asm volatile("s_waitcnt vmcnt(0)" ::: "memory");
  __syncthreads();
  if (leader) {
    const unsigned x = xb_xcc_id();
    __builtin_amdgcn_s_waitcnt(0);
    unsigned nloc = st[0], nx = st[1];
    if (nloc == 0u) { xcd_barrier_complete(bar, x, nloc, nx); st[0] = nloc; st[1] = nx; }
    const unsigned old = xb_add(&bar[XB_XSUB(x)], 1u);
    const unsigned gen = old / nloc;
    if (old + 1u == (gen + 1u) * nloc) {
      __builtin_amdgcn_fence(__ATOMIC_RELEASE, "agent");
      asm volatile("s_waitcnt vmcnt(0)" ::: "memory");
      const unsigned og = xb_add(&bar[XB_TOP], 1u);
      const unsigned tg = og / nx;
      if (og + 1u == (tg + 1u) * nx) xb_add(&bar[XB_TOPGEN], 1u);
      else XB_SPIN(xb_ld(&bar[XB_TOPGEN]) == tg, bar);
      __builtin_amdgcn_fence(__ATOMIC_ACQUIRE, "agent");
      xb_add(&bar[XB_XGEN(x)], 1u);
      asm volatile("s_waitcnt vmcnt(0)" ::: "memory");
    } else {
      XB_SPIN(xb_ld(&bar[XB_XGEN(x)]) == gen, bar);
      __builtin_amdgcn_fence(__ATOMIC_ACQUIRE, "agent");
      asm volatile("s_waitcnt vmcnt(0)" ::: "memory");
    }
  }
  __syncthreads();
}

__global__ void __launch_bounds__(512, 2) mega(Params p) {
  extern __shared__ __attribute__((aligned(16))) unsigned char smem[];
  const int wv0 = __builtin_amdgcn_readfirstlane((int)(threadIdx.x >> 6));
  const int lo = p.lo, hi = p.hi;
  PP kp0 = (PP)__builtin_amdgcn_kernarg_segment_ptr();
  __shared__ uint4 xb_words;
  if (threadIdx.x == 0) {
    xb_words = make_uint4(0u, 0u, 0u, 0u);
    (void)xb_add((unsigned*)(kp0->ws + OFF_BAR) + XB_XCNT(xb_xcc_id()), 1u);
  }
  __syncthreads();
#define PH(N, CALL)                                  \
  if (lo <= N && N < hi) {                           \
    PP kp = kp0;                                     \
    asm volatile("" : "+s"(kp));                     \
    if (N > lo) {                                    \
      if (N == 1) cg::this_grid().sync();            \
      else xcd_barrier((unsigned*)(kp->ws + OFF_BAR), (volatile LAS unsigned*)&xb_words, my_tid(wv0) == 0); \
    }                                                \
    CALL;                                            \
    if ((PROBE_MASK >> N) & 1) { CALL; }             \
  }
  PH(0, phaseA(wv0, kp, smem))
  PH(1, phaseB(wv0, kp, smem))
  PH(2, phaseC(wv0, kp, smem))
  PH(3, phaseD1(wv0, kp, smem))
  PH(4, phaseD(wv0, kp, smem))
  PH(5, phaseE(wv0, kp, smem, 0))
  PH(6, phaseF(wv0, kp, smem))
  PH(7, phaseG(wv0, kp, smem))
  PH(8, phaseH(wv0, kp, smem))
  PH(9, phaseI(wv0, kp, smem))
  PH(10, phaseJ(wv0, kp))
}

extern "C" void kernel_launch(void* const* d_in, const int* in_sizes, int n_in, void* d_out, int out_size, void* d_ws,
                              size_t ws_size, hipStream_t stream) {
  static int grid_blocks = 0;
  if (!grid_blocks) {
    int dev = 0, cus = 0, per_cu = 0;
    (void)hipGetDevice(&dev);
    (void)hipDeviceGetAttribute(&cus, hipDeviceAttributeMultiprocessorCount, dev);
    (void)hipFuncSetAttribute((const void*)mega, hipFuncAttributeMaxDynamicSharedMemorySize, SMEM_BYTES);
    (void)hipOccupancyMaxActiveBlocksPerMultiprocessor(&per_cu, mega, NT_, SMEM_BYTES);
    if (per_cu > 1) per_cu = 1;
    if (per_cu < 1) per_cu = 1;
    grid_blocks = cus * per_cu;
  }
  if (ws_size < WS_NEED) { fprintf(stderr, "workspace too small: %zu < %zu\n", ws_size, (size_t)WS_NEED); }
  Params p{};
  const float** f = (const float**)&p;
  for (int i = 0; i < 24; ++i) f[i] = (const float*)d_in[i];
  p.out = (float*)d_out;
  p.ws = (unsigned char*)d_ws;
  p.lo = 0; p.hi = 11;
  (void)hipMemsetAsync((unsigned char*)d_ws + OFF_BAR, 0, 16384, stream);
  void* args[] = {&p};
  hipError_t e = hipLaunchCooperativeKernel((void*)mega, dim3(grid_blocks), dim3(NT_), args, SMEM_BYTES, stream);
  if (e != hipSuccess) fprintf(stderr, "cooperative launch failed: %s (grid %d)\n", hipGetErrorString(e), grid_blocks);
}
```

```cpp
#include <hip/hip_runtime.h>
#include <hip/hip_cooperative_groups.h>
#include <cstdio>
namespace cg = cooperative_groups;

#ifndef PROBE_MASK
#define PROBE_MASK 0
#endif

#define DI __device__ __forceinline__
typedef unsigned short u16;
typedef unsigned long long u64;
using bf16x8 = __attribute__((ext_vector_type(8))) short;
using f32x4 = __attribute__((ext_vector_type(4))) float;
using u32x4 = __attribute__((ext_vector_type(4))) unsigned;

constexpr int B_ = 4, S_ = 8192, T_ = B_ * S_;
constexpr int NT_ = 512;
constexpr int NINP = 4096;
constexpr float QSCALE = 0.125f * 1.44269504089f;

constexpr size_t MB = 1024 * 1024;
constexpr size_t OFF_WINT = 0;
constexpr size_t OFF_W1KT = OFF_WINT + (size_t)NINP * 1024 * 2;
constexpr size_t OFF_W1VT = OFF_W1KT + 256 * 2048 * 2;
constexpr size_t OFF_W2KT = OFF_W1VT + 256 * 2048 * 2;
constexpr size_t OFF_W2VT = OFF_W2KT + 256 * 256 * 2;
constexpr size_t OFF_WAT = OFF_W2VT + 256 * 256 * 2;
constexpr size_t OFF_WVT = OFF_WAT + 1024 * 512 * 2;
constexpr size_t OFF_WGT = OFF_WVT + 1024 * 512 * 2;
constexpr size_t OFF_WOT = OFF_WGT + 1024 * 512 * 2;
constexpr size_t OFF_WUPT = OFF_WOT + 1024 * 1024 * 2;
constexpr size_t OFF_WDT = OFF_WUPT + 4096 * 1024 * 2;
constexpr size_t OFF_ROPE = OFF_WDT + 4096 * 1024 * 2;
constexpr size_t OFF_CBP = OFF_ROPE + 8192 * 16 * 4;
constexpr size_t OFF_CTR = OFF_CBP + 2 * 32 * 256 * 4;
constexpr size_t OFF_KMAX = OFF_CTR + 64;
constexpr size_t OFF_BAR = OFF_CTR + 256;
constexpr size_t OFF_SS1 = OFF_BAR + 16384;
constexpr size_t OFF_SS2 = OFF_SS1 + (size_t)T_ * 16 * 4;
constexpr size_t OFF_NG = OFF_SS2 + (size_t)T_ * 16 * 4;
constexpr size_t OFF_HC = OFF_NG + (size_t)T_ * 24 * 4;
constexpr size_t OFF_KCC = OFF_HC + 2 * 4096 * 256 * 2;
constexpr size_t OFF_VCT = OFF_KCC + 8 * 512 * 64 * 2;
constexpr size_t OFF_HLOC = OFF_VCT + 8 * 512 * 64 * 2;
constexpr size_t OFF_ARENA = OFF_HLOC + (size_t)4 * 128 * 32 * 64 * 8;
constexpr size_t OFF_MG = OFF_ARENA;
constexpr size_t OFF_HN = OFF_ARENA + 128 * MB;
constexpr size_t OFF_QRAW = OFF_ARENA + 192 * MB;
constexpr size_t OFF_QROT = OFF_ARENA + 224 * MB;
constexpr size_t OFF_KCIN = OFF_ARENA + 256 * MB;
constexpr size_t OFF_VCIN = OFF_KCIN + 8 * MB;
constexpr size_t OFF_KS = OFF_VCIN + 8 * MB;
constexpr size_t OFF_VST = OFF_KS + 8 * MB;
constexpr size_t OFF_KW = OFF_VST + 8 * MB;
constexpr size_t OFF_VWT = OFF_KW + 8 * MB;
constexpr size_t OFF_U = OFF_ARENA + 304 * MB;
constexpr size_t OFF_NSA = OFF_ARENA + 336 * MB;
constexpr size_t OFF_YS = OFF_ARENA + 368 * MB;
constexpr size_t OFF_CPART = OFF_ARENA + 400 * MB;
constexpr size_t OFF_S5T = OFF_CPART + 32 * MB;
constexpr size_t OFF_S5L = OFF_S5T + 32 * 8192;
constexpr size_t WS_NEED = OFF_S5L + 32 * 64 * 8;
constexpr size_t OFF_ACT = OFF_ARENA;
constexpr size_t OFF_X1B = OFF_ARENA + 256 * MB;
constexpr size_t OFF_MERGED = OFF_HN;

constexpr int SMEM_BYTES = 131072 + 1024;

struct Params {
  const float *x, *g1, *w_in, *pe, *kw1, *kw2, *vw1, *vw2, *lam_re, *lam_im, *log_step, *b_re, *b_im, *c_re, *c_im, *dsk,
      *w_attn, *w_val, *w_gate, *w_out, *g2, *w_up, *w_down, *g3;
  float* out;
  unsigned char* ws;
  int lo, hi;
};

typedef const __attribute__((address_space(4))) Params* PP;

DI int my_tid(int wv0) {
  int t = wv0 * 64 + (int)__lane_id();
  asm volatile("" : "+v"(t));
  return t;
}
DI unsigned pk2(float a, float b);
DI u16 f2bf(float x) { return (u16)(pk2(x, 0.f) & 0xffffu); }
DI float bf2f(u16 h) { return __uint_as_float(((unsigned)h) << 16); }
typedef float f32x2_t __attribute__((ext_vector_type(2)));
typedef __bf16 bf16x2_t __attribute__((ext_vector_type(2)));
DI unsigned pk2(float a, float b) {
  const f32x2_t v = {a, b};
  return __builtin_bit_cast(unsigned, __builtin_convertvector(v, bf16x2_t));
}
DI uint2 pk4(float a, float b, float c, float d) { uint2 o; o.x = pk2(a, b); o.y = pk2(c, d); return o; }
DI float sigmoidf_(float x) { return 1.f / (1.f + __expf(-x)); }
DI float gelu_t(float x) {
  float u = 0.7978845608f * (x + 0.044715f * x * x * x);
  float e = __expf(2.f * u);
  float th = 1.f - 2.f / (e + 1.f);
  return 0.5f * x * (1.f + th);
}
DI float wave_sum(float v) {
#pragma unroll
  for (int o = 32; o > 0; o >>= 1) v += __shfl_xor(v, o);
  return v;
}
DI f32x4 mfma16(bf16x8 a, bf16x8 b, f32x4 c) { return __builtin_amdgcn_mfma_f32_16x16x32_bf16(a, b, c, 0, 0, 0); }

constexpr int G_HT = 128 * 64;
DI int lds_byte(int r, int c) {
  const int st = (r >> 4) * 2 + (c >> 5), rr = r & 15, cc = c & 31, ob = rr * 64 + cc * 2;
  return st * 1024 + (ob ^ (((ob >> 9) & 1) << 5));
}
DI void stage_rc(int b, int& R, int& C) {
  const int st = b / 1024, sb = b % 1024, swz = sb ^ (((sb >> 9) & 1) << 5);
  R = (st >> 1) * 16 + swz / 64;
  C = (st & 1) * 32 + (swz % 64) / 2;
}
typedef __attribute__((address_space(3))) unsigned* lds_u32p;
DI void gemm256(int wv0, f32x4 (&acc)[2][2][4][2], const u16* __restrict__ A, int lda, const u16* __restrict__ Bt, int ldb,
                int K, unsigned char* smem) {
  u16* shm = (u16*)smem;
  const int tid = my_tid(wv0), lane = tid & 63;
  const int wr = wv0 >> 2, wc = wv0 & 3, fr = lane & 15, fq = lane >> 4;
#define SA(b, h) (shm + ((b)*2 + (h)) * G_HT)
#define SB(b, h) (shm + (4 + (b)*2 + (h)) * G_HT)
  int sr0, sc0, sr1, sc1;
  stage_rc(tid * 16, sr0, sc0);
  stage_rc(tid * 16 + 8192, sr1, sc1);
  const u16* a0 = A + (size_t)sr0 * lda + sc0;
  const u16* a1 = A + (size_t)sr1 * lda + sc1;
  const u16* b0 = Bt + (size_t)sr0 * ldb + sc0;
  const u16* b1 = Bt + (size_t)sr1 * ldb + sc1;
#define STAGE_A(P, half, kt)                                                                                              \
  {                                                                                                                       \
    __builtin_amdgcn_global_load_lds((const unsigned*)(a0 + (size_t)((half)*128) * lda + (kt)*64),                        \
                                     (unsigned*)((char*)(P) + tid * 16), 16, 0, 0);                               \
    __builtin_amdgcn_global_load_lds((const unsigned*)(a1 + (size_t)((half)*128) * lda + (kt)*64),                        \
                                     (unsigned*)((char*)(P) + tid * 16 + 8192), 16, 0, 0);                        \
  }
#define STAGE_B(P, half, kt)                                                                                              \
  {                                                                                                                       \
    __builtin_amdgcn_global_load_lds((const unsigned*)(b0 + (size_t)((half)*128) * ldb + (kt)*64),                        \
                                     (unsigned*)((char*)(P) + tid * 16), 16, 0, 0);                               \
    __builtin_amdgcn_global_load_lds((const unsigned*)(b1 + (size_t)((half)*128) * ldb + (kt)*64),                        \
                                     (unsigned*)((char*)(P) + tid * 16 + 8192), 16, 0, 0);                        \
  }
#define LDA(dst, b, h)                                                                                                    \
  _Pragma("unroll") for (int m = 0; m < 4; ++m) _Pragma("unroll") for (int k = 0; k < 2; ++k)                             \
      dst[m][k] = *(const bf16x8*)((const unsigned char*)SA(b, h) + lds_byte(wr * 64 + m * 16 + fr, k * 32 + fq * 8));
#define LDB(dst, b, h)                                                                                                    \
  _Pragma("unroll") for (int n = 0; n < 2; ++n) _Pragma("unroll") for (int k = 0; k < 2; ++k)                             \
      dst[n][k] = *(const bf16x8*)((const unsigned char*)SB(b, h) + lds_byte(wc * 32 + n * 16 + fr, k * 32 + fq * 8));
#define MMA(ai, bj, At_, Bt_)                                                                                             \
  {                                                                                                                       \
    __builtin_amdgcn_s_setprio(1);                                                                                        \
    _Pragma("unroll") for (int m = 0; m < 4; ++m) _Pragma("unroll") for (int n = 0; n < 2; ++n)                           \
        _Pragma("unroll") for (int k = 0; k < 2; ++k) acc[ai][bj][m][n] =                                                 \
            __builtin_amdgcn_mfma_f32_16x16x32_bf16(Bt_[n][k], At_[m][k], acc[ai][bj][m][n], 0, 0, 0);                    \
    __builtin_amdgcn_s_setprio(0);                                                                                        \
  }
#define WAIT_V(n) asm volatile("s_waitcnt vmcnt(" #n ")" ::: "memory")
#define WAIT_L(n) asm volatile("s_waitcnt lgkmcnt(" #n ")" ::: "memory")
#define BAR __builtin_amdgcn_s_barrier()
#define SCHED __builtin_amdgcn_sched_barrier(0)
#pragma unroll
  for (int a = 0; a < 2; ++a)
#pragma unroll
    for (int b = 0; b < 2; ++b)
#pragma unroll
      for (int m = 0; m < 4; ++m)
#pragma unroll
        for (int n = 0; n < 2; ++n) acc[a][b][m][n] = f32x4{0.f, 0.f, 0.f, 0.f};
  bf16x8 At[4][2], B0[2][2], B1[2][2];
  const int nt = K / 64;
  WAIT_V(0);
  __syncthreads();
  STAGE_B(SB(0, 0), 0, 0) STAGE_A(SA(0, 0), 0, 0)
  STAGE_B(SB(0, 1), 1, 0) STAGE_A(SA(0, 1), 1, 0)
  if (wr == 1) BAR;
  WAIT_V(4); BAR;
  STAGE_B(SB(1, 0), 0, 1) STAGE_A(SA(1, 0), 0, 1) STAGE_B(SB(1, 1), 1, 1)
  WAIT_V(6); BAR;
#pragma unroll 1
  for (int t = 0; t < nt - 2; t += 2) {
    LDB(B0, 0, 0) SCHED; LDA(At, 0, 0) STAGE_A(SA(1, 1), 1, t + 1)
    WAIT_L(8); BAR; WAIT_L(0); MMA(0, 0, At, B0) BAR; SCHED;
    LDB(B1, 0, 1) STAGE_B(SB(0, 0), 0, t + 2)
    BAR; WAIT_L(0); MMA(0, 1, At, B1) BAR;
    LDA(At, 0, 1) STAGE_A(SA(0, 0), 0, t + 2)
    BAR; WAIT_L(0); MMA(1, 0, At, B0) BAR; SCHED;
    STAGE_B(SB(0, 1), 1, t + 2)
    WAIT_V(6); BAR; MMA(1, 1, At, B1) BAR;
    LDB(B0, 1, 0) SCHED; LDA(At, 1, 0) STAGE_A(SA(0, 1), 1, t + 2)
    WAIT_L(8); BAR; WAIT_L(0); MMA(0, 0, At, B0) BAR; SCHED;
    LDB(B1, 1, 1) STAGE_B(SB(1, 0), 0, t + 3)
    BAR; WAIT_L(0); MMA(0, 1, At, B1) BAR;
    LDA(At, 1, 1) STAGE_A(SA(1, 0), 0, t + 3)
    BAR; WAIT_L(0); MMA(1, 0, At, B0) BAR; SCHED;
    STAGE_B(SB(1, 1), 1, t + 3)
    WAIT_V(6); BAR; MMA(1, 1, At, B1) BAR;
  }
  {
    LDB(B0, 0, 0) LDA(At, 0, 0) STAGE_A(SA(1, 1), 1, nt - 1)
    BAR; WAIT_L(0); MMA(0, 0, At, B0) BAR;
    LDB(B1, 0, 1) BAR; WAIT_L(0); MMA(0, 1, At, B1) BAR;
    LDA(At, 0, 1) WAIT_V(4); BAR; WAIT_L(0); MMA(1, 0, At, B0) MMA(1, 1, At, B1) BAR;
  }
  {
    LDB(B0, 1, 0) LDA(At, 1, 0) WAIT_V(2); BAR; WAIT_L(0); MMA(0, 0, At, B0) BAR;
    LDB(B1, 1, 1) WAIT_V(0); BAR; WAIT_L(0); MMA(0, 1, At, B1) BAR;
    LDA(At, 1, 1) BAR; WAIT_L(0); MMA(1, 0, At, B0) MMA(1, 1, At, B1) BAR;
  }
  if (wr == 0) BAR;
}
DI void tile_map_n16(int id, int& pm, int& pn) {
  const int k = id & 255, rnd = id >> 8, x = k & 7, slot = k >> 3;
  pm = rnd * 16 + 4 * (x >> 1) + (slot >> 3);
  pn = 8 * (x & 1) + (slot & 7);
}
DI void tile_map_n4(int id, int& pm, int& pn) {
  const int k = id & 255, rnd = id >> 8, x = k & 7, slot = k >> 3;
  pm = rnd * 64 + 8 * x + (slot >> 2);
  pn = slot & 3;
}
template <class F>
DI void epi256(int wv0, f32x4 (&acc)[2][2][4][2], int brow, int bcol, F f) {
  const int lane = my_tid(wv0) & 63, wr = wv0 >> 2, wc = wv0 & 3;
#pragma unroll
  for (int ai = 0; ai < 2; ++ai)
#pragma unroll
    for (int bj = 0; bj < 2; ++bj)
#pragma unroll
      for (int m = 0; m < 4; ++m)
#pragma unroll
        for (int n = 0; n < 2; ++n) {
          const int row = brow + ai * 128 + wr * 64 + m * 16 + (lane & 15);
          const int col0 = bcol + bj * 128 + wc * 32 + n * 16 + (lane >> 4) * 4;
          f(ai, bj, m, n, row, col0, acc[ai][bj][m][n]);
          if (n == 1 && (m & 1)) __builtin_amdgcn_sched_barrier(0);
        }
}

constexpr int NXT_A = 1024 + 128 + 128 + 16 + 16;
constexpr int NXT = NXT_A + 128 * 3 + 256 + 1024 + 1024;
DI void xpose_tile(int wv0, PP p, int jt, unsigned char* smem) {
  const int tid = my_tid(wv0);
  float* tile = (float*)smem;
  int t = jt;
  const float* src;
  u16* dst;
  int K, Nsrc, mode = 0, rowil = -1;
  const float* scl = nullptr;
  if (t < 1024) { src = p->w_in; dst = (u16*)(p->ws + OFF_WINT); K = 1024; Nsrc = 3864; mode = 1; }
  else if ((t -= 1024) < 128) { src = p->kw1; dst = (u16*)(p->ws + OFF_W1KT); K = 2048; Nsrc = 256; }
  else if ((t -= 128) < 128) { src = p->vw1; dst = (u16*)(p->ws + OFF_W1VT); K = 2048; Nsrc = 256; }
  else if ((t -= 128) < 16) { src = p->kw2; dst = (u16*)(p->ws + OFF_W2KT); K = 256; Nsrc = 64; mode = 2; }
  else if ((t -= 16) < 16) { src = p->vw2; dst = (u16*)(p->ws + OFF_W2VT); K = 256; Nsrc = 64; mode = 2; }
  else if ((t -= 16) < 128) { src = p->w_attn; dst = (u16*)(p->ws + OFF_WAT); K = 512; Nsrc = 1024; }
  else if ((t -= 128) < 128) { src = p->w_val; dst = (u16*)(p->ws + OFF_WVT); K = 512; Nsrc = 1024; rowil = 0; }
  else if ((t -= 128) < 128) { src = p->w_gate; dst = (u16*)(p->ws + OFF_WVT); K = 512; Nsrc = 1024; rowil = 128; }
  else if ((t -= 128) < 256) { src = p->w_out; dst = (u16*)(p->ws + OFF_WOT); K = 1024; Nsrc = 1024; }
  else if ((t -= 256) < 1024) { src = p->w_up; dst = (u16*)(p->ws + OFF_WUPT); K = 1024; Nsrc = 4096; scl = p->g2; }
  else { t -= 1024; src = p->w_down; dst = (u16*)(p->ws + OFF_WDT); K = 4096; Nsrc = 1024; }
  const int nkt = K >> 6, tn = t / nkt, tk = t % nkt, n0 = tn * 64, k0 = tk * 64;
  const int tx = tid & 63, ty = tid >> 6;
  const int np = n0 + tx;
  int sc = np;
  if (mode == 1) {
    if (np < 1280) sc = np;
    else if (np < 1792) sc = 1304 + (np - 1280);
    else if (np < 3840) sc = 1816 + (np - 1792);
    else if (np < 3864) sc = 1280 + (np - 3840);
    else sc = -1;
  } else if (mode == 2) {
    sc = np < 64 ? np : -1;
  }
  for (int kk = ty; kk < 64; kk += 8) {
    float val = 0.f;
    if (sc >= 0) val = src[(size_t)(k0 + kk) * Nsrc + sc];
    if (scl) val *= scl[k0 + kk];
    tile[kk * 65 + tx] = val;
  }
  __syncthreads();
  {
    const int n = tid >> 3, kc = tid & 7;
    uint4 o;
    o.x = pk2(tile[(kc * 8 + 0) * 65 + n], tile[(kc * 8 + 1) * 65 + n]);
    o.y = pk2(tile[(kc * 8 + 2) * 65 + n], tile[(kc * 8 + 3) * 65 + n]);
    o.z = pk2(tile[(kc * 8 + 4) * 65 + n], tile[(kc * 8 + 5) * 65 + n]);
    o.w = pk2(tile[(kc * 8 + 6) * 65 + n], tile[(kc * 8 + 7) * 65 + n]);
    const int drow = rowil < 0 ? (n0 + n) : (((n0 + n) >> 7) * 256 + ((n0 + n) & 127) + rowil);
    *(uint4*)(dst + (size_t)drow * K + k0 + kc * 8) = o;
  }
  __syncthreads();
}

DI void phaseA(int wv0, PP p, unsigned char* smem) {
  const int tid = my_tid(wv0), lane = tid & 63;
  u16* HN = (u16*)(p->ws + OFF_HN);
  for (int row = blockIdx.x * 8 + wv0; row < T_; row += gridDim.x * 8) {
    const float4* xr = (const float4*)(p->x + (size_t)row * 1024);
    float4 v[4];
    float ss = 0.f;
#pragma unroll
    for (int r = 0; r < 4; ++r) {
      v[r] = xr[lane + 64 * r];
      ss += v[r].x * v[r].x + v[r].y * v[r].y + v[r].z * v[r].z + v[r].w * v[r].w;
    }
    ss = wave_sum(ss);
    const float rinv = rsqrtf(ss * (1.f / 1024.f) + 1e-6f);
#pragma unroll
    for (int r = 0; r < 4; ++r) {
      const float4 g = ((const float4*)p->g1)[lane + 64 * r];
      uint2 o;
      o.x = pk2(v[r].x * rinv * g.x, v[r].y * rinv * g.y);
      o.y = pk2(v[r].z * rinv * g.z, v[r].w * rinv * g.w);
      *(uint2*)(HN + (size_t)row * 1024 + (lane + 64 * r) * 4) = o;
    }
  }
  for (int jt = blockIdx.x; jt < NXT_A + 32 + 32; jt += gridDim.x) {
    if (jt < NXT_A) {
      xpose_tile(wv0, p, jt, smem);
    } else if (jt >= NXT_A + 32) {
      const int g = jt - (NXT_A + 32);
      u16* TB = (u16*)(p->ws + OFF_S5T + (size_t)g * 8192);
      const float step = expf(p->log_step[g]);
      for (int e = tid; e < 2048; e += NT_) {
        const int np = e >> 4, c = e & 15, n = np & 63;
        const float lr = p->lam_re[g * 64 + n], li = p->lam_im[g * 64 + n];
        const float er = expf(lr * step);
        float sn, cs;
        sincosf(li * step, &sn, &cs);
        const float nr = er * cs - 1.f, ni = er * sn, den = lr * lr + li * li;
        const float cr = (nr * lr + ni * li) / den, ci = (ni * lr - nr * li) / den;
        const float bre = p->b_re[(g * 64 + n) * 16 + c], bim = p->b_im[(g * 64 + n) * 16 + c];
        TB[np * 16 + c] = f2bf(np < 64 ? (cr * bre - ci * bim) : (cr * bim + ci * bre));
        const int cc = e >> 7, k = e & 127;
        TB[2048 + cc * 128 + k] = f2bf(k < 64 ? p->c_re[(g * 16 + cc) * 64 + k] : -p->c_im[(g * 16 + cc) * 64 + (k - 64)]);
      }
      if (tid < 64) {
        const float lr = p->lam_re[g * 64 + tid], li = p->lam_im[g * 64 + tid];
        const float er = expf(lr * step);
        float sn, cs;
        sincosf(li * step, &sn, &cs);
        ((float2*)(p->ws + OFF_S5L))[g * 64 + tid] = make_float2(er * cs, er * sn);
      }
    } else {
      const int item = jt - NXT_A, kv = item >> 4, slice = item & 15;
      const float* w1 = kv ? p->vw1 : p->kw1;
      const int col = tid & 255, h = tid >> 8, kb = slice * 128 + h * 64;
      float s0 = 0.f, s1 = 0.f, s2 = 0.f, s3 = 0.f;
      for (int k = kb; k < kb + 64; k += 4) {
        s0 += p->pe[k] * w1[(size_t)k * 256 + col];
        s1 += p->pe[k + 1] * w1[(size_t)(k + 1) * 256 + col];
        s2 += p->pe[k + 2] * w1[(size_t)(k + 2) * 256 + col];
        s3 += p->pe[k + 3] * w1[(size_t)(k + 3) * 256 + col];
      }
      ((float*)(p->ws + OFF_CBP))[(kv * 32 + slice * 2 + h) * 256 + col] = (s0 + s1) + (s2 + s3);
    }
  }
  float* rope = (float*)(p->ws + OFF_ROPE);
  for (int i = blockIdx.x * NT_ + tid; i < S_ * 8; i += gridDim.x * NT_) {
    const int pos = i >> 3, k = i & 7;
    const float inv = powf(500000.0f, -(2.0f * (float)k) / 16.0f);
    const float ang = (float)pos * inv;
    rope[pos * 16 + k] = cosf(ang);
    rope[pos * 16 + 8 + k] = sinf(ang);
  }
  if (blockIdx.x == 0 && tid < 64) ((int*)(p->ws + OFF_CTR))[tid] = 0;
}

DI void phaseB(int wv0, PP p, unsigned char* smem) {
  const u16* HN = (const u16*)(p->ws + OFF_HN);
  const u16* WT = (const u16*)(p->ws + OFF_WINT);
  const float* rope = (const float*)(p->ws + OFF_ROPE);
  const int lane = my_tid(wv0) & 63;
  const bool ropewave = (wv0 & 1) == 0;
  for (int id = blockIdx.x; id < 128 * 16; id += gridDim.x) {
    int pm, pn;
    tile_map_n16(id, pm, pn);
    pm = 127 - pm;
    const int brow = pm * 256, bcol = pn * 256;
    f32x4 acc[2][2][4][2];
    gemm256(wv0, acc, HN + (size_t)brow * 1024, 1024, WT + (size_t)bcol * 1024, 1024, 1024, smem);
    if (pn < 2) {
      u16* QR = (u16*)(p->ws + OFF_QRAW);
      u16* QO = (u16*)(p->ws + OFF_QROT);
      epi256(wv0, acc, brow, bcol, [&](int ai, int bj, int m, int n, int row, int col0, f32x4& v) {
        f32x4 r = v;
        if (n == 0 && ropewave) {
          const int pos = row & (S_ - 1), kq = ((lane >> 4) & 1) * 4;
          const float4 c4 = *(const float4*)(rope + pos * 16 + kq), s4 = *(const float4*)(rope + pos * 16 + 8 + kq);
          const float cc[4] = {c4.x, c4.y, c4.z, c4.w}, ss[4] = {s4.x, s4.y, s4.z, s4.w};
#pragma unroll
          for (int j = 0; j < 4; ++j) {
            const float pr = __shfl_xor(v[j], 32);
            r[j] = (lane & 32) ? (v[j] * cc[j] + pr * ss[j]) : (v[j] * cc[j] - pr * ss[j]);
          }
        }
        *(uint2*)(QR + (size_t)row * 512 + col0) = pk4(v[0] * QSCALE, v[1] * QSCALE, v[2] * QSCALE, v[3] * QSCALE);
        *(uint2*)(QO + (size_t)row * 512 + col0) = pk4(r[0] * QSCALE, r[1] * QSCALE, r[2] * QSCALE, r[3] * QSCALE);
      });
    } else if (pn < 5) {
      epi256(wv0, acc, brow, bcol, [&](int ai, int bj, int m, int n, int row, int col0, f32x4& v) {
        const int sub = (pn - 2) * 2 + bj;
        const bool dorope = (sub == 2 || sub == 4), transposed = (sub == 3 || sub == 5);
        u16* dst = (u16*)(p->ws + OFF_KCIN + (size_t)sub * 8 * MB);
        const int c128 = col0 & 127, g = c128 >> 6, d0 = c128 & 63;
        const int b = row >> 13, sq = row & (S_ - 1);
        f32x4 r = v;
        if (dorope && n == 0 && ropewave) {
          const int kq = ((lane >> 4) & 1) * 4;
          const float4 c4 = *(const float4*)(rope + sq * 16 + kq), s4 = *(const float4*)(rope + sq * 16 + 8 + kq);
          const float cc[4] = {c4.x, c4.y, c4.z, c4.w}, ss[4] = {s4.x, s4.y, s4.z, s4.w};
#pragma unroll
          for (int j = 0; j < 4; ++j) {
            const float pr = __shfl_xor(v[j], 32);
            r[j] = (lane & 32) ? (v[j] * cc[j] + pr * ss[j]) : (v[j] * cc[j] - pr * ss[j]);
          }
        }
        if (transposed) {
#pragma unroll
          for (int j = 0; j < 4; ++j) dst[((size_t)((b * 2 + g) * 64 + d0 + j)) * S_ + sq] = f2bf(r[j]);
        } else {
          *(uint2*)(dst + ((size_t)(b * 2 + g) * S_ + sq) * 64 + d0) = pk4(r[0], r[1], r[2], r[3]);
        }
      });
    } else if (pn < 7) {
      u16* U = (u16*)(p->ws + OFF_U);
      epi256(wv0, acc, brow, bcol, [&](int ai, int bj, int m, int n, int row, int col0, f32x4& v) {
        *(uint2*)(U + (size_t)row * 512 + (col0 - 1280)) = pk4(v[0], v[1], v[2], v[3]);
      });
    } else if (pn < 15) {
      u16* MG = (u16*)(p->ws + OFF_MG);
      epi256(wv0, acc, brow, bcol, [&](int ai, int bj, int m, int n, int row, int col0, f32x4& v) {
        *(uint2*)(MG + (size_t)row * 2048 + (col0 - 1792)) = pk4(sigmoidf_(v[0]), sigmoidf_(v[1]), sigmoidf_(v[2]), sigmoidf_(v[3]));
      });
    } else {
      float* NG = (float*)(p->ws + OFF_NG);
      epi256(wv0, acc, brow, bcol, [&](int ai, int bj, int m, int n, int row, int col0, f32x4& v) {
        const int cc = col0 - 3840;
        if (cc < 24) *(float4*)(NG + (size_t)row * 24 + cc) = make_float4(sigmoidf_(v[0]), sigmoidf_(v[1]), sigmoidf_(v[2]), sigmoidf_(v[3]));
      });
    }
  }
}

template <bool OUT>
DI void s5_item(int wv0, PP p, int item, unsigned char* smem) {
  const int tid = my_tid(wv0), lane = tid & 63, fr = lane & 15, fq = lane >> 4;
  const int b = item >> 9, g = (item >> 4) & 31, c8 = item & 15, ch = c8 * 8 + wv0;
  u16* sBb = (u16*)smem;
  u16* sCm = sBb + 128 * 16;
  float* sBU = (float*)(smem + 8192) + wv0 * (16 * 132);
  u16* sH = (u16*)(smem + 8192 + 8 * 16 * 132 * 4) + wv0 * (16 * 136);
  *(uint4*)(smem + tid * 16) = *(const uint4*)(p->ws + OFF_S5T + (size_t)g * 8192 + tid * 16);
  const float2 lb = ((const float2*)(p->ws + OFF_S5L))[g * 64 + lane];
  const float lbr = lb.x, lbi = lb.y;
  float2* HL = (float2*)(p->ws + OFF_HLOC) + ((size_t)(b * 128 + ch) * 32 + g) * 64 + lane;
  float hr = 0.f, hi = 0.f;
  if (OUT) { const float2 h0 = *HL; hr = h0.x; hi = h0.y; }
  const u16* U = (const u16*)(p->ws + OFF_U) + ((size_t)(b * S_ + ch * 64)) * 512 + g * 16;
  u16* YS = (u16*)(p->ws + OFF_YS) + ((size_t)(b * S_ + ch * 64)) * 512 + g * 16;
  const float dk = p->dsk[g * 16 + fr];
  const bf16x8 zero8 = {0, 0, 0, 0, 0, 0, 0, 0};
  bf16x8 uall[4];
  u16 usk[4][4];
#pragma unroll
  for (int sub = 0; sub < 4; ++sub) {
    uall[sub] = fq < 2 ? *(const bf16x8*)(U + (size_t)(sub * 16 + fr) * 512 + 8 * fq) : zero8;
    if (OUT) {
#pragma unroll
      for (int j = 0; j < 4; ++j) usk[sub][j] = U[(size_t)(sub * 16 + 4 * fq + j) * 512 + fr];
    }
  }
  __syncthreads();
  bf16x8 bb[8], cf[4];
#pragma unroll
  for (int nt = 0; nt < 8; ++nt) bb[nt] = fq < 2 ? *(const bf16x8*)(sBb + (16 * nt + fr) * 16 + 8 * fq) : zero8;
  if (OUT) {
#pragma unroll
    for (int ks = 0; ks < 4; ++ks) cf[ks] = *(const bf16x8*)(sCm + fr * 128 + 32 * ks + 8 * fq);
  }
#pragma unroll
  for (int sub = 0; sub < 4; ++sub) {
    const bf16x8 ua = uall[sub];
#pragma unroll
    for (int nt = 0; nt < 8; ++nt) {
      const f32x4 a = mfma16(ua, bb[nt], f32x4{0.f, 0.f, 0.f, 0.f});
#pragma unroll
      for (int j = 0; j < 4; ++j) sBU[(4 * fq + j) * 132 + 16 * nt + fr] = a[j];
    }
    __syncthreads();
#pragma unroll 4
    for (int t = 0; t < 16; ++t) {
      const float bur = sBU[t * 132 + lane], bui = sBU[t * 132 + 64 + lane];
      const float nr = lbr * hr - lbi * hi + bur;
      const float nim = lbr * hi + lbi * hr + bui;
      hr = nr;
      hi = nim;
      if (OUT) {
        sH[t * 136 + lane] = f2bf(hr);
        sH[t * 136 + 64 + lane] = f2bf(hi);
      }
    }
    __syncthreads();
    if (OUT) {
      f32x4 y = {0.f, 0.f, 0.f, 0.f};
#pragma unroll
      for (int ks = 0; ks < 4; ++ks) y = mfma16(*(const bf16x8*)(sH + fr * 136 + 32 * ks + 8 * fq), cf[ks], y);
#pragma unroll
      for (int j = 0; j < 4; ++j) {
        const size_t o = (size_t)(sub * 16 + 4 * fq + j) * 512 + fr;
        YS[o] = f2bf(gelu_t(y[j] + dk * bf2f(usk[sub][j])));
      }
      __syncthreads();
    }
  }
  if (!OUT) *HL = make_float2(hr, hi);
  __syncthreads();
}
DI void s5_carry(int wv0, PP p) {
  const int x = blockIdx.x * NT_ + my_tid(wv0);
  if (x >= 8192) return;
  const int b = x >> 11, g = (x >> 6) & 31, n = x & 63;
  const float step = expf(p->log_step[g]);
  const float lr = p->lam_re[g * 64 + n], li = p->lam_im[g * 64 + n];
  const float er = expf(64.f * lr * step);
  float sn, cs;
  sincosf(64.f * li * step, &sn, &cs);
  const float Lr = er * cs, Li = er * sn;
  float2* HL = (float2*)(p->ws + OFF_HLOC) + (size_t)b * 128 * 2048 + g * 64 + n;
  float hr = 0.f, hi = 0.f;
  for (int c0 = 0; c0 < 128; c0 += 16) {
    float2 v[16];
#pragma unroll
    for (int k = 0; k < 16; ++k) v[k] = HL[(size_t)(c0 + k) * 2048];
#pragma unroll
    for (int k = 0; k < 16; ++k) {
      HL[(size_t)(c0 + k) * 2048] = make_float2(hr, hi);
      const float nr = Lr * hr - Li * hi + v[k].x;
      const float nim = Lr * hi + Li * hr + v[k].y;
      hr = nr;
      hi = nim;
    }
  }
}
DI void phaseC(int wv0, PP p, unsigned char* smem) {
  for (int id = blockIdx.x; id < 128 + 2048 + 256; id += gridDim.x) {
    if (id >= 128 + 2048) {
      const int it = id - (128 + 2048), tns = it >> 7, bg = (it >> 4) & 7, part = it & 15;
      const int tid = my_tid(wv0);
      const u16* K = (const u16*)(p->ws + (tns ? OFF_KW : OFF_KS)) + ((size_t)bg * S_ + part * 512 + tid) * 64;
      float q2 = 0.f;
#pragma unroll
      for (int c = 0; c < 8; ++c) {
        const uint4 w = *(const uint4*)(K + c * 8);
        const unsigned ww[4] = {w.x, w.y, w.z, w.w};
#pragma unroll
        for (int e = 0; e < 4; ++e) {
          const float a = __uint_as_float(ww[e] << 16), b2 = __uint_as_float(ww[e] & 0xffff0000u);
          q2 += a * a + b2 * b2;
        }
      }
#pragma unroll
      for (int o = 32; o > 0; o >>= 1) q2 = fmaxf(q2, __shfl_xor(q2, o));
      if ((tid & 63) == 0) atomicMax((unsigned*)(p->ws + OFF_KMAX) + tns * 8 + bg, __float_as_uint(q2));
    } else if (id < 128) {
      const int kv = id >> 6, pm = (id >> 2) & 15, ks = id & 3, brow = pm * 256;
      const u16* A = (const u16*)(p->ws + (kv ? OFF_VCIN : OFF_KCIN)) + (size_t)brow * 1024 + ks * 512;
      const u16* Bt = (const u16*)(p->ws + (kv ? OFF_W1VT : OFF_W1KT)) + ks * 512;
      f32x4 acc[2][2][4][2];
      gemm256(wv0, acc, A, 1024, Bt, 2048, 512, smem);
      float* PART = (float*)(p->ws + OFF_CPART) + (size_t)(ks * 2 + kv) * 4096 * 256;
      epi256(wv0, acc, brow, 0, [&](int ai, int bj, int m, int n, int row, int col0, f32x4& v) {
        *(float4*)(PART + (size_t)row * 256 + col0) = make_float4(v[0], v[1], v[2], v[3]);
      });
    } else {
      s5_item<false>(wv0, p, id - 128, smem);
    }
  }
}
DI void phaseD1(int wv0, PP p, unsigned char* smem) {
  const int tid = my_tid(wv0);
  float* sB = (float*)smem;
  {
    const float* cbp = (const float*)(p->ws + OFF_CBP);
    float bb = 0.f;
    for (int sl = 0; sl < 32; ++sl) bb += cbp[((tid >> 8) * 32 + sl) * 256 + (tid & 255)];
    sB[tid] = bb;
  }
  __syncthreads();
  const float* PART = (const float*)(p->ws + OFF_CPART);
  u16* HC = (u16*)(p->ws + OFF_HC);
  for (int e = blockIdx.x * NT_ + tid; e < 2 * 4096 * 64; e += gridDim.x * NT_) {
    const int kv = e >> 18, rc = e & 262143, c4 = (rc & 63) * 4;
    const size_t o = (size_t)kv * 4096 * 256 + (size_t)rc * 4;
    float4 a = *(const float4*)(PART + o);
#pragma unroll
    for (int ks = 1; ks < 4; ++ks) {
      const float4 t = *(const float4*)(PART + (size_t)ks * 2 * 4096 * 256 + o);
      a.x += t.x; a.y += t.y; a.z += t.z; a.w += t.w;
    }
    const float* bv = sB + kv * 256 + c4;
    *(uint2*)(HC + o) = pk4(gelu_t(a.x + bv[0]), gelu_t(a.y + bv[1]), gelu_t(a.z + bv[2]), gelu_t(a.w + bv[3]));
  }
}
DI void phaseD(int wv0, PP p, unsigned char* smem) {
  for (int id = blockIdx.x; id < 32; id += gridDim.x) {
    const int kv = id >> 4, pm = id & 15, brow = pm * 256;
    const u16* A = (const u16*)(p->ws + OFF_HC) + (size_t)kv * 4096 * 256 + (size_t)brow * 256;
    const u16* Bt = (const u16*)(p->ws + (kv ? OFF_W2VT : OFF_W2KT));
    f32x4 acc[2][2][4][2];
    gemm256(wv0, acc, A, 256, Bt, 256, 256, smem);
    u16* KCC = (u16*)(p->ws + OFF_KCC);
    u16* VCT = (u16*)(p->ws + OFF_VCT);
    epi256(wv0, acc, brow, 0, [&](int ai, int bj, int m, int n, int row, int col0, f32x4& v) {
      if (col0 < 64) {
        const int bg = row >> 9, nn = row & 511;
        f32x4 r = v;
        if (nn == 511) r = f32x4{0.f, 0.f, 0.f, 0.f};
        if (kv == 0) {
          *(uint2*)(KCC + ((size_t)bg * 512 + nn) * 64 + col0) = pk4(r[0], r[1], r[2], r[3]);
        } else {
#pragma unroll
          for (int j = 0; j < 4; ++j) VCT[((size_t)bg * 64 + col0 + j) * 512 + nn] = f2bf(r[j]);
        }
      }
    });
  }
  s5_carry(wv0, p);
}

DI bool bit128(u64 lo, u64 hi, int j) { return j < 64 ? ((lo >> j) & 1ull) : ((hi >> (j - 64)) & 1ull); }
DI int next_bit(u64 lo, u64 hi, int from) {
  if (from < 64) {
    const u64 x = (lo >> from) << from;
    if (x) return __ffsll((long long)x) - 1;
    from = 64;
  }
  if (from >= 128) return -1;
  const u64 y = (hi >> (from - 64)) << (from - 64);
  return y ? 63 + __ffsll((long long)y) : -1;
}

template <int MODE, bool MASKED, class MaskF>
DI void flash_tile(const u16* sK, const u16* sV, const bf16x8 (&qf)[2][2], f32x4 (&O)[2][4], float (&m)[2], float (&l)[2],
                   float (&ps)[4][4], MaskF ok, bool sel, int lane) {
  const int l15 = lane & 15, lg = lane >> 4;
  bf16x8 kf[4][2];
#pragma unroll
  for (int kt = 0; kt < 4; ++kt)
#pragma unroll
    for (int ks = 0; ks < 2; ++ks) kf[kt][ks] = *(const bf16x8*)(sK + (16 * kt + l15) * 72 + ks * 32 + lg * 8);
  if (MODE == 1) {
#pragma unroll
    for (int a = 0; a < 4; ++a)
#pragma unroll
      for (int b = 0; b < 4; ++b) ps[a][b] = 0.f;
  }
  union PFrag { unsigned u[4]; bf16x8 v; };
  PFrag pf[2][2];
#pragma unroll
  for (int qt = 0; qt < 2; ++qt) {
    f32x4 s[4];
    const float sinit = (MODE == 3) ? ((MASKED || sel) ? m[qt] : -1e30f) : 0.f;
#pragma unroll
    for (int kt = 0; kt < 4; ++kt) {
      s[kt] = f32x4{sinit, sinit, sinit, sinit};
#pragma unroll
      for (int ks = 0; ks < 2; ++ks) s[kt] = mfma16(kf[kt][ks], qf[qt][ks], s[kt]);
    }
    float pr[4][4];
    if (MODE == 3) {
      float rs = 0.f;
#pragma unroll
      for (int kt = 0; kt < 4; ++kt)
#pragma unroll
        for (int i = 0; i < 4; ++i) {
          float pv = __builtin_amdgcn_exp2f(s[kt][i]);
          if (MASKED) pv = ok(kt, i) ? pv : 0.f;
          pr[kt][i] = pv;
          rs += pv;
        }
      l[qt] += rs;
    } else {
    float mx = -1e30f;
#pragma unroll
    for (int kt = 0; kt < 4; ++kt)
#pragma unroll
      for (int i = 0; i < 4; ++i) {
        if (MASKED) s[kt][i] = ok(kt, i) ? s[kt][i] : -1e30f;
        mx = fmaxf(mx, s[kt][i]);
      }
    if (!MASKED) mx = sel ? mx : -1e30f;
    if (MODE == 1) {
      const float mm = m[qt], il = l[qt];
#pragma unroll
      for (int kt = 0; kt < 4; ++kt)
#pragma unroll
        for (int i = 0; i < 4; ++i) {
          const float pv = (s[kt][i] > -1e29f) ? __builtin_amdgcn_exp2f(s[kt][i] - mm) * il : 0.f;
          pr[kt][i] = pv;
          ps[kt][i] += pv;
        }
    } else {
      mx = fmaxf(mx, __shfl_xor(mx, 16));
      mx = fmaxf(mx, __shfl_xor(mx, 32));
      const float mnew = fmaxf(m[qt], mx);
      const float alpha = __builtin_amdgcn_exp2f(m[qt] - mnew);
      m[qt] = mnew;
      float rs = 0.f;
      if (MASKED) {
#pragma unroll
        for (int kt = 0; kt < 4; ++kt)
#pragma unroll
          for (int i = 0; i < 4; ++i) {
            const float pv = (s[kt][i] > -1e29f) ? __builtin_amdgcn_exp2f(s[kt][i] - mnew) : 0.f;
            pr[kt][i] = pv;
            rs += pv;
          }
      } else {
        const float me = sel ? mnew : 1e30f;
#pragma unroll
        for (int kt = 0; kt < 4; ++kt)
#pragma unroll
          for (int i = 0; i < 4; ++i) {
            const float pv = __builtin_amdgcn_exp2f(s[kt][i] - me);
            pr[kt][i] = pv;
            rs += pv;
          }
      }
      l[qt] = l[qt] * alpha + rs;
      if (MODE == 2) {
#pragma unroll
        for (int dt = 0; dt < 4; ++dt) O[qt][dt] *= alpha;
      }
    }
    }
    if (MODE != 0) {
#pragma unroll
      for (int ks2 = 0; ks2 < 2; ++ks2) {
        pf[qt][ks2].u[0] = pk2(pr[2 * ks2][0], pr[2 * ks2][1]);
        pf[qt][ks2].u[1] = pk2(pr[2 * ks2][2], pr[2 * ks2][3]);
        pf[qt][ks2].u[2] = pk2(pr[2 * ks2 + 1][0], pr[2 * ks2 + 1][1]);
        pf[qt][ks2].u[3] = pk2(pr[2 * ks2 + 1][2], pr[2 * ks2 + 1][3]);
      }
    }
  }
  if (MODE != 0) {
#pragma unroll
    for (int ks2 = 0; ks2 < 2; ++ks2) {
#pragma unroll
      for (int dt = 0; dt < 4; ++dt) {
        union { uint2 h[2]; bf16x8 v; } vf;
        vf.h[0] = *(const uint2*)(sV + (16 * dt + l15) * 72 + 32 * ks2 + 4 * lg);
        vf.h[1] = *(const uint2*)(sV + (16 * dt + l15) * 72 + 32 * ks2 + 16 + 4 * lg);
        O[0][dt] = mfma16(vf.v, pf[0][ks2].v, O[0][dt]);
        O[1][dt] = mfma16(vf.v, pf[1][ks2].v, O[1][dt]);
      }
    }
  }
}

DI void flash_s3(const u16* sK, const bf16x8 (&qf)[2][2], float si0, float si1, f32x4 (&s)[2][4], int lane) {
  const int l15 = lane & 15, lg = lane >> 4;
  bf16x8 kf[4][2];
#pragma unroll
  for (int kt = 0; kt < 4; ++kt)
#pragma unroll
    for (int ks = 0; ks < 2; ++ks) kf[kt][ks] = *(const bf16x8*)(sK + (16 * kt + l15) * 72 + ks * 32 + lg * 8);
#pragma unroll
  for (int qt = 0; qt < 2; ++qt) {
    const float si = qt ? si1 : si0;
#pragma unroll
    for (int kt = 0; kt < 4; ++kt) {
      s[qt][kt] = f32x4{si, si, si, si};
#pragma unroll
      for (int ks = 0; ks < 2; ++ks) s[qt][kt] = mfma16(kf[kt][ks], qf[qt][ks], s[qt][kt]);
    }
  }
}
template <bool MASKED, class MaskF>
DI void flash_pv3(const u16* sV, const f32x4 (&s)[2][4], f32x4 (&O)[2][4], float (&l)[2], MaskF ok, int lane) {
  const int l15 = lane & 15, lg = lane >> 4;
  union PFrag { unsigned u[4]; bf16x8 v; };
  PFrag pf[2][2];
#pragma unroll
  for (int qt = 0; qt < 2; ++qt) {
    float pr[4][4];
    float rs = 0.f;
#pragma unroll
    for (int kt = 0; kt < 4; ++kt)
#pragma unroll
      for (int i = 0; i < 4; ++i) {
        float pv = __builtin_amdgcn_exp2f(s[qt][kt][i]);
        if (MASKED) pv = ok(kt, i) ? pv : 0.f;
        pr[kt][i] = pv;
        rs += pv;
      }
    l[qt] += rs;
#pragma unroll
    for (int ks2 = 0; ks2 < 2; ++ks2) {
      pf[qt][ks2].u[0] = pk2(pr[2 * ks2][0], pr[2 * ks2][1]);
      pf[qt][ks2].u[1] = pk2(pr[2 * ks2][2], pr[2 * ks2][3]);
      pf[qt][ks2].u[2] = pk2(pr[2 * ks2 + 1][0], pr[2 * ks2 + 1][1]);
      pf[qt][ks2].u[3] = pk2(pr[2 * ks2 + 1][2], pr[2 * ks2 + 1][3]);
    }
  }
#pragma unroll
  for (int ks2 = 0; ks2 < 2; ++ks2) {
#pragma unroll
    for (int dt = 0; dt < 4; ++dt) {
      union { uint2 h[2]; bf16x8 v; } vf;
      vf.h[0] = *(const uint2*)(sV + (16 * dt + l15) * 72 + 32 * ks2 + 4 * lg);
      vf.h[1] = *(const uint2*)(sV + (16 * dt + l15) * 72 + 32 * ks2 + 16 + 4 * lg);
      O[0][dt] = mfma16(vf.v, pf[0][ks2].v, O[0][dt]);
      O[1][dt] = mfma16(vf.v, pf[1][ks2].v, O[1][dt]);
    }
  }
}

DI void nsa_item(int wv0, PP p, int item, unsigned char* smem) {
  const int tid = my_tid(wv0), lane = tid & 63, wv = wv0 & 3, hp = wv0 >> 2, l15 = lane & 15, lg = lane >> 4;
  const int i = 127 - (item >> 3), bg = item & 7, b = bg >> 1, g = bg & 1;
  u16* sK = (u16*)smem;
  u16* sV = sK + 64 * 72;
  float* sImp0 = (float*)(smem + 55296);
  float* sImp = sImp0 + hp * (64 * 132);
  u64* sUni = (u64*)(smem + 55296 + 2 * 64 * 132 * 4);
  u64* sSel = sUni + 16;
  const int t0 = i * 64, qloc = 16 * wv + l15, tq = t0 + qloc;
  const unsigned tokq = (unsigned)(b * S_ + tq);
  const float* NGb = (const float*)(p->ws + OFF_NG);
  const unsigned ngoff = tokq * 24 + g * 12 + hp * 6;
  float* ACCb = p->out;
  const unsigned aoff = tokq * 512 + g * 256 + hp * 128 + 4 * lg;
  const unsigned qoff = tokq * 512 + g * 256 + hp * 128 + lg * 8;
  const int lrow = tid >> 3, lpart = tid & 7;
  const unsigned koff = (lrow * 64 + lpart * 8) * 2, voffc = (lrow * 512 + lpart * 8) * 2, voffs = (lrow * S_ + lpart * 8) * 2;

  for (int e = tid; e < 2 * 64 * 132; e += NT_) sImp0[e] = 0.f;

  bf16x8 qf[2][2];
  f32x4 O[2][4];
  float m[2], l[2], ps[4][4];
  u32x4 pk0, pv0;
  auto nomask = [](int, int) { return true; };

#define MAKE_RSRC(PTR) __builtin_amdgcn_make_buffer_rsrc((void*)(PTR), 0, 0x7fffffff, 0x00020000)
#define BLOAD(R, VO, SO) __builtin_amdgcn_raw_buffer_load_b128((R), (int)(VO), (int)(SO), 0)
#define ISSUE_TILE(RK, RV, T, LDV)                                                   \
  {                                                                                  \
    pk0 = BLOAD(RK, koff, (T)*8192);                                                 \
    pv0 = BLOAD(RV, ((LDV) == 512) ? voffc : voffs, (T)*128);                        \
  }
#define COMMIT_TILE()                                                                \
  {                                                                                  \
    *(u32x4*)(sK + lrow * 72 + lpart * 8) = pk0;                                     \
    *(u32x4*)(sV + lrow * 72 + lpart * 8) = pv0;                                     \
  }
#define COMMIT_BUF(BUF)                                                              \
  {                                                                                  \
    *(u32x4*)(sK + (BUF)*9216 + lrow * 72 + lpart * 8) = pk0;                        \
    *(u32x4*)(sV + (BUF)*9216 + lrow * 72 + lpart * 8) = pv0;                        \
  }
#define LOAD_Q(BASE)                                                                 \
  {                                                                                  \
    const u16* Q_ = (const u16*)(p->ws + (BASE));                                    \
    _Pragma("unroll") for (int qt = 0; qt < 2; ++qt)                                 \
      _Pragma("unroll") for (int ks = 0; ks < 2; ++ks)                               \
        qf[qt][ks] = *(const bf16x8*)(Q_ + (qoff + qt * 64 + ks * 32));             \
  }
#define RESET_STATE()                                                                \
  {                                                                                  \
    _Pragma("unroll") for (int qt = 0; qt < 2; ++qt) { m[qt] = -1e30f; l[qt] = 0.f; } \
    _Pragma("unroll") for (int a = 0; a < 2; ++a)                                    \
      _Pragma("unroll") for (int c = 0; c < 4; ++c) O[a][c] = f32x4{0.f, 0.f, 0.f, 0.f}; \
  }

  {
    const u16* Kc0 = (const u16*)(p->ws + OFF_KCC) + (size_t)bg * 512 * 64;
    const u16* Vc0 = (const u16*)(p->ws + OFF_VCT) + (size_t)bg * 64 * 512;
    const int nE = (4 * i + 3) < 511 ? (4 * i + 3) : 511;
    const int nkb = (nE + 63) >> 6;
    const __amdgpu_buffer_rsrc_t rK = MAKE_RSRC(Kc0), rV = MAKE_RSRC(Vc0);
    LOAD_Q(OFF_QRAW)
    RESET_STATE()
    ISSUE_TILE(rK, rV, 0, 512)
    for (int kb = 0; kb < nkb; ++kb) {
      __syncthreads();
      COMMIT_TILE()
      __syncthreads();
      if (kb + 1 < nkb) ISSUE_TILE(rK, rV, kb + 1, 512)
      auto ok = [&](int kt, int ii) { return 16 * (kb * 64 + 16 * kt + 4 * lg + ii) + 31 <= tq; };
      flash_tile<0, true>(sK, sV, qf, O, m, l, ps, ok, true, lane);
    }
#pragma unroll
    for (int qt = 0; qt < 2; ++qt) {
      float s = l[qt];
      s += __shfl_xor(s, 16);
      s += __shfl_xor(s, 32);
      l[qt] = s > 0.f ? 1.f / s : 0.f;
    }
    ISSUE_TILE(rK, rV, 0, 512)
    for (int kb = 0; kb < nkb; ++kb) {
      __syncthreads();
      COMMIT_TILE()
      __syncthreads();
      if (kb + 1 < nkb) ISSUE_TILE(rK, rV, kb + 1, 512)
      auto ok = [&](int kt, int ii) { return 16 * (kb * 64 + 16 * kt + 4 * lg + ii) + 31 <= tq; };
      flash_tile<1, true>(sK, sV, qf, O, m, l, ps, ok, true, lane);
#pragma unroll
      for (int kt = 0; kt < 4; ++kt) {
        const int j = kb * 16 + kt * 4 + lg;
        sImp[qloc * 132 + j] += ps[kt][0] + ps[kt][1] + ps[kt][2] + ps[kt][3];
      }
      __syncthreads();
#pragma unroll
      for (int kt = 0; kt < 4; ++kt) {
        const int j1 = kb * 16 + kt * 4 + lg + 1;
        if (j1 < 128) sImp[qloc * 132 + j1] += ps[kt][3];
      }
    }
#pragma unroll
    for (int qt = 0; qt < 2; ++qt) {
      const float gt = NGb[ngoff + qt * 3 + 0];
#pragma unroll
      for (int dt = 0; dt < 4; ++dt) {
        float4 o = make_float4(O[qt][dt][0] * gt, O[qt][dt][1] * gt, O[qt][dt][2] * gt, O[qt][dt][3] * gt);
        *(float4*)(ACCb + (aoff + qt * 64 + 16 * dt)) = o;
      }
    }
  }
  __syncthreads();
  u64 mlo = 0, mhi = 0, wlo = 0, whi = 0;
  if (i < 16) {
    mlo = (1ull << (i + 1)) - 1ull;
    wlo = mlo;
  } else {
    const bool v0 = lane <= i, v1 = (lane + 64) <= i;
    const bool f0 = (lane == 0) || (lane == i) || (lane == i - 1);
    const bool f1 = (lane + 64 == i) || (lane + 64 == i - 1);
    const u64 ltm = (1ull << lane) - 1ull;
    for (int qq = hp * 8; qq < hp * 8 + 8; ++qq) {
      const float* ir = sImp0 + (16 * wv + qq) * 132;
      const float i0 = ir[lane] + ir[64 * 132 + lane], i1 = ir[lane + 64] + ir[64 * 132 + lane + 64];
      const unsigned k0 = v0 ? __float_as_uint(i0 + (f0 ? 1000.f : 0.f)) : 0u;
      const unsigned k1 = v1 ? __float_as_uint(i1 + (f1 ? 1000.f : 0.f)) : 0u;
      unsigned T = 0;
      for (int bit = 30; bit >= 0; --bit) {
        const unsigned cand = T | (1u << bit);
        const int cnt = __popcll(__ballot(k0 >= cand)) + __popcll(__ballot(k1 >= cand));
        if (cnt >= 16) T = cand;
      }
      const bool g0 = k0 > T, g1 = k1 > T, e0 = k0 == T, e1 = k1 == T;
      const int need = 16 - (__popcll(__ballot(g0)) + __popcll(__ballot(g1)));
      const u64 be0 = __ballot(e0), be1 = __ballot(e1);
      const int r0 = __popcll(be0 & ltm), r1 = __popcll(be0) + __popcll(be1 & ltm);
      const u64 s0 = __ballot(v0 && (g0 || (e0 && r0 < need)));
      const u64 s1 = __ballot(v1 && (g1 || (e1 && r1 < need)));
      wlo |= s0;
      whi |= s1;
      if (lane == 0) { sSel[(16 * wv + qq) * 2] = s0; sSel[(16 * wv + qq) * 2 + 1] = s1; }
    }
  }
  if (lane == 0) { sUni[wv0 * 2] = wlo; sUni[wv0 * 2 + 1] = whi; }
  __syncthreads();
  if (i >= 16) { mlo = sSel[qloc * 2]; mhi = sSel[qloc * 2 + 1]; }
  wlo = sUni[wv * 2] | sUni[(wv + 4) * 2];
  whi = sUni[wv * 2 + 1] | sUni[(wv + 4) * 2 + 1];
  const u64 blo = sUni[0] | sUni[2] | sUni[4] | sUni[6] | sUni[8] | sUni[10] | sUni[12] | sUni[14];
  const u64 bhi = sUni[1] | sUni[3] | sUni[5] | sUni[7] | sUni[9] | sUni[11] | sUni[13] | sUni[15];

  LOAD_Q(OFF_QROT)
  float nb_s[2], nb_w[2];
  bool usefix;
  {
    const float* KM = (const float*)(p->ws + OFF_KMAX);
    const float kms = KM[bg], kmw = KM[8 + bg];
    float bmax = 0.f;
#pragma unroll
    for (int qt = 0; qt < 2; ++qt) {
      float q2 = 0.f;
#pragma unroll
      for (int ks = 0; ks < 2; ++ks)
#pragma unroll
        for (int e = 0; e < 8; ++e) {
          const float qv = __uint_as_float(((unsigned)(u16)qf[qt][ks][e]) << 16);
          q2 += qv * qv;
        }
      q2 += __shfl_xor(q2, 16);
      q2 += __shfl_xor(q2, 32);
      const float bs = sqrtf(q2 * kms) * 1.001f + 1e-3f, bw = sqrtf(q2 * kmw) * 1.001f + 1e-3f;
      nb_s[qt] = -bs;
      nb_w[qt] = -bw;
      bmax = fmaxf(bmax, fmaxf(bs, bw));
    }
    usefix = __ballot(bmax > 60.f) == 0ull;
  }
  RESET_STATE()
  if (usefix) { m[0] = nb_s[0]; m[1] = nb_s[1]; }
  {
    const __amdgpu_buffer_rsrc_t rK = MAKE_RSRC((const u16*)(p->ws + OFF_KS) + (size_t)bg * S_ * 64);
    const __amdgpu_buffer_rsrc_t rV = MAKE_RSRC((const u16*)(p->ws + OFF_VST) + (size_t)bg * 64 * S_);
    if (usefix) {
      int jc = next_bit(blo, bhi, 0);
      int j1 = next_bit(blo, bhi, jc + 1);
      ISSUE_TILE(rK, rV, jc, S_)
      COMMIT_BUF(0)
      if (j1 >= 0) {
        ISSUE_TILE(rK, rV, j1, S_)
        COMMIT_BUF(1)
      }
      __syncthreads();
      int j2 = j1 >= 0 ? next_bit(blo, bhi, j1 + 1) : -1;
      if (j2 >= 0) ISSUE_TILE(rK, rV, j2, S_)
      f32x4 sc_[2][4], sn_[2][4];
      {
        const bool selc = bit128(mlo, mhi, jc);
        flash_s3(sK, qf, (selc || jc == i) ? m[0] : -1e30f, (selc || jc == i) ? m[1] : -1e30f, sc_, lane);
      }
      int bc = 0;
      while (jc >= 0) {
        const int bn = bc == 2 ? 0 : bc + 1, bn2 = bn == 2 ? 0 : bn + 1;
        const bool needn = j1 >= 0 && bit128(wlo, whi, j1);
        if (needn) {
          const bool seln = bit128(mlo, mhi, j1);
          const bool on = seln || j1 == i;
          flash_s3(sK + bn * 9216, qf, on ? m[0] : -1e30f, on ? m[1] : -1e30f, sn_, lane);
        }
        if (bit128(wlo, whi, jc)) {
          if (jc == i) {
            const bool sel = bit128(mlo, mhi, jc);
            auto ok = [&](int kt, int ii) { return sel && (16 * kt + 4 * lg + ii) <= qloc; };
            flash_pv3<true>(sV + bc * 9216, sc_, O, l, ok, lane);
          } else {
            flash_pv3<false>(sV + bc * 9216, sc_, O, l, nomask, lane);
          }
        }
        if (j2 >= 0) COMMIT_BUF(bn2)
        __syncthreads();
        jc = j1;
        j1 = j2;
        bc = bn;
        if (j1 >= 0) {
          j2 = next_bit(blo, bhi, j1 + 1);
          if (j2 >= 0) ISSUE_TILE(rK, rV, j2, S_)
        } else {
          j2 = -1;
        }
#pragma unroll
        for (int a = 0; a < 2; ++a)
#pragma unroll
          for (int c = 0; c < 4; ++c) sc_[a][c] = sn_[a][c];
      }
    } else {
      int j = next_bit(blo, bhi, 0);
      ISSUE_TILE(rK, rV, j, S_)
      COMMIT_BUF(0)
      __syncthreads();
      int jn = next_bit(blo, bhi, j + 1);
      if (jn >= 0) ISSUE_TILE(rK, rV, jn, S_)
      int cur = 0;
      while (j >= 0) {
        const u16* cK = sK + cur * 9216;
        const u16* cV = sV + cur * 9216;
        if (bit128(wlo, whi, j)) {
          const bool sel = bit128(mlo, mhi, j);
          if (j == i) {
            auto ok = [&](int kt, int ii) { return sel && (16 * kt + 4 * lg + ii) <= qloc; };
            if (usefix) flash_tile<3, true>(cK, cV, qf, O, m, l, ps, ok, true, lane);
            else flash_tile<2, true>(cK, cV, qf, O, m, l, ps, ok, true, lane);
          } else {
            if (usefix) flash_tile<3, false>(cK, cV, qf, O, m, l, ps, nomask, sel, lane);
            else flash_tile<2, false>(cK, cV, qf, O, m, l, ps, nomask, sel, lane);
          }
        }
        cur ^= 1;
        if (jn >= 0) COMMIT_BUF(cur)
        __syncthreads();
        j = jn;
        if (j >= 0) {
          jn = next_bit(blo, bhi, j + 1);
          if (jn >= 0) ISSUE_TILE(rK, rV, jn, S_)
        }
      }
    }
  }
#pragma unroll
  for (int qt = 0; qt < 2; ++qt) {
    float s = l[qt];
    s += __shfl_xor(s, 16);
    s += __shfl_xor(s, 32);
    const float sc = NGb[ngoff + qt * 3 + 1] / s;
#pragma unroll
    for (int dt = 0; dt < 4; ++dt) {
      float4* a = (float4*)(ACCb + (aoff + qt * 64 + 16 * dt));
      float4 o = *a;
      o.x += O[qt][dt][0] * sc; o.y += O[qt][dt][1] * sc; o.z += O[qt][dt][2] * sc; o.w += O[qt][dt][3] * sc;
      *a = o;
    }
  }
  RESET_STATE()
  if (usefix) { m[0] = nb_w[0]; m[1] = nb_w[1]; }
  {
    const __amdgpu_buffer_rsrc_t rK = MAKE_RSRC((const u16*)(p->ws + OFF_KW) + (size_t)bg * S_ * 64);
    const __amdgpu_buffer_rsrc_t rV = MAKE_RSRC((const u16*)(p->ws + OFF_VWT) + (size_t)bg * 64 * S_);
    const int j0 = i >= 8 ? i - 8 : 0;
    ISSUE_TILE(rK, rV, j0, S_)
    COMMIT_BUF(0)
    __syncthreads();
    if (j0 + 1 <= i) ISSUE_TILE(rK, rV, j0 + 1, S_)
    int cur = 0;
    for (int j = j0; j <= i; ++j) {
      const u16* cK = sK + cur * 9216;
      const u16* cV = sV + cur * 9216;
      if (j == i || j == i - 8) {
        auto ok = [&](int kt, int ii) {
          const int kp = j * 64 + 16 * kt + 4 * lg + ii;
          return kp <= tq && kp > tq - 512;
        };
        if (usefix) flash_tile<3, true>(cK, cV, qf, O, m, l, ps, ok, true, lane);
        else flash_tile<2, true>(cK, cV, qf, O, m, l, ps, ok, true, lane);
      } else {
        if (usefix) flash_tile<3, false>(cK, cV, qf, O, m, l, ps, nomask, true, lane);
        else flash_tile<2, false>(cK, cV, qf, O, m, l, ps, nomask, true, lane);
      }
      cur ^= 1;
      if (j + 1 <= i) COMMIT_BUF(cur)
      __syncthreads();
      if (j + 2 <= i) ISSUE_TILE(rK, rV, j + 2, S_)
    }
  }
  u16* NSAb = (u16*)(p->ws + OFF_NSA);
#pragma unroll
  for (int qt = 0; qt < 2; ++qt) {
    float s = l[qt];
    s += __shfl_xor(s, 16);
    s += __shfl_xor(s, 32);
    const float sc = NGb[ngoff + qt * 3 + 2] / s;
#pragma unroll
    for (int dt = 0; dt < 4; ++dt) {
      const float4 a = *(const float4*)(ACCb + (aoff + qt * 64 + 16 * dt));
      uint2 o;
      o.x = pk2(a.x + O[qt][dt][0] * sc, a.y + O[qt][dt][1] * sc);
      o.y = pk2(a.z + O[qt][dt][2] * sc, a.w + O[qt][dt][3] * sc);
      *(uint2*)(NSAb + (aoff + qt * 64 + 16 * dt)) = o;
    }
  }
  __syncthreads();
}

DI void phaseE(int wv0, PP p, unsigned char* smem, int cidx) {
  __shared__ int s_item;
  int* ctr = (int*)(p->ws + OFF_CTR) + cidx;
  for (;;) {
    __syncthreads();
    if (my_tid(wv0) == 0) s_item = atomicAdd(ctr, 1);
    __syncthreads();
    const int item = s_item;
    if (item >= 1024 + 2048 + (NXT - NXT_A)) break;
    if (item < 1024) nsa_item(wv0, p, item, smem);
    else if (item < 1024 + 2048) s5_item<true>(wv0, p, item - 1024, smem);
    else xpose_tile(wv0, p, NXT_A + (item - 3072), smem);
  }
}

DI void phaseF(int wv0, PP p, unsigned char* smem) {
  const u16* YS = (const u16*)(p->ws + OFF_YS);
  const u16* NSA = (const u16*)(p->ws + OFF_NSA);
  const u16* MG = (const u16*)(p->ws + OFF_MG);
  u16* MR = (u16*)(p->ws + OFF_MERGED);
  for (int id = blockIdx.x; id < 128 * 4; id += gridDim.x) {
    int pm, pn;
    tile_map_n4(id, pm, pn);
    const int brow = pm * 256, bcol = pn * 256;
    f32x4 acc[2][2][4][2];
#pragma unroll 1
    for (int h = 0; h < 2; ++h) {
      const int grp = pn * 2 + h;
      gemm256(wv0, acc, YS + (size_t)brow * 512, 512, (const u16*)(p->ws + OFF_WVT) + (size_t)grp * 256 * 512, 512, 512, smem);
#pragma unroll
      for (int ai = 0; ai < 2; ++ai)
#pragma unroll
        for (int m = 0; m < 4; ++m)
#pragma unroll
          for (int n = 0; n < 2; ++n)
#pragma unroll
            for (int j = 0; j < 4; ++j) acc[ai][0][m][n][j] *= sigmoidf_(acc[ai][1][m][n][j]);
      __builtin_amdgcn_sched_barrier(0);
      epi256(wv0, acc, brow, grp * 128, [&](int ai, int bj, int m, int n, int row, int col0, f32x4& v) {
        if (bj == 0) {
          const unsigned og = (unsigned)row * 2048u + 1024u + (unsigned)col0, om = (unsigned)row * 1024u + (unsigned)col0;
          const uint2 gq = *(const uint2*)(MG + og);
          *(uint2*)(MR + om) = pk4(__uint_as_float(gq.x << 16) * v[0], __uint_as_float(gq.x & 0xffff0000u) * v[1],
                                   __uint_as_float(gq.y << 16) * v[2], __uint_as_float(gq.y & 0xffff0000u) * v[3]);
        }
      });
    }
    gemm256(wv0, acc, NSA + (size_t)brow * 512, 512, (const u16*)(p->ws + OFF_WAT) + (size_t)bcol * 512, 512, 512, smem);
    epi256(wv0, acc, brow, bcol, [&](int ai, int bj, int m, int n, int row, int col0, f32x4& v) {
      const unsigned og = (unsigned)row * 2048u + (unsigned)col0, om = (unsigned)row * 1024u + (unsigned)col0;
      const uint2 t = *(const uint2*)(MR + om);
      const uint2 gq = *(const uint2*)(MG + og);
      *(uint2*)(MR + om) =
          pk4(__uint_as_float(gq.x << 16) * v[0] + __uint_as_float(t.x << 16), __uint_as_float(gq.x & 0xffff0000u) * v[1] + __uint_as_float(t.x & 0xffff0000u),
              __uint_as_float(gq.y << 16) * v[2] + __uint_as_float(t.y << 16), __uint_as_float(gq.y & 0xffff0000u) * v[3] + __uint_as_float(t.y & 0xffff0000u));
    });
  }
}
DI void ss_partial(int wv0, f32x4 (&acc)[2][2][4][2], float* SS, int brow, int pn) {
  const int lane = my_tid(wv0) & 63, wr = wv0 >> 2, wc = wv0 & 3;
#pragma unroll
  for (int ai = 0; ai < 2; ++ai)
#pragma unroll
    for (int m = 0; m < 4; ++m) {
      float s = 0.f;
#pragma unroll
      for (int bj = 0; bj < 2; ++bj)
#pragma unroll
        for (int n = 0; n < 2; ++n)
#pragma unroll
          for (int j = 0; j < 4; ++j) s += acc[ai][bj][m][n][j] * acc[ai][bj][m][n][j];
      s += __shfl_xor(s, 16);
      s += __shfl_xor(s, 32);
      if (lane < 16) SS[(size_t)(brow + ai * 128 + wr * 64 + m * 16 + lane) * 16 + pn * 4 + wc] = s;
    }
}
DI void phaseG(int wv0, PP p, unsigned char* smem) {
  const u16* MR = (const u16*)(p->ws + OFF_MERGED);
  u16* X1B = (u16*)(p->ws + OFF_X1B);
  float* SS1 = (float*)(p->ws + OFF_SS1);
  for (int id = blockIdx.x; id < 128 * 4; id += gridDim.x) {
    int pm, pn;
    tile_map_n4(id, pm, pn);
    pm = 127 - pm;
    const int brow = pm * 256, bcol = pn * 256;
    f32x4 acc[2][2][4][2];
    gemm256(wv0, acc, MR + (size_t)brow * 1024, 1024, (const u16*)(p->ws + OFF_WOT) + (size_t)bcol * 1024, 1024, 1024, smem);
    epi256(wv0, acc, brow, bcol, [&](int ai, int bj, int m, int n, int row, int col0, f32x4& v) {
      const size_t o = (size_t)row * 1024 + col0;
      const float4 xv = *(const float4*)(p->x + o);
      v[0] += xv.x; v[1] += xv.y; v[2] += xv.z; v[3] += xv.w;
      *(uint2*)(X1B + o) = pk4(v[0], v[1], v[2], v[3]);
    });
    ss_partial(wv0, acc, SS1, brow, pn);
  }
}
DI void phaseH(int wv0, PP p, unsigned char* smem) {
  const u16* X1B = (const u16*)(p->ws + OFF_X1B);
  const float* SS1 = (const float*)(p->ws + OFF_SS1);
  u16* ACT = (u16*)(p->ws + OFF_ACT);
  float* sR = (float*)(smem + 131072);
  for (int id = blockIdx.x; id < 128 * 16; id += gridDim.x) {
    int pm, pn;
    tile_map_n16(id, pm, pn);
    const int brow = pm * 256, bcol = pn * 256;
    const int tid = my_tid(wv0);
    if (tid < 256) {
      const float4* s = (const float4*)(SS1 + (size_t)(brow + tid) * 16);
      const float4 a = s[0], b = s[1], c = s[2], d = s[3];
      const float t = a.x + a.y + a.z + a.w + b.x + b.y + b.z + b.w + c.x + c.y + c.z + c.w + d.x + d.y + d.z + d.w;
      sR[tid] = rsqrtf(t * (1.f / 1024.f) + 1e-6f);
    }
    f32x4 acc[2][2][4][2];
    gemm256(wv0, acc, X1B + (size_t)brow * 1024, 1024, (const u16*)(p->ws + OFF_WUPT) + (size_t)bcol * 1024, 1024, 1024, smem);
    epi256(wv0, acc, brow, bcol, [&](int ai, int bj, int m, int n, int row, int col0, f32x4& v) {
      const float ri = sR[row - brow];
      const float a0 = fmaxf(v[0] * ri, 0.f), a1 = fmaxf(v[1] * ri, 0.f), a2 = fmaxf(v[2] * ri, 0.f), a3 = fmaxf(v[3] * ri, 0.f);
      *(uint2*)(ACT + (size_t)row * 4096 + col0) = pk4(a0 * a0, a1 * a1, a2 * a2, a3 * a3);
    });
    __syncthreads();
  }
}
DI void phaseI(int wv0, PP p, unsigned char* smem) {
  const u16* ACT = (const u16*)(p->ws + OFF_ACT);
  const u16* X1B = (const u16*)(p->ws + OFF_X1B);
  float* SS2 = (float*)(p->ws + OFF_SS2);
  for (int id = blockIdx.x; id < 128 * 4; id += gridDim.x) {
    int pm, pn;
    tile_map_n4(id, pm, pn);
    pm = 127 - pm;
    const int brow = pm * 256, bcol = pn * 256;
    f32x4 acc[2][2][4][2];
    gemm256(wv0, acc, ACT + (size_t)brow * 4096, 4096, (const u16*)(p->ws + OFF_WDT) + (size_t)bcol * 4096, 4096, 4096, smem);
    epi256(wv0, acc, brow, bcol, [&](int ai, int bj, int m, int n, int row, int col0, f32x4& v) {
      const size_t o = (size_t)row * 1024 + col0;
      const uint2 xb = *(const uint2*)(X1B + o);
      v[0] += __uint_as_float(xb.x << 16); v[1] += __uint_as_float(xb.x & 0xffff0000u);
      v[2] += __uint_as_float(xb.y << 16); v[3] += __uint_as_float(xb.y & 0xffff0000u);
      *(float4*)(p->out + o) = make_float4(v[0], v[1], v[2], v[3]);
    });
    ss_partial(wv0, acc, SS2, brow, pn);
  }
}
DI void phaseJ(int wv0, PP p) {
  const int lane = my_tid(wv0) & 63;
  const float* SS2 = (const float*)(p->ws + OFF_SS2);
  for (int row = blockIdx.x * 8 + wv0; row < T_; row += gridDim.x * 8) {
    float t = (lane < 16) ? SS2[(size_t)row * 16 + lane] : 0.f;
    t = wave_sum(t);
    const float rinv = rsqrtf(t * (1.f / 1024.f) + 1e-6f);
    float4* xr = (float4*)(p->out + (size_t)row * 1024);
#pragma unroll
    for (int r = 0; r < 4; ++r) {
      float4 v = xr[lane + 64 * r];
      const float4 g = ((const float4*)p->g3)[lane + 64 * r];
      v.x *= rinv * g.x; v.y *= rinv * g.y; v.z *= rinv * g.z; v.w *= rinv * g.w;
      xr[lane + 64 * r] = v;
    }
  }
}


#define XB_TMO      128
#define XB_XCNT(j)  (256  + 64 * (j))
#define XB_XSUB(j)  (1280 + 64 * (j))
#define XB_XGEN(j)  (2304 + 64 * (j))
#define XB_TOP      3328
#define XB_TOPGEN   3392
#define XB_SPIN_CAP (1u << 18)
#define LAS __attribute__((address_space(3)))
DI unsigned xb_ld(unsigned* p) { return __hip_atomic_load(p, __ATOMIC_RELAXED, __HIP_MEMORY_SCOPE_AGENT); }
DI unsigned xb_add(unsigned* p, unsigned v) { return __hip_atomic_fetch_add(p, v, __ATOMIC_RELAXED, __HIP_MEMORY_SCOPE_AGENT); }
DI unsigned xb_xcc_id() { return (unsigned)__builtin_amdgcn_s_getreg((3 << 11) | 20) & 0xFu; }
#define XB_SPIN(cond, bar) do { unsigned _sp = 0; while (cond) { __builtin_amdgcn_s_sleep(1); \
    if ((++_sp & 255u) == 0u) { if (xb_ld(&(bar)[XB_TMO])) break; if (_sp > XB_SPIN_CAP) { atomicAdd(&(bar)[XB_TMO], 1u); break; } } } } while (0)
DI void xcd_barrier_complete(unsigned* bar, unsigned x, unsigned& nloc, unsigned& nx) {
  const unsigned G = gridDim.x * gridDim.y * gridDim.z;
  unsigned sum, cnt, mine, sp = 0u;
  for (;;) {
    sum = 0u; cnt = 0u; mine = 0u;
#pragma unroll
    for (unsigned j = 0; j < 16; ++j) { const unsigned c = xb_ld(&bar[XB_XCNT(j)]); sum += c; cnt += (c > 0u) ? 1u : 0u; mine = (j == x) ? c : mine; }
    if (sum == G) break;
    __builtin_amdgcn_s_sleep(1);
    if ((++sp & 255u) == 0u) { if (xb_ld(&bar[XB_TMO])) break; if (sp > XB_SPIN_CAP) { atomicAdd(&bar[XB_TMO], 1u); break; } }
  }
  nloc = mine > 0u ? mine : 1u; nx = cnt > 0u ? cnt : 1u;
}
DI void xcd_barrier(unsigned* bar, volatile LAS unsigned* st, bool leader) {
  asm volatile("s_waitcnt vmcnt(0)" ::: "memory");
  __syncthreads();
  if (leader) {
    const unsigned x = xb_xcc_id();
    __builtin_amdgcn_s_waitcnt(0);
    unsigned nloc = st[0], nx = st[1];
    if (nloc == 0u) { xcd_barrier_complete(bar, x, nloc, nx); st[0] = nloc; st[1] = nx; }
    const unsigned old = xb_add(&bar[XB_XSUB(x)], 1u);
    const unsigned gen = old / nloc;
    if (old + 1u == (gen + 1u) * nloc) {
      __builtin_amdgcn_fence(__ATOMIC_RELEASE, "agent");
      asm volatile("s_waitcnt vmcnt(0)" ::: "memory");
      const unsigned og = xb_add(&bar[XB_TOP], 1u);
      const unsigned tg = og / nx;
      if (og + 1u == (tg + 1u) * nx) xb_add(&bar[XB_TOPGEN], 1u);
      else XB_SPIN(xb_ld(&bar[XB_TOPGEN]) == tg, bar);
      __builtin_amdgcn_fence(__ATOMIC_ACQUIRE, "agent");
      xb_add(&bar[XB_XGEN(x)], 1u);
      asm volatile("s_waitcnt vmcnt(0)" ::: "memory");
    } else {
      XB_SPIN(xb_ld(&bar[XB_XGEN(x)]) == gen, bar);
      __builtin_amdgcn_fence(__ATOMIC_ACQUIRE, "agent");
      asm volatile("s_waitcnt vmcnt(0)" ::: "memory");
    }
  }
  __syncthreads();
}

__global__ void __launch_bounds__(512, 2) mega(Params p) {
  extern __shared__ __attribute__((aligned(16))) unsigned char smem[];
  const int wv0 = __builtin_amdgcn_readfirstlane((int)(threadIdx.x >> 6));
  const int lo = p.lo, hi = p.hi;
  PP kp0 = (PP)__builtin_amdgcn_kernarg_segment_ptr();
  __shared__ uint4 xb_words;
  if (threadIdx.x == 0) {
    xb_words = make_uint4(0u, 0u, 0u, 0u);
    (void)xb_add((unsigned*)(kp0->ws + OFF_BAR) + XB_XCNT(xb_xcc_id()), 1u);
  }
  __syncthreads();
#define PH(N, CALL)                                  \
  if (lo <= N && N < hi) {                           \
    PP kp = kp0;                                     \
    asm volatile("" : "+s"(kp));                     \
    if (N > lo) {                                    \
      if (N == 1) cg::this_grid().sync();            \
      else xcd_barrier((unsigned*)(kp->ws + OFF_BAR), (volatile LAS unsigned*)&xb_words, my_tid(wv0) == 0); \
    }                                                \
    CALL;                                            \
    if ((PROBE_MASK >> N) & 1) { CALL; }             \
  }
  PH(0, phaseA(wv0, kp, smem))
  PH(1, phaseB(wv0, kp, smem))
  PH(2, phaseC(wv0, kp, smem))
  PH(3, phaseD1(wv0, kp, smem))
  PH(4, phaseD(wv0, kp, smem))
  PH(5, phaseE(wv0, kp, smem, 0))
  PH(6, phaseF(wv0, kp, smem))
  PH(7, phaseG(wv0, kp, smem))
  PH(8, phaseH(wv0, kp, smem))
  PH(9, phaseI(wv0, kp, smem))
  PH(10, phaseJ(wv0, kp))
}

extern "C" void kernel_launch(void* const* d_in, const int* in_sizes, int n_in, void* d_out, int out_size, void* d_ws,
                              size_t ws_size, hipStream_t stream) {
  static int grid_blocks = 0;
  if (!grid_blocks) {
    int dev = 0, cus = 0, per_cu = 0;
    (void)hipGetDevice(&dev);
    (void)hipDeviceGetAttribute(&cus, hipDeviceAttributeMultiprocessorCount, dev);
    (void)hipFuncSetAttribute((const void*)mega, hipFuncAttributeMaxDynamicSharedMemorySize, SMEM_BYTES);
    (void)hipOccupancyMaxActiveBlocksPerMultiprocessor(&per_cu, mega, NT_, SMEM_BYTES);
    if (per_cu > 1) per_cu = 1;
    if (per_cu < 1) per_cu = 1;
    grid_blocks = cus * per_cu;
  }
  if (ws_size < WS_NEED) { fprintf(stderr, "workspace too small: %zu < %zu\n", ws_size, (size_t)WS_NEED); }
  Params p{};
  const float** f = (const float**)&p;
  for (int i = 0; i < 24; ++i) f[i] = (const float*)d_in[i];
  p.out = (float*)d_out;
  p.ws = (unsigned char*)d_ws;
  p.lo = 0; p.hi = 11;
  (void)hipMemsetAsync((unsigned char*)d_ws + OFF_BAR, 0, 16384, stream);
  void* args[] = {&p};
  hipError_t e = hipLaunchCooperativeKernel((void*)mega, dim3(grid_blocks), dim3(NT_), args, SMEM_BYTES, stream);
  if (e != hipSuccess) fprintf(stderr, "cooperative launch failed: %s (grid %d)\n", hipGetErrorString(e), grid_blocks);
}
```

```cpp
#include <hip/hip_runtime.h>
#include <hip/hip_cooperative_groups.h>
#include <cstdio>
namespace cg = cooperative_groups;

#ifndef PROBE_MASK
#define PROBE_MASK 0
#endif

#define DI __device__ __forceinline__
typedef unsigned short u16;
typedef unsigned long long u64;
using bf16x8 = __attribute__((ext_vector_type(8))) short;
using f32x4 = __attribute__((ext_vector_type(4))) float;
using u32x4 = __attribute__((ext_vector_type(4))) unsigned;

constexpr int B_ = 4, S_ = 8192, T_ = B_ * S_;
constexpr int NT_ = 512;
constexpr int NINP = 4096;
constexpr float QSCALE = 0.125f * 1.44269504089f;

constexpr size_t MB = 1024 * 1024;
constexpr size_t OFF_WINT = 0;
constexpr size_t OFF_W1KT = OFF_WINT + (size_t)NINP * 1024 * 2;
constexpr size_t OFF_W1VT = OFF_W1KT + 256 * 2048 * 2;
constexpr size_t OFF_W2KT = OFF_W1VT + 256 * 2048 * 2;
constexpr size_t OFF_W2VT = OFF_W2KT + 256 * 256 * 2;
constexpr size_t OFF_WAT = OFF_W2VT + 256 * 256 * 2;
constexpr size_t OFF_WVT = OFF_WAT + 1024 * 512 * 2;
constexpr size_t OFF_WGT = OFF_WVT + 1024 * 512 * 2;
constexpr size_t OFF_WOT = OFF_WGT + 1024 * 512 * 2;
constexpr size_t OFF_WUPT = OFF_WOT + 1024 * 1024 * 2;
constexpr size_t OFF_WDT = OFF_WUPT + 4096 * 1024 * 2;
constexpr size_t OFF_ROPE = OFF_WDT + 4096 * 1024 * 2;
constexpr size_t OFF_CBP = OFF_ROPE + 8192 * 16 * 4;
constexpr size_t OFF_CTR = OFF_CBP + 2 * 32 * 256 * 4;
constexpr size_t OFF_KMAX = OFF_CTR + 64;
constexpr size_t OFF_BAR = OFF_CTR + 256;
constexpr size_t OFF_SS1 = OFF_BAR + 16384;
constexpr size_t OFF_SS2 = OFF_SS1 + (size_t)T_ * 16 * 4;
constexpr size_t OFF_NG = OFF_SS2 + (size_t)T_ * 16 * 4;
constexpr size_t OFF_HC = OFF_NG + (size_t)T_ * 24 * 4;
constexpr size_t OFF_KCC = OFF_HC + 2 * 4096 * 256 * 2;
constexpr size_t OFF_VCT = OFF_KCC + 8 * 512 * 64 * 2;
constexpr size_t OFF_HLOC = OFF_VCT + 8 * 512 * 64 * 2;
constexpr size_t OFF_ARENA = OFF_HLOC + (size_t)4 * 128 * 32 * 64 * 8;
constexpr size_t OFF_MG = OFF_ARENA;
constexpr size_t OFF_HN = OFF_ARENA + 128 * MB;
constexpr size_t OFF_QRAW = OFF_ARENA + 192 * MB;
constexpr size_t OFF_QROT = OFF_ARENA + 224 * MB;
constexpr size_t OFF_KCIN = OFF_ARENA + 256 * MB;
constexpr size_t OFF_VCIN = OFF_KCIN + 8 * MB;
constexpr size_t OFF_KS = OFF_VCIN + 8 * MB;
constexpr size_t OFF_VST = OFF_KS + 8 * MB;
constexpr size_t OFF_KW = OFF_VST + 8 * MB;
constexpr size_t OFF_VWT = OFF_KW + 8 * MB;
constexpr size_t OFF_U = OFF_ARENA + 304 * MB;
constexpr size_t OFF_NSA = OFF_ARENA + 336 * MB;
constexpr size_t OFF_YS = OFF_ARENA + 368 * MB;
constexpr size_t OFF_CPART = OFF_ARENA + 400 * MB;
constexpr size_t OFF_S5T = OFF_CPART + 32 * MB;
constexpr size_t OFF_S5L = OFF_S5T + 32 * 8192;
constexpr size_t WS_NEED = OFF_S5L + 32 * 64 * 8;
constexpr size_t OFF_ACT = OFF_ARENA;
constexpr size_t OFF_X1B = OFF_ARENA + 256 * MB;
constexpr size_t OFF_MERGED = OFF_HN;

constexpr int SMEM_BYTES = 131072 + 1024;

struct Params {
  const float *x, *g1, *w_in, *pe, *kw1, *kw2, *vw1, *vw2, *lam_re, *lam_im, *log_step, *b_re, *b_im, *c_re, *c_im, *dsk,
      *w_attn, *w_val, *w_gate, *w_out, *g2, *w_up, *w_down, *g3;
  float* out;
  unsigned char* ws;
  int lo, hi;
};

typedef const __attribute__((address_space(4))) Params* PP;

DI int my_tid(int wv0) {
  int t = wv0 * 64 + (int)__lane_id();
  asm volatile("" : "+v"(t));
  return t;
}
DI unsigned pk2(float a, float b);
DI u16 f2bf(float x) { return (u16)(pk2(x, 0.f) & 0xffffu); }
DI float bf2f(u16 h) { return __uint_as_float(((unsigned)h) << 16); }
typedef float f32x2_t __attribute__((ext_vector_type(2)));
typedef __bf16 bf16x2_t __attribute__((ext_vector_type(2)));
DI unsigned pk2(float a, float b) {
  const f32x2_t v = {a, b};
  return __builtin_bit_cast(unsigned, __builtin_convertvector(v, bf16x2_t));
}
DI uint2 pk4(float a, float b, float c, float d) { uint2 o; o.x = pk2(a, b); o.y = pk2(c, d); return o; }
DI float sigmoidf_(float x) { return 1.f / (1.f + __expf(-x)); }
DI float gelu_t(float x) {
  float u = 0.7978845608f * (x + 0.044715f * x * x * x);
  float e = __expf(2.f * u);
  float th = 1.f - 2.f / (e + 1.f);
  return 0.5f * x * (1.f + th);
}
DI float wave_sum(float v) {
#pragma unroll
  for (int o = 32; o > 0; o >>= 1) v += __shfl_xor(v, o);
  return v;
}
DI f32x4 mfma16(bf16x8 a, bf16x8 b, f32x4 c) { return __builtin_amdgcn_mfma_f32_16x16x32_bf16(a, b, c, 0, 0, 0); }

constexpr int G_HT = 128 * 64;
DI int lds_byte(int r, int c) {
  const int st = (r >> 4) * 2 + (c >> 5), rr = r & 15, cc = c & 31, ob = rr * 64 + cc * 2;
  return st * 1024 + (ob ^ (((ob >> 9) & 1) << 5));
}
DI void stage_rc(int b, int& R, int& C) {
  const int st = b / 1024, sb = b % 1024, swz = sb ^ (((sb >> 9) & 1) << 5);
  R = (st >> 1) * 16 + swz / 64;
  C = (st & 1) * 32 + (swz % 64) / 2;
}
typedef __attribute__((address_space(3))) unsigned* lds_u32p;
DI void gemm256(int wv0, f32x4 (&acc)[2][2][4][2], const u16* __restrict__ A, int lda, const u16* __restrict__ Bt, int ldb,
                int K, unsigned char* smem) {
  u16* shm = (u16*)smem;
  const int tid = my_tid(wv0), lane = tid & 63;
  const int wr = wv0 >> 2, wc = wv0 & 3, fr = lane & 15, fq = lane >> 4;
#define SA(b, h) (shm + ((b)*2 + (h)) * G_HT)
#define SB(b, h) (shm + (4 + (b)*2 + (h)) * G_HT)
  int sr0, sc0, sr1, sc1;
  stage_rc(tid * 16, sr0, sc0);
  stage_rc(tid * 16 + 8192, sr1, sc1);
  const u16* a0 = A + (size_t)sr0 * lda + sc0;
  const u16* a1 = A + (size_t)sr1 * lda + sc1;
  const u16* b0 = Bt + (size_t)sr0 * ldb + sc0;
  const u16* b1 = Bt + (size_t)sr1 * ldb + sc1;
#define STAGE_A(P, half, kt)                                                                                              \
  {                                                                                                                       \
    __builtin_amdgcn_global_load_lds((const unsigned*)(a0 + (size_t)((half)*128) * lda + (kt)*64),                        \
                                     (unsigned*)((char*)(P) + tid * 16), 16, 0, 0);                               \
    __builtin_amdgcn_global_load_lds((const unsigned*)(a1 + (size_t)((half)*128) * lda + (kt)*64),                        \
                                     (unsigned*)((char*)(P) + tid * 16 + 8192), 16, 0, 0);                        \
  }
#define STAGE_B(P, half, kt)                                                                                              \
  {                                                                                                                       \
    __builtin_amdgcn_global_load_lds((const unsigned*)(b0 + (size_t)((half)*128) * ldb + (kt)*64),                        \
                                     (unsigned*)((char*)(P) + tid * 16), 16, 0, 0);                               \
    __builtin_amdgcn_global_load_lds((const unsigned*)(b1 + (size_t)((half)*128) * ldb + (kt)*64),                        \
                                     (unsigned*)((char*)(P) + tid * 16 + 8192), 16, 0, 0);                        \
  }
#define LDA(dst, b, h)                                                                                                    \
  _Pragma("unroll") for (int m = 0; m < 4; ++m) _Pragma("unroll") for (int k = 0; k < 2; ++k)                             \
      dst[m][k] = *(const bf16x8*)((const unsigned char*)SA(b, h) + lds_byte(wr * 64 + m * 16 + fr, k * 32 + fq * 8));
#define LDB(dst, b, h)                                                                                                    \
  _Pragma("unroll") for (int n = 0; n < 2; ++n) _Pragma("unroll") for (int k = 0; k < 2; ++k)                             \
      dst[n][k] = *(const bf16x8*)((const unsigned char*)SB(b, h) + lds_byte(wc * 32 + n * 16 + fr, k * 32 + fq * 8));
#define MMA(ai, bj, At_, Bt_)                                                                                             \
  {                                                                                                                       \
    __builtin_amdgcn_s_setprio(1);                                                                                        \
    _Pragma("unroll") for (int m = 0; m < 4; ++m) _Pragma("unroll") for (int n = 0; n < 2; ++n)                           \
        _Pragma("unroll") for (int k = 0; k < 2; ++k) acc[ai][bj][m][n] =                                                 \
            __builtin_amdgcn_mfma_f32_16x16x32_bf16(Bt_[n][k], At_[m][k], acc[ai][bj][m][n], 0, 0, 0);                    \
    __builtin_amdgcn_s_setprio(0);                                                                                        \
  }
#define WAIT_V(n) asm volatile("s_waitcnt vmcnt(" #n ")" ::: "memory")
#define WAIT_L(n) asm volatile("s_waitcnt lgkmcnt(" #n ")" ::: "memory")
#define BAR __builtin_amdgcn_s_barrier()
#define SCHED __builtin_amdgcn_sched_barrier(0)
#pragma unroll
  for (int a = 0; a < 2; ++a)
#pragma unroll
    for (int b = 0; b < 2; ++b)
#pragma unroll
      for (int m = 0; m < 4; ++m)
#pragma unroll
        for (int n = 0; n < 2; ++n) acc[a][b][m][n] = f32x4{0.f, 0.f, 0.f, 0.f};
  bf16x8 At[4][2], B0[2][2], B1[2][2];
  const int nt = K / 64;
  WAIT_V(0);
  __syncthreads();
  STAGE_B(SB(0, 0), 0, 0) STAGE_A(SA(0, 0), 0, 0)
  STAGE_B(SB(0, 1), 1, 0) STAGE_A(SA(0, 1), 1, 0)
  if (wr == 1) BAR;
  WAIT_V(4); BAR;
  STAGE_B(SB(1, 0), 0, 1) STAGE_A(SA(1, 0), 0, 1) STAGE_B(SB(1, 1), 1, 1)
  WAIT_V(6); BAR;
#pragma unroll 1
  for (int t = 0; t < nt - 2; t += 2) {
    LDB(B0, 0, 0) SCHED; LDA(At, 0, 0) STAGE_A(SA(1, 1), 1, t + 1)
    WAIT_L(8); BAR; WAIT_L(0); MMA(0, 0, At, B0) BAR; SCHED;
    LDB(B1, 0, 1) STAGE_B(SB(0, 0), 0, t + 2)
    BAR; WAIT_L(0); MMA(0, 1, At, B1) BAR;
    LDA(At, 0, 1) STAGE_A(SA(0, 0), 0, t + 2)
    BAR; WAIT_L(0); MMA(1, 0, At, B0) BAR; SCHED;
    STAGE_B(SB(0, 1), 1, t + 2)
    WAIT_V(6); BAR; MMA(1, 1, At, B1) BAR;
    LDB(B0, 1, 0) SCHED; LDA(At, 1, 0) STAGE_A(SA(0, 1), 1, t + 2)
    WAIT_L(8); BAR; WAIT_L(0); MMA(0, 0, At, B0) BAR; SCHED;
    LDB(B1, 1, 1) STAGE_B(SB(1, 0), 0, t + 3)
    BAR; WAIT_L(0); MMA(0, 1, At, B1) BAR;
    LDA(At, 1, 1) STAGE_A(SA(1, 0), 0, t + 3)
    BAR; WAIT_L(0); MMA(1, 0, At, B0) BAR; SCHED;
    STAGE_B(SB(1, 1), 1, t + 3)
    WAIT_V(6); BAR; MMA(1, 1, At, B1) BAR;
  }
  {
    LDB(B0, 0, 0) LDA(At, 0, 0) STAGE_A(SA(1, 1), 1, nt - 1)
    BAR; WAIT_L(0); MMA(0, 0, At, B0) BAR;
    LDB(B1, 0, 1) BAR; WAIT_L(0); MMA(0, 1, At, B1) BAR;
    LDA(At, 0, 1) WAIT_V(4); BAR; WAIT_L(0); MMA(1, 0, At, B0) MMA(1, 1, At, B1) BAR;
  }
  {
    LDB(B0, 1, 0) LDA(At, 1, 0) WAIT_V(2); BAR; WAIT_L(0); MMA(0, 0, At, B0) BAR;
    LDB(B1, 1, 1) WAIT_V(0); BAR; WAIT_L(0); MMA(0, 1, At, B1) BAR;
    LDA(At, 1, 1) BAR; WAIT_L(0); MMA(1, 0, At, B0) MMA(1, 1, At, B1) BAR;
  }
  if (wr == 0) BAR;
}
DI void tile_map_n16(int id, int& pm, int& pn) {
  const int k = id & 255, rnd = id >> 8, x = k & 7, slot = k >> 3;
  pm = rnd * 16 + 4 * (x >> 1) + (slot >> 3);
  pn = 8 * (x & 1) + (slot & 7);
}
DI void tile_map_n4(int id, int& pm, int& pn) {
  const int k = id & 255, rnd = id >> 8, x = k & 7, slot = k >> 3;
  pm = rnd * 64 + 8 * x + (slot >> 2);
  pn = slot & 3;
}
template <class F>
DI void epi256(int wv0, f32x4 (&acc)[2][2][4][2], int brow, int bcol, F f) {
  const int lane = my_tid(wv0) & 63, wr = wv0 >> 2, wc = wv0 & 3;
#pragma unroll
  for (int ai = 0; ai < 2; ++ai)
#pragma unroll
    for (int bj = 0; bj < 2; ++bj)
#pragma unroll
      for (int m = 0; m < 4; ++m)
#pragma unroll
        for (int n = 0; n < 2; ++n) {
          const int row = brow + ai * 128 + wr * 64 + m * 16 + (lane & 15);
          const int col0 = bcol + bj * 128 + wc * 32 + n * 16 + (lane >> 4) * 4;
          f(ai, bj, m, n, row, col0, acc[ai][bj][m][n]);
          if (n == 1 && (m & 1)) __builtin_amdgcn_sched_barrier(0);
        }
}

constexpr int NXT_A = 1024 + 128 + 128 + 16 + 16;
constexpr int NXT = NXT_A + 128 * 3 + 256 + 1024 + 1024;
DI void xpose_tile(int wv0, PP p, int jt, unsigned char* smem) {
  const int tid = my_tid(wv0);
  float* tile = (float*)smem;
  int t = jt;
  const float* src;
  u16* dst;
  int K, Nsrc, mode = 0, rowil = -1;
  const float* scl = nullptr;
  if (t < 1024) { src = p->w_in; dst = (u16*)(p->ws + OFF_WINT); K = 1024; Nsrc = 3864; mode = 1; }
  else if ((t -= 1024) < 128) { src = p->kw1; dst = (u16*)(p->ws + OFF_W1KT); K = 2048; Nsrc = 256; }
  else if ((t -= 128) < 128) { src = p->vw1; dst = (u16*)(p->ws + OFF_W1VT); K = 2048; Nsrc = 256; }
  else if ((t -= 128) < 16) { src = p->kw2; dst = (u16*)(p->ws + OFF_W2KT); K = 256; Nsrc = 64; mode = 2; }
  else if ((t -= 16) < 16) { src = p->vw2; dst = (u16*)(p->ws + OFF_W2VT); K = 256; Nsrc = 64; mode = 2; }
  else if ((t -= 16) < 128) { src = p->w_attn; dst = (u16*)(p->ws + OFF_WAT); K = 512; Nsrc = 1024; }
  else if ((t -= 128) < 128) { src = p->w_val; dst = (u16*)(p->ws + OFF_WVT); K = 512; Nsrc = 1024; rowil = 0; }
  else if ((t -= 128) < 128) { src = p->w_gate; dst = (u16*)(p->ws + OFF_WVT); K = 512; Nsrc = 1024; rowil = 128; }
  else if ((t -= 128) < 256) { src = p->w_out; dst = (u16*)(p->ws + OFF_WOT); K = 1024; Nsrc = 1024; }
  else if ((t -= 256) < 1024) { src = p->w_up; dst = (u16*)(p->ws + OFF_WUPT); K = 1024; Nsrc = 4096; scl = p->g2; }
  else { t -= 1024; src = p->w_down; dst = (u16*)(p->ws + OFF_WDT); K = 4096; Nsrc = 1024; }
  const int nkt = K >> 6, tn = t / nkt, tk = t % nkt, n0 = tn * 64, k0 = tk * 64;
  const int tx = tid & 63, ty = tid >> 6;
  const int np = n0 + tx;
  int sc = np;
  if (mode == 1) {
    if (np < 1280) sc = np;
    else if (np < 1792) sc = 1304 + (np - 1280);
    else if (np < 3840) sc = 1816 + (np - 1792);
    else if (np < 3864) sc = 1280 + (np - 3840);
    else sc = -1;
  } else if (mode == 2) {
    sc = np < 64 ? np : -1;
  }
  for (int kk = ty; kk < 64; kk += 8) {
    float val = 0.f;
    if (sc >= 0) val = src[(size_t)(k0 + kk) * Nsrc + sc];
    if (scl) val *= scl[k0 + kk];
    tile[kk * 65 + tx] = val;
  }
  __syncthreads();
  {
    const int n = tid >> 3, kc = tid & 7;
    uint4 o;
    o.x = pk2(tile[(kc * 8 + 0) * 65 + n], tile[(kc * 8 + 1) * 65 + n]);
    o.y = pk2(tile[(kc * 8 + 2) * 65 + n], tile[(kc * 8 + 3) * 65 + n]);
    o.z = pk2(tile[(kc * 8 + 4) * 65 + n], tile[(kc * 8 + 5) * 65 + n]);
    o.w = pk2(tile[(kc * 8 + 6) * 65 + n], tile[(kc * 8 + 7) * 65 + n]);
    const int drow = rowil < 0 ? (n0 + n) : (((n0 + n) >> 7) * 256 + ((n0 + n) & 127) + rowil);
    *(uint4*)(dst + (size_t)drow * K + k0 + kc * 8) = o;
  }
  __syncthreads();
}

DI void phaseA(int wv0, PP p, unsigned char* smem) {
  const int tid = my_tid(wv0), lane = tid & 63;
  u16* HN = (u16*)(p->ws + OFF_HN);
  for (int row = blockIdx.x * 8 + wv0; row < T_; row += gridDim.x * 8) {
    const float4* xr = (const float4*)(p->x + (size_t)row * 1024);
    float4 v[4];
    float ss = 0.f;
#pragma unroll
    for (int r = 0; r < 4; ++r) {
      v[r] = xr[lane + 64 * r];
      ss += v[r].x * v[r].x + v[r].y * v[r].y + v[r].z * v[r].z + v[r].w * v[r].w;
    }
    ss = wave_sum(ss);
    const float rinv = rsqrtf(ss * (1.f / 1024.f) + 1e-6f);
#pragma unroll
    for (int r = 0; r < 4; ++r) {
      const float4 g = ((const float4*)p->g1)[lane + 64 * r];
      uint2 o;
      o.x = pk2(v[r].x * rinv * g.x, v[r].y * rinv * g.y);
      o.y = pk2(v[r].z * rinv * g.z, v[r].w * rinv * g.w);
      *(uint2*)(HN + (size_t)row * 1024 + (lane + 64 * r) * 4) = o;
    }
  }
  for (int jt = blockIdx.x; jt < NXT_A + 32 + 32; jt += gridDim.x) {
    if (jt < NXT_A) {
      xpose_tile(wv0, p, jt, smem);
    } else if (jt >= NXT_A + 32) {
      const int g = jt - (NXT_A + 32);
      u16* TB = (u16*)(p->ws + OFF_S5T + (size_t)g * 8192);
      const float step = expf(p->log_step[g]);
      for (int e = tid; e < 2048; e += NT_) {
        const int np = e >> 4, c = e & 15, n = np & 63;
        const float lr = p->lam_re[g * 64 + n], li = p->lam_im[g * 64 + n];
        const float er = expf(lr * step);
        float sn, cs;
        sincosf(li * step, &sn, &cs);
        const float nr = er * cs - 1.f, ni = er * sn, den = lr * lr + li * li;
        const float cr = (nr * lr + ni * li) / den, ci = (ni * lr - nr * li) / den;
        const float bre = p->b_re[(g * 64 + n) * 16 + c], bim = p->b_im[(g * 64 + n) * 16 + c];
        TB[np * 16 + c] = f2bf(np < 64 ? (cr * bre - ci * bim) : (cr * bim + ci * bre));
        const int cc = e >> 7, k = e & 127;
        TB[2048 + cc * 128 + k] = f2bf(k < 64 ? p->c_re[(g * 16 + cc) * 64 + k] : -p->c_im[(g * 16 + cc) * 64 + (k - 64)]);
      }
      if (tid < 64) {
        const float lr = p->lam_re[g * 64 + tid], li = p->lam_im[g * 64 + tid];
        const float er = expf(lr * step);
        float sn, cs;
        sincosf(li * step, &sn, &cs);
        ((float2*)(p->ws + OFF_S5L))[g * 64 + tid] = make_float2(er * cs, er * sn);
      }
    } else {
      const int item = jt - NXT_A, kv = item >> 4, slice = item & 15;
      const float* w1 = kv ? p->vw1 : p->kw1;
      const int col = tid & 255, h = tid >> 8, kb = slice * 128 + h * 64;
      float s0 = 0.f, s1 = 0.f, s2 = 0.f, s3 = 0.f;
      for (int k = kb; k < kb + 64; k += 4) {
        s0 += p->pe[k] * w1[(size_t)k * 256 + col];
        s1 += p->pe[k + 1] * w1[(size_t)(k + 1) * 256 + col];
        s2 += p->pe[k + 2] * w1[(size_t)(k + 2) * 256 + col];
        s3 += p->pe[k + 3] * w1[(size_t)(k + 3) * 256 + col];
      }
      ((float*)(p->ws + OFF_CBP))[(kv * 32 + slice * 2 + h) * 256 + col] = (s0 + s1) + (s2 + s3);
    }
  }
  float* rope = (float*)(p->ws + OFF_ROPE);
  for (int i = blockIdx.x * NT_ + tid; i < S_ * 8; i += gridDim.x * NT_) {
    const int pos = i >> 3, k = i & 7;
    const float inv = powf(500000.0f, -(2.0f * (float)k) / 16.0f);
    const float ang = (float)pos * inv;
    rope[pos * 16 + k] = cosf(ang);
    rope[pos * 16 + 8 + k] = sinf(ang);
  }
  if (blockIdx.x == 0 && tid < 64) ((int*)(p->ws + OFF_CTR))[tid] = 0;
}

DI void phaseB(int wv0, PP p, unsigned char* smem) {
  const u16* HN = (const u16*)(p->ws + OFF_HN);
  const u16* WT = (const u16*)(p->ws + OFF_WINT);
  const float* rope = (const float*)(p->ws + OFF_ROPE);
  const int lane = my_tid(wv0) & 63;
  const bool ropewave = (wv0 & 1) == 0;
  for (int id = blockIdx.x; id < 128 * 16; id += gridDim.x) {
    int pm, pn;
    tile_map_n16(id, pm, pn);
    pm = 127 - pm;
    pn = (pn + 5 * (id >> 8)) & 15;
    const int brow = pm * 256, bcol = pn * 256;
    f32x4 acc[2][2][4][2];
    gemm256(wv0, acc, HN + (size_t)brow * 1024, 1024, WT + (size_t)bcol * 1024, 1024, 1024, smem);
    if (pn < 2) {
      u16* QR = (u16*)(p->ws + OFF_QRAW);
      u16* QO = (u16*)(p->ws + OFF_QROT);
      epi256(wv0, acc, brow, bcol, [&](int ai, int bj, int m, int n, int row, int col0, f32x4& v) {
        f32x4 r = v;
        if (n == 0 && ropewave) {
          const int pos = row & (S_ - 1), kq = ((lane >> 4) & 1) * 4;
          const float4 c4 = *(const float4*)(rope + pos * 16 + kq), s4 = *(const float4*)(rope + pos * 16 + 8 + kq);
          const float cc[4] = {c4.x, c4.y, c4.z, c4.w}, ss[4] = {s4.x, s4.y, s4.z, s4.w};
#pragma unroll
          for (int j = 0; j < 4; ++j) {
            const float pr = __shfl_xor(v[j], 32);
            r[j] = (lane & 32) ? (v[j] * cc[j] + pr * ss[j]) : (v[j] * cc[j] - pr * ss[j]);
          }
        }
        *(uint2*)(QR + (size_t)row * 512 + col0) = pk4(v[0] * QSCALE, v[1] * QSCALE, v[2] * QSCALE, v[3] * QSCALE);
        *(uint2*)(QO + (size_t)row * 512 + col0) = pk4(r[0] * QSCALE, r[1] * QSCALE, r[2] * QSCALE, r[3] * QSCALE);
      });
    } else if (pn < 5) {
      epi256(wv0, acc, brow, bcol, [&](int ai, int bj, int m, int n, int row, int col0, f32x4& v) {
        const int sub = (pn - 2) * 2 + bj;
        const bool dorope = (sub == 2 || sub == 4), transposed = (sub == 3 || sub == 5);
        u16* dst = (u16*)(p->ws + OFF_KCIN + (size_t)sub * 8 * MB);
        const int c128 = col0 & 127, g = c128 >> 6, d0 = c128 & 63;
        const int b = row >> 13, sq = row & (S_ - 1);
        f32x4 r = v;
        if (dorope && n == 0 && ropewave) {
          const int kq = ((lane >> 4) & 1) * 4;
          const float4 c4 = *(const float4*)(rope + sq * 16 + kq), s4 = *(const float4*)(rope + sq * 16 + 8 + kq);
          const float cc[4] = {c4.x, c4.y, c4.z, c4.w}, ss[4] = {s4.x, s4.y, s4.z, s4.w};
#pragma unroll
          for (int j = 0; j < 4; ++j) {
            const float pr = __shfl_xor(v[j], 32);
            r[j] = (lane & 32) ? (v[j] * cc[j] + pr * ss[j]) : (v[j] * cc[j] - pr * ss[j]);
          }
        }
        if (transposed) {
#pragma unroll
          for (int j = 0; j < 4; ++j) dst[((size_t)((b * 2 + g) * 64 + d0 + j)) * S_ + sq] = f2bf(r[j]);
        } else {
          *(uint2*)(dst + ((size_t)(b * 2 + g) * S_ + sq) * 64 + d0) = pk4(r[0], r[1], r[2], r[3]);
        }
      });
    } else if (pn < 7) {
      u16* U = (u16*)(p->ws + OFF_U);
      epi256(wv0, acc, brow, bcol, [&](int ai, int bj, int m, int n, int row, int col0, f32x4& v) {
        *(uint2*)(U + (size_t)row * 512 + (col0 - 1280)) = pk4(v[0], v[1], v[2], v[3]);
      });
    } else if (pn < 15) {
      u16* MG = (u16*)(p->ws + OFF_MG);
      epi256(wv0, acc, brow, bcol, [&](int ai, int bj, int m, int n, int row, int col0, f32x4& v) {
        *(uint2*)(MG + (size_t)row * 2048 + (col0 - 1792)) = pk4(sigmoidf_(v[0]), sigmoidf_(v[1]), sigmoidf_(v[2]), sigmoidf_(v[3]));
      });
    } else {
      float* NG = (float*)(p->ws + OFF_NG);
      epi256(wv0, acc, brow, bcol, [&](int ai, int bj, int m, int n, int row, int col0, f32x4& v) {
        const int cc = col0 - 3840;
        if (cc < 24) *(float4*)(NG + (size_t)row * 24 + cc) = make_float4(sigmoidf_(v[0]), sigmoidf_(v[1]), sigmoidf_(v[2]), sigmoidf_(v[3]));
      });
    }
  }
}

template <bool OUT>
DI void s5_item(int wv0, PP p, int item, unsigned char* smem) {
  const int tid = my_tid(wv0), lane = tid & 63, fr = lane & 15, fq = lane >> 4;
  const int b = item >> 9, g = (item >> 4) & 31, c8 = item & 15, ch = c8 * 8 + wv0;
  u16* sBb = (u16*)smem;
  u16* sCm = sBb + 128 * 16;
  float* sBU = (float*)(smem + 8192) + wv0 * (16 * 132);
  u16* sH = (u16*)(smem + 8192 + 8 * 16 * 132 * 4) + wv0 * (16 * 136);
  *(uint4*)(smem + tid * 16) = *(const uint4*)(p->ws + OFF_S5T + (size_t)g * 8192 + tid * 16);
  const float2 lb = ((const float2*)(p->ws + OFF_S5L))[g * 64 + lane];
  const float lbr = lb.x, lbi = lb.y;
  float2* HL = (float2*)(p->ws + OFF_HLOC) + ((size_t)(b * 128 + ch) * 32 + g) * 64 + lane;
  float hr = 0.f, hi = 0.f;
  if (OUT) { const float2 h0 = *HL; hr = h0.x; hi = h0.y; }
  const u16* U = (const u16*)(p->ws + OFF_U) + ((size_t)(b * S_ + ch * 64)) * 512 + g * 16;
  u16* YS = (u16*)(p->ws + OFF_YS) + ((size_t)(b * S_ + ch * 64)) * 512 + g * 16;
  const float dk = p->dsk[g * 16 + fr];
  const bf16x8 zero8 = {0, 0, 0, 0, 0, 0, 0, 0};
  bf16x8 uall[4];
  u16 usk[4][4];
#pragma unroll
  for (int sub = 0; sub < 4; ++sub) {
    uall[sub] = fq < 2 ? *(const bf16x8*)(U + (size_t)(sub * 16 + fr) * 512 + 8 * fq) : zero8;
    if (OUT) {
#pragma unroll
      for (int j = 0; j < 4; ++j) usk[sub][j] = U[(size_t)(sub * 16 + 4 * fq + j) * 512 + fr];
    }
  }
  __syncthreads();
  bf16x8 bb[8], cf[4];
#pragma unroll
  for (int nt = 0; nt < 8; ++nt) bb[nt] = fq < 2 ? *(const bf16x8*)(sBb + (16 * nt + fr) * 16 + 8 * fq) : zero8;
  if (OUT) {
#pragma unroll
    for (int ks = 0; ks < 4; ++ks) cf[ks] = *(const bf16x8*)(sCm + fr * 128 + 32 * ks + 8 * fq);
  }
#pragma unroll
  for (int sub = 0; sub < 4; ++sub) {
    const bf16x8 ua = uall[sub];
#pragma unroll
    for (int nt = 0; nt < 8; ++nt) {
      const f32x4 a = mfma16(ua, bb[nt], f32x4{0.f, 0.f, 0.f, 0.f});
#pragma unroll
      for (int j = 0; j < 4; ++j) sBU[(4 * fq + j) * 132 + 16 * nt + fr] = a[j];
    }
    __syncthreads();
#pragma unroll 4
    for (int t = 0; t < 16; ++t) {
      const float bur = sBU[t * 132 + lane], bui = sBU[t * 132 + 64 + lane];
      const float nr = lbr * hr - lbi * hi + bur;
      const float nim = lbr * hi + lbi * hr + bui;
      hr = nr;
      hi = nim;
      if (OUT) {
        sH[t * 136 + lane] = f2bf(hr);
        sH[t * 136 + 64 + lane] = f2bf(hi);
      }
    }
    __syncthreads();
    if (OUT) {
      f32x4 y = {0.f, 0.f, 0.f, 0.f};
#pragma unroll
      for (int ks = 0; ks < 4; ++ks) y = mfma16(*(const bf16x8*)(sH + fr * 136 + 32 * ks + 8 * fq), cf[ks], y);
#pragma unroll
      for (int j = 0; j < 4; ++j) {
        const size_t o = (size_t)(sub * 16 + 4 * fq + j) * 512 + fr;
        YS[o] = f2bf(gelu_t(y[j] + dk * bf2f(usk[sub][j])));
      }
      __syncthreads();
    }
  }
  if (!OUT) *HL = make_float2(hr, hi);
  __syncthreads();
}
DI void s5_carry(int wv0, PP p) {
  const int x = blockIdx.x * NT_ + my_tid(wv0);
  if (x >= 8192) return;
  const int b = x >> 11, g = (x >> 6) & 31, n = x & 63;
  const float step = expf(p->log_step[g]);
  const float lr = p->lam_re[g * 64 + n], li = p->lam_im[g * 64 + n];
  const float er = expf(64.f * lr * step);
  float sn, cs;
  sincosf(64.f * li * step, &sn, &cs);
  const float Lr = er * cs, Li = er * sn;
  float2* HL = (float2*)(p->ws + OFF_HLOC) + (size_t)b * 128 * 2048 + g * 64 + n;
  float hr = 0.f, hi = 0.f;
  for (int c0 = 0; c0 < 128; c0 += 16) {
    float2 v[16];
#pragma unroll
    for (int k = 0; k < 16; ++k) v[k] = HL[(size_t)(c0 + k) * 2048];
#pragma unroll
    for (int k = 0; k < 16; ++k) {
      HL[(size_t)(c0 + k) * 2048] = make_float2(hr, hi);
      const float nr = Lr * hr - Li * hi + v[k].x;
      const float nim = Lr * hi + Li * hr + v[k].y;
      hr = nr;
      hi = nim;
    }
  }
}
DI void phaseC(int wv0, PP p, unsigned char* smem) {
  for (int id = blockIdx.x; id < 128 + 2048 + 256; id += gridDim.x) {
    if (id >= 128 + 2048) {
      const int it = id - (128 + 2048), tns = it >> 7, bg = (it >> 4) & 7, part = it & 15;
      const int tid = my_tid(wv0);
      const u16* K = (const u16*)(p->ws + (tns ? OFF_KW : OFF_KS)) + ((size_t)bg * S_ + part * 512 + tid) * 64;
      float q2 = 0.f;
#pragma unroll
      for (int c = 0; c < 8; ++c) {
        const uint4 w = *(const uint4*)(K + c * 8);
        const unsigned ww[4] = {w.x, w.y, w.z, w.w};
#pragma unroll
        for (int e = 0; e < 4; ++e) {
          const float a = __uint_as_float(ww[e] << 16), b2 = __uint_as_float(ww[e] & 0xffff0000u);
          q2 += a * a + b2 * b2;
        }
      }
#pragma unroll
      for (int o = 32; o > 0; o >>= 1) q2 = fmaxf(q2, __shfl_xor(q2, o));
      if ((tid & 63) == 0) atomicMax((unsigned*)(p->ws + OFF_KMAX) + tns * 8 + bg, __float_as_uint(q2));
    } else if (id < 128) {
      const int kv = id >> 6, pm = (id >> 2) & 15, ks = id & 3, brow = pm * 256;
      const u16* A = (const u16*)(p->ws + (kv ? OFF_VCIN : OFF_KCIN)) + (size_t)brow * 1024 + ks * 512;
      const u16* Bt = (const u16*)(p->ws + (kv ? OFF_W1VT : OFF_W1KT)) + ks * 512;
      f32x4 acc[2][2][4][2];
      gemm256(wv0, acc, A, 1024, Bt, 2048, 512, smem);
      float* PART = (float*)(p->ws + OFF_CPART) + (size_t)(ks * 2 + kv) * 4096 * 256;
      epi256(wv0, acc, brow, 0, [&](int ai, int bj, int m, int n, int row, int col0, f32x4& v) {
        *(float4*)(PART + (size_t)row * 256 + col0) = make_float4(v[0], v[1], v[2], v[3]);
      });
    } else {
      s5_item<false>(wv0, p, id - 128, smem);
    }
  }
}
DI void phaseD1(int wv0, PP p, unsigned char* smem) {
  const int tid = my_tid(wv0);
  float* sB = (float*)smem;
  {
    const float* cbp = (const float*)(p->ws + OFF_CBP);
    float bb = 0.f;
    for (int sl = 0; sl < 32; ++sl) bb += cbp[((tid >> 8) * 32 + sl) * 256 + (tid & 255)];
    sB[tid] = bb;
  }
  __syncthreads();
  const float* PART = (const float*)(p->ws + OFF_CPART);
  u16* HC = (u16*)(p->ws + OFF_HC);
  for (int e = blockIdx.x * NT_ + tid; e < 2 * 4096 * 64; e += gridDim.x * NT_) {
    const int kv = e >> 18, rc = e & 262143, c4 = (rc & 63) * 4;
    const size_t o = (size_t)kv * 4096 * 256 + (size_t)rc * 4;
    float4 a = *(const float4*)(PART + o);
#pragma unroll
    for (int ks = 1; ks < 4; ++ks) {
      const float4 t = *(const float4*)(PART + (size_t)ks * 2 * 4096 * 256 + o);
      a.x += t.x; a.y += t.y; a.z += t.z; a.w += t.w;
    }
    const float* bv = sB + kv * 256 + c4;
    *(uint2*)(HC + o) = pk4(gelu_t(a.x + bv[0]), gelu_t(a.y + bv[1]), gelu_t(a.z + bv[2]), gelu_t(a.w + bv[3]));
  }
}
DI void phaseD(int wv0, PP p, unsigned char* smem) {
  for (int id = blockIdx.x; id < 32; id += gridDim.x) {
    const int kv = id >> 4, pm = id & 15, brow = pm * 256;
    const u16* A = (const u16*)(p->ws + OFF_HC) + (size_t)kv * 4096 * 256 + (size_t)brow * 256;
    const u16* Bt = (const u16*)(p->ws + (kv ? OFF_W2VT : OFF_W2KT));
    f32x4 acc[2][2][4][2];
    gemm256(wv0, acc, A, 256, Bt, 256, 256, smem);
    u16* KCC = (u16*)(p->ws + OFF_KCC);
    u16* VCT = (u16*)(p->ws + OFF_VCT);
    epi256(wv0, acc, brow, 0, [&](int ai, int bj, int m, int n, int row, int col0, f32x4& v) {
      if (col0 < 64) {
        const int bg = row >> 9, nn = row & 511;
        f32x4 r = v;
        if (nn == 511) r = f32x4{0.f, 0.f, 0.f, 0.f};
        if (kv == 0) {
          *(uint2*)(KCC + ((size_t)bg * 512 + nn) * 64 + col0) = pk4(r[0], r[1], r[2], r[3]);
        } else {
#pragma unroll
          for (int j = 0; j < 4; ++j) VCT[((size_t)bg * 64 + col0 + j) * 512 + nn] = f2bf(r[j]);
        }
      }
    });
  }
  s5_carry(wv0, p);
}

DI bool bit128(u64 lo, u64 hi, int j) { return j < 64 ? ((lo >> j) & 1ull) : ((hi >> (j - 64)) & 1ull); }
DI int next_bit(u64 lo, u64 hi, int from) {
  if (from < 64) {
    const u64 x = (lo >> from) << from;
    if (x) return __ffsll((long long)x) - 1;
    from = 64;
  }
  if (from >= 128) return -1;
  const u64 y = (hi >> (from - 64)) << (from - 64);
  return y ? 63 + __ffsll((long long)y) : -1;
}

template <int MODE, bool MASKED, class MaskF>
DI void flash_tile(const u16* sK, const u16* sV, const bf16x8 (&qf)[2][2], f32x4 (&O)[2][4], float (&m)[2], float (&l)[2],
                   float (&ps)[4][4], MaskF ok, bool sel, int lane) {
  const int l15 = lane & 15, lg = lane >> 4;
  bf16x8 kf[4][2];
#pragma unroll
  for (int kt = 0; kt < 4; ++kt)
#pragma unroll
    for (int ks = 0; ks < 2; ++ks) kf[kt][ks] = *(const bf16x8*)(sK + (16 * kt + l15) * 72 + ks * 32 + lg * 8);
  if (MODE == 1) {
#pragma unroll
    for (int a = 0; a < 4; ++a)
#pragma unroll
      for (int b = 0; b < 4; ++b) ps[a][b] = 0.f;
  }
  union PFrag { unsigned u[4]; bf16x8 v; };
  PFrag pf[2][2];
#pragma unroll
  for (int qt = 0; qt < 2; ++qt) {
    f32x4 s[4];
    const float sinit = (MODE == 3) ? ((MASKED || sel) ? m[qt] : -1e30f) : 0.f;
#pragma unroll
    for (int kt = 0; kt < 4; ++kt) {
      s[kt] = f32x4{sinit, sinit, sinit, sinit};
#pragma unroll
      for (int ks = 0; ks < 2; ++ks) s[kt] = mfma16(kf[kt][ks], qf[qt][ks], s[kt]);
    }
    float pr[4][4];
    if (MODE == 3) {
      float rs = 0.f;
#pragma unroll
      for (int kt = 0; kt < 4; ++kt)
#pragma unroll
        for (int i = 0; i < 4; ++i) {
          float pv = __builtin_amdgcn_exp2f(s[kt][i]);
          if (MASKED) pv = ok(kt, i) ? pv : 0.f;
          pr[kt][i] = pv;
          rs += pv;
        }
      l[qt] += rs;
    } else {
    float mx = -1e30f;
#pragma unroll
    for (int kt = 0; kt < 4; ++kt)
#pragma unroll
      for (int i = 0; i < 4; ++i) {
        if (MASKED) s[kt][i] = ok(kt, i) ? s[kt][i] : -1e30f;
        mx = fmaxf(mx, s[kt][i]);
      }
    if (!MASKED) mx = sel ? mx : -1e30f;
    if (MODE == 1) {
      const float mm = m[qt], il = l[qt];
#pragma unroll
      for (int kt = 0; kt < 4; ++kt)
#pragma unroll
        for (int i = 0; i < 4; ++i) {
          const float pv = (s[kt][i] > -1e29f) ? __builtin_amdgcn_exp2f(s[kt][i] - mm) * il : 0.f;
          pr[kt][i] = pv;
          ps[kt][i] += pv;
        }
    } else {
      mx = fmaxf(mx, __shfl_xor(mx, 16));
      mx = fmaxf(mx, __shfl_xor(mx, 32));
      const float mnew = fmaxf(m[qt], mx);
      const float alpha = __builtin_amdgcn_exp2f(m[qt] - mnew);
      m[qt] = mnew;
      float rs = 0.f;
      if (MASKED) {
#pragma unroll
        for (int kt = 0; kt < 4; ++kt)
#pragma unroll
          for (int i = 0; i < 4; ++i) {
            const float pv = (s[kt][i] > -1e29f) ? __builtin_amdgcn_exp2f(s[kt][i] - mnew) : 0.f;
            pr[kt][i] = pv;
            rs += pv;
          }
      } else {
        const float me = sel ? mnew : 1e30f;
#pragma unroll
        for (int kt = 0; kt < 4; ++kt)
#pragma unroll
          for (int i = 0; i < 4; ++i) {
            const float pv = __builtin_amdgcn_exp2f(s[kt][i] - me);
            pr[kt][i] = pv;
            rs += pv;
          }
      }
      l[qt] = l[qt] * alpha + rs;
      if (MODE == 2) {
#pragma unroll
        for (int dt = 0; dt < 4; ++dt) O[qt][dt] *= alpha;
      }
    }
    }
    if (MODE != 0) {
#pragma unroll
      for (int ks2 = 0; ks2 < 2; ++ks2) {
        pf[qt][ks2].u[0] = pk2(pr[2 * ks2][0], pr[2 * ks2][1]);
        pf[qt][ks2].u[1] = pk2(pr[2 * ks2][2], pr[2 * ks2][3]);
        pf[qt][ks2].u[2] = pk2(pr[2 * ks2 + 1][0], pr[2 * ks2 + 1][1]);
        pf[qt][ks2].u[3] = pk2(pr[2 * ks2 + 1][2], pr[2 * ks2 + 1][3]);
      }
    }
  }
  if (MODE != 0) {
#pragma unroll
    for (int ks2 = 0; ks2 < 2; ++ks2) {
#pragma unroll
      for (int dt = 0; dt < 4; ++dt) {
        union { uint2 h[2]; bf16x8 v; } vf;
        vf.h[0] = *(const uint2*)(sV + (16 * dt + l15) * 72 + 32 * ks2 + 4 * lg);
        vf.h[1] = *(const uint2*)(sV + (16 * dt + l15) * 72 + 32 * ks2 + 16 + 4 * lg);
        O[0][dt] = mfma16(vf.v, pf[0][ks2].v, O[0][dt]);
        O[1][dt] = mfma16(vf.v, pf[1][ks2].v, O[1][dt]);
      }
    }
  }
}

DI void flash_s3(const u16* sK, const bf16x8 (&qf)[2][2], float si0, float si1, f32x4 (&s)[2][4], int lane) {
  const int l15 = lane & 15, lg = lane >> 4;
  bf16x8 kf[4][2];
#pragma unroll
  for (int kt = 0; kt < 4; ++kt)
#pragma unroll
    for (int ks = 0; ks < 2; ++ks) kf[kt][ks] = *(const bf16x8*)(sK + (16 * kt + l15) * 72 + ks * 32 + lg * 8);
#pragma unroll
  for (int qt = 0; qt < 2; ++qt) {
    const float si = qt ? si1 : si0;
#pragma unroll
    for (int kt = 0; kt < 4; ++kt) {
      s[qt][kt] = f32x4{si, si, si, si};
#pragma unroll
      for (int ks = 0; ks < 2; ++ks) s[qt][kt] = mfma16(kf[kt][ks], qf[qt][ks], s[qt][kt]);
    }
  }
}
template <bool MASKED, class MaskF>
DI void flash_pv3(const u16* sV, const f32x4 (&s)[2][4], f32x4 (&O)[2][4], float (&l)[2], MaskF ok, int lane) {
  const int l15 = lane & 15, lg = lane >> 4;
  union PFrag { unsigned u[4]; bf16x8 v; };
  PFrag pf[2][2];
#pragma unroll
  for (int qt = 0; qt < 2; ++qt) {
    float pr[4][4];
    float rs = 0.f;
#pragma unroll
    for (int kt = 0; kt < 4; ++kt)
#pragma unroll
      for (int i = 0; i < 4; ++i) {
        float pv = __builtin_amdgcn_exp2f(s[qt][kt][i]);
        if (MASKED) pv = ok(kt, i) ? pv : 0.f;
        pr[kt][i] = pv;
        rs += pv;
      }
    l[qt] += rs;
#pragma unroll
    for (int ks2 = 0; ks2 < 2; ++ks2) {
      pf[qt][ks2].u[0] = pk2(pr[2 * ks2][0], pr[2 * ks2][1]);
      pf[qt][ks2].u[1] = pk2(pr[2 * ks2][2], pr[2 * ks2][3]);
      pf[qt][ks2].u[2] = pk2(pr[2 * ks2 + 1][0], pr[2 * ks2 + 1][1]);
      pf[qt][ks2].u[3] = pk2(pr[2 * ks2 + 1][2], pr[2 * ks2 + 1][3]);
    }
  }
#pragma unroll
  for (int ks2 = 0; ks2 < 2; ++ks2) {
#pragma unroll
    for (int dt = 0; dt < 4; ++dt) {
      union { uint2 h[2]; bf16x8 v; } vf;
      vf.h[0] = *(const uint2*)(sV + (16 * dt + l15) * 72 + 32 * ks2 + 4 * lg);
      vf.h[1] = *(const uint2*)(sV + (16 * dt + l15) * 72 + 32 * ks2 + 16 + 4 * lg);
      O[0][dt] = mfma16(vf.v, pf[0][ks2].v, O[0][dt]);
      O[1][dt] = mfma16(vf.v, pf[1][ks2].v, O[1][dt]);
    }
  }
}

DI void nsa_item(int wv0, PP p, int item, unsigned char* smem) {
  const int tid = my_tid(wv0), lane = tid & 63, wv = wv0 & 3, hp = wv0 >> 2, l15 = lane & 15, lg = lane >> 4;
  const int i = 127 - (item >> 3), bg = item & 7, b = bg >> 1, g = bg & 1;
  u16* sK = (u16*)smem;
  u16* sV = sK + 64 * 72;
  float* sImp0 = (float*)(smem + 55296);
  float* sImp = sImp0 + hp * (64 * 132);
  u64* sUni = (u64*)(smem + 55296 + 2 * 64 * 132 * 4);
  u64* sSel = sUni + 16;
  const int t0 = i * 64, qloc = 16 * wv + l15, tq = t0 + qloc;
  const unsigned tokq = (unsigned)(b * S_ + tq);
  const float* NGb = (const float*)(p->ws + OFF_NG);
  const unsigned ngoff = tokq * 24 + g * 12 + hp * 6;
  float* ACCb = p->out;
  const unsigned aoff = tokq * 512 + g * 256 + hp * 128 + 4 * lg;
  const unsigned qoff = tokq * 512 + g * 256 + hp * 128 + lg * 8;
  const int lrow = tid >> 3, lpart = tid & 7;
  const unsigned koff = (lrow * 64 + lpart * 8) * 2, voffc = (lrow * 512 + lpart * 8) * 2, voffs = (lrow * S_ + lpart * 8) * 2;

  for (int e = tid; e < 2 * 64 * 132; e += NT_) sImp0[e] = 0.f;

  bf16x8 qf[2][2];
  f32x4 O[2][4];
  float m[2], l[2], ps[4][4];
  u32x4 pk0, pv0;
  auto nomask = [](int, int) { return true; };

#define MAKE_RSRC(PTR) __builtin_amdgcn_make_buffer_rsrc((void*)(PTR), 0, 0x7fffffff, 0x00020000)
#define BLOAD(R, VO, SO) __builtin_amdgcn_raw_buffer_load_b128((R), (int)(VO), (int)(SO), 0)
#define ISSUE_TILE(RK, RV, T, LDV)                                                   \
  {                                                                                  \
    pk0 = BLOAD(RK, koff, (T)*8192);                                                 \
    pv0 = BLOAD(RV, ((LDV) == 512) ? voffc : voffs, (T)*128);                        \
  }
#define COMMIT_TILE()                                                                \
  {                                                                                  \
    *(u32x4*)(sK + lrow * 72 + lpart * 8) = pk0;                                     \
    *(u32x4*)(sV + lrow * 72 + lpart * 8) = pv0;                                     \
  }
#define COMMIT_BUF(BUF)                                                              \
  {                                                                                  \
    *(u32x4*)(sK + (BUF)*9216 + lrow * 72 + lpart * 8) = pk0;                        \
    *(u32x4*)(sV + (BUF)*9216 + lrow * 72 + lpart * 8) = pv0;                        \
  }
#define LOAD_Q(BASE)                                                                 \
  {                                                                                  \
    const u16* Q_ = (const u16*)(p->ws + (BASE));                                    \
    _Pragma("unroll") for (int qt = 0; qt < 2; ++qt)                                 \
      _Pragma("unroll") for (int ks = 0; ks < 2; ++ks)                               \
        qf[qt][ks] = *(const bf16x8*)(Q_ + (qoff + qt * 64 + ks * 32));             \
  }
#define RESET_STATE()                                                                \
  {                                                                                  \
    _Pragma("unroll") for (int qt = 0; qt < 2; ++qt) { m[qt] = -1e30f; l[qt] = 0.f; } \
    _Pragma("unroll") for (int a = 0; a < 2; ++a)                                    \
      _Pragma("unroll") for (int c = 0; c < 4; ++c) O[a][c] = f32x4{0.f, 0.f, 0.f, 0.f}; \
  }

  {
    const u16* Kc0 = (const u16*)(p->ws + OFF_KCC) + (size_t)bg * 512 * 64;
    const u16* Vc0 = (const u16*)(p->ws + OFF_VCT) + (size_t)bg * 64 * 512;
    const int nE = (4 * i + 3) < 511 ? (4 * i + 3) : 511;
    const int nkb = (nE + 63) >> 6;
    const __amdgpu_buffer_rsrc_t rK = MAKE_RSRC(Kc0), rV = MAKE_RSRC(Vc0);
    LOAD_Q(OFF_QRAW)
    RESET_STATE()
    ISSUE_TILE(rK, rV, 0, 512)
    for (int kb = 0; kb < nkb; ++kb) {
      __syncthreads();
      COMMIT_TILE()
      __syncthreads();
      if (kb + 1 < nkb) ISSUE_TILE(rK, rV, kb + 1, 512)
      auto ok = [&](int kt, int ii) { return 16 * (kb * 64 + 16 * kt + 4 * lg + ii) + 31 <= tq; };
      flash_tile<0, true>(sK, sV, qf, O, m, l, ps, ok, true, lane);
    }
#pragma unroll
    for (int qt = 0; qt < 2; ++qt) {
      float s = l[qt];
      s += __shfl_xor(s, 16);
      s += __shfl_xor(s, 32);
      l[qt] = s > 0.f ? 1.f / s : 0.f;
    }
    ISSUE_TILE(rK, rV, 0, 512)
    for (int kb = 0; kb < nkb; ++kb) {
      __syncthreads();
      COMMIT_TILE()
      __syncthreads();
      if (kb + 1 < nkb) ISSUE_TILE(rK, rV, kb + 1, 512)
      auto ok = [&](int kt, int ii) { return 16 * (kb * 64 + 16 * kt + 4 * lg + ii) + 31 <= tq; };
      flash_tile<1, true>(sK, sV, qf, O, m, l, ps, ok, true, lane);
#pragma unroll
      for (int kt = 0; kt < 4; ++kt) {
        const int j = kb * 16 + kt * 4 + lg;
        sImp[qloc * 132 + j] += ps[kt][0] + ps[kt][1] + ps[kt][2] + ps[kt][3];
      }
      __syncthreads();
#pragma unroll
      for (int kt = 0; kt < 4; ++kt) {
        const int j1 = kb * 16 + kt * 4 + lg + 1;
        if (j1 < 128) sImp[qloc * 132 + j1] += ps[kt][3];
      }
    }
#pragma unroll
    for (int qt = 0; qt < 2; ++qt) {
      const float gt = NGb[ngoff + qt * 3 + 0];
#pragma unroll
      for (int dt = 0; dt < 4; ++dt) {
        float4 o = make_float4(O[qt][dt][0] * gt, O[qt][dt][1] * gt, O[qt][dt][2] * gt, O[qt][dt][3] * gt);
        *(float4*)(ACCb + (aoff + qt * 64 + 16 * dt)) = o;
      }
    }
  }
  __syncthreads();
  u64 mlo = 0, mhi = 0, wlo = 0, whi = 0;
  if (i < 16) {
    mlo = (1ull << (i + 1)) - 1ull;
    wlo = mlo;
  } else {
    const bool v0 = lane <= i, v1 = (lane + 64) <= i;
    const bool f0 = (lane == 0) || (lane == i) || (lane == i - 1);
    const bool f1 = (lane + 64 == i) || (lane + 64 == i - 1);
    const u64 ltm = (1ull << lane) - 1ull;
    for (int qq = hp * 8; qq < hp * 8 + 8; ++qq) {
      const float* ir = sImp0 + (16 * wv + qq) * 132;
      const float i0 = ir[lane] + ir[64 * 132 + lane], i1 = ir[lane + 64] + ir[64 * 132 + lane + 64];
      const unsigned k0 = v0 ? __float_as_uint(i0 + (f0 ? 1000.f : 0.f)) : 0u;
      const unsigned k1 = v1 ? __float_as_uint(i1 + (f1 ? 1000.f : 0.f)) : 0u;
      unsigned T = 0;
      for (int bit = 30; bit >= 0; --bit) {
        const unsigned cand = T | (1u << bit);
        const int cnt = __popcll(__ballot(k0 >= cand)) + __popcll(__ballot(k1 >= cand));
        if (cnt >= 16) T = cand;
      }
      const bool g0 = k0 > T, g1 = k1 > T, e0 = k0 == T, e1 = k1 == T;
      const int need = 16 - (__popcll(__ballot(g0)) + __popcll(__ballot(g1)));
      const u64 be0 = __ballot(e0), be1 = __ballot(e1);
      const int r0 = __popcll(be0 & ltm), r1 = __popcll(be0) + __popcll(be1 & ltm);
      const u64 s0 = __ballot(v0 && (g0 || (e0 && r0 < need)));
      const u64 s1 = __ballot(v1 && (g1 || (e1 && r1 < need)));
      wlo |= s0;
      whi |= s1;
      if (lane == 0) { sSel[(16 * wv + qq) * 2] = s0; sSel[(16 * wv + qq) * 2 + 1] = s1; }
    }
  }
  if (lane == 0) { sUni[wv0 * 2] = wlo; sUni[wv0 * 2 + 1] = whi; }
  __syncthreads();
  if (i >= 16) { mlo = sSel[qloc * 2]; mhi = sSel[qloc * 2 + 1]; }
  wlo = sUni[wv * 2] | sUni[(wv + 4) * 2];
  whi = sUni[wv * 2 + 1] | sUni[(wv + 4) * 2 + 1];
  const u64 blo = sUni[0] | sUni[2] | sUni[4] | sUni[6] | sUni[8] | sUni[10] | sUni[12] | sUni[14];
  const u64 bhi = sUni[1] | sUni[3] | sUni[5] | sUni[7] | sUni[9] | sUni[11] | sUni[13] | sUni[15];

  LOAD_Q(OFF_QROT)
  float nb_s[2], nb_w[2];
  bool usefix;
  {
    const float* KM = (const float*)(p->ws + OFF_KMAX);
    const float kms = KM[bg], kmw = KM[8 + bg];
    float bmax = 0.f;
#pragma unroll
    for (int qt = 0; qt < 2; ++qt) {
      float q2 = 0.f;
#pragma unroll
      for (int ks = 0; ks < 2; ++ks)
#pragma unroll
        for (int e = 0; e < 8; ++e) {
          const float qv = __uint_as_float(((unsigned)(u16)qf[qt][ks][e]) << 16);
          q2 += qv * qv;
        }
      q2 += __shfl_xor(q2, 16);
      q2 += __shfl_xor(q2, 32);
      const float bs = sqrtf(q2 * kms) * 1.001f + 1e-3f, bw = sqrtf(q2 * kmw) * 1.001f + 1e-3f;
      nb_s[qt] = -bs;
      nb_w[qt] = -bw;
      bmax = fmaxf(bmax, fmaxf(bs, bw));
    }
    usefix = __ballot(bmax > 60.f) == 0ull;
  }
  RESET_STATE()
  if (usefix) { m[0] = nb_s[0]; m[1] = nb_s[1]; }
  {
    const __amdgpu_buffer_rsrc_t rK = MAKE_RSRC((const u16*)(p->ws + OFF_KS) + (size_t)bg * S_ * 64);
    const __amdgpu_buffer_rsrc_t rV = MAKE_RSRC((const u16*)(p->ws + OFF_VST) + (size_t)bg * 64 * S_);
    if (usefix) {
      int jc = next_bit(blo, bhi, 0);
      int j1 = next_bit(blo, bhi, jc + 1);
      ISSUE_TILE(rK, rV, jc, S_)
      COMMIT_BUF(0)
      if (j1 >= 0) {
        ISSUE_TILE(rK, rV, j1, S_)
        COMMIT_BUF(1)
      }
      __syncthreads();
      int j2 = j1 >= 0 ? next_bit(blo, bhi, j1 + 1) : -1;
      if (j2 >= 0) ISSUE_TILE(rK, rV, j2, S_)
      f32x4 sc_[2][4], sn_[2][4];
      {
        const bool selc = bit128(mlo, mhi, jc);
        flash_s3(sK, qf, (selc || jc == i) ? m[0] : -1e30f, (selc || jc == i) ? m[1] : -1e30f, sc_, lane);
      }
      int bc = 0;
      while (jc >= 0) {
        const int bn = bc == 2 ? 0 : bc + 1, bn2 = bn == 2 ? 0 : bn + 1;
        const bool needn = j1 >= 0 && bit128(wlo, whi, j1);
        if (needn) {
          const bool seln = bit128(mlo, mhi, j1);
          const bool on = seln || j1 == i;
          flash_s3(sK + bn * 9216, qf, on ? m[0] : -1e30f, on ? m[1] : -1e30f, sn_, lane);
        }
        if (bit128(wlo, whi, jc)) {
          if (jc == i) {
            const bool sel = bit128(mlo, mhi, jc);
            auto ok = [&](int kt, int ii) { return sel && (16 * kt + 4 * lg + ii) <= qloc; };
            flash_pv3<true>(sV + bc * 9216, sc_, O, l, ok, lane);
          } else {
            flash_pv3<false>(sV + bc * 9216, sc_, O, l, nomask, lane);
          }
        }
        if (j2 >= 0) COMMIT_BUF(bn2)
        __syncthreads();
        jc = j1;
        j1 = j2;
        bc = bn;
        if (j1 >= 0) {
          j2 = next_bit(blo, bhi, j1 + 1);
          if (j2 >= 0) ISSUE_TILE(rK, rV, j2, S_)
        } else {
          j2 = -1;
        }
#pragma unroll
        for (int a = 0; a < 2; ++a)
#pragma unroll
          for (int c = 0; c < 4; ++c) sc_[a][c] = sn_[a][c];
      }
    } else {
      int j = next_bit(blo, bhi, 0);
      ISSUE_TILE(rK, rV, j, S_)
      COMMIT_BUF(0)
      __syncthreads();
      int jn = next_bit(blo, bhi, j + 1);
      if (jn >= 0) ISSUE_TILE(rK, rV, jn, S_)
      int cur = 0;
      while (j >= 0) {
        const u16* cK = sK + cur * 9216;
        const u16* cV = sV + cur * 9216;
        if (bit128(wlo, whi, j)) {
          const bool sel = bit128(mlo, mhi, j);
          if (j == i) {
            auto ok = [&](int kt, int ii) { return sel && (16 * kt + 4 * lg + ii) <= qloc; };
            if (usefix) flash_tile<3, true>(cK, cV, qf, O, m, l, ps, ok, true, lane);
            else flash_tile<2, true>(cK, cV, qf, O, m, l, ps, ok, true, lane);
          } else {
            if (usefix) flash_tile<3, false>(cK, cV, qf, O, m, l, ps, nomask, sel, lane);
            else flash_tile<2, false>(cK, cV, qf, O, m, l, ps, nomask, sel, lane);
          }
        }
        cur ^= 1;
        if (jn >= 0) COMMIT_BUF(cur)
        __syncthreads();
        j = jn;
        if (j >= 0) {
          jn = next_bit(blo, bhi, j + 1);
          if (jn >= 0) ISSUE_TILE(rK, rV, jn, S_)
        }
      }
    }
  }
#pragma unroll
  for (int qt = 0; qt < 2; ++qt) {
    float s = l[qt];
    s += __shfl_xor(s, 16);
    s += __shfl_xor(s, 32);
    const float sc = NGb[ngoff + qt * 3 + 1] / s;
#pragma unroll
    for (int dt = 0; dt < 4; ++dt) {
      float4* a = (float4*)(ACCb + (aoff + qt * 64 + 16 * dt));
      float4 o = *a;
      o.x += O[qt][dt][0] * sc; o.y += O[qt][dt][1] * sc; o.z += O[qt][dt][2] * sc; o.w += O[qt][dt][3] * sc;
      *a = o;
    }
  }
  RESET_STATE()
  if (usefix) { m[0] = nb_w[0]; m[1] = nb_w[1]; }
  {
    const __amdgpu_buffer_rsrc_t rK = MAKE_RSRC((const u16*)(p->ws + OFF_KW) + (size_t)bg * S_ * 64);
    const __amdgpu_buffer_rsrc_t rV = MAKE_RSRC((const u16*)(p->ws + OFF_VWT) + (size_t)bg * 64 * S_);
    const int j0 = i >= 8 ? i - 8 : 0;
    ISSUE_TILE(rK, rV, j0, S_)
    COMMIT_BUF(0)
    __syncthreads();
    if (j0 + 1 <= i) ISSUE_TILE(rK, rV, j0 + 1, S_)
    int cur = 0;
    for (int j = j0; j <= i; ++j) {
      const u16* cK = sK + cur * 9216;
      const u16* cV = sV + cur * 9216;
      if (j == i || j == i - 8) {
        auto ok = [&](int kt, int ii) {
          const int kp = j * 64 + 16 * kt + 4 * lg + ii;
          return kp <= tq && kp > tq - 512;
        };
        if (usefix) flash_tile<3, true>(cK, cV, qf, O, m, l, ps, ok, true, lane);
        else flash_tile<2, true>(cK, cV, qf, O, m, l, ps, ok, true, lane);
      } else {
        if (usefix) flash_tile<3, false>(cK, cV, qf, O, m, l, ps, nomask, true, lane);
        else flash_tile<2, false>(cK, cV, qf, O, m, l, ps, nomask, true, lane);
      }
      cur ^= 1;
      if (j + 1 <= i) COMMIT_BUF(cur)
      __syncthreads();
      if (j + 2 <= i) ISSUE_TILE(rK, rV, j + 2, S_)
    }
  }
  u16* NSAb = (u16*)(p->ws + OFF_NSA);
#pragma unroll
  for (int qt = 0; qt < 2; ++qt) {
    float s = l[qt];
    s += __shfl_xor(s, 16);
    s += __shfl_xor(s, 32);
    const float sc = NGb[ngoff + qt * 3 + 2] / s;
#pragma unroll
    for (int dt = 0; dt < 4; ++dt) {
      const float4 a = *(const float4*)(ACCb + (aoff + qt * 64 + 16 * dt));
      uint2 o;
      o.x = pk2(a.x + O[qt][dt][0] * sc, a.y + O[qt][dt][1] * sc);
      o.y = pk2(a.z + O[qt][dt][2] * sc, a.w + O[qt][dt][3] * sc);
      *(uint2*)(NSAb + (aoff + qt * 64 + 16 * dt)) = o;
    }
  }
  __syncthreads();
}

DI void phaseE(int wv0, PP p, unsigned char* smem, int cidx) {
  __shared__ int s_item;
  int* ctr = (int*)(p->ws + OFF_CTR) + cidx;
  for (;;) {
    __syncthreads();
    if (my_tid(wv0) == 0) s_item = atomicAdd(ctr, 1);
    __syncthreads();
    const int item = s_item;
    if (item >= 1024 + 2048 + (NXT - NXT_A)) break;
    if (item < 1024) nsa_item(wv0, p, item, smem);
    else if (item < 1024 + 2048) s5_item<true>(wv0, p, item - 1024, smem);
    else xpose_tile(wv0, p, NXT_A + (item - 3072), smem);
  }
}

DI void phaseF(int wv0, PP p, unsigned char* smem) {
  const u16* YS = (const u16*)(p->ws + OFF_YS);
  const u16* NSA = (const u16*)(p->ws + OFF_NSA);
  const u16* MG = (const u16*)(p->ws + OFF_MG);
  u16* MR = (u16*)(p->ws + OFF_MERGED);
  for (int id = blockIdx.x; id < 128 * 4; id += gridDim.x) {
    int pm, pn;
    tile_map_n4(id, pm, pn);
    const int brow = pm * 256, bcol = pn * 256;
    f32x4 acc[2][2][4][2];
#pragma unroll 1
    for (int h = 0; h < 2; ++h) {
      const int grp = pn * 2 + h;
      gemm256(wv0, acc, YS + (size_t)brow * 512, 512, (const u16*)(p->ws + OFF_WVT) + (size_t)grp * 256 * 512, 512, 512, smem);
#pragma unroll
      for (int ai = 0; ai < 2; ++ai)
#pragma unroll
        for (int m = 0; m < 4; ++m)
#pragma unroll
          for (int n = 0; n < 2; ++n)
#pragma unroll
            for (int j = 0; j < 4; ++j) acc[ai][0][m][n][j] *= sigmoidf_(acc[ai][1][m][n][j]);
      __builtin_amdgcn_sched_barrier(0);
      epi256(wv0, acc, brow, grp * 128, [&](int ai, int bj, int m, int n, int row, int col0, f32x4& v) {
        if (bj == 0) {
          const unsigned og = (unsigned)row * 2048u + 1024u + (unsigned)col0, om = (unsigned)row * 1024u + (unsigned)col0;
          const uint2 gq = *(const uint2*)(MG + og);
          *(uint2*)(MR + om) = pk4(__uint_as_float(gq.x << 16) * v[0], __uint_as_float(gq.x & 0xffff0000u) * v[1],
                                   __uint_as_float(gq.y << 16) * v[2], __uint_as_float(gq.y & 0xffff0000u) * v[3]);
        }
      });
    }
    gemm256(wv0, acc, NSA + (size_t)brow * 512, 512, (const u16*)(p->ws + OFF_WAT) + (size_t)bcol * 512, 512, 512, smem);
    epi256(wv0, acc, brow, bcol, [&](int ai, int bj, int m, int n, int row, int col0, f32x4& v) {
      const unsigned og = (unsigned)row * 2048u + (unsigned)col0, om = (unsigned)row * 1024u + (unsigned)col0;
      const uint2 t = *(const uint2*)(MR + om);
      const uint2 gq = *(const uint2*)(MG + og);
      *(uint2*)(MR + om) =
          pk4(__uint_as_float(gq.x << 16) * v[0] + __uint_as_float(t.x << 16), __uint_as_float(gq.x & 0xffff0000u) * v[1] + __uint_as_float(t.x & 0xffff0000u),
              __uint_as_float(gq.y << 16) * v[2] + __uint_as_float(t.y << 16), __uint_as_float(gq.y & 0xffff0000u) * v[3] + __uint_as_float(t.y & 0xffff0000u));
    });
  }
}
DI void ss_partial(int wv0, f32x4 (&acc)[2][2][4][2], float* SS, int brow, int pn) {
  const int lane = my_tid(wv0) & 63, wr = wv0 >> 2, wc = wv0 & 3;
#pragma unroll
  for (int ai = 0; ai < 2; ++ai)
#pragma unroll
    for (int m = 0; m < 4; ++m) {
      float s = 0.f;
#pragma unroll
      for (int bj = 0; bj < 2; ++bj)
#pragma unroll
        for (int n = 0; n < 2; ++n)
#pragma unroll
          for (int j = 0; j < 4; ++j) s += acc[ai][bj][m][n][j] * acc[ai][bj][m][n][j];
      s += __shfl_xor(s, 16);
      s += __shfl_xor(s, 32);
      if (lane < 16) SS[(size_t)(brow + ai * 128 + wr * 64 + m * 16 + lane) * 16 + pn * 4 + wc] = s;
    }
}
DI void phaseG(int wv0, PP p, unsigned char* smem) {
  const u16* MR = (const u16*)(p->ws + OFF_MERGED);
  u16* X1B = (u16*)(p->ws + OFF_X1B);
  float* SS1 = (float*)(p->ws + OFF_SS1);
  for (int id = blockIdx.x; id < 128 * 4; id += gridDim.x) {
    int pm, pn;
    tile_map_n4(id, pm, pn);
    pm = 127 - pm;
    const int brow = pm * 256, bcol = pn * 256;
    f32x4 acc[2][2][4][2];
    gemm256(wv0, acc, MR + (size_t)brow * 1024, 1024, (const u16*)(p->ws + OFF_WOT) + (size_t)bcol * 1024, 1024, 1024, smem);
    epi256(wv0, acc, brow, bcol, [&](int ai, int bj, int m, int n, int row, int col0, f32x4& v) {
      const size_t o = (size_t)row * 1024 + col0;
      const float4 xv = *(const float4*)(p->x + o);
      v[0] += xv.x; v[1] += xv.y; v[2] += xv.z; v[3] += xv.w;
      *(uint2*)(X1B + o) = pk4(v[0], v[1], v[2], v[3]);
    });
    ss_partial(wv0, acc, SS1, brow, pn);
  }
}
DI void phaseH(int wv0, PP p, unsigned char* smem) {
  const u16* X1B = (const u16*)(p->ws + OFF_X1B);
  const float* SS1 = (const float*)(p->ws + OFF_SS1);
  u16* ACT = (u16*)(p->ws + OFF_ACT);
  float* sR = (float*)(smem + 131072);
  for (int id = blockIdx.x; id < 128 * 16; id += gridDim.x) {
    int pm, pn;
    tile_map_n16(id, pm, pn);
    const int brow = pm * 256, bcol = pn * 256;
    const int tid = my_tid(wv0);
    if (tid < 256) {
      const float4* s = (const float4*)(SS1 + (size_t)(brow + tid) * 16);
      const float4 a = s[0], b = s[1], c = s[2], d = s[3];
      const float t = a.x + a.y + a.z + a.w + b.x + b.y + b.z + b.w + c.x + c.y + c.z + c.w + d.x + d.y + d.z + d.w;
      sR[tid] = rsqrtf(t * (1.f / 1024.f) + 1e-6f);
    }
    f32x4 acc[2][2][4][2];
    gemm256(wv0, acc, X1B + (size_t)brow * 1024, 1024, (const u16*)(p->ws + OFF_WUPT) + (size_t)bcol * 1024, 1024, 1024, smem);
    epi256(wv0, acc, brow, bcol, [&](int ai, int bj, int m, int n, int row, int col0, f32x4& v) {
      const float ri = sR[row - brow];
      const float a0 = fmaxf(v[0] * ri, 0.f), a1 = fmaxf(v[1] * ri, 0.f), a2 = fmaxf(v[2] * ri, 0.f), a3 = fmaxf(v[3] * ri, 0.f);
      *(uint2*)(ACT + (size_t)row * 4096 + col0) = pk4(a0 * a0, a1 * a1, a2 * a2, a3 * a3);
    });
    __syncthreads();
  }
}
DI void phaseI(int wv0, PP p, unsigned char* smem) {
  const u16* ACT = (const u16*)(p->ws + OFF_ACT);
  const u16* X1B = (const u16*)(p->ws + OFF_X1B);
  float* SS2 = (float*)(p->ws + OFF_SS2);
  for (int id = blockIdx.x; id < 128 * 4; id += gridDim.x) {
    int pm, pn;
    tile_map_n4(id, pm, pn);
    pm = 127 - pm;
    const int brow = pm * 256, bcol = pn * 256;
    f32x4 acc[2][2][4][2];
    gemm256(wv0, acc, ACT + (size_t)brow * 4096, 4096, (const u16*)(p->ws + OFF_WDT) + (size_t)bcol * 4096, 4096, 4096, smem);
    epi256(wv0, acc, brow, bcol, [&](int ai, int bj, int m, int n, int row, int col0, f32x4& v) {
      const size_t o = (size_t)row * 1024 + col0;
      const uint2 xb = *(const uint2*)(X1B + o);
      v[0] += __uint_as_float(xb.x << 16); v[1] += __uint_as_float(xb.x & 0xffff0000u);
      v[2] += __uint_as_float(xb.y << 16); v[3] += __uint_as_float(xb.y & 0xffff0000u);
      *(float4*)(p->out + o) = make_float4(v[0], v[1], v[2], v[3]);
    });
    ss_partial(wv0, acc, SS2, brow, pn);
  }
}
DI void phaseJ(int wv0, PP p) {
  const int lane = my_tid(wv0) & 63;
  const float* SS2 = (const float*)(p->ws + OFF_SS2);
  for (int row = blockIdx.x * 8 + wv0; row < T_; row += gridDim.x * 8) {
    float t = (lane < 16) ? SS2[(size_t)row * 16 + lane] : 0.f;
    t = wave_sum(t);
    const float rinv = rsqrtf(t * (1.f / 1024.f) + 1e-6f);
    float4* xr = (float4*)(p->out + (size_t)row * 1024);
#pragma unroll
    for (int r = 0; r < 4; ++r) {
      float4 v = xr[lane + 64 * r];
      const float4 g = ((const float4*)p->g3)[lane + 64 * r];
      v.x *= rinv * g.x; v.y *= rinv * g.y; v.z *= rinv * g.z; v.w *= rinv * g.w;
      xr[lane + 64 * r] = v;
    }
  }
}


#define XB_TMO      128
#define XB_XCNT(j)  (256  + 64 * (j))
#define XB_XSUB(j)  (1280 + 64 * (j))
#define XB_XGEN(j)  (2304 + 64 * (j))
#define XB_TOP      3328
#define XB_TOPGEN   3392
#define XB_SPIN_CAP (1u << 18)
#define LAS __attribute__((address_space(3)))
DI unsigned xb_ld(unsigned* p) { return __hip_atomic_load(p, __ATOMIC_RELAXED, __HIP_MEMORY_SCOPE_AGENT); }
DI unsigned xb_add(unsigned* p, unsigned v) { return __hip_atomic_fetch_add(p, v, __ATOMIC_RELAXED, __HIP_MEMORY_SCOPE_AGENT); }
DI unsigned xb_xcc_id() { return (unsigned)__builtin_amdgcn_s_getreg((3 << 11) | 20) & 0xFu; }
#define XB_SPIN(cond, bar) do { unsigned _sp = 0; while (cond) { __builtin_amdgcn_s_sleep(1); \
    if ((++_sp & 255u) == 0u) { if (xb_ld(&(bar)[XB_TMO])) break; if (_sp > XB_SPIN_CAP) { atomicAdd(&(bar)[XB_TMO], 1u); break; } } } } while (0)
DI void xcd_barrier_complete(unsigned* bar, unsigned x, unsigned& nloc, unsigned& nx) {
  const unsigned G = gridDim.x * gridDim.y * gridDim.z;
  unsigned sum, cnt, mine, sp = 0u;
  for (;;) {
    sum = 0u; cnt = 0u; mine = 0u;
#pragma unroll
    for (unsigned j = 0; j < 16; ++j) { const unsigned c = xb_ld(&bar[XB_XCNT(j)]); sum += c; cnt += (c > 0u) ? 1u : 0u; mine = (j == x) ? c : mine; }
    if (sum == G) break;
    __builtin_amdgcn_s_sleep(1);
    if ((++sp & 255u) == 0u) { if (xb_ld(&bar[XB_TMO])) break; if (sp > XB_SPIN_CAP) { atomicAdd(&bar[XB_TMO], 1u); break; } }
  }
  nloc = mine > 0u ? mine : 1u; nx = cnt > 0u ? cnt : 1u;
}
DI void xcd_barrier(unsigned* bar, volatile LAS unsigned* st, bool leader) {
  asm volatile("s_waitcnt vmcnt(0)" ::: "memory");
  __syncthreads();
  if (leader) {
    const unsigned x = xb_xcc_id();
    __builtin_amdgcn_s_waitcnt(0);
    unsigned nloc = st[0], nx = st[1];
    if (nloc == 0u) { xcd_barrier_complete(bar, x, nloc, nx); st[0] = nloc; st[1] = nx; }
    const unsigned old = xb_add(&bar[XB_XSUB(x)], 1u);
    const unsigned gen = old / nloc;
    if (old + 1u == (gen + 1u) * nloc) {
      __builtin_amdgcn_fence(__ATOMIC_RELEASE, "agent");
      asm volatile("s_waitcnt vmcnt(0)" ::: "memory");
      const unsigned og = xb_add(&bar[XB_TOP], 1u);
      const unsigned tg = og / nx;
      if (og + 1u == (tg + 1u) * nx) xb_add(&bar[XB_TOPGEN], 1u);
      else XB_SPIN(xb_ld(&bar[XB_TOPGEN]) == tg, bar);
      __builtin_amdgcn_fence(__ATOMIC_ACQUIRE, "agent");
      xb_add(&bar[XB_XGEN(x)], 1u);
      asm volatile("s_waitcnt vmcnt(0)" ::: "memory");
    } else {
      XB_SPIN(xb_ld(&bar[XB_XGEN(x)]) == gen, bar);
      __builtin_amdgcn_fence(__ATOMIC_ACQUIRE, "agent");
      asm volatile("s_waitcnt vmcnt(0)" ::: "memory");
    }
  }
  __syncthreads();
}

__global__ void __launch_bounds__(512, 2) mega(Params p) {
  extern __shared__ __attribute__((aligned(16))) unsigned char smem[];
  const int wv0 = __builtin_amdgcn_readfirstlane((int)(threadIdx.x >> 6));
  const int lo = p.lo, hi = p.hi;
  PP kp0 = (PP)__builtin_amdgcn_kernarg_segment_ptr();
  __shared__ uint4 xb_words;
  if (threadIdx.x == 0) {
    xb_words = make_uint4(0u, 0u, 0u, 0u);
    (void)xb_add((unsigned*)(kp0->ws + OFF_BAR) + XB_XCNT(xb_xcc_id()), 1u);
  }
  __syncthreads();
#define PH(N, CALL)                                  \
  if (lo <= N && N < hi) {                           \
    PP kp = kp0;                                     \
    asm volatile("" : "+s"(kp));                     \
    if (N > lo) {                                    \
      if (N == 1) cg::this_grid().sync();            \
      else xcd_barrier((unsigned*)(kp->ws + OFF_BAR), (volatile LAS unsigned*)&xb_words, my_tid(wv0) == 0); \
    }                                                \
    CALL;                                            \
    if ((PROBE_MASK >> N) & 1) { CALL; }             \
  }
  PH(0, phaseA(wv0, kp, smem))
  PH(1, phaseB(wv0, kp, smem))
  PH(2, phaseC(wv0, kp, smem))
  PH(3, phaseD1(wv0, kp, smem))
  PH(4, phaseD(wv0, kp, smem))
  PH(5, phaseE(wv0, kp, smem, 0))
  PH(6, phaseF(wv0, kp, smem))
  PH(7, phaseG(wv0, kp, smem))
  PH(8, phaseH(wv0, kp, smem))
  PH(9, phaseI(wv0, kp, smem))
  PH(10, phaseJ(wv0, kp))
}

extern "C" void kernel_launch(void* const* d_in, const int* in_sizes, int n_in, void* d_out, int out_size, void* d_ws,
                              size_t ws_size, hipStream_t stream) {
  static int grid_blocks = 0;
  if (!grid_blocks) {
    int dev = 0, cus = 0, per_cu = 0;
    (void)hipGetDevice(&dev);
    (void)hipDeviceGetAttribute(&cus, hipDeviceAttributeMultiprocessorCount, dev);
    (void)hipFuncSetAttribute((const void*)mega, hipFuncAttributeMaxDynamicSharedMemorySize, SMEM_BYTES);
    (void)hipOccupancyMaxActiveBlocksPerMultiprocessor(&per_cu, mega, NT_, SMEM_BYTES);
    if (per_cu > 1) per_cu = 1;
    if (per_cu < 1) per_cu = 1;
    grid_blocks = cus * per_cu;
  }
  if (ws_size < WS_NEED) { fprintf(stderr, "workspace too small: %zu < %zu\n", ws_size, (size_t)WS_NEED); }
  Params p{};
  const float** f = (const float**)&p;
  for (int i = 0; i < 24; ++i) f[i] = (const float*)d_in[i];
  p.out = (float*)d_out;
  p.ws = (unsigned char*)d_ws;
  p.lo = 0; p.hi = 11;
  (void)hipMemsetAsync((unsigned char*)d_ws + OFF_BAR, 0, 16384, stream);
  void* args[] = {&p};
  hipError_t e = hipLaunchCooperativeKernel((void*)mega, dim3(grid_blocks), dim3(NT_), args, SMEM_BYTES, stream);
  if (e != hipSuccess) fprintf(stderr, "cooperative launch failed: %s (grid %d)\n", hipGetErrorString(e), grid_blocks);
}
```

```cpp
#include <hip/hip_runtime.h>
#include <hip/hip_cooperative_groups.h>
#include <cstdio>
namespace cg = cooperative_groups;

#ifndef PROBE_MASK
#define PROBE_MASK 0
#endif

#define DI __device__ __forceinline__
typedef unsigned short u16;
typedef unsigned long long u64;
using bf16x8 = __attribute__((ext_vector_type(8))) short;
using f32x4 = __attribute__((ext_vector_type(4))) float;
using u32x4 = __attribute__((ext_vector_type(4))) unsigned;

constexpr int B_ = 4, S_ = 8192, T_ = B_ * S_;
constexpr int NT_ = 512;
constexpr int NINP = 4096;
constexpr float QSCALE = 0.125f * 1.44269504089f;

constexpr size_t MB = 1024 * 1024;
constexpr size_t OFF_WINT = 0;
constexpr size_t OFF_W1KT = OFF_WINT + (size_t)NINP * 1024 * 2;
constexpr size_t OFF_W1VT = OFF_W1KT + 256 * 2048 * 2;
constexpr size_t OFF_W2KT = OFF_W1VT + 256 * 2048 * 2;
constexpr size_t OFF_W2VT = OFF_W2KT + 256 * 256 * 2;
constexpr size_t OFF_WAT = OFF_W2VT + 256 * 256 * 2;
constexpr size_t OFF_WVT = OFF_WAT + 1024 * 512 * 2;
constexpr size_t OFF_WGT = OFF_WVT + 1024 * 512 * 2;
constexpr size_t OFF_WOT = OFF_WGT + 1024 * 512 * 2;
constexpr size_t OFF_WUPT = OFF_WOT + 1024 * 1024 * 2;
constexpr size_t OFF_WDT = OFF_WUPT + 4096 * 1024 * 2;
constexpr size_t OFF_ROPE = OFF_WDT + 4096 * 1024 * 2;
constexpr size_t OFF_CBP = OFF_ROPE + 8192 * 16 * 4;
constexpr size_t OFF_CTR = OFF_CBP + 2 * 32 * 256 * 4;
constexpr size_t OFF_KMAX = OFF_CTR + 64;
constexpr size_t OFF_BAR = OFF_CTR + 256;
constexpr size_t OFF_SS1 = OFF_BAR + 16384;
constexpr size_t OFF_SS2 = OFF_SS1 + (size_t)T_ * 16 * 4;
constexpr size_t OFF_NG = OFF_SS2 + (size_t)T_ * 16 * 4;
constexpr size_t OFF_HC = OFF_NG + (size_t)T_ * 24 * 4;
constexpr size_t OFF_KCC = OFF_HC + 2 * 4096 * 256 * 2;
constexpr size_t OFF_VCT = OFF_KCC + 8 * 512 * 64 * 2;
constexpr size_t OFF_HLOC = OFF_VCT + 8 * 512 * 64 * 2;
constexpr size_t OFF_ARENA = OFF_HLOC + (size_t)4 * 128 * 32 * 64 * 8;
constexpr size_t OFF_MG = OFF_ARENA;
constexpr size_t OFF_HN = OFF_ARENA + 128 * MB;
constexpr size_t OFF_QRAW = OFF_ARENA + 192 * MB;
constexpr size_t OFF_QROT = OFF_ARENA + 224 * MB;
constexpr size_t OFF_KCIN = OFF_ARENA + 256 * MB;
constexpr size_t OFF_VCIN = OFF_KCIN + 8 * MB;
constexpr size_t OFF_KS = OFF_VCIN + 8 * MB;
constexpr size_t OFF_VST = OFF_KS + 8 * MB;
constexpr size_t OFF_KW = OFF_VST + 8 * MB;
constexpr size_t OFF_VWT = OFF_KW + 8 * MB;
constexpr size_t OFF_U = OFF_ARENA + 304 * MB;
constexpr size_t OFF_NSA = OFF_ARENA + 336 * MB;
constexpr size_t OFF_YS = OFF_ARENA + 368 * MB;
constexpr size_t OFF_CPART = OFF_ARENA + 400 * MB;
constexpr size_t OFF_S5T = OFF_CPART + 32 * MB;
constexpr size_t OFF_S5L = OFF_S5T + 32 * 8192;
constexpr size_t WS_NEED = OFF_S5L + 32 * 64 * 8;
constexpr size_t OFF_ACT = OFF_ARENA;
constexpr size_t OFF_X1B = OFF_ARENA + 256 * MB;
constexpr size_t OFF_MERGED = OFF_HN;

constexpr int SMEM_BYTES = 131072 + 1024;

struct Params {
  const float *x, *g1, *w_in, *pe, *kw1, *kw2, *vw1, *vw2, *lam_re, *lam_im, *log_step, *b_re, *b_im, *c_re, *c_im, *dsk,
      *w_attn, *w_val, *w_gate, *w_out, *g2, *w_up, *w_down, *g3;
  float* out;
  unsigned char* ws;
  int lo, hi;
};

typedef const __attribute__((address_space(4))) Params* PP;

DI int my_tid(int wv0) {
  int t = wv0 * 64 + (int)__lane_id();
  asm volatile("" : "+v"(t));
  return t;
}
DI unsigned pk2(float a, float b);
DI u16 f2bf(float x) { return (u16)(pk2(x, 0.f) & 0xffffu); }
DI float bf2f(u16 h) { return __uint_as_float(((unsigned)h) << 16); }
typedef float f32x2_t __attribute__((ext_vector_type(2)));
typedef __bf16 bf16x2_t __attribute__((ext_vector_type(2)));
DI unsigned pk2(float a, float b) {
  const f32x2_t v = {a, b};
  return __builtin_bit_cast(unsigned, __builtin_convertvector(v, bf16x2_t));
}
DI uint2 pk4(float a, float b, float c, float d) { uint2 o; o.x = pk2(a, b); o.y = pk2(c, d); return o; }
DI float sigmoidf_(float x) { return 1.f / (1.f + __expf(-x)); }
DI float gelu_t(float x) {
  float u = 0.7978845608f * (x + 0.044715f * x * x * x);
  float e = __expf(2.f * u);
  float th = 1.f - 2.f / (e + 1.f);
  return 0.5f * x * (1.f + th);
}
DI float wave_sum(float v) {
#pragma unroll
  for (int o = 32; o > 0; o >>= 1) v += __shfl_xor(v, o);
  return v;
}
DI f32x4 mfma16(bf16x8 a, bf16x8 b, f32x4 c) { return __builtin_amdgcn_mfma_f32_16x16x32_bf16(a, b, c, 0, 0, 0); }

constexpr int G_HT = 128 * 64;
DI int lds_byte(int r, int c) {
  const int st = (r >> 4) * 2 + (c >> 5), rr = r & 15, cc = c & 31, ob = rr * 64 + cc * 2;
  return st * 1024 + (ob ^ (((ob >> 9) & 1) << 5));
}
DI void stage_rc(int b, int& R, int& C) {
  const int st = b / 1024, sb = b % 1024, swz = sb ^ (((sb >> 9) & 1) << 5);
  R = (st >> 1) * 16 + swz / 64;
  C = (st & 1) * 32 + (swz % 64) / 2;
}
typedef __attribute__((address_space(3))) unsigned* lds_u32p;
DI void gemm256(int wv0, f32x4 (&acc)[2][2][4][2], const u16* __restrict__ A, int lda, const u16* __restrict__ Bt, int ldb,
                int K, unsigned char* smem) {
  u16* shm = (u16*)smem;
  const int tid = my_tid(wv0), lane = tid & 63;
  const int wr = wv0 >> 2, wc = wv0 & 3, fr = lane & 15, fq = lane >> 4;
#define SA(b, h) (shm + ((b)*2 + (h)) * G_HT)
#define SB(b, h) (shm + (4 + (b)*2 + (h)) * G_HT)
  int sr0, sc0, sr1, sc1;
  stage_rc(tid * 16, sr0, sc0);
  stage_rc(tid * 16 + 8192, sr1, sc1);
  const u16* a0 = A + (size_t)sr0 * lda + sc0;
  const u16* a1 = A + (size_t)sr1 * lda + sc1;
  const u16* b0 = Bt + (size_t)sr0 * ldb + sc0;
  const u16* b1 = Bt + (size_t)sr1 * ldb + sc1;
#define STAGE_A(P, half, kt)                                                                                              \
  {                                                                                                                       \
    __builtin_amdgcn_global_load_lds((const unsigned*)(a0 + (size_t)((half)*128) * lda + (kt)*64),                        \
                                     (unsigned*)((char*)(P) + tid * 16), 16, 0, 0);                               \
    __builtin_amdgcn_global_load_lds((const unsigned*)(a1 + (size_t)((half)*128) * lda + (kt)*64),                        \
                                     (unsigned*)((char*)(P) + tid * 16 + 8192), 16, 0, 0);                        \
  }
#define STAGE_B(P, half, kt)                                                                                              \
  {                                                                                                                       \
    __builtin_amdgcn_global_load_lds((const unsigned*)(b0 + (size_t)((half)*128) * ldb + (kt)*64),                        \
                                     (unsigned*)((char*)(P) + tid * 16), 16, 0, 0);                               \
    __builtin_amdgcn_global_load_lds((const unsigned*)(b1 + (size_t)((half)*128) * ldb + (kt)*64),                        \
                                     (unsigned*)((char*)(P) + tid * 16 + 8192), 16, 0, 0);                        \
  }
#define LDA(dst, b, h)                                                                                                    \
  _Pragma("unroll") for (int m = 0; m < 4; ++m) _Pragma("unroll") for (int k = 0; k < 2; ++k)                             \
      dst[m][k] = *(const bf16x8*)((const unsigned char*)SA(b, h) + lds_byte(wr * 64 + m * 16 + fr, k * 32 + fq * 8));
#define LDB(dst, b, h)                                                                                                    \
  _Pragma("unroll") for (int n = 0; n < 2; ++n) _Pragma("unroll") for (int k = 0; k < 2; ++k)                             \
      dst[n][k] = *(const bf16x8*)((const unsigned char*)SB(b, h) + lds_byte(wc * 32 + n * 16 + fr, k * 32 + fq * 8));
#define MMA(ai, bj, At_, Bt_)                                                                                             \
  {                                                                                                                       \
    __builtin_amdgcn_s_setprio(1);                                                                                        \
    _Pragma("unroll") for (int m = 0; m < 4; ++m) _Pragma("unroll") for (int n = 0; n < 2; ++n)                           \
        _Pragma("unroll") for (int k = 0; k < 2; ++k) acc[ai][bj][m][n] =                                                 \
            __builtin_amdgcn_mfma_f32_16x16x32_bf16(Bt_[n][k], At_[m][k], acc[ai][bj][m][n], 0, 0, 0);                    \
    __builtin_amdgcn_s_setprio(0);                                                                                        \
  }
#define WAIT_V(n) asm volatile("s_waitcnt vmcnt(" #n ")" ::: "memory")
#define WAIT_L(n) asm volatile("s_waitcnt lgkmcnt(" #n ")" ::: "memory")
#define BAR __builtin_amdgcn_s_barrier()
#define SCHED __builtin_amdgcn_sched_barrier(0)
#pragma unroll
  for (int a = 0; a < 2; ++a)
#pragma unroll
    for (int b = 0; b < 2; ++b)
#pragma unroll
      for (int m = 0; m < 4; ++m)
#pragma unroll
        for (int n = 0; n < 2; ++n) acc[a][b][m][n] = f32x4{0.f, 0.f, 0.f, 0.f};
  bf16x8 At[4][2], B0[2][2], B1[2][2];
  const int nt = K / 64;
  WAIT_V(0);
  __syncthreads();
  STAGE_B(SB(0, 0), 0, 0) STAGE_A(SA(0, 0), 0, 0)
  STAGE_B(SB(0, 1), 1, 0) STAGE_A(SA(0, 1), 1, 0)
  if (wr == 1) BAR;
  WAIT_V(4); BAR;
  STAGE_B(SB(1, 0), 0, 1) STAGE_A(SA(1, 0), 0, 1) STAGE_B(SB(1, 1), 1, 1)
  WAIT_V(6); BAR;
#pragma unroll 1
  for (int t = 0; t < nt - 2; t += 2) {
    LDB(B0, 0, 0) SCHED; LDA(At, 0, 0) STAGE_A(SA(1, 1), 1, t + 1)
    WAIT_L(8); BAR; WAIT_L(0); MMA(0, 0, At, B0) BAR; SCHED;
    LDB(B1, 0, 1) STAGE_B(SB(0, 0), 0, t + 2)
    BAR; WAIT_L(0); MMA(0, 1, At, B1) BAR;
    LDA(At, 0, 1) STAGE_A(SA(0, 0), 0, t + 2)
    BAR; WAIT_L(0); MMA(1, 0, At, B0) BAR; SCHED;
    STAGE_B(SB(0, 1), 1, t + 2)
    WAIT_V(6); BAR; MMA(1, 1, At, B1) BAR;
    LDB(B0, 1, 0) SCHED; LDA(At, 1, 0) STAGE_A(SA(0, 1), 1, t + 2)
    WAIT_L(8); BAR; WAIT_L(0); MMA(0, 0, At, B0) BAR; SCHED;
    LDB(B1, 1, 1) STAGE_B(SB(1, 0), 0, t + 3)
    BAR; WAIT_L(0); MMA(0, 1, At, B1) BAR;
    LDA(At, 1, 1) STAGE_A(SA(1, 0), 0, t + 3)
    BAR; WAIT_L(0); MMA(1, 0, At, B0) BAR; SCHED;
    STAGE_B(SB(1, 1), 1, t + 3)
    WAIT_V(6); BAR; MMA(1, 1, At, B1) BAR;
  }
  {
    LDB(B0, 0, 0) LDA(At, 0, 0) STAGE_A(SA(1, 1), 1, nt - 1)
    BAR; WAIT_L(0); MMA(0, 0, At, B0) BAR;
    LDB(B1, 0, 1) BAR; WAIT_L(0); MMA(0, 1, At, B1) BAR;
    LDA(At, 0, 1) WAIT_V(4); BAR; WAIT_L(0); MMA(1, 0, At, B0) MMA(1, 1, At, B1) BAR;
  }
  {
    LDB(B0, 1, 0) LDA(At, 1, 0) WAIT_V(2); BAR; WAIT_L(0); MMA(0, 0, At, B0) BAR;
    LDB(B1, 1, 1) WAIT_V(0); BAR; WAIT_L(0); MMA(0, 1, At, B1) BAR;
    LDA(At, 1, 1) BAR; WAIT_L(0); MMA(1, 0, At, B0) MMA(1, 1, At, B1) BAR;
  }
  if (wr == 0) BAR;
}
DI void tile_map_n16(int id, int& pm, int& pn) {
  const int k = id & 255, rnd = id >> 8, x = k & 7, slot = k >> 3;
  pm = rnd * 16 + 4 * (x >> 1) + (slot >> 3);
  pn = 8 * (x & 1) + (slot & 7);
}
DI void tile_map_n4(int id, int& pm, int& pn) {
  const int k = id & 255, rnd = id >> 8, x = k & 7, slot = k >> 3;
  pm = rnd * 64 + 8 * x + (slot >> 2);
  pn = slot & 3;
}
template <class F>
DI void epi256(int wv0, f32x4 (&acc)[2][2][4][2], int brow, int bcol, F f) {
  const int lane = my_tid(wv0) & 63, wr = wv0 >> 2, wc = wv0 & 3;
#pragma unroll
  for (int ai = 0; ai < 2; ++ai)
#pragma unroll
    for (int bj = 0; bj < 2; ++bj)
#pragma unroll
      for (int m = 0; m < 4; ++m)
#pragma unroll
        for (int n = 0; n < 2; ++n) {
          const int row = brow + ai * 128 + wr * 64 + m * 16 + (lane & 15);
          const int col0 = bcol + bj * 128 + wc * 32 + n * 16 + (lane >> 4) * 4;
          f(ai, bj, m, n, row, col0, acc[ai][bj][m][n]);
          if (n == 1 && (m & 1)) __builtin_amdgcn_sched_barrier(0);
        }
}

constexpr int NXT_A = 1024 + 128 + 128 + 16 + 16;
constexpr int NXT = NXT_A + 128 * 3 + 256 + 1024 + 1024;
DI void xpose_tile(int wv0, PP p, int jt, unsigned char* smem) {
  const int tid = my_tid(wv0);
  float* tile = (float*)smem;
  int t = jt;
  const float* src;
  u16* dst;
  int K, Nsrc, mode = 0, rowil = -1;
  const float* scl = nullptr;
  if (t < 1024) { src = p->w_in; dst = (u16*)(p->ws + OFF_WINT); K = 1024; Nsrc = 3864; mode = 1; }
  else if ((t -= 1024) < 128) { src = p->kw1; dst = (u16*)(p->ws + OFF_W1KT); K = 2048; Nsrc = 256; }
  else if ((t -= 128) < 128) { src = p->vw1; dst = (u16*)(p->ws + OFF_W1VT); K = 2048; Nsrc = 256; }
  else if ((t -= 128) < 16) { src = p->kw2; dst = (u16*)(p->ws + OFF_W2KT); K = 256; Nsrc = 64; mode = 2; }
  else if ((t -= 16) < 16) { src = p->vw2; dst = (u16*)(p->ws + OFF_W2VT); K = 256; Nsrc = 64; mode = 2; }
  else if ((t -= 16) < 128) { src = p->w_attn; dst = (u16*)(p->ws + OFF_WAT); K = 512; Nsrc = 1024; }
  else if ((t -= 128) < 128) { src = p->w_val; dst = (u16*)(p->ws + OFF_WVT); K = 512; Nsrc = 1024; rowil = 0; }
  else if ((t -= 128) < 128) { src = p->w_gate; dst = (u16*)(p->ws + OFF_WVT); K = 512; Nsrc = 1024; rowil = 128; }
  else if ((t -= 128) < 256) { src = p->w_out; dst = (u16*)(p->ws + OFF_WOT); K = 1024; Nsrc = 1024; }
  else if ((t -= 256) < 1024) { src = p->w_up; dst = (u16*)(p->ws + OFF_WUPT); K = 1024; Nsrc = 4096; scl = p->g2; }
  else { t -= 1024; src = p->w_down; dst = (u16*)(p->ws + OFF_WDT); K = 4096; Nsrc = 1024; }
  const int nkt = K >> 6, tn = t / nkt, tk = t % nkt, n0 = tn * 64, k0 = tk * 64;
  const int tx = tid & 63, ty = tid >> 6;
  const int np = n0 + tx;
  int sc = np;
  if (mode == 1) {
    if (np < 1280) sc = np;
    else if (np < 1792) sc = 1304 + (np - 1280);
    else if (np < 3840) sc = 1816 + (np - 1792);
    else if (np < 3864) sc = 1280 + (np - 3840);
    else sc = -1;
  } else if (mode == 2) {
    sc = np < 64 ? np : -1;
  }
  for (int kk = ty; kk < 64; kk += 8) {
    float val = 0.f;
    if (sc >= 0) val = src[(size_t)(k0 + kk) * Nsrc + sc];
    if (scl) val *= scl[k0 + kk];
    tile[kk * 65 + tx] = val;
  }
  __syncthreads();
  {
    const int n = tid >> 3, kc = tid & 7;
    uint4 o;
    o.x = pk2(tile[(kc * 8 + 0) * 65 + n], tile[(kc * 8 + 1) * 65 + n]);
    o.y = pk2(tile[(kc * 8 + 2) * 65 + n], tile[(kc * 8 + 3) * 65 + n]);
    o.z = pk2(tile[(kc * 8 + 4) * 65 + n], tile[(kc * 8 + 5) * 65 + n]);
    o.w = pk2(tile[(kc * 8 + 6) * 65 + n], tile[(kc * 8 + 7) * 65 + n]);
    const int drow = rowil < 0 ? (n0 + n) : (((n0 + n) >> 7) * 256 + ((n0 + n) & 127) + rowil);
    *(uint4*)(dst + (size_t)drow * K + k0 + kc * 8) = o;
  }
  __syncthreads();
}

DI void phaseA(int wv0, PP p, unsigned char* smem) {
  const int tid = my_tid(wv0), lane = tid & 63;
  u16* HN = (u16*)(p->ws + OFF_HN);
  for (int row = blockIdx.x * 8 + wv0; row < T_; row += gridDim.x * 8) {
    const float4* xr = (const float4*)(p->x + (size_t)row * 1024);
    float4 v[4];
    float ss = 0.f;
#pragma unroll
    for (int r = 0; r < 4; ++r) {
      v[r] = xr[lane + 64 * r];
      ss += v[r].x * v[r].x + v[r].y * v[r].y + v[r].z * v[r].z + v[r].w * v[r].w;
    }
    ss = wave_sum(ss);
    const float rinv = rsqrtf(ss * (1.f / 1024.f) + 1e-6f);
#pragma unroll
    for (int r = 0; r < 4; ++r) {
      const float4 g = ((const float4*)p->g1)[lane + 64 * r];
      uint2 o;
      o.x = pk2(v[r].x * rinv * g.x, v[r].y * rinv * g.y);
      o.y = pk2(v[r].z * rinv * g.z, v[r].w * rinv * g.w);
      *(uint2*)(HN + (size_t)row * 1024 + (lane + 64 * r) * 4) = o;
    }
  }
  for (int jt = blockIdx.x; jt < NXT_A + 32 + 32; jt += gridDim.x) {
    if (jt < NXT_A) {
      xpose_tile(wv0, p, jt, smem);
    } else if (jt >= NXT_A + 32) {
      const int g = jt - (NXT_A + 32);
      u16* TB = (u16*)(p->ws + OFF_S5T + (size_t)g * 8192);
      const float step = expf(p->log_step[g]);
      for (int e = tid; e < 2048; e += NT_) {
        const int np = e >> 4, c = e & 15, n = np & 63;
        const float lr = p->lam_re[g * 64 + n], li = p->lam_im[g * 64 + n];
        const float er = expf(lr * step);
        float sn, cs;
        sincosf(li * step, &sn, &cs);
        const float nr = er * cs - 1.f, ni = er * sn, den = lr * lr + li * li;
        const float cr = (nr * lr + ni * li) / den, ci = (ni * lr - nr * li) / den;
        const float bre = p->b_re[(g * 64 + n) * 16 + c], bim = p->b_im[(g * 64 + n) * 16 + c];
        TB[np * 16 + c] = f2bf(np < 64 ? (cr * bre - ci * bim) : (cr * bim + ci * bre));
        const int cc = e >> 7, k = e & 127;
        TB[2048 + cc * 128 + k] = f2bf(k < 64 ? p->c_re[(g * 16 + cc) * 64 + k] : -p->c_im[(g * 16 + cc) * 64 + (k - 64)]);
      }
      if (tid < 64) {
        const float lr = p->lam_re[g * 64 + tid], li = p->lam_im[g * 64 + tid];
        const float er = expf(lr * step);
        float sn, cs;
        sincosf(li * step, &sn, &cs);
        ((float2*)(p->ws + OFF_S5L))[g * 64 + tid] = make_float2(er * cs, er * sn);
      }
    } else {
      const int item = jt - NXT_A, kv = item >> 4, slice = item & 15;
      const float* w1 = kv ? p->vw1 : p->kw1;
      const int col = tid & 255, h = tid >> 8, kb = slice * 128 + h * 64;
      float s0 = 0.f, s1 = 0.f, s2 = 0.f, s3 = 0.f;
      for (int k = kb; k < kb + 64; k += 4) {
        s0 += p->pe[k] * w1[(size_t)k * 256 + col];
        s1 += p->pe[k + 1] * w1[(size_t)(k + 1) * 256 + col];
        s2 += p->pe[k + 2] * w1[(size_t)(k + 2) * 256 + col];
        s3 += p->pe[k + 3] * w1[(size_t)(k + 3) * 256 + col];
      }
      ((float*)(p->ws + OFF_CBP))[(kv * 32 + slice * 2 + h) * 256 + col] = (s0 + s1) + (s2 + s3);
    }
  }
  float* rope = (float*)(p->ws + OFF_ROPE);
  for (int i = blockIdx.x * NT_ + tid; i < S_ * 8; i += gridDim.x * NT_) {
    const int pos = i >> 3, k = i & 7;
    const float inv = powf(500000.0f, -(2.0f * (float)k) / 16.0f);
    const float ang = (float)pos * inv;
    rope[pos * 16 + k] = cosf(ang);
    rope[pos * 16 + 8 + k] = sinf(ang);
  }
  if (blockIdx.x == 0 && tid < 64) ((int*)(p->ws + OFF_CTR))[tid] = 0;
}

DI void phaseB(int wv0, PP p, unsigned char* smem) {
  const u16* HN = (const u16*)(p->ws + OFF_HN);
  const u16* WT = (const u16*)(p->ws + OFF_WINT);
  const float* rope = (const float*)(p->ws + OFF_ROPE);
  const int lane = my_tid(wv0) & 63;
  const bool ropewave = (wv0 & 1) == 0;
  for (int id = blockIdx.x; id < 128 * 16; id += gridDim.x) {
    int pm, pn;
    tile_map_n16(id, pm, pn);
    pm = 127 - pm;
    pn = (pn + 5 * (id >> 8)) & 15;
    const int brow = pm * 256, bcol = pn * 256;
    f32x4 acc[2][2][4][2];
    gemm256(wv0, acc, HN + (size_t)brow * 1024, 1024, WT + (size_t)bcol * 1024, 1024, 1024, smem);
    if (pn < 2) {
      u16* QR = (u16*)(p->ws + OFF_QRAW);
      u16* QO = (u16*)(p->ws + OFF_QROT);
      epi256(wv0, acc, brow, bcol, [&](int ai, int bj, int m, int n, int row, int col0, f32x4& v) {
        f32x4 r = v;
        if (n == 0 && ropewave) {
          const int pos = row & (S_ - 1), kq = ((lane >> 4) & 1) * 4;
          const float4 c4 = *(const float4*)(rope + pos * 16 + kq), s4 = *(const float4*)(rope + pos * 16 + 8 + kq);
          const float cc[4] = {c4.x, c4.y, c4.z, c4.w}, ss[4] = {s4.x, s4.y, s4.z, s4.w};
#pragma unroll
          for (int j = 0; j < 4; ++j) {
            const float pr = __shfl_xor(v[j], 32);
            r[j] = (lane & 32) ? (v[j] * cc[j] + pr * ss[j]) : (v[j] * cc[j] - pr * ss[j]);
          }
        }
        *(uint2*)(QR + (size_t)row * 512 + col0) = pk4(v[0] * QSCALE, v[1] * QSCALE, v[2] * QSCALE, v[3] * QSCALE);
        *(uint2*)(QO + (size_t)row * 512 + col0) = pk4(r[0] * QSCALE, r[1] * QSCALE, r[2] * QSCALE, r[3] * QSCALE);
      });
    } else if (pn < 5) {
      epi256(wv0, acc, brow, bcol, [&](int ai, int bj, int m, int n, int row, int col0, f32x4& v) {
        const int sub = (pn - 2) * 2 + bj;
        const bool dorope = (sub == 2 || sub == 4), transposed = (sub == 3 || sub == 5);
        u16* dst = (u16*)(p->ws + OFF_KCIN + (size_t)sub * 8 * MB);
        const int c128 = col0 & 127, g = c128 >> 6, d0 = c128 & 63;
        const int b = row >> 13, sq = row & (S_ - 1);
        f32x4 r = v;
        if (dorope && n == 0 && ropewave) {
          const int kq = ((lane >> 4) & 1) * 4;
          const float4 c4 = *(const float4*)(rope + sq * 16 + kq), s4 = *(const float4*)(rope + sq * 16 + 8 + kq);
          const float cc[4] = {c4.x, c4.y, c4.z, c4.w}, ss[4] = {s4.x, s4.y, s4.z, s4.w};
#pragma unroll
          for (int j = 0; j < 4; ++j) {
            const float pr = __shfl_xor(v[j], 32);
            r[j] = (lane & 32) ? (v[j] * cc[j] + pr * ss[j]) : (v[j] * cc[j] - pr * ss[j]);
          }
        }
        if (transposed) {
#pragma unroll
          for (int j = 0; j < 4; ++j) dst[((size_t)((b * 2 + g) * 64 + d0 + j)) * S_ + sq] = f2bf(r[j]);
        } else {
          *(uint2*)(dst + ((size_t)(b * 2 + g) * S_ + sq) * 64 + d0) = pk4(r[0], r[1], r[2], r[3]);
        }
      });
    } else if (pn < 7) {
      u16* U = (u16*)(p->ws + OFF_U);
      epi256(wv0, acc, brow, bcol, [&](int ai, int bj, int m, int n, int row, int col0, f32x4& v) {
        *(uint2*)(U + (size_t)row * 512 + (col0 - 1280)) = pk4(v[0], v[1], v[2], v[3]);
      });
    } else if (pn < 15) {
      u16* MG = (u16*)(p->ws + OFF_MG);
      epi256(wv0, acc, brow, bcol, [&](int ai, int bj, int m, int n, int row, int col0, f32x4& v) {
        *(uint2*)(MG + (size_t)row * 2048 + (col0 - 1792)) = pk4(sigmoidf_(v[0]), sigmoidf_(v[1]), sigmoidf_(v[2]), sigmoidf_(v[3]));
      });
    } else {
      float* NG = (float*)(p->ws + OFF_NG);
      epi256(wv0, acc, brow, bcol, [&](int ai, int bj, int m, int n, int row, int col0, f32x4& v) {
        const int cc = col0 - 3840;
        if (cc < 24) *(float4*)(NG + (size_t)row * 24 + cc) = make_float4(sigmoidf_(v[0]), sigmoidf_(v[1]), sigmoidf_(v[2]), sigmoidf_(v[3]));
      });
    }
  }
}

template <bool OUT>
DI void s5_item(int wv0, PP p, int item, unsigned char* smem) {
  const int tid = my_tid(wv0), lane = tid & 63, fr = lane & 15, fq = lane >> 4;
  const int b = item >> 9, g = (item >> 4) & 31, c8 = item & 15, ch = c8 * 8 + wv0;
  u16* sBb = (u16*)smem;
  u16* sCm = sBb + 128 * 16;
  float* sBU = (float*)(smem + 8192) + wv0 * (16 * 132);
  u16* sH = (u16*)(smem + 8192 + 8 * 16 * 132 * 4) + wv0 * (16 * 136);
  *(uint4*)(smem + tid * 16) = *(const uint4*)(p->ws + OFF_S5T + (size_t)g * 8192 + tid * 16);
  const float2 lb = ((const float2*)(p->ws + OFF_S5L))[g * 64 + lane];
  const float lbr = lb.x, lbi = lb.y;
  float2* HL = (float2*)(p->ws + OFF_HLOC) + ((size_t)(b * 128 + ch) * 32 + g) * 64 + lane;
  float hr = 0.f, hi = 0.f;
  if (OUT) { const float2 h0 = *HL; hr = h0.x; hi = h0.y; }
  const u16* U = (const u16*)(p->ws + OFF_U) + ((size_t)(b * S_ + ch * 64)) * 512 + g * 16;
  u16* YS = (u16*)(p->ws + OFF_YS) + ((size_t)(b * S_ + ch * 64)) * 512 + g * 16;
  const float dk = p->dsk[g * 16 + fr];
  const bf16x8 zero8 = {0, 0, 0, 0, 0, 0, 0, 0};
  bf16x8 uall[4];
  u16 usk[4][4];
#pragma unroll
  for (int sub = 0; sub < 4; ++sub) {
    uall[sub] = fq < 2 ? *(const bf16x8*)(U + (size_t)(sub * 16 + fr) * 512 + 8 * fq) : zero8;
    if (OUT) {
#pragma unroll
      for (int j = 0; j < 4; ++j) usk[sub][j] = U[(size_t)(sub * 16 + 4 * fq + j) * 512 + fr];
    }
  }
  __syncthreads();
  bf16x8 bb[8], cf[4];
#pragma unroll
  for (int nt = 0; nt < 8; ++nt) bb[nt] = fq < 2 ? *(const bf16x8*)(sBb + (16 * nt + fr) * 16 + 8 * fq) : zero8;
  if (OUT) {
#pragma unroll
    for (int ks = 0; ks < 4; ++ks) cf[ks] = *(const bf16x8*)(sCm + fr * 128 + 32 * ks + 8 * fq);
  }
#pragma unroll
  for (int sub = 0; sub < 4; ++sub) {
    const bf16x8 ua = uall[sub];
#pragma unroll
    for (int nt = 0; nt < 8; ++nt) {
      const f32x4 a = mfma16(ua, bb[nt], f32x4{0.f, 0.f, 0.f, 0.f});
#pragma unroll
      for (int j = 0; j < 4; ++j) sBU[(4 * fq + j) * 132 + 16 * nt + fr] = a[j];
    }
    __syncthreads();
#pragma unroll 4
    for (int t = 0; t < 16; ++t) {
      const float bur = sBU[t * 132 + lane], bui = sBU[t * 132 + 64 + lane];
      const float nr = lbr * hr - lbi * hi + bur;
      const float nim = lbr * hi + lbi * hr + bui;
      hr = nr;
      hi = nim;
      if (OUT) {
        sH[t * 136 + lane] = f2bf(hr);
        sH[t * 136 + 64 + lane] = f2bf(hi);
      }
    }
    __syncthreads();
    if (OUT) {
      f32x4 y = {0.f, 0.f, 0.f, 0.f};
#pragma unroll
      for (int ks = 0; ks < 4; ++ks) y = mfma16(*(const bf16x8*)(sH + fr * 136 + 32 * ks + 8 * fq), cf[ks], y);
#pragma unroll
      for (int j = 0; j < 4; ++j) {
        const size_t o = (size_t)(sub * 16 + 4 * fq + j) * 512 + fr;
        YS[o] = f2bf(gelu_t(y[j] + dk * bf2f(usk[sub][j])));
      }
      __syncthreads();
    }
  }
  if (!OUT) *HL = make_float2(hr, hi);
  __syncthreads();
}
DI void s5_carry(int wv0, PP p) {
  const int x = ((int)blockIdx.x - (gridDim.x >= 48 ? (int)gridDim.x - 16 : 0)) * NT_ + my_tid(wv0);
  if (x < 0 || x >= 8192) return;
  const int b = x >> 11, g = (x >> 6) & 31, n = x & 63;
  const float step = expf(p->log_step[g]);
  const float lr = p->lam_re[g * 64 + n], li = p->lam_im[g * 64 + n];
  const float er = expf(64.f * lr * step);
  float sn, cs;
  sincosf(64.f * li * step, &sn, &cs);
  const float Lr = er * cs, Li = er * sn;
  float2* HL = (float2*)(p->ws + OFF_HLOC) + (size_t)b * 128 * 2048 + g * 64 + n;
  float hr = 0.f, hi = 0.f;
  for (int c0 = 0; c0 < 128; c0 += 16) {
    float2 v[16];
#pragma unroll
    for (int k = 0; k < 16; ++k) v[k] = HL[(size_t)(c0 + k) * 2048];
#pragma unroll
    for (int k = 0; k < 16; ++k) {
      HL[(size_t)(c0 + k) * 2048] = make_float2(hr, hi);
      const float nr = Lr * hr - Li * hi + v[k].x;
      const float nim = Lr * hi + Li * hr + v[k].y;
      hr = nr;
      hi = nim;
    }
  }
}
DI void phaseC(int wv0, PP p, unsigned char* smem) {
  for (int id = blockIdx.x; id < 128 + 2048 + 256; id += gridDim.x) {
    if (id >= 128 + 2048) {
      const int it = id - (128 + 2048), tns = it >> 7, bg = (it >> 4) & 7, part = it & 15;
      const int tid = my_tid(wv0);
      const u16* K = (const u16*)(p->ws + (tns ? OFF_KW : OFF_KS)) + ((size_t)bg * S_ + part * 512 + tid) * 64;
      float q2 = 0.f;
#pragma unroll
      for (int c = 0; c < 8; ++c) {
        const uint4 w = *(const uint4*)(K + c * 8);
        const unsigned ww[4] = {w.x, w.y, w.z, w.w};
#pragma unroll
        for (int e = 0; e < 4; ++e) {
          const float a = __uint_as_float(ww[e] << 16), b2 = __uint_as_float(ww[e] & 0xffff0000u);
          q2 += a * a + b2 * b2;
        }
      }
#pragma unroll
      for (int o = 32; o > 0; o >>= 1) q2 = fmaxf(q2, __shfl_xor(q2, o));
      if ((tid & 63) == 0) atomicMax((unsigned*)(p->ws + OFF_KMAX) + tns * 8 + bg, __float_as_uint(q2));
    } else if (id < 128) {
      const int kv = id >> 6, pm = (id >> 2) & 15, ks = id & 3, brow = pm * 256;
      const u16* A = (const u16*)(p->ws + (kv ? OFF_VCIN : OFF_KCIN)) + (size_t)brow * 1024 + ks * 512;
      const u16* Bt = (const u16*)(p->ws + (kv ? OFF_W1VT : OFF_W1KT)) + ks * 512;
      f32x4 acc[2][2][4][2];
      gemm256(wv0, acc, A, 1024, Bt, 2048, 512, smem);
      float* PART = (float*)(p->ws + OFF_CPART) + (size_t)(ks * 2 + kv) * 4096 * 256;
      epi256(wv0, acc, brow, 0, [&](int ai, int bj, int m, int n, int row, int col0, f32x4& v) {
        *(float4*)(PART + (size_t)row * 256 + col0) = make_float4(v[0], v[1], v[2], v[3]);
      });
    } else {
      s5_item<false>(wv0, p, id - 128, smem);
    }
  }
}
DI void phaseD1(int wv0, PP p, unsigned char* smem) {
  const int tid = my_tid(wv0);
  float* sB = (float*)smem;
  {
    const float* cbp = (const float*)(p->ws + OFF_CBP);
    float bb = 0.f;
    for (int sl = 0; sl < 32; ++sl) bb += cbp[((tid >> 8) * 32 + sl) * 256 + (tid & 255)];
    sB[tid] = bb;
  }
  __syncthreads();
  const float* PART = (const float*)(p->ws + OFF_CPART);
  u16* HC = (u16*)(p->ws + OFF_HC);
  for (int e = blockIdx.x * NT_ + tid; e < 2 * 4096 * 64; e += gridDim.x * NT_) {
    const int kv = e >> 18, rc = e & 262143, c4 = (rc & 63) * 4;
    const size_t o = (size_t)kv * 4096 * 256 + (size_t)rc * 4;
    float4 a = *(const float4*)(PART + o);
#pragma unroll
    for (int ks = 1; ks < 4; ++ks) {
      const float4 t = *(const float4*)(PART + (size_t)ks * 2 * 4096 * 256 + o);
      a.x += t.x; a.y += t.y; a.z += t.z; a.w += t.w;
    }
    const float* bv = sB + kv * 256 + c4;
    *(uint2*)(HC + o) = pk4(gelu_t(a.x + bv[0]), gelu_t(a.y + bv[1]), gelu_t(a.z + bv[2]), gelu_t(a.w + bv[3]));
  }
}
DI void phaseD(int wv0, PP p, unsigned char* smem) {
  for (int id = blockIdx.x; id < 32; id += gridDim.x) {
    const int kv = id >> 4, pm = id & 15, brow = pm * 256;
    const u16* A = (const u16*)(p->ws + OFF_HC) + (size_t)kv * 4096 * 256 + (size_t)brow * 256;
    const u16* Bt = (const u16*)(p->ws + (kv ? OFF_W2VT : OFF_W2KT));
    f32x4 acc[2][2][4][2];
    gemm256(wv0, acc, A, 256, Bt, 256, 256, smem);
    u16* KCC = (u16*)(p->ws + OFF_KCC);
    u16* VCT = (u16*)(p->ws + OFF_VCT);
    epi256(wv0, acc, brow, 0, [&](int ai, int bj, int m, int n, int row, int col0, f32x4& v) {
      if (col0 < 64) {
        const int bg = row >> 9, nn = row & 511;
        f32x4 r = v;
        if (nn == 511) r = f32x4{0.f, 0.f, 0.f, 0.f};
        if (kv == 0) {
          *(uint2*)(KCC + ((size_t)bg * 512 + nn) * 64 + col0) = pk4(r[0], r[1], r[2], r[3]);
        } else {
#pragma unroll
          for (int j = 0; j < 4; ++j) VCT[((size_t)bg * 64 + col0 + j) * 512 + nn] = f2bf(r[j]);
        }
      }
    });
  }
  s5_carry(wv0, p);
}

DI bool bit128(u64 lo, u64 hi, int j) { return j < 64 ? ((lo >> j) & 1ull) : ((hi >> (j - 64)) & 1ull); }
DI int next_bit(u64 lo, u64 hi, int from) {
  if (from < 64) {
    const u64 x = (lo >> from) << from;
    if (x) return __ffsll((long long)x) - 1;
    from = 64;
  }
  if (from >= 128) return -1;
  const u64 y = (hi >> (from - 64)) << (from - 64);
  return y ? 63 + __ffsll((long long)y) : -1;
}

template <int MODE, bool MASKED, class MaskF>
DI void flash_tile(const u16* sK, const u16* sV, const bf16x8 (&qf)[2][2], f32x4 (&O)[2][4], float (&m)[2], float (&l)[2],
                   float (&ps)[4][4], MaskF ok, bool sel, int lane) {
  const int l15 = lane & 15, lg = lane >> 4;
  bf16x8 kf[4][2];
#pragma unroll
  for (int kt = 0; kt < 4; ++kt)
#pragma unroll
    for (int ks = 0; ks < 2; ++ks) kf[kt][ks] = *(const bf16x8*)(sK + (16 * kt + l15) * 72 + ks * 32 + lg * 8);
  if (MODE == 1) {
#pragma unroll
    for (int a = 0; a < 4; ++a)
#pragma unroll
      for (int b = 0; b < 4; ++b) ps[a][b] = 0.f;
  }
  union PFrag { unsigned u[4]; bf16x8 v; };
  PFrag pf[2][2];
#pragma unroll
  for (int qt = 0; qt < 2; ++qt) {
    f32x4 s[4];
    const float sinit = (MODE == 3) ? ((MASKED || sel) ? m[qt] : -1e30f) : 0.f;
#pragma unroll
    for (int kt = 0; kt < 4; ++kt) {
      s[kt] = f32x4{sinit, sinit, sinit, sinit};
#pragma unroll
      for (int ks = 0; ks < 2; ++ks) s[kt] = mfma16(kf[kt][ks], qf[qt][ks], s[kt]);
    }
    float pr[4][4];
    if (MODE == 3) {
      float rs = 0.f;
#pragma unroll
      for (int kt = 0; kt < 4; ++kt)
#pragma unroll
        for (int i = 0; i < 4; ++i) {
          float pv = __builtin_amdgcn_exp2f(s[kt][i]);
          if (MASKED) pv = ok(kt, i) ? pv : 0.f;
          pr[kt][i] = pv;
          rs += pv;
        }
      l[qt] += rs;
    } else {
    float mx = -1e30f;
#pragma unroll
    for (int kt = 0; kt < 4; ++kt)
#pragma unroll
      for (int i = 0; i < 4; ++i) {
        if (MASKED) s[kt][i] = ok(kt, i) ? s[kt][i] : -1e30f;
        mx = fmaxf(mx, s[kt][i]);
      }
    if (!MASKED) mx = sel ? mx : -1e30f;
    if (MODE == 1) {
      const float mm = m[qt], il = l[qt];
#pragma unroll
      for (int kt = 0; kt < 4; ++kt)
#pragma unroll
        for (int i = 0; i < 4; ++i) {
          const float pv = (s[kt][i] > -1e29f) ? __builtin_amdgcn_exp2f(s[kt][i] - mm) * il : 0.f;
          pr[kt][i] = pv;
          ps[kt][i] += pv;
        }
    } else {
      mx = fmaxf(mx, __shfl_xor(mx, 16));
      mx = fmaxf(mx, __shfl_xor(mx, 32));
      const float mnew = fmaxf(m[qt], mx);
      const float alpha = __builtin_amdgcn_exp2f(m[qt] - mnew);
      m[qt] = mnew;
      float rs = 0.f;
      if (MASKED) {
#pragma unroll
        for (int kt = 0; kt < 4; ++kt)
#pragma unroll
          for (int i = 0; i < 4; ++i) {
            const float pv = (s[kt][i] > -1e29f) ? __builtin_amdgcn_exp2f(s[kt][i] - mnew) : 0.f;
            pr[kt][i] = pv;
            rs += pv;
          }
      } else {
        const float me = sel ? mnew : 1e30f;
#pragma unroll
        for (int kt = 0; kt < 4; ++kt)
#pragma unroll
          for (int i = 0; i < 4; ++i) {
            const float pv = __builtin_amdgcn_exp2f(s[kt][i] - me);
            pr[kt][i] = pv;
            rs += pv;
          }
      }
      l[qt] = l[qt] * alpha + rs;
      if (MODE == 2) {
#pragma unroll
        for (int dt = 0; dt < 4; ++dt) O[qt][dt] *= alpha;
      }
    }
    }
    if (MODE != 0) {
#pragma unroll
      for (int ks2 = 0; ks2 < 2; ++ks2) {
        pf[qt][ks2].u[0] = pk2(pr[2 * ks2][0], pr[2 * ks2][1]);
        pf[qt][ks2].u[1] = pk2(pr[2 * ks2][2], pr[2 * ks2][3]);
        pf[qt][ks2].u[2] = pk2(pr[2 * ks2 + 1][0], pr[2 * ks2 + 1][1]);
        pf[qt][ks2].u[3] = pk2(pr[2 * ks2 + 1][2], pr[2 * ks2 + 1][3]);
      }
    }
  }
  if (MODE != 0) {
#pragma unroll
    for (int ks2 = 0; ks2 < 2; ++ks2) {
#pragma unroll
      for (int dt = 0; dt < 4; ++dt) {
        union { uint2 h[2]; bf16x8 v; } vf;
        vf.h[0] = *(const uint2*)(sV + (16 * dt + l15) * 72 + 32 * ks2 + 4 * lg);
        vf.h[1] = *(const uint2*)(sV + (16 * dt + l15) * 72 + 32 * ks2 + 16 + 4 * lg);
        O[0][dt] = mfma16(vf.v, pf[0][ks2].v, O[0][dt]);
        O[1][dt] = mfma16(vf.v, pf[1][ks2].v, O[1][dt]);
      }
    }
  }
}

DI void flash_s3(const u16* sK, const bf16x8 (&qf)[2][2], float si0, float si1, f32x4 (&s)[2][4], int lane) {
  const int l15 = lane & 15, lg = lane >> 4;
  bf16x8 kf[4][2];
#pragma unroll
  for (int kt = 0; kt < 4; ++kt)
#pragma unroll
    for (int ks = 0; ks < 2; ++ks) kf[kt][ks] = *(const bf16x8*)(sK + (16 * kt + l15) * 72 + ks * 32 + lg * 8);
#pragma unroll
  for (int qt = 0; qt < 2; ++qt) {
    const float si = qt ? si1 : si0;
#pragma unroll
    for (int kt = 0; kt < 4; ++kt) {
      s[qt][kt] = f32x4{si, si, si, si};
#pragma unroll
      for (int ks = 0; ks < 2; ++ks) s[qt][kt] = mfma16(kf[kt][ks], qf[qt][ks], s[qt][kt]);
    }
  }
}
template <bool MASKED, class MaskF>
DI void flash_pv3(const u16* sV, const f32x4 (&s)[2][4], f32x4 (&O)[2][4], float (&l)[2], MaskF ok, int lane) {
  const int l15 = lane & 15, lg = lane >> 4;
  union PFrag { unsigned u[4]; bf16x8 v; };
  PFrag pf[2][2];
#pragma unroll
  for (int qt = 0; qt < 2; ++qt) {
    float pr[4][4];
    float rs = 0.f;
#pragma unroll
    for (int kt = 0; kt < 4; ++kt)
#pragma unroll
      for (int i = 0; i < 4; ++i) {
        float pv = __builtin_amdgcn_exp2f(s[qt][kt][i]);
        if (MASKED) pv = ok(kt, i) ? pv : 0.f;
        pr[kt][i] = pv;
        rs += pv;
      }
    l[qt] += rs;
#pragma unroll
    for (int ks2 = 0; ks2 < 2; ++ks2) {
      pf[qt][ks2].u[0] = pk2(pr[2 * ks2][0], pr[2 * ks2][1]);
      pf[qt][ks2].u[1] = pk2(pr[2 * ks2][2], pr[2 * ks2][3]);
      pf[qt][ks2].u[2] = pk2(pr[2 * ks2 + 1][0], pr[2 * ks2 + 1][1]);
      pf[qt][ks2].u[3] = pk2(pr[2 * ks2 + 1][2], pr[2 * ks2 + 1][3]);
    }
  }
#pragma unroll
  for (int ks2 = 0; ks2 < 2; ++ks2) {
#pragma unroll
    for (int dt = 0; dt < 4; ++dt) {
      union { uint2 h[2]; bf16x8 v; } vf;
      vf.h[0] = *(const uint2*)(sV + (16 * dt + l15) * 72 + 32 * ks2 + 4 * lg);
      vf.h[1] = *(const uint2*)(sV + (16 * dt + l15) * 72 + 32 * ks2 + 16 + 4 * lg);
      O[0][dt] = mfma16(vf.v, pf[0][ks2].v, O[0][dt]);
      O[1][dt] = mfma16(vf.v, pf[1][ks2].v, O[1][dt]);
    }
  }
}

DI void nsa_item(int wv0, PP p, int item, unsigned char* smem) {
  const int tid = my_tid(wv0), lane = tid & 63, wv = wv0 & 3, hp = wv0 >> 2, l15 = lane & 15, lg = lane >> 4;
  const int i = 127 - (item >> 3), bg = item & 7, b = bg >> 1, g = bg & 1;
  u16* sK = (u16*)smem;
  u16* sV = sK + 64 * 72;
  float* sImp0 = (float*)(smem + 55296);
  float* sImp = sImp0 + hp * (64 * 132);
  u64* sUni = (u64*)(smem + 55296 + 2 * 64 * 132 * 4);
  u64* sSel = sUni + 16;
  const int t0 = i * 64, qloc = 16 * wv + l15, tq = t0 + qloc;
  const unsigned tokq = (unsigned)(b * S_ + tq);
  const float* NGb = (const float*)(p->ws + OFF_NG);
  const unsigned ngoff = tokq * 24 + g * 12 + hp * 6;
  float* ACCb = p->out;
  const unsigned aoff = tokq * 512 + g * 256 + hp * 128 + 4 * lg;
  const unsigned qoff = tokq * 512 + g * 256 + hp * 128 + lg * 8;
  const int lrow = tid >> 3, lpart = tid & 7;
  const unsigned koff = (lrow * 64 + lpart * 8) * 2, voffc = (lrow * 512 + lpart * 8) * 2, voffs = (lrow * S_ + lpart * 8) * 2;

  for (int e = tid; e < 2 * 64 * 132; e += NT_) sImp0[e] = 0.f;

  bf16x8 qf[2][2];
  f32x4 O[2][4];
  float m[2], l[2], ps[4][4];
  u32x4 pk0, pv0;
  auto nomask = [](int, int) { return true; };

#define MAKE_RSRC(PTR) __builtin_amdgcn_make_buffer_rsrc((void*)(PTR), 0, 0x7fffffff, 0x00020000)
#define BLOAD(R, VO, SO) __builtin_amdgcn_raw_buffer_load_b128((R), (int)(VO), (int)(SO), 0)
#define ISSUE_TILE(RK, RV, T, LDV)                                                   \
  {                                                                                  \
    pk0 = BLOAD(RK, koff, (T)*8192);                                                 \
    pv0 = BLOAD(RV, ((LDV) == 512) ? voffc : voffs, (T)*128);                        \
  }
#define COMMIT_TILE()                                                                \
  {                                                                                  \
    *(u32x4*)(sK + lrow * 72 + lpart * 8) = pk0;                                     \
    *(u32x4*)(sV + lrow * 72 + lpart * 8) = pv0;                                     \
  }
#define COMMIT_BUF(BUF)                                                              \
  {                                                                                  \
    *(u32x4*)(sK + (BUF)*9216 + lrow * 72 + lpart * 8) = pk0;                        \
    *(u32x4*)(sV + (BUF)*9216 + lrow * 72 + lpart * 8) = pv0;                        \
  }
#define LOAD_Q(BASE)                                                                 \
  {                                                                                  \
    const u16* Q_ = (const u16*)(p->ws + (BASE));                                    \
    _Pragma("unroll") for (int qt = 0; qt < 2; ++qt)                                 \
      _Pragma("unroll") for (int ks = 0; ks < 2; ++ks)                               \
        qf[qt][ks] = *(const bf16x8*)(Q_ + (qoff + qt * 64 + ks * 32));             \
  }
#define RESET_STATE()                                                                \
  {                                                                                  \
    _Pragma("unroll") for (int qt = 0; qt < 2; ++qt) { m[qt] = -1e30f; l[qt] = 0.f; } \
    _Pragma("unroll") for (int a = 0; a < 2; ++a)                                    \
      _Pragma("unroll") for (int c = 0; c < 4; ++c) O[a][c] = f32x4{0.f, 0.f, 0.f, 0.f}; \
  }

  {
    const u16* Kc0 = (const u16*)(p->ws + OFF_KCC) + (size_t)bg * 512 * 64;
    const u16* Vc0 = (const u16*)(p->ws + OFF_VCT) + (size_t)bg * 64 * 512;
    const int nE = (4 * i + 3) < 511 ? (4 * i + 3) : 511;
    const int nkb = (nE + 63) >> 6;
    const __amdgpu_buffer_rsrc_t rK = MAKE_RSRC(Kc0), rV = MAKE_RSRC(Vc0);
    LOAD_Q(OFF_QRAW)
    RESET_STATE()
    ISSUE_TILE(rK, rV, 0, 512)
    for (int kb = 0; kb < nkb; ++kb) {
      __syncthreads();
      COMMIT_TILE()
      __syncthreads();
      if (kb + 1 < nkb) ISSUE_TILE(rK, rV, kb + 1, 512)
      auto ok = [&](int kt, int ii) { return 16 * (kb * 64 + 16 * kt + 4 * lg + ii) + 31 <= tq; };
      flash_tile<0, true>(sK, sV, qf, O, m, l, ps, ok, true, lane);
    }
#pragma unroll
    for (int qt = 0; qt < 2; ++qt) {
      float s = l[qt];
      s += __shfl_xor(s, 16);
      s += __shfl_xor(s, 32);
      l[qt] = s > 0.f ? 1.f / s : 0.f;
    }
    ISSUE_TILE(rK, rV, 0, 512)
    for (int kb = 0; kb < nkb; ++kb) {
      __syncthreads();
      COMMIT_TILE()
      __syncthreads();
      if (kb + 1 < nkb) ISSUE_TILE(rK, rV, kb + 1, 512)
      auto ok = [&](int kt, int ii) { return 16 * (kb * 64 + 16 * kt + 4 * lg + ii) + 31 <= tq; };
      flash_tile<1, true>(sK, sV, qf, O, m, l, ps, ok, true, lane);
#pragma unroll
      for (int kt = 0; kt < 4; ++kt) {
        const int j = kb * 16 + kt * 4 + lg;
        sImp[qloc * 132 + j] += ps[kt][0] + ps[kt][1] + ps[kt][2] + ps[kt][3];
      }
      __syncthreads();
#pragma unroll
      for (int kt = 0; kt < 4; ++kt) {
        const int j1 = kb * 16 + kt * 4 + lg + 1;
        if (j1 < 128) sImp[qloc * 132 + j1] += ps[kt][3];
      }
    }
#pragma unroll
    for (int qt = 0; qt < 2; ++qt) {
      const float gt = NGb[ngoff + qt * 3 + 0];
#pragma unroll
      for (int dt = 0; dt < 4; ++dt) {
        float4 o = make_float4(O[qt][dt][0] * gt, O[qt][dt][1] * gt, O[qt][dt][2] * gt, O[qt][dt][3] * gt);
        *(float4*)(ACCb + (aoff + qt * 64 + 16 * dt)) = o;
      }
    }
  }
  __syncthreads();
  u64 mlo = 0, mhi = 0, wlo = 0, whi = 0;
  if (i < 16) {
    mlo = (1ull << (i + 1)) - 1ull;
    wlo = mlo;
  } else {
    const bool v0 = lane <= i, v1 = (lane + 64) <= i;
    const bool f0 = (lane == 0) || (lane == i) || (lane == i - 1);
    const bool f1 = (lane + 64 == i) || (lane + 64 == i - 1);
    const u64 ltm = (1ull << lane) - 1ull;
    for (int qq = hp * 8; qq < hp * 8 + 8; ++qq) {
      const float* ir = sImp0 + (16 * wv + qq) * 132;
      const float i0 = ir[lane] + ir[64 * 132 + lane], i1 = ir[lane + 64] + ir[64 * 132 + lane + 64];
      const unsigned k0 = v0 ? __float_as_uint(i0 + (f0 ? 1000.f : 0.f)) : 0u;
      const unsigned k1 = v1 ? __float_as_uint(i1 + (f1 ? 1000.f : 0.f)) : 0u;
      unsigned T = 0;
      for (int bit = 30; bit >= 0; --bit) {
        const unsigned cand = T | (1u << bit);
        const int cnt = __popcll(__ballot(k0 >= cand)) + __popcll(__ballot(k1 >= cand));
        if (cnt >= 16) T = cand;
      }
      const bool g0 = k0 > T, g1 = k1 > T, e0 = k0 == T, e1 = k1 == T;
      const int need = 16 - (__popcll(__ballot(g0)) + __popcll(__ballot(g1)));
      const u64 be0 = __ballot(e0), be1 = __ballot(e1);
      const int r0 = __popcll(be0 & ltm), r1 = __popcll(be0) + __popcll(be1 & ltm);
      const u64 s0 = __ballot(v0 && (g0 || (e0 && r0 < need)));
      const u64 s1 = __ballot(v1 && (g1 || (e1 && r1 < need)));
      wlo |= s0;
      whi |= s1;
      if (lane == 0) { sSel[(16 * wv + qq) * 2] = s0; sSel[(16 * wv + qq) * 2 + 1] = s1; }
    }
  }
  if (lane == 0) { sUni[wv0 * 2] = wlo; sUni[wv0 * 2 + 1] = whi; }
  __syncthreads();
  if (i >= 16) { mlo = sSel[qloc * 2]; mhi = sSel[qloc * 2 + 1]; }
  wlo = sUni[wv * 2] | sUni[(wv + 4) * 2];
  whi = sUni[wv * 2 + 1] | sUni[(wv + 4) * 2 + 1];
  const u64 blo = sUni[0] | sUni[2] | sUni[4] | sUni[6] | sUni[8] | sUni[10] | sUni[12] | sUni[14];
  const u64 bhi = sUni[1] | sUni[3] | sUni[5] | sUni[7] | sUni[9] | sUni[11] | sUni[13] | sUni[15];

  LOAD_Q(OFF_QROT)
  float nb_s[2], nb_w[2];
  bool usefix;
  {
    const float* KM = (const float*)(p->ws + OFF_KMAX);
    const float kms = KM[bg], kmw = KM[8 + bg];
    float bmax = 0.f;
#pragma unroll
    for (int qt = 0; qt < 2; ++qt) {
      float q2 = 0.f;
#pragma unroll
      for (int ks = 0; ks < 2; ++ks)
#pragma unroll
        for (int e = 0; e < 8; ++e) {
          const float qv = __uint_as_float(((unsigned)(u16)qf[qt][ks][e]) << 16);
          q2 += qv * qv;
        }
      q2 += __shfl_xor(q2, 16);
      q2 += __shfl_xor(q2, 32);
      const float bs = sqrtf(q2 * kms) * 1.001f + 1e-3f, bw = sqrtf(q2 * kmw) * 1.001f + 1e-3f;
      nb_s[qt] = -bs;
      nb_w[qt] = -bw;
      bmax = fmaxf(bmax, fmaxf(bs, bw));
    }
    usefix = __ballot(bmax > 60.f) == 0ull;
  }
  RESET_STATE()
  if (usefix) { m[0] = nb_s[0]; m[1] = nb_s[1]; }
  {
    const __amdgpu_buffer_rsrc_t rK = MAKE_RSRC((const u16*)(p->ws + OFF_KS) + (size_t)bg * S_ * 64);
    const __amdgpu_buffer_rsrc_t rV = MAKE_RSRC((const u16*)(p->ws + OFF_VST) + (size_t)bg * 64 * S_);
    if (usefix) {
      int jc = next_bit(blo, bhi, 0);
      int j1 = next_bit(blo, bhi, jc + 1);
      ISSUE_TILE(rK, rV, jc, S_)
      COMMIT_BUF(0)
      if (j1 >= 0) {
        ISSUE_TILE(rK, rV, j1, S_)
        COMMIT_BUF(1)
      }
      __syncthreads();
      int j2 = j1 >= 0 ? next_bit(blo, bhi, j1 + 1) : -1;
      if (j2 >= 0) ISSUE_TILE(rK, rV, j2, S_)
      f32x4 sc_[2][4], sn_[2][4];
      {
        const bool selc = bit128(mlo, mhi, jc);
        flash_s3(sK, qf, (selc || jc == i) ? m[0] : -1e30f, (selc || jc == i) ? m[1] : -1e30f, sc_, lane);
      }
      int bc = 0;
      while (jc >= 0) {
        const int bn = bc == 2 ? 0 : bc + 1, bn2 = bn == 2 ? 0 : bn + 1;
        const bool needn = j1 >= 0 && bit128(wlo, whi, j1);
        if (needn) {
          const bool seln = bit128(mlo, mhi, j1);
          const bool on = seln || j1 == i;
          flash_s3(sK + bn * 9216, qf, on ? m[0] : -1e30f, on ? m[1] : -1e30f, sn_, lane);
        }
        if (bit128(wlo, whi, jc)) {
          if (jc == i) {
            const bool sel = bit128(mlo, mhi, jc);
            auto ok = [&](int kt, int ii) { return sel && (16 * kt + 4 * lg + ii) <= qloc; };
            flash_pv3<true>(sV + bc * 9216, sc_, O, l, ok, lane);
          } else {
            flash_pv3<false>(sV + bc * 9216, sc_, O, l, nomask, lane);
          }
        }
        if (j2 >= 0) COMMIT_BUF(bn2)
        __syncthreads();
        jc = j1;
        j1 = j2;
        bc = bn;
        if (j1 >= 0) {
          j2 = next_bit(blo, bhi, j1 + 1);
          if (j2 >= 0) ISSUE_TILE(rK, rV, j2, S_)
        } else {
          j2 = -1;
        }
#pragma unroll
        for (int a = 0; a < 2; ++a)
#pragma unroll
          for (int c = 0; c < 4; ++c) sc_[a][c] = sn_[a][c];
      }
    } else {
      int j = next_bit(blo, bhi, 0);
      ISSUE_TILE(rK, rV, j, S_)
      COMMIT_BUF(0)
      __syncthreads();
      int jn = next_bit(blo, bhi, j + 1);
      if (jn >= 0) ISSUE_TILE(rK, rV, jn, S_)
      int cur = 0;
      while (j >= 0) {
        const u16* cK = sK + cur * 9216;
        const u16* cV = sV + cur * 9216;
        if (bit128(wlo, whi, j)) {
          const bool sel = bit128(mlo, mhi, j);
          if (j == i) {
            auto ok = [&](int kt, int ii) { return sel && (16 * kt + 4 * lg + ii) <= qloc; };
            if (usefix) flash_tile<3, true>(cK, cV, qf, O, m, l, ps, ok, true, lane);
            else flash_tile<2, true>(cK, cV, qf, O, m, l, ps, ok, true, lane);
          } else {
            if (usefix) flash_tile<3, false>(cK, cV, qf, O, m, l, ps, nomask, sel, lane);
            else flash_tile<2, false>(cK, cV, qf, O, m, l, ps, nomask, sel, lane);
          }
        }
        cur ^= 1;
        if (jn >= 0) COMMIT_BUF(cur)
        __syncthreads();
        j = jn;
        if (j >= 0) {
          jn = next_bit(blo, bhi, j + 1);
          if (jn >= 0) ISSUE_TILE(rK, rV, jn, S_)
        }
      }
    }
  }
#pragma unroll
  for (int qt = 0; qt < 2; ++qt) {
    float s = l[qt];
    s += __shfl_xor(s, 16);
    s += __shfl_xor(s, 32);
    const float sc = NGb[ngoff + qt * 3 + 1] / s;
#pragma unroll
    for (int dt = 0; dt < 4; ++dt) {
      float4* a = (float4*)(ACCb + (aoff + qt * 64 + 16 * dt));
      float4 o = *a;
      o.x += O[qt][dt][0] * sc; o.y += O[qt][dt][1] * sc; o.z += O[qt][dt][2] * sc; o.w += O[qt][dt][3] * sc;
      *a = o;
    }
  }
  RESET_STATE()
  if (usefix) { m[0] = nb_w[0]; m[1] = nb_w[1]; }
  {
    const __amdgpu_buffer_rsrc_t rK = MAKE_RSRC((const u16*)(p->ws + OFF_KW) + (size_t)bg * S_ * 64);
    const __amdgpu_buffer_rsrc_t rV = MAKE_RSRC((const u16*)(p->ws + OFF_VWT) + (size_t)bg * 64 * S_);
    const int j0 = i >= 8 ? i - 8 : 0;
    ISSUE_TILE(rK, rV, j0, S_)
    COMMIT_BUF(0)
    __syncthreads();
    if (j0 + 1 <= i) ISSUE_TILE(rK, rV, j0 + 1, S_)
    int cur = 0;
    for (int j = j0; j <= i; ++j) {
      const u16* cK = sK + cur * 9216;
      const u16* cV = sV + cur * 9216;
      if (j == i || j == i - 8) {
        auto ok = [&](int kt, int ii) {
          const int kp = j * 64 + 16 * kt + 4 * lg + ii;
          return kp <= tq && kp > tq - 512;
        };
        if (usefix) flash_tile<3, true>(cK, cV, qf, O, m, l, ps, ok, true, lane);
        else flash_tile<2, true>(cK, cV, qf, O, m, l, ps, ok, true, lane);
      } else {
        if (usefix) flash_tile<3, false>(cK, cV, qf, O, m, l, ps, nomask, true, lane);
        else flash_tile<2, false>(cK, cV, qf, O, m, l, ps, nomask, true, lane);
      }
      cur ^= 1;
      if (j + 1 <= i) COMMIT_BUF(cur)
      __syncthreads();
      if (j + 2 <= i) ISSUE_TILE(rK, rV, j + 2, S_)
    }
  }
  u16* NSAb = (u16*)(p->ws + OFF_NSA);
#pragma unroll
  for (int qt = 0; qt < 2; ++qt) {
    float s = l[qt];
    s += __shfl_xor(s, 16);
    s += __shfl_xor(s, 32);
    const float sc = NGb[ngoff + qt * 3 + 2] / s;
#pragma unroll
    for (int dt = 0; dt < 4; ++dt) {
      const float4 a = *(const float4*)(ACCb + (aoff + qt * 64 + 16 * dt));
      uint2 o;
      o.x = pk2(a.x + O[qt][dt][0] * sc, a.y + O[qt][dt][1] * sc);
      o.y = pk2(a.z + O[qt][dt][2] * sc, a.w + O[qt][dt][3] * sc);
      *(uint2*)(NSAb + (aoff + qt * 64 + 16 * dt)) = o;
    }
  }
  __syncthreads();
}

DI void phaseE(int wv0, PP p, unsigned char* smem, int cidx) {
  __shared__ int s_item;
  int* ctr = (int*)(p->ws + OFF_CTR) + cidx;
  for (;;) {
    __syncthreads();
    if (my_tid(wv0) == 0) s_item = atomicAdd(ctr, 1);
    __syncthreads();
    const int item = s_item;
    if (item >= 1024 + 2048 + (NXT - NXT_A)) break;
    if (item < 1024) nsa_item(wv0, p, item, smem);
    else if (item < 1024 + 2048) s5_item<true>(wv0, p, item - 1024, smem);
    else xpose_tile(wv0, p, NXT_A + (item - 3072), smem);
  }
}

DI void phaseF(int wv0, PP p, unsigned char* smem) {
  const u16* YS = (const u16*)(p->ws + OFF_YS);
  const u16* NSA = (const u16*)(p->ws + OFF_NSA);
  const u16* MG = (const u16*)(p->ws + OFF_MG);
  u16* MR = (u16*)(p->ws + OFF_MERGED);
  for (int id = blockIdx.x; id < 128 * 4; id += gridDim.x) {
    int pm, pn;
    tile_map_n4(id, pm, pn);
    const int brow = pm * 256, bcol = pn * 256;
    f32x4 acc[2][2][4][2];
#pragma unroll 1
    for (int h = 0; h < 2; ++h) {
      const int grp = pn * 2 + h;
      gemm256(wv0, acc, YS + (size_t)brow * 512, 512, (const u16*)(p->ws + OFF_WVT) + (size_t)grp * 256 * 512, 512, 512, smem);
#pragma unroll
      for (int ai = 0; ai < 2; ++ai)
#pragma unroll
        for (int m = 0; m < 4; ++m)
#pragma unroll
          for (int n = 0; n < 2; ++n)
#pragma unroll
            for (int j = 0; j < 4; ++j) acc[ai][0][m][n][j] *= sigmoidf_(acc[ai][1][m][n][j]);
      __builtin_amdgcn_sched_barrier(0);
      epi256(wv0, acc, brow, grp * 128, [&](int ai, int bj, int m, int n, int row, int col0, f32x4& v) {
        if (bj == 0) {
          const unsigned og = (unsigned)row * 2048u + 1024u + (unsigned)col0, om = (unsigned)row * 1024u + (unsigned)col0;
          const uint2 gq = *(const uint2*)(MG + og);
          *(uint2*)(MR + om) = pk4(__uint_as_float(gq.x << 16) * v[0], __uint_as_float(gq.x & 0xffff0000u) * v[1],
                                   __uint_as_float(gq.y << 16) * v[2], __uint_as_float(gq.y & 0xffff0000u) * v[3]);
        }
      });
    }
    gemm256(wv0, acc, NSA + (size_t)brow * 512, 512, (const u16*)(p->ws + OFF_WAT) + (size_t)bcol * 512, 512, 512, smem);
    epi256(wv0, acc, brow, bcol, [&](int ai, int bj, int m, int n, int row, int col0, f32x4& v) {
      const unsigned og = (unsigned)row * 2048u + (unsigned)col0, om = (unsigned)row * 1024u + (unsigned)col0;
      const uint2 t = *(const uint2*)(MR + om);
      const uint2 gq = *(const uint2*)(MG + og);
      *(uint2*)(MR + om) =
          pk4(__uint_as_float(gq.x << 16) * v[0] + __uint_as_float(t.x << 16), __uint_as_float(gq.x & 0xffff0000u) * v[1] + __uint_as_float(t.x & 0xffff0000u),
              __uint_as_float(gq.y << 16) * v[2] + __uint_as_float(t.y << 16), __uint_as_float(gq.y & 0xffff0000u) * v[3] + __uint_as_float(t.y & 0xffff0000u));
    });
  }
}
DI void ss_partial(int wv0, f32x4 (&acc)[2][2][4][2], float* SS, int brow, int pn) {
  const int lane = my_tid(wv0) & 63, wr = wv0 >> 2, wc = wv0 & 3;
#pragma unroll
  for (int ai = 0; ai < 2; ++ai)
#pragma unroll
    for (int m = 0; m < 4; ++m) {
      float s = 0.f;
#pragma unroll
      for (int bj = 0; bj < 2; ++bj)
#pragma unroll
        for (int n = 0; n < 2; ++n)
#pragma unroll
          for (int j = 0; j < 4; ++j) s += acc[ai][bj][m][n][j] * acc[ai][bj][m][n][j];
      s += __shfl_xor(s, 16);
      s += __shfl_xor(s, 32);
      if (lane < 16) SS[(size_t)(brow + ai * 128 + wr * 64 + m * 16 + lane) * 16 + pn * 4 + wc] = s;
    }
}
DI void phaseG(int wv0, PP p, unsigned char* smem) {
  const u16* MR = (const u16*)(p->ws + OFF_MERGED);
  u16* X1B = (u16*)(p->ws + OFF_X1B);
  float* SS1 = (float*)(p->ws + OFF_SS1);
  for (int id = blockIdx.x; id < 128 * 4; id += gridDim.x) {
    int pm, pn;
    tile_map_n4(id, pm, pn);
    pm = 127 - pm;
    const int brow = pm * 256, bcol = pn * 256;
    f32x4 acc[2][2][4][2];
    gemm256(wv0, acc, MR + (size_t)brow * 1024, 1024, (const u16*)(p->ws + OFF_WOT) + (size_t)bcol * 1024, 1024, 1024, smem);
    epi256(wv0, acc, brow, bcol, [&](int ai, int bj, int m, int n, int row, int col0, f32x4& v) {
      const size_t o = (size_t)row * 1024 + col0;
      const float4 xv = *(const float4*)(p->x + o);
      v[0] += xv.x; v[1] += xv.y; v[2] += xv.z; v[3] += xv.w;
      *(uint2*)(X1B + o) = pk4(v[0], v[1], v[2], v[3]);
    });
    ss_partial(wv0, acc, SS1, brow, pn);
  }
}
DI void phaseH(int wv0, PP p, unsigned char* smem) {
  const u16* X1B = (const u16*)(p->ws + OFF_X1B);
  const float* SS1 = (const float*)(p->ws + OFF_SS1);
  u16* ACT = (u16*)(p->ws + OFF_ACT);
  float* sR = (float*)(smem + 131072);
  for (int id = blockIdx.x; id < 128 * 16; id += gridDim.x) {
    int pm, pn;
    tile_map_n16(id, pm, pn);
    const int brow = pm * 256, bcol = pn * 256;
    const int tid = my_tid(wv0);
    if (tid < 256) {
      const float4* s = (const float4*)(SS1 + (size_t)(brow + tid) * 16);
      const float4 a = s[0], b = s[1], c = s[2], d = s[3];
      const float t = a.x + a.y + a.z + a.w + b.x + b.y + b.z + b.w + c.x + c.y + c.z + c.w + d.x + d.y + d.z + d.w;
      sR[tid] = rsqrtf(t * (1.f / 1024.f) + 1e-6f);
    }
    f32x4 acc[2][2][4][2];
    gemm256(wv0, acc, X1B + (size_t)brow * 1024, 1024, (const u16*)(p->ws + OFF_WUPT) + (size_t)bcol * 1024, 1024, 1024, smem);
    epi256(wv0, acc, brow, bcol, [&](int ai, int bj, int m, int n, int row, int col0, f32x4& v) {
      const float ri = sR[row - brow];
      const float a0 = fmaxf(v[0] * ri, 0.f), a1 = fmaxf(v[1] * ri, 0.f), a2 = fmaxf(v[2] * ri, 0.f), a3 = fmaxf(v[3] * ri, 0.f);
      *(uint2*)(ACT + (size_t)row * 4096 + col0) = pk4(a0 * a0, a1 * a1, a2 * a2, a3 * a3);
    });
    __syncthreads();
  }
}
DI void phaseI(int wv0, PP p, unsigned char* smem) {
  const u16* ACT = (const u16*)(p->ws + OFF_ACT);
  const u16* X1B = (const u16*)(p->ws + OFF_X1B);
  float* SS2 = (float*)(p->ws + OFF_SS2);
  for (int id = blockIdx.x; id < 128 * 4; id += gridDim.x) {
    int pm, pn;
    tile_map_n4(id, pm, pn);
    pm = 127 - pm;
    const int brow = pm * 256, bcol = pn * 256;
    f32x4 acc[2][2][4][2];
    gemm256(wv0, acc, ACT + (size_t)brow * 4096, 4096, (const u16*)(p->ws + OFF_WDT) + (size_t)bcol * 4096, 4096, 4096, smem);
    epi256(wv0, acc, brow, bcol, [&](int ai, int bj, int m, int n, int row, int col0, f32x4& v) {
      const size_t o = (size_t)row * 1024 + col0;
      const uint2 xb = *(const uint2*)(X1B + o);
      v[0] += __uint_as_float(xb.x << 16); v[1] += __uint_as_float(xb.x & 0xffff0000u);
      v[2] += __uint_as_float(xb.y << 16); v[3] += __uint_as_float(xb.y & 0xffff0000u);
      *(float4*)(p->out + o) = make_float4(v[0], v[1], v[2], v[3]);
    });
    ss_partial(wv0, acc, SS2, brow, pn);
  }
}
DI void phaseJ(int wv0, PP p) {
  const int lane = my_tid(wv0) & 63;
  const float* SS2 = (const float*)(p->ws + OFF_SS2);
  for (int row = blockIdx.x * 8 + wv0; row < T_; row += gridDim.x * 8) {
    float t = (lane < 16) ? SS2[(size_t)row * 16 + lane] : 0.f;
    t = wave_sum(t);
    const float rinv = rsqrtf(t * (1.f / 1024.f) + 1e-6f);
    float4* xr = (float4*)(p->out + (size_t)row * 1024);
#pragma unroll
    for (int r = 0; r < 4; ++r) {
      float4 v = xr[lane + 64 * r];
      const float4 g = ((const float4*)p->g3)[lane + 64 * r];
      v.x *= rinv * g.x; v.y *= rinv * g.y; v.z *= rinv * g.z; v.w *= rinv * g.w;
      xr[lane + 64 * r] = v;
    }
  }
}


#define XB_TMO      128
#define XB_XCNT(j)  (256  + 64 * (j))
#define XB_XSUB(j)  (1280 + 64 * (j))
#define XB_XGEN(j)  (2304 + 64 * (j))
#define XB_TOP      3328
#define XB_TOPGEN   3392
#define XB_SPIN_CAP (1u << 18)
#define LAS __attribute__((address_space(3)))
DI unsigned xb_ld(unsigned* p) { return __hip_atomic_load(p, __ATOMIC_RELAXED, __HIP_MEMORY_SCOPE_AGENT); }
DI unsigned xb_add(unsigned* p, unsigned v) { return __hip_atomic_fetch_add(p, v, __ATOMIC_RELAXED, __HIP_MEMORY_SCOPE_AGENT); }
DI unsigned xb_xcc_id() { return (unsigned)__builtin_amdgcn_s_getreg((3 << 11) | 20) & 0xFu; }
#define XB_SPIN(cond, bar) do { unsigned _sp = 0; while (cond) { __builtin_amdgcn_s_sleep(1); \
    if ((++_sp & 255u) == 0u) { if (xb_ld(&(bar)[XB_TMO])) break; if (_sp > XB_SPIN_CAP) { atomicAdd(&(bar)[XB_TMO], 1u); break; } } } } while (0)
DI void xcd_barrier_complete(unsigned* bar, unsigned x, unsigned& nloc, unsigned& nx) {
  const unsigned G = gridDim.x * gridDim.y * gridDim.z;
  unsigned sum, cnt, mine, sp = 0u;
  for (;;) {
    sum = 0u; cnt = 0u; mine = 0u;
#pragma unroll
    for (unsigned j = 0; j < 16; ++j) { const unsigned c = xb_ld(&bar[XB_XCNT(j)]); sum += c; cnt += (c > 0u) ? 1u : 0u; mine = (j == x) ? c : mine; }
    if (sum == G) break;
    __builtin_amdgcn_s_sleep(1);
    if ((++sp & 255u) == 0u) { if (xb_ld(&bar[XB_TMO])) break; if (sp > XB_SPIN_CAP) { atomicAdd(&bar[XB_TMO], 1u); break; } }
  }
  nloc = mine > 0u ? mine : 1u; nx = cnt > 0u ? cnt : 1u;
}
DI void xcd_barrier(unsigned* bar, volatile LAS unsigned* st, bool leader) {
  asm volatile("s_waitcnt vmcnt(0)" ::: "memory");
  __syncthreads();
  if (leader) {
    const unsigned x = xb_xcc_id();
    __builtin_amdgcn_s_waitcnt(0);
    unsigned nloc = st[0], nx = st[1];
    if (nloc == 0u) { xcd_barrier_complete(bar, x, nloc, nx); st[0] = nloc; st[1] = nx; }
    const unsigned old = xb_add(&bar[XB_XSUB(x)], 1u);
    const unsigned gen = old / nloc;
    if (old + 1u == (gen + 1u) * nloc) {
      __builtin_amdgcn_fence(__ATOMIC_RELEASE, "agent");
      asm volatile("s_waitcnt vmcnt(0)" ::: "memory");
      const unsigned og = xb_add(&bar[XB_TOP], 1u);
      const unsigned tg = og / nx;
      if (og + 1u == (tg + 1u) * nx) xb_add(&bar[XB_TOPGEN], 1u);
      else XB_SPIN(xb_ld(&bar[XB_TOPGEN]) == tg, bar);
      __builtin_amdgcn_fence(__ATOMIC_ACQUIRE, "agent");
      xb_add(&bar[XB_XGEN(x)], 1u);
      asm volatile("s_waitcnt vmcnt(0)" ::: "memory");
    } else {
      XB_SPIN(xb_ld(&bar[XB_XGEN(x)]) == gen, bar);
      __builtin_amdgcn_fence(__ATOMIC_ACQUIRE, "agent");
      asm volatile("s_waitcnt vmcnt(0)" ::: "memory");
    }
  }
  __syncthreads();
}

__global__ void __launch_bounds__(512, 2) mega(Params p) {
  extern __shared__ __attribute__((aligned(16))) unsigned char smem[];
  const int wv0 = __builtin_amdgcn_readfirstlane((int)(threadIdx.x >> 6));
  const int lo = p.lo, hi = p.hi;
  PP kp0 = (PP)__builtin_amdgcn_kernarg_segment_ptr();
  __shared__ uint4 xb_words;
  if (threadIdx.x == 0) {
    xb_words = make_uint4(0u, 0u, 0u, 0u);
    (void)xb_add((unsigned*)(kp0->ws + OFF_BAR) + XB_XCNT(xb_xcc_id()), 1u);
  }
  __syncthreads();
#define PH(N, CALL)                                  \
  if (lo <= N && N < hi) {                           \
    PP kp = kp0;                                     \
    asm volatile("" : "+s"(kp));                     \
    if (N > lo) {                                    \
      if (N == 1) cg::this_grid().sync();            \
      else xcd_barrier((unsigned*)(kp->ws + OFF_BAR), (volatile LAS unsigned*)&xb_words, my_tid(wv0) == 0); \
    }                                                \
    CALL;                                            \
    if ((PROBE_MASK >> N) & 1) { CALL; }             \
  }
  PH(0, phaseA(wv0, kp, smem))
  PH(1, phaseB(wv0, kp, smem))
  PH(2, phaseC(wv0, kp, smem))
  PH(3, phaseD1(wv0, kp, smem))
  PH(4, phaseD(wv0, kp, smem))
  PH(5, phaseE(wv0, kp, smem, 0))
  PH(6, phaseF(wv0, kp, smem))
  PH(7, phaseG(wv0, kp, smem))
  PH(8, phaseH(wv0, kp, smem))
  PH(9, phaseI(wv0, kp, smem))
  PH(10, phaseJ(wv0, kp))
}

extern "C" void kernel_launch(void* const* d_in, const int* in_sizes, int n_in, void* d_out, int out_size, void* d_ws,
                              size_t ws_size, hipStream_t stream) {
  static int grid_blocks = 0;
  if (!grid_blocks) {
    int dev = 0, cus = 0, per_cu = 0;
    (void)hipGetDevice(&dev);
    (void)hipDeviceGetAttribute(&cus, hipDeviceAttributeMultiprocessorCount, dev);
    (void)hipFuncSetAttribute((const void*)mega, hipFuncAttributeMaxDynamicSharedMemorySize, SMEM_BYTES);
    (void)hipOccupancyMaxActiveBlocksPerMultiprocessor(&per_cu, mega, NT_, SMEM_BYTES);
    if (per_cu > 1) per_cu = 1;
    if (per_cu < 1) per_cu = 1;
    grid_blocks = cus * per_cu;
  }
  if (ws_size < WS_NEED) { fprintf(stderr, "workspace too small: %zu < %zu\n", ws_size, (size_t)WS_NEED); }
  Params p{};
  const float** f = (const float**)&p;
  for (int i = 0; i < 24; ++i) f[i] = (const float*)d_in[i];
  p.out = (float*)d_out;
  p.ws = (unsigned char*)d_ws;
  p.lo = 0; p.hi = 11;
  (void)hipMemsetAsync((unsigned char*)d_ws + OFF_BAR, 0, 16384, stream);
  void* args[] = {&p};
  hipError_t e = hipLaunchCooperativeKernel((void*)mega, dim3(grid_blocks), dim3(NT_), args, SMEM_BYTES, stream);
  if (e != hipSuccess) fprintf(stderr, "cooperative launch failed: %s (grid %d)\n", hipGetErrorString(e), grid_blocks);
}
```
